# Optimizing an MI355X kernel written in HIP

```python
import jax, jax.numpy as jnp
from jax import lax
import numpy as np

D_MODEL = 1024
BATCH = 4
SEQ = 4096
DEPTH = 1

GRID_W = 64
CTX_LEN = 256
D_CONV = 512
CONV_W = 3
D_RWKV = 512
HEAD_SIZE = 64
N_RWKV_HEADS = D_RWKV // HEAD_SIZE
D_MIX = D_CONV + D_RWKV
D_DECAY_LORA = 64
D_AAA_LORA = 64
D_GATE_LORA = 128
COL_SIZES = (D_CONV, D_CONV, D_CONV, D_RWKV, D_RWKV, D_RWKV, D_GATE_LORA, D_DECAY_LORA, D_DECAY_LORA, D_AAA_LORA, D_AAA_LORA)
COL_SPLITS = (512, 1024, 1536, 2048, 2560, 3072, 3200, 3264, 3328, 3392)
D_IN_PROJ = 3 * D_CONV + 3 * D_RWKV + D_GATE_LORA + 2 * D_DECAY_LORA + 2 * D_AAA_LORA
N_KEYS = 128
N_EXPERTS = N_KEYS * N_KEYS
PEER_HEADS = 8
PEER_TOPK = 16
D_QUERY = 256
D_HALF = D_QUERY // 2
PEER_CHUNK = 128
NORM_EPS = 1e-6
LNX_EPS = 64e-5

kernel_name = 'hybrid_conv_rwkv7_peer_dit_layer'


def _rmsnorm(x, g):
    xf = x.astype(jnp.float32)
    xf = xf * lax.rsqrt(jnp.mean(xf * xf, axis=-1, keepdims=True) + NORM_EPS)
    return xf.astype(x.dtype) * g


def _modulate(h, shift, scale):
    return h * (1 + scale) + shift


def _neighbours(z):
    pad = [(0, 0)] * (z.ndim - 2) + [(1, 1), (0, 0)]
    zp = jnp.pad(z, pad)
    return zp[..., :-2, :], zp[..., 2:, :]


def _conv3(z, w):
    prev, nxt = _neighbours(z)
    return w[0] * prev + w[1] * z + w[2] * nxt


def _token_shift(z, mu_prev, mu_next):
    prev, nxt = _neighbours(z)
    return z + mu_prev * (prev - z) + mu_next * (nxt - z)


def _wkv_scan(s0, r, w, k, v, kk, a, reverse):
    xs = tuple(jnp.moveaxis(z, 1, 0) for z in (r, w, k, v, kk, a))

    def step(s, inp):
        r_t, w_t, k_t, v_t, kk_t, a_t = inp
        sa = jnp.einsum('bhvk,bhk->bhv', s, kk_t)
        s = (s * w_t[:, :, None, :]
             - sa[..., :, None] * (kk_t * a_t)[:, :, None, :]
             + v_t[..., :, None] * k_t[:, :, None, :])
        return s, jnp.einsum('bhvk,bhk->bhv', s, r_t)

    s_fin, ys = lax.scan(step, s0, xs, reverse=reverse)
    return s_fin, jnp.moveaxis(ys, 0, 1)


def _token_mixer(h, s0_fwd, s0_bwd, on_grid, with_output, w_in, w_out, conv_w, tshift_mu,
                 decay_w0, decay_w2, iclr_a0, iclr_a2, gate_w2, k_k, k_a, r_k, lnx_g, lnx_b):
    bsz, length, _ = h.shape
    (xb, xc_gate, xc, r, k, v, g_lo, wf_lo, wb_lo, af_lo, ab_lo) = jnp.split(h @ w_in, COL_SPLITS, axis=-1)

    def heads(z):
        return z.astype(jnp.float32).reshape(bsz, length, N_RWKV_HEADS, HEAD_SIZE)

    r = _token_shift(r, tshift_mu[0, 0], tshift_mu[1, 0])
    k = _token_shift(k, tshift_mu[0, 1], tshift_mu[1, 1])
    v = _token_shift(v, tshift_mu[0, 2], tshift_mu[1, 2])
    r_h, k_h, v_h = heads(r), heads(k), heads(v)
    kk = k_h * k_k.astype(jnp.float32).reshape(N_RWKV_HEADS, HEAD_SIZE)
    kk = kk * lax.rsqrt(jnp.sum(kk * kk, axis=-1, keepdims=True) + 1e-12)
    k_a_h = k_a.astype(jnp.float32).reshape(N_RWKV_HEADS, HEAD_SIZE)
    finals, outs = [], []
    for d, (lo_w, lo_a, s0) in enumerate(((wf_lo, af_lo, s0_fwd), (wb_lo, ab_lo, s0_bwd))):
        logw = -jax.nn.softplus(-(decay_w0[d] + jnp.tanh(lo_w) @ decay_w2[d]).astype(jnp.float32)) - 0.5
        decay = heads(jnp.exp(-jnp.exp(logw)))
        a = heads(jax.nn.sigmoid(iclr_a0[d] + lo_a @ iclr_a2[d]))
        k_d = k_h * (1 + (a - 1) * k_a_h)
        s_fin, y_d = _wkv_scan(s0, r_h, decay, k_d, v_h, kk, a, reverse=(d == 1))
        finals.append(s_fin)
        outs.append(y_d)
    if not with_output:
        return None, finals[0], finals[1]
    y = outs[0] + outs[1]
    mu = jnp.mean(y, axis=-1, keepdims=True)
    var = jnp.mean(jnp.square(y - mu), axis=-1, keepdims=True)
    y = ((y - mu) * lax.rsqrt(var + LNX_EPS)).reshape(bsz, length, D_RWKV) * lnx_g + lnx_b
    bonus = jnp.sum(r_h * k_h * r_k.astype(jnp.float32), axis=-1, keepdims=True) * v_h
    y = (y + bonus.reshape(bsz, length, D_RWKV)).astype(h.dtype)
    y_rwkv = y * (jax.nn.sigmoid(g_lo) @ gate_w2)

    z = xc_gate * xc
    if on_grid:
        rows = length // GRID_W
        z = _conv3(z.reshape(bsz, rows, GRID_W, D_CONV), conv_w).reshape(bsz, length, D_CONV)
    else:
        z = _conv3(z, conv_w)
    y_conv = xb * z

    out = jnp.concatenate([y_conv, y_rwkv], axis=-1) @ w_out
    return out, finals[0], finals[1]


def _peer(h, wq, subkeys, u, v):
    bsz, length, dim = h.shape
    chunks = h.reshape(-1, PEER_CHUNK, dim)

    def chunk_fn(hc):
        q = (hc @ wq).reshape(PEER_CHUNK, PEER_HEADS, 2, D_HALF)
        s = jnp.einsum('chsd,hskd->chsk', q, subkeys)
        vals, idx = lax.top_k(s, PEER_TOPK)
        cand = vals[:, :, 0, :, None] + vals[:, :, 1, None, :]
        cand_idx = idx[:, :, 0, :, None] * N_KEYS + idx[:, :, 1, None, :]
        sc, pos = lax.top_k(cand.reshape(PEER_CHUNK, PEER_HEADS, PEER_TOPK * PEER_TOPK), PEER_TOPK)
        ex = jnp.take_along_axis(cand_idx.reshape(PEER_CHUNK, PEER_HEADS, PEER_TOPK * PEER_TOPK), pos, axis=-1)
        g = jax.nn.softmax(sc.astype(jnp.float32), axis=-1).astype(hc.dtype)
        act = jax.nn.gelu(jnp.einsum('chkd,cd->chk', u[ex], hc), approximate=False)
        return jnp.einsum('chk,chkd->cd', g * act, v[ex])

    return lax.map(chunk_fn, chunks).reshape(bsz, length, dim)


def setup_inputs(seed: int = 0) -> dict:
    key = jax.random.key(seed)
    ks = jax.random.split(key, 25)
    L, D = DEPTH, D_MODEL

    def nrm(k, shape, s):
        return jax.random.normal(k, shape, jnp.float32) * s

    return {
        'x': nrm(ks[0], (BATCH, SEQ, D), 1.0),
        'c': nrm(ks[1], (BATCH, D), 1.0),
        'ctx': nrm(ks[2], (BATCH, CTX_LEN, D), 1.0),
        'c_ctx': nrm(ks[3], (D,), 1.0),
        'w_mod': nrm(ks[4], (L, D, 6 * D), 0.5 * D ** -0.5),
        'b_mod': nrm(ks[5], (L, 6 * D), 0.01),
        'norm_gains': 1.0 + nrm(ks[6], (L, 4, D), 0.05),
        'w_in': nrm(ks[7], (L, D, D_IN_PROJ), D ** -0.5),
        'w_out': nrm(ks[8], (L, D_MIX, D), D_MIX ** -0.5),
        'conv_w': nrm(ks[9], (L, CONV_W, D_CONV), CONV_W ** -0.5),
        'tshift_mu': jax.random.uniform(ks[10], (L, 2, 3, D_RWKV), jnp.float32, 0.0, 0.5),
        'decay_w0': jax.random.uniform(ks[11], (L, 2, D_RWKV), jnp.float32, -6.0, 0.0),
        'decay_w2': nrm(ks[12], (L, 2, D_DECAY_LORA, D_RWKV), 0.5 * D_DECAY_LORA ** -0.5),
        'iclr_a0': nrm(ks[13], (L, 2, D_RWKV), 0.5),
        'iclr_a2': nrm(ks[14], (L, 2, D_AAA_LORA, D_RWKV), 0.5 * D_AAA_LORA ** -0.5),
        'gate_w2': nrm(ks[15], (L, D_GATE_LORA, D_RWKV), D_GATE_LORA ** -0.5),
        'k_k': 0.85 + nrm(ks[16], (L, D_RWKV), 0.05),
        'k_a': 1.0 + nrm(ks[17], (L, D_RWKV), 0.05),
        'r_k': nrm(ks[18], (L, N_RWKV_HEADS, HEAD_SIZE), 0.1),
        'lnx_g': 1.0 + nrm(ks[19], (L, D_RWKV), 0.05),
        'lnx_b': nrm(ks[20], (L, D_RWKV), 0.01),
        'peer_wq': nrm(ks[21], (L, D, PEER_HEADS * D_QUERY), D ** -0.5),
        'peer_subkeys': nrm(ks[22], (L, PEER_HEADS, 2, N_KEYS, D_HALF), D_HALF ** -0.5),
        'peer_u': nrm(ks[23], (L, N_EXPERTS, D), D ** -0.5),
        'peer_v': nrm(ks[24], (L, N_EXPERTS, D), D ** -0.5),
    }


def reference(x, c, ctx, c_ctx, w_mod, b_mod, norm_gains, w_in, w_out, conv_w, tshift_mu,
              decay_w0, decay_w2, iclr_a0, iclr_a2, gate_w2, k_k, k_a, r_k, lnx_g, lnx_b,
              peer_wq, peer_subkeys, peer_u, peer_v):
    bsz = x.shape[0]
    s_zero = jnp.zeros((bsz, N_RWKV_HEADS, HEAD_SIZE, HEAD_SIZE), jnp.float32)
    for l in range(DEPTH):
        last = l == DEPTH - 1
        mp = dict(w_in=w_in[l], w_out=w_out[l], conv_w=conv_w[l], tshift_mu=tshift_mu[l],
                  decay_w0=decay_w0[l], decay_w2=decay_w2[l], iclr_a0=iclr_a0[l], iclr_a2=iclr_a2[l],
                  gate_w2=gate_w2[l], k_k=k_k[l], k_a=k_a[l], r_k=r_k[l], lnx_g=lnx_g[l], lnx_b=lnx_b[l])
        ng = norm_gains[l]
        mod_lat = (jax.nn.silu(c) @ w_mod[l] + b_mod[l])[:, None, :]
        sh1, sc1, gt1, sh2, sc2, gt2 = jnp.split(mod_lat, 6, axis=-1)
        mod_ctx = jax.nn.silu(c_ctx) @ w_mod[l] + b_mod[l]
        csh1, csc1, cgt1, csh2, csc2, cgt2 = jnp.split(mod_ctx, 6, axis=-1)

        hc = _modulate(_rmsnorm(ctx, ng[0]), csh1, csc1)
        yc, st_fwd, st_bwd = _token_mixer(hc, s_zero, s_zero, False, not last, **mp)
        hx = _modulate(_rmsnorm(x, ng[0]), sh1, sc1)
        yx, _, _ = _token_mixer(hx, st_fwd, st_bwd, True, True, **mp)
        x = x + gt1 * _rmsnorm(yx, ng[1])
        if not last:
            ctx = ctx + cgt1 * _rmsnorm(yc, ng[1])

        hx = _modulate(_rmsnorm(x, ng[2]), sh2, sc2)
        x = x + gt2 * _rmsnorm(_peer(hx, peer_wq[l], peer_subkeys[l], peer_u[l], peer_v[l]), ng[3])
        if not last:
            hc = _modulate(_rmsnorm(ctx, ng[2]), csh2, csc2)
            ctx = ctx + cgt2 * _rmsnorm(_peer(hc, peer_wq[l], peer_subkeys[l], peer_u[l], peer_v[l]), ng[3])
    return x
```

```cpp
#include <hip/hip_runtime.h>
#include <cstdio>
#include <cstdint>
namespace pg8 {
#define PG8_LAS __attribute__((address_space(3)))
typedef unsigned short bf16_t;
typedef short bf16x8 __attribute__((ext_vector_type(8)));
typedef float f32x4 __attribute__((ext_vector_type(4)));
typedef unsigned u32x4 __attribute__((ext_vector_type(4)));
constexpr int BM = 256, BK = 64, HALF = 128, HTB = HALF * BK * 2  , STAGE_BYTES = 8 * HTB, NXCD = 8, WGM = 8;

__host__ __device__ __forceinline__ int lds_byte(int r, int c) { const int st = (r >> 4) * 2 + (c >> 5), rr = r & 15, cc = c & 31, ob = rr * 64 + cc * 2; return st * 1024 + (ob ^ (((ob >> 9) & 1) << 5)); }
__host__ __device__ __forceinline__ void stage_rc(int b, int& R, int& C) { const int st = b / 1024, sb = b % 1024, swz = sb ^ (((sb >> 9) & 1) << 5); R = (st >> 1) * 16 + swz / 64; C = (st & 1) * 32 + (swz % 64) / 2; }
__host__ __device__ __forceinline__ int perm32(int rho) { const int n = rho >> 4, i = rho & 15; return 8 * (i >> 2) + 4 * n + (i & 3); }

struct Unit { int pm, pn; };
struct Gemm { const bf16_t* A; const bf16_t* Bt; int M, N, K; };

struct StaticOrder {
    int nM, nN, nwg, G, c;
    __host__ __device__ void init(int M, int N, int G_, int c_) { nM = M / BM; nN = N / BM; nwg = nM * nN; G = G_; c = c_; }
    __host__ __device__ bool next(int i, Unit& u) const {
        const long L = (long)i * G + c; if (L >= nwg) return false;
        int wgid = (int)L; { const int q = nwg / NXCD, r = nwg % NXCD, xcd = wgid % NXCD, off = wgid / NXCD; wgid = (xcd < r ? xcd * (q + 1) : r * (q + 1) + (xcd - r) * q) + off; }
        const int nig = WGM * nN, gid = wgid / nig, fm = gid * WGM, gsz = (nM - fm) < WGM ? (nM - fm) : WGM;
        u.pm = fm + ((wgid % nig) % gsz); u.pn = (wgid % nig) / gsz; return true;
    }
    __device__ __forceinline__ void a_ready(const Unit&) const {}
    __device__ __forceinline__ void done(const Unit&) const {}
};

__device__ __forceinline__ unsigned cvt_pk_bf16(float lo, float hi) { unsigned r; asm volatile("v_cvt_pk_bf16_f32 %0, %1, %2" : "=v"(r) : "v"(lo), "v"(hi)); return r; }
typedef float f32x2 __attribute__((ext_vector_type(2)));
__device__ __forceinline__ f32x2 gelu_pk(f32x2 v) {
    const f32x2 av = __builtin_elementwise_abs(v), d = av * 0.2316418882f + 1.0f;
    f32x2 t; t.x = __builtin_amdgcn_rcpf(d.x); t.y = __builtin_amdgcn_rcpf(d.y);
    f32x2 q = t * 0.5307027145f + (-0.7265760135f); q = q * t + 0.7107068705f; q = q * t + (-0.142248368f); q = q * t + 0.127414796f; q = q * t;
    const f32x2 s = (v * v) * (-0.72134752044f);
    f32x2 e; e.x = __builtin_amdgcn_exp2f(s.x); e.y = __builtin_amdgcn_exp2f(s.y);
    const f32x2 m = v * (q * e), r = v - m;
    f32x2 o; o.x = v.x < 0.f ? m.x : r.x; o.y = v.y < 0.f ? m.y : r.y; return o;
}

template <int ACT  > struct EpiBf16 {
    static constexpr bool PERM = true, AFTER_DRAIN = false; static_assert(ACT == 0 || ACT == 1, "EpiBf16: ACT is 0 (none) or 1 (gelu_pk)");
    bf16_t* O; int ldc; const float* bias; int split_cols; size_t split_stride; float scale0;
    __device__ __forceinline__ void operator()(const f32x4 (&acc)[2][2][4][2], const Unit& u, int wr, int wc, int fr, int fq) const {
        const int row0 = u.pm * BM + wr * 64 + fr; int colt = u.pn * BM; bf16_t* base = O;
        float sc = 1.f; if (split_cols) { const int t = colt / split_cols; base += (size_t)t * split_stride; colt -= t * split_cols; if (t == 0) sc = scale0; }
        const int col0 = colt + wc * 32 + 8 * fq, bcol0 = u.pn * BM + wc * 32 + 8 * fq;
        f32x4 bv[2][2];
#pragma unroll
        for (int bj = 0; bj < 2; ++bj)
#pragma unroll
            for (int n = 0; n < 2; ++n) bv[bj][n] = bias ? *(const f32x4*)(bias + bcol0 + bj * HALF + 4 * n) : (f32x4){0.f, 0.f, 0.f, 0.f};
#pragma unroll
        for (int ai = 0; ai < 2; ++ai)
#pragma unroll
            for (int m = 0; m < 4; ++m) { bf16_t* rowp = base + (size_t)(row0 + ai * HALF + m * 16) * ldc + col0;
#pragma unroll
                for (int bj = 0; bj < 2; ++bj) { f32x4 v0 = acc[ai][bj][m][0] + bv[bj][0], v1 = acc[ai][bj][m][1] + bv[bj][1];
                    if (ACT == 1) { f32x2 a = gelu_pk((f32x2){v0[0], v0[1]}), b = gelu_pk((f32x2){v0[2], v0[3]}), c = gelu_pk((f32x2){v1[0], v1[1]}), d = gelu_pk((f32x2){v1[2], v1[3]});
                        v0 = (f32x4){a.x, a.y, b.x, b.y}; v1 = (f32x4){c.x, c.y, d.x, d.y}; }
                    v0 = v0 * sc; v1 = v1 * sc; u32x4 w; w.x = cvt_pk_bf16(v0[0], v0[1]); w.y = cvt_pk_bf16(v0[2], v0[3]); w.z = cvt_pk_bf16(v1[0], v1[1]); w.w = cvt_pk_bf16(v1[2], v1[3]);
                    *(u32x4*)(rowp + bj * HALF) = w; } }
    }
};

struct EpiF32 {
    static constexpr bool PERM = false, AFTER_DRAIN = false;
    float* C; int ldc;
    __device__ __forceinline__ void operator()(const f32x4 (&acc)[2][2][4][2], const Unit& u, int wr, int wc, int fr, int fq) const {
        const int row0 = u.pm * BM + wr * 64 + fr, col0 = u.pn * BM + wc * 32 + 4 * fq;
#pragma unroll
        for (int ai = 0; ai < 2; ++ai)
#pragma unroll
            for (int m = 0; m < 4; ++m) { float* rowp = C + (size_t)(row0 + ai * HALF + m * 16) * ldc + col0;
#pragma unroll
                for (int bj = 0; bj < 2; ++bj)
#pragma unroll
                    for (int n = 0; n < 2; ++n) *(f32x4*)(rowp + bj * HALF + n * 16) = acc[ai][bj][m][n]; }
    }
};
struct EpiProj {
    static constexpr bool PERM = true, AFTER_DRAIN = false;
    bf16_t* O; int ldc; int ncols;
    __device__ __forceinline__ void operator()(const f32x4 (&acc)[2][2][4][2], const Unit& u, int wr, int wc, int fr, int fq) const {
        const int row0 = u.pm * BM + wr * 64 + fr; const int col0 = u.pn * BM + wc * 32 + 8 * fq;
#pragma unroll
        for (int ai = 0; ai < 2; ++ai)
#pragma unroll
            for (int m = 0; m < 4; ++m) { bf16_t* rowp = O + (size_t)(row0 + ai * HALF + m * 16) * ldc + col0;
#pragma unroll
                for (int bj = 0; bj < 2; ++bj) { const f32x4 v0 = acc[ai][bj][m][0], v1 = acc[ai][bj][m][1];
                    u32x4 w; w.x = cvt_pk_bf16(v0[0], v0[1]); w.y = cvt_pk_bf16(v0[2], v0[3]); w.z = cvt_pk_bf16(v1[0], v1[1]); w.w = cvt_pk_bf16(v1[2], v1[3]);
                    if (col0 + bj * HALF < ncols) *(u32x4*)(rowp + bj * HALF) = w; } }
    }
};
template <class Epi, class Sched, bool ALIGN_EPI = false, bool SP2 = false>
__device__ __forceinline__ void gemm_phase(PG8_LAS unsigned char* lds, const Gemm g, const Sched& S, const Epi& E) {
    const int tid = threadIdx.x, wid = __builtin_amdgcn_readfirstlane(tid >> 6), lane = tid & 63, wr = wid >> 2, wc = wid & 3, fr = lane & 15, fq = lane >> 4;
    const int K = g.K, nt = K / BK;
    unsigned voffA[2], voffB[2];
#pragma unroll
    for (int i = 0; i < 2; ++i) { int R, C; stage_rc(tid * 16 + i * 8192, R, C); const int Rb = Epi::PERM ? ((R & ~31) + perm32(R & 31)) : R;
        voffA[i] = (unsigned)(R * K + C) * 2u; voffB[i] = (unsigned)(Rb * K + C) * 2u; }
    const size_t kstep = (size_t)(BK * 2);
    const size_t hstep = (size_t)HALF * K * 2;
    const size_t tstep = 2 * hstep;
    const unsigned ldsw = (unsigned)wid * 1024u;
    const int aoff = lds_byte(wr * 64 + fr, fq * 8), boff = lds_byte(wc * 32 + fr, fq * 8);
#define PG8_SA(b, h) (((b) * 2 + (h)) * HTB)
#define PG8_SB(b, h) ((4 + (b) * 2 + (h)) * HTB)
#define PG8_STAGE(bufoff, gbase, voff) do { _Pragma("unroll") for (int _i = 0; _i < 2; ++_i) \
        __builtin_amdgcn_global_load_lds((const unsigned*)((const char*)(gbase) + (voff)[_i]), (PG8_LAS unsigned*)(lds + (bufoff) + ldsw + _i * 8192), 16, 0, 0); } while (0)
#define PG8_LDA(dst, b, h) do { _Pragma("unroll") for (int m = 0; m < 4; ++m) _Pragma("unroll") for (int k = 0; k < 2; ++k) dst[m][k] = *(const PG8_LAS bf16x8*)(lds + PG8_SA(b, h) + aoff + m * 2048 + k * 1024); } while (0)
#define PG8_LDB(dst, b, h) do { _Pragma("unroll") for (int n = 0; n < 2; ++n) _Pragma("unroll") for (int k = 0; k < 2; ++k) dst[n][k] = *(const PG8_LAS bf16x8*)(lds + PG8_SB(b, h) + boff + n * 2048 + k * 1024); } while (0)
#define PG8_MMA(ai, bj, At, Bt) do { __builtin_amdgcn_s_setprio(1); _Pragma("unroll") for (int m = 0; m < 4; ++m) _Pragma("unroll") for (int n = 0; n < 2; ++n) _Pragma("unroll") for (int k = 0; k < 2; ++k) \
        acc[ai][bj][m][n] = __builtin_amdgcn_mfma_f32_16x16x32_bf16(Bt[n][k], At[m][k], acc[ai][bj][m][n], 0, 0, 0); __builtin_amdgcn_s_setprio(0); } while (0)
#define PG8_WAIT_V(n) asm volatile("s_waitcnt vmcnt(" #n ")" ::: "memory")
#define PG8_WAIT_L(n) asm volatile("s_waitcnt lgkmcnt(" #n ")" ::: "memory")
#define PG8_BAR __builtin_amdgcn_s_barrier()
#define PG8_SCHED __builtin_amdgcn_sched_barrier(0)
    Unit cur, nxt; int ui = 0;
    if (!S.next(0, cur)) return;
    f32x4 acc[2][2][4][2];
#pragma unroll
    for (int a = 0; a < 2; ++a)
#pragma unroll
        for (int b = 0; b < 2; ++b)
#pragma unroll
            for (int m = 0; m < 4; ++m)
#pragma unroll
                for (int n = 0; n < 2; ++n) acc[a][b][m][n] = (f32x4){0.f, 0.f, 0.f, 0.f};
    bf16x8 At[4][2], B0[2][2], B1[2][2];
    const char* cA = (const char*)g.A + (size_t)cur.pm * tstep; const char* cB = (const char*)g.Bt + (size_t)cur.pn * tstep;
    S.a_ready(cur);
    if constexpr (SP2) {
        PG8_STAGE(PG8_SB(0, 0), cB, voffB); PG8_STAGE(PG8_SB(0, 1), cB + hstep, voffB); PG8_STAGE(PG8_SA(0, 0), cA, voffA); PG8_STAGE(PG8_SA(0, 1), cA + hstep, voffA);
        if (wr == 1) PG8_BAR;
        PG8_WAIT_V(2); PG8_BAR;
        PG8_STAGE(PG8_SB(1, 0), cB + kstep, voffB); PG8_STAGE(PG8_SA(1, 0), cA + kstep, voffA); PG8_STAGE(PG8_SB(1, 1), cB + hstep + kstep, voffB);
        PG8_WAIT_V(6); PG8_BAR;
    } else {
        PG8_STAGE(PG8_SB(0, 0), cB, voffB); PG8_STAGE(PG8_SA(0, 0), cA, voffA); PG8_STAGE(PG8_SB(0, 1), cB + hstep, voffB); PG8_STAGE(PG8_SA(0, 1), cA + hstep, voffA);
        if (wr == 1) PG8_BAR;
        PG8_WAIT_V(4); PG8_BAR;
        PG8_STAGE(PG8_SB(1, 0), cB + kstep, voffB); PG8_STAGE(PG8_SA(1, 0), cA + kstep, voffA); PG8_STAGE(PG8_SB(1, 1), cB + hstep + kstep, voffB);
        PG8_WAIT_V(6); PG8_BAR;
    }
    for (;;) {
        const bool has_next = S.next(ui + 1, nxt);
        const char* nA = has_next ? (const char*)g.A + (size_t)nxt.pm * tstep : cA; const char* nB = has_next ? (const char*)g.Bt + (size_t)nxt.pn * tstep : cB;
        for (int t = 0; t < nt; t += 2) {
            const bool last = (t == nt - 2);
            const char* a1 = cA + (size_t)(t + 1) * kstep;
            const char* a2 = last ? nA : cA + (size_t)(t + 2) * kstep; const char* b2 = last ? nB : cB + (size_t)(t + 2) * kstep;
            const char* a3 = a2 + kstep; const char* b3 = b2 + kstep;
            if (last && has_next) S.a_ready(nxt);
            if constexpr (SP2) {
            PG8_LDB(B0, 0, 0); PG8_LDB(B1, 0, 1); PG8_SCHED; PG8_LDA(At, 0, 0); PG8_STAGE(PG8_SA(1, 1), a1 + hstep, voffA);
            PG8_WAIT_V(8); PG8_WAIT_L(0); PG8_BAR; PG8_MMA(0, 0, At, B0); PG8_MMA(0, 1, At, B1); PG8_BAR; PG8_SCHED;
            PG8_LDA(At, 0, 1); PG8_STAGE(PG8_SB(0, 0), b2, voffB); PG8_STAGE(PG8_SB(0, 1), b2 + hstep, voffB); PG8_STAGE(PG8_SA(0, 0), a2, voffA);
            PG8_WAIT_V(8); PG8_WAIT_L(0); PG8_BAR; PG8_MMA(1, 0, At, B0); PG8_MMA(1, 1, At, B1); PG8_BAR; PG8_SCHED;
            PG8_LDB(B0, 1, 0); PG8_LDB(B1, 1, 1); PG8_SCHED; PG8_LDA(At, 1, 0); PG8_STAGE(PG8_SA(0, 1), a2 + hstep, voffA);
            PG8_WAIT_V(8); PG8_WAIT_L(0); PG8_BAR; PG8_MMA(0, 0, At, B0); PG8_MMA(0, 1, At, B1); PG8_BAR; PG8_SCHED;
            PG8_LDA(At, 1, 1); PG8_STAGE(PG8_SB(1, 0), b3, voffB); PG8_STAGE(PG8_SB(1, 1), b3 + hstep, voffB); PG8_STAGE(PG8_SA(1, 0), a3, voffA);
            PG8_WAIT_V(8); PG8_WAIT_L(0); PG8_BAR; PG8_MMA(1, 0, At, B0); PG8_MMA(1, 1, At, B1); PG8_BAR; PG8_SCHED;
            } else {
            PG8_LDB(B0, 0, 0); PG8_SCHED; PG8_LDA(At, 0, 0); PG8_STAGE(PG8_SA(1, 1), a1 + hstep, voffA);
            PG8_WAIT_L(8); PG8_BAR; PG8_WAIT_L(0); PG8_MMA(0, 0, At, B0); PG8_BAR; PG8_SCHED;
            PG8_LDB(B1, 0, 1); PG8_STAGE(PG8_SB(0, 0), b2, voffB);
            PG8_BAR; PG8_WAIT_L(0); PG8_MMA(0, 1, At, B1); PG8_BAR;
            PG8_LDA(At, 0, 1); PG8_STAGE(PG8_SA(0, 0), a2, voffA);
            PG8_BAR; PG8_WAIT_L(0); PG8_MMA(1, 0, At, B0); PG8_BAR; PG8_SCHED;
            PG8_STAGE(PG8_SB(0, 1), b2 + hstep, voffB);
            PG8_WAIT_V(6); PG8_BAR; PG8_MMA(1, 1, At, B1); PG8_BAR;
            PG8_LDB(B0, 1, 0); PG8_SCHED; PG8_LDA(At, 1, 0); PG8_STAGE(PG8_SA(0, 1), a2 + hstep, voffA);
            PG8_WAIT_L(8); PG8_BAR; PG8_WAIT_L(0); PG8_MMA(0, 0, At, B0); PG8_BAR; PG8_SCHED;
            PG8_LDB(B1, 1, 1); PG8_STAGE(PG8_SB(1, 0), b3, voffB);
            PG8_BAR; PG8_WAIT_L(0); PG8_MMA(0, 1, At, B1); PG8_BAR;
            PG8_LDA(At, 1, 1); PG8_STAGE(PG8_SA(1, 0), a3, voffA);
            PG8_BAR; PG8_WAIT_L(0); PG8_MMA(1, 0, At, B0); PG8_BAR; PG8_SCHED;
            PG8_STAGE(PG8_SB(1, 1), b3 + hstep, voffB);
            PG8_WAIT_V(6); PG8_BAR; PG8_MMA(1, 1, At, B1); PG8_BAR;
            }
        }
        if constexpr (ALIGN_EPI) { if (wr == 0) PG8_BAR; }
        if constexpr (!Epi::AFTER_DRAIN) { E(acc, cur, wr, wc, fr, fq); S.done(cur); }
        if (!has_next) break;
#pragma unroll
        for (int a = 0; a < 2; ++a)
#pragma unroll
            for (int b = 0; b < 2; ++b)
#pragma unroll
                for (int m = 0; m < 4; ++m)
#pragma unroll
                    for (int n = 0; n < 2; ++n) acc[a][b][m][n] = (f32x4){0.f, 0.f, 0.f, 0.f};
        cur = nxt; cA = nA; cB = nB; ++ui;
        if constexpr (ALIGN_EPI) { if (wr == 1) PG8_BAR; }
    }
    PG8_WAIT_V(0);
    if constexpr (!ALIGN_EPI) { if (wr == 0) PG8_BAR; }
    PG8_BAR;
    if constexpr (Epi::AFTER_DRAIN) { E.fused(acc, cur, wr, wc, fr, fq, lds, wid, lane); S.done(cur); }
#undef PG8_SA
#undef PG8_SB
#undef PG8_STAGE
#undef PG8_LDA
#undef PG8_LDB
#undef PG8_MMA
#undef PG8_WAIT_V
#undef PG8_WAIT_L
#undef PG8_BAR
#undef PG8_SCHED
}
}
#ifndef PG8_SP2
#define PG8_SP2 true
#endif
#ifndef PG8_ALIGN
#define PG8_ALIGN true
#endif
constexpr int NWAVES = 8;
constexpr int D = 1024, NB = 4, T = 4096, TC = 256;
constexpr int MX = NB * T, MC = NB * TC, MA = MX + MC;
constexpr int NPROJ = 3456, NPROJ_PAD = 3584;
constexpr int COL_XB = 0, COL_XG = 512, COL_XC = 1024, COL_R = 1536, COL_K = 2048, COL_V = 2560, COL_G = 3072, COL_LW = 3200, COL_LA = 3328;
constexpr int NMOD = 6 * D;
constexpr int NEXP = 16384, NSC = 2048;
constexpr float NORM_EPS = 1e-6f, LNX_EPS = 64e-5f;
#ifndef MK_N_LAUNCHES
#define MK_N_LAUNCHES 9
#endif
constexpr int NPH = 9;
constexpr size_t MiB = 1u << 20;
constexpr size_t WS_CTL = 0, CTL_ZERO_BYTES = 64 * 1024;
constexpr size_t WS_MOD = 3 * MiB;
constexpr size_t WS_WINT = 6 * MiB;
constexpr size_t WS_WOUTT = 13 * MiB;
constexpr size_t WS_WEFFT = 15 * MiB;
constexpr size_t WS_U = 20 * MiB, WS_V = 52 * MiB;
constexpr size_t WS_HX = 84 * MiB;
constexpr size_t WS_PROJ = 118 * MiB;
constexpr size_t WS_END = 246 * MiB;
static_assert(WS_PROJ + (size_t)MA * NPROJ * 2 <= WS_END && WS_PROJ + (size_t)MX * NSC * 4 <= WS_END && WS_HX + (size_t)MA * D * 2 <= WS_PROJ, "d_ws map");
constexpr int CW_BAR = 1024;
constexpr int RING_BYTES = 131072;
constexpr int LDSCTL_OFF = RING_BYTES, MISC_OFF = LDSCTL_OFF + 320;
constexpr int LDS_BYTES = 147456;

#define GAS __attribute__((address_space(1)))
#define LAS __attribute__((address_space(3)))
typedef unsigned short bf16;
typedef unsigned v4u __attribute__((ext_vector_type(4)));
typedef unsigned v2u __attribute__((ext_vector_type(2)));
typedef float f32x4 __attribute__((ext_vector_type(4)));
typedef float f32x2 __attribute__((ext_vector_type(2)));
typedef float f32x16 __attribute__((ext_vector_type(16)));
typedef short bf16x8 __attribute__((ext_vector_type(8)));
typedef GAS unsigned gu32;
#define RLX_AGENT __ATOMIC_RELAXED, __HIP_MEMORY_SCOPE_AGENT
#define LDS_WAIT() asm volatile("s_waitcnt lgkmcnt(0)" ::: "memory")
#define VM_WAIT() asm volatile("s_waitcnt vmcnt(0)" ::: "memory")
__device__ __forceinline__ unsigned pk2(float lo, float hi) { return pg8::cvt_pk_bf16(lo, hi); }
__device__ __forceinline__ float bf_lo(unsigned w) { return __builtin_bit_cast(float, w << 16); }
__device__ __forceinline__ float bf_hi(unsigned w) { return __builtin_bit_cast(float, w & 0xffff0000u); }
__device__ __forceinline__ float bf1(bf16 b) { return __builtin_bit_cast(float, (unsigned)b << 16); }
__device__ __forceinline__ float fast_exp(float x) { return __builtin_amdgcn_exp2f(x * 1.44269504089f); }
__device__ __forceinline__ float fast_rcp(float x) { return __builtin_amdgcn_rcpf(x); }
__device__ __forceinline__ float sigmoidf(float x) { return fast_rcp(1.f + fast_exp(-x)); }
__device__ __forceinline__ float tanh_fast(float x) { return 1.f - 2.f * fast_rcp(fast_exp(2.f * x) + 1.f); }
__device__ __forceinline__ float siluf(float x) { return x * sigmoidf(x); }
template <int CTRL> __device__ __forceinline__ float dppf(float x) { return __builtin_bit_cast(float, __builtin_amdgcn_update_dpp(0, __builtin_bit_cast(int, x), CTRL, 0xF, 0xF, false)); }
template <int CTRL> __device__ __forceinline__ unsigned dppu(unsigned x) { return (unsigned)__builtin_amdgcn_update_dpp(0, (int)x, CTRL, 0xF, 0xF, false); }
__device__ __forceinline__ float rowsum16(float x) { x += dppf<0xB1>(x); x += dppf<0x4E>(x); x += dppf<0x141>(x); x += dppf<0x140>(x); return x; }
__device__ __forceinline__ float wave_sum(float v) {
    v = rowsum16(v); v += __shfl_xor(v, 16); v += __shfl_xor(v, 32); return v;
}
__device__ __forceinline__ float half_sum32(float v) { v = rowsum16(v); v += __shfl_xor(v, 16); return v; }
__device__ __forceinline__ unsigned umaxu(unsigned a, unsigned b) { return a > b ? a : b; }
__device__ __forceinline__ unsigned wave_max_u32(unsigned x) {
    x = umaxu(x, dppu<0xB1>(x)); x = umaxu(x, dppu<0x4E>(x)); x = umaxu(x, dppu<0x141>(x)); x = umaxu(x, dppu<0x140>(x));
    const unsigned a = __builtin_amdgcn_readlane((int)x, 0), b = __builtin_amdgcn_readlane((int)x, 16), c = __builtin_amdgcn_readlane((int)x, 32), d = __builtin_amdgcn_readlane((int)x, 48);
    return umaxu(umaxu(a, b), umaxu(c, d));
}
__device__ __forceinline__ unsigned f2key(float f) { const unsigned u = __builtin_bit_cast(unsigned, f); return (u & 0x80000000u) ? ~u : (u | 0x80000000u); }
__device__ __forceinline__ float key2f(unsigned k) { const unsigned u = (k & 0x80000000u) ? (k ^ 0x80000000u) : ~k; return __builtin_bit_cast(float, u); }
#define XB_TMO      128
#define XB_XCNT(j)  (256  + 64 * (j))
#define XB_XSUB(j)  (1280 + 64 * (j))
#define XB_XGEN(j)  (2304 + 64 * (j))
#define XB_TOP      3328
#define XB_TOPGEN   3392
#define XCD_BAR_WORDS 3456
#define XB_SPIN_CAP (1u << 18)

__device__ __forceinline__ unsigned xb_ld(unsigned* p)              { return __hip_atomic_load(p, __ATOMIC_RELAXED, __HIP_MEMORY_SCOPE_AGENT); }
__device__ __forceinline__ unsigned xb_add(unsigned* p, unsigned v) { return __hip_atomic_fetch_add(p, v, __ATOMIC_RELAXED, __HIP_MEMORY_SCOPE_AGENT); }
__device__ __forceinline__ unsigned xb_xcc_id() { return (unsigned)__builtin_amdgcn_s_getreg((3 << 11) | 20) & 0xFu; }
#define XB_SPIN(cond, bar) do { unsigned _sp = 0; while (cond) { __builtin_amdgcn_s_sleep(1); \
    if ((++_sp & 255u) == 0u) { if (xb_ld(&(bar)[XB_TMO])) break; if (_sp > XB_SPIN_CAP) { atomicAdd(&(bar)[XB_TMO], 1u); break; } } } } while (0)

struct XcdBarrier {
    unsigned* bar; unsigned x;
    volatile LAS unsigned* st;
};

__device__ __forceinline__ XcdBarrier xcd_barrier_post(unsigned* bar, volatile LAS unsigned* st) {
    XcdBarrier b; b.bar = bar; b.x = xb_xcc_id(); b.st = st;
    if (threadIdx.x == 0) (void)xb_add(&bar[XB_XCNT(b.x)], 1u);
    return b;
}
__device__ __forceinline__ void xcd_barrier_complete(unsigned* bar, unsigned x, unsigned& nloc, unsigned& nx) {
    const unsigned G = gridDim.x * gridDim.y * gridDim.z;
    unsigned sum, cnt, mine, sp = 0u;
    for (;;) {
        sum = 0u; cnt = 0u; mine = 0u;
#pragma unroll
        for (unsigned j = 0; j < 16; ++j) { const unsigned c = xb_ld(&bar[XB_XCNT(j)]); sum += c; cnt += (c > 0u) ? 1u : 0u; mine = (j == x) ? c : mine; }
        if (sum == G) break;
        __builtin_amdgcn_s_sleep(1);
        if ((++sp & 255u) == 0u) { if (xb_ld(&bar[XB_TMO])) break; if (sp > XB_SPIN_CAP) { atomicAdd(&bar[XB_TMO], 1u); break; } }
    }
    nloc = mine > 0u ? mine : 1u; nx = cnt > 0u ? cnt : 1u;
}

__device__ __forceinline__ void xcd_barrier(const XcdBarrier& b) {
    asm volatile("s_waitcnt vmcnt(0)" ::: "memory");
    __syncthreads();
    if (threadIdx.x == 0) {
        unsigned* bar = b.bar;
        __builtin_amdgcn_s_waitcnt(0);
        unsigned nloc = b.st[0], nx = b.st[1];
        if (nloc == 0u) { xcd_barrier_complete(bar, b.x, nloc, nx); b.st[0] = nloc; b.st[1] = nx; }
        const unsigned old = xb_add(&bar[XB_XSUB(b.x)], 1u);
        const unsigned gen = old / nloc;
        if (old + 1u == (gen + 1u) * nloc) {
            __builtin_amdgcn_fence(__ATOMIC_RELEASE, "agent");
            asm volatile("s_waitcnt vmcnt(0)" ::: "memory");
            const unsigned og = xb_add(&bar[XB_TOP], 1u);
            const unsigned tg = og / nx;
            if (og + 1u == (tg + 1u) * nx) xb_add(&bar[XB_TOPGEN], 1u);
            else XB_SPIN(xb_ld(&bar[XB_TOPGEN]) == tg, bar);
            __builtin_amdgcn_fence(__ATOMIC_ACQUIRE, "agent");
            xb_add(&bar[XB_XGEN(b.x)], 1u);
            asm volatile("s_waitcnt vmcnt(0)" ::: "memory");
        } else {
            XB_SPIN(xb_ld(&bar[XB_XGEN(b.x)]) == gen, bar);
            __builtin_amdgcn_fence(__ATOMIC_ACQUIRE, "agent");
            asm volatile("s_waitcnt vmcnt(0)" ::: "memory");
        }
    }
    __syncthreads();
}
struct Frame {
    LAS unsigned char* lds;
    volatile LAS unsigned* MISC;
    gu32* ctl;
    int tid, lane, wave, G, bid;
    const float* in[25];
    float* out;
    unsigned char* ws;
};
enum { I_X = 0, I_C, I_CTX, I_CCTX, I_WMOD, I_BMOD, I_NG, I_WIN, I_WOUT, I_CONVW, I_TMU, I_DW0, I_DW2, I_A0, I_A2, I_GW2, I_KK, I_KA, I_RK, I_LNG, I_LNB, I_WQ, I_SUBK, I_PU, I_PV };

__device__ __forceinline__ void p0_transpose_item(const float* W, int K, int N, bf16* WT, LAS float* scr, int item, int lane) {
    const int nblk = N / 32, kb = item / nblk, nb = item % nblk, k0 = 64 * kb, n0 = 32 * nb;
#pragma unroll 8
    for (int i = 0; i < 32; ++i) { const int kk = 2 * i + (lane >> 5); scr[kk * 33 + (lane & 31)] = W[(size_t)(k0 + kk) * N + n0 + (lane & 31)]; }
    LDS_WAIT(); asm volatile("" ::: "memory");
    const int c = lane & 7;
#pragma unroll
    for (int j = 0; j < 4; ++j) { const int n = (lane >> 3) + 8 * j; const LAS float* s = scr + (8 * c) * 33 + n;
        v4u o; o.x = pk2(s[0 * 33], s[1 * 33]); o.y = pk2(s[2 * 33], s[3 * 33]); o.z = pk2(s[4 * 33], s[5 * 33]); o.w = pk2(s[6 * 33], s[7 * 33]);
        *(v4u*)(WT + (size_t)(n0 + n) * K + k0 + 8 * c) = o; }
    LDS_WAIT(); asm volatile("" ::: "memory");
}
__device__ __forceinline__ void p0_mod_item(Frame& F, int cb) {
    LAS float* S = (LAS float*)F.lds;
    LAS float* RED = (LAS float*)(F.lds + 32768);
    const float* c = F.in[I_C]; const float* cc = F.in[I_CCTX];
    for (int i = F.tid; i < 5 * D; i += 512) { const int r = i >> 10, k = i & 1023; const float v = (r < 4) ? c[r * D + k] : cc[k]; S[i] = siluf(v); }
    __syncthreads();
    const int col = F.tid & 63, kg = F.tid >> 6;
    const float* wp = F.in[I_WMOD] + (size_t)(kg * 128) * NMOD + cb * 64 + col;
    float a0 = 0.f, a1 = 0.f, a2 = 0.f, a3 = 0.f, a4 = 0.f;
#pragma unroll 8
    for (int k = 0; k < 128; ++k) { const float w = wp[(size_t)k * NMOD]; const int kk = kg * 128 + k;
        a0 += S[kk] * w; a1 += S[D + kk] * w; a2 += S[2 * D + kk] * w; a3 += S[3 * D + kk] * w; a4 += S[4 * D + kk] * w; }
    RED[(kg * 5 + 0) * 64 + col] = a0; RED[(kg * 5 + 1) * 64 + col] = a1; RED[(kg * 5 + 2) * 64 + col] = a2; RED[(kg * 5 + 3) * 64 + col] = a3; RED[(kg * 5 + 4) * 64 + col] = a4;
    __syncthreads();
    if (F.tid < 320) { const int r = F.tid >> 6, cl = F.tid & 63; float s = F.in[I_BMOD][cb * 64 + cl];
#pragma unroll
        for (int g = 0; g < 8; ++g) s += RED[(g * 5 + r) * 64 + cl];
        ((float*)(F.ws + WS_MOD))[r * NMOD + cb * 64 + cl] = s; }
    __syncthreads();
}
__device__ __forceinline__ void p0_weff_item(Frame& F, int item) {
    const int hs = item >> 4, kb = item & 15;
    LAS float* SK = (LAS float*)F.lds;
    LAS float* WQ = (LAS float*)(F.lds + 128 * 132 * 4);
    const float* sk = F.in[I_SUBK] + (size_t)hs * 128 * 128;
    const float* wq = F.in[I_WQ] + (size_t)(kb * 64) * 2048 + hs * 128;
#pragma unroll
    for (int i = 0; i < 8; ++i) { const int idx = F.tid + 512 * i, row = idx >> 5, c4 = idx & 31; const f32x4 v = *(const f32x4*)(sk + row * 128 + c4 * 4); *(LAS f32x4*)(SK + row * 132 + c4 * 4) = v; }
#pragma unroll
    for (int i = 0; i < 4; ++i) { const int idx = F.tid + 512 * i, row = idx >> 5, c4 = idx & 31; const f32x4 v = *(const f32x4*)(wq + (size_t)row * 2048 + c4 * 4); *(LAS f32x4*)(WQ + row * 132 + c4 * 4) = v; }
    __syncthreads();
    const int key = F.tid >> 2, kq = F.tid & 3;
    float acc[16];
#pragma unroll
    for (int i = 0; i < 16; ++i) acc[i] = 0.f;
    for (int d = 0; d < 128; d += 4) {
        const f32x4 a = *(const LAS f32x4*)(SK + key * 132 + d);
#pragma unroll
        for (int i = 0; i < 16; ++i) { const f32x4 b = *(const LAS f32x4*)(WQ + (4 * i + kq) * 132 + d); acc[i] += a.x * b.x + a.y * b.y + a.z * b.z + a.w * b.w; }
    }
    bf16* dst = (bf16*)(F.ws + WS_WEFFT) + (size_t)(hs * 128 + key) * D + kb * 64;
#pragma unroll
    for (int i = 0; i < 16; ++i) dst[4 * i + kq] = (bf16)(pk2(acc[i], 0.f) & 0xffffu);
    __syncthreads();
}
__device__ __forceinline__ void p0_prep(Frame& F) {
    for (int it = F.bid; it < 96 + 256; it += F.G) { if (it < 96) p0_mod_item(F, it); else p0_weff_item(F, it - 96); }
    LAS float* scr = (LAS float*)(F.lds + F.wave * 16384);
    const int gw = F.bid * NWAVES + F.wave, NGW = F.G * NWAVES;
    constexpr int I_IN = (D / 64) * (NPROJ / 32), I_OUT = (D / 64) * (D / 32);
    for (int it = gw; it < I_IN + I_OUT; it += NGW) {
        if (it < I_IN) p0_transpose_item(F.in[I_WIN], D, NPROJ, (bf16*)(F.ws + WS_WINT), scr, it, F.lane);
        else p0_transpose_item(F.in[I_WOUT], D, D, (bf16*)(F.ws + WS_WOUTT), scr, it - I_IN, F.lane);
    }
    { v4u* z = (v4u*)((bf16*)(F.ws + WS_WINT) + (size_t)NPROJ * D); const int n16 = (NPROJ_PAD - NPROJ) * D * 2 / 16;
      for (int i = F.bid * 512 + F.tid; i < n16; i += F.G * 512) z[i] = (v4u){0u, 0u, 0u, 0u}; }
    { const f32x4* pu = (const f32x4*)F.in[I_PU]; const f32x4* pv = (const f32x4*)F.in[I_PV]; v4u* du = (v4u*)(F.ws + WS_U); v4u* dv = (v4u*)(F.ws + WS_V);
      const int n8 = NEXP * D / 8;
      for (int i = F.bid * 512 + F.tid; i < n8; i += F.G * 512) {
          const f32x4 a0 = pu[2 * i], a1 = pu[2 * i + 1], b0 = pv[2 * i], b1 = pv[2 * i + 1];
          du[i] = (v4u){pk2(a0.x, a0.y), pk2(a0.z, a0.w), pk2(a1.x, a1.y), pk2(a1.z, a1.w)};
          dv[i] = (v4u){pk2(b0.x, b0.y), pk2(b0.z, b0.w), pk2(b1.x, b1.y), pk2(b1.z, b1.w)}; } }
}

__device__ __forceinline__ void p1_hx(Frame& F) {
    const float* mod = (const float*)(F.ws + WS_MOD); const float* ng = F.in[I_NG];
    bf16* hx = (bf16*)(F.ws + WS_HX);
    for (int m = F.bid * NWAVES + F.wave; m < MA; m += F.G * NWAVES) {
        const float* src = (m < MX) ? F.in[I_X] + (size_t)m * D : F.in[I_CTX] + (size_t)(m - MX) * D;
        const float* mr = mod + ((m < MX) ? (m >> 12) : 4) * NMOD;
        f32x4 v[4]; float ss = 0.f;
#pragma unroll
        for (int j = 0; j < 4; ++j) { v[j] = *(const f32x4*)(src + j * 256 + F.lane * 4); ss += v[j].x * v[j].x + v[j].y * v[j].y + v[j].z * v[j].z + v[j].w * v[j].w; }
        const float rstd = __builtin_amdgcn_rsqf(wave_sum(ss) * (1.f / D) + NORM_EPS);
#pragma unroll
        for (int j = 0; j < 4; ++j) { const int c = j * 256 + F.lane * 4;
            const f32x4 g = *(const f32x4*)(ng + c), sh = *(const f32x4*)(mr + c), sc = *(const f32x4*)(mr + D + c);
            const float o0 = v[j].x * rstd * g.x * (1.f + sc.x) + sh.x, o1 = v[j].y * rstd * g.y * (1.f + sc.y) + sh.y, o2 = v[j].z * rstd * g.z * (1.f + sc.z) + sh.z, o3 = v[j].w * rstd * g.w * (1.f + sc.w) + sh.w;
            *(v2u*)(hx + (size_t)m * D + c) = (v2u){pk2(o0, o1), pk2(o2, o3)}; }
    }
}
constexpr int SC_W = 0, SC_KK = 8192, SC_KKA = 16384, SC_KD = 24576, SC_R = 32768, SC_V = 40960, SC_Y = 43008, SC_RAW = 45056, SC_TLW = 58368, SC_LOA = 62976,
              SC_W2T = 67584, SC_A2T = 76800, SC_LG = 86016, SC_CONST = 102400, SC_END = 104960;
constexpr int SC_NTILE = (TC + T) / 32;
__device__ __forceinline__ void scan_issue_loads(const bf16* proj, int b, int h, int d, int tile, int tid, v4u (&rg)[3]) {
    const bool isctx = tile < TC / 32; const int L = isctx ? TC : T; const int jt = isctx ? tile : tile - TC / 32;
    const size_t rowbase = isctx ? (size_t)(MX + b * TC) : (size_t)b * T;
    const int tlo = d == 0 ? 32 * jt : L - 32 * (jt + 1);
#pragma unroll
    for (int i = 0; i < 3; ++i) {
        const int q = tid + 512 * i; v4u val = (v4u){0u, 0u, 0u, 0u};
        if (q < 816) { const int row = q / 24, rem = q - row * 24, which = rem >> 3, ch8 = rem & 7; const int tok = tlo - 1 + row;
            if (tok >= 0 && tok < L) val = *(const v4u*)(proj + (rowbase + tok) * NPROJ + COL_R + which * 512 + h * 64 + ch8 * 8); }
        else if (q < 1328) { const int q2 = q - 816, row = q2 >> 4, rem = q2 & 15, which = rem >> 3, ch8 = rem & 7; const int tok = tlo + row;
            val = *(const v4u*)(proj + (rowbase + tok) * NPROJ + (which ? COL_LA : COL_LW) + d * 64 + ch8 * 8); }
        rg[i] = val;
    }
}
__device__ __forceinline__ unsigned tanh_pk(unsigned w) { return pk2(tanh_fast(bf_lo(w)), tanh_fast(bf_hi(w))); }
__device__ __forceinline__ void scan_store_raw(LAS unsigned char* lds, int tid, const v4u (&rg)[3]) {
#pragma unroll
    for (int i = 0; i < 3; ++i) {
        const int q = tid + 512 * i;
        if (q < 816) { const int row = q / 24, rem = q - row * 24, which = rem >> 3, ch8 = rem & 7; *(LAS v4u*)(lds + SC_RAW + (which * 34 + row) * 128 + ch8 * 16) = rg[i]; }
        else if (q < 1328) { const int q2 = q - 816, row = q2 >> 4, rem = q2 & 15, which = rem >> 3, ch8 = rem & 7;
            if (which) *(LAS v4u*)(lds + SC_LOA + row * 144 + ch8 * 16) = rg[i];
            else { v4u t; t.x = tanh_pk(rg[i].x); t.y = tanh_pk(rg[i].y); t.z = tanh_pk(rg[i].z); t.w = tanh_pk(rg[i].w); *(LAS v4u*)(lds + SC_TLW + row * 144 + ch8 * 16) = t; } }
    }
}
__device__ __forceinline__ void p3_scan(Frame& F) {
    LAS unsigned char* lds = F.lds; const int tid = F.tid, lane = F.lane, wave = F.wave;
    const bf16* proj = (const bf16*)(F.ws + WS_PROJ);
    float* yscr = F.out;
    for (int unit = F.bid; unit < 256; unit += F.G) {
        const int chain = unit >> 2, rgp = unit & 3, b = chain >> 4, h = (chain >> 1) & 7, d = chain & 1;
        __syncthreads();
        { LAS float* C = (LAS float*)(lds + SC_CONST);
          if (tid < 384) { const int pn = tid / 192, r = tid - pn * 192, which = r >> 6, c = r & 63; C[pn * 192 + which * 64 + c] = F.in[I_TMU][(pn * 3 + which) * 512 + h * 64 + c]; }
          else if (tid < 448) { const int c = tid - 384; C[384 + c] = F.in[I_KK][h * 64 + c]; C[448 + c] = F.in[I_KA][h * 64 + c]; }
          else { const int c = tid - 448; C[512 + c] = F.in[I_DW0][d * 512 + h * 64 + c]; C[576 + c] = F.in[I_A0][d * 512 + h * 64 + c]; }
          const float* w2 = F.in[I_DW2] + (size_t)d * 64 * 512 + h * 64; const float* a2 = F.in[I_A2] + (size_t)d * 64 * 512 + h * 64;
#pragma unroll
          for (int i = 0; i < 8; ++i) { const int idx = tid + 512 * i, j = idx >> 6, c = idx & 63;
              *(LAS bf16*)(lds + SC_W2T + c * 144 + j * 2) = (bf16)(pk2(w2[j * 512 + c], 0.f) & 0xffffu);
              *(LAS bf16*)(lds + SC_A2T + c * 144 + j * 2) = (bf16)(pk2(a2[j * 512 + c], 0.f) & 0xffffu); } }
        f32x4 st = (f32x4){0.f, 0.f, 0.f, 0.f};
        v4u rg[3];
        scan_issue_loads(proj, b, h, d, 0, tid, rg);
        for (int tile = 0; tile < SC_NTILE; ++tile) {
            const bool isctx = tile < TC / 32; const int L = isctx ? TC : T; const int jt = isctx ? tile : tile - TC / 32;
            const int tlo = d == 0 ? 32 * jt : L - 32 * (jt + 1);
            scan_store_raw(lds, tid, rg);
            __syncthreads();
            if (tile + 1 < SC_NTILE) scan_issue_loads(proj, b, h, d, tile + 1, tid, rg);
            if (wave < 4) {
                const int mat = wave >> 1, nt = wave & 1, r = lane & 31, hh = lane >> 5;
                const LAS unsigned char* Ab = lds + (mat ? SC_LOA : SC_TLW) + r * 144 + hh * 16;
                const LAS unsigned char* Bb = lds + (mat ? SC_A2T : SC_W2T) + (nt * 32 + r) * 144 + hh * 16;
                f32x16 acc;
#pragma unroll
                for (int i = 0; i < 16; ++i) acc[i] = 0.f;
#pragma unroll
                for (int ks = 0; ks < 4; ++ks) { const bf16x8 a = *(const LAS bf16x8*)(Ab + ks * 32), bb = *(const LAS bf16x8*)(Bb + ks * 32); acc = __builtin_amdgcn_mfma_f32_32x32x16_bf16(a, bb, acc, 0, 0, 0); }
                LAS float* LG = (LAS float*)(lds + SC_LG) + mat * 2048 + nt * 32 + r;
#pragma unroll
                for (int i = 0; i < 16; ++i) LG[((i & 3) + 8 * (i >> 2) + 4 * hh) * 64] = acc[i];
            }
            __syncthreads();
            { const int tok = tid >> 4, cq = tid & 15, c0 = cq * 4;
              const LAS float* C = (const LAS float*)(lds + SC_CONST);
              f32x4 xs[3];
#pragma unroll
              for (int which = 0; which < 3; ++which) {
                  const LAS unsigned char* rp = lds + SC_RAW + (which * 34 + tok) * 128 + c0 * 2;
                  const v2u p = *(const LAS v2u*)rp, x = *(const LAS v2u*)(rp + 128), n = *(const LAS v2u*)(rp + 256);
                  const f32x4 mp = *(const LAS f32x4*)(C + which * 64 + c0), mn = *(const LAS f32x4*)(C + 192 + which * 64 + c0);
                  const f32x4 xp = (f32x4){bf_lo(p.x), bf_hi(p.x), bf_lo(p.y), bf_hi(p.y)}, xc = (f32x4){bf_lo(x.x), bf_hi(x.x), bf_lo(x.y), bf_hi(x.y)}, xn = (f32x4){bf_lo(n.x), bf_hi(n.x), bf_lo(n.y), bf_hi(n.y)};
                  xs[which] = xc + mp * (xp - xc) + mn * (xn - xc); }
              const f32x4 kkc = *(const LAS f32x4*)(C + 384 + c0), kac = *(const LAS f32x4*)(C + 448 + c0), w0 = *(const LAS f32x4*)(C + 512 + c0), a0 = *(const LAS f32x4*)(C + 576 + c0);
              f32x4 kk = xs[1] * kkc;
              const float ss = rowsum16(kk.x * kk.x + kk.y * kk.y + kk.z * kk.z + kk.w * kk.w);
              kk = kk * __builtin_amdgcn_rsqf(ss + 1e-12f);
              const f32x4 uw = *(const LAS f32x4*)(lds + SC_LG + (tok * 64 + c0) * 4) + w0, ua = *(const LAS f32x4*)(lds + SC_LG + 8192 + (tok * 64 + c0) * 4) + a0;
              f32x4 dec, av;
#pragma unroll
              for (int e = 0; e < 4; ++e) { dec[e] = fast_exp(-0.60653066f * sigmoidf(uw[e])); av[e] = sigmoidf(ua[e]); }
              const f32x4 kd = xs[1] * (1.f + (av - 1.f) * kac), kka = kk * av;
              const int s = d == 0 ? tok : 31 - tok;
              *(LAS f32x4*)(lds + SC_W + (s * 64 + c0) * 4) = dec; *(LAS f32x4*)(lds + SC_KK + (s * 64 + c0) * 4) = kk; *(LAS f32x4*)(lds + SC_KKA + (s * 64 + c0) * 4) = kka;
              *(LAS f32x4*)(lds + SC_KD + (s * 64 + c0) * 4) = kd; *(LAS f32x4*)(lds + SC_R + (s * 64 + c0) * 4) = xs[0];
              if ((cq >> 2) == rgp) *(LAS f32x4*)(lds + SC_V + (s * 16 + (cq & 3) * 4) * 4) = xs[2]; }
            __syncthreads();
            if (wave < 4) {
                const int q = lane & 15, row = wave * 4 + (lane >> 4);
#pragma unroll 4
                for (int s = 0; s < 32; ++s) {
                    const f32x4 w = *(const LAS f32x4*)(lds + SC_W + (s * 64 + q * 4) * 4), kk = *(const LAS f32x4*)(lds + SC_KK + (s * 64 + q * 4) * 4), kka = *(const LAS f32x4*)(lds + SC_KKA + (s * 64 + q * 4) * 4);
                    const f32x4 kd = *(const LAS f32x4*)(lds + SC_KD + (s * 64 + q * 4) * 4), r = *(const LAS f32x4*)(lds + SC_R + (s * 64 + q * 4) * 4);
                    const float v = *(const LAS float*)(lds + SC_V + (s * 16 + row) * 4);
                    const float sa = rowsum16((st.x * kk.x + st.y * kk.y) + (st.z * kk.z + st.w * kk.w));
                    st = st * w + v * kd - sa * kka;
                    const float y = rowsum16((st.x * r.x + st.y * r.y) + (st.z * r.z + st.w * r.w));
                    if (q == 0) *(LAS float*)(lds + SC_Y + (s * 16 + row) * 4) = y;
                }
            }
            __syncthreads();
            if (!isctx && tid < 128) { const int s = tid >> 2, part = tid & 3; const int tok = d == 0 ? tlo + s : tlo + 31 - s;
                *(f32x4*)(yscr + ((size_t)(b * T + tok)) * D + d * 512 + h * 64 + rgp * 16 + part * 4) = *(const LAS f32x4*)(lds + SC_Y + (s * 16 + part * 4) * 4); }
        }
    }
}
__device__ __forceinline__ void p4_mix(Frame& F) {
    LAS unsigned char* lds = F.lds; const int tid = F.tid;
    const bf16* proj = (const bf16*)(F.ws + WS_PROJ); bf16* cat = (bf16*)(F.ws + WS_HX); const float* yscr = F.out;
    LAS float* SG = (LAS float*)lds;
    LAS bf16* GT = (LAS bf16*)(lds + 32768);
    for (int unit = F.bid; unit < MX / 64; unit += F.G) {
        const size_t row0 = (size_t)unit * 64; const int tb0 = (unit * 64) & (T - 1);
        __syncthreads();
#pragma unroll
        for (int i = 0; i < 2; ++i) { const int ck = tid + 512 * i, tok = ck >> 4, j0 = (ck & 15) * 8;
            const v4u w = *(const v4u*)(proj + (row0 + tok) * NPROJ + COL_G + j0);
            SG[(j0 + 0) * 64 + tok] = sigmoidf(bf_lo(w.x)); SG[(j0 + 1) * 64 + tok] = sigmoidf(bf_hi(w.x)); SG[(j0 + 2) * 64 + tok] = sigmoidf(bf_lo(w.y)); SG[(j0 + 3) * 64 + tok] = sigmoidf(bf_hi(w.y));
            SG[(j0 + 4) * 64 + tok] = sigmoidf(bf_lo(w.z)); SG[(j0 + 5) * 64 + tok] = sigmoidf(bf_hi(w.z)); SG[(j0 + 6) * 64 + tok] = sigmoidf(bf_lo(w.w)); SG[(j0 + 7) * 64 + tok] = sigmoidf(bf_hi(w.w)); }
        __syncthreads();
        { float acc[64];
#pragma unroll
          for (int i = 0; i < 64; ++i) acc[i] = 0.f;
          const float* gw = F.in[I_GW2] + tid;
#pragma unroll 2
          for (int j = 0; j < 128; ++j) { const float wv = gw[j * 512];
#pragma unroll
              for (int tq = 0; tq < 16; ++tq) { const f32x4 s4 = *(const LAS f32x4*)(SG + j * 64 + tq * 4);
                  acc[4 * tq] += s4.x * wv; acc[4 * tq + 1] += s4.y * wv; acc[4 * tq + 2] += s4.z * wv; acc[4 * tq + 3] += s4.w * wv; } }
#pragma unroll
          for (int i = 0; i < 64; ++i) GT[i * 512 + tid] = (bf16)(pk2(acc[i], 0.f) & 0xffffu); }
        __syncthreads();
        if (tid < 256) {
            const int c = 2 * tid; const float* cw = F.in[I_CONVW];
            const f32x2 w0 = *(const f32x2*)(cw + c), w1 = *(const f32x2*)(cw + 512 + c), w2 = *(const f32x2*)(cw + 1024 + c);
            const bf16* pr = proj + row0 * NPROJ + c;
            f32x2 zp = (f32x2){0.f, 0.f}, zc, zn;
            { const unsigned g = *(const unsigned*)(pr + COL_XG), x = *(const unsigned*)(pr + COL_XC); zc = (f32x2){bf_lo(g) * bf_lo(x), bf_hi(g) * bf_hi(x)}; }
            for (int t = 0; t < 64; ++t) {
                if (t < 63) { const unsigned g = *(const unsigned*)(pr + (size_t)(t + 1) * NPROJ + COL_XG), x = *(const unsigned*)(pr + (size_t)(t + 1) * NPROJ + COL_XC); zn = (f32x2){bf_lo(g) * bf_lo(x), bf_hi(g) * bf_hi(x)}; }
                else zn = (f32x2){0.f, 0.f};
                const unsigned xb = *(const unsigned*)(pr + (size_t)t * NPROJ + COL_XB);
                const f32x2 z = w0 * zp + w1 * zc + w2 * zn;
                *(unsigned*)(cat + (row0 + t) * D + c) = pk2(bf_lo(xb) * z.x, bf_hi(xb) * z.y);
                zp = zc; zc = zn;
            }
        } else {
            const int ri = tid - 256, c = 2 * ri, h = ri >> 5;
            const f32x2 mpr = *(const f32x2*)(F.in[I_TMU] + 0 * 512 + c), mpk = *(const f32x2*)(F.in[I_TMU] + 1 * 512 + c), mpv = *(const f32x2*)(F.in[I_TMU] + 2 * 512 + c);
            const f32x2 mnr = *(const f32x2*)(F.in[I_TMU] + 3 * 512 + c), mnk = *(const f32x2*)(F.in[I_TMU] + 4 * 512 + c), mnv = *(const f32x2*)(F.in[I_TMU] + 5 * 512 + c);
            const f32x2 rk = *(const f32x2*)(F.in[I_RK] + c), lg = *(const f32x2*)(F.in[I_LNG] + c), lb = *(const f32x2*)(F.in[I_LNB] + c);
            const bf16* pr = proj + row0 * NPROJ + c;
            f32x2 rp, kp, vp, rc, kc, vc, rn, kn, vn;
#define LD2(dst, ptr) do { const unsigned _w = *(const unsigned*)(ptr); dst = (f32x2){bf_lo(_w), bf_hi(_w)}; } while (0)
            if (tb0 > 0) { LD2(rp, pr - NPROJ + COL_R); LD2(kp, pr - NPROJ + COL_K); LD2(vp, pr - NPROJ + COL_V); } else { rp = kp = vp = (f32x2){0.f, 0.f}; }
            LD2(rc, pr + COL_R); LD2(kc, pr + COL_K); LD2(vc, pr + COL_V);
            for (int t = 0; t < 64; ++t) {
                if (tb0 + t + 1 < T) { const bf16* pn = pr + (size_t)(t + 1) * NPROJ; LD2(rn, pn + COL_R); LD2(kn, pn + COL_K); LD2(vn, pn + COL_V); } else { rn = kn = vn = (f32x2){0.f, 0.f}; }
                const f32x2 rs = rc + mpr * (rp - rc) + mnr * (rn - rc), ks = kc + mpk * (kp - kc) + mnk * (kn - kc), vs = vc + mpv * (vp - vc) + mnv * (vn - vc);
                const float* yr = yscr + (row0 + t) * D + c;
                const f32x2 y = *(const f32x2*)yr + *(const f32x2*)(yr + 512);
                const float mu = half_sum32(y.x + y.y) * (1.f / 64.f);
                const f32x2 yc = y - mu;
                const float var = half_sum32(yc.x * yc.x + yc.y * yc.y) * (1.f / 64.f);
                const float bon = half_sum32(rs.x * ks.x * rk.x + rs.y * ks.y * rk.y);
                const f32x2 yn = yc * __builtin_amdgcn_rsqf(var + LNX_EPS) * lg + lb + bon * vs;
                const unsigned gt = *(const LAS unsigned*)(GT + t * 512 + c);
                *(unsigned*)(cat + (row0 + t) * D + 512 + c) = pk2(yn.x * bf_lo(gt), yn.y * bf_hi(gt));
                rp = rc; kp = kc; vp = vc; rc = rn; kc = kn; vc = vn;
            }
#undef LD2
        }
    }
}

__device__ __forceinline__ void p6_mid(Frame& F) {
    const float* mod = (const float*)(F.ws + WS_MOD); const float* ng = F.in[I_NG];
    const float* yx = (const float*)(F.ws + WS_PROJ); bf16* hx2 = (bf16*)(F.ws + WS_HX);
    for (int m = F.bid * NWAVES + F.wave; m < MX; m += F.G * NWAVES) {
        const float* mr = mod + (m >> 12) * NMOD;
        f32x4 v[4], xv[4]; float ss = 0.f;
#pragma unroll
        for (int j = 0; j < 4; ++j) { v[j] = *(const f32x4*)(yx + (size_t)m * D + j * 256 + F.lane * 4); xv[j] = *(const f32x4*)(F.in[I_X] + (size_t)m * D + j * 256 + F.lane * 4);
            ss += v[j].x * v[j].x + v[j].y * v[j].y + v[j].z * v[j].z + v[j].w * v[j].w; }
        const float rstd = __builtin_amdgcn_rsqf(wave_sum(ss) * (1.f / D) + NORM_EPS);
        float ss2 = 0.f;
#pragma unroll
        for (int j = 0; j < 4; ++j) { const int c = j * 256 + F.lane * 4;
            const f32x4 g1 = *(const f32x4*)(ng + D + c), gt = *(const f32x4*)(mr + 2 * D + c);
            xv[j] = xv[j] + gt * (v[j] * rstd * g1);
            *(f32x4*)(F.out + (size_t)m * D + c) = xv[j];
            ss2 += xv[j].x * xv[j].x + xv[j].y * xv[j].y + xv[j].z * xv[j].z + xv[j].w * xv[j].w; }
        const float rstd2 = __builtin_amdgcn_rsqf(wave_sum(ss2) * (1.f / D) + NORM_EPS);
#pragma unroll
        for (int j = 0; j < 4; ++j) { const int c = j * 256 + F.lane * 4;
            const f32x4 g2 = *(const f32x4*)(ng + 2 * D + c), sh = *(const f32x4*)(mr + 3 * D + c), sc = *(const f32x4*)(mr + 4 * D + c);
            const f32x4 o = xv[j] * rstd2 * g2 * (1.f + sc) + sh;
            *(v2u*)(hx2 + (size_t)m * D + c) = (v2u){pk2(o.x, o.y), pk2(o.z, o.w)}; }
    }
}
__device__ __forceinline__ float gelu_erf(float x) { return 0.5f * x * (1.f + erff(x * 0.70710678118f)); }
__device__ __forceinline__ float dot2bf(unsigned a, unsigned b, float c) {
    typedef __bf16 bf2 __attribute__((ext_vector_type(2)));
    return __builtin_amdgcn_fdot2_f32_bf16(__builtin_bit_cast(bf2, a), __builtin_bit_cast(bf2, b), c, false);
}
__device__ __forceinline__ void p8_peer(Frame& F) {
    const int lane = F.lane, wave = F.wave;
    LAS int* EX = (LAS int*)(F.lds + wave * 2048);
    LAS float* GG = (LAS float*)(F.lds + wave * 2048 + 512);
    const float* scores = (const float*)(F.ws + WS_PROJ); const bf16* hx2 = (const bf16*)(F.ws + WS_HX);
    const unsigned char* U = F.ws + WS_U; const unsigned char* V = F.ws + WS_V;
    const float* mod = (const float*)(F.ws + WS_MOD); const float* ng3 = F.in[I_NG] + 3 * D;
    int ci = 0, cj = 0; { int l = lane, i = 0; for (; i < 16; ++i) { const int n = 16 / (i + 1); if (l < n) break; l -= n; } ci = i < 16 ? i : 0; cj = i < 16 ? l : 0; }
    const bool cvalid = lane < 50;
    for (int m = F.bid * NWAVES + wave; m < MX; m += F.G * NWAVES) {
        const float* srow = scores + (size_t)m * NSC;
        for (int h = 0; h < 8; ++h) {
            unsigned res[2];
#pragma unroll
            for (int s = 0; s < 2; ++s) {
                const float* lp = srow + (h * 2 + s) * 128;
                unsigned k0 = (f2key(lp[lane]) & ~127u) | (unsigned)(127 - lane), k1 = (f2key(lp[64 + lane]) & ~127u) | (unsigned)(63 - lane);
                unsigned r = 0u;
                for (int it = 0; it < 16; ++it) { const unsigned mx = wave_max_u32(umaxu(k0, k1)); r = (lane == it) ? mx : r; k0 = (k0 == mx) ? 0u : k0; k1 = (k1 == mx) ? 0u : k1; }
                res[s] = r;
            }
            const unsigned ka = (unsigned)__shfl((int)res[0], ci), kb = (unsigned)__shfl((int)res[1], cj);
            const float sum = key2f(ka & ~127u) + key2f(kb & ~127u);
            unsigned ck = cvalid ? ((f2key(sum) & ~63u) | (unsigned)(63 - lane)) : 0u;
            unsigned win = 0u;
            for (int it = 0; it < 16; ++it) { const unsigned mx = wave_max_u32(ck); win = (lane == it) ? mx : win; ck = (ck == mx) ? 0u : ck; }
            const int wl = 63 - (int)(win & 63u);
            const int wi = __shfl(ci, wl), wj = __shfl(cj, wl);
            const int idx0 = 127 - (int)((unsigned)__shfl((int)res[0], wi) & 127u), idx1 = 127 - (int)((unsigned)__shfl((int)res[1], wj) & 127u);
            const float scv = key2f(win & ~63u);
            const float smax = __shfl(scv, 0);
            const float e = (lane < 16) ? fast_exp(scv - smax) : 0.f;
            const float den = rowsum16(e);
            if (lane < 16) { EX[h * 16 + lane] = idx0 * 128 + idx1; GG[h * 16 + lane] = e * fast_rcp(den); }
        }
        LDS_WAIT();
        const v4u ha = *(const v4u*)(hx2 + (size_t)m * D + lane * 8), hb = *(const v4u*)(hx2 + (size_t)m * D + 512 + lane * 8);
        for (int e0 = 0; e0 < 128; e0 += 8) {
            v4u ua[8], ub[8];
#pragma unroll
            for (int j = 0; j < 8; ++j) { const int ex = __builtin_amdgcn_readfirstlane(EX[e0 + j]); const unsigned char* up = U + (size_t)ex * 2048 + lane * 16; ua[j] = *(const v4u*)up; ub[j] = *(const v4u*)(up + 1024); }
#pragma unroll
            for (int j = 0; j < 8; ++j) {
                float p = dot2bf(ua[j].x, ha.x, 0.f); p = dot2bf(ua[j].y, ha.y, p); p = dot2bf(ua[j].z, ha.z, p); p = dot2bf(ua[j].w, ha.w, p);
                p = dot2bf(ub[j].x, hb.x, p); p = dot2bf(ub[j].y, hb.y, p); p = dot2bf(ub[j].z, hb.z, p); p = dot2bf(ub[j].w, hb.w, p);
                p = wave_sum(p);
                if (lane == 0) GG[e0 + j] = GG[e0 + j] * gelu_erf(p);
            }
        }
        LDS_WAIT();
        float acc[16];
#pragma unroll
        for (int i = 0; i < 16; ++i) acc[i] = 0.f;
        for (int e0 = 0; e0 < 128; e0 += 8) {
            v4u va[8], vb[8];
#pragma unroll
            for (int j = 0; j < 8; ++j) { const int ex = __builtin_amdgcn_readfirstlane(EX[e0 + j]); const unsigned char* vp = V + (size_t)ex * 2048 + lane * 16; va[j] = *(const v4u*)vp; vb[j] = *(const v4u*)(vp + 1024); }
#pragma unroll
            for (int j = 0; j < 8; ++j) { const float cf = GG[e0 + j];
                acc[0] += cf * bf_lo(va[j].x); acc[1] += cf * bf_hi(va[j].x); acc[2] += cf * bf_lo(va[j].y); acc[3] += cf * bf_hi(va[j].y);
                acc[4] += cf * bf_lo(va[j].z); acc[5] += cf * bf_hi(va[j].z); acc[6] += cf * bf_lo(va[j].w); acc[7] += cf * bf_hi(va[j].w);
                acc[8] += cf * bf_lo(vb[j].x); acc[9] += cf * bf_hi(vb[j].x); acc[10] += cf * bf_lo(vb[j].y); acc[11] += cf * bf_hi(vb[j].y);
                acc[12] += cf * bf_lo(vb[j].z); acc[13] += cf * bf_hi(vb[j].z); acc[14] += cf * bf_lo(vb[j].w); acc[15] += cf * bf_hi(vb[j].w); }
        }
        float ss = 0.f;
#pragma unroll
        for (int i = 0; i < 16; ++i) ss += acc[i] * acc[i];
        const float rstd = __builtin_amdgcn_rsqf(wave_sum(ss) * (1.f / D) + NORM_EPS);
        const float* gt2 = mod + (m >> 12) * NMOD + 5 * D;
#pragma unroll
        for (int half = 0; half < 2; ++half)
#pragma unroll
            for (int q = 0; q < 2; ++q) { const int c = half * 512 + lane * 8 + q * 4; float* op = F.out + (size_t)m * D + c;
                const f32x4 x1 = *(const f32x4*)op, g = *(const f32x4*)(ng3 + c), gt = *(const f32x4*)(gt2 + c);
                const f32x4 a = (f32x4){acc[half * 8 + q * 4], acc[half * 8 + q * 4 + 1], acc[half * 8 + q * 4 + 2], acc[half * 8 + q * 4 + 3]};
                *(f32x4*)op = x1 + gt * (a * rstd * g); }
        LDS_WAIT();
    }
}
struct Args { const float* in[25]; float* out; unsigned char* ws; int ph_lo, ph_hi; };
__global__ void __launch_bounds__(NWAVES * 64, 2) mk_fwd(Args args) {
    extern __shared__ __attribute__((aligned(16))) unsigned char lds_raw[];
    Frame F;
    F.lds = (LAS unsigned char*)lds_raw;
    F.MISC = (volatile LAS unsigned*)(F.lds + MISC_OFF);
    F.tid = threadIdx.x; F.lane = F.tid & 63; F.wave = __builtin_amdgcn_readfirstlane(F.tid >> 6);
    F.G = gridDim.x; F.bid = blockIdx.x;
#pragma unroll
    for (int i = 0; i < 25; ++i) F.in[i] = args.in[i];
    F.out = args.out; F.ws = args.ws; F.ctl = (gu32*)(args.ws + WS_CTL);
    for (int u = F.tid; u < (LDS_BYTES - LDSCTL_OFF) / 4; u += NWAVES * 64) ((LAS unsigned*)(F.lds + LDSCTL_OFF))[u] = 0u;
    __syncthreads();
    const int lo = args.ph_lo, hi = args.ph_hi;
    XcdBarrier bar; bar.bar = (unsigned*)(F.ctl + CW_BAR); bar.x = 0; bar.st = nullptr;
    if (hi - lo > 1) bar = xcd_barrier_post((unsigned*)(F.ctl + CW_BAR), F.MISC + 8);
#define IN(k) (lo <= (k) && (k) < hi)
#define SEAM(k) do { if (IN(k) && IN((k) + 1)) xcd_barrier(bar); } while (0)
    if (IN(0)) { p0_prep(F); } SEAM(0);
    if (IN(1)) { p1_hx(F); } SEAM(1);
    if (IN(2)) {
        pg8::Gemm g{(const pg8::bf16_t*)(F.ws + WS_HX), (const pg8::bf16_t*)(F.ws + WS_WINT), MA, NPROJ_PAD, D}; pg8::StaticOrder S; S.init(MA, NPROJ_PAD, F.G, F.bid);
        pg8::EpiProj E{(pg8::bf16_t*)(F.ws + WS_PROJ), NPROJ, NPROJ};
        pg8::gemm_phase<pg8::EpiProj, pg8::StaticOrder, PG8_ALIGN, PG8_SP2>(F.lds, g, S, E);
    } SEAM(2);
    if (IN(3)) { p3_scan(F); } SEAM(3);
    if (IN(4)) { p4_mix(F); } SEAM(4);
    if (IN(5)) {
        pg8::Gemm g{(const pg8::bf16_t*)(F.ws + WS_HX), (const pg8::bf16_t*)(F.ws + WS_WOUTT), MX, D, D}; pg8::StaticOrder S; S.init(MX, D, F.G, F.bid);
        pg8::EpiF32 E{(float*)(F.ws + WS_PROJ), D};
        pg8::gemm_phase<pg8::EpiF32, pg8::StaticOrder, PG8_ALIGN, PG8_SP2>(F.lds, g, S, E);
    } SEAM(5);
    if (IN(6)) { p6_mid(F); } SEAM(6);
    if (IN(7)) {
        pg8::Gemm g{(const pg8::bf16_t*)(F.ws + WS_HX), (const pg8::bf16_t*)(F.ws + WS_WEFFT), MX, NSC, D}; pg8::StaticOrder S; S.init(MX, NSC, F.G, F.bid);
        pg8::EpiF32 E{(float*)(F.ws + WS_PROJ), NSC};
        pg8::gemm_phase<pg8::EpiF32, pg8::StaticOrder, PG8_ALIGN, PG8_SP2>(F.lds, g, S, E);
    } SEAM(7);
    if (IN(8)) { p8_peer(F); }
#undef IN
#undef SEAM
}

extern "C" void kernel_launch(void* const* d_in, const int* in_sizes, int n_in, void* d_out, int out_size, void* d_ws, size_t ws_size, hipStream_t stream) {
    static int grid = 0;
    if (grid == 0) {
        if (n_in != 25 || in_sizes[0] != MX * D || out_size != MX * D || ws_size < WS_END) { fprintf(stderr, "kernel_launch: unexpected problem (n_in %d, in0 %d, out %d, ws %zu); nothing launched\n", n_in, n_in > 0 ? in_sizes[0] : -1, out_size, ws_size); grid = -1; return; }
        int dev = 0, cus = 0, per_cu = 0;
        if (hipGetDevice(&dev) != hipSuccess || hipDeviceGetAttribute(&cus, hipDeviceAttributeMultiprocessorCount, dev) != hipSuccess) { fprintf(stderr, "kernel_launch: device query failed\n"); grid = -1; return; }
        if (hipFuncSetAttribute((const void*)mk_fwd, hipFuncAttributeMaxDynamicSharedMemorySize, LDS_BYTES) != hipSuccess) { fprintf(stderr, "kernel_launch: hipFuncSetAttribute failed\n"); grid = -1; return; }
        if (hipOccupancyMaxActiveBlocksPerMultiprocessor(&per_cu, (const void*)mk_fwd, NWAVES * 64, LDS_BYTES) != hipSuccess || per_cu < 1) fprintf(stderr, "kernel_launch: occupancy query reports %d workgroups per CU\n", per_cu);
        (void)hipGetLastError();
        grid = cus;
    }
    if (grid < 0) return;
    if (hipMemsetAsync((char*)d_ws + WS_CTL, 0, CTL_ZERO_BYTES, stream) != hipSuccess) { fprintf(stderr, "kernel_launch: memset failed\n"); return; }
    Args a{};
    for (int i = 0; i < 25; ++i) a.in[i] = (const float*)d_in[i];
    a.out = (float*)d_out; a.ws = (unsigned char*)d_ws;
    if (MK_N_LAUNCHES == 1) { a.ph_lo = 0; a.ph_hi = NPH; hipLaunchKernelGGL(mk_fwd, dim3(grid), dim3(NWAVES * 64), LDS_BYTES, stream, a); }
    else for (int p = 0; p < NPH; ++p) { a.ph_lo = p; a.ph_hi = p + 1; hipLaunchKernelGGL(mk_fwd, dim3(grid), dim3(NWAVES * 64), LDS_BYTES, stream, a); }
    const hipError_t le = hipPeekAtLastError();
    if (le != hipSuccess) fprintf(stderr, "kernel_launch: launch failed: %s\n", hipGetErrorName(le));
}
```

```cpp
#include <hip/hip_runtime.h>
#include <cstdio>
#include <cstdint>
namespace pg8 {
#define PG8_LAS __attribute__((address_space(3)))
typedef unsigned short bf16_t;
typedef short bf16x8 __attribute__((ext_vector_type(8)));
typedef float f32x4 __attribute__((ext_vector_type(4)));
typedef unsigned u32x4 __attribute__((ext_vector_type(4)));
constexpr int BM = 256, BK = 64, HALF = 128, HTB = HALF * BK * 2  , STAGE_BYTES = 8 * HTB, NXCD = 8, WGM = 8;

__host__ __device__ __forceinline__ int lds_byte(int r, int c) { const int st = (r >> 4) * 2 + (c >> 5), rr = r & 15, cc = c & 31, ob = rr * 64 + cc * 2; return st * 1024 + (ob ^ (((ob >> 9) & 1) << 5)); }
__host__ __device__ __forceinline__ void stage_rc(int b, int& R, int& C) { const int st = b / 1024, sb = b % 1024, swz = sb ^ (((sb >> 9) & 1) << 5); R = (st >> 1) * 16 + swz / 64; C = (st & 1) * 32 + (swz % 64) / 2; }
__host__ __device__ __forceinline__ int perm32(int rho) { const int n = rho >> 4, i = rho & 15; return 8 * (i >> 2) + 4 * n + (i & 3); }

struct Unit { int pm, pn; };
struct Gemm { const bf16_t* A; const bf16_t* Bt; int M, N, K; };

struct StaticOrder {
    int nM, nN, nwg, G, c;
    __host__ __device__ void init(int M, int N, int G_, int c_) { nM = M / BM; nN = N / BM; nwg = nM * nN; G = G_; c = c_; }
    __host__ __device__ bool next(int i, Unit& u) const {
        const long L = (long)i * G + c; if (L >= nwg) return false;
        int wgid = (int)L; { const int q = nwg / NXCD, r = nwg % NXCD, xcd = wgid % NXCD, off = wgid / NXCD; wgid = (xcd < r ? xcd * (q + 1) : r * (q + 1) + (xcd - r) * q) + off; }
        const int nig = WGM * nN, gid = wgid / nig, fm = gid * WGM, gsz = (nM - fm) < WGM ? (nM - fm) : WGM;
        u.pm = fm + ((wgid % nig) % gsz); u.pn = (wgid % nig) / gsz; return true;
    }
    __device__ __forceinline__ void a_ready(const Unit&) const {}
    __device__ __forceinline__ void done(const Unit&) const {}
};

__device__ __forceinline__ unsigned cvt_pk_bf16(float lo, float hi) { unsigned r; asm volatile("v_cvt_pk_bf16_f32 %0, %1, %2" : "=v"(r) : "v"(lo), "v"(hi)); return r; }
typedef float f32x2 __attribute__((ext_vector_type(2)));
__device__ __forceinline__ f32x2 gelu_pk(f32x2 v) {
    const f32x2 av = __builtin_elementwise_abs(v), d = av * 0.2316418882f + 1.0f;
    f32x2 t; t.x = __builtin_amdgcn_rcpf(d.x); t.y = __builtin_amdgcn_rcpf(d.y);
    f32x2 q = t * 0.5307027145f + (-0.7265760135f); q = q * t + 0.7107068705f; q = q * t + (-0.142248368f); q = q * t + 0.127414796f; q = q * t;
    const f32x2 s = (v * v) * (-0.72134752044f);
    f32x2 e; e.x = __builtin_amdgcn_exp2f(s.x); e.y = __builtin_amdgcn_exp2f(s.y);
    const f32x2 m = v * (q * e), r = v - m;
    f32x2 o; o.x = v.x < 0.f ? m.x : r.x; o.y = v.y < 0.f ? m.y : r.y; return o;
}

template <int ACT  > struct EpiBf16 {
    static constexpr bool PERM = true, AFTER_DRAIN = false; static_assert(ACT == 0 || ACT == 1, "EpiBf16: ACT is 0 (none) or 1 (gelu_pk)");
    bf16_t* O; int ldc; const float* bias; int split_cols; size_t split_stride; float scale0;
    __device__ __forceinline__ void operator()(const f32x4 (&acc)[2][2][4][2], const Unit& u, int wr, int wc, int fr, int fq) const {
        const int row0 = u.pm * BM + wr * 64 + fr; int colt = u.pn * BM; bf16_t* base = O;
        float sc = 1.f; if (split_cols) { const int t = colt / split_cols; base += (size_t)t * split_stride; colt -= t * split_cols; if (t == 0) sc = scale0; }
        const int col0 = colt + wc * 32 + 8 * fq, bcol0 = u.pn * BM + wc * 32 + 8 * fq;
        f32x4 bv[2][2];
#pragma unroll
        for (int bj = 0; bj < 2; ++bj)
#pragma unroll
            for (int n = 0; n < 2; ++n) bv[bj][n] = bias ? *(const f32x4*)(bias + bcol0 + bj * HALF + 4 * n) : (f32x4){0.f, 0.f, 0.f, 0.f};
#pragma unroll
        for (int ai = 0; ai < 2; ++ai)
#pragma unroll
            for (int m = 0; m < 4; ++m) { bf16_t* rowp = base + (size_t)(row0 + ai * HALF + m * 16) * ldc + col0;
#pragma unroll
                for (int bj = 0; bj < 2; ++bj) { f32x4 v0 = acc[ai][bj][m][0] + bv[bj][0], v1 = acc[ai][bj][m][1] + bv[bj][1];
                    if (ACT == 1) { f32x2 a = gelu_pk((f32x2){v0[0], v0[1]}), b = gelu_pk((f32x2){v0[2], v0[3]}), c = gelu_pk((f32x2){v1[0], v1[1]}), d = gelu_pk((f32x2){v1[2], v1[3]});
                        v0 = (f32x4){a.x, a.y, b.x, b.y}; v1 = (f32x4){c.x, c.y, d.x, d.y}; }
                    v0 = v0 * sc; v1 = v1 * sc; u32x4 w; w.x = cvt_pk_bf16(v0[0], v0[1]); w.y = cvt_pk_bf16(v0[2], v0[3]); w.z = cvt_pk_bf16(v1[0], v1[1]); w.w = cvt_pk_bf16(v1[2], v1[3]);
                    *(u32x4*)(rowp + bj * HALF) = w; } }
    }
};

struct EpiF32 {
    static constexpr bool PERM = false, AFTER_DRAIN = false;
    float* C; int ldc;
    __device__ __forceinline__ void operator()(const f32x4 (&acc)[2][2][4][2], const Unit& u, int wr, int wc, int fr, int fq) const {
        const int row0 = u.pm * BM + wr * 64 + fr, col0 = u.pn * BM + wc * 32 + 4 * fq;
#pragma unroll
        for (int ai = 0; ai < 2; ++ai)
#pragma unroll
            for (int m = 0; m < 4; ++m) { float* rowp = C + (size_t)(row0 + ai * HALF + m * 16) * ldc + col0;
#pragma unroll
                for (int bj = 0; bj < 2; ++bj)
#pragma unroll
                    for (int n = 0; n < 2; ++n) *(f32x4*)(rowp + bj * HALF + n * 16) = acc[ai][bj][m][n]; }
    }
};
struct EpiProj {
    static constexpr bool PERM = true, AFTER_DRAIN = false;
    bf16_t* O; int ldc; int ncols;
    __device__ __forceinline__ void operator()(const f32x4 (&acc)[2][2][4][2], const Unit& u, int wr, int wc, int fr, int fq) const {
        const int row0 = u.pm * BM + wr * 64 + fr; const int col0 = u.pn * BM + wc * 32 + 8 * fq;
#pragma unroll
        for (int ai = 0; ai < 2; ++ai)
#pragma unroll
            for (int m = 0; m < 4; ++m) { bf16_t* rowp = O + (size_t)(row0 + ai * HALF + m * 16) * ldc + col0;
#pragma unroll
                for (int bj = 0; bj < 2; ++bj) { const f32x4 v0 = acc[ai][bj][m][0], v1 = acc[ai][bj][m][1];
                    u32x4 w; w.x = cvt_pk_bf16(v0[0], v0[1]); w.y = cvt_pk_bf16(v0[2], v0[3]); w.z = cvt_pk_bf16(v1[0], v1[1]); w.w = cvt_pk_bf16(v1[2], v1[3]);
                    if (col0 + bj * HALF < ncols) *(u32x4*)(rowp + bj * HALF) = w; } }
    }
};
template <class Epi, class Sched, bool ALIGN_EPI = false, bool SP2 = false>
__device__ __forceinline__ void gemm_phase(PG8_LAS unsigned char* lds, const Gemm g, const Sched& S, const Epi& E) {
    const int tid = threadIdx.x, wid = __builtin_amdgcn_readfirstlane(tid >> 6), lane = tid & 63, wr = wid >> 2, wc = wid & 3, fr = lane & 15, fq = lane >> 4;
    const int K = g.K, nt = K / BK;
    unsigned voffA[2], voffB[2];
#pragma unroll
    for (int i = 0; i < 2; ++i) { int R, C; stage_rc(tid * 16 + i * 8192, R, C); const int Rb = Epi::PERM ? ((R & ~31) + perm32(R & 31)) : R;
        voffA[i] = (unsigned)(R * K + C) * 2u; voffB[i] = (unsigned)(Rb * K + C) * 2u; }
    const size_t kstep = (size_t)(BK * 2);
    const size_t hstep = (size_t)HALF * K * 2;
    const size_t tstep = 2 * hstep;
    const unsigned ldsw = (unsigned)wid * 1024u;
    const int aoff = lds_byte(wr * 64 + fr, fq * 8), boff = lds_byte(wc * 32 + fr, fq * 8);
#define PG8_SA(b, h) (((b) * 2 + (h)) * HTB)
#define PG8_SB(b, h) ((4 + (b) * 2 + (h)) * HTB)
#define PG8_STAGE(bufoff, gbase, voff) do { _Pragma("unroll") for (int _i = 0; _i < 2; ++_i) \
        __builtin_amdgcn_global_load_lds((const unsigned*)((const char*)(gbase) + (voff)[_i]), (PG8_LAS unsigned*)(lds + (bufoff) + ldsw + _i * 8192), 16, 0, 0); } while (0)
#define PG8_LDA(dst, b, h) do { _Pragma("unroll") for (int m = 0; m < 4; ++m) _Pragma("unroll") for (int k = 0; k < 2; ++k) dst[m][k] = *(const PG8_LAS bf16x8*)(lds + PG8_SA(b, h) + aoff + m * 2048 + k * 1024); } while (0)
#define PG8_LDB(dst, b, h) do { _Pragma("unroll") for (int n = 0; n < 2; ++n) _Pragma("unroll") for (int k = 0; k < 2; ++k) dst[n][k] = *(const PG8_LAS bf16x8*)(lds + PG8_SB(b, h) + boff + n * 2048 + k * 1024); } while (0)
#define PG8_MMA(ai, bj, At, Bt) do { __builtin_amdgcn_s_setprio(1); _Pragma("unroll") for (int m = 0; m < 4; ++m) _Pragma("unroll") for (int n = 0; n < 2; ++n) _Pragma("unroll") for (int k = 0; k < 2; ++k) \
        acc[ai][bj][m][n] = __builtin_amdgcn_mfma_f32_16x16x32_bf16(Bt[n][k], At[m][k], acc[ai][bj][m][n], 0, 0, 0); __builtin_amdgcn_s_setprio(0); } while (0)
#define PG8_WAIT_V(n) asm volatile("s_waitcnt vmcnt(" #n ")" ::: "memory")
#define PG8_WAIT_L(n) asm volatile("s_waitcnt lgkmcnt(" #n ")" ::: "memory")
#define PG8_BAR __builtin_amdgcn_s_barrier()
#define PG8_SCHED __builtin_amdgcn_sched_barrier(0)
    Unit cur, nxt; int ui = 0;
    if (!S.next(0, cur)) return;
    f32x4 acc[2][2][4][2];
#pragma unroll
    for (int a = 0; a < 2; ++a)
#pragma unroll
        for (int b = 0; b < 2; ++b)
#pragma unroll
            for (int m = 0; m < 4; ++m)
#pragma unroll
                for (int n = 0; n < 2; ++n) acc[a][b][m][n] = (f32x4){0.f, 0.f, 0.f, 0.f};
    bf16x8 At[4][2], B0[2][2], B1[2][2];
    const char* cA = (const char*)g.A + (size_t)cur.pm * tstep; const char* cB = (const char*)g.Bt + (size_t)cur.pn * tstep;
    S.a_ready(cur);
    if constexpr (SP2) {
        PG8_STAGE(PG8_SB(0, 0), cB, voffB); PG8_STAGE(PG8_SB(0, 1), cB + hstep, voffB); PG8_STAGE(PG8_SA(0, 0), cA, voffA); PG8_STAGE(PG8_SA(0, 1), cA + hstep, voffA);
        if (wr == 1) PG8_BAR;
        PG8_WAIT_V(2); PG8_BAR;
        PG8_STAGE(PG8_SB(1, 0), cB + kstep, voffB); PG8_STAGE(PG8_SA(1, 0), cA + kstep, voffA); PG8_STAGE(PG8_SB(1, 1), cB + hstep + kstep, voffB);
        PG8_WAIT_V(6); PG8_BAR;
    } else {
        PG8_STAGE(PG8_SB(0, 0), cB, voffB); PG8_STAGE(PG8_SA(0, 0), cA, voffA); PG8_STAGE(PG8_SB(0, 1), cB + hstep, voffB); PG8_STAGE(PG8_SA(0, 1), cA + hstep, voffA);
        if (wr == 1) PG8_BAR;
        PG8_WAIT_V(4); PG8_BAR;
        PG8_STAGE(PG8_SB(1, 0), cB + kstep, voffB); PG8_STAGE(PG8_SA(1, 0), cA + kstep, voffA); PG8_STAGE(PG8_SB(1, 1), cB + hstep + kstep, voffB);
        PG8_WAIT_V(6); PG8_BAR;
    }
    for (;;) {
        const bool has_next = S.next(ui + 1, nxt);
        const char* nA = has_next ? (const char*)g.A + (size_t)nxt.pm * tstep : cA; const char* nB = has_next ? (const char*)g.Bt + (size_t)nxt.pn * tstep : cB;
        for (int t = 0; t < nt; t += 2) {
            const bool last = (t == nt - 2);
            const char* a1 = cA + (size_t)(t + 1) * kstep;
            const char* a2 = last ? nA : cA + (size_t)(t + 2) * kstep; const char* b2 = last ? nB : cB + (size_t)(t + 2) * kstep;
            const char* a3 = a2 + kstep; const char* b3 = b2 + kstep;
            if (last && has_next) S.a_ready(nxt);
            if constexpr (SP2) {
            PG8_LDB(B0, 0, 0); PG8_LDB(B1, 0, 1); PG8_SCHED; PG8_LDA(At, 0, 0); PG8_STAGE(PG8_SA(1, 1), a1 + hstep, voffA);
            PG8_WAIT_V(8); PG8_WAIT_L(0); PG8_BAR; PG8_MMA(0, 0, At, B0); PG8_MMA(0, 1, At, B1); PG8_BAR; PG8_SCHED;
            PG8_LDA(At, 0, 1); PG8_STAGE(PG8_SB(0, 0), b2, voffB); PG8_STAGE(PG8_SB(0, 1), b2 + hstep, voffB); PG8_STAGE(PG8_SA(0, 0), a2, voffA);
            PG8_WAIT_V(8); PG8_WAIT_L(0); PG8_BAR; PG8_MMA(1, 0, At, B0); PG8_MMA(1, 1, At, B1); PG8_BAR; PG8_SCHED;
            PG8_LDB(B0, 1, 0); PG8_LDB(B1, 1, 1); PG8_SCHED; PG8_LDA(At, 1, 0); PG8_STAGE(PG8_SA(0, 1), a2 + hstep, voffA);
            PG8_WAIT_V(8); PG8_WAIT_L(0); PG8_BAR; PG8_MMA(0, 0, At, B0); PG8_MMA(0, 1, At, B1); PG8_BAR; PG8_SCHED;
            PG8_LDA(At, 1, 1); PG8_STAGE(PG8_SB(1, 0), b3, voffB); PG8_STAGE(PG8_SB(1, 1), b3 + hstep, voffB); PG8_STAGE(PG8_SA(1, 0), a3, voffA);
            PG8_WAIT_V(8); PG8_WAIT_L(0); PG8_BAR; PG8_MMA(1, 0, At, B0); PG8_MMA(1, 1, At, B1); PG8_BAR; PG8_SCHED;
            } else {
            PG8_LDB(B0, 0, 0); PG8_SCHED; PG8_LDA(At, 0, 0); PG8_STAGE(PG8_SA(1, 1), a1 + hstep, voffA);
            PG8_WAIT_L(8); PG8_BAR; PG8_WAIT_L(0); PG8_MMA(0, 0, At, B0); PG8_BAR; PG8_SCHED;
            PG8_LDB(B1, 0, 1); PG8_STAGE(PG8_SB(0, 0), b2, voffB);
            PG8_BAR; PG8_WAIT_L(0); PG8_MMA(0, 1, At, B1); PG8_BAR;
            PG8_LDA(At, 0, 1); PG8_STAGE(PG8_SA(0, 0), a2, voffA);
            PG8_BAR; PG8_WAIT_L(0); PG8_MMA(1, 0, At, B0); PG8_BAR; PG8_SCHED;
            PG8_STAGE(PG8_SB(0, 1), b2 + hstep, voffB);
            PG8_WAIT_V(6); PG8_BAR; PG8_MMA(1, 1, At, B1); PG8_BAR;
            PG8_LDB(B0, 1, 0); PG8_SCHED; PG8_LDA(At, 1, 0); PG8_STAGE(PG8_SA(0, 1), a2 + hstep, voffA);
            PG8_WAIT_L(8); PG8_BAR; PG8_WAIT_L(0); PG8_MMA(0, 0, At, B0); PG8_BAR; PG8_SCHED;
            PG8_LDB(B1, 1, 1); PG8_STAGE(PG8_SB(1, 0), b3, voffB);
            PG8_BAR; PG8_WAIT_L(0); PG8_MMA(0, 1, At, B1); PG8_BAR;
            PG8_LDA(At, 1, 1); PG8_STAGE(PG8_SA(1, 0), a3, voffA);
            PG8_BAR; PG8_WAIT_L(0); PG8_MMA(1, 0, At, B0); PG8_BAR; PG8_SCHED;
            PG8_STAGE(PG8_SB(1, 1), b3 + hstep, voffB);
            PG8_WAIT_V(6); PG8_BAR; PG8_MMA(1, 1, At, B1); PG8_BAR;
            }
        }
        if constexpr (ALIGN_EPI) { if (wr == 0) PG8_BAR; }
        if constexpr (!Epi::AFTER_DRAIN) { E(acc, cur, wr, wc, fr, fq); S.done(cur); }
        if (!has_next) break;
#pragma unroll
        for (int a = 0; a < 2; ++a)
#pragma unroll
            for (int b = 0; b < 2; ++b)
#pragma unroll
                for (int m = 0; m < 4; ++m)
#pragma unroll
                    for (int n = 0; n < 2; ++n) acc[a][b][m][n] = (f32x4){0.f, 0.f, 0.f, 0.f};
        cur = nxt; cA = nA; cB = nB; ++ui;
        if constexpr (ALIGN_EPI) { if (wr == 1) PG8_BAR; }
    }
    PG8_WAIT_V(0);
    if constexpr (!ALIGN_EPI) { if (wr == 0) PG8_BAR; }
    PG8_BAR;
    if constexpr (Epi::AFTER_DRAIN) { E.fused(acc, cur, wr, wc, fr, fq, lds, wid, lane); S.done(cur); }
#undef PG8_SA
#undef PG8_SB
#undef PG8_STAGE
#undef PG8_LDA
#undef PG8_LDB
#undef PG8_MMA
#undef PG8_WAIT_V
#undef PG8_WAIT_L
#undef PG8_BAR
#undef PG8_SCHED
}
}
#ifndef PG8_SP2
#define PG8_SP2 true
#endif
#ifndef PG8_ALIGN
#define PG8_ALIGN true
#endif
constexpr int NWAVES = 8;
constexpr int D = 1024, NB = 4, T = 4096, TC = 256;
constexpr int MX = NB * T, MC = NB * TC, MA = MX + MC;
constexpr int NPROJ = 3456, NPROJ_PAD = 3584;
constexpr int COL_XB = 0, COL_XG = 512, COL_XC = 1024, COL_R = 1536, COL_K = 2048, COL_V = 2560, COL_G = 3072, COL_LW = 3200, COL_LA = 3328;
constexpr int NMOD = 6 * D;
constexpr int NEXP = 16384, NSC = 2048;
constexpr float NORM_EPS = 1e-6f, LNX_EPS = 64e-5f;
#ifndef MK_N_LAUNCHES
#define MK_N_LAUNCHES 1
#endif
constexpr int NPH = 9;
constexpr size_t MiB = 1u << 20;
constexpr size_t WS_CTL = 0, CTL_ZERO_BYTES = 64 * 1024;
constexpr size_t WS_MOD = 3 * MiB;
constexpr size_t WS_WINT = 6 * MiB;
constexpr size_t WS_WOUTT = 13 * MiB;
constexpr size_t WS_WEFFT = 15 * MiB;
constexpr size_t WS_U = 20 * MiB, WS_V = 52 * MiB;
constexpr size_t WS_HX = 84 * MiB;
constexpr size_t WS_PROJ = 118 * MiB;
constexpr size_t WS_END = 246 * MiB;
static_assert(WS_PROJ + (size_t)MA * NPROJ * 2 <= WS_END && WS_PROJ + (size_t)MX * NSC * 4 <= WS_END && WS_HX + (size_t)MA * D * 2 <= WS_PROJ, "d_ws map");
constexpr int CW_BAR = 1024;
constexpr int RING_BYTES = 131072;
constexpr int LDSCTL_OFF = RING_BYTES, MISC_OFF = LDSCTL_OFF + 320;
constexpr int LDS_BYTES = 147456;

#define GAS __attribute__((address_space(1)))
#define LAS __attribute__((address_space(3)))
typedef unsigned short bf16;
typedef unsigned v4u __attribute__((ext_vector_type(4)));
typedef unsigned v2u __attribute__((ext_vector_type(2)));
typedef float f32x4 __attribute__((ext_vector_type(4)));
typedef float f32x2 __attribute__((ext_vector_type(2)));
typedef float f32x16 __attribute__((ext_vector_type(16)));
typedef short bf16x8 __attribute__((ext_vector_type(8)));
typedef GAS unsigned gu32;
#define RLX_AGENT __ATOMIC_RELAXED, __HIP_MEMORY_SCOPE_AGENT
#define LDS_WAIT() asm volatile("s_waitcnt lgkmcnt(0)" ::: "memory")
#define VM_WAIT() asm volatile("s_waitcnt vmcnt(0)" ::: "memory")
__device__ __forceinline__ unsigned pk2(float lo, float hi) { return pg8::cvt_pk_bf16(lo, hi); }
__device__ __forceinline__ float bf_lo(unsigned w) { return __builtin_bit_cast(float, w << 16); }
__device__ __forceinline__ float bf_hi(unsigned w) { return __builtin_bit_cast(float, w & 0xffff0000u); }
__device__ __forceinline__ float bf1(bf16 b) { return __builtin_bit_cast(float, (unsigned)b << 16); }
__device__ __forceinline__ float fast_exp(float x) { return __builtin_amdgcn_exp2f(x * 1.44269504089f); }
__device__ __forceinline__ float fast_rcp(float x) { return __builtin_amdgcn_rcpf(x); }
__device__ __forceinline__ float sigmoidf(float x) { return fast_rcp(1.f + fast_exp(-x)); }
__device__ __forceinline__ float tanh_fast(float x) { return 1.f - 2.f * fast_rcp(fast_exp(2.f * x) + 1.f); }
__device__ __forceinline__ float siluf(float x) { return x * sigmoidf(x); }
template <int CTRL> __device__ __forceinline__ float dppf(float x) { return __builtin_bit_cast(float, __builtin_amdgcn_update_dpp(0, __builtin_bit_cast(int, x), CTRL, 0xF, 0xF, false)); }
template <int CTRL> __device__ __forceinline__ unsigned dppu(unsigned x) { return (unsigned)__builtin_amdgcn_update_dpp(0, (int)x, CTRL, 0xF, 0xF, false); }
__device__ __forceinline__ float rowsum16(float x) { x += dppf<0xB1>(x); x += dppf<0x4E>(x); x += dppf<0x141>(x); x += dppf<0x140>(x); return x; }
__device__ __forceinline__ float wave_sum(float v) {
    v = rowsum16(v); v += __shfl_xor(v, 16); v += __shfl_xor(v, 32); return v;
}
__device__ __forceinline__ float half_sum32(float v) { v = rowsum16(v); v += __shfl_xor(v, 16); return v; }
__device__ __forceinline__ unsigned umaxu(unsigned a, unsigned b) { return a > b ? a : b; }
__device__ __forceinline__ unsigned wave_max_u32(unsigned x) {
    x = umaxu(x, dppu<0xB1>(x)); x = umaxu(x, dppu<0x4E>(x)); x = umaxu(x, dppu<0x141>(x)); x = umaxu(x, dppu<0x140>(x));
    const unsigned a = __builtin_amdgcn_readlane((int)x, 0), b = __builtin_amdgcn_readlane((int)x, 16), c = __builtin_amdgcn_readlane((int)x, 32), d = __builtin_amdgcn_readlane((int)x, 48);
    return umaxu(umaxu(a, b), umaxu(c, d));
}
__device__ __forceinline__ unsigned f2key(float f) { const unsigned u = __builtin_bit_cast(unsigned, f); return (u & 0x80000000u) ? ~u : (u | 0x80000000u); }
__device__ __forceinline__ float key2f(unsigned k) { const unsigned u = (k & 0x80000000u) ? (k ^ 0x80000000u) : ~k; return __builtin_bit_cast(float, u); }
#define XB_TMO      128
#define XB_XCNT(j)  (256  + 64 * (j))
#define XB_XSUB(j)  (1280 + 64 * (j))
#define XB_XGEN(j)  (2304 + 64 * (j))
#define XB_TOP      3328
#define XB_TOPGEN   3392
#define XCD_BAR_WORDS 3456
#define XB_SPIN_CAP (1u << 18)

__device__ __forceinline__ unsigned xb_ld(unsigned* p)              { return __hip_atomic_load(p, __ATOMIC_RELAXED, __HIP_MEMORY_SCOPE_AGENT); }
__device__ __forceinline__ unsigned xb_add(unsigned* p, unsigned v) { return __hip_atomic_fetch_add(p, v, __ATOMIC_RELAXED, __HIP_MEMORY_SCOPE_AGENT); }
__device__ __forceinline__ unsigned xb_xcc_id() { return (unsigned)__builtin_amdgcn_s_getreg((3 << 11) | 20) & 0xFu; }
#define XB_SPIN(cond, bar) do { unsigned _sp = 0; while (cond) { __builtin_amdgcn_s_sleep(1); \
    if ((++_sp & 255u) == 0u) { if (xb_ld(&(bar)[XB_TMO])) break; if (_sp > XB_SPIN_CAP) { atomicAdd(&(bar)[XB_TMO], 1u); break; } } } } while (0)

struct XcdBarrier {
    unsigned* bar; unsigned x;
    volatile LAS unsigned* st;
};

__device__ __forceinline__ XcdBarrier xcd_barrier_post(unsigned* bar, volatile LAS unsigned* st) {
    XcdBarrier b; b.bar = bar; b.x = xb_xcc_id(); b.st = st;
    if (threadIdx.x == 0) (void)xb_add(&bar[XB_XCNT(b.x)], 1u);
    return b;
}
__device__ __forceinline__ void xcd_barrier_complete(unsigned* bar, unsigned x, unsigned& nloc, unsigned& nx) {
    const unsigned G = gridDim.x * gridDim.y * gridDim.z;
    unsigned sum, cnt, mine, sp = 0u;
    for (;;) {
        sum = 0u; cnt = 0u; mine = 0u;
#pragma unroll
        for (unsigned j = 0; j < 16; ++j) { const unsigned c = xb_ld(&bar[XB_XCNT(j)]); sum += c; cnt += (c > 0u) ? 1u : 0u; mine = (j == x) ? c : mine; }
        if (sum == G) break;
        __builtin_amdgcn_s_sleep(1);
        if ((++sp & 255u) == 0u) { if (xb_ld(&bar[XB_TMO])) break; if (sp > XB_SPIN_CAP) { atomicAdd(&bar[XB_TMO], 1u); break; } }
    }
    nloc = mine > 0u ? mine : 1u; nx = cnt > 0u ? cnt : 1u;
}

__device__ __forceinline__ void xcd_barrier(const XcdBarrier& b) {
    asm volatile("s_waitcnt vmcnt(0)" ::: "memory");
    __syncthreads();
    if (threadIdx.x == 0) {
        unsigned* bar = b.bar;
        __builtin_amdgcn_s_waitcnt(0);
        unsigned nloc = b.st[0], nx = b.st[1];
        if (nloc == 0u) { xcd_barrier_complete(bar, b.x, nloc, nx); b.st[0] = nloc; b.st[1] = nx; }
        const unsigned old = xb_add(&bar[XB_XSUB(b.x)], 1u);
        const unsigned gen = old / nloc;
        if (old + 1u == (gen + 1u) * nloc) {
            __builtin_amdgcn_fence(__ATOMIC_RELEASE, "agent");
            asm volatile("s_waitcnt vmcnt(0)" ::: "memory");
            const unsigned og = xb_add(&bar[XB_TOP], 1u);
            const unsigned tg = og / nx;
            if (og + 1u == (tg + 1u) * nx) xb_add(&bar[XB_TOPGEN], 1u);
            else XB_SPIN(xb_ld(&bar[XB_TOPGEN]) == tg, bar);
            __builtin_amdgcn_fence(__ATOMIC_ACQUIRE, "agent");
            xb_add(&bar[XB_XGEN(b.x)], 1u);
            asm volatile("s_waitcnt vmcnt(0)" ::: "memory");
        } else {
            XB_SPIN(xb_ld(&bar[XB_XGEN(b.x)]) == gen, bar);
            __builtin_amdgcn_fence(__ATOMIC_ACQUIRE, "agent");
            asm volatile("s_waitcnt vmcnt(0)" ::: "memory");
        }
    }
    __syncthreads();
}
struct Frame {
    LAS unsigned char* lds;
    volatile LAS unsigned* MISC;
    gu32* ctl;
    int tid, lane, wave, G, bid;
    const float* in[25];
    float* out;
    unsigned char* ws;
};
enum { I_X = 0, I_C, I_CTX, I_CCTX, I_WMOD, I_BMOD, I_NG, I_WIN, I_WOUT, I_CONVW, I_TMU, I_DW0, I_DW2, I_A0, I_A2, I_GW2, I_KK, I_KA, I_RK, I_LNG, I_LNB, I_WQ, I_SUBK, I_PU, I_PV };

__device__ __forceinline__ void p0_transpose_item(const float* W, int K, int N, bf16* WT, LAS float* scr, int item, int lane) {
    const int nblk = N / 32, kb = item / nblk, nb = item % nblk, k0 = 64 * kb, n0 = 32 * nb;
#pragma unroll 8
    for (int i = 0; i < 32; ++i) { const int kk = 2 * i + (lane >> 5); scr[kk * 33 + (lane & 31)] = W[(size_t)(k0 + kk) * N + n0 + (lane & 31)]; }
    LDS_WAIT(); asm volatile("" ::: "memory");
    const int c = lane & 7;
#pragma unroll
    for (int j = 0; j < 4; ++j) { const int n = (lane >> 3) + 8 * j; const LAS float* s = scr + (8 * c) * 33 + n;
        v4u o; o.x = pk2(s[0 * 33], s[1 * 33]); o.y = pk2(s[2 * 33], s[3 * 33]); o.z = pk2(s[4 * 33], s[5 * 33]); o.w = pk2(s[6 * 33], s[7 * 33]);
        *(v4u*)(WT + (size_t)(n0 + n) * K + k0 + 8 * c) = o; }
    LDS_WAIT(); asm volatile("" ::: "memory");
}
__device__ __forceinline__ void p0_mod_item(Frame& F, int cb) {
    LAS float* S = (LAS float*)F.lds;
    LAS float* RED = (LAS float*)(F.lds + 32768);
    const float* c = F.in[I_C]; const float* cc = F.in[I_CCTX];
    for (int i = F.tid; i < 5 * D; i += 512) { const int r = i >> 10, k = i & 1023; const float v = (r < 4) ? c[r * D + k] : cc[k]; S[i] = siluf(v); }
    __syncthreads();
    const int col = F.tid & 63, kg = F.tid >> 6;
    const float* wp = F.in[I_WMOD] + (size_t)(kg * 128) * NMOD + cb * 64 + col;
    float a0 = 0.f, a1 = 0.f, a2 = 0.f, a3 = 0.f, a4 = 0.f;
#pragma unroll 8
    for (int k = 0; k < 128; ++k) { const float w = wp[(size_t)k * NMOD]; const int kk = kg * 128 + k;
        a0 += S[kk] * w; a1 += S[D + kk] * w; a2 += S[2 * D + kk] * w; a3 += S[3 * D + kk] * w; a4 += S[4 * D + kk] * w; }
    RED[(kg * 5 + 0) * 64 + col] = a0; RED[(kg * 5 + 1) * 64 + col] = a1; RED[(kg * 5 + 2) * 64 + col] = a2; RED[(kg * 5 + 3) * 64 + col] = a3; RED[(kg * 5 + 4) * 64 + col] = a4;
    __syncthreads();
    if (F.tid < 320) { const int r = F.tid >> 6, cl = F.tid & 63; float s = F.in[I_BMOD][cb * 64 + cl];
#pragma unroll
        for (int g = 0; g < 8; ++g) s += RED[(g * 5 + r) * 64 + cl];
        ((float*)(F.ws + WS_MOD))[r * NMOD + cb * 64 + cl] = s; }
    __syncthreads();
}
__device__ __forceinline__ void p0_weff_item(Frame& F, int item) {
    const int hs = item >> 4, kb = item & 15;
    LAS float* SK = (LAS float*)F.lds;
    LAS float* WQ = (LAS float*)(F.lds + 128 * 132 * 4);
    const float* sk = F.in[I_SUBK] + (size_t)hs * 128 * 128;
    const float* wq = F.in[I_WQ] + (size_t)(kb * 64) * 2048 + hs * 128;
#pragma unroll
    for (int i = 0; i < 8; ++i) { const int idx = F.tid + 512 * i, row = idx >> 5, c4 = idx & 31; const f32x4 v = *(const f32x4*)(sk + row * 128 + c4 * 4); *(LAS f32x4*)(SK + row * 132 + c4 * 4) = v; }
#pragma unroll
    for (int i = 0; i < 4; ++i) { const int idx = F.tid + 512 * i, row = idx >> 5, c4 = idx & 31; const f32x4 v = *(const f32x4*)(wq + (size_t)row * 2048 + c4 * 4); *(LAS f32x4*)(WQ + row * 132 + c4 * 4) = v; }
    __syncthreads();
    const int key = F.tid >> 2, kq = F.tid & 3;
    float acc[16];
#pragma unroll
    for (int i = 0; i < 16; ++i) acc[i] = 0.f;
    for (int d = 0; d < 128; d += 4) {
        const f32x4 a = *(const LAS f32x4*)(SK + key * 132 + d);
#pragma unroll
        for (int i = 0; i < 16; ++i) { const f32x4 b = *(const LAS f32x4*)(WQ + (4 * i + kq) * 132 + d); acc[i] += a.x * b.x + a.y * b.y + a.z * b.z + a.w * b.w; }
    }
    bf16* dst = (bf16*)(F.ws + WS_WEFFT) + (size_t)(hs * 128 + key) * D + kb * 64;
#pragma unroll
    for (int i = 0; i < 16; ++i) dst[4 * i + kq] = (bf16)(pk2(acc[i], 0.f) & 0xffffu);
    __syncthreads();
}
__device__ __forceinline__ void p0_prep(Frame& F) {
    for (int it = F.bid; it < 96 + 256; it += F.G) { if (it < 96) p0_mod_item(F, it); else p0_weff_item(F, it - 96); }
    LAS float* scr = (LAS float*)(F.lds + F.wave * 16384);
    const int gw = F.bid * NWAVES + F.wave, NGW = F.G * NWAVES;
    constexpr int I_IN = (D / 64) * (NPROJ / 32), I_OUT = (D / 64) * (D / 32);
    for (int it = gw; it < I_IN + I_OUT; it += NGW) {
        if (it < I_IN) p0_transpose_item(F.in[I_WIN], D, NPROJ, (bf16*)(F.ws + WS_WINT), scr, it, F.lane);
        else p0_transpose_item(F.in[I_WOUT], D, D, (bf16*)(F.ws + WS_WOUTT), scr, it - I_IN, F.lane);
    }
    { v4u* z = (v4u*)((bf16*)(F.ws + WS_WINT) + (size_t)NPROJ * D); const int n16 = (NPROJ_PAD - NPROJ) * D * 2 / 16;
      for (int i = F.bid * 512 + F.tid; i < n16; i += F.G * 512) z[i] = (v4u){0u, 0u, 0u, 0u}; }
    { const f32x4* pu = (const f32x4*)F.in[I_PU]; const f32x4* pv = (const f32x4*)F.in[I_PV]; v4u* du = (v4u*)(F.ws + WS_U); v4u* dv = (v4u*)(F.ws + WS_V);
      const int n8 = NEXP * D / 8;
      for (int i = F.bid * 512 + F.tid; i < n8; i += F.G * 512) {
          const f32x4 a0 = pu[2 * i], a1 = pu[2 * i + 1], b0 = pv[2 * i], b1 = pv[2 * i + 1];
          du[i] = (v4u){pk2(a0.x, a0.y), pk2(a0.z, a0.w), pk2(a1.x, a1.y), pk2(a1.z, a1.w)};
          dv[i] = (v4u){pk2(b0.x, b0.y), pk2(b0.z, b0.w), pk2(b1.x, b1.y), pk2(b1.z, b1.w)}; } }
}

__device__ __forceinline__ void p1_hx(Frame& F) {
    const float* mod = (const float*)(F.ws + WS_MOD); const float* ng = F.in[I_NG];
    bf16* hx = (bf16*)(F.ws + WS_HX);
    for (int m = F.bid * NWAVES + F.wave; m < MA; m += F.G * NWAVES) {
        const float* src = (m < MX) ? F.in[I_X] + (size_t)m * D : F.in[I_CTX] + (size_t)(m - MX) * D;
        const float* mr = mod + ((m < MX) ? (m >> 12) : 4) * NMOD;
        f32x4 v[4]; float ss = 0.f;
#pragma unroll
        for (int j = 0; j < 4; ++j) { v[j] = *(const f32x4*)(src + j * 256 + F.lane * 4); ss += v[j].x * v[j].x + v[j].y * v[j].y + v[j].z * v[j].z + v[j].w * v[j].w; }
        const float rstd = __builtin_amdgcn_rsqf(wave_sum(ss) * (1.f / D) + NORM_EPS);
#pragma unroll
        for (int j = 0; j < 4; ++j) { const int c = j * 256 + F.lane * 4;
            const f32x4 g = *(const f32x4*)(ng + c), sh = *(const f32x4*)(mr + c), sc = *(const f32x4*)(mr + D + c);
            const float o0 = v[j].x * rstd * g.x * (1.f + sc.x) + sh.x, o1 = v[j].y * rstd * g.y * (1.f + sc.y) + sh.y, o2 = v[j].z * rstd * g.z * (1.f + sc.z) + sh.z, o3 = v[j].w * rstd * g.w * (1.f + sc.w) + sh.w;
            *(v2u*)(hx + (size_t)m * D + c) = (v2u){pk2(o0, o1), pk2(o2, o3)}; }
    }
}
constexpr int SC_W = 0, SC_KK = 8192, SC_KKA = 16384, SC_KD = 24576, SC_R = 32768, SC_V = 40960, SC_Y = 43008, SC_RAW = 45056, SC_TLW = 58368, SC_LOA = 62976,
              SC_W2T = 67584, SC_A2T = 76800, SC_LG = 86016, SC_CONST = 102400, SC_END = 104960;
constexpr int SC_NTILE = (TC + T) / 32;
__device__ __forceinline__ void scan_issue_loads(const bf16* proj, int b, int h, int d, int tile, int tid, v4u (&rg)[3]) {
    const bool isctx = tile < TC / 32; const int L = isctx ? TC : T; const int jt = isctx ? tile : tile - TC / 32;
    const size_t rowbase = isctx ? (size_t)(MX + b * TC) : (size_t)b * T;
    const int tlo = d == 0 ? 32 * jt : L - 32 * (jt + 1);
#pragma unroll
    for (int i = 0; i < 3; ++i) {
        const int q = tid + 512 * i; v4u val = (v4u){0u, 0u, 0u, 0u};
        if (q < 816) { const int row = q / 24, rem = q - row * 24, which = rem >> 3, ch8 = rem & 7; const int tok = tlo - 1 + row;
            if (tok >= 0 && tok < L) val = *(const v4u*)(proj + (rowbase + tok) * NPROJ + COL_R + which * 512 + h * 64 + ch8 * 8); }
        else if (q < 1328) { const int q2 = q - 816, row = q2 >> 4, rem = q2 & 15, which = rem >> 3, ch8 = rem & 7; const int tok = tlo + row;
            val = *(const v4u*)(proj + (rowbase + tok) * NPROJ + (which ? COL_LA : COL_LW) + d * 64 + ch8 * 8); }
        rg[i] = val;
    }
}
__device__ __forceinline__ unsigned tanh_pk(unsigned w) { return pk2(tanh_fast(bf_lo(w)), tanh_fast(bf_hi(w))); }
__device__ __forceinline__ void scan_store_raw(LAS unsigned char* lds, int tid, const v4u (&rg)[3]) {
#pragma unroll
    for (int i = 0; i < 3; ++i) {
        const int q = tid + 512 * i;
        if (q < 816) { const int row = q / 24, rem = q - row * 24, which = rem >> 3, ch8 = rem & 7; *(LAS v4u*)(lds + SC_RAW + (which * 34 + row) * 128 + ch8 * 16) = rg[i]; }
        else if (q < 1328) { const int q2 = q - 816, row = q2 >> 4, rem = q2 & 15, which = rem >> 3, ch8 = rem & 7;
            if (which) *(LAS v4u*)(lds + SC_LOA + row * 144 + ch8 * 16) = rg[i];
            else { v4u t; t.x = tanh_pk(rg[i].x); t.y = tanh_pk(rg[i].y); t.z = tanh_pk(rg[i].z); t.w = tanh_pk(rg[i].w); *(LAS v4u*)(lds + SC_TLW + row * 144 + ch8 * 16) = t; } }
    }
}
__device__ __forceinline__ void p3_scan(Frame& F) {
    LAS unsigned char* lds = F.lds; const int tid = F.tid, lane = F.lane, wave = F.wave;
    const bf16* proj = (const bf16*)(F.ws + WS_PROJ);
    float* yscr = F.out;
    for (int unit = F.bid; unit < 256; unit += F.G) {
        const int chain = unit >> 2, rgp = unit & 3, b = chain >> 4, h = (chain >> 1) & 7, d = chain & 1;
        __syncthreads();
        { LAS float* C = (LAS float*)(lds + SC_CONST);
          if (tid < 384) { const int pn = tid / 192, r = tid - pn * 192, which = r >> 6, c = r & 63; C[pn * 192 + which * 64 + c] = F.in[I_TMU][(pn * 3 + which) * 512 + h * 64 + c]; }
          else if (tid < 448) { const int c = tid - 384; C[384 + c] = F.in[I_KK][h * 64 + c]; C[448 + c] = F.in[I_KA][h * 64 + c]; }
          else { const int c = tid - 448; C[512 + c] = F.in[I_DW0][d * 512 + h * 64 + c]; C[576 + c] = F.in[I_A0][d * 512 + h * 64 + c]; }
          const float* w2 = F.in[I_DW2] + (size_t)d * 64 * 512 + h * 64; const float* a2 = F.in[I_A2] + (size_t)d * 64 * 512 + h * 64;
#pragma unroll
          for (int i = 0; i < 8; ++i) { const int idx = tid + 512 * i, j = idx >> 6, c = idx & 63;
              *(LAS bf16*)(lds + SC_W2T + c * 144 + j * 2) = (bf16)(pk2(w2[j * 512 + c], 0.f) & 0xffffu);
              *(LAS bf16*)(lds + SC_A2T + c * 144 + j * 2) = (bf16)(pk2(a2[j * 512 + c], 0.f) & 0xffffu); } }
        f32x4 st = (f32x4){0.f, 0.f, 0.f, 0.f};
        v4u rg[3];
        scan_issue_loads(proj, b, h, d, 0, tid, rg);
        for (int tile = 0; tile < SC_NTILE; ++tile) {
            const bool isctx = tile < TC / 32; const int L = isctx ? TC : T; const int jt = isctx ? tile : tile - TC / 32;
            const int tlo = d == 0 ? 32 * jt : L - 32 * (jt + 1);
            scan_store_raw(lds, tid, rg);
            __syncthreads();
            if (tile + 1 < SC_NTILE) scan_issue_loads(proj, b, h, d, tile + 1, tid, rg);
            if (wave < 4) {
                const int mat = wave >> 1, nt = wave & 1, r = lane & 31, hh = lane >> 5;
                const LAS unsigned char* Ab = lds + (mat ? SC_LOA : SC_TLW) + r * 144 + hh * 16;
                const LAS unsigned char* Bb = lds + (mat ? SC_A2T : SC_W2T) + (nt * 32 + r) * 144 + hh * 16;
                f32x16 acc;
#pragma unroll
                for (int i = 0; i < 16; ++i) acc[i] = 0.f;
#pragma unroll
                for (int ks = 0; ks < 4; ++ks) { const bf16x8 a = *(const LAS bf16x8*)(Ab + ks * 32), bb = *(const LAS bf16x8*)(Bb + ks * 32); acc = __builtin_amdgcn_mfma_f32_32x32x16_bf16(a, bb, acc, 0, 0, 0); }
                LAS float* LG = (LAS float*)(lds + SC_LG) + mat * 2048 + nt * 32 + r;
#pragma unroll
                for (int i = 0; i < 16; ++i) LG[((i & 3) + 8 * (i >> 2) + 4 * hh) * 64] = acc[i];
            }
            __syncthreads();
            { const int tok = tid >> 4, cq = tid & 15, c0 = cq * 4;
              const LAS float* C = (const LAS float*)(lds + SC_CONST);
              f32x4 xs[3];
#pragma unroll
              for (int which = 0; which < 3; ++which) {
                  const LAS unsigned char* rp = lds + SC_RAW + (which * 34 + tok) * 128 + c0 * 2;
                  const v2u p = *(const LAS v2u*)rp, x = *(const LAS v2u*)(rp + 128), n = *(const LAS v2u*)(rp + 256);
                  const f32x4 mp = *(const LAS f32x4*)(C + which * 64 + c0), mn = *(const LAS f32x4*)(C + 192 + which * 64 + c0);
                  const f32x4 xp = (f32x4){bf_lo(p.x), bf_hi(p.x), bf_lo(p.y), bf_hi(p.y)}, xc = (f32x4){bf_lo(x.x), bf_hi(x.x), bf_lo(x.y), bf_hi(x.y)}, xn = (f32x4){bf_lo(n.x), bf_hi(n.x), bf_lo(n.y), bf_hi(n.y)};
                  xs[which] = xc + mp * (xp - xc) + mn * (xn - xc); }
              const f32x4 kkc = *(const LAS f32x4*)(C + 384 + c0), kac = *(const LAS f32x4*)(C + 448 + c0), w0 = *(const LAS f32x4*)(C + 512 + c0), a0 = *(const LAS f32x4*)(C + 576 + c0);
              f32x4 kk = xs[1] * kkc;
              const float ss = rowsum16(kk.x * kk.x + kk.y * kk.y + kk.z * kk.z + kk.w * kk.w);
              kk = kk * __builtin_amdgcn_rsqf(ss + 1e-12f);
              const f32x4 uw = *(const LAS f32x4*)(lds + SC_LG + (tok * 64 + c0) * 4) + w0, ua = *(const LAS f32x4*)(lds + SC_LG + 8192 + (tok * 64 + c0) * 4) + a0;
              f32x4 dec, av;
#pragma unroll
              for (int e = 0; e < 4; ++e) { dec[e] = fast_exp(-0.60653066f * sigmoidf(uw[e])); av[e] = sigmoidf(ua[e]); }
              const f32x4 kd = xs[1] * (1.f + (av - 1.f) * kac), kka = kk * av;
              const int s = d == 0 ? tok : 31 - tok;
              *(LAS f32x4*)(lds + SC_W + (s * 64 + c0) * 4) = dec; *(LAS f32x4*)(lds + SC_KK + (s * 64 + c0) * 4) = kk; *(LAS f32x4*)(lds + SC_KKA + (s * 64 + c0) * 4) = kka;
              *(LAS f32x4*)(lds + SC_KD + (s * 64 + c0) * 4) = kd; *(LAS f32x4*)(lds + SC_R + (s * 64 + c0) * 4) = xs[0];
              if ((cq >> 2) == rgp) *(LAS f32x4*)(lds + SC_V + (s * 16 + (cq & 3) * 4) * 4) = xs[2]; }
            __syncthreads();
            if (wave < 4) {
                const int q = lane & 15, row = wave * 4 + (lane >> 4);
#pragma unroll 4
                for (int s = 0; s < 32; ++s) {
                    const f32x4 w = *(const LAS f32x4*)(lds + SC_W + (s * 64 + q * 4) * 4), kk = *(const LAS f32x4*)(lds + SC_KK + (s * 64 + q * 4) * 4), kka = *(const LAS f32x4*)(lds + SC_KKA + (s * 64 + q * 4) * 4);
                    const f32x4 kd = *(const LAS f32x4*)(lds + SC_KD + (s * 64 + q * 4) * 4), r = *(const LAS f32x4*)(lds + SC_R + (s * 64 + q * 4) * 4);
                    const float v = *(const LAS float*)(lds + SC_V + (s * 16 + row) * 4);
                    const float sa = rowsum16((st.x * kk.x + st.y * kk.y) + (st.z * kk.z + st.w * kk.w));
                    st = st * w + v * kd - sa * kka;
                    const float y = rowsum16((st.x * r.x + st.y * r.y) + (st.z * r.z + st.w * r.w));
                    if (q == 0) *(LAS float*)(lds + SC_Y + (s * 16 + row) * 4) = y;
                }
            }
            __syncthreads();
            if (!isctx && tid < 128) { const int s = tid >> 2, part = tid & 3; const int tok = d == 0 ? tlo + s : tlo + 31 - s;
                *(f32x4*)(yscr + ((size_t)(b * T + tok)) * D + d * 512 + h * 64 + rgp * 16 + part * 4) = *(const LAS f32x4*)(lds + SC_Y + (s * 16 + part * 4) * 4); }
        }
    }
}
__device__ __forceinline__ void p4_mix(Frame& F) {
    LAS unsigned char* lds = F.lds; const int tid = F.tid;
    const bf16* proj = (const bf16*)(F.ws + WS_PROJ); bf16* cat = (bf16*)(F.ws + WS_HX); const float* yscr = F.out;
    LAS float* SG = (LAS float*)lds;
    LAS bf16* GT = (LAS bf16*)(lds + 32768);
    for (int unit = F.bid; unit < MX / 64; unit += F.G) {
        const size_t row0 = (size_t)unit * 64; const int tb0 = (unit * 64) & (T - 1);
        __syncthreads();
#pragma unroll
        for (int i = 0; i < 2; ++i) { const int ck = tid + 512 * i, tok = ck >> 4, j0 = (ck & 15) * 8;
            const v4u w = *(const v4u*)(proj + (row0 + tok) * NPROJ + COL_G + j0);
            SG[(j0 + 0) * 64 + tok] = sigmoidf(bf_lo(w.x)); SG[(j0 + 1) * 64 + tok] = sigmoidf(bf_hi(w.x)); SG[(j0 + 2) * 64 + tok] = sigmoidf(bf_lo(w.y)); SG[(j0 + 3) * 64 + tok] = sigmoidf(bf_hi(w.y));
            SG[(j0 + 4) * 64 + tok] = sigmoidf(bf_lo(w.z)); SG[(j0 + 5) * 64 + tok] = sigmoidf(bf_hi(w.z)); SG[(j0 + 6) * 64 + tok] = sigmoidf(bf_lo(w.w)); SG[(j0 + 7) * 64 + tok] = sigmoidf(bf_hi(w.w)); }
        __syncthreads();
        { float acc[64];
#pragma unroll
          for (int i = 0; i < 64; ++i) acc[i] = 0.f;
          const float* gw = F.in[I_GW2] + tid;
#pragma unroll 2
          for (int j = 0; j < 128; ++j) { const float wv = gw[j * 512];
#pragma unroll
              for (int tq = 0; tq < 16; ++tq) { const f32x4 s4 = *(const LAS f32x4*)(SG + j * 64 + tq * 4);
                  acc[4 * tq] += s4.x * wv; acc[4 * tq + 1] += s4.y * wv; acc[4 * tq + 2] += s4.z * wv; acc[4 * tq + 3] += s4.w * wv; } }
#pragma unroll
          for (int i = 0; i < 64; ++i) GT[i * 512 + tid] = (bf16)(pk2(acc[i], 0.f) & 0xffffu); }
        __syncthreads();
        if (tid < 256) {
            const int c = 2 * tid; const float* cw = F.in[I_CONVW];
            const f32x2 w0 = *(const f32x2*)(cw + c), w1 = *(const f32x2*)(cw + 512 + c), w2 = *(const f32x2*)(cw + 1024 + c);
            const bf16* pr = proj + row0 * NPROJ + c;
            f32x2 zp = (f32x2){0.f, 0.f}, zc, zn;
            { const unsigned g = *(const unsigned*)(pr + COL_XG), x = *(const unsigned*)(pr + COL_XC); zc = (f32x2){bf_lo(g) * bf_lo(x), bf_hi(g) * bf_hi(x)}; }
            for (int t = 0; t < 64; ++t) {
                if (t < 63) { const unsigned g = *(const unsigned*)(pr + (size_t)(t + 1) * NPROJ + COL_XG), x = *(const unsigned*)(pr + (size_t)(t + 1) * NPROJ + COL_XC); zn = (f32x2){bf_lo(g) * bf_lo(x), bf_hi(g) * bf_hi(x)}; }
                else zn = (f32x2){0.f, 0.f};
                const unsigned xb = *(const unsigned*)(pr + (size_t)t * NPROJ + COL_XB);
                const f32x2 z = w0 * zp + w1 * zc + w2 * zn;
                *(unsigned*)(cat + (row0 + t) * D + c) = pk2(bf_lo(xb) * z.x, bf_hi(xb) * z.y);
                zp = zc; zc = zn;
            }
        } else {
            const int ri = tid - 256, c = 2 * ri, h = ri >> 5;
            const f32x2 mpr = *(const f32x2*)(F.in[I_TMU] + 0 * 512 + c), mpk = *(const f32x2*)(F.in[I_TMU] + 1 * 512 + c), mpv = *(const f32x2*)(F.in[I_TMU] + 2 * 512 + c);
            const f32x2 mnr = *(const f32x2*)(F.in[I_TMU] + 3 * 512 + c), mnk = *(const f32x2*)(F.in[I_TMU] + 4 * 512 + c), mnv = *(const f32x2*)(F.in[I_TMU] + 5 * 512 + c);
            const f32x2 rk = *(const f32x2*)(F.in[I_RK] + c), lg = *(const f32x2*)(F.in[I_LNG] + c), lb = *(const f32x2*)(F.in[I_LNB] + c);
            const bf16* pr = proj + row0 * NPROJ + c;
            f32x2 rp, kp, vp, rc, kc, vc, rn, kn, vn;
#define LD2(dst, ptr) do { const unsigned _w = *(const unsigned*)(ptr); dst = (f32x2){bf_lo(_w), bf_hi(_w)}; } while (0)
            if (tb0 > 0) { LD2(rp, pr - NPROJ + COL_R); LD2(kp, pr - NPROJ + COL_K); LD2(vp, pr - NPROJ + COL_V); } else { rp = kp = vp = (f32x2){0.f, 0.f}; }
            LD2(rc, pr + COL_R); LD2(kc, pr + COL_K); LD2(vc, pr + COL_V);
            for (int t = 0; t < 64; ++t) {
                if (tb0 + t + 1 < T) { const bf16* pn = pr + (size_t)(t + 1) * NPROJ; LD2(rn, pn + COL_R); LD2(kn, pn + COL_K); LD2(vn, pn + COL_V); } else { rn = kn = vn = (f32x2){0.f, 0.f}; }
                const f32x2 rs = rc + mpr * (rp - rc) + mnr * (rn - rc), ks = kc + mpk * (kp - kc) + mnk * (kn - kc), vs = vc + mpv * (vp - vc) + mnv * (vn - vc);
                const float* yr = yscr + (row0 + t) * D + c;
                const f32x2 y = *(const f32x2*)yr + *(const f32x2*)(yr + 512);
                const float mu = half_sum32(y.x + y.y) * (1.f / 64.f);
                const f32x2 yc = y - mu;
                const float var = half_sum32(yc.x * yc.x + yc.y * yc.y) * (1.f / 64.f);
                const float bon = half_sum32(rs.x * ks.x * rk.x + rs.y * ks.y * rk.y);
                const f32x2 yn = yc * __builtin_amdgcn_rsqf(var + LNX_EPS) * lg + lb + bon * vs;
                const unsigned gt = *(const LAS unsigned*)(GT + t * 512 + c);
                *(unsigned*)(cat + (row0 + t) * D + 512 + c) = pk2(yn.x * bf_lo(gt), yn.y * bf_hi(gt));
                rp = rc; kp = kc; vp = vc; rc = rn; kc = kn; vc = vn;
            }
#undef LD2
        }
    }
}

__device__ __forceinline__ void p6_mid(Frame& F) {
    const float* mod = (const float*)(F.ws + WS_MOD); const float* ng = F.in[I_NG];
    const float* yx = (const float*)(F.ws + WS_PROJ); bf16* hx2 = (bf16*)(F.ws + WS_HX);
    for (int m = F.bid * NWAVES + F.wave; m < MX; m += F.G * NWAVES) {
        const float* mr = mod + (m >> 12) * NMOD;
        f32x4 v[4], xv[4]; float ss = 0.f;
#pragma unroll
        for (int j = 0; j < 4; ++j) { v[j] = *(const f32x4*)(yx + (size_t)m * D + j * 256 + F.lane * 4); xv[j] = *(const f32x4*)(F.in[I_X] + (size_t)m * D + j * 256 + F.lane * 4);
            ss += v[j].x * v[j].x + v[j].y * v[j].y + v[j].z * v[j].z + v[j].w * v[j].w; }
        const float rstd = __builtin_amdgcn_rsqf(wave_sum(ss) * (1.f / D) + NORM_EPS);
        float ss2 = 0.f;
#pragma unroll
        for (int j = 0; j < 4; ++j) { const int c = j * 256 + F.lane * 4;
            const f32x4 g1 = *(const f32x4*)(ng + D + c), gt = *(const f32x4*)(mr + 2 * D + c);
            xv[j] = xv[j] + gt * (v[j] * rstd * g1);
            *(f32x4*)(F.out + (size_t)m * D + c) = xv[j];
            ss2 += xv[j].x * xv[j].x + xv[j].y * xv[j].y + xv[j].z * xv[j].z + xv[j].w * xv[j].w; }
        const float rstd2 = __builtin_amdgcn_rsqf(wave_sum(ss2) * (1.f / D) + NORM_EPS);
#pragma unroll
        for (int j = 0; j < 4; ++j) { const int c = j * 256 + F.lane * 4;
            const f32x4 g2 = *(const f32x4*)(ng + 2 * D + c), sh = *(const f32x4*)(mr + 3 * D + c), sc = *(const f32x4*)(mr + 4 * D + c);
            const f32x4 o = xv[j] * rstd2 * g2 * (1.f + sc) + sh;
            *(v2u*)(hx2 + (size_t)m * D + c) = (v2u){pk2(o.x, o.y), pk2(o.z, o.w)}; }
    }
}
__device__ __forceinline__ float gelu_erf(float x) { return 0.5f * x * (1.f + erff(x * 0.70710678118f)); }
__device__ __forceinline__ float dot2bf(unsigned a, unsigned b, float c) {
    typedef __bf16 bf2 __attribute__((ext_vector_type(2)));
    return __builtin_amdgcn_fdot2_f32_bf16(__builtin_bit_cast(bf2, a), __builtin_bit_cast(bf2, b), c, false);
}
__device__ __forceinline__ void p8_peer(Frame& F) {
    const int lane = F.lane, wave = F.wave;
    LAS int* EX = (LAS int*)(F.lds + wave * 2048);
    LAS float* GG = (LAS float*)(F.lds + wave * 2048 + 512);
    const float* scores = (const float*)(F.ws + WS_PROJ); const bf16* hx2 = (const bf16*)(F.ws + WS_HX);
    const unsigned char* U = F.ws + WS_U; const unsigned char* V = F.ws + WS_V;
    const float* mod = (const float*)(F.ws + WS_MOD); const float* ng3 = F.in[I_NG] + 3 * D;
    int ci = 0, cj = 0; { int l = lane, i = 0; for (; i < 16; ++i) { const int n = 16 / (i + 1); if (l < n) break; l -= n; } ci = i < 16 ? i : 0; cj = i < 16 ? l : 0; }
    const bool cvalid = lane < 50;
    for (int m = F.bid * NWAVES + wave; m < MX; m += F.G * NWAVES) {
        const float* srow = scores + (size_t)m * NSC;
        for (int h = 0; h < 8; ++h) {
            unsigned res[2];
#pragma unroll
            for (int s = 0; s < 2; ++s) {
                const float* lp = srow + (h * 2 + s) * 128;
                unsigned k0 = (f2key(lp[lane]) & ~127u) | (unsigned)(127 - lane), k1 = (f2key(lp[64 + lane]) & ~127u) | (unsigned)(63 - lane);
                unsigned r = 0u;
                for (int it = 0; it < 16; ++it) { const unsigned mx = wave_max_u32(umaxu(k0, k1)); r = (lane == it) ? mx : r; k0 = (k0 == mx) ? 0u : k0; k1 = (k1 == mx) ? 0u : k1; }
                res[s] = r;
            }
            const unsigned ka = (unsigned)__shfl((int)res[0], ci), kb = (unsigned)__shfl((int)res[1], cj);
            const float sum = key2f(ka & ~127u) + key2f(kb & ~127u);
            unsigned ck = cvalid ? ((f2key(sum) & ~63u) | (unsigned)(63 - lane)) : 0u;
            unsigned win = 0u;
            for (int it = 0; it < 16; ++it) { const unsigned mx = wave_max_u32(ck); win = (lane == it) ? mx : win; ck = (ck == mx) ? 0u : ck; }
            const int wl = 63 - (int)(win & 63u);
            const int wi = __shfl(ci, wl), wj = __shfl(cj, wl);
            const int idx0 = 127 - (int)((unsigned)__shfl((int)res[0], wi) & 127u), idx1 = 127 - (int)((unsigned)__shfl((int)res[1], wj) & 127u);
            const float scv = key2f(win & ~63u);
            const float smax = __shfl(scv, 0);
            const float e = (lane < 16) ? fast_exp(scv - smax) : 0.f;
            const float den = rowsum16(e);
            if (lane < 16) { EX[h * 16 + lane] = idx0 * 128 + idx1; GG[h * 16 + lane] = e * fast_rcp(den); }
        }
        LDS_WAIT();
        const v4u ha = *(const v4u*)(hx2 + (size_t)m * D + lane * 8), hb = *(const v4u*)(hx2 + (size_t)m * D + 512 + lane * 8);
        for (int e0 = 0; e0 < 128; e0 += 8) {
            v4u ua[8], ub[8];
#pragma unroll
            for (int j = 0; j < 8; ++j) { const int ex = __builtin_amdgcn_readfirstlane(EX[e0 + j]); const unsigned char* up = U + (size_t)ex * 2048 + lane * 16; ua[j] = *(const v4u*)up; ub[j] = *(const v4u*)(up + 1024); }
#pragma unroll
            for (int j = 0; j < 8; ++j) {
                float p = dot2bf(ua[j].x, ha.x, 0.f); p = dot2bf(ua[j].y, ha.y, p); p = dot2bf(ua[j].z, ha.z, p); p = dot2bf(ua[j].w, ha.w, p);
                p = dot2bf(ub[j].x, hb.x, p); p = dot2bf(ub[j].y, hb.y, p); p = dot2bf(ub[j].z, hb.z, p); p = dot2bf(ub[j].w, hb.w, p);
                p = wave_sum(p);
                if (lane == 0) GG[e0 + j] = GG[e0 + j] * gelu_erf(p);
            }
        }
        LDS_WAIT();
        float acc[16];
#pragma unroll
        for (int i = 0; i < 16; ++i) acc[i] = 0.f;
        for (int e0 = 0; e0 < 128; e0 += 8) {
            v4u va[8], vb[8];
#pragma unroll
            for (int j = 0; j < 8; ++j) { const int ex = __builtin_amdgcn_readfirstlane(EX[e0 + j]); const unsigned char* vp = V + (size_t)ex * 2048 + lane * 16; va[j] = *(const v4u*)vp; vb[j] = *(const v4u*)(vp + 1024); }
#pragma unroll
            for (int j = 0; j < 8; ++j) { const float cf = GG[e0 + j];
                acc[0] += cf * bf_lo(va[j].x); acc[1] += cf * bf_hi(va[j].x); acc[2] += cf * bf_lo(va[j].y); acc[3] += cf * bf_hi(va[j].y);
                acc[4] += cf * bf_lo(va[j].z); acc[5] += cf * bf_hi(va[j].z); acc[6] += cf * bf_lo(va[j].w); acc[7] += cf * bf_hi(va[j].w);
                acc[8] += cf * bf_lo(vb[j].x); acc[9] += cf * bf_hi(vb[j].x); acc[10] += cf * bf_lo(vb[j].y); acc[11] += cf * bf_hi(vb[j].y);
                acc[12] += cf * bf_lo(vb[j].z); acc[13] += cf * bf_hi(vb[j].z); acc[14] += cf * bf_lo(vb[j].w); acc[15] += cf * bf_hi(vb[j].w); }
        }
        float ss = 0.f;
#pragma unroll
        for (int i = 0; i < 16; ++i) ss += acc[i] * acc[i];
        const float rstd = __builtin_amdgcn_rsqf(wave_sum(ss) * (1.f / D) + NORM_EPS);
        const float* gt2 = mod + (m >> 12) * NMOD + 5 * D;
#pragma unroll
        for (int half = 0; half < 2; ++half)
#pragma unroll
            for (int q = 0; q < 2; ++q) { const int c = half * 512 + lane * 8 + q * 4; float* op = F.out + (size_t)m * D + c;
                const f32x4 x1 = *(const f32x4*)op, g = *(const f32x4*)(ng3 + c), gt = *(const f32x4*)(gt2 + c);
                const f32x4 a = (f32x4){acc[half * 8 + q * 4], acc[half * 8 + q * 4 + 1], acc[half * 8 + q * 4 + 2], acc[half * 8 + q * 4 + 3]};
                *(f32x4*)op = x1 + gt * (a * rstd * g); }
        LDS_WAIT();
    }
}
struct Args { const float* in[25]; float* out; unsigned char* ws; int ph_lo, ph_hi; };
__global__ void __launch_bounds__(NWAVES * 64, 2) mk_fwd(Args args) {
    extern __shared__ __attribute__((aligned(16))) unsigned char lds_raw[];
    Frame F;
    F.lds = (LAS unsigned char*)lds_raw;
    F.MISC = (volatile LAS unsigned*)(F.lds + MISC_OFF);
    F.tid = threadIdx.x; F.lane = F.tid & 63; F.wave = __builtin_amdgcn_readfirstlane(F.tid >> 6);
    F.G = gridDim.x; F.bid = blockIdx.x;
#pragma unroll
    for (int i = 0; i < 25; ++i) F.in[i] = args.in[i];
    F.out = args.out; F.ws = args.ws; F.ctl = (gu32*)(args.ws + WS_CTL);
    for (int u = F.tid; u < (LDS_BYTES - LDSCTL_OFF) / 4; u += NWAVES * 64) ((LAS unsigned*)(F.lds + LDSCTL_OFF))[u] = 0u;
    __syncthreads();
    const int lo = args.ph_lo, hi = args.ph_hi;
    XcdBarrier bar; bar.bar = (unsigned*)(F.ctl + CW_BAR); bar.x = 0; bar.st = nullptr;
    if (hi - lo > 1) bar = xcd_barrier_post((unsigned*)(F.ctl + CW_BAR), F.MISC + 8);
#define IN(k) (lo <= (k) && (k) < hi)
#define SEAM(k) do { if (IN(k) && IN((k) + 1)) xcd_barrier(bar); } while (0)
    if (IN(0)) { p0_prep(F); } SEAM(0);
    if (IN(1)) { p1_hx(F); } SEAM(1);
    if (IN(2)) {
        pg8::Gemm g{(const pg8::bf16_t*)(F.ws + WS_HX), (const pg8::bf16_t*)(F.ws + WS_WINT), MA, NPROJ_PAD, D}; pg8::StaticOrder S; S.init(MA, NPROJ_PAD, F.G, F.bid);
        pg8::EpiProj E{(pg8::bf16_t*)(F.ws + WS_PROJ), NPROJ, NPROJ};
        pg8::gemm_phase<pg8::EpiProj, pg8::StaticOrder, PG8_ALIGN, PG8_SP2>(F.lds, g, S, E);
    } SEAM(2);
    if (IN(3)) { p3_scan(F); } SEAM(3);
    if (IN(4)) { p4_mix(F); } SEAM(4);
    if (IN(5)) {
        pg8::Gemm g{(const pg8::bf16_t*)(F.ws + WS_HX), (const pg8::bf16_t*)(F.ws + WS_WOUTT), MX, D, D}; pg8::StaticOrder S; S.init(MX, D, F.G, F.bid);
        pg8::EpiF32 E{(float*)(F.ws + WS_PROJ), D};
        pg8::gemm_phase<pg8::EpiF32, pg8::StaticOrder, PG8_ALIGN, PG8_SP2>(F.lds, g, S, E);
    } SEAM(5);
    if (IN(6)) { p6_mid(F); } SEAM(6);
    if (IN(7)) {
        pg8::Gemm g{(const pg8::bf16_t*)(F.ws + WS_HX), (const pg8::bf16_t*)(F.ws + WS_WEFFT), MX, NSC, D}; pg8::StaticOrder S; S.init(MX, NSC, F.G, F.bid);
        pg8::EpiF32 E{(float*)(F.ws + WS_PROJ), NSC};
        pg8::gemm_phase<pg8::EpiF32, pg8::StaticOrder, PG8_ALIGN, PG8_SP2>(F.lds, g, S, E);
    } SEAM(7);
    if (IN(8)) { p8_peer(F); }
#undef IN
#undef SEAM
}

extern "C" void kernel_launch(void* const* d_in, const int* in_sizes, int n_in, void* d_out, int out_size, void* d_ws, size_t ws_size, hipStream_t stream) {
    static int grid = 0;
    if (grid == 0) {
        if (n_in != 25 || in_sizes[0] != MX * D || out_size != MX * D || ws_size < WS_END) { fprintf(stderr, "kernel_launch: unexpected problem (n_in %d, in0 %d, out %d, ws %zu); nothing launched\n", n_in, n_in > 0 ? in_sizes[0] : -1, out_size, ws_size); grid = -1; return; }
        int dev = 0, cus = 0, per_cu = 0;
        if (hipGetDevice(&dev) != hipSuccess || hipDeviceGetAttribute(&cus, hipDeviceAttributeMultiprocessorCount, dev) != hipSuccess) { fprintf(stderr, "kernel_launch: device query failed\n"); grid = -1; return; }
        if (hipFuncSetAttribute((const void*)mk_fwd, hipFuncAttributeMaxDynamicSharedMemorySize, LDS_BYTES) != hipSuccess) { fprintf(stderr, "kernel_launch: hipFuncSetAttribute failed\n"); grid = -1; return; }
        if (hipOccupancyMaxActiveBlocksPerMultiprocessor(&per_cu, (const void*)mk_fwd, NWAVES * 64, LDS_BYTES) != hipSuccess || per_cu < 1) fprintf(stderr, "kernel_launch: occupancy query reports %d workgroups per CU\n", per_cu);
        (void)hipGetLastError();
        grid = cus;
    }
    if (grid < 0) return;
    if (hipMemsetAsync((char*)d_ws + WS_CTL, 0, CTL_ZERO_BYTES, stream) != hipSuccess) { fprintf(stderr, "kernel_launch: memset failed\n"); return; }
    Args a{};
    for (int i = 0; i < 25; ++i) a.in[i] = (const float*)d_in[i];
    a.out = (float*)d_out; a.ws = (unsigned char*)d_ws;
    if (MK_N_LAUNCHES == 1) { a.ph_lo = 0; a.ph_hi = NPH; hipLaunchKernelGGL(mk_fwd, dim3(grid), dim3(NWAVES * 64), LDS_BYTES, stream, a); }
    else for (int p = 0; p < NPH; ++p) { a.ph_lo = p; a.ph_hi = p + 1; hipLaunchKernelGGL(mk_fwd, dim3(grid), dim3(NWAVES * 64), LDS_BYTES, stream, a); }
    const hipError_t le = hipPeekAtLastError();
    if (le != hipSuccess) fprintf(stderr, "kernel_launch: launch failed: %s\n", hipGetErrorName(le));
}
```

```cpp
#include <hip/hip_runtime.h>
#include <cstdio>
#include <cstdint>
namespace pg8 {
#define PG8_LAS __attribute__((address_space(3)))
typedef unsigned short bf16_t;
typedef short bf16x8 __attribute__((ext_vector_type(8)));
typedef float f32x4 __attribute__((ext_vector_type(4)));
typedef unsigned u32x4 __attribute__((ext_vector_type(4)));
constexpr int BM = 256, BK = 64, HALF = 128, HTB = HALF * BK * 2  , STAGE_BYTES = 8 * HTB, NXCD = 8, WGM = 8;

__host__ __device__ __forceinline__ int lds_byte(int r, int c) { const int st = (r >> 4) * 2 + (c >> 5), rr = r & 15, cc = c & 31, ob = rr * 64 + cc * 2; return st * 1024 + (ob ^ (((ob >> 9) & 1) << 5)); }
__host__ __device__ __forceinline__ void stage_rc(int b, int& R, int& C) { const int st = b / 1024, sb = b % 1024, swz = sb ^ (((sb >> 9) & 1) << 5); R = (st >> 1) * 16 + swz / 64; C = (st & 1) * 32 + (swz % 64) / 2; }
__host__ __device__ __forceinline__ int perm32(int rho) { const int n = rho >> 4, i = rho & 15; return 8 * (i >> 2) + 4 * n + (i & 3); }

struct Unit { int pm, pn; };
struct Gemm { const bf16_t* A; const bf16_t* Bt; int M, N, K; };

struct StaticOrder {
    int nM, nN, nwg, G, c;
    __host__ __device__ void init(int M, int N, int G_, int c_) { nM = M / BM; nN = N / BM; nwg = nM * nN; G = G_; c = c_; }
    __host__ __device__ bool next(int i, Unit& u) const {
        const long L = (long)i * G + c; if (L >= nwg) return false;
        int wgid = (int)L; { const int q = nwg / NXCD, r = nwg % NXCD, xcd = wgid % NXCD, off = wgid / NXCD; wgid = (xcd < r ? xcd * (q + 1) : r * (q + 1) + (xcd - r) * q) + off; }
        const int nig = WGM * nN, gid = wgid / nig, fm = gid * WGM, gsz = (nM - fm) < WGM ? (nM - fm) : WGM;
        u.pm = fm + ((wgid % nig) % gsz); u.pn = (wgid % nig) / gsz; return true;
    }
    __device__ __forceinline__ void a_ready(const Unit&) const {}
    __device__ __forceinline__ void done(const Unit&) const {}
};

__device__ __forceinline__ unsigned cvt_pk_bf16(float lo, float hi) { unsigned r; asm volatile("v_cvt_pk_bf16_f32 %0, %1, %2" : "=v"(r) : "v"(lo), "v"(hi)); return r; }
typedef float f32x2 __attribute__((ext_vector_type(2)));
__device__ __forceinline__ f32x2 gelu_pk(f32x2 v) {
    const f32x2 av = __builtin_elementwise_abs(v), d = av * 0.2316418882f + 1.0f;
    f32x2 t; t.x = __builtin_amdgcn_rcpf(d.x); t.y = __builtin_amdgcn_rcpf(d.y);
    f32x2 q = t * 0.5307027145f + (-0.7265760135f); q = q * t + 0.7107068705f; q = q * t + (-0.142248368f); q = q * t + 0.127414796f; q = q * t;
    const f32x2 s = (v * v) * (-0.72134752044f);
    f32x2 e; e.x = __builtin_amdgcn_exp2f(s.x); e.y = __builtin_amdgcn_exp2f(s.y);
    const f32x2 m = v * (q * e), r = v - m;
    f32x2 o; o.x = v.x < 0.f ? m.x : r.x; o.y = v.y < 0.f ? m.y : r.y; return o;
}

template <int ACT  > struct EpiBf16 {
    static constexpr bool PERM = true, AFTER_DRAIN = false; static_assert(ACT == 0 || ACT == 1, "EpiBf16: ACT is 0 (none) or 1 (gelu_pk)");
    bf16_t* O; int ldc; const float* bias; int split_cols; size_t split_stride; float scale0;
    __device__ __forceinline__ void operator()(const f32x4 (&acc)[2][2][4][2], const Unit& u, int wr, int wc, int fr, int fq) const {
        const int row0 = u.pm * BM + wr * 64 + fr; int colt = u.pn * BM; bf16_t* base = O;
        float sc = 1.f; if (split_cols) { const int t = colt / split_cols; base += (size_t)t * split_stride; colt -= t * split_cols; if (t == 0) sc = scale0; }
        const int col0 = colt + wc * 32 + 8 * fq, bcol0 = u.pn * BM + wc * 32 + 8 * fq;
        f32x4 bv[2][2];
#pragma unroll
        for (int bj = 0; bj < 2; ++bj)
#pragma unroll
            for (int n = 0; n < 2; ++n) bv[bj][n] = bias ? *(const f32x4*)(bias + bcol0 + bj * HALF + 4 * n) : (f32x4){0.f, 0.f, 0.f, 0.f};
#pragma unroll
        for (int ai = 0; ai < 2; ++ai)
#pragma unroll
            for (int m = 0; m < 4; ++m) { bf16_t* rowp = base + (size_t)(row0 + ai * HALF + m * 16) * ldc + col0;
#pragma unroll
                for (int bj = 0; bj < 2; ++bj) { f32x4 v0 = acc[ai][bj][m][0] + bv[bj][0], v1 = acc[ai][bj][m][1] + bv[bj][1];
                    if (ACT == 1) { f32x2 a = gelu_pk((f32x2){v0[0], v0[1]}), b = gelu_pk((f32x2){v0[2], v0[3]}), c = gelu_pk((f32x2){v1[0], v1[1]}), d = gelu_pk((f32x2){v1[2], v1[3]});
                        v0 = (f32x4){a.x, a.y, b.x, b.y}; v1 = (f32x4){c.x, c.y, d.x, d.y}; }
                    v0 = v0 * sc; v1 = v1 * sc; u32x4 w; w.x = cvt_pk_bf16(v0[0], v0[1]); w.y = cvt_pk_bf16(v0[2], v0[3]); w.z = cvt_pk_bf16(v1[0], v1[1]); w.w = cvt_pk_bf16(v1[2], v1[3]);
                    *(u32x4*)(rowp + bj * HALF) = w; } }
    }
};

struct EpiF32 {
    static constexpr bool PERM = false, AFTER_DRAIN = false;
    float* C; int ldc;
    __device__ __forceinline__ void operator()(const f32x4 (&acc)[2][2][4][2], const Unit& u, int wr, int wc, int fr, int fq) const {
        const int row0 = u.pm * BM + wr * 64 + fr, col0 = u.pn * BM + wc * 32 + 4 * fq;
#pragma unroll
        for (int ai = 0; ai < 2; ++ai)
#pragma unroll
            for (int m = 0; m < 4; ++m) { float* rowp = C + (size_t)(row0 + ai * HALF + m * 16) * ldc + col0;
#pragma unroll
                for (int bj = 0; bj < 2; ++bj)
#pragma unroll
                    for (int n = 0; n < 2; ++n) *(f32x4*)(rowp + bj * HALF + n * 16) = acc[ai][bj][m][n]; }
    }
};
struct EpiProj {
    static constexpr bool PERM = true, AFTER_DRAIN = false;
    bf16_t* O; int ldc; int ncols;
    __device__ __forceinline__ void operator()(const f32x4 (&acc)[2][2][4][2], const Unit& u, int wr, int wc, int fr, int fq) const {
        const int row0 = u.pm * BM + wr * 64 + fr; const int col0 = u.pn * BM + wc * 32 + 8 * fq;
#pragma unroll
        for (int ai = 0; ai < 2; ++ai)
#pragma unroll
            for (int m = 0; m < 4; ++m) { bf16_t* rowp = O + (size_t)(row0 + ai * HALF + m * 16) * ldc + col0;
#pragma unroll
                for (int bj = 0; bj < 2; ++bj) { const f32x4 v0 = acc[ai][bj][m][0], v1 = acc[ai][bj][m][1];
                    u32x4 w; w.x = cvt_pk_bf16(v0[0], v0[1]); w.y = cvt_pk_bf16(v0[2], v0[3]); w.z = cvt_pk_bf16(v1[0], v1[1]); w.w = cvt_pk_bf16(v1[2], v1[3]);
                    if (col0 + bj * HALF < ncols) *(u32x4*)(rowp + bj * HALF) = w; } }
    }
};
template <class Epi, class Sched, bool ALIGN_EPI = false, bool SP2 = false>
__device__ __forceinline__ void gemm_phase(PG8_LAS unsigned char* lds, const Gemm g, const Sched& S, const Epi& E) {
    const int tid = threadIdx.x, wid = __builtin_amdgcn_readfirstlane(tid >> 6), lane = tid & 63, wr = wid >> 2, wc = wid & 3, fr = lane & 15, fq = lane >> 4;
    const int K = g.K, nt = K / BK;
    unsigned voffA[2], voffB[2];
#pragma unroll
    for (int i = 0; i < 2; ++i) { int R, C; stage_rc(tid * 16 + i * 8192, R, C); const int Rb = Epi::PERM ? ((R & ~31) + perm32(R & 31)) : R;
        voffA[i] = (unsigned)(R * K + C) * 2u; voffB[i] = (unsigned)(Rb * K + C) * 2u; }
    const size_t kstep = (size_t)(BK * 2);
    const size_t hstep = (size_t)HALF * K * 2;
    const size_t tstep = 2 * hstep;
    const unsigned ldsw = (unsigned)wid * 1024u;
    const int aoff = lds_byte(wr * 64 + fr, fq * 8), boff = lds_byte(wc * 32 + fr, fq * 8);
#define PG8_SA(b, h) (((b) * 2 + (h)) * HTB)
#define PG8_SB(b, h) ((4 + (b) * 2 + (h)) * HTB)
#define PG8_STAGE(bufoff, gbase, voff) do { _Pragma("unroll") for (int _i = 0; _i < 2; ++_i) \
        __builtin_amdgcn_global_load_lds((const unsigned*)((const char*)(gbase) + (voff)[_i]), (PG8_LAS unsigned*)(lds + (bufoff) + ldsw + _i * 8192), 16, 0, 0); } while (0)
#define PG8_LDA(dst, b, h) do { _Pragma("unroll") for (int m = 0; m < 4; ++m) _Pragma("unroll") for (int k = 0; k < 2; ++k) dst[m][k] = *(const PG8_LAS bf16x8*)(lds + PG8_SA(b, h) + aoff + m * 2048 + k * 1024); } while (0)
#define PG8_LDB(dst, b, h) do { _Pragma("unroll") for (int n = 0; n < 2; ++n) _Pragma("unroll") for (int k = 0; k < 2; ++k) dst[n][k] = *(const PG8_LAS bf16x8*)(lds + PG8_SB(b, h) + boff + n * 2048 + k * 1024); } while (0)
#define PG8_MMA(ai, bj, At, Bt) do { __builtin_amdgcn_s_setprio(1); _Pragma("unroll") for (int m = 0; m < 4; ++m) _Pragma("unroll") for (int n = 0; n < 2; ++n) _Pragma("unroll") for (int k = 0; k < 2; ++k) \
        acc[ai][bj][m][n] = __builtin_amdgcn_mfma_f32_16x16x32_bf16(Bt[n][k], At[m][k], acc[ai][bj][m][n], 0, 0, 0); __builtin_amdgcn_s_setprio(0); } while (0)
#define PG8_WAIT_V(n) asm volatile("s_waitcnt vmcnt(" #n ")" ::: "memory")
#define PG8_WAIT_L(n) asm volatile("s_waitcnt lgkmcnt(" #n ")" ::: "memory")
#define PG8_BAR __builtin_amdgcn_s_barrier()
#define PG8_SCHED __builtin_amdgcn_sched_barrier(0)
    Unit cur, nxt; int ui = 0;
    if (!S.next(0, cur)) return;
    f32x4 acc[2][2][4][2];
#pragma unroll
    for (int a = 0; a < 2; ++a)
#pragma unroll
        for (int b = 0; b < 2; ++b)
#pragma unroll
            for (int m = 0; m < 4; ++m)
#pragma unroll
                for (int n = 0; n < 2; ++n) acc[a][b][m][n] = (f32x4){0.f, 0.f, 0.f, 0.f};
    bf16x8 At[4][2], B0[2][2], B1[2][2];
    const char* cA = (const char*)g.A + (size_t)cur.pm * tstep; const char* cB = (const char*)g.Bt + (size_t)cur.pn * tstep;
    S.a_ready(cur);
    if constexpr (SP2) {
        PG8_STAGE(PG8_SB(0, 0), cB, voffB); PG8_STAGE(PG8_SB(0, 1), cB + hstep, voffB); PG8_STAGE(PG8_SA(0, 0), cA, voffA); PG8_STAGE(PG8_SA(0, 1), cA + hstep, voffA);
        if (wr == 1) PG8_BAR;
        PG8_WAIT_V(2); PG8_BAR;
        PG8_STAGE(PG8_SB(1, 0), cB + kstep, voffB); PG8_STAGE(PG8_SA(1, 0), cA + kstep, voffA); PG8_STAGE(PG8_SB(1, 1), cB + hstep + kstep, voffB);
        PG8_WAIT_V(6); PG8_BAR;
    } else {
        PG8_STAGE(PG8_SB(0, 0), cB, voffB); PG8_STAGE(PG8_SA(0, 0), cA, voffA); PG8_STAGE(PG8_SB(0, 1), cB + hstep, voffB); PG8_STAGE(PG8_SA(0, 1), cA + hstep, voffA);
        if (wr == 1) PG8_BAR;
        PG8_WAIT_V(4); PG8_BAR;
        PG8_STAGE(PG8_SB(1, 0), cB + kstep, voffB); PG8_STAGE(PG8_SA(1, 0), cA + kstep, voffA); PG8_STAGE(PG8_SB(1, 1), cB + hstep + kstep, voffB);
        PG8_WAIT_V(6); PG8_BAR;
    }
    for (;;) {
        const bool has_next = S.next(ui + 1, nxt);
        const char* nA = has_next ? (const char*)g.A + (size_t)nxt.pm * tstep : cA; const char* nB = has_next ? (const char*)g.Bt + (size_t)nxt.pn * tstep : cB;
        for (int t = 0; t < nt; t += 2) {
            const bool last = (t == nt - 2);
            const char* a1 = cA + (size_t)(t + 1) * kstep;
            const char* a2 = last ? nA : cA + (size_t)(t + 2) * kstep; const char* b2 = last ? nB : cB + (size_t)(t + 2) * kstep;
            const char* a3 = a2 + kstep; const char* b3 = b2 + kstep;
            if (last && has_next) S.a_ready(nxt);
            if constexpr (SP2) {
            PG8_LDB(B0, 0, 0); PG8_LDB(B1, 0, 1); PG8_SCHED; PG8_LDA(At, 0, 0); PG8_STAGE(PG8_SA(1, 1), a1 + hstep, voffA);
            PG8_WAIT_V(8); PG8_WAIT_L(0); PG8_BAR; PG8_MMA(0, 0, At, B0); PG8_MMA(0, 1, At, B1); PG8_BAR; PG8_SCHED;
            PG8_LDA(At, 0, 1); PG8_STAGE(PG8_SB(0, 0), b2, voffB); PG8_STAGE(PG8_SB(0, 1), b2 + hstep, voffB); PG8_STAGE(PG8_SA(0, 0), a2, voffA);
            PG8_WAIT_V(8); PG8_WAIT_L(0); PG8_BAR; PG8_MMA(1, 0, At, B0); PG8_MMA(1, 1, At, B1); PG8_BAR; PG8_SCHED;
            PG8_LDB(B0, 1, 0); PG8_LDB(B1, 1, 1); PG8_SCHED; PG8_LDA(At, 1, 0); PG8_STAGE(PG8_SA(0, 1), a2 + hstep, voffA);
            PG8_WAIT_V(8); PG8_WAIT_L(0); PG8_BAR; PG8_MMA(0, 0, At, B0); PG8_MMA(0, 1, At, B1); PG8_BAR; PG8_SCHED;
            PG8_LDA(At, 1, 1); PG8_STAGE(PG8_SB(1, 0), b3, voffB); PG8_STAGE(PG8_SB(1, 1), b3 + hstep, voffB); PG8_STAGE(PG8_SA(1, 0), a3, voffA);
            PG8_WAIT_V(8); PG8_WAIT_L(0); PG8_BAR; PG8_MMA(1, 0, At, B0); PG8_MMA(1, 1, At, B1); PG8_BAR; PG8_SCHED;
            } else {
            PG8_LDB(B0, 0, 0); PG8_SCHED; PG8_LDA(At, 0, 0); PG8_STAGE(PG8_SA(1, 1), a1 + hstep, voffA);
            PG8_WAIT_L(8); PG8_BAR; PG8_WAIT_L(0); PG8_MMA(0, 0, At, B0); PG8_BAR; PG8_SCHED;
            PG8_LDB(B1, 0, 1); PG8_STAGE(PG8_SB(0, 0), b2, voffB);
            PG8_BAR; PG8_WAIT_L(0); PG8_MMA(0, 1, At, B1); PG8_BAR;
            PG8_LDA(At, 0, 1); PG8_STAGE(PG8_SA(0, 0), a2, voffA);
            PG8_BAR; PG8_WAIT_L(0); PG8_MMA(1, 0, At, B0); PG8_BAR; PG8_SCHED;
            PG8_STAGE(PG8_SB(0, 1), b2 + hstep, voffB);
            PG8_WAIT_V(6); PG8_BAR; PG8_MMA(1, 1, At, B1); PG8_BAR;
            PG8_LDB(B0, 1, 0); PG8_SCHED; PG8_LDA(At, 1, 0); PG8_STAGE(PG8_SA(0, 1), a2 + hstep, voffA);
            PG8_WAIT_L(8); PG8_BAR; PG8_WAIT_L(0); PG8_MMA(0, 0, At, B0); PG8_BAR; PG8_SCHED;
            PG8_LDB(B1, 1, 1); PG8_STAGE(PG8_SB(1, 0), b3, voffB);
            PG8_BAR; PG8_WAIT_L(0); PG8_MMA(0, 1, At, B1); PG8_BAR;
            PG8_LDA(At, 1, 1); PG8_STAGE(PG8_SA(1, 0), a3, voffA);
            PG8_BAR; PG8_WAIT_L(0); PG8_MMA(1, 0, At, B0); PG8_BAR; PG8_SCHED;
            PG8_STAGE(PG8_SB(1, 1), b3 + hstep, voffB);
            PG8_WAIT_V(6); PG8_BAR; PG8_MMA(1, 1, At, B1); PG8_BAR;
            }
        }
        if constexpr (ALIGN_EPI) { if (wr == 0) PG8_BAR; }
        if constexpr (!Epi::AFTER_DRAIN) { E(acc, cur, wr, wc, fr, fq); S.done(cur); }
        if (!has_next) break;
#pragma unroll
        for (int a = 0; a < 2; ++a)
#pragma unroll
            for (int b = 0; b < 2; ++b)
#pragma unroll
                for (int m = 0; m < 4; ++m)
#pragma unroll
                    for (int n = 0; n < 2; ++n) acc[a][b][m][n] = (f32x4){0.f, 0.f, 0.f, 0.f};
        cur = nxt; cA = nA; cB = nB; ++ui;
        if constexpr (ALIGN_EPI) { if (wr == 1) PG8_BAR; }
    }
    PG8_WAIT_V(0);
    if constexpr (!ALIGN_EPI) { if (wr == 0) PG8_BAR; }
    PG8_BAR;
    if constexpr (Epi::AFTER_DRAIN) { E.fused(acc, cur, wr, wc, fr, fq, lds, wid, lane); S.done(cur); }
#undef PG8_SA
#undef PG8_SB
#undef PG8_STAGE
#undef PG8_LDA
#undef PG8_LDB
#undef PG8_MMA
#undef PG8_WAIT_V
#undef PG8_WAIT_L
#undef PG8_BAR
#undef PG8_SCHED
}
}
#ifndef PG8_SP2
#define PG8_SP2 true
#endif
#ifndef PG8_ALIGN
#define PG8_ALIGN true
#endif
constexpr int NWAVES = 8;
constexpr int D = 1024, NB = 4, T = 4096, TC = 256;
constexpr int MX = NB * T, MC = NB * TC, MA = MX + MC;
constexpr int NPROJ = 3456, NPROJ_PAD = 3584;
constexpr int COL_XB = 0, COL_XG = 512, COL_XC = 1024, COL_R = 1536, COL_K = 2048, COL_V = 2560, COL_G = 3072, COL_LW = 3200, COL_LA = 3328;
constexpr int NMOD = 6 * D;
constexpr int NEXP = 16384, NSC = 2048;
constexpr float NORM_EPS = 1e-6f, LNX_EPS = 64e-5f;
#ifndef MK_N_LAUNCHES
#define MK_N_LAUNCHES 1
#endif
constexpr int NPH = 13;
constexpr size_t MiB = 1u << 20;
constexpr size_t WS_CTL = 0, CTL_ZERO_BYTES = 64 * 1024;
constexpr size_t WS_MOD = 3 * MiB;
constexpr size_t WS_WINT = 6 * MiB;
constexpr size_t WS_WOUTT = 13 * MiB;
constexpr size_t WS_WEFFT = 15 * MiB;
constexpr size_t WS_U = 20 * MiB, WS_V = 52 * MiB;
constexpr size_t WS_HX = 84 * MiB;
constexpr size_t WS_PROJ = 118 * MiB;
constexpr size_t WS_END = 246 * MiB;
constexpr size_t WS_EXL = WS_V, WS_GL = WS_V + 4 * MiB, WS_PL = WS_V + 12 * MiB;
constexpr size_t WS_PART = WS_PROJ, WS_PO = WS_PROJ + 64 * MiB;
static_assert(WS_PROJ + (size_t)MA * NPROJ * 2 <= WS_END && WS_PROJ + (size_t)MX * NSC * 4 <= WS_END && WS_HX + (size_t)MA * D * 2 <= WS_PROJ, "d_ws map");
constexpr int CW_BAR = 1024;
constexpr int RING_BYTES = 131072;
constexpr int LDSCTL_OFF = RING_BYTES, MISC_OFF = LDSCTL_OFF + 320;
constexpr int LDS_BYTES = 147456;

#define GAS __attribute__((address_space(1)))
#define LAS __attribute__((address_space(3)))
typedef unsigned short bf16;
typedef unsigned v4u __attribute__((ext_vector_type(4)));
typedef unsigned v2u __attribute__((ext_vector_type(2)));
typedef float f32x4 __attribute__((ext_vector_type(4)));
typedef float f32x2 __attribute__((ext_vector_type(2)));
typedef float f32x16 __attribute__((ext_vector_type(16)));
typedef short bf16x8 __attribute__((ext_vector_type(8)));
typedef GAS unsigned gu32;
#define RLX_AGENT __ATOMIC_RELAXED, __HIP_MEMORY_SCOPE_AGENT
#define LDS_WAIT() asm volatile("s_waitcnt lgkmcnt(0)" ::: "memory")
#define VM_WAIT() asm volatile("s_waitcnt vmcnt(0)" ::: "memory")
__device__ __forceinline__ unsigned pk2(float lo, float hi) { return pg8::cvt_pk_bf16(lo, hi); }
__device__ __forceinline__ float bf_lo(unsigned w) { return __builtin_bit_cast(float, w << 16); }
__device__ __forceinline__ float bf_hi(unsigned w) { return __builtin_bit_cast(float, w & 0xffff0000u); }
__device__ __forceinline__ float bf1(bf16 b) { return __builtin_bit_cast(float, (unsigned)b << 16); }
__device__ __forceinline__ float fast_exp(float x) { return __builtin_amdgcn_exp2f(x * 1.44269504089f); }
__device__ __forceinline__ float fast_rcp(float x) { return __builtin_amdgcn_rcpf(x); }
__device__ __forceinline__ float sigmoidf(float x) { return fast_rcp(1.f + fast_exp(-x)); }
__device__ __forceinline__ float tanh_fast(float x) { return 1.f - 2.f * fast_rcp(fast_exp(2.f * x) + 1.f); }
__device__ __forceinline__ float siluf(float x) { return x * sigmoidf(x); }
template <int CTRL> __device__ __forceinline__ float dppf(float x) { return __builtin_bit_cast(float, __builtin_amdgcn_update_dpp(0, __builtin_bit_cast(int, x), CTRL, 0xF, 0xF, false)); }
template <int CTRL> __device__ __forceinline__ unsigned dppu(unsigned x) { return (unsigned)__builtin_amdgcn_update_dpp(0, (int)x, CTRL, 0xF, 0xF, false); }
__device__ __forceinline__ float rowsum16(float x) { x += dppf<0xB1>(x); x += dppf<0x4E>(x); x += dppf<0x141>(x); x += dppf<0x140>(x); return x; }
__device__ __forceinline__ float wave_sum(float v) {
    v = rowsum16(v); v += __shfl_xor(v, 16); v += __shfl_xor(v, 32); return v;
}
__device__ __forceinline__ float half_sum32(float v) { v = rowsum16(v); v += __shfl_xor(v, 16); return v; }
__device__ __forceinline__ unsigned umaxu(unsigned a, unsigned b) { return a > b ? a : b; }
__device__ __forceinline__ unsigned wave_max_u32(unsigned x) {
    x = umaxu(x, dppu<0xB1>(x)); x = umaxu(x, dppu<0x4E>(x)); x = umaxu(x, dppu<0x141>(x)); x = umaxu(x, dppu<0x140>(x));
    const unsigned a = __builtin_amdgcn_readlane((int)x, 0), b = __builtin_amdgcn_readlane((int)x, 16), c = __builtin_amdgcn_readlane((int)x, 32), d = __builtin_amdgcn_readlane((int)x, 48);
    return umaxu(umaxu(a, b), umaxu(c, d));
}
__device__ __forceinline__ unsigned f2key(float f) { const unsigned u = __builtin_bit_cast(unsigned, f); return (u & 0x80000000u) ? ~u : (u | 0x80000000u); }
__device__ __forceinline__ float key2f(unsigned k) { const unsigned u = (k & 0x80000000u) ? (k ^ 0x80000000u) : ~k; return __builtin_bit_cast(float, u); }
#define XB_TMO      128
#define XB_XCNT(j)  (256  + 64 * (j))
#define XB_XSUB(j)  (1280 + 64 * (j))
#define XB_XGEN(j)  (2304 + 64 * (j))
#define XB_TOP      3328
#define XB_TOPGEN   3392
#define XCD_BAR_WORDS 3456
#define XB_SPIN_CAP (1u << 18)

__device__ __forceinline__ unsigned xb_ld(unsigned* p)              { return __hip_atomic_load(p, __ATOMIC_RELAXED, __HIP_MEMORY_SCOPE_AGENT); }
__device__ __forceinline__ unsigned xb_add(unsigned* p, unsigned v) { return __hip_atomic_fetch_add(p, v, __ATOMIC_RELAXED, __HIP_MEMORY_SCOPE_AGENT); }
__device__ __forceinline__ unsigned xb_xcc_id() { return (unsigned)__builtin_amdgcn_s_getreg((3 << 11) | 20) & 0xFu; }
#define XB_SPIN(cond, bar) do { unsigned _sp = 0; while (cond) { __builtin_amdgcn_s_sleep(1); \
    if ((++_sp & 255u) == 0u) { if (xb_ld(&(bar)[XB_TMO])) break; if (_sp > XB_SPIN_CAP) { atomicAdd(&(bar)[XB_TMO], 1u); break; } } } } while (0)

struct XcdBarrier {
    unsigned* bar; unsigned x;
    volatile LAS unsigned* st;
};

__device__ __forceinline__ XcdBarrier xcd_barrier_post(unsigned* bar, volatile LAS unsigned* st) {
    XcdBarrier b; b.bar = bar; b.x = xb_xcc_id(); b.st = st;
    if (threadIdx.x == 0) (void)xb_add(&bar[XB_XCNT(b.x)], 1u);
    return b;
}
__device__ __forceinline__ void xcd_barrier_complete(unsigned* bar, unsigned x, unsigned& nloc, unsigned& nx) {
    const unsigned G = gridDim.x * gridDim.y * gridDim.z;
    unsigned sum, cnt, mine, sp = 0u;
    for (;;) {
        sum = 0u; cnt = 0u; mine = 0u;
#pragma unroll
        for (unsigned j = 0; j < 16; ++j) { const unsigned c = xb_ld(&bar[XB_XCNT(j)]); sum += c; cnt += (c > 0u) ? 1u : 0u; mine = (j == x) ? c : mine; }
        if (sum == G) break;
        __builtin_amdgcn_s_sleep(1);
        if ((++sp & 255u) == 0u) { if (xb_ld(&bar[XB_TMO])) break; if (sp > XB_SPIN_CAP) { atomicAdd(&bar[XB_TMO], 1u); break; } }
    }
    nloc = mine > 0u ? mine : 1u; nx = cnt > 0u ? cnt : 1u;
}

__device__ __forceinline__ void xcd_barrier(const XcdBarrier& b) {
    asm volatile("s_waitcnt vmcnt(0)" ::: "memory");
    __syncthreads();
    if (threadIdx.x == 0) {
        unsigned* bar = b.bar;
        __builtin_amdgcn_s_waitcnt(0);
        unsigned nloc = b.st[0], nx = b.st[1];
        if (nloc == 0u) { xcd_barrier_complete(bar, b.x, nloc, nx); b.st[0] = nloc; b.st[1] = nx; }
        const unsigned old = xb_add(&bar[XB_XSUB(b.x)], 1u);
        const unsigned gen = old / nloc;
        if (old + 1u == (gen + 1u) * nloc) {
            __builtin_amdgcn_fence(__ATOMIC_RELEASE, "agent");
            asm volatile("s_waitcnt vmcnt(0)" ::: "memory");
            const unsigned og = xb_add(&bar[XB_TOP], 1u);
            const unsigned tg = og / nx;
            if (og + 1u == (tg + 1u) * nx) xb_add(&bar[XB_TOPGEN], 1u);
            else XB_SPIN(xb_ld(&bar[XB_TOPGEN]) == tg, bar);
            __builtin_amdgcn_fence(__ATOMIC_ACQUIRE, "agent");
            xb_add(&bar[XB_XGEN(b.x)], 1u);
            asm volatile("s_waitcnt vmcnt(0)" ::: "memory");
        } else {
            XB_SPIN(xb_ld(&bar[XB_XGEN(b.x)]) == gen, bar);
            __builtin_amdgcn_fence(__ATOMIC_ACQUIRE, "agent");
            asm volatile("s_waitcnt vmcnt(0)" ::: "memory");
        }
    }
    __syncthreads();
}
struct Frame {
    LAS unsigned char* lds;
    volatile LAS unsigned* MISC;
    gu32* ctl;
    int tid, lane, wave, G, bid;
    const float* in[25];
    float* out;
    unsigned char* ws;
};
enum { I_X = 0, I_C, I_CTX, I_CCTX, I_WMOD, I_BMOD, I_NG, I_WIN, I_WOUT, I_CONVW, I_TMU, I_DW0, I_DW2, I_A0, I_A2, I_GW2, I_KK, I_KA, I_RK, I_LNG, I_LNB, I_WQ, I_SUBK, I_PU, I_PV };

__device__ __forceinline__ void p0_transpose_item(const float* W, int K, int N, bf16* WT, LAS float* scr, int item, int lane) {
    const int nblk = N / 32, kb = item / nblk, nb = item % nblk, k0 = 64 * kb, n0 = 32 * nb;
#pragma unroll 8
    for (int i = 0; i < 32; ++i) { const int kk = 2 * i + (lane >> 5); scr[kk * 33 + (lane & 31)] = W[(size_t)(k0 + kk) * N + n0 + (lane & 31)]; }
    LDS_WAIT(); asm volatile("" ::: "memory");
    const int c = lane & 7;
#pragma unroll
    for (int j = 0; j < 4; ++j) { const int n = (lane >> 3) + 8 * j; const LAS float* s = scr + (8 * c) * 33 + n;
        v4u o; o.x = pk2(s[0 * 33], s[1 * 33]); o.y = pk2(s[2 * 33], s[3 * 33]); o.z = pk2(s[4 * 33], s[5 * 33]); o.w = pk2(s[6 * 33], s[7 * 33]);
        *(v4u*)(WT + (size_t)(n0 + n) * K + k0 + 8 * c) = o; }
    LDS_WAIT(); asm volatile("" ::: "memory");
}
__device__ __forceinline__ void p0_mod_item(Frame& F, int cb) {
    LAS float* S = (LAS float*)F.lds;
    LAS float* RED = (LAS float*)(F.lds + 32768);
    const float* c = F.in[I_C]; const float* cc = F.in[I_CCTX];
    for (int i = F.tid; i < 5 * D; i += 512) { const int r = i >> 10, k = i & 1023; const float v = (r < 4) ? c[r * D + k] : cc[k]; S[i] = siluf(v); }
    __syncthreads();
    const int col = F.tid & 63, kg = F.tid >> 6;
    const float* wp = F.in[I_WMOD] + (size_t)(kg * 128) * NMOD + cb * 64 + col;
    float a0 = 0.f, a1 = 0.f, a2 = 0.f, a3 = 0.f, a4 = 0.f;
#pragma unroll 8
    for (int k = 0; k < 128; ++k) { const float w = wp[(size_t)k * NMOD]; const int kk = kg * 128 + k;
        a0 += S[kk] * w; a1 += S[D + kk] * w; a2 += S[2 * D + kk] * w; a3 += S[3 * D + kk] * w; a4 += S[4 * D + kk] * w; }
    RED[(kg * 5 + 0) * 64 + col] = a0; RED[(kg * 5 + 1) * 64 + col] = a1; RED[(kg * 5 + 2) * 64 + col] = a2; RED[(kg * 5 + 3) * 64 + col] = a3; RED[(kg * 5 + 4) * 64 + col] = a4;
    __syncthreads();
    if (F.tid < 320) { const int r = F.tid >> 6, cl = F.tid & 63; float s = F.in[I_BMOD][cb * 64 + cl];
#pragma unroll
        for (int g = 0; g < 8; ++g) s += RED[(g * 5 + r) * 64 + cl];
        ((float*)(F.ws + WS_MOD))[r * NMOD + cb * 64 + cl] = s; }
    __syncthreads();
}
__device__ __forceinline__ void p0_weff_item(Frame& F, int item) {
    const int hs = item >> 4, kb = item & 15;
    LAS float* SK = (LAS float*)F.lds;
    LAS float* WQ = (LAS float*)(F.lds + 128 * 132 * 4);
    const float* sk = F.in[I_SUBK] + (size_t)hs * 128 * 128;
    const float* wq = F.in[I_WQ] + (size_t)(kb * 64) * 2048 + hs * 128;
#pragma unroll
    for (int i = 0; i < 8; ++i) { const int idx = F.tid + 512 * i, row = idx >> 5, c4 = idx & 31; const f32x4 v = *(const f32x4*)(sk + row * 128 + c4 * 4); *(LAS f32x4*)(SK + row * 132 + c4 * 4) = v; }
#pragma unroll
    for (int i = 0; i < 4; ++i) { const int idx = F.tid + 512 * i, row = idx >> 5, c4 = idx & 31; const f32x4 v = *(const f32x4*)(wq + (size_t)row * 2048 + c4 * 4); *(LAS f32x4*)(WQ + row * 132 + c4 * 4) = v; }
    __syncthreads();
    const int key = F.tid >> 2, kq = F.tid & 3;
    float acc[16];
#pragma unroll
    for (int i = 0; i < 16; ++i) acc[i] = 0.f;
    for (int d = 0; d < 128; d += 4) {
        const f32x4 a = *(const LAS f32x4*)(SK + key * 132 + d);
#pragma unroll
        for (int i = 0; i < 16; ++i) { const f32x4 b = *(const LAS f32x4*)(WQ + (4 * i + kq) * 132 + d); acc[i] += a.x * b.x + a.y * b.y + a.z * b.z + a.w * b.w; }
    }
    bf16* dst = (bf16*)(F.ws + WS_WEFFT) + (size_t)(hs * 128 + key) * D + kb * 64;
#pragma unroll
    for (int i = 0; i < 16; ++i) dst[4 * i + kq] = (bf16)(pk2(acc[i], 0.f) & 0xffffu);
    __syncthreads();
}
__device__ __forceinline__ void p0_prep(Frame& F) {
    for (int it = F.bid; it < 96 + 256; it += F.G) { if (it < 96) p0_mod_item(F, it); else p0_weff_item(F, it - 96); }
    LAS float* scr = (LAS float*)(F.lds + F.wave * 16384);
    const int gw = F.bid * NWAVES + F.wave, NGW = F.G * NWAVES;
    constexpr int I_IN = (D / 64) * (NPROJ / 32), I_OUT = (D / 64) * (D / 32);
    for (int it = gw; it < I_IN + I_OUT; it += NGW) {
        if (it < I_IN) p0_transpose_item(F.in[I_WIN], D, NPROJ, (bf16*)(F.ws + WS_WINT), scr, it, F.lane);
        else p0_transpose_item(F.in[I_WOUT], D, D, (bf16*)(F.ws + WS_WOUTT), scr, it - I_IN, F.lane);
    }
    { v4u* z = (v4u*)((bf16*)(F.ws + WS_WINT) + (size_t)NPROJ * D); const int n16 = (NPROJ_PAD - NPROJ) * D * 2 / 16;
      for (int i = F.bid * 512 + F.tid; i < n16; i += F.G * 512) z[i] = (v4u){0u, 0u, 0u, 0u}; }
    { const f32x4* pu = (const f32x4*)F.in[I_PU]; v4u* du = (v4u*)(F.ws + WS_U);
      const int n8 = NEXP * D / 8;
      for (int i = F.bid * 512 + F.tid; i < n8; i += F.G * 512) {
          const f32x4 a0 = pu[2 * i], a1 = pu[2 * i + 1];
          du[i] = (v4u){pk2(a0.x, a0.y), pk2(a0.z, a0.w), pk2(a1.x, a1.y), pk2(a1.z, a1.w)}; } }
}

__device__ __forceinline__ void p1_hx(Frame& F) {
    const float* mod = (const float*)(F.ws + WS_MOD); const float* ng = F.in[I_NG];
    bf16* hx = (bf16*)(F.ws + WS_HX);
    for (int m = F.bid * NWAVES + F.wave; m < MA; m += F.G * NWAVES) {
        const float* src = (m < MX) ? F.in[I_X] + (size_t)m * D : F.in[I_CTX] + (size_t)(m - MX) * D;
        const float* mr = mod + ((m < MX) ? (m >> 12) : 4) * NMOD;
        f32x4 v[4]; float ss = 0.f;
#pragma unroll
        for (int j = 0; j < 4; ++j) { v[j] = *(const f32x4*)(src + j * 256 + F.lane * 4); ss += v[j].x * v[j].x + v[j].y * v[j].y + v[j].z * v[j].z + v[j].w * v[j].w; }
        const float rstd = __builtin_amdgcn_rsqf(wave_sum(ss) * (1.f / D) + NORM_EPS);
#pragma unroll
        for (int j = 0; j < 4; ++j) { const int c = j * 256 + F.lane * 4;
            const f32x4 g = *(const f32x4*)(ng + c), sh = *(const f32x4*)(mr + c), sc = *(const f32x4*)(mr + D + c);
            const float o0 = v[j].x * rstd * g.x * (1.f + sc.x) + sh.x, o1 = v[j].y * rstd * g.y * (1.f + sc.y) + sh.y, o2 = v[j].z * rstd * g.z * (1.f + sc.z) + sh.z, o3 = v[j].w * rstd * g.w * (1.f + sc.w) + sh.w;
            *(v2u*)(hx + (size_t)m * D + c) = (v2u){pk2(o0, o1), pk2(o2, o3)}; }
    }
}
constexpr int SC_W = 0, SC_KK = 8192, SC_KKA = 16384, SC_KD = 24576, SC_R = 32768, SC_V = 40960, SC_Y = 43008, SC_RAW = 45056, SC_TLW = 58368, SC_LOA = 62976,
              SC_W2T = 67584, SC_A2T = 76800, SC_LG = 86016, SC_CONST = 102400, SC_END = 104960;
constexpr int SC_NTILE = (TC + T) / 32;
__device__ __forceinline__ void scan_issue_loads(const bf16* proj, int b, int h, int d, int tile, int tid, v4u (&rg)[3]) {
    const bool isctx = tile < TC / 32; const int L = isctx ? TC : T; const int jt = isctx ? tile : tile - TC / 32;
    const size_t rowbase = isctx ? (size_t)(MX + b * TC) : (size_t)b * T;
    const int tlo = d == 0 ? 32 * jt : L - 32 * (jt + 1);
#pragma unroll
    for (int i = 0; i < 3; ++i) {
        const int q = tid + 512 * i; v4u val = (v4u){0u, 0u, 0u, 0u};
        if (q < 816) { const int row = q / 24, rem = q - row * 24, which = rem >> 3, ch8 = rem & 7; const int tok = tlo - 1 + row;
            if (tok >= 0 && tok < L) val = *(const v4u*)(proj + (rowbase + tok) * NPROJ + COL_R + which * 512 + h * 64 + ch8 * 8); }
        else if (q < 1328) { const int q2 = q - 816, row = q2 >> 4, rem = q2 & 15, which = rem >> 3, ch8 = rem & 7; const int tok = tlo + row;
            val = *(const v4u*)(proj + (rowbase + tok) * NPROJ + (which ? COL_LA : COL_LW) + d * 64 + ch8 * 8); }
        rg[i] = val;
    }
}
__device__ __forceinline__ unsigned tanh_pk(unsigned w) { return pk2(tanh_fast(bf_lo(w)), tanh_fast(bf_hi(w))); }
__device__ __forceinline__ void scan_store_raw(LAS unsigned char* lds, int tid, const v4u (&rg)[3]) {
#pragma unroll
    for (int i = 0; i < 3; ++i) {
        const int q = tid + 512 * i;
        if (q < 816) { const int row = q / 24, rem = q - row * 24, which = rem >> 3, ch8 = rem & 7; *(LAS v4u*)(lds + SC_RAW + (which * 34 + row) * 128 + ch8 * 16) = rg[i]; }
        else if (q < 1328) { const int q2 = q - 816, row = q2 >> 4, rem = q2 & 15, which = rem >> 3, ch8 = rem & 7;
            if (which) *(LAS v4u*)(lds + SC_LOA + row * 144 + ch8 * 16) = rg[i];
            else { v4u t; t.x = tanh_pk(rg[i].x); t.y = tanh_pk(rg[i].y); t.z = tanh_pk(rg[i].z); t.w = tanh_pk(rg[i].w); *(LAS v4u*)(lds + SC_TLW + row * 144 + ch8 * 16) = t; } }
    }
}
template <bool NOSTEPS> __device__ __forceinline__ void p3_scan(Frame& F) {
    LAS unsigned char* lds = F.lds; const int tid = F.tid, lane = F.lane, wave = F.wave;
    const bf16* proj = (const bf16*)(F.ws + WS_PROJ);
    float* yscr = F.out;
    for (int unit = F.bid; unit < 256; unit += F.G) {
        const int chain = unit >> 2, rgp = unit & 3, b = chain >> 4, h = (chain >> 1) & 7, d = chain & 1;
        __syncthreads();
        { LAS float* C = (LAS float*)(lds + SC_CONST);
          if (tid < 384) { const int pn = tid / 192, r = tid - pn * 192, which = r >> 6, c = r & 63; C[pn * 192 + which * 64 + c] = F.in[I_TMU][(pn * 3 + which) * 512 + h * 64 + c]; }
          else if (tid < 448) { const int c = tid - 384; C[384 + c] = F.in[I_KK][h * 64 + c]; C[448 + c] = F.in[I_KA][h * 64 + c]; }
          else { const int c = tid - 448; C[512 + c] = F.in[I_DW0][d * 512 + h * 64 + c]; C[576 + c] = F.in[I_A0][d * 512 + h * 64 + c]; }
          const float* w2 = F.in[I_DW2] + (size_t)d * 64 * 512 + h * 64; const float* a2 = F.in[I_A2] + (size_t)d * 64 * 512 + h * 64;
#pragma unroll
          for (int i = 0; i < 8; ++i) { const int idx = tid + 512 * i, j = idx >> 6, c = idx & 63;
              *(LAS bf16*)(lds + SC_W2T + c * 144 + j * 2) = (bf16)(pk2(w2[j * 512 + c], 0.f) & 0xffffu);
              *(LAS bf16*)(lds + SC_A2T + c * 144 + j * 2) = (bf16)(pk2(a2[j * 512 + c], 0.f) & 0xffffu); } }
        f32x4 st = (f32x4){0.f, 0.f, 0.f, 0.f};
        v4u rg[3];
        scan_issue_loads(proj, b, h, d, 0, tid, rg);
        for (int tile = 0; tile < SC_NTILE; ++tile) {
            const bool isctx = tile < TC / 32; const int L = isctx ? TC : T; const int jt = isctx ? tile : tile - TC / 32;
            const int tlo = d == 0 ? 32 * jt : L - 32 * (jt + 1);
            scan_store_raw(lds, tid, rg);
            __syncthreads();
            if (tile + 1 < SC_NTILE) scan_issue_loads(proj, b, h, d, tile + 1, tid, rg);
            if (wave < 4) {
                const int mat = wave >> 1, nt = wave & 1, r = lane & 31, hh = lane >> 5;
                const LAS unsigned char* Ab = lds + (mat ? SC_LOA : SC_TLW) + r * 144 + hh * 16;
                const LAS unsigned char* Bb = lds + (mat ? SC_A2T : SC_W2T) + (nt * 32 + r) * 144 + hh * 16;
                f32x16 acc;
#pragma unroll
                for (int i = 0; i < 16; ++i) acc[i] = 0.f;
#pragma unroll
                for (int ks = 0; ks < 4; ++ks) { const bf16x8 a = *(const LAS bf16x8*)(Ab + ks * 32), bb = *(const LAS bf16x8*)(Bb + ks * 32); acc = __builtin_amdgcn_mfma_f32_32x32x16_bf16(a, bb, acc, 0, 0, 0); }
                LAS float* LG = (LAS float*)(lds + SC_LG) + mat * 2048 + nt * 32 + r;
#pragma unroll
                for (int i = 0; i < 16; ++i) LG[((i & 3) + 8 * (i >> 2) + 4 * hh) * 64] = acc[i];
            }
            __syncthreads();
            { const int tok = tid >> 4, cq = tid & 15, c0 = cq * 4;
              const LAS float* C = (const LAS float*)(lds + SC_CONST);
              f32x4 xs[3];
#pragma unroll
              for (int which = 0; which < 3; ++which) {
                  const LAS unsigned char* rp = lds + SC_RAW + (which * 34 + tok) * 128 + c0 * 2;
                  const v2u p = *(const LAS v2u*)rp, x = *(const LAS v2u*)(rp + 128), n = *(const LAS v2u*)(rp + 256);
                  const f32x4 mp = *(const LAS f32x4*)(C + which * 64 + c0), mn = *(const LAS f32x4*)(C + 192 + which * 64 + c0);
                  const f32x4 xp = (f32x4){bf_lo(p.x), bf_hi(p.x), bf_lo(p.y), bf_hi(p.y)}, xc = (f32x4){bf_lo(x.x), bf_hi(x.x), bf_lo(x.y), bf_hi(x.y)}, xn = (f32x4){bf_lo(n.x), bf_hi(n.x), bf_lo(n.y), bf_hi(n.y)};
                  xs[which] = xc + mp * (xp - xc) + mn * (xn - xc); }
              const f32x4 kkc = *(const LAS f32x4*)(C + 384 + c0), kac = *(const LAS f32x4*)(C + 448 + c0), w0 = *(const LAS f32x4*)(C + 512 + c0), a0 = *(const LAS f32x4*)(C + 576 + c0);
              f32x4 kk = xs[1] * kkc;
              const float ss = rowsum16(kk.x * kk.x + kk.y * kk.y + kk.z * kk.z + kk.w * kk.w);
              kk = kk * __builtin_amdgcn_rsqf(ss + 1e-12f);
              const f32x4 uw = *(const LAS f32x4*)(lds + SC_LG + (tok * 64 + c0) * 4) + w0, ua = *(const LAS f32x4*)(lds + SC_LG + 8192 + (tok * 64 + c0) * 4) + a0;
              f32x4 dec, av;
#pragma unroll
              for (int e = 0; e < 4; ++e) { dec[e] = fast_exp(-0.60653066f * sigmoidf(uw[e])); av[e] = sigmoidf(ua[e]); }
              const f32x4 kd = xs[1] * (1.f + (av - 1.f) * kac), kka = kk * av;
              const int s = d == 0 ? tok : 31 - tok;
              *(LAS f32x4*)(lds + SC_W + (s * 64 + c0) * 4) = dec; *(LAS f32x4*)(lds + SC_KK + (s * 64 + c0) * 4) = kk; *(LAS f32x4*)(lds + SC_KKA + (s * 64 + c0) * 4) = kka;
              *(LAS f32x4*)(lds + SC_KD + (s * 64 + c0) * 4) = kd; *(LAS f32x4*)(lds + SC_R + (s * 64 + c0) * 4) = xs[0];
              if ((cq >> 2) == rgp) *(LAS f32x4*)(lds + SC_V + (s * 16 + (cq & 3) * 4) * 4) = xs[2]; }
            __syncthreads();
            if (!NOSTEPS && wave < 4) {
                const int q = lane & 15, row = wave * 4 + (lane >> 4);
                const LAS unsigned char* op = lds + q * 16; const LAS unsigned char* vp = lds + SC_V + row * 4;
                f32x4 w = *(const LAS f32x4*)(op + SC_W), kk = *(const LAS f32x4*)(op + SC_KK), kka = *(const LAS f32x4*)(op + SC_KKA), kd = *(const LAS f32x4*)(op + SC_KD), r = *(const LAS f32x4*)(op + SC_R);
                float v = *(const LAS float*)vp;
                float yk = 0.f;
#pragma unroll
                for (int s = 0; s < 32; ++s) {
                    f32x4 w2 = w, kk2 = kk, kka2 = kka, kd2 = kd, r2 = r; float v2 = v;
                    if (s < 31) { w2 = *(const LAS f32x4*)(op + SC_W + (s + 1) * 256); kk2 = *(const LAS f32x4*)(op + SC_KK + (s + 1) * 256); kka2 = *(const LAS f32x4*)(op + SC_KKA + (s + 1) * 256);
                        kd2 = *(const LAS f32x4*)(op + SC_KD + (s + 1) * 256); r2 = *(const LAS f32x4*)(op + SC_R + (s + 1) * 256); v2 = *(const LAS float*)(vp + (s + 1) * 64); }
                    const float sa = rowsum16((st.x * kk.x + st.y * kk.y) + (st.z * kk.z + st.w * kk.w));
                    st = st * w + v * kd - sa * kka;
                    const float y = rowsum16((st.x * r.x + st.y * r.y) + (st.z * r.z + st.w * r.w));
                    yk = (q == (s & 15)) ? y : yk;
                    if ((s & 15) == 15) *(LAS float*)(lds + SC_Y + (((s - 15) + q) * 16 + row) * 4) = yk;
                    w = w2; kk = kk2; kka = kka2; kd = kd2; r = r2; v = v2;
                }
            }
            __syncthreads();
            if (!isctx && tid < 128) { const int s = tid >> 2, part = tid & 3; const int tok = d == 0 ? tlo + s : tlo + 31 - s;
                *(f32x4*)(yscr + ((size_t)(b * T + tok)) * D + d * 512 + h * 64 + rgp * 16 + part * 4) = *(const LAS f32x4*)(lds + SC_Y + (s * 16 + part * 4) * 4); }
        }
    }
}
__device__ __forceinline__ void p4_mix(Frame& F) {
    LAS unsigned char* lds = F.lds; const int tid = F.tid;
    const bf16* proj = (const bf16*)(F.ws + WS_PROJ); bf16* cat = (bf16*)(F.ws + WS_HX); const float* yscr = F.out;
    LAS float* SG = (LAS float*)lds;
    LAS bf16* GT = (LAS bf16*)(lds + 32768);
    for (int unit = F.bid; unit < MX / 64; unit += F.G) {
        const size_t row0 = (size_t)unit * 64; const int tb0 = (unit * 64) & (T - 1);
        __syncthreads();
#pragma unroll
        for (int i = 0; i < 2; ++i) { const int ck = tid + 512 * i, tok = ck >> 4, j0 = (ck & 15) * 8;
            const v4u w = *(const v4u*)(proj + (row0 + tok) * NPROJ + COL_G + j0);
            SG[(j0 + 0) * 64 + tok] = sigmoidf(bf_lo(w.x)); SG[(j0 + 1) * 64 + tok] = sigmoidf(bf_hi(w.x)); SG[(j0 + 2) * 64 + tok] = sigmoidf(bf_lo(w.y)); SG[(j0 + 3) * 64 + tok] = sigmoidf(bf_hi(w.y));
            SG[(j0 + 4) * 64 + tok] = sigmoidf(bf_lo(w.z)); SG[(j0 + 5) * 64 + tok] = sigmoidf(bf_hi(w.z)); SG[(j0 + 6) * 64 + tok] = sigmoidf(bf_lo(w.w)); SG[(j0 + 7) * 64 + tok] = sigmoidf(bf_hi(w.w)); }
        __syncthreads();
        { float acc[64];
#pragma unroll
          for (int i = 0; i < 64; ++i) acc[i] = 0.f;
          const float* gw = F.in[I_GW2] + tid;
#pragma unroll 2
          for (int j = 0; j < 128; ++j) { const float wv = gw[j * 512];
#pragma unroll
              for (int tq = 0; tq < 16; ++tq) { const f32x4 s4 = *(const LAS f32x4*)(SG + j * 64 + tq * 4);
                  acc[4 * tq] += s4.x * wv; acc[4 * tq + 1] += s4.y * wv; acc[4 * tq + 2] += s4.z * wv; acc[4 * tq + 3] += s4.w * wv; } }
#pragma unroll
          for (int i = 0; i < 64; ++i) GT[i * 512 + tid] = (bf16)(pk2(acc[i], 0.f) & 0xffffu); }
        __syncthreads();
        if (tid < 256) {
            const int c = 2 * tid; const float* cw = F.in[I_CONVW];
            const f32x2 w0 = *(const f32x2*)(cw + c), w1 = *(const f32x2*)(cw + 512 + c), w2 = *(const f32x2*)(cw + 1024 + c);
            const bf16* pr = proj + row0 * NPROJ + c;
            f32x2 zp = (f32x2){0.f, 0.f}, zc, zn;
            { const unsigned g = *(const unsigned*)(pr + COL_XG), x = *(const unsigned*)(pr + COL_XC); zc = (f32x2){bf_lo(g) * bf_lo(x), bf_hi(g) * bf_hi(x)}; }
            for (int t = 0; t < 64; ++t) {
                if (t < 63) { const unsigned g = *(const unsigned*)(pr + (size_t)(t + 1) * NPROJ + COL_XG), x = *(const unsigned*)(pr + (size_t)(t + 1) * NPROJ + COL_XC); zn = (f32x2){bf_lo(g) * bf_lo(x), bf_hi(g) * bf_hi(x)}; }
                else zn = (f32x2){0.f, 0.f};
                const unsigned xb = *(const unsigned*)(pr + (size_t)t * NPROJ + COL_XB);
                const f32x2 z = w0 * zp + w1 * zc + w2 * zn;
                *(unsigned*)(cat + (row0 + t) * D + c) = pk2(bf_lo(xb) * z.x, bf_hi(xb) * z.y);
                zp = zc; zc = zn;
            }
        } else {
            const int ri = tid - 256, c = 2 * ri, h = ri >> 5;
            const f32x2 mpr = *(const f32x2*)(F.in[I_TMU] + 0 * 512 + c), mpk = *(const f32x2*)(F.in[I_TMU] + 1 * 512 + c), mpv = *(const f32x2*)(F.in[I_TMU] + 2 * 512 + c);
            const f32x2 mnr = *(const f32x2*)(F.in[I_TMU] + 3 * 512 + c), mnk = *(const f32x2*)(F.in[I_TMU] + 4 * 512 + c), mnv = *(const f32x2*)(F.in[I_TMU] + 5 * 512 + c);
            const f32x2 rk = *(const f32x2*)(F.in[I_RK] + c), lg = *(const f32x2*)(F.in[I_LNG] + c), lb = *(const f32x2*)(F.in[I_LNB] + c);
            const bf16* pr = proj + row0 * NPROJ + c;
            f32x2 rp, kp, vp, rc, kc, vc, rn, kn, vn;
#define LD2(dst, ptr) do { const unsigned _w = *(const unsigned*)(ptr); dst = (f32x2){bf_lo(_w), bf_hi(_w)}; } while (0)
            if (tb0 > 0) { LD2(rp, pr - NPROJ + COL_R); LD2(kp, pr - NPROJ + COL_K); LD2(vp, pr - NPROJ + COL_V); } else { rp = kp = vp = (f32x2){0.f, 0.f}; }
            LD2(rc, pr + COL_R); LD2(kc, pr + COL_K); LD2(vc, pr + COL_V);
            for (int t = 0; t < 64; ++t) {
                if (tb0 + t + 1 < T) { const bf16* pn = pr + (size_t)(t + 1) * NPROJ; LD2(rn, pn + COL_R); LD2(kn, pn + COL_K); LD2(vn, pn + COL_V); } else { rn = kn = vn = (f32x2){0.f, 0.f}; }
                const f32x2 rs = rc + mpr * (rp - rc) + mnr * (rn - rc), ks = kc + mpk * (kp - kc) + mnk * (kn - kc), vs = vc + mpv * (vp - vc) + mnv * (vn - vc);
                const float* yr = yscr + (row0 + t) * D + c;
                const f32x2 y = *(const f32x2*)yr + *(const f32x2*)(yr + 512);
                const float mu = half_sum32(y.x + y.y) * (1.f / 64.f);
                const f32x2 yc = y - mu;
                const float var = half_sum32(yc.x * yc.x + yc.y * yc.y) * (1.f / 64.f);
                const float bon = half_sum32(rs.x * ks.x * rk.x + rs.y * ks.y * rk.y);
                const f32x2 yn = yc * __builtin_amdgcn_rsqf(var + LNX_EPS) * lg + lb + bon * vs;
                const unsigned gt = *(const LAS unsigned*)(GT + t * 512 + c);
                *(unsigned*)(cat + (row0 + t) * D + 512 + c) = pk2(yn.x * bf_lo(gt), yn.y * bf_hi(gt));
                rp = rc; kp = kc; vp = vc; rc = rn; kc = kn; vc = vn;
            }
#undef LD2
        }
    }
}

__device__ __forceinline__ void p6_mid(Frame& F) {
    const float* mod = (const float*)(F.ws + WS_MOD); const float* ng = F.in[I_NG];
    const float* yx = (const float*)(F.ws + WS_PROJ); bf16* hx2 = (bf16*)(F.ws + WS_HX);
    for (int m = F.bid * NWAVES + F.wave; m < MX; m += F.G * NWAVES) {
        const float* mr = mod + (m >> 12) * NMOD;
        f32x4 v[4], xv[4]; float ss = 0.f;
#pragma unroll
        for (int j = 0; j < 4; ++j) { v[j] = *(const f32x4*)(yx + (size_t)m * D + j * 256 + F.lane * 4); xv[j] = *(const f32x4*)(F.in[I_X] + (size_t)m * D + j * 256 + F.lane * 4);
            ss += v[j].x * v[j].x + v[j].y * v[j].y + v[j].z * v[j].z + v[j].w * v[j].w; }
        const float rstd = __builtin_amdgcn_rsqf(wave_sum(ss) * (1.f / D) + NORM_EPS);
        float ss2 = 0.f;
#pragma unroll
        for (int j = 0; j < 4; ++j) { const int c = j * 256 + F.lane * 4;
            const f32x4 g1 = *(const f32x4*)(ng + D + c), gt = *(const f32x4*)(mr + 2 * D + c);
            xv[j] = xv[j] + gt * (v[j] * rstd * g1);
            *(f32x4*)(F.out + (size_t)m * D + c) = xv[j];
            ss2 += xv[j].x * xv[j].x + xv[j].y * xv[j].y + xv[j].z * xv[j].z + xv[j].w * xv[j].w; }
        const float rstd2 = __builtin_amdgcn_rsqf(wave_sum(ss2) * (1.f / D) + NORM_EPS);
#pragma unroll
        for (int j = 0; j < 4; ++j) { const int c = j * 256 + F.lane * 4;
            const f32x4 g2 = *(const f32x4*)(ng + 2 * D + c), sh = *(const f32x4*)(mr + 3 * D + c), sc = *(const f32x4*)(mr + 4 * D + c);
            const f32x4 o = xv[j] * rstd2 * g2 * (1.f + sc) + sh;
            *(v2u*)(hx2 + (size_t)m * D + c) = (v2u){pk2(o.x, o.y), pk2(o.z, o.w)}; }
    }
}
__device__ __forceinline__ float gelu_erf(float x) { return 0.5f * x * (1.f + erff(x * 0.70710678118f)); }
__device__ __forceinline__ float dot2bf(unsigned a, unsigned b, float c) {
    typedef __bf16 bf2 __attribute__((ext_vector_type(2)));
    return __builtin_amdgcn_fdot2_f32_bf16(__builtin_bit_cast(bf2, a), __builtin_bit_cast(bf2, b), c, false);
}
__device__ __forceinline__ void p8a_route(Frame& F) {
    const int lane = F.lane, wave = F.wave;
    LAS int* EX = (LAS int*)(F.lds + wave * 2048);
    LAS float* GG = (LAS float*)(F.lds + wave * 2048 + 512);
    const float* scores = (const float*)(F.ws + WS_PROJ);
    unsigned* exl32 = (unsigned*)(F.ws + WS_EXL); f32x2* gl2 = (f32x2*)(F.ws + WS_GL);
    int ci = 0, cj = 0; { int l = lane, i = 0; for (; i < 16; ++i) { const int n = 16 / (i + 1); if (l < n) break; l -= n; } ci = i < 16 ? i : 0; cj = i < 16 ? l : 0; }
    const bool cvalid = lane < 50;
    for (int m = F.bid * NWAVES + wave; m < MX; m += F.G * NWAVES) {
        const float* srow = scores + (size_t)m * NSC;
        for (int h = 0; h < 8; ++h) {
            unsigned res[2];
#pragma unroll
            for (int s = 0; s < 2; ++s) {
                const float* lp = srow + (h * 2 + s) * 128;
                unsigned k0 = (f2key(lp[lane]) & ~127u) | (unsigned)(127 - lane), k1 = (f2key(lp[64 + lane]) & ~127u) | (unsigned)(63 - lane);
                unsigned r = 0u;
                for (int it = 0; it < 16; ++it) { const unsigned mx = wave_max_u32(umaxu(k0, k1)); r = (lane == it) ? mx : r; k0 = (k0 == mx) ? 0u : k0; k1 = (k1 == mx) ? 0u : k1; }
                res[s] = r;
            }
            const unsigned ka = (unsigned)__shfl((int)res[0], ci), kb = (unsigned)__shfl((int)res[1], cj);
            const float sum = key2f(ka & ~127u) + key2f(kb & ~127u);
            unsigned ck = cvalid ? ((f2key(sum) & ~63u) | (unsigned)(63 - lane)) : 0u;
            unsigned win = 0u;
            for (int it = 0; it < 16; ++it) { const unsigned mx = wave_max_u32(ck); win = (lane == it) ? mx : win; ck = (ck == mx) ? 0u : ck; }
            const int wl = 63 - (int)(win & 63u);
            const int wi = __shfl(ci, wl), wj = __shfl(cj, wl);
            const int idx0 = 127 - (int)((unsigned)__shfl((int)res[0], wi) & 127u), idx1 = 127 - (int)((unsigned)__shfl((int)res[1], wj) & 127u);
            const float scv = key2f(win & ~63u);
            const float smax = __shfl(scv, 0);
            const float e = (lane < 16) ? fast_exp(scv - smax) : 0.f;
            const float den = rowsum16(e);
            if (lane < 16) { EX[h * 16 + lane] = idx0 * 128 + idx1; GG[h * 16 + lane] = e * fast_rcp(den); }
        }
        LDS_WAIT();
        exl32[(size_t)m * 64 + lane] = (unsigned)EX[2 * lane] | ((unsigned)EX[2 * lane + 1] << 16);
        gl2[(size_t)m * 64 + lane] = (f32x2){GG[2 * lane], GG[2 * lane + 1]};
        LDS_WAIT();
    }
}
__device__ __forceinline__ void p9_upass(Frame& F) {
    const int lane = F.lane, wave = F.wave, x = F.bid & 7, r = F.bid >> 3, nr = F.G >> 3, g = lane >> 4, q = lane & 15;
    LAS unsigned short* EXW = (LAS unsigned short*)(F.lds + wave * 256);
    const unsigned* exl32 = (const unsigned*)(F.ws + WS_EXL); const bf16* hx2 = (const bf16*)(F.ws + WS_HX);
    const unsigned char* U = F.ws + WS_U + 256 * x + 16 * q; float* part = (float*)(F.ws + WS_PART) + (size_t)x * MX * 128;
    for (int m = r + nr * wave; m < MX; m += nr * NWAVES) {
        *(LAS unsigned*)(EXW + 2 * lane) = exl32[(size_t)m * 64 + lane];
        const v4u hs = *(const v4u*)(hx2 + (size_t)m * D + 128 * x + 8 * q);
        LDS_WAIT();
        float keep[2];
#pragma unroll
        for (int j = 0; j < 2; ++j) {
            float kp = 0.f;
#pragma unroll
            for (int i0 = 0; i0 < 16; i0 += 8) {
                v4u uu[8];
#pragma unroll
                for (int i = 0; i < 8; ++i) { const unsigned ex = EXW[64 * j + 4 * (i0 + i) + g]; uu[i] = *(const v4u*)(U + (size_t)ex * 2048); }
#pragma unroll
                for (int i = 0; i < 8; ++i) { float p = dot2bf(uu[i].x, hs.x, 0.f); p = dot2bf(uu[i].y, hs.y, p); p = dot2bf(uu[i].z, hs.z, p); p = dot2bf(uu[i].w, hs.w, p);
                    p = rowsum16(p); kp = (q == i0 + i) ? p : kp; }
            }
            keep[j] = kp;
        }
        part[(size_t)m * 128 + 4 * q + g] = keep[0]; part[(size_t)m * 128 + 64 + 4 * q + g] = keep[1];
        LDS_WAIT();
    }
}
__device__ __forceinline__ void p10_combine(Frame& F) {
    const f32x4* part = (const f32x4*)(F.ws + WS_PART); const f32x4* gl = (const f32x4*)(F.ws + WS_GL); const v2u* exl = (const v2u*)(F.ws + WS_EXL); v4u* pl = (v4u*)(F.ws + WS_PL);
    for (int i = F.bid * 512 + F.tid; i < MX * 32; i += F.G * 512) {
        f32x4 s = part[i];
#pragma unroll
        for (int x = 1; x < 8; ++x) s = s + part[(size_t)x * MX * 32 + i];
        const f32x4 gg = gl[i]; const v2u e = exl[i];
        v4u o; o.x = (e.x & 0xffffu) | (pk2(0.f, gg.x * gelu_erf(s.x)) & 0xffff0000u); o.y = (e.x >> 16) | (pk2(0.f, gg.y * gelu_erf(s.y)) & 0xffff0000u);
        o.z = (e.y & 0xffffu) | (pk2(0.f, gg.z * gelu_erf(s.z)) & 0xffff0000u); o.w = (e.y >> 16) | (pk2(0.f, gg.w * gelu_erf(s.w)) & 0xffff0000u);
        pl[i] = o;
    }
}
__device__ __forceinline__ void p11_vpass(Frame& F) {
    const int lane = F.lane, wave = F.wave, tq = lane >> 4, q = lane & 15;
    const unsigned* pl = (const unsigned*)(F.ws + WS_PL); float* po = (float*)(F.ws + WS_PO);
    for (int cg = F.bid; cg < 256; cg += F.G) {
        const int c0 = 128 * (cg & 7) + 4 * (cg >> 3);
        __syncthreads();
        for (int e = F.tid; e < NEXP; e += 512) { const f32x4 vv = *(const f32x4*)(F.in[I_PV] + (size_t)e * D + c0); *(LAS v2u*)(F.lds + e * 8) = (v2u){pk2(vv.x, vv.y), pk2(vv.z, vv.w)}; }
        __syncthreads();
        for (int mb = wave * 4; mb < MX; mb += NWAVES * 4) {
            const int m = mb + tq;
            unsigned p[8];
#pragma unroll
            for (int i = 0; i < 8; ++i) p[i] = pl[(size_t)m * 128 + q + 16 * i];
            f32x4 acc = (f32x4){0.f, 0.f, 0.f, 0.f};
#pragma unroll
            for (int i = 0; i < 8; ++i) { const v2u vv = *(const LAS v2u*)(F.lds + (p[i] & 0xffffu) * 8); const float cf = bf_hi(p[i]);
                acc.x += cf * bf_lo(vv.x); acc.y += cf * bf_hi(vv.x); acc.z += cf * bf_lo(vv.y); acc.w += cf * bf_hi(vv.y); }
            acc.x = rowsum16(acc.x); acc.y = rowsum16(acc.y); acc.z = rowsum16(acc.z); acc.w = rowsum16(acc.w);
            if (q == 0) *(f32x4*)(po + (size_t)m * D + c0) = acc;
        }
    }
}
__device__ __forceinline__ void p12_final(Frame& F) {
    const float* mod = (const float*)(F.ws + WS_MOD); const float* ng3 = F.in[I_NG] + 3 * D; const float* po = (const float*)(F.ws + WS_PO);
    for (int m = F.bid * NWAVES + F.wave; m < MX; m += F.G * NWAVES) {
        const float* gt2 = mod + (m >> 12) * NMOD + 5 * D;
        f32x4 v[4]; float ss = 0.f;
#pragma unroll
        for (int j = 0; j < 4; ++j) { v[j] = *(const f32x4*)(po + (size_t)m * D + j * 256 + F.lane * 4); ss += v[j].x * v[j].x + v[j].y * v[j].y + v[j].z * v[j].z + v[j].w * v[j].w; }
        const float rstd = __builtin_amdgcn_rsqf(wave_sum(ss) * (1.f / D) + NORM_EPS);
#pragma unroll
        for (int j = 0; j < 4; ++j) { const int c = j * 256 + F.lane * 4; float* op = F.out + (size_t)m * D + c;
            const f32x4 x1 = *(const f32x4*)op, g = *(const f32x4*)(ng3 + c), gt = *(const f32x4*)(gt2 + c);
            *(f32x4*)op = x1 + gt * (v[j] * rstd * g); }
    }
}
struct Args { const float* in[25]; float* out; unsigned char* ws; int ph_lo, ph_hi; };
__global__ void __launch_bounds__(NWAVES * 64, 2) mk_fwd(Args args) {
    extern __shared__ __attribute__((aligned(16))) unsigned char lds_raw[];
    Frame F;
    F.lds = (LAS unsigned char*)lds_raw;
    F.MISC = (volatile LAS unsigned*)(F.lds + MISC_OFF);
    F.tid = threadIdx.x; F.lane = F.tid & 63; F.wave = __builtin_amdgcn_readfirstlane(F.tid >> 6);
    F.G = gridDim.x; F.bid = blockIdx.x;
#pragma unroll
    for (int i = 0; i < 25; ++i) F.in[i] = args.in[i];
    F.out = args.out; F.ws = args.ws; F.ctl = (gu32*)(args.ws + WS_CTL);
    for (int u = F.tid; u < (LDS_BYTES - LDSCTL_OFF) / 4; u += NWAVES * 64) ((LAS unsigned*)(F.lds + LDSCTL_OFF))[u] = 0u;
    __syncthreads();
    const int lo = args.ph_lo, hi = args.ph_hi;
    XcdBarrier bar; bar.bar = (unsigned*)(F.ctl + CW_BAR); bar.x = 0; bar.st = nullptr;
    if (hi - lo > 1) bar = xcd_barrier_post((unsigned*)(F.ctl + CW_BAR), F.MISC + 8);
#ifndef PROBE_LO
#define PROBE_LO -1
#define PROBE_HI -1
#endif
#define IN(k) (lo <= (k) && (k) < hi)
#define SEAM(k) do { if (IN(k) && IN((k) + 1)) xcd_barrier(bar); } while (0)
#define PH0 { p0_prep(F); }
#define PH1 { p1_hx(F); }
#define PH2 { pg8::Gemm g{(const pg8::bf16_t*)(F.ws + WS_HX), (const pg8::bf16_t*)(F.ws + WS_WINT), MA, NPROJ_PAD, D}; pg8::StaticOrder S; S.init(MA, NPROJ_PAD, F.G, F.bid); \
        pg8::EpiProj E{(pg8::bf16_t*)(F.ws + WS_PROJ), NPROJ, NPROJ}; \
        pg8::gemm_phase<pg8::EpiProj, pg8::StaticOrder, PG8_ALIGN, PG8_SP2>(F.lds, g, S, E); }
#define PH3 { p3_scan<false>(F); }
#define PH4 { p4_mix(F); }
#define PH5 { pg8::Gemm g{(const pg8::bf16_t*)(F.ws + WS_HX), (const pg8::bf16_t*)(F.ws + WS_WOUTT), MX, D, D}; pg8::StaticOrder S; S.init(MX, D, F.G, F.bid); \
        pg8::EpiF32 E{(float*)(F.ws + WS_PROJ), D}; \
        pg8::gemm_phase<pg8::EpiF32, pg8::StaticOrder, PG8_ALIGN, PG8_SP2>(F.lds, g, S, E); }
#define PH6 { p6_mid(F); }
#define PH7 { pg8::Gemm g{(const pg8::bf16_t*)(F.ws + WS_HX), (const pg8::bf16_t*)(F.ws + WS_WEFFT), MX, NSC, D}; pg8::StaticOrder S; S.init(MX, NSC, F.G, F.bid); \
        pg8::EpiF32 E{(float*)(F.ws + WS_PROJ), NSC}; \
        pg8::gemm_phase<pg8::EpiF32, pg8::StaticOrder, PG8_ALIGN, PG8_SP2>(F.lds, g, S, E); }
#define PH8 { p8a_route(F); }
#define PH9 { p9_upass(F); }
#define PH10 { p10_combine(F); }
#define PH11 { p11_vpass(F); }
#define PH12 { p12_final(F); }
#define PRB(k, body) if constexpr (PROBE_LO <= (k) && (k) <= PROBE_HI) { xcd_barrier(bar); body }
    if (IN(0)) PH0 PRB(0, PH0) SEAM(0);
    if (IN(1)) PH1 PRB(1, PH1) SEAM(1);
    if (IN(2)) PH2 PRB(2, PH2) SEAM(2);
    if constexpr (PROBE_LO == 33) { p3_scan<true>(F); xcd_barrier(bar); }
    if (IN(3)) PH3 PRB(3, PH3) SEAM(3);
    if (IN(4)) PH4 PRB(4, PH4) SEAM(4);
    if (IN(5)) PH5 PRB(5, PH5) SEAM(5);
    if (IN(6)) PH6 PRB(6, PH6) SEAM(6);
    if (IN(7)) PH7 PRB(7, PH7) SEAM(7);
    if (IN(8)) PH8 PRB(8, PH8) SEAM(8);
    if (IN(9)) PH9 PRB(9, PH9) SEAM(9);
    if (IN(10)) PH10 PRB(10, PH10) SEAM(10);
    if (IN(11)) PH11 PRB(11, PH11) SEAM(11);
    if (IN(12)) PH12
#undef IN
#undef SEAM
}

extern "C" void kernel_launch(void* const* d_in, const int* in_sizes, int n_in, void* d_out, int out_size, void* d_ws, size_t ws_size, hipStream_t stream) {
    static int grid = 0;
    if (grid == 0) {
        if (n_in != 25 || in_sizes[0] != MX * D || out_size != MX * D || ws_size < WS_END) { fprintf(stderr, "kernel_launch: unexpected problem (n_in %d, in0 %d, out %d, ws %zu); nothing launched\n", n_in, n_in > 0 ? in_sizes[0] : -1, out_size, ws_size); grid = -1; return; }
        int dev = 0, cus = 0, per_cu = 0;
        if (hipGetDevice(&dev) != hipSuccess || hipDeviceGetAttribute(&cus, hipDeviceAttributeMultiprocessorCount, dev) != hipSuccess) { fprintf(stderr, "kernel_launch: device query failed\n"); grid = -1; return; }
        if (hipFuncSetAttribute((const void*)mk_fwd, hipFuncAttributeMaxDynamicSharedMemorySize, LDS_BYTES) != hipSuccess) { fprintf(stderr, "kernel_launch: hipFuncSetAttribute failed\n"); grid = -1; return; }
        if (hipOccupancyMaxActiveBlocksPerMultiprocessor(&per_cu, (const void*)mk_fwd, NWAVES * 64, LDS_BYTES) != hipSuccess || per_cu < 1) fprintf(stderr, "kernel_launch: occupancy query reports %d workgroups per CU\n", per_cu);
        (void)hipGetLastError();
        grid = cus;
    }
    if (grid < 0) return;
    if (hipMemsetAsync((char*)d_ws + WS_CTL, 0, CTL_ZERO_BYTES, stream) != hipSuccess) { fprintf(stderr, "kernel_launch: memset failed\n"); return; }
    Args a{};
    for (int i = 0; i < 25; ++i) a.in[i] = (const float*)d_in[i];
    a.out = (float*)d_out; a.ws = (unsigned char*)d_ws;
    if (MK_N_LAUNCHES == 1) { a.ph_lo = 0; a.ph_hi = NPH; hipLaunchKernelGGL(mk_fwd, dim3(grid), dim3(NWAVES * 64), LDS_BYTES, stream, a); }
    else for (int p = 0; p < NPH; ++p) { a.ph_lo = p; a.ph_hi = p + 1; hipLaunchKernelGGL(mk_fwd, dim3(grid), dim3(NWAVES * 64), LDS_BYTES, stream, a); }
    const hipError_t le = hipPeekAtLastError();
    if (le != hipSuccess) fprintf(stderr, "kernel_launch: launch failed: %s\n", hipGetErrorName(le));
}
```

```cpp
#include <hip/hip_runtime.h>
#include <cstdio>
#include <cstdint>
namespace pg8 {
#define PG8_LAS __attribute__((address_space(3)))
typedef unsigned short bf16_t;
typedef short bf16x8 __attribute__((ext_vector_type(8)));
typedef float f32x4 __attribute__((ext_vector_type(4)));
typedef unsigned u32x4 __attribute__((ext_vector_type(4)));
constexpr int BM = 256, BK = 64, HALF = 128, HTB = HALF * BK * 2  , STAGE_BYTES = 8 * HTB, NXCD = 8, WGM = 8;

__host__ __device__ __forceinline__ int lds_byte(int r, int c) { const int st = (r >> 4) * 2 + (c >> 5), rr = r & 15, cc = c & 31, ob = rr * 64 + cc * 2; return st * 1024 + (ob ^ (((ob >> 9) & 1) << 5)); }
__host__ __device__ __forceinline__ void stage_rc(int b, int& R, int& C) { const int st = b / 1024, sb = b % 1024, swz = sb ^ (((sb >> 9) & 1) << 5); R = (st >> 1) * 16 + swz / 64; C = (st & 1) * 32 + (swz % 64) / 2; }
__host__ __device__ __forceinline__ int perm32(int rho) { const int n = rho >> 4, i = rho & 15; return 8 * (i >> 2) + 4 * n + (i & 3); }

struct Unit { int pm, pn; };
struct Gemm { const bf16_t* A; const bf16_t* Bt; int M, N, K; };

struct StaticOrder {
    int nM, nN, nwg, G, c;
    __host__ __device__ void init(int M, int N, int G_, int c_) { nM = M / BM; nN = N / BM; nwg = nM * nN; G = G_; c = c_; }
    __host__ __device__ bool next(int i, Unit& u) const {
        const long L = (long)i * G + c; if (L >= nwg) return false;
        int wgid = (int)L; { const int q = nwg / NXCD, r = nwg % NXCD, xcd = wgid % NXCD, off = wgid / NXCD; wgid = (xcd < r ? xcd * (q + 1) : r * (q + 1) + (xcd - r) * q) + off; }
        const int nig = WGM * nN, gid = wgid / nig, fm = gid * WGM, gsz = (nM - fm) < WGM ? (nM - fm) : WGM;
        u.pm = fm + ((wgid % nig) % gsz); u.pn = (wgid % nig) / gsz; return true;
    }
    __device__ __forceinline__ void a_ready(const Unit&) const {}
    __device__ __forceinline__ void done(const Unit&) const {}
};

__device__ __forceinline__ unsigned cvt_pk_bf16(float lo, float hi) { unsigned r; asm volatile("v_cvt_pk_bf16_f32 %0, %1, %2" : "=v"(r) : "v"(lo), "v"(hi)); return r; }
typedef float f32x2 __attribute__((ext_vector_type(2)));
__device__ __forceinline__ f32x2 gelu_pk(f32x2 v) {
    const f32x2 av = __builtin_elementwise_abs(v), d = av * 0.2316418882f + 1.0f;
    f32x2 t; t.x = __builtin_amdgcn_rcpf(d.x); t.y = __builtin_amdgcn_rcpf(d.y);
    f32x2 q = t * 0.5307027145f + (-0.7265760135f); q = q * t + 0.7107068705f; q = q * t + (-0.142248368f); q = q * t + 0.127414796f; q = q * t;
    const f32x2 s = (v * v) * (-0.72134752044f);
    f32x2 e; e.x = __builtin_amdgcn_exp2f(s.x); e.y = __builtin_amdgcn_exp2f(s.y);
    const f32x2 m = v * (q * e), r = v - m;
    f32x2 o; o.x = v.x < 0.f ? m.x : r.x; o.y = v.y < 0.f ? m.y : r.y; return o;
}

template <int ACT  > struct EpiBf16 {
    static constexpr bool PERM = true, AFTER_DRAIN = false; static_assert(ACT == 0 || ACT == 1, "EpiBf16: ACT is 0 (none) or 1 (gelu_pk)");
    bf16_t* O; int ldc; const float* bias; int split_cols; size_t split_stride; float scale0;
    __device__ __forceinline__ void operator()(const f32x4 (&acc)[2][2][4][2], const Unit& u, int wr, int wc, int fr, int fq) const {
        const int row0 = u.pm * BM + wr * 64 + fr; int colt = u.pn * BM; bf16_t* base = O;
        float sc = 1.f; if (split_cols) { const int t = colt / split_cols; base += (size_t)t * split_stride; colt -= t * split_cols; if (t == 0) sc = scale0; }
        const int col0 = colt + wc * 32 + 8 * fq, bcol0 = u.pn * BM + wc * 32 + 8 * fq;
        f32x4 bv[2][2];
#pragma unroll
        for (int bj = 0; bj < 2; ++bj)
#pragma unroll
            for (int n = 0; n < 2; ++n) bv[bj][n] = bias ? *(const f32x4*)(bias + bcol0 + bj * HALF + 4 * n) : (f32x4){0.f, 0.f, 0.f, 0.f};
#pragma unroll
        for (int ai = 0; ai < 2; ++ai)
#pragma unroll
            for (int m = 0; m < 4; ++m) { bf16_t* rowp = base + (size_t)(row0 + ai * HALF + m * 16) * ldc + col0;
#pragma unroll
                for (int bj = 0; bj < 2; ++bj) { f32x4 v0 = acc[ai][bj][m][0] + bv[bj][0], v1 = acc[ai][bj][m][1] + bv[bj][1];
                    if (ACT == 1) { f32x2 a = gelu_pk((f32x2){v0[0], v0[1]}), b = gelu_pk((f32x2){v0[2], v0[3]}), c = gelu_pk((f32x2){v1[0], v1[1]}), d = gelu_pk((f32x2){v1[2], v1[3]});
                        v0 = (f32x4){a.x, a.y, b.x, b.y}; v1 = (f32x4){c.x, c.y, d.x, d.y}; }
                    v0 = v0 * sc; v1 = v1 * sc; u32x4 w; w.x = cvt_pk_bf16(v0[0], v0[1]); w.y = cvt_pk_bf16(v0[2], v0[3]); w.z = cvt_pk_bf16(v1[0], v1[1]); w.w = cvt_pk_bf16(v1[2], v1[3]);
                    *(u32x4*)(rowp + bj * HALF) = w; } }
    }
};

struct EpiF32 {
    static constexpr bool PERM = false, AFTER_DRAIN = false;
    float* C; int ldc;
    __device__ __forceinline__ void operator()(const f32x4 (&acc)[2][2][4][2], const Unit& u, int wr, int wc, int fr, int fq) const {
        const int row0 = u.pm * BM + wr * 64 + fr, col0 = u.pn * BM + wc * 32 + 4 * fq;
#pragma unroll
        for (int ai = 0; ai < 2; ++ai)
#pragma unroll
            for (int m = 0; m < 4; ++m) { float* rowp = C + (size_t)(row0 + ai * HALF + m * 16) * ldc + col0;
#pragma unroll
                for (int bj = 0; bj < 2; ++bj)
#pragma unroll
                    for (int n = 0; n < 2; ++n) *(f32x4*)(rowp + bj * HALF + n * 16) = acc[ai][bj][m][n]; }
    }
};
struct EpiProj {
    static constexpr bool PERM = true, AFTER_DRAIN = false;
    bf16_t* O; int ldc; int ncols;
    __device__ __forceinline__ void operator()(const f32x4 (&acc)[2][2][4][2], const Unit& u, int wr, int wc, int fr, int fq) const {
        const int row0 = u.pm * BM + wr * 64 + fr; const int col0 = u.pn * BM + wc * 32 + 8 * fq;
#pragma unroll
        for (int ai = 0; ai < 2; ++ai)
#pragma unroll
            for (int m = 0; m < 4; ++m) { bf16_t* rowp = O + (size_t)(row0 + ai * HALF + m * 16) * ldc + col0;
#pragma unroll
                for (int bj = 0; bj < 2; ++bj) { const f32x4 v0 = acc[ai][bj][m][0], v1 = acc[ai][bj][m][1];
                    u32x4 w; w.x = cvt_pk_bf16(v0[0], v0[1]); w.y = cvt_pk_bf16(v0[2], v0[3]); w.z = cvt_pk_bf16(v1[0], v1[1]); w.w = cvt_pk_bf16(v1[2], v1[3]);
                    if (col0 + bj * HALF < ncols) *(u32x4*)(rowp + bj * HALF) = w; } }
    }
};
template <class Epi, class Sched, bool ALIGN_EPI = false, bool SP2 = false>
__device__ __forceinline__ void gemm_phase(PG8_LAS unsigned char* lds, const Gemm g, const Sched& S, const Epi& E) {
    const int tid = threadIdx.x, wid = __builtin_amdgcn_readfirstlane(tid >> 6), lane = tid & 63, wr = wid >> 2, wc = wid & 3, fr = lane & 15, fq = lane >> 4;
    const int K = g.K, nt = K / BK;
    unsigned voffA[2], voffB[2];
#pragma unroll
    for (int i = 0; i < 2; ++i) { int R, C; stage_rc(tid * 16 + i * 8192, R, C); const int Rb = Epi::PERM ? ((R & ~31) + perm32(R & 31)) : R;
        voffA[i] = (unsigned)(R * K + C) * 2u; voffB[i] = (unsigned)(Rb * K + C) * 2u; }
    const size_t kstep = (size_t)(BK * 2);
    const size_t hstep = (size_t)HALF * K * 2;
    const size_t tstep = 2 * hstep;
    const unsigned ldsw = (unsigned)wid * 1024u;
    const int aoff = lds_byte(wr * 64 + fr, fq * 8), boff = lds_byte(wc * 32 + fr, fq * 8);
#define PG8_SA(b, h) (((b) * 2 + (h)) * HTB)
#define PG8_SB(b, h) ((4 + (b) * 2 + (h)) * HTB)
#define PG8_STAGE(bufoff, gbase, voff) do { _Pragma("unroll") for (int _i = 0; _i < 2; ++_i) \
        __builtin_amdgcn_global_load_lds((const unsigned*)((const char*)(gbase) + (voff)[_i]), (PG8_LAS unsigned*)(lds + (bufoff) + ldsw + _i * 8192), 16, 0, 0); } while (0)
#define PG8_LDA(dst, b, h) do { _Pragma("unroll") for (int m = 0; m < 4; ++m) _Pragma("unroll") for (int k = 0; k < 2; ++k) dst[m][k] = *(const PG8_LAS bf16x8*)(lds + PG8_SA(b, h) + aoff + m * 2048 + k * 1024); } while (0)
#define PG8_LDB(dst, b, h) do { _Pragma("unroll") for (int n = 0; n < 2; ++n) _Pragma("unroll") for (int k = 0; k < 2; ++k) dst[n][k] = *(const PG8_LAS bf16x8*)(lds + PG8_SB(b, h) + boff + n * 2048 + k * 1024); } while (0)
#define PG8_MMA(ai, bj, At, Bt) do { __builtin_amdgcn_s_setprio(1); _Pragma("unroll") for (int m = 0; m < 4; ++m) _Pragma("unroll") for (int n = 0; n < 2; ++n) _Pragma("unroll") for (int k = 0; k < 2; ++k) \
        acc[ai][bj][m][n] = __builtin_amdgcn_mfma_f32_16x16x32_bf16(Bt[n][k], At[m][k], acc[ai][bj][m][n], 0, 0, 0); __builtin_amdgcn_s_setprio(0); } while (0)
#define PG8_WAIT_V(n) asm volatile("s_waitcnt vmcnt(" #n ")" ::: "memory")
#define PG8_WAIT_L(n) asm volatile("s_waitcnt lgkmcnt(" #n ")" ::: "memory")
#define PG8_BAR __builtin_amdgcn_s_barrier()
#define PG8_SCHED __builtin_amdgcn_sched_barrier(0)
    Unit cur, nxt; int ui = 0;
    if (!S.next(0, cur)) return;
    f32x4 acc[2][2][4][2];
#pragma unroll
    for (int a = 0; a < 2; ++a)
#pragma unroll
        for (int b = 0; b < 2; ++b)
#pragma unroll
            for (int m = 0; m < 4; ++m)
#pragma unroll
                for (int n = 0; n < 2; ++n) acc[a][b][m][n] = (f32x4){0.f, 0.f, 0.f, 0.f};
    bf16x8 At[4][2], B0[2][2], B1[2][2];
    const char* cA = (const char*)g.A + (size_t)cur.pm * tstep; const char* cB = (const char*)g.Bt + (size_t)cur.pn * tstep;
    S.a_ready(cur);
    if constexpr (SP2) {
        PG8_STAGE(PG8_SB(0, 0), cB, voffB); PG8_STAGE(PG8_SB(0, 1), cB + hstep, voffB); PG8_STAGE(PG8_SA(0, 0), cA, voffA); PG8_STAGE(PG8_SA(0, 1), cA + hstep, voffA);
        if (wr == 1) PG8_BAR;
        PG8_WAIT_V(2); PG8_BAR;
        PG8_STAGE(PG8_SB(1, 0), cB + kstep, voffB); PG8_STAGE(PG8_SA(1, 0), cA + kstep, voffA); PG8_STAGE(PG8_SB(1, 1), cB + hstep + kstep, voffB);
        PG8_WAIT_V(6); PG8_BAR;
    } else {
        PG8_STAGE(PG8_SB(0, 0), cB, voffB); PG8_STAGE(PG8_SA(0, 0), cA, voffA); PG8_STAGE(PG8_SB(0, 1), cB + hstep, voffB); PG8_STAGE(PG8_SA(0, 1), cA + hstep, voffA);
        if (wr == 1) PG8_BAR;
        PG8_WAIT_V(4); PG8_BAR;
        PG8_STAGE(PG8_SB(1, 0), cB + kstep, voffB); PG8_STAGE(PG8_SA(1, 0), cA + kstep, voffA); PG8_STAGE(PG8_SB(1, 1), cB + hstep + kstep, voffB);
        PG8_WAIT_V(6); PG8_BAR;
    }
    for (;;) {
        const bool has_next = S.next(ui + 1, nxt);
        const char* nA = has_next ? (const char*)g.A + (size_t)nxt.pm * tstep : cA; const char* nB = has_next ? (const char*)g.Bt + (size_t)nxt.pn * tstep : cB;
        for (int t = 0; t < nt; t += 2) {
            const bool last = (t == nt - 2);
            const char* a1 = cA + (size_t)(t + 1) * kstep;
            const char* a2 = last ? nA : cA + (size_t)(t + 2) * kstep; const char* b2 = last ? nB : cB + (size_t)(t + 2) * kstep;
            const char* a3 = a2 + kstep; const char* b3 = b2 + kstep;
            if (last && has_next) S.a_ready(nxt);
            if constexpr (SP2) {
            PG8_LDB(B0, 0, 0); PG8_LDB(B1, 0, 1); PG8_SCHED; PG8_LDA(At, 0, 0); PG8_STAGE(PG8_SA(1, 1), a1 + hstep, voffA);
            PG8_WAIT_V(8); PG8_WAIT_L(0); PG8_BAR; PG8_MMA(0, 0, At, B0); PG8_MMA(0, 1, At, B1); PG8_BAR; PG8_SCHED;
            PG8_LDA(At, 0, 1); PG8_STAGE(PG8_SB(0, 0), b2, voffB); PG8_STAGE(PG8_SB(0, 1), b2 + hstep, voffB); PG8_STAGE(PG8_SA(0, 0), a2, voffA);
            PG8_WAIT_V(8); PG8_WAIT_L(0); PG8_BAR; PG8_MMA(1, 0, At, B0); PG8_MMA(1, 1, At, B1); PG8_BAR; PG8_SCHED;
            PG8_LDB(B0, 1, 0); PG8_LDB(B1, 1, 1); PG8_SCHED; PG8_LDA(At, 1, 0); PG8_STAGE(PG8_SA(0, 1), a2 + hstep, voffA);
            PG8_WAIT_V(8); PG8_WAIT_L(0); PG8_BAR; PG8_MMA(0, 0, At, B0); PG8_MMA(0, 1, At, B1); PG8_BAR; PG8_SCHED;
            PG8_LDA(At, 1, 1); PG8_STAGE(PG8_SB(1, 0), b3, voffB); PG8_STAGE(PG8_SB(1, 1), b3 + hstep, voffB); PG8_STAGE(PG8_SA(1, 0), a3, voffA);
            PG8_WAIT_V(8); PG8_WAIT_L(0); PG8_BAR; PG8_MMA(1, 0, At, B0); PG8_MMA(1, 1, At, B1); PG8_BAR; PG8_SCHED;
            } else {
            PG8_LDB(B0, 0, 0); PG8_SCHED; PG8_LDA(At, 0, 0); PG8_STAGE(PG8_SA(1, 1), a1 + hstep, voffA);
            PG8_WAIT_L(8); PG8_BAR; PG8_WAIT_L(0); PG8_MMA(0, 0, At, B0); PG8_BAR; PG8_SCHED;
            PG8_LDB(B1, 0, 1); PG8_STAGE(PG8_SB(0, 0), b2, voffB);
            PG8_BAR; PG8_WAIT_L(0); PG8_MMA(0, 1, At, B1); PG8_BAR;
            PG8_LDA(At, 0, 1); PG8_STAGE(PG8_SA(0, 0), a2, voffA);
            PG8_BAR; PG8_WAIT_L(0); PG8_MMA(1, 0, At, B0); PG8_BAR; PG8_SCHED;
            PG8_STAGE(PG8_SB(0, 1), b2 + hstep, voffB);
            PG8_WAIT_V(6); PG8_BAR; PG8_MMA(1, 1, At, B1); PG8_BAR;
            PG8_LDB(B0, 1, 0); PG8_SCHED; PG8_LDA(At, 1, 0); PG8_STAGE(PG8_SA(0, 1), a2 + hstep, voffA);
            PG8_WAIT_L(8); PG8_BAR; PG8_WAIT_L(0); PG8_MMA(0, 0, At, B0); PG8_BAR; PG8_SCHED;
            PG8_LDB(B1, 1, 1); PG8_STAGE(PG8_SB(1, 0), b3, voffB);
            PG8_BAR; PG8_WAIT_L(0); PG8_MMA(0, 1, At, B1); PG8_BAR;
            PG8_LDA(At, 1, 1); PG8_STAGE(PG8_SA(1, 0), a3, voffA);
            PG8_BAR; PG8_WAIT_L(0); PG8_MMA(1, 0, At, B0); PG8_BAR; PG8_SCHED;
            PG8_STAGE(PG8_SB(1, 1), b3 + hstep, voffB);
            PG8_WAIT_V(6); PG8_BAR; PG8_MMA(1, 1, At, B1); PG8_BAR;
            }
        }
        if constexpr (ALIGN_EPI) { if (wr == 0) PG8_BAR; }
        if constexpr (!Epi::AFTER_DRAIN) { E(acc, cur, wr, wc, fr, fq); S.done(cur); }
        if (!has_next) break;
#pragma unroll
        for (int a = 0; a < 2; ++a)
#pragma unroll
            for (int b = 0; b < 2; ++b)
#pragma unroll
                for (int m = 0; m < 4; ++m)
#pragma unroll
                    for (int n = 0; n < 2; ++n) acc[a][b][m][n] = (f32x4){0.f, 0.f, 0.f, 0.f};
        cur = nxt; cA = nA; cB = nB; ++ui;
        if constexpr (ALIGN_EPI) { if (wr == 1) PG8_BAR; }
    }
    PG8_WAIT_V(0);
    if constexpr (!ALIGN_EPI) { if (wr == 0) PG8_BAR; }
    PG8_BAR;
    if constexpr (Epi::AFTER_DRAIN) { E.fused(acc, cur, wr, wc, fr, fq, lds, wid, lane); S.done(cur); }
#undef PG8_SA
#undef PG8_SB
#undef PG8_STAGE
#undef PG8_LDA
#undef PG8_LDB
#undef PG8_MMA
#undef PG8_WAIT_V
#undef PG8_WAIT_L
#undef PG8_BAR
#undef PG8_SCHED
}
}
#ifndef PG8_SP2
#define PG8_SP2 true
#endif
#ifndef PG8_ALIGN
#define PG8_ALIGN true
#endif
constexpr int NWAVES = 8;
constexpr int D = 1024, NB = 4, T = 4096, TC = 256;
constexpr int MX = NB * T, MC = NB * TC, MA = MX + MC;
constexpr int NPROJ = 3456, NPROJ_PAD = 3584;
constexpr int COL_XB = 0, COL_XG = 512, COL_XC = 1024, COL_R = 1536, COL_K = 2048, COL_V = 2560, COL_G = 3072, COL_LW = 3200, COL_LA = 3328;
constexpr int NMOD = 6 * D;
constexpr int NEXP = 16384, NSC = 2048;
constexpr float NORM_EPS = 1e-6f, LNX_EPS = 64e-5f;
#ifndef MK_N_LAUNCHES
#define MK_N_LAUNCHES 1
#endif
constexpr int NPH = 13;
constexpr size_t MiB = 1u << 20;
constexpr size_t WS_CTL = 0, CTL_ZERO_BYTES = 64 * 1024;
constexpr size_t WS_MOD = 3 * MiB;
constexpr size_t WS_WINT = 6 * MiB;
constexpr size_t WS_WOUTT = 13 * MiB;
constexpr size_t WS_WEFFT = 15 * MiB;
constexpr size_t WS_U = 20 * MiB, WS_V = 52 * MiB;
constexpr size_t WS_HX = 84 * MiB;
constexpr size_t WS_PROJ = 118 * MiB;
constexpr size_t WS_END = 246 * MiB;
constexpr size_t WS_EXL = WS_V, WS_GL = WS_V + 4 * MiB, WS_PL = WS_V + 12 * MiB;
constexpr size_t WS_BLOB0 = WS_V, WS_BLOB1 = WS_HX;
constexpr size_t WS_PART = WS_PROJ, WS_PO = WS_PROJ + 64 * MiB;
static_assert(WS_PROJ + (size_t)MA * NPROJ * 2 <= WS_END && WS_PROJ + (size_t)MX * NSC * 4 <= WS_END && WS_HX + (size_t)MA * D * 2 <= WS_PROJ, "d_ws map");
constexpr int CW_BAR = 1024;
constexpr int RING_BYTES = 131072;
constexpr int LDSCTL_OFF = RING_BYTES, MISC_OFF = LDSCTL_OFF + 320;
constexpr int LDS_BYTES = 147456;

#define GAS __attribute__((address_space(1)))
#define LAS __attribute__((address_space(3)))
typedef unsigned short bf16;
typedef unsigned v4u __attribute__((ext_vector_type(4)));
typedef unsigned v2u __attribute__((ext_vector_type(2)));
typedef float f32x4 __attribute__((ext_vector_type(4)));
typedef float f32x2 __attribute__((ext_vector_type(2)));
typedef float f32x16 __attribute__((ext_vector_type(16)));
typedef short bf16x8 __attribute__((ext_vector_type(8)));
typedef GAS unsigned gu32;
#define RLX_AGENT __ATOMIC_RELAXED, __HIP_MEMORY_SCOPE_AGENT
#define LDS_WAIT() asm volatile("s_waitcnt lgkmcnt(0)" ::: "memory")
#define VM_WAIT() asm volatile("s_waitcnt vmcnt(0)" ::: "memory")
typedef __bf16 bf16v2 __attribute__((ext_vector_type(2)));
__device__ __forceinline__ unsigned pk2(float lo, float hi) { const f32x2 v = {lo, hi}; return __builtin_bit_cast(unsigned, __builtin_convertvector(v, bf16v2)); }
__device__ __forceinline__ float bf_lo(unsigned w) { return __builtin_bit_cast(float, w << 16); }
__device__ __forceinline__ float bf_hi(unsigned w) { return __builtin_bit_cast(float, w & 0xffff0000u); }
__device__ __forceinline__ float bf1(bf16 b) { return __builtin_bit_cast(float, (unsigned)b << 16); }
__device__ __forceinline__ float fast_exp(float x) { return __builtin_amdgcn_exp2f(x * 1.44269504089f); }
__device__ __forceinline__ float fast_rcp(float x) { return __builtin_amdgcn_rcpf(x); }
__device__ __forceinline__ float sigmoidf(float x) { return fast_rcp(1.f + fast_exp(-x)); }
__device__ __forceinline__ float tanh_fast(float x) { return 1.f - 2.f * fast_rcp(fast_exp(2.f * x) + 1.f); }
__device__ __forceinline__ float siluf(float x) { return x * sigmoidf(x); }
template <int CTRL> __device__ __forceinline__ float dppf(float x) { return __builtin_bit_cast(float, __builtin_amdgcn_update_dpp(0, __builtin_bit_cast(int, x), CTRL, 0xF, 0xF, false)); }
template <int CTRL> __device__ __forceinline__ unsigned dppu(unsigned x) { return (unsigned)__builtin_amdgcn_update_dpp(0, (int)x, CTRL, 0xF, 0xF, false); }
__device__ __forceinline__ float rowsum16(float x) { x += dppf<0xB1>(x); x += dppf<0x4E>(x); x += dppf<0x141>(x); x += dppf<0x140>(x); return x; }
__device__ __forceinline__ float wave_sum(float v) {
    v = rowsum16(v); v += __shfl_xor(v, 16); v += __shfl_xor(v, 32); return v;
}
__device__ __forceinline__ float half_sum32(float v) { v = rowsum16(v); v += __shfl_xor(v, 16); return v; }
__device__ __forceinline__ unsigned umaxu(unsigned a, unsigned b) { return a > b ? a : b; }
__device__ __forceinline__ unsigned wave_max_u32(unsigned x) {
    x = umaxu(x, dppu<0xB1>(x)); x = umaxu(x, dppu<0x4E>(x)); x = umaxu(x, dppu<0x141>(x)); x = umaxu(x, dppu<0x140>(x));
    const unsigned a = __builtin_amdgcn_readlane((int)x, 0), b = __builtin_amdgcn_readlane((int)x, 16), c = __builtin_amdgcn_readlane((int)x, 32), d = __builtin_amdgcn_readlane((int)x, 48);
    return umaxu(umaxu(a, b), umaxu(c, d));
}
__device__ __forceinline__ unsigned f2key(float f) { const unsigned u = __builtin_bit_cast(unsigned, f); return (u & 0x80000000u) ? ~u : (u | 0x80000000u); }
__device__ __forceinline__ float key2f(unsigned k) { const unsigned u = (k & 0x80000000u) ? (k ^ 0x80000000u) : ~k; return __builtin_bit_cast(float, u); }
#define XB_TMO      128
#define XB_XCNT(j)  (256  + 64 * (j))
#define XB_XSUB(j)  (1280 + 64 * (j))
#define XB_XGEN(j)  (2304 + 64 * (j))
#define XB_TOP      3328
#define XB_TOPGEN   3392
#define XCD_BAR_WORDS 3456
#define XB_SPIN_CAP (1u << 18)

__device__ __forceinline__ unsigned xb_ld(unsigned* p)              { return __hip_atomic_load(p, __ATOMIC_RELAXED, __HIP_MEMORY_SCOPE_AGENT); }
__device__ __forceinline__ unsigned xb_add(unsigned* p, unsigned v) { return __hip_atomic_fetch_add(p, v, __ATOMIC_RELAXED, __HIP_MEMORY_SCOPE_AGENT); }
__device__ __forceinline__ unsigned xb_xcc_id() { return (unsigned)__builtin_amdgcn_s_getreg((3 << 11) | 20) & 0xFu; }
#define XB_SPIN(cond, bar) do { unsigned _sp = 0; while (cond) { __builtin_amdgcn_s_sleep(1); \
    if ((++_sp & 255u) == 0u) { if (xb_ld(&(bar)[XB_TMO])) break; if (_sp > XB_SPIN_CAP) { atomicAdd(&(bar)[XB_TMO], 1u); break; } } } } while (0)

struct XcdBarrier {
    unsigned* bar; unsigned x;
    volatile LAS unsigned* st;
};

__device__ __forceinline__ XcdBarrier xcd_barrier_post(unsigned* bar, volatile LAS unsigned* st) {
    XcdBarrier b; b.bar = bar; b.x = xb_xcc_id(); b.st = st;
    if (threadIdx.x == 0) (void)xb_add(&bar[XB_XCNT(b.x)], 1u);
    return b;
}
__device__ __forceinline__ void xcd_barrier_complete(unsigned* bar, unsigned x, unsigned& nloc, unsigned& nx) {
    const unsigned G = gridDim.x * gridDim.y * gridDim.z;
    unsigned sum, cnt, mine, sp = 0u;
    for (;;) {
        sum = 0u; cnt = 0u; mine = 0u;
#pragma unroll
        for (unsigned j = 0; j < 16; ++j) { const unsigned c = xb_ld(&bar[XB_XCNT(j)]); sum += c; cnt += (c > 0u) ? 1u : 0u; mine = (j == x) ? c : mine; }
        if (sum == G) break;
        __builtin_amdgcn_s_sleep(1);
        if ((++sp & 255u) == 0u) { if (xb_ld(&bar[XB_TMO])) break; if (sp > XB_SPIN_CAP) { atomicAdd(&bar[XB_TMO], 1u); break; } }
    }
    nloc = mine > 0u ? mine : 1u; nx = cnt > 0u ? cnt : 1u;
}

__device__ __forceinline__ void xcd_barrier(const XcdBarrier& b) {
    asm volatile("s_waitcnt vmcnt(0)" ::: "memory");
    __syncthreads();
    if (threadIdx.x == 0) {
        unsigned* bar = b.bar;
        __builtin_amdgcn_s_waitcnt(0);
        unsigned nloc = b.st[0], nx = b.st[1];
        if (nloc == 0u) { xcd_barrier_complete(bar, b.x, nloc, nx); b.st[0] = nloc; b.st[1] = nx; }
        const unsigned old = xb_add(&bar[XB_XSUB(b.x)], 1u);
        const unsigned gen = old / nloc;
        if (old + 1u == (gen + 1u) * nloc) {
            __builtin_amdgcn_fence(__ATOMIC_RELEASE, "agent");
            asm volatile("s_waitcnt vmcnt(0)" ::: "memory");
            const unsigned og = xb_add(&bar[XB_TOP], 1u);
            const unsigned tg = og / nx;
            if (og + 1u == (tg + 1u) * nx) xb_add(&bar[XB_TOPGEN], 1u);
            else XB_SPIN(xb_ld(&bar[XB_TOPGEN]) == tg, bar);
            __builtin_amdgcn_fence(__ATOMIC_ACQUIRE, "agent");
            xb_add(&bar[XB_XGEN(b.x)], 1u);
            asm volatile("s_waitcnt vmcnt(0)" ::: "memory");
        } else {
            XB_SPIN(xb_ld(&bar[XB_XGEN(b.x)]) == gen, bar);
            __builtin_amdgcn_fence(__ATOMIC_ACQUIRE, "agent");
            asm volatile("s_waitcnt vmcnt(0)" ::: "memory");
        }
    }
    __syncthreads();
}
struct Frame {
    LAS unsigned char* lds;
    volatile LAS unsigned* MISC;
    gu32* ctl;
    int tid, lane, wave, G, bid;
    const float* in[25];
    float* out;
    unsigned char* ws;
};
enum { I_X = 0, I_C, I_CTX, I_CCTX, I_WMOD, I_BMOD, I_NG, I_WIN, I_WOUT, I_CONVW, I_TMU, I_DW0, I_DW2, I_A0, I_A2, I_GW2, I_KK, I_KA, I_RK, I_LNG, I_LNB, I_WQ, I_SUBK, I_PU, I_PV };

__device__ __forceinline__ void p0_transpose_item(const float* W, int K, int N, bf16* WT, LAS float* scr, int item, int lane) {
    const int nblk = N / 32, kb = item / nblk, nb = item % nblk, k0 = 64 * kb, n0 = 32 * nb;
#pragma unroll 8
    for (int i = 0; i < 32; ++i) { const int kk = 2 * i + (lane >> 5); scr[kk * 33 + (lane & 31)] = W[(size_t)(k0 + kk) * N + n0 + (lane & 31)]; }
    LDS_WAIT(); asm volatile("" ::: "memory");
    const int c = lane & 7;
#pragma unroll
    for (int j = 0; j < 4; ++j) { const int n = (lane >> 3) + 8 * j; const LAS float* s = scr + (8 * c) * 33 + n;
        v4u o; o.x = pk2(s[0 * 33], s[1 * 33]); o.y = pk2(s[2 * 33], s[3 * 33]); o.z = pk2(s[4 * 33], s[5 * 33]); o.w = pk2(s[6 * 33], s[7 * 33]);
        *(v4u*)(WT + (size_t)(n0 + n) * K + k0 + 8 * c) = o; }
    LDS_WAIT(); asm volatile("" ::: "memory");
}
__device__ __forceinline__ void p0_mod_item(Frame& F, int cb) {
    LAS float* S = (LAS float*)F.lds;
    LAS float* RED = (LAS float*)(F.lds + 32768);
    const float* c = F.in[I_C]; const float* cc = F.in[I_CCTX];
    for (int i = F.tid; i < 5 * D; i += 512) { const int r = i >> 10, k = i & 1023; const float v = (r < 4) ? c[r * D + k] : cc[k]; S[i] = siluf(v); }
    __syncthreads();
    const int col = F.tid & 63, kg = F.tid >> 6;
    const float* wp = F.in[I_WMOD] + (size_t)(kg * 128) * NMOD + cb * 64 + col;
    float a0 = 0.f, a1 = 0.f, a2 = 0.f, a3 = 0.f, a4 = 0.f;
#pragma unroll 8
    for (int k = 0; k < 128; ++k) { const float w = wp[(size_t)k * NMOD]; const int kk = kg * 128 + k;
        a0 += S[kk] * w; a1 += S[D + kk] * w; a2 += S[2 * D + kk] * w; a3 += S[3 * D + kk] * w; a4 += S[4 * D + kk] * w; }
    RED[(kg * 5 + 0) * 64 + col] = a0; RED[(kg * 5 + 1) * 64 + col] = a1; RED[(kg * 5 + 2) * 64 + col] = a2; RED[(kg * 5 + 3) * 64 + col] = a3; RED[(kg * 5 + 4) * 64 + col] = a4;
    __syncthreads();
    if (F.tid < 320) { const int r = F.tid >> 6, cl = F.tid & 63; float s = F.in[I_BMOD][cb * 64 + cl];
#pragma unroll
        for (int g = 0; g < 8; ++g) s += RED[(g * 5 + r) * 64 + cl];
        ((float*)(F.ws + WS_MOD))[r * NMOD + cb * 64 + cl] = s; }
    __syncthreads();
}
__device__ __forceinline__ void p0_weff_item(Frame& F, int item) {
    const int hs = item >> 4, kb = item & 15;
    LAS float* SK = (LAS float*)F.lds;
    LAS float* WQ = (LAS float*)(F.lds + 128 * 132 * 4);
    const float* sk = F.in[I_SUBK] + (size_t)hs * 128 * 128;
    const float* wq = F.in[I_WQ] + (size_t)(kb * 64) * 2048 + hs * 128;
#pragma unroll
    for (int i = 0; i < 8; ++i) { const int idx = F.tid + 512 * i, row = idx >> 5, c4 = idx & 31; const f32x4 v = *(const f32x4*)(sk + row * 128 + c4 * 4); *(LAS f32x4*)(SK + row * 132 + c4 * 4) = v; }
#pragma unroll
    for (int i = 0; i < 4; ++i) { const int idx = F.tid + 512 * i, row = idx >> 5, c4 = idx & 31; const f32x4 v = *(const f32x4*)(wq + (size_t)row * 2048 + c4 * 4); *(LAS f32x4*)(WQ + row * 132 + c4 * 4) = v; }
    __syncthreads();
    const int key = F.tid >> 2, kq = F.tid & 3;
    float acc[16];
#pragma unroll
    for (int i = 0; i < 16; ++i) acc[i] = 0.f;
    for (int d = 0; d < 128; d += 4) {
        const f32x4 a = *(const LAS f32x4*)(SK + key * 132 + d);
#pragma unroll
        for (int i = 0; i < 16; ++i) { const f32x4 b = *(const LAS f32x4*)(WQ + (4 * i + kq) * 132 + d); acc[i] += a.x * b.x + a.y * b.y + a.z * b.z + a.w * b.w; }
    }
    bf16* dst = (bf16*)(F.ws + WS_WEFFT) + (size_t)(hs * 128 + key) * D + kb * 64;
#pragma unroll
    for (int i = 0; i < 16; ++i) dst[4 * i + kq] = (bf16)(pk2(acc[i], 0.f) & 0xffffu);
    __syncthreads();
}
__device__ __forceinline__ void p0_prep(Frame& F) {
    for (int it = F.bid; it < 96 + 256; it += F.G) { if (it < 96) p0_mod_item(F, it); else p0_weff_item(F, it - 96); }
    LAS float* scr = (LAS float*)(F.lds + F.wave * 16384);
    const int gw = F.bid * NWAVES + F.wave, NGW = F.G * NWAVES;
    constexpr int I_IN = (D / 64) * (NPROJ / 32), I_OUT = (D / 64) * (D / 32);
    for (int it = gw; it < I_IN + I_OUT; it += NGW) {
        if (it < I_IN) p0_transpose_item(F.in[I_WIN], D, NPROJ, (bf16*)(F.ws + WS_WINT), scr, it, F.lane);
        else p0_transpose_item(F.in[I_WOUT], D, D, (bf16*)(F.ws + WS_WOUTT), scr, it - I_IN, F.lane);
    }
    { v4u* z = (v4u*)((bf16*)(F.ws + WS_WINT) + (size_t)NPROJ * D); const int n16 = (NPROJ_PAD - NPROJ) * D * 2 / 16;
      for (int i = F.bid * 512 + F.tid; i < n16; i += F.G * 512) z[i] = (v4u){0u, 0u, 0u, 0u}; }
    { const f32x4* pu = (const f32x4*)F.in[I_PU]; v4u* du = (v4u*)(F.ws + WS_U);
      const int n8 = NEXP * D / 8;
      for (int i = F.bid * 512 + F.tid; i < n8; i += F.G * 512) {
          const f32x4 a0 = pu[2 * i], a1 = pu[2 * i + 1];
          du[i] = (v4u){pk2(a0.x, a0.y), pk2(a0.z, a0.w), pk2(a1.x, a1.y), pk2(a1.z, a1.w)}; } }
}

__device__ __forceinline__ void p1_hx(Frame& F) {
    const float* mod = (const float*)(F.ws + WS_MOD); const float* ng = F.in[I_NG];
    bf16* hx = (bf16*)(F.ws + WS_HX);
    for (int m = F.bid * NWAVES + F.wave; m < MA; m += F.G * NWAVES) {
        const float* src = (m < MX) ? F.in[I_X] + (size_t)m * D : F.in[I_CTX] + (size_t)(m - MX) * D;
        const float* mr = mod + ((m < MX) ? (m >> 12) : 4) * NMOD;
        f32x4 v[4]; float ss = 0.f;
#pragma unroll
        for (int j = 0; j < 4; ++j) { v[j] = *(const f32x4*)(src + j * 256 + F.lane * 4); ss += v[j].x * v[j].x + v[j].y * v[j].y + v[j].z * v[j].z + v[j].w * v[j].w; }
        const float rstd = __builtin_amdgcn_rsqf(wave_sum(ss) * (1.f / D) + NORM_EPS);
#pragma unroll
        for (int j = 0; j < 4; ++j) { const int c = j * 256 + F.lane * 4;
            const f32x4 g = *(const f32x4*)(ng + c), sh = *(const f32x4*)(mr + c), sc = *(const f32x4*)(mr + D + c);
            const float o0 = v[j].x * rstd * g.x * (1.f + sc.x) + sh.x, o1 = v[j].y * rstd * g.y * (1.f + sc.y) + sh.y, o2 = v[j].z * rstd * g.z * (1.f + sc.z) + sh.z, o3 = v[j].w * rstd * g.w * (1.f + sc.w) + sh.w;
            *(v2u*)(hx + (size_t)m * D + c) = (v2u){pk2(o0, o1), pk2(o2, o3)}; }
    }
}
constexpr int BL_APT = 0, BL_NPT = 4608, BL_RH = 7168, BL_MKR = 11776, BL_MBR = 14336, BL_KGC = 16896, BL_BGC = 22016, BL_GC = 27136, BL_VT = 27648, BL_BYTES = 32768;
constexpr int CS_AH = 32768, CS_BH = 37376, CS_KH = 41984, CS_AHC = 46592, CS_E = 51712, CS_RAW = 59904, CS_TLW = 72960, CS_LOA = 77568, CS_W2T = 82176, CS_A2T = 91392,
              CS_LG = 100608, CS_NBA = 100608, CS_NKA = 105216, CS_TT = 107776, CS_CONST = 116992, CS_END = 119552;
constexpr int CS_RH = BL_RH, CS_KGC = BL_KGC, CS_BGC = BL_BGC, CS_VT = BL_VT, CS_GC = BL_GC, CS_APT = BL_APT, CS_NPT = BL_NPT, CS_MKR = BL_MKR, CS_MBR = BL_MBR;
constexpr int SC_NTILE = (TC + T) / 32, SC_RT = 16, SC_NROUND = (SC_NTILE + SC_RT - 1) / SC_RT;
constexpr int GS_YS = 65536;
__device__ __forceinline__ void scan_issue_loads(const bf16* proj, int b, int h, int d, int tile, int tid, v4u (&rg)[3]) {
    const bool isctx = tile < TC / 32; const int L = isctx ? TC : T; const int jt = isctx ? tile : tile - TC / 32;
    const size_t rowbase = isctx ? (size_t)(MX + b * TC) : (size_t)b * T;
    const int tlo = d == 0 ? 32 * jt : L - 32 * (jt + 1);
#pragma unroll
    for (int i = 0; i < 3; ++i) {
        const int q = tid + 512 * i; v4u val = (v4u){0u, 0u, 0u, 0u};
        if (q < 816) { const int row = q / 24, rem = q - row * 24, which = rem >> 3, ch8 = rem & 7; const int tok = tlo - 1 + row;
            if (tok >= 0 && tok < L) val = *(const v4u*)(proj + (rowbase + tok) * NPROJ + COL_R + which * 512 + h * 64 + ch8 * 8); }
        else if (q < 1328) { const int q2 = q - 816, row = q2 >> 4, rem = q2 & 15, which = rem >> 3, ch8 = rem & 7; const int tok = tlo + row;
            val = *(const v4u*)(proj + (rowbase + tok) * NPROJ + (which ? COL_LA : COL_LW) + d * 64 + ch8 * 8); }
        rg[i] = val;
    }
}
__device__ __forceinline__ unsigned tanh_pk(unsigned w) { return pk2(tanh_fast(bf_lo(w)), tanh_fast(bf_hi(w))); }
__device__ __forceinline__ void scan_store_raw(LAS unsigned char* lds, int tid, const v4u (&rg)[3]) {
#pragma unroll
    for (int i = 0; i < 3; ++i) {
        const int q = tid + 512 * i;
        if (q < 816) { const int row = q / 24, rem = q - row * 24, which = rem >> 3, ch8 = rem & 7; *(LAS v4u*)(lds + CS_RAW + (which * 34 + row) * 128 + ch8 * 16) = rg[i]; }
        else if (q < 1328) { const int q2 = q - 816, row = q2 >> 4, rem = q2 & 15, which = rem >> 3, ch8 = rem & 7;
            if (which) *(LAS v4u*)(lds + CS_LOA + row * 144 + ch8 * 16) = rg[i];
            else { v4u t; t.x = tanh_pk(rg[i].x); t.y = tanh_pk(rg[i].y); t.z = tanh_pk(rg[i].z); t.w = tanh_pk(rg[i].w); *(LAS v4u*)(lds + CS_TLW + row * 144 + ch8 * 16) = t; } }
    }
}
__device__ __forceinline__ v2u pack4(f32x4 v) { return (v2u){pk2(v.x, v.y), pk2(v.z, v.w)}; }
__device__ __forceinline__ bf16 bfs(float v) { return (bf16)(pk2(v, 0.f) & 0xffffu); }
typedef v2u v2u_t;
__device__ __forceinline__ bf16x8 frag2(const LAS unsigned char* p0, const LAS unsigned char* p1) {
    const v2u a = *(const LAS v2u*)p0, b = *(const LAS v2u*)p1; const v4u w = (v4u){a.x, a.y, b.x, b.y}; return __builtin_bit_cast(bf16x8, w);
}
__device__ __forceinline__ bf16x8 frag_acc(f32x4 lo, f32x4 hi) { const v4u w = (v4u){pk2(lo.x, lo.y), pk2(lo.z, lo.w), pk2(hi.x, hi.y), pk2(hi.z, hi.w)}; return __builtin_bit_cast(bf16x8, w); }
__device__ __forceinline__ bf16x8 frag_zero() { const v4u w = (v4u){0u, 0u, 0u, 0u}; return __builtin_bit_cast(bf16x8, w); }
__device__ __forceinline__ void scan_prep_task(Frame& F, const bf16* proj, int chain, int tile, bool load_consts, bool have_next, int nchain, int ntile, v4u (&rg)[3], unsigned char* blob) {
    LAS unsigned char* lds = F.lds; const int tid = F.tid, lane = F.lane, wave = F.wave;
    const int b = chain >> 4, h = (chain >> 1) & 7, d = chain & 1, nb = nchain >> 4, nh = (nchain >> 1) & 7, nd = nchain & 1;
    if (load_consts) {
        __syncthreads();
        LAS float* C = (LAS float*)(lds + CS_CONST);
        if (tid < 384) { const int pn = tid / 192, r = tid - pn * 192, which = r >> 6, c = r & 63; C[pn * 192 + which * 64 + c] = F.in[I_TMU][(pn * 3 + which) * 512 + h * 64 + c]; }
        else if (tid < 448) { const int c = tid - 384; C[384 + c] = F.in[I_KK][h * 64 + c]; C[448 + c] = F.in[I_KA][h * 64 + c]; }
        else { const int c = tid - 448; C[512 + c] = F.in[I_DW0][d * 512 + h * 64 + c]; C[576 + c] = F.in[I_A0][d * 512 + h * 64 + c]; }
        const float* w2 = F.in[I_DW2] + (size_t)d * 64 * 512 + h * 64; const float* a2 = F.in[I_A2] + (size_t)d * 64 * 512 + h * 64;
#pragma unroll
        for (int i = 0; i < 8; ++i) { const int idx = tid + 512 * i, j = idx >> 6, c = idx & 63;
            *(LAS bf16*)(lds + CS_W2T + c * 144 + j * 2) = bfs(w2[j * 512 + c]);
            *(LAS bf16*)(lds + CS_A2T + c * 144 + j * 2) = bfs(a2[j * 512 + c]); }
    }
    {
            scan_store_raw(lds, tid, rg);
            __syncthreads();
            if (have_next) scan_issue_loads(proj, nb, nh, nd, ntile, tid, rg);
            if (wave < 4) {
                const int mat = wave >> 1, nt = wave & 1, r = lane & 31, hh = lane >> 5;
                const LAS unsigned char* Ab = lds + (mat ? CS_LOA : CS_TLW) + r * 144 + hh * 16;
                const LAS unsigned char* Bb = lds + (mat ? CS_A2T : CS_W2T) + (nt * 32 + r) * 144 + hh * 16;
                f32x16 acc;
#pragma unroll
                for (int i = 0; i < 16; ++i) acc[i] = 0.f;
#pragma unroll
                for (int ks = 0; ks < 4; ++ks) { const bf16x8 a = *(const LAS bf16x8*)(Ab + ks * 32), bb = *(const LAS bf16x8*)(Bb + ks * 32); acc = __builtin_amdgcn_mfma_f32_32x32x16_bf16(a, bb, acc, 0, 0, 0); }
                LAS float* LG = (LAS float*)(lds + CS_LG) + mat * 2048 + nt * 32 + r;
#pragma unroll
                for (int i = 0; i < 16; ++i) LG[((i & 3) + 8 * (i >> 2) + 4 * hh) * 64] = acc[i];
            }
            __syncthreads();
            const int tok = tid >> 4, cq = tid & 15, c0 = cq * 4, s = d == 0 ? tok : 31 - tok;
            f32x4 rs, vs, kd, kk, kka, ev;
            { const LAS float* C = (const LAS float*)(lds + CS_CONST);
              f32x4 xs[3];
#pragma unroll
              for (int which = 0; which < 3; ++which) {
                  const LAS unsigned char* rp = lds + CS_RAW + (which * 34 + tok) * 128 + c0 * 2;
                  const v2u p = *(const LAS v2u*)rp, x = *(const LAS v2u*)(rp + 128), n = *(const LAS v2u*)(rp + 256);
                  const f32x4 mp = *(const LAS f32x4*)(C + which * 64 + c0), mn = *(const LAS f32x4*)(C + 192 + which * 64 + c0);
                  const f32x4 xp = (f32x4){bf_lo(p.x), bf_hi(p.x), bf_lo(p.y), bf_hi(p.y)}, xc = (f32x4){bf_lo(x.x), bf_hi(x.x), bf_lo(x.y), bf_hi(x.y)}, xn = (f32x4){bf_lo(n.x), bf_hi(n.x), bf_lo(n.y), bf_hi(n.y)};
                  xs[which] = xc + mp * (xp - xc) + mn * (xn - xc); }
              const f32x4 kkc = *(const LAS f32x4*)(C + 384 + c0), kac = *(const LAS f32x4*)(C + 448 + c0), w0 = *(const LAS f32x4*)(C + 512 + c0), a0 = *(const LAS f32x4*)(C + 576 + c0);
              kk = xs[1] * kkc;
              const float ss = rowsum16(kk.x * kk.x + kk.y * kk.y + kk.z * kk.z + kk.w * kk.w);
              kk = kk * __builtin_amdgcn_rsqf(ss + 1e-12f);
              const f32x4 uw = *(const LAS f32x4*)(lds + CS_LG + (tok * 64 + c0) * 4) + w0, ua = *(const LAS f32x4*)(lds + CS_LG + 8192 + (tok * 64 + c0) * 4) + a0;
              f32x4 av;
#pragma unroll
              for (int e = 0; e < 4; ++e) { ev[e] = 0.60653066f * sigmoidf(uw[e]); av[e] = sigmoidf(ua[e]); }
              kd = xs[1] * (1.f + (av - 1.f) * kac); kka = kk * av; rs = xs[0]; vs = xs[2];
              *(LAS f32x4*)(lds + CS_E + (s * 64 + c0) * 4) = ev; }
            __syncthreads();
            { const int cb = s & 16, sl = s & 15;
              f32x4 cum = (f32x4){0.f, 0.f, 0.f, 0.f}, tot = cum;
#pragma unroll
              for (int ii = 0; ii < 16; ++ii) { const f32x4 e4 = *(const LAS f32x4*)(lds + CS_E + ((cb + ii) * 64 + c0) * 4); tot = tot + e4; if (ii <= sl) cum = cum + e4; }
              f32x4 g, gm1, gi, ge, gt;
#pragma unroll
              for (int e = 0; e < 4; ++e) { g[e] = fast_exp(-cum[e]); gm1[e] = fast_exp(ev[e] - cum[e]); gi[e] = fast_exp(cum[e]); ge[e] = fast_exp(cum[e] - tot[e]); gt[e] = fast_exp(-tot[e]); }
              const f32x4 ah = gm1 * kk, bh = kka * gi, kh = kd * gi, rh = g * rs, kg = kd * ge, bg = kka * ge;
              *(LAS v2u*)(lds + CS_AH + s * 144 + c0 * 2) = pack4(ah); *(LAS v2u*)(lds + CS_BH + s * 144 + c0 * 2) = pack4(bh);
              *(LAS v2u*)(lds + CS_KH + s * 144 + c0 * 2) = pack4(kh); *(LAS v2u*)(lds + CS_RH + s * 144 + c0 * 2) = pack4(rh);
#pragma unroll
              for (int e = 0; e < 4; ++e) { *(LAS bf16*)(lds + CS_AHC + (c0 + e) * 80 + s * 2) = bfs(ah[e]); *(LAS bf16*)(lds + CS_KGC + (c0 + e) * 80 + s * 2) = bfs(kg[e]); *(LAS bf16*)(lds + CS_BGC + (c0 + e) * 80 + s * 2) = bfs(-bg[e]); }
#pragma unroll
              for (int e = 0; e < 4; ++e) *(LAS bf16*)(lds + CS_VT + (c0 + e) * 80 + s * 2) = bfs(vs[e]);
              if (sl == 15) *(LAS f32x4*)(lds + CS_GC + ((s >> 4) * 64 + c0) * 4) = gt; }
            __syncthreads();
            if (wave < 4) {
                const int r = lane & 31, hh = lane >> 5;
                const LAS unsigned char* Ab = lds + ((wave == 0 || wave == 3) ? CS_BH : CS_KH) + r * 144 + hh * 16;
                const LAS unsigned char* Bb = lds + (wave < 2 ? CS_AH : CS_RH) + r * 144 + hh * 16;
                f32x16 acc;
#pragma unroll
                for (int i = 0; i < 16; ++i) acc[i] = 0.f;
#pragma unroll
                for (int ks = 0; ks < 4; ++ks) { const bf16x8 a = *(const LAS bf16x8*)(Ab + ks * 32), bb = *(const LAS bf16x8*)(Bb + ks * 32); acc = __builtin_amdgcn_mfma_f32_32x32x16_bf16(a, bb, acc, 0, 0, 0); }
                const int t = r;
#pragma unroll
                for (int i = 0; i < 16; ++i) { const int j = (i & 3) + 8 * (i >> 2) + 4 * hh; const bool same = (j >> 4) == (t >> 4);
                    const bool keep = same && (wave < 2 ? (j < t) : (j <= t)); acc[i] = keep ? acc[i] : 0.f; }
                if (wave == 0) {
#pragma unroll
                    for (int i = 0; i < 16; ++i) { const int j = (i & 3) + 8 * (i >> 2) + 4 * hh; *(LAS float*)(lds + CS_NBA + (t * 36 + j) * 4) = acc[i]; } }
                else if (wave == 1) {
#pragma unroll
                    for (int i = 0; i < 16; ++i) { const int j = (i & 3) + 8 * (i >> 2) + 4 * hh; *(LAS bf16*)(lds + CS_NKA + j * 80 + t * 2) = bfs(acc[i]); } }
                else { const float sg = wave == 2 ? 1.f : -1.f; const int base = wave == 2 ? CS_MKR : CS_MBR;
#pragma unroll
                    for (int q4 = 0; q4 < 4; ++q4) *(LAS v2u*)(lds + base + t * 80 + (8 * q4 + 4 * hh) * 2) = pack4((f32x4){sg * acc[4 * q4], sg * acc[4 * q4 + 1], sg * acc[4 * q4 + 2], sg * acc[4 * q4 + 3]}); }
            }
            __syncthreads();
            if (wave == 0 && lane < 32) {
                const int blk = lane >> 4, i = lane & 15;
                float Tr[16];
#pragma unroll
                for (int t = 0; t < 16; ++t) {
                    float acc = (t == i) ? 1.f : 0.f;
                    const LAS float* np = (const LAS float*)(lds + CS_NBA) + (16 * blk + t) * 36 + 16 * blk;
#pragma unroll
                    for (int j = 0; j < t; ++j) acc -= Tr[j] * np[j];
                    Tr[t] = acc;
                }
#pragma unroll
                for (int t = 0; t < 16; ++t) { *(LAS bf16*)(lds + CS_TT + (16 * blk + t) * 80 + (16 * blk + i) * 2) = bfs(Tr[t]); *(LAS bf16*)(lds + CS_TT + (16 * blk + t) * 80 + (16 * (1 - blk) + i) * 2) = (bf16)0; }
            }
            __syncthreads();
            if (wave < 3) {
                const int r = lane & 31, hh = lane >> 5;
                const LAS unsigned char* Ab = lds + (wave < 2 ? CS_AHC + (32 * wave + r) * 80 : CS_NKA + r * 80) + hh * 16;
                const LAS unsigned char* Bb = lds + CS_TT + r * 80 + hh * 16;
                f32x16 acc;
#pragma unroll
                for (int i = 0; i < 16; ++i) acc[i] = 0.f;
#pragma unroll
                for (int ks = 0; ks < 2; ++ks) { const bf16x8 a = *(const LAS bf16x8*)(Ab + ks * 32), bb = *(const LAS bf16x8*)(Bb + ks * 32); acc = __builtin_amdgcn_mfma_f32_32x32x16_bf16(a, bb, acc, 0, 0, 0); }
                const int t = r;
#pragma unroll
                for (int q4 = 0; q4 < 4; ++q4) { const v2u pk = pack4((f32x4){acc[4 * q4], acc[4 * q4 + 1], acc[4 * q4 + 2], acc[4 * q4 + 3]});
                    if (wave < 2) *(LAS v2u*)(lds + CS_APT + t * 144 + (32 * wave + 8 * q4 + 4 * hh) * 2) = pk;
                    else *(LAS v2u*)(lds + CS_NPT + t * 80 + (8 * q4 + 4 * hh) * 2) = pk; }
            }
            __syncthreads();
#pragma unroll
            for (int i = 0; i < 4; ++i) { const int idx = tid + 512 * i; *(v4u*)(blob + idx * 16) = *(const LAS v4u*)(lds + idx * 16); }
    }
}
__device__ __forceinline__ void scan_state_round(Frame& F, int chain, int t0, int t1, const unsigned char* blobs, f32x4 (&Z)[4]) {
    LAS unsigned char* lds = F.lds; const int tid = F.tid, lane = F.lane, wave = F.wave;
    const int b = chain >> 4, h = (chain >> 1) & 7, d = chain & 1;
    float* yscr = F.out;
    v4u bg[4];
    __syncthreads();
#pragma unroll
    for (int i = 0; i < 4; ++i) bg[i] = *(const v4u*)(blobs + (tid + 512 * i) * 16);
#pragma unroll
    for (int i = 0; i < 4; ++i) *(LAS v4u*)(lds + (tid + 512 * i) * 16) = bg[i];
    __syncthreads();
    for (int tile = t0; tile < t1; ++tile) {
        const bool isctx = tile < TC / 32; const int L = isctx ? TC : T; const int jt = isctx ? tile : tile - TC / 32;
        const int tlo = d == 0 ? 32 * jt : L - 32 * (jt + 1);
        const LAS unsigned char* bl = lds + ((tile - t0) & 1) * BL_BYTES;
        if (tile + 1 < t1) {
#pragma unroll
            for (int i = 0; i < 4; ++i) bg[i] = *(const v4u*)(blobs + (size_t)(tile + 1 - t0) * BL_BYTES + (tid + 512 * i) * 16); }
            if (wave < 4) {
                const int n = lane & 15, g = lane >> 4;
                const bf16x8 bvt = *(const LAS bf16x8*)(bl + BL_VT + (16 * wave + n) * 80 + g * 16);
                f32x4 U[2]; U[0] = (f32x4){0.f, 0.f, 0.f, 0.f}; U[1] = U[0];
#pragma unroll
                for (int cc = 0; cc < 2; ++cc) {
                    const int trow = 16 * cc + n;
                    const bf16x8 bz01 = frag_acc(Z[0], Z[1]), bz23 = frag_acc(Z[2], Z[3]);
                    { const LAS unsigned char* ap = bl + BL_APT + trow * 144;
                      f32x4 u = __builtin_amdgcn_mfma_f32_16x16x32_bf16(frag2(ap + (4 * g) * 2, ap + (16 + 4 * g) * 2), bz01, (f32x4){0.f, 0.f, 0.f, 0.f}, 0, 0, 0);
                      u = __builtin_amdgcn_mfma_f32_16x16x32_bf16(frag2(ap + (32 + 4 * g) * 2, ap + (48 + 4 * g) * 2), bz23, u, 0, 0, 0);
                      u = __builtin_amdgcn_mfma_f32_16x16x32_bf16(*(const LAS bf16x8*)(bl + BL_NPT + trow * 80 + g * 16), bvt, u, 0, 0, 0);
                      U[cc] = u; }
                    const bf16x8 bu = frag_acc(U[0], U[1]);
                    if (!isctx) { const LAS unsigned char* rp = bl + BL_RH + trow * 144;
                      f32x4 y = __builtin_amdgcn_mfma_f32_16x16x32_bf16(frag2(rp + (4 * g) * 2, rp + (16 + 4 * g) * 2), bz01, (f32x4){0.f, 0.f, 0.f, 0.f}, 0, 0, 0);
                      y = __builtin_amdgcn_mfma_f32_16x16x32_bf16(frag2(rp + (32 + 4 * g) * 2, rp + (48 + 4 * g) * 2), bz23, y, 0, 0, 0);
                      y = __builtin_amdgcn_mfma_f32_16x16x32_bf16(*(const LAS bf16x8*)(bl + BL_MKR + trow * 80 + g * 16), bvt, y, 0, 0, 0);
                      const LAS unsigned char* mp = bl + BL_MBR + trow * 80;
                      y = __builtin_amdgcn_mfma_f32_16x16x32_bf16(frag2(mp + (4 * g) * 2, mp + (16 + 4 * g) * 2), bu, y, 0, 0, 0);
#pragma unroll
                      for (int i = 0; i < 4; ++i) *(LAS float*)(lds + GS_YS + ((16 * cc + 4 * g + i) * 64 + 16 * wave + n) * 4) = y[i]; }
#pragma unroll
                    for (int kt = 0; kt < 4; ++kt) {
                        const f32x4 gc = *(const LAS f32x4*)(bl + BL_GC + (cc * 64 + 16 * kt + 4 * g) * 4);
                        bf16x8 ka = *(const LAS bf16x8*)(bl + BL_KGC + (16 * kt + n) * 80 + g * 16);
                        if ((g >> 1) != cc) ka = frag_zero();
                        const LAS unsigned char* bp = bl + BL_BGC + (16 * kt + n) * 80;
                        const v2u b0 = *(const LAS v2u*)(bp + (4 * g) * 2), b1 = *(const LAS v2u*)(bp + (16 + 4 * g) * 2);
                        const v4u bw = cc == 0 ? (v4u){b0.x, b0.y, 0u, 0u} : (v4u){0u, 0u, b1.x, b1.y};
                        f32x4 z = Z[kt] * gc;
                        z = __builtin_amdgcn_mfma_f32_16x16x32_bf16(ka, bvt, z, 0, 0, 0);
                        z = __builtin_amdgcn_mfma_f32_16x16x32_bf16(__builtin_bit_cast(bf16x8, bw), bu, z, 0, 0, 0);
                        Z[kt] = z;
                    }
                }
            }
        __syncthreads();
        if (!isctx) { const int s2 = tid >> 4, part = tid & 15; const int tk = d == 0 ? tlo + s2 : tlo + 31 - s2;
            *(f32x4*)(yscr + ((size_t)(b * T + tk)) * D + d * 512 + h * 64 + part * 4) = *(const LAS f32x4*)(lds + GS_YS + (s2 * 64 + part * 4) * 4); }
        if (tile + 1 < t1) {
#pragma unroll
            for (int i = 0; i < 4; ++i) *(LAS v4u*)(lds + ((tile + 1 - t0) & 1) * BL_BYTES + (tid + 512 * i) * 16) = bg[i]; }
        __syncthreads();
    }
}
template <int LEVEL> __device__ __forceinline__ void p3_scan(Frame& F, const XcdBarrier& bar) {
    const bf16* proj = (const bf16*)(F.ws + WS_PROJ);
    const bool state_role = F.bid < 64;
    f32x4 Z[4];
#pragma unroll
    for (int kt = 0; kt < 4; ++kt) Z[kt] = (f32x4){0.f, 0.f, 0.f, 0.f};
    for (int step = 0; step <= SC_NROUND; ++step) {
        if (step >= 1 && state_role) {
            const int r = step - 1, t0 = r * SC_RT, t1 = (t0 + SC_RT < SC_NTILE) ? t0 + SC_RT : SC_NTILE;
            scan_state_round(F, F.bid, t0, t1, F.ws + ((r & 1) ? WS_BLOB1 : WS_BLOB0) + (size_t)F.bid * SC_RT * BL_BYTES, Z);
        }
        const bool prep_here = step < SC_NROUND && (step == 0 || !state_role);
        if (prep_here) {
            const int t0 = step * SC_RT, nt = (t0 + SC_RT < SC_NTILE) ? SC_RT : SC_NTILE - t0, ntask = 64 * nt;
            const int P = step == 0 ? F.G : F.G - 64, p = step == 0 ? F.bid : F.bid - 64;
            const int k0 = (int)((long)ntask * p / P), k1 = (int)((long)ntask * (p + 1) / P);
            unsigned char* base = F.ws + ((step & 1) ? WS_BLOB1 : WS_BLOB0);
            v4u rg[3];
            if (k0 < k1) scan_issue_loads(proj, (k0 / nt) >> 4, ((k0 / nt) >> 1) & 7, (k0 / nt) & 1, t0 + k0 % nt, F.tid, rg);
            int prev_chain = -1;
            for (int k = k0; k < k1; ++k) {
                const int chain = k / nt, tl = k % nt, kn = k + 1, nchain = kn / nt, ntl = kn % nt;
                scan_prep_task(F, proj, chain, t0 + tl, chain != prev_chain, kn < k1, nchain, t0 + ntl, rg, base + ((size_t)chain * SC_RT + tl) * BL_BYTES);
                prev_chain = chain;
            }
        }
        if (step < SC_NROUND) xcd_barrier(bar);
    }
}
__device__ __forceinline__ void p4_mix(Frame& F) {
    LAS unsigned char* lds = F.lds; const int tid = F.tid;
    const bf16* proj = (const bf16*)(F.ws + WS_PROJ); bf16* cat = (bf16*)(F.ws + WS_HX); const float* yscr = F.out;
    LAS float* SG = (LAS float*)lds;
    LAS bf16* GT = (LAS bf16*)(lds + 32768);
    for (int unit = F.bid; unit < MX / 64; unit += F.G) {
        const size_t row0 = (size_t)unit * 64; const int tb0 = (unit * 64) & (T - 1);
        __syncthreads();
#pragma unroll
        for (int i = 0; i < 2; ++i) { const int ck = tid + 512 * i, tok = ck >> 4, j0 = (ck & 15) * 8;
            const v4u w = *(const v4u*)(proj + (row0 + tok) * NPROJ + COL_G + j0);
            SG[(j0 + 0) * 64 + tok] = sigmoidf(bf_lo(w.x)); SG[(j0 + 1) * 64 + tok] = sigmoidf(bf_hi(w.x)); SG[(j0 + 2) * 64 + tok] = sigmoidf(bf_lo(w.y)); SG[(j0 + 3) * 64 + tok] = sigmoidf(bf_hi(w.y));
            SG[(j0 + 4) * 64 + tok] = sigmoidf(bf_lo(w.z)); SG[(j0 + 5) * 64 + tok] = sigmoidf(bf_hi(w.z)); SG[(j0 + 6) * 64 + tok] = sigmoidf(bf_lo(w.w)); SG[(j0 + 7) * 64 + tok] = sigmoidf(bf_hi(w.w)); }
        __syncthreads();
        { float acc[64];
#pragma unroll
          for (int i = 0; i < 64; ++i) acc[i] = 0.f;
          const float* gw = F.in[I_GW2] + tid;
#pragma unroll 2
          for (int j = 0; j < 128; ++j) { const float wv = gw[j * 512];
#pragma unroll
              for (int tq = 0; tq < 16; ++tq) { const f32x4 s4 = *(const LAS f32x4*)(SG + j * 64 + tq * 4);
                  acc[4 * tq] += s4.x * wv; acc[4 * tq + 1] += s4.y * wv; acc[4 * tq + 2] += s4.z * wv; acc[4 * tq + 3] += s4.w * wv; } }
#pragma unroll
          for (int i = 0; i < 64; ++i) GT[i * 512 + tid] = (bf16)(pk2(acc[i], 0.f) & 0xffffu); }
        __syncthreads();
        if (tid < 256) {
            const int c = 2 * tid; const float* cw = F.in[I_CONVW];
            const f32x2 w0 = *(const f32x2*)(cw + c), w1 = *(const f32x2*)(cw + 512 + c), w2 = *(const f32x2*)(cw + 1024 + c);
            const bf16* pr = proj + row0 * NPROJ + c;
            f32x2 zp = (f32x2){0.f, 0.f}, zc, zn;
            { const unsigned g = *(const unsigned*)(pr + COL_XG), x = *(const unsigned*)(pr + COL_XC); zc = (f32x2){bf_lo(g) * bf_lo(x), bf_hi(g) * bf_hi(x)}; }
            for (int t = 0; t < 64; ++t) {
                if (t < 63) { const unsigned g = *(const unsigned*)(pr + (size_t)(t + 1) * NPROJ + COL_XG), x = *(const unsigned*)(pr + (size_t)(t + 1) * NPROJ + COL_XC); zn = (f32x2){bf_lo(g) * bf_lo(x), bf_hi(g) * bf_hi(x)}; }
                else zn = (f32x2){0.f, 0.f};
                const unsigned xb = *(const unsigned*)(pr + (size_t)t * NPROJ + COL_XB);
                const f32x2 z = w0 * zp + w1 * zc + w2 * zn;
                *(unsigned*)(cat + (row0 + t) * D + c) = pk2(bf_lo(xb) * z.x, bf_hi(xb) * z.y);
                zp = zc; zc = zn;
            }
        } else {
            const int ri = tid - 256, c = 2 * ri, h = ri >> 5;
            const f32x2 mpr = *(const f32x2*)(F.in[I_TMU] + 0 * 512 + c), mpk = *(const f32x2*)(F.in[I_TMU] + 1 * 512 + c), mpv = *(const f32x2*)(F.in[I_TMU] + 2 * 512 + c);
            const f32x2 mnr = *(const f32x2*)(F.in[I_TMU] + 3 * 512 + c), mnk = *(const f32x2*)(F.in[I_TMU] + 4 * 512 + c), mnv = *(const f32x2*)(F.in[I_TMU] + 5 * 512 + c);
            const f32x2 rk = *(const f32x2*)(F.in[I_RK] + c), lg = *(const f32x2*)(F.in[I_LNG] + c), lb = *(const f32x2*)(F.in[I_LNB] + c);
            const bf16* pr = proj + row0 * NPROJ + c;
            f32x2 rp, kp, vp, rc, kc, vc, rn, kn, vn;
#define LD2(dst, ptr) do { const unsigned _w = *(const unsigned*)(ptr); dst = (f32x2){bf_lo(_w), bf_hi(_w)}; } while (0)
            if (tb0 > 0) { LD2(rp, pr - NPROJ + COL_R); LD2(kp, pr - NPROJ + COL_K); LD2(vp, pr - NPROJ + COL_V); } else { rp = kp = vp = (f32x2){0.f, 0.f}; }
            LD2(rc, pr + COL_R); LD2(kc, pr + COL_K); LD2(vc, pr + COL_V);
            for (int t = 0; t < 64; ++t) {
                if (tb0 + t + 1 < T) { const bf16* pn = pr + (size_t)(t + 1) * NPROJ; LD2(rn, pn + COL_R); LD2(kn, pn + COL_K); LD2(vn, pn + COL_V); } else { rn = kn = vn = (f32x2){0.f, 0.f}; }
                const f32x2 rs = rc + mpr * (rp - rc) + mnr * (rn - rc), ks = kc + mpk * (kp - kc) + mnk * (kn - kc), vs = vc + mpv * (vp - vc) + mnv * (vn - vc);
                const float* yr = yscr + (row0 + t) * D + c;
                const f32x2 y = *(const f32x2*)yr + *(const f32x2*)(yr + 512);
                const float mu = half_sum32(y.x + y.y) * (1.f / 64.f);
                const f32x2 yc = y - mu;
                const float var = half_sum32(yc.x * yc.x + yc.y * yc.y) * (1.f / 64.f);
                const float bon = half_sum32(rs.x * ks.x * rk.x + rs.y * ks.y * rk.y);
                const f32x2 yn = yc * __builtin_amdgcn_rsqf(var + LNX_EPS) * lg + lb + bon * vs;
                const unsigned gt = *(const LAS unsigned*)(GT + t * 512 + c);
                *(unsigned*)(cat + (row0 + t) * D + 512 + c) = pk2(yn.x * bf_lo(gt), yn.y * bf_hi(gt));
                rp = rc; kp = kc; vp = vc; rc = rn; kc = kn; vc = vn;
            }
#undef LD2
        }
    }
}

__device__ __forceinline__ void p6_mid(Frame& F) {
    const float* mod = (const float*)(F.ws + WS_MOD); const float* ng = F.in[I_NG];
    const float* yx = (const float*)(F.ws + WS_PROJ); bf16* hx2 = (bf16*)(F.ws + WS_HX);
    for (int m = F.bid * NWAVES + F.wave; m < MX; m += F.G * NWAVES) {
        const float* mr = mod + (m >> 12) * NMOD;
        f32x4 v[4], xv[4]; float ss = 0.f;
#pragma unroll
        for (int j = 0; j < 4; ++j) { v[j] = *(const f32x4*)(yx + (size_t)m * D + j * 256 + F.lane * 4); xv[j] = *(const f32x4*)(F.in[I_X] + (size_t)m * D + j * 256 + F.lane * 4);
            ss += v[j].x * v[j].x + v[j].y * v[j].y + v[j].z * v[j].z + v[j].w * v[j].w; }
        const float rstd = __builtin_amdgcn_rsqf(wave_sum(ss) * (1.f / D) + NORM_EPS);
        float ss2 = 0.f;
#pragma unroll
        for (int j = 0; j < 4; ++j) { const int c = j * 256 + F.lane * 4;
            const f32x4 g1 = *(const f32x4*)(ng + D + c), gt = *(const f32x4*)(mr + 2 * D + c);
            xv[j] = xv[j] + gt * (v[j] * rstd * g1);
            *(f32x4*)(F.out + (size_t)m * D + c) = xv[j];
            ss2 += xv[j].x * xv[j].x + xv[j].y * xv[j].y + xv[j].z * xv[j].z + xv[j].w * xv[j].w; }
        const float rstd2 = __builtin_amdgcn_rsqf(wave_sum(ss2) * (1.f / D) + NORM_EPS);
#pragma unroll
        for (int j = 0; j < 4; ++j) { const int c = j * 256 + F.lane * 4;
            const f32x4 g2 = *(const f32x4*)(ng + 2 * D + c), sh = *(const f32x4*)(mr + 3 * D + c), sc = *(const f32x4*)(mr + 4 * D + c);
            const f32x4 o = xv[j] * rstd2 * g2 * (1.f + sc) + sh;
            *(v2u*)(hx2 + (size_t)m * D + c) = (v2u){pk2(o.x, o.y), pk2(o.z, o.w)}; }
    }
}
__device__ __forceinline__ float gelu_erf(float x) { return 0.5f * x * (1.f + erff(x * 0.70710678118f)); }
__device__ __forceinline__ float dot2bf(unsigned a, unsigned b, float c) {
    typedef __bf16 bf2 __attribute__((ext_vector_type(2)));
    return __builtin_amdgcn_fdot2_f32_bf16(__builtin_bit_cast(bf2, a), __builtin_bit_cast(bf2, b), c, false);
}
__device__ __forceinline__ void p8a_route(Frame& F) {
    const int lane = F.lane, wave = F.wave;
    LAS int* EX = (LAS int*)(F.lds + wave * 2048);
    LAS float* GG = (LAS float*)(F.lds + wave * 2048 + 512);
    const float* scores = (const float*)(F.ws + WS_PROJ);
    unsigned* exl32 = (unsigned*)(F.ws + WS_EXL); f32x2* gl2 = (f32x2*)(F.ws + WS_GL);
    int ci = 0, cj = 0; { int l = lane, i = 0; for (; i < 16; ++i) { const int n = 16 / (i + 1); if (l < n) break; l -= n; } ci = i < 16 ? i : 0; cj = i < 16 ? l : 0; }
    const bool cvalid = lane < 50;
    for (int m = F.bid * NWAVES + wave; m < MX; m += F.G * NWAVES) {
        const float* srow = scores + (size_t)m * NSC;
        for (int h = 0; h < 8; ++h) {
            unsigned res[2];
#pragma unroll
            for (int s = 0; s < 2; ++s) {
                const float* lp = srow + (h * 2 + s) * 128;
                unsigned k0 = (f2key(lp[lane]) & ~127u) | (unsigned)(127 - lane), k1 = (f2key(lp[64 + lane]) & ~127u) | (unsigned)(63 - lane);
                unsigned r = 0u;
                for (int it = 0; it < 16; ++it) { const unsigned mx = wave_max_u32(umaxu(k0, k1)); r = (lane == it) ? mx : r; k0 = (k0 == mx) ? 0u : k0; k1 = (k1 == mx) ? 0u : k1; }
                res[s] = r;
            }
            const unsigned ka = (unsigned)__shfl((int)res[0], ci), kb = (unsigned)__shfl((int)res[1], cj);
            const float sum = key2f(ka & ~127u) + key2f(kb & ~127u);
            unsigned ck = cvalid ? ((f2key(sum) & ~63u) | (unsigned)(63 - lane)) : 0u;
            unsigned win = 0u;
            for (int it = 0; it < 16; ++it) { const unsigned mx = wave_max_u32(ck); win = (lane == it) ? mx : win; ck = (ck == mx) ? 0u : ck; }
            const int wl = 63 - (int)(win & 63u);
            const int wi = __shfl(ci, wl), wj = __shfl(cj, wl);
            const int idx0 = 127 - (int)((unsigned)__shfl((int)res[0], wi) & 127u), idx1 = 127 - (int)((unsigned)__shfl((int)res[1], wj) & 127u);
            const float scv = key2f(win & ~63u);
            const float smax = __shfl(scv, 0);
            const float e = (lane < 16) ? fast_exp(scv - smax) : 0.f;
            const float den = rowsum16(e);
            if (lane < 16) { EX[h * 16 + lane] = idx0 * 128 + idx1; GG[h * 16 + lane] = e * fast_rcp(den); }
        }
        LDS_WAIT();
        exl32[(size_t)m * 64 + lane] = (unsigned)EX[2 * lane] | ((unsigned)EX[2 * lane + 1] << 16);
        gl2[(size_t)m * 64 + lane] = (f32x2){GG[2 * lane], GG[2 * lane + 1]};
        LDS_WAIT();
    }
}
__device__ __forceinline__ void p9_upass(Frame& F) {
    const int lane = F.lane, wave = F.wave, x = F.bid & 7, r = F.bid >> 3, nr = F.G >> 3, g = lane >> 4, q = lane & 15;
    LAS unsigned short* EXW = (LAS unsigned short*)(F.lds + wave * 256);
    const unsigned* exl32 = (const unsigned*)(F.ws + WS_EXL); const bf16* hx2 = (const bf16*)(F.ws + WS_HX);
    const unsigned char* U = F.ws + WS_U + 256 * x + 16 * q; float* part = (float*)(F.ws + WS_PART) + (size_t)x * MX * 128;
    for (int m = r + nr * wave; m < MX; m += nr * NWAVES) {
        *(LAS unsigned*)(EXW + 2 * lane) = exl32[(size_t)m * 64 + lane];
        const v4u hs = *(const v4u*)(hx2 + (size_t)m * D + 128 * x + 8 * q);
        LDS_WAIT();
        float keep[2];
#pragma unroll
        for (int j = 0; j < 2; ++j) {
            float kp = 0.f;
#pragma unroll
            for (int i0 = 0; i0 < 16; i0 += 8) {
                v4u uu[8];
#pragma unroll
                for (int i = 0; i < 8; ++i) { const unsigned ex = EXW[64 * j + 4 * (i0 + i) + g]; uu[i] = *(const v4u*)(U + (size_t)ex * 2048); }
#pragma unroll
                for (int i = 0; i < 8; ++i) { float p = dot2bf(uu[i].x, hs.x, 0.f); p = dot2bf(uu[i].y, hs.y, p); p = dot2bf(uu[i].z, hs.z, p); p = dot2bf(uu[i].w, hs.w, p);
                    p = rowsum16(p); kp = (q == i0 + i) ? p : kp; }
            }
            keep[j] = kp;
        }
        part[(size_t)m * 128 + 4 * q + g] = keep[0]; part[(size_t)m * 128 + 64 + 4 * q + g] = keep[1];
        LDS_WAIT();
    }
}
__device__ __forceinline__ void p10_combine(Frame& F) {
    const float* __restrict__ part = (const float*)(F.ws + WS_PART); const float* __restrict__ gl = (const float*)(F.ws + WS_GL);
    const unsigned short* __restrict__ exl = (const unsigned short*)(F.ws + WS_EXL); unsigned* __restrict__ plt = (unsigned*)(F.ws + WS_PL);
    LAS unsigned* TL = (LAS unsigned*)F.lds;
    for (int unit = F.bid; unit < MX / 64; unit += F.G) {
        const int m0 = unit * 64;
        __syncthreads();
#pragma unroll 4
        for (int i = 0; i < 16; ++i) { const int idx = F.tid + 512 * i, ml = idx >> 7, k = idx & 127; const size_t gi = (size_t)(m0 + ml) * 128 + k;
            float s = part[gi];
#pragma unroll
            for (int x = 1; x < 8; ++x) s += part[(size_t)x * MX * 128 + gi];
            TL[k * 65 + ml] = (unsigned)exl[gi] | (pk2(0.f, gl[gi] * gelu_erf(s)) & 0xffff0000u); }
        __syncthreads();
#pragma unroll 4
        for (int i = 0; i < 16; ++i) { const int idx = F.tid + 512 * i, k = idx >> 6, ml = idx & 63; plt[(size_t)k * MX + m0 + ml] = TL[k * 65 + ml]; }
    }
}
template <int MODE> __device__ __forceinline__ void p11_vpass(Frame& F) {
    const int lane = F.lane, wave = F.wave;
    const unsigned* __restrict__ plt = (const unsigned*)(F.ws + WS_PL); float* __restrict__ po = (float*)(F.ws + WS_PO);
    for (int cg = F.bid; cg < 256; cg += F.G) {
        const int c0 = 128 * (cg & 7) + 4 * (cg >> 3);
        __syncthreads();
        if (MODE != 2) for (int e = F.tid; e < NEXP; e += 512) { const f32x4 vv = *(const f32x4*)(F.in[I_PV] + (size_t)e * D + c0); *(LAS v2u*)(F.lds + e * 8) = (v2u){pk2(vv.x, vv.y), pk2(vv.z, vv.w)}; }
        __syncthreads();
        if (MODE != 1) for (int mg = wave; mg < MX / 64; mg += NWAVES) {
            const unsigned* __restrict__ pg = plt + mg * 64;
            f32x4 acc = (f32x4){0.f, 0.f, 0.f, 0.f};
#pragma unroll 2
            for (int k0 = 0; k0 < 128; k0 += 8) {
                unsigned p[8];
#pragma unroll
                for (int i = 0; i < 8; ++i) p[i] = pg[(size_t)(k0 + i) * MX + lane];
#pragma unroll
                for (int i = 0; i < 8; ++i) { const v2u vv = *(const LAS v2u*)(unsigned)((p[i] & 0xffffu) << 3); const float cf = bf_hi(p[i]);
                    acc.x += cf * bf_lo(vv.x); acc.y += cf * bf_hi(vv.x); acc.z += cf * bf_lo(vv.y); acc.w += cf * bf_hi(vv.y); }
            }
            *(f32x4*)(po + (size_t)(mg * 64 + lane) * D + c0) = acc;
        }
    }
}
__device__ __forceinline__ void p12_final(Frame& F) {
    const float* mod = (const float*)(F.ws + WS_MOD); const float* ng3 = F.in[I_NG] + 3 * D; const float* po = (const float*)(F.ws + WS_PO);
    for (int m = F.bid * NWAVES + F.wave; m < MX; m += F.G * NWAVES) {
        const float* gt2 = mod + (m >> 12) * NMOD + 5 * D;
        f32x4 v[4]; float ss = 0.f;
#pragma unroll
        for (int j = 0; j < 4; ++j) { v[j] = *(const f32x4*)(po + (size_t)m * D + j * 256 + F.lane * 4); ss += v[j].x * v[j].x + v[j].y * v[j].y + v[j].z * v[j].z + v[j].w * v[j].w; }
        const float rstd = __builtin_amdgcn_rsqf(wave_sum(ss) * (1.f / D) + NORM_EPS);
#pragma unroll
        for (int j = 0; j < 4; ++j) { const int c = j * 256 + F.lane * 4; float* op = F.out + (size_t)m * D + c;
            const f32x4 x1 = *(const f32x4*)op, g = *(const f32x4*)(ng3 + c), gt = *(const f32x4*)(gt2 + c);
            *(f32x4*)op = x1 + gt * (v[j] * rstd * g); }
    }
}
struct Args { const float* in[25]; float* out; unsigned char* ws; int ph_lo, ph_hi; };
__global__ void __launch_bounds__(NWAVES * 64, 2) mk_fwd(Args args) {
    extern __shared__ __attribute__((aligned(16))) unsigned char lds_raw[];
    Frame F;
    F.lds = (LAS unsigned char*)lds_raw;
    F.MISC = (volatile LAS unsigned*)(F.lds + MISC_OFF);
    F.tid = threadIdx.x; F.lane = F.tid & 63; F.wave = __builtin_amdgcn_readfirstlane(F.tid >> 6);
    F.G = gridDim.x; F.bid = blockIdx.x;
#pragma unroll
    for (int i = 0; i < 25; ++i) F.in[i] = args.in[i];
    F.out = args.out; F.ws = args.ws; F.ctl = (gu32*)(args.ws + WS_CTL);
    for (int u = F.tid; u < (LDS_BYTES - LDSCTL_OFF) / 4; u += NWAVES * 64) ((LAS unsigned*)(F.lds + LDSCTL_OFF))[u] = 0u;
    __syncthreads();
    const int lo = args.ph_lo, hi = args.ph_hi;
    XcdBarrier bar; bar.bar = (unsigned*)(F.ctl + CW_BAR); bar.x = 0; bar.st = nullptr;
    if (hi - lo > 1) bar = xcd_barrier_post((unsigned*)(F.ctl + CW_BAR), F.MISC + 8);
#ifndef PROBE_LO
#define PROBE_LO -1
#define PROBE_HI -1
#endif
#define IN(k) (lo <= (k) && (k) < hi)
#define SEAM(k) do { if (IN(k) && IN((k) + 1)) xcd_barrier(bar); } while (0)
#define PH0 { p0_prep(F); }
#define PH1 { p1_hx(F); }
#define PH2 { pg8::Gemm g{(const pg8::bf16_t*)(F.ws + WS_HX), (const pg8::bf16_t*)(F.ws + WS_WINT), MA, NPROJ_PAD, D}; pg8::StaticOrder S; S.init(MA, NPROJ_PAD, F.G, F.bid); \
        pg8::EpiProj E{(pg8::bf16_t*)(F.ws + WS_PROJ), NPROJ, NPROJ}; \
        pg8::gemm_phase<pg8::EpiProj, pg8::StaticOrder, PG8_ALIGN, PG8_SP2>(F.lds, g, S, E); }
#define PH3 { p3_scan<0>(F, bar); }
#define PH4 { p4_mix(F); }
#define PH5 { pg8::Gemm g{(const pg8::bf16_t*)(F.ws + WS_HX), (const pg8::bf16_t*)(F.ws + WS_WOUTT), MX, D, D}; pg8::StaticOrder S; S.init(MX, D, F.G, F.bid); \
        pg8::EpiF32 E{(float*)(F.ws + WS_PROJ), D}; \
        pg8::gemm_phase<pg8::EpiF32, pg8::StaticOrder, PG8_ALIGN, PG8_SP2>(F.lds, g, S, E); }
#define PH6 { p6_mid(F); }
#define PH7 { pg8::Gemm g{(const pg8::bf16_t*)(F.ws + WS_HX), (const pg8::bf16_t*)(F.ws + WS_WEFFT), MX, NSC, D}; pg8::StaticOrder S; S.init(MX, NSC, F.G, F.bid); \
        pg8::EpiF32 E{(float*)(F.ws + WS_PROJ), NSC}; \
        pg8::gemm_phase<pg8::EpiF32, pg8::StaticOrder, PG8_ALIGN, PG8_SP2>(F.lds, g, S, E); }
#define PH8 { p8a_route(F); }
#define PH9 { p9_upass(F); }
#define PH10 { p10_combine(F); }
#define PH11 { p11_vpass<0>(F); }
#define PH12 { p12_final(F); }
#define PRB(k, body) if constexpr (PROBE_LO <= (k) && (k) <= PROBE_HI) { xcd_barrier(bar); body }
    if (IN(0)) PH0 PRB(0, PH0) SEAM(0);
    if (IN(1)) PH1 PRB(1, PH1) SEAM(1);
    if (IN(2)) PH2 PRB(2, PH2) SEAM(2);
    if (IN(3)) PH3 PRB(3, PH3) SEAM(3);
    if (IN(4)) PH4 PRB(4, PH4) SEAM(4);
    if (IN(5)) PH5 PRB(5, PH5) SEAM(5);
    if (IN(6)) PH6 PRB(6, PH6) SEAM(6);
    if (IN(7)) PH7 PRB(7, PH7) SEAM(7);
    if (IN(8)) PH8 PRB(8, PH8) SEAM(8);
    if (IN(9)) PH9 PRB(9, PH9) SEAM(9);
    if (IN(10)) PH10 PRB(10, PH10) SEAM(10);
    if constexpr (PROBE_LO == 111) { p11_vpass<1>(F); xcd_barrier(bar); }
    if constexpr (PROBE_LO == 112) { p11_vpass<2>(F); xcd_barrier(bar); }
    if (IN(11)) PH11 PRB(11, PH11) SEAM(11);
    if (IN(12)) PH12
#undef IN
#undef SEAM
}

extern "C" void kernel_launch(void* const* d_in, const int* in_sizes, int n_in, void* d_out, int out_size, void* d_ws, size_t ws_size, hipStream_t stream) {
    static int grid = 0;
    if (grid == 0) {
        if (n_in != 25 || in_sizes[0] != MX * D || out_size != MX * D || ws_size < WS_END) { fprintf(stderr, "kernel_launch: unexpected problem (n_in %d, in0 %d, out %d, ws %zu); nothing launched\n", n_in, n_in > 0 ? in_sizes[0] : -1, out_size, ws_size); grid = -1; return; }
        int dev = 0, cus = 0, per_cu = 0;
        if (hipGetDevice(&dev) != hipSuccess || hipDeviceGetAttribute(&cus, hipDeviceAttributeMultiprocessorCount, dev) != hipSuccess) { fprintf(stderr, "kernel_launch: device query failed\n"); grid = -1; return; }
        if (hipFuncSetAttribute((const void*)mk_fwd, hipFuncAttributeMaxDynamicSharedMemorySize, LDS_BYTES) != hipSuccess) { fprintf(stderr, "kernel_launch: hipFuncSetAttribute failed\n"); grid = -1; return; }
        if (hipOccupancyMaxActiveBlocksPerMultiprocessor(&per_cu, (const void*)mk_fwd, NWAVES * 64, LDS_BYTES) != hipSuccess || per_cu < 1) fprintf(stderr, "kernel_launch: occupancy query reports %d workgroups per CU\n", per_cu);
        (void)hipGetLastError();
        grid = cus;
    }
    if (grid < 0) return;
    if (hipMemsetAsync((char*)d_ws + WS_CTL, 0, CTL_ZERO_BYTES, stream) != hipSuccess) { fprintf(stderr, "kernel_launch: memset failed\n"); return; }
    Args a{};
    for (int i = 0; i < 25; ++i) a.in[i] = (const float*)d_in[i];
    a.out = (float*)d_out; a.ws = (unsigned char*)d_ws;
    if (MK_N_LAUNCHES == 1) { a.ph_lo = 0; a.ph_hi = NPH; hipLaunchKernelGGL(mk_fwd, dim3(grid), dim3(NWAVES * 64), LDS_BYTES, stream, a); }
    else for (int p = 0; p < NPH; ++p) { a.ph_lo = p; a.ph_hi = p + 1; hipLaunchKernelGGL(mk_fwd, dim3(grid), dim3(NWAVES * 64), LDS_BYTES, stream, a); }
    const hipError_t le = hipPeekAtLastError();
    if (le != hipSuccess) fprintf(stderr, "kernel_launch: launch failed: %s\n", hipGetErrorName(le));
}
```

```cpp
#include <hip/hip_runtime.h>
#include <cstdio>
#include <cstdint>
namespace pg8 {
#define PG8_LAS __attribute__((address_space(3)))
typedef unsigned short bf16_t;
typedef short bf16x8 __attribute__((ext_vector_type(8)));
typedef float f32x4 __attribute__((ext_vector_type(4)));
typedef unsigned u32x4 __attribute__((ext_vector_type(4)));
constexpr int BM = 256, BK = 64, HALF = 128, HTB = HALF * BK * 2  , STAGE_BYTES = 8 * HTB, NXCD = 8, WGM = 8;

__host__ __device__ __forceinline__ int lds_byte(int r, int c) { const int st = (r >> 4) * 2 + (c >> 5), rr = r & 15, cc = c & 31, ob = rr * 64 + cc * 2; return st * 1024 + (ob ^ (((ob >> 9) & 1) << 5)); }
__host__ __device__ __forceinline__ void stage_rc(int b, int& R, int& C) { const int st = b / 1024, sb = b % 1024, swz = sb ^ (((sb >> 9) & 1) << 5); R = (st >> 1) * 16 + swz / 64; C = (st & 1) * 32 + (swz % 64) / 2; }
__host__ __device__ __forceinline__ int perm32(int rho) { const int n = rho >> 4, i = rho & 15; return 8 * (i >> 2) + 4 * n + (i & 3); }

struct Unit { int pm, pn; };
struct Gemm { const bf16_t* A; const bf16_t* Bt; int M, N, K; };

struct StaticOrder {
    int nM, nN, nwg, G, c;
    __host__ __device__ void init(int M, int N, int G_, int c_) { nM = M / BM; nN = N / BM; nwg = nM * nN; G = G_; c = c_; }
    __host__ __device__ bool next(int i, Unit& u) const {
        const long L = (long)i * G + c; if (L >= nwg) return false;
        int wgid = (int)L; { const int q = nwg / NXCD, r = nwg % NXCD, xcd = wgid % NXCD, off = wgid / NXCD; wgid = (xcd < r ? xcd * (q + 1) : r * (q + 1) + (xcd - r) * q) + off; }
        const int nig = WGM * nN, gid = wgid / nig, fm = gid * WGM, gsz = (nM - fm) < WGM ? (nM - fm) : WGM;
        u.pm = fm + ((wgid % nig) % gsz); u.pn = (wgid % nig) / gsz; return true;
    }
    __device__ __forceinline__ void a_ready(const Unit&) const {}
    __device__ __forceinline__ void done(const Unit&) const {}
};

__device__ __forceinline__ unsigned cvt_pk_bf16(float lo, float hi) { unsigned r; asm volatile("v_cvt_pk_bf16_f32 %0, %1, %2" : "=v"(r) : "v"(lo), "v"(hi)); return r; }
typedef float f32x2 __attribute__((ext_vector_type(2)));
__device__ __forceinline__ f32x2 gelu_pk(f32x2 v) {
    const f32x2 av = __builtin_elementwise_abs(v), d = av * 0.2316418882f + 1.0f;
    f32x2 t; t.x = __builtin_amdgcn_rcpf(d.x); t.y = __builtin_amdgcn_rcpf(d.y);
    f32x2 q = t * 0.5307027145f + (-0.7265760135f); q = q * t + 0.7107068705f; q = q * t + (-0.142248368f); q = q * t + 0.127414796f; q = q * t;
    const f32x2 s = (v * v) * (-0.72134752044f);
    f32x2 e; e.x = __builtin_amdgcn_exp2f(s.x); e.y = __builtin_amdgcn_exp2f(s.y);
    const f32x2 m = v * (q * e), r = v - m;
    f32x2 o; o.x = v.x < 0.f ? m.x : r.x; o.y = v.y < 0.f ? m.y : r.y; return o;
}

template <int ACT  > struct EpiBf16 {
    static constexpr bool PERM = true, AFTER_DRAIN = false; static_assert(ACT == 0 || ACT == 1, "EpiBf16: ACT is 0 (none) or 1 (gelu_pk)");
    bf16_t* O; int ldc; const float* bias; int split_cols; size_t split_stride; float scale0;
    __device__ __forceinline__ void operator()(const f32x4 (&acc)[2][2][4][2], const Unit& u, int wr, int wc, int fr, int fq) const {
        const int row0 = u.pm * BM + wr * 64 + fr; int colt = u.pn * BM; bf16_t* base = O;
        float sc = 1.f; if (split_cols) { const int t = colt / split_cols; base += (size_t)t * split_stride; colt -= t * split_cols; if (t == 0) sc = scale0; }
        const int col0 = colt + wc * 32 + 8 * fq, bcol0 = u.pn * BM + wc * 32 + 8 * fq;
        f32x4 bv[2][2];
#pragma unroll
        for (int bj = 0; bj < 2; ++bj)
#pragma unroll
            for (int n = 0; n < 2; ++n) bv[bj][n] = bias ? *(const f32x4*)(bias + bcol0 + bj * HALF + 4 * n) : (f32x4){0.f, 0.f, 0.f, 0.f};
#pragma unroll
        for (int ai = 0; ai < 2; ++ai)
#pragma unroll
            for (int m = 0; m < 4; ++m) { bf16_t* rowp = base + (size_t)(row0 + ai * HALF + m * 16) * ldc + col0;
#pragma unroll
                for (int bj = 0; bj < 2; ++bj) { f32x4 v0 = acc[ai][bj][m][0] + bv[bj][0], v1 = acc[ai][bj][m][1] + bv[bj][1];
                    if (ACT == 1) { f32x2 a = gelu_pk((f32x2){v0[0], v0[1]}), b = gelu_pk((f32x2){v0[2], v0[3]}), c = gelu_pk((f32x2){v1[0], v1[1]}), d = gelu_pk((f32x2){v1[2], v1[3]});
                        v0 = (f32x4){a.x, a.y, b.x, b.y}; v1 = (f32x4){c.x, c.y, d.x, d.y}; }
                    v0 = v0 * sc; v1 = v1 * sc; u32x4 w; w.x = cvt_pk_bf16(v0[0], v0[1]); w.y = cvt_pk_bf16(v0[2], v0[3]); w.z = cvt_pk_bf16(v1[0], v1[1]); w.w = cvt_pk_bf16(v1[2], v1[3]);
                    *(u32x4*)(rowp + bj * HALF) = w; } }
    }
};

struct EpiF32 {
    static constexpr bool PERM = false, AFTER_DRAIN = false;
    float* C; int ldc;
    __device__ __forceinline__ void operator()(const f32x4 (&acc)[2][2][4][2], const Unit& u, int wr, int wc, int fr, int fq) const {
        const int row0 = u.pm * BM + wr * 64 + fr, col0 = u.pn * BM + wc * 32 + 4 * fq;
#pragma unroll
        for (int ai = 0; ai < 2; ++ai)
#pragma unroll
            for (int m = 0; m < 4; ++m) { float* rowp = C + (size_t)(row0 + ai * HALF + m * 16) * ldc + col0;
#pragma unroll
                for (int bj = 0; bj < 2; ++bj)
#pragma unroll
                    for (int n = 0; n < 2; ++n) *(f32x4*)(rowp + bj * HALF + n * 16) = acc[ai][bj][m][n]; }
    }
};
struct EpiProj {
    static constexpr bool PERM = true, AFTER_DRAIN = false;
    bf16_t* O; int ldc; int ncols;
    __device__ __forceinline__ void operator()(const f32x4 (&acc)[2][2][4][2], const Unit& u, int wr, int wc, int fr, int fq) const {
        const int row0 = u.pm * BM + wr * 64 + fr; const int col0 = u.pn * BM + wc * 32 + 8 * fq;
#pragma unroll
        for (int ai = 0; ai < 2; ++ai)
#pragma unroll
            for (int m = 0; m < 4; ++m) { bf16_t* rowp = O + (size_t)(row0 + ai * HALF + m * 16) * ldc + col0;
#pragma unroll
                for (int bj = 0; bj < 2; ++bj) { const f32x4 v0 = acc[ai][bj][m][0], v1 = acc[ai][bj][m][1];
                    u32x4 w; w.x = cvt_pk_bf16(v0[0], v0[1]); w.y = cvt_pk_bf16(v0[2], v0[3]); w.z = cvt_pk_bf16(v1[0], v1[1]); w.w = cvt_pk_bf16(v1[2], v1[3]);
                    if (col0 + bj * HALF < ncols) *(u32x4*)(rowp + bj * HALF) = w; } }
    }
};
template <class Epi, class Sched, bool ALIGN_EPI = false, bool SP2 = false>
__device__ __forceinline__ void gemm_phase(PG8_LAS unsigned char* lds, const Gemm g, const Sched& S, const Epi& E) {
    const int tid = threadIdx.x, wid = __builtin_amdgcn_readfirstlane(tid >> 6), lane = tid & 63, wr = wid >> 2, wc = wid & 3, fr = lane & 15, fq = lane >> 4;
    const int K = g.K, nt = K / BK;
    unsigned voffA[2], voffB[2];
#pragma unroll
    for (int i = 0; i < 2; ++i) { int R, C; stage_rc(tid * 16 + i * 8192, R, C); const int Rb = Epi::PERM ? ((R & ~31) + perm32(R & 31)) : R;
        voffA[i] = (unsigned)(R * K + C) * 2u; voffB[i] = (unsigned)(Rb * K + C) * 2u; }
    const size_t kstep = (size_t)(BK * 2);
    const size_t hstep = (size_t)HALF * K * 2;
    const size_t tstep = 2 * hstep;
    const unsigned ldsw = (unsigned)wid * 1024u;
    const int aoff = lds_byte(wr * 64 + fr, fq * 8), boff = lds_byte(wc * 32 + fr, fq * 8);
#define PG8_SA(b, h) (((b) * 2 + (h)) * HTB)
#define PG8_SB(b, h) ((4 + (b) * 2 + (h)) * HTB)
#define PG8_STAGE(bufoff, gbase, voff) do { _Pragma("unroll") for (int _i = 0; _i < 2; ++_i) \
        __builtin_amdgcn_global_load_lds((const unsigned*)((const char*)(gbase) + (voff)[_i]), (PG8_LAS unsigned*)(lds + (bufoff) + ldsw + _i * 8192), 16, 0, 0); } while (0)
#define PG8_LDA(dst, b, h) do { _Pragma("unroll") for (int m = 0; m < 4; ++m) _Pragma("unroll") for (int k = 0; k < 2; ++k) dst[m][k] = *(const PG8_LAS bf16x8*)(lds + PG8_SA(b, h) + aoff + m * 2048 + k * 1024); } while (0)
#define PG8_LDB(dst, b, h) do { _Pragma("unroll") for (int n = 0; n < 2; ++n) _Pragma("unroll") for (int k = 0; k < 2; ++k) dst[n][k] = *(const PG8_LAS bf16x8*)(lds + PG8_SB(b, h) + boff + n * 2048 + k * 1024); } while (0)
#define PG8_MMA(ai, bj, At, Bt) do { __builtin_amdgcn_s_setprio(1); _Pragma("unroll") for (int m = 0; m < 4; ++m) _Pragma("unroll") for (int n = 0; n < 2; ++n) _Pragma("unroll") for (int k = 0; k < 2; ++k) \
        acc[ai][bj][m][n] = __builtin_amdgcn_mfma_f32_16x16x32_bf16(Bt[n][k], At[m][k], acc[ai][bj][m][n], 0, 0, 0); __builtin_amdgcn_s_setprio(0); } while (0)
#define PG8_WAIT_V(n) asm volatile("s_waitcnt vmcnt(" #n ")" ::: "memory")
#define PG8_WAIT_L(n) asm volatile("s_waitcnt lgkmcnt(" #n ")" ::: "memory")
#define PG8_BAR __builtin_amdgcn_s_barrier()
#define PG8_SCHED __builtin_amdgcn_sched_barrier(0)
    Unit cur, nxt; int ui = 0;
    if (!S.next(0, cur)) return;
    f32x4 acc[2][2][4][2];
#pragma unroll
    for (int a = 0; a < 2; ++a)
#pragma unroll
        for (int b = 0; b < 2; ++b)
#pragma unroll
            for (int m = 0; m < 4; ++m)
#pragma unroll
                for (int n = 0; n < 2; ++n) acc[a][b][m][n] = (f32x4){0.f, 0.f, 0.f, 0.f};
    bf16x8 At[4][2], B0[2][2], B1[2][2];
    const char* cA = (const char*)g.A + (size_t)cur.pm * tstep; const char* cB = (const char*)g.Bt + (size_t)cur.pn * tstep;
    S.a_ready(cur);
    if constexpr (SP2) {
        PG8_STAGE(PG8_SB(0, 0), cB, voffB); PG8_STAGE(PG8_SB(0, 1), cB + hstep, voffB); PG8_STAGE(PG8_SA(0, 0), cA, voffA); PG8_STAGE(PG8_SA(0, 1), cA + hstep, voffA);
        if (wr == 1) PG8_BAR;
        PG8_WAIT_V(2); PG8_BAR;
        PG8_STAGE(PG8_SB(1, 0), cB + kstep, voffB); PG8_STAGE(PG8_SA(1, 0), cA + kstep, voffA); PG8_STAGE(PG8_SB(1, 1), cB + hstep + kstep, voffB);
        PG8_WAIT_V(6); PG8_BAR;
    } else {
        PG8_STAGE(PG8_SB(0, 0), cB, voffB); PG8_STAGE(PG8_SA(0, 0), cA, voffA); PG8_STAGE(PG8_SB(0, 1), cB + hstep, voffB); PG8_STAGE(PG8_SA(0, 1), cA + hstep, voffA);
        if (wr == 1) PG8_BAR;
        PG8_WAIT_V(4); PG8_BAR;
        PG8_STAGE(PG8_SB(1, 0), cB + kstep, voffB); PG8_STAGE(PG8_SA(1, 0), cA + kstep, voffA); PG8_STAGE(PG8_SB(1, 1), cB + hstep + kstep, voffB);
        PG8_WAIT_V(6); PG8_BAR;
    }
    for (;;) {
        const bool has_next = S.next(ui + 1, nxt);
        const char* nA = has_next ? (const char*)g.A + (size_t)nxt.pm * tstep : cA; const char* nB = has_next ? (const char*)g.Bt + (size_t)nxt.pn * tstep : cB;
        for (int t = 0; t < nt; t += 2) {
            const bool last = (t == nt - 2);
            const char* a1 = cA + (size_t)(t + 1) * kstep;
            const char* a2 = last ? nA : cA + (size_t)(t + 2) * kstep; const char* b2 = last ? nB : cB + (size_t)(t + 2) * kstep;
            const char* a3 = a2 + kstep; const char* b3 = b2 + kstep;
            if (last && has_next) S.a_ready(nxt);
            if constexpr (SP2) {
            PG8_LDB(B0, 0, 0); PG8_LDB(B1, 0, 1); PG8_SCHED; PG8_LDA(At, 0, 0); PG8_STAGE(PG8_SA(1, 1), a1 + hstep, voffA);
            PG8_WAIT_V(8); PG8_WAIT_L(0); PG8_BAR; PG8_MMA(0, 0, At, B0); PG8_MMA(0, 1, At, B1); PG8_BAR; PG8_SCHED;
            PG8_LDA(At, 0, 1); PG8_STAGE(PG8_SB(0, 0), b2, voffB); PG8_STAGE(PG8_SB(0, 1), b2 + hstep, voffB); PG8_STAGE(PG8_SA(0, 0), a2, voffA);
            PG8_WAIT_V(8); PG8_WAIT_L(0); PG8_BAR; PG8_MMA(1, 0, At, B0); PG8_MMA(1, 1, At, B1); PG8_BAR; PG8_SCHED;
            PG8_LDB(B0, 1, 0); PG8_LDB(B1, 1, 1); PG8_SCHED; PG8_LDA(At, 1, 0); PG8_STAGE(PG8_SA(0, 1), a2 + hstep, voffA);
            PG8_WAIT_V(8); PG8_WAIT_L(0); PG8_BAR; PG8_MMA(0, 0, At, B0); PG8_MMA(0, 1, At, B1); PG8_BAR; PG8_SCHED;
            PG8_LDA(At, 1, 1); PG8_STAGE(PG8_SB(1, 0), b3, voffB); PG8_STAGE(PG8_SB(1, 1), b3 + hstep, voffB); PG8_STAGE(PG8_SA(1, 0), a3, voffA);
            PG8_WAIT_V(8); PG8_WAIT_L(0); PG8_BAR; PG8_MMA(1, 0, At, B0); PG8_MMA(1, 1, At, B1); PG8_BAR; PG8_SCHED;
            } else {
            PG8_LDB(B0, 0, 0); PG8_SCHED; PG8_LDA(At, 0, 0); PG8_STAGE(PG8_SA(1, 1), a1 + hstep, voffA);
            PG8_WAIT_L(8); PG8_BAR; PG8_WAIT_L(0); PG8_MMA(0, 0, At, B0); PG8_BAR; PG8_SCHED;
            PG8_LDB(B1, 0, 1); PG8_STAGE(PG8_SB(0, 0), b2, voffB);
            PG8_BAR; PG8_WAIT_L(0); PG8_MMA(0, 1, At, B1); PG8_BAR;
            PG8_LDA(At, 0, 1); PG8_STAGE(PG8_SA(0, 0), a2, voffA);
            PG8_BAR; PG8_WAIT_L(0); PG8_MMA(1, 0, At, B0); PG8_BAR; PG8_SCHED;
            PG8_STAGE(PG8_SB(0, 1), b2 + hstep, voffB);
            PG8_WAIT_V(6); PG8_BAR; PG8_MMA(1, 1, At, B1); PG8_BAR;
            PG8_LDB(B0, 1, 0); PG8_SCHED; PG8_LDA(At, 1, 0); PG8_STAGE(PG8_SA(0, 1), a2 + hstep, voffA);
            PG8_WAIT_L(8); PG8_BAR; PG8_WAIT_L(0); PG8_MMA(0, 0, At, B0); PG8_BAR; PG8_SCHED;
            PG8_LDB(B1, 1, 1); PG8_STAGE(PG8_SB(1, 0), b3, voffB);
            PG8_BAR; PG8_WAIT_L(0); PG8_MMA(0, 1, At, B1); PG8_BAR;
            PG8_LDA(At, 1, 1); PG8_STAGE(PG8_SA(1, 0), a3, voffA);
            PG8_BAR; PG8_WAIT_L(0); PG8_MMA(1, 0, At, B0); PG8_BAR; PG8_SCHED;
            PG8_STAGE(PG8_SB(1, 1), b3 + hstep, voffB);
            PG8_WAIT_V(6); PG8_BAR; PG8_MMA(1, 1, At, B1); PG8_BAR;
            }
        }
        if constexpr (ALIGN_EPI) { if (wr == 0) PG8_BAR; }
        if constexpr (!Epi::AFTER_DRAIN) { E(acc, cur, wr, wc, fr, fq); S.done(cur); }
        if (!has_next) break;
#pragma unroll
        for (int a = 0; a < 2; ++a)
#pragma unroll
            for (int b = 0; b < 2; ++b)
#pragma unroll
                for (int m = 0; m < 4; ++m)
#pragma unroll
                    for (int n = 0; n < 2; ++n) acc[a][b][m][n] = (f32x4){0.f, 0.f, 0.f, 0.f};
        cur = nxt; cA = nA; cB = nB; ++ui;
        if constexpr (ALIGN_EPI) { if (wr == 1) PG8_BAR; }
    }
    PG8_WAIT_V(0);
    if constexpr (!ALIGN_EPI) { if (wr == 0) PG8_BAR; }
    PG8_BAR;
    if constexpr (Epi::AFTER_DRAIN) { E.fused(acc, cur, wr, wc, fr, fq, lds, wid, lane); S.done(cur); }
#undef PG8_SA
#undef PG8_SB
#undef PG8_STAGE
#undef PG8_LDA
#undef PG8_LDB
#undef PG8_MMA
#undef PG8_WAIT_V
#undef PG8_WAIT_L
#undef PG8_BAR
#undef PG8_SCHED
}
}
#ifndef PG8_SP2
#define PG8_SP2 true
#endif
#ifndef PG8_ALIGN
#define PG8_ALIGN true
#endif
constexpr int NWAVES = 8;
constexpr int D = 1024, NB = 4, T = 4096, TC = 256;
constexpr int MX = NB * T, MC = NB * TC, MA = MX + MC;
constexpr int NPROJ = 3456, NPROJ_PAD = 3584;
constexpr int COL_XB = 0, COL_XG = 512, COL_XC = 1024, COL_R = 1536, COL_K = 2048, COL_V = 2560, COL_G = 3072, COL_LW = 3200, COL_LA = 3328;
constexpr int NMOD = 6 * D;
constexpr int NEXP = 16384, NSC = 2048;
constexpr float NORM_EPS = 1e-6f, LNX_EPS = 64e-5f;
#ifndef MK_N_LAUNCHES
#define MK_N_LAUNCHES 1
#endif
constexpr int NPH = 13;
constexpr size_t MiB = 1u << 20;
constexpr size_t WS_CTL = 0, CTL_ZERO_BYTES = 64 * 1024;
constexpr size_t WS_MOD = 3 * MiB;
constexpr size_t WS_WINT = 6 * MiB;
constexpr size_t WS_WOUTT = 13 * MiB;
constexpr size_t WS_WEFFT = 15 * MiB;
constexpr size_t WS_U = 20 * MiB, WS_V = 52 * MiB;
constexpr size_t WS_HX = 84 * MiB;
constexpr size_t WS_PROJ = 118 * MiB;
constexpr size_t WS_END = 246 * MiB;
constexpr size_t WS_EXL = WS_V, WS_GL = WS_V + 4 * MiB, WS_PL = WS_V + 12 * MiB;
constexpr size_t WS_BLOB0 = WS_V, WS_BLOB1 = WS_HX;
constexpr size_t WS_PART = WS_PROJ, WS_PO = WS_PROJ + 64 * MiB;
static_assert(WS_PROJ + (size_t)MA * NPROJ * 2 <= WS_END && WS_PROJ + (size_t)MX * NSC * 4 <= WS_END && WS_HX + (size_t)MA * D * 2 <= WS_PROJ, "d_ws map");
constexpr int CW_BAR = 1024;
constexpr int RING_BYTES = 131072;
constexpr int LDSCTL_OFF = RING_BYTES, MISC_OFF = LDSCTL_OFF + 320;
constexpr int LDS_BYTES = 147456;

#define GAS __attribute__((address_space(1)))
#define LAS __attribute__((address_space(3)))
typedef unsigned short bf16;
typedef unsigned v4u __attribute__((ext_vector_type(4)));
typedef unsigned v2u __attribute__((ext_vector_type(2)));
typedef float f32x4 __attribute__((ext_vector_type(4)));
typedef float f32x2 __attribute__((ext_vector_type(2)));
typedef float f32x16 __attribute__((ext_vector_type(16)));
typedef short bf16x8 __attribute__((ext_vector_type(8)));
typedef GAS unsigned gu32;
#define RLX_AGENT __ATOMIC_RELAXED, __HIP_MEMORY_SCOPE_AGENT
#define LDS_WAIT() asm volatile("s_waitcnt lgkmcnt(0)" ::: "memory")
#define VM_WAIT() asm volatile("s_waitcnt vmcnt(0)" ::: "memory")
typedef __bf16 bf16v2 __attribute__((ext_vector_type(2)));
__device__ __forceinline__ unsigned pk2(float lo, float hi) { const f32x2 v = {lo, hi}; return __builtin_bit_cast(unsigned, __builtin_convertvector(v, bf16v2)); }
__device__ __forceinline__ float bf_lo(unsigned w) { return __builtin_bit_cast(float, w << 16); }
__device__ __forceinline__ float bf_hi(unsigned w) { return __builtin_bit_cast(float, w & 0xffff0000u); }
__device__ __forceinline__ float bf1(bf16 b) { return __builtin_bit_cast(float, (unsigned)b << 16); }
__device__ __forceinline__ float fast_exp(float x) { return __builtin_amdgcn_exp2f(x * 1.44269504089f); }
__device__ __forceinline__ float fast_rcp(float x) { return __builtin_amdgcn_rcpf(x); }
__device__ __forceinline__ float sigmoidf(float x) { return fast_rcp(1.f + fast_exp(-x)); }
__device__ __forceinline__ float tanh_fast(float x) { return 1.f - 2.f * fast_rcp(fast_exp(2.f * x) + 1.f); }
__device__ __forceinline__ float siluf(float x) { return x * sigmoidf(x); }
template <int CTRL> __device__ __forceinline__ float dppf(float x) { return __builtin_bit_cast(float, __builtin_amdgcn_update_dpp(0, __builtin_bit_cast(int, x), CTRL, 0xF, 0xF, false)); }
template <int CTRL> __device__ __forceinline__ unsigned dppu(unsigned x) { return (unsigned)__builtin_amdgcn_update_dpp(0, (int)x, CTRL, 0xF, 0xF, false); }
__device__ __forceinline__ float rowsum16(float x) { x += dppf<0xB1>(x); x += dppf<0x4E>(x); x += dppf<0x141>(x); x += dppf<0x140>(x); return x; }
__device__ __forceinline__ float wave_sum(float v) {
    v = rowsum16(v); v += __shfl_xor(v, 16); v += __shfl_xor(v, 32); return v;
}
__device__ __forceinline__ float half_sum32(float v) { v = rowsum16(v); v += __shfl_xor(v, 16); return v; }
__device__ __forceinline__ unsigned umaxu(unsigned a, unsigned b) { return a > b ? a : b; }
__device__ __forceinline__ unsigned wave_max_u32(unsigned x) {
    x = umaxu(x, dppu<0xB1>(x)); x = umaxu(x, dppu<0x4E>(x)); x = umaxu(x, dppu<0x141>(x)); x = umaxu(x, dppu<0x140>(x));
    const unsigned a = __builtin_amdgcn_readlane((int)x, 0), b = __builtin_amdgcn_readlane((int)x, 16), c = __builtin_amdgcn_readlane((int)x, 32), d = __builtin_amdgcn_readlane((int)x, 48);
    return umaxu(umaxu(a, b), umaxu(c, d));
}
__device__ __forceinline__ unsigned f2key(float f) { const unsigned u = __builtin_bit_cast(unsigned, f); return (u & 0x80000000u) ? ~u : (u | 0x80000000u); }
__device__ __forceinline__ float key2f(unsigned k) { const unsigned u = (k & 0x80000000u) ? (k ^ 0x80000000u) : ~k; return __builtin_bit_cast(float, u); }
#define XB_TMO      128
#define XB_XCNT(j)  (256  + 64 * (j))
#define XB_XSUB(j)  (1280 + 64 * (j))
#define XB_XGEN(j)  (2304 + 64 * (j))
#define XB_TOP      3328
#define XB_TOPGEN   3392
#define XCD_BAR_WORDS 3456
#define XB_SPIN_CAP (1u << 18)

__device__ __forceinline__ unsigned xb_ld(unsigned* p)              { return __hip_atomic_load(p, __ATOMIC_RELAXED, __HIP_MEMORY_SCOPE_AGENT); }
__device__ __forceinline__ unsigned xb_add(unsigned* p, unsigned v) { return __hip_atomic_fetch_add(p, v, __ATOMIC_RELAXED, __HIP_MEMORY_SCOPE_AGENT); }
__device__ __forceinline__ unsigned xb_xcc_id() { return (unsigned)__builtin_amdgcn_s_getreg((3 << 11) | 20) & 0xFu; }
#define XB_SPIN(cond, bar) do { unsigned _sp = 0; while (cond) { __builtin_amdgcn_s_sleep(1); \
    if ((++_sp & 255u) == 0u) { if (xb_ld(&(bar)[XB_TMO])) break; if (_sp > XB_SPIN_CAP) { atomicAdd(&(bar)[XB_TMO], 1u); break; } } } } while (0)

struct XcdBarrier {
    unsigned* bar; unsigned x;
    volatile LAS unsigned* st;
};

__device__ __forceinline__ XcdBarrier xcd_barrier_post(unsigned* bar, volatile LAS unsigned* st) {
    XcdBarrier b; b.bar = bar; b.x = xb_xcc_id(); b.st = st;
    if (threadIdx.x == 0) (void)xb_add(&bar[XB_XCNT(b.x)], 1u);
    return b;
}
__device__ __forceinline__ void xcd_barrier_complete(unsigned* bar, unsigned x, unsigned& nloc, unsigned& nx) {
    const unsigned G = gridDim.x * gridDim.y * gridDim.z;
    unsigned sum, cnt, mine, sp = 0u;
    for (;;) {
        sum = 0u; cnt = 0u; mine = 0u;
#pragma unroll
        for (unsigned j = 0; j < 16; ++j) { const unsigned c = xb_ld(&bar[XB_XCNT(j)]); sum += c; cnt += (c > 0u) ? 1u : 0u; mine = (j == x) ? c : mine; }
        if (sum == G) break;
        __builtin_amdgcn_s_sleep(1);
        if ((++sp & 255u) == 0u) { if (xb_ld(&bar[XB_TMO])) break; if (sp > XB_SPIN_CAP) { atomicAdd(&bar[XB_TMO], 1u); break; } }
    }
    nloc = mine > 0u ? mine : 1u; nx = cnt > 0u ? cnt : 1u;
}

__device__ __forceinline__ void xcd_barrier(const XcdBarrier& b) {
    asm volatile("s_waitcnt vmcnt(0)" ::: "memory");
    __syncthreads();
    if (threadIdx.x == 0) {
        unsigned* bar = b.bar;
        __builtin_amdgcn_s_waitcnt(0);
        unsigned nloc = b.st[0], nx = b.st[1];
        if (nloc == 0u) { xcd_barrier_complete(bar, b.x, nloc, nx); b.st[0] = nloc; b.st[1] = nx; }
        const unsigned old = xb_add(&bar[XB_XSUB(b.x)], 1u);
        const unsigned gen = old / nloc;
        if (old + 1u == (gen + 1u) * nloc) {
            __builtin_amdgcn_fence(__ATOMIC_RELEASE, "agent");
            asm volatile("s_waitcnt vmcnt(0)" ::: "memory");
            const unsigned og = xb_add(&bar[XB_TOP], 1u);
            const unsigned tg = og / nx;
            if (og + 1u == (tg + 1u) * nx) xb_add(&bar[XB_TOPGEN], 1u);
            else XB_SPIN(xb_ld(&bar[XB_TOPGEN]) == tg, bar);
            __builtin_amdgcn_fence(__ATOMIC_ACQUIRE, "agent");
            xb_add(&bar[XB_XGEN(b.x)], 1u);
            asm volatile("s_waitcnt vmcnt(0)" ::: "memory");
        } else {
            XB_SPIN(xb_ld(&bar[XB_XGEN(b.x)]) == gen, bar);
            __builtin_amdgcn_fence(__ATOMIC_ACQUIRE, "agent");
            asm volatile("s_waitcnt vmcnt(0)" ::: "memory");
        }
    }
    __syncthreads();
}
struct Frame {
    LAS unsigned char* lds;
    volatile LAS unsigned* MISC;
    gu32* ctl;
    int tid, lane, wave, G, bid;
    const float* in[25];
    float* out;
    unsigned char* ws;
};
enum { I_X = 0, I_C, I_CTX, I_CCTX, I_WMOD, I_BMOD, I_NG, I_WIN, I_WOUT, I_CONVW, I_TMU, I_DW0, I_DW2, I_A0, I_A2, I_GW2, I_KK, I_KA, I_RK, I_LNG, I_LNB, I_WQ, I_SUBK, I_PU, I_PV };

__device__ __forceinline__ void p0_transpose_item(const float* W, int K, int N, bf16* WT, LAS float* scr, int item, int lane) {
    const int nblk = N / 32, kb = item / nblk, nb = item % nblk, k0 = 64 * kb, n0 = 32 * nb;
#pragma unroll 8
    for (int i = 0; i < 32; ++i) { const int kk = 2 * i + (lane >> 5); scr[kk * 33 + (lane & 31)] = W[(size_t)(k0 + kk) * N + n0 + (lane & 31)]; }
    LDS_WAIT(); asm volatile("" ::: "memory");
    const int c = lane & 7;
#pragma unroll
    for (int j = 0; j < 4; ++j) { const int n = (lane >> 3) + 8 * j; const LAS float* s = scr + (8 * c) * 33 + n;
        v4u o; o.x = pk2(s[0 * 33], s[1 * 33]); o.y = pk2(s[2 * 33], s[3 * 33]); o.z = pk2(s[4 * 33], s[5 * 33]); o.w = pk2(s[6 * 33], s[7 * 33]);
        *(v4u*)(WT + (size_t)(n0 + n) * K + k0 + 8 * c) = o; }
    LDS_WAIT(); asm volatile("" ::: "memory");
}
__device__ __forceinline__ void p0_mod_item(Frame& F, int cb) {
    LAS float* S = (LAS float*)F.lds;
    LAS float* RED = (LAS float*)(F.lds + 32768);
    const float* c = F.in[I_C]; const float* cc = F.in[I_CCTX];
    for (int i = F.tid; i < 5 * D; i += 512) { const int r = i >> 10, k = i & 1023; const float v = (r < 4) ? c[r * D + k] : cc[k]; S[i] = siluf(v); }
    __syncthreads();
    const int col = F.tid & 63, kg = F.tid >> 6;
    const float* wp = F.in[I_WMOD] + (size_t)(kg * 128) * NMOD + cb * 64 + col;
    float a0 = 0.f, a1 = 0.f, a2 = 0.f, a3 = 0.f, a4 = 0.f;
#pragma unroll 8
    for (int k = 0; k < 128; ++k) { const float w = wp[(size_t)k * NMOD]; const int kk = kg * 128 + k;
        a0 += S[kk] * w; a1 += S[D + kk] * w; a2 += S[2 * D + kk] * w; a3 += S[3 * D + kk] * w; a4 += S[4 * D + kk] * w; }
    RED[(kg * 5 + 0) * 64 + col] = a0; RED[(kg * 5 + 1) * 64 + col] = a1; RED[(kg * 5 + 2) * 64 + col] = a2; RED[(kg * 5 + 3) * 64 + col] = a3; RED[(kg * 5 + 4) * 64 + col] = a4;
    __syncthreads();
    if (F.tid < 320) { const int r = F.tid >> 6, cl = F.tid & 63; float s = F.in[I_BMOD][cb * 64 + cl];
#pragma unroll
        for (int g = 0; g < 8; ++g) s += RED[(g * 5 + r) * 64 + cl];
        ((float*)(F.ws + WS_MOD))[r * NMOD + cb * 64 + cl] = s; }
    __syncthreads();
}
__device__ __forceinline__ void p0_weff_item(Frame& F, int item) {
    const int hs = item >> 4, kb = item & 15;
    LAS float* SK = (LAS float*)F.lds;
    LAS float* WQ = (LAS float*)(F.lds + 128 * 132 * 4);
    const float* sk = F.in[I_SUBK] + (size_t)hs * 128 * 128;
    const float* wq = F.in[I_WQ] + (size_t)(kb * 64) * 2048 + hs * 128;
#pragma unroll
    for (int i = 0; i < 8; ++i) { const int idx = F.tid + 512 * i, row = idx >> 5, c4 = idx & 31; const f32x4 v = *(const f32x4*)(sk + row * 128 + c4 * 4); *(LAS f32x4*)(SK + row * 132 + c4 * 4) = v; }
#pragma unroll
    for (int i = 0; i < 4; ++i) { const int idx = F.tid + 512 * i, row = idx >> 5, c4 = idx & 31; const f32x4 v = *(const f32x4*)(wq + (size_t)row * 2048 + c4 * 4); *(LAS f32x4*)(WQ + row * 132 + c4 * 4) = v; }
    __syncthreads();
    const int key = F.tid >> 2, kq = F.tid & 3;
    float acc[16];
#pragma unroll
    for (int i = 0; i < 16; ++i) acc[i] = 0.f;
    for (int d = 0; d < 128; d += 4) {
        const f32x4 a = *(const LAS f32x4*)(SK + key * 132 + d);
#pragma unroll
        for (int i = 0; i < 16; ++i) { const f32x4 b = *(const LAS f32x4*)(WQ + (4 * i + kq) * 132 + d); acc[i] += a.x * b.x + a.y * b.y + a.z * b.z + a.w * b.w; }
    }
    bf16* dst = (bf16*)(F.ws + WS_WEFFT) + (size_t)(hs * 128 + key) * D + kb * 64;
#pragma unroll
    for (int i = 0; i < 16; ++i) dst[4 * i + kq] = (bf16)(pk2(acc[i], 0.f) & 0xffffu);
    __syncthreads();
}
__device__ __forceinline__ void p0_prep(Frame& F) {
    for (int it = F.bid; it < 96 + 256; it += F.G) { if (it < 96) p0_mod_item(F, it); else p0_weff_item(F, it - 96); }
    LAS float* scr = (LAS float*)(F.lds + F.wave * 16384);
    const int gw = F.bid * NWAVES + F.wave, NGW = F.G * NWAVES;
    constexpr int I_IN = (D / 64) * (NPROJ / 32), I_OUT = (D / 64) * (D / 32);
    for (int it = gw; it < I_IN + I_OUT; it += NGW) {
        if (it < I_IN) p0_transpose_item(F.in[I_WIN], D, NPROJ, (bf16*)(F.ws + WS_WINT), scr, it, F.lane);
        else p0_transpose_item(F.in[I_WOUT], D, D, (bf16*)(F.ws + WS_WOUTT), scr, it - I_IN, F.lane);
    }
    { v4u* z = (v4u*)((bf16*)(F.ws + WS_WINT) + (size_t)NPROJ * D); const int n16 = (NPROJ_PAD - NPROJ) * D * 2 / 16;
      for (int i = F.bid * 512 + F.tid; i < n16; i += F.G * 512) z[i] = (v4u){0u, 0u, 0u, 0u}; }
    { const f32x4* pu = (const f32x4*)F.in[I_PU]; v4u* du = (v4u*)(F.ws + WS_U);
      const int n8 = NEXP * D / 8;
      for (int i = F.bid * 512 + F.tid; i < n8; i += F.G * 512) {
          const f32x4 a0 = pu[2 * i], a1 = pu[2 * i + 1];
          du[i] = (v4u){pk2(a0.x, a0.y), pk2(a0.z, a0.w), pk2(a1.x, a1.y), pk2(a1.z, a1.w)}; } }
}

__device__ __forceinline__ void p1_hx(Frame& F) {
    const float* mod = (const float*)(F.ws + WS_MOD); const float* ng = F.in[I_NG];
    bf16* hx = (bf16*)(F.ws + WS_HX);
    for (int m = F.bid * NWAVES + F.wave; m < MA; m += F.G * NWAVES) {
        const float* src = (m < MX) ? F.in[I_X] + (size_t)m * D : F.in[I_CTX] + (size_t)(m - MX) * D;
        const float* mr = mod + ((m < MX) ? (m >> 12) : 4) * NMOD;
        f32x4 v[4]; float ss = 0.f;
#pragma unroll
        for (int j = 0; j < 4; ++j) { v[j] = *(const f32x4*)(src + j * 256 + F.lane * 4); ss += v[j].x * v[j].x + v[j].y * v[j].y + v[j].z * v[j].z + v[j].w * v[j].w; }
        const float rstd = __builtin_amdgcn_rsqf(wave_sum(ss) * (1.f / D) + NORM_EPS);
#pragma unroll
        for (int j = 0; j < 4; ++j) { const int c = j * 256 + F.lane * 4;
            const f32x4 g = *(const f32x4*)(ng + c), sh = *(const f32x4*)(mr + c), sc = *(const f32x4*)(mr + D + c);
            const float o0 = v[j].x * rstd * g.x * (1.f + sc.x) + sh.x, o1 = v[j].y * rstd * g.y * (1.f + sc.y) + sh.y, o2 = v[j].z * rstd * g.z * (1.f + sc.z) + sh.z, o3 = v[j].w * rstd * g.w * (1.f + sc.w) + sh.w;
            *(v2u*)(hx + (size_t)m * D + c) = (v2u){pk2(o0, o1), pk2(o2, o3)}; }
    }
}
constexpr int BL_APT = 0, BL_NPT = 4608, BL_RH = 7168, BL_MKR = 11776, BL_MBR = 14336, BL_KGC = 16896, BL_BGC = 22016, BL_GC = 27136, BL_VT = 27648, BL_BYTES = 32768;
constexpr int CS_AH = 32768, CS_BH = 37376, CS_KH = 41984, CS_AHC = 46592, CS_E = 51712, CS_RAW = 59904, CS_TLW = 72960, CS_LOA = 77568, CS_W2T = 82176, CS_A2T = 91392,
              CS_LG = 100608, CS_NBA = 100608, CS_NKA = 105216, CS_TT = 107776, CS_CONST = 116992, CS_END = 119552;
constexpr int CS_RH = BL_RH, CS_KGC = BL_KGC, CS_BGC = BL_BGC, CS_VT = BL_VT, CS_GC = BL_GC, CS_APT = BL_APT, CS_NPT = BL_NPT, CS_MKR = BL_MKR, CS_MBR = BL_MBR;
constexpr int SC_NTILE = (TC + T) / 32, SC_RT = 16, SC_NROUND = (SC_NTILE + SC_RT - 1) / SC_RT;
constexpr int GS_YS = 65536;
__device__ __forceinline__ void scan_issue_loads(const bf16* proj, int b, int h, int d, int tile, int tid, v4u (&rg)[3]) {
    const bool isctx = tile < TC / 32; const int L = isctx ? TC : T; const int jt = isctx ? tile : tile - TC / 32;
    const size_t rowbase = isctx ? (size_t)(MX + b * TC) : (size_t)b * T;
    const int tlo = d == 0 ? 32 * jt : L - 32 * (jt + 1);
#pragma unroll
    for (int i = 0; i < 3; ++i) {
        const int q = tid + 512 * i; v4u val = (v4u){0u, 0u, 0u, 0u};
        if (q < 816) { const int row = q / 24, rem = q - row * 24, which = rem >> 3, ch8 = rem & 7; const int tok = tlo - 1 + row;
            if (tok >= 0 && tok < L) val = *(const v4u*)(proj + (rowbase + tok) * NPROJ + COL_R + which * 512 + h * 64 + ch8 * 8); }
        else if (q < 1328) { const int q2 = q - 816, row = q2 >> 4, rem = q2 & 15, which = rem >> 3, ch8 = rem & 7; const int tok = tlo + row;
            val = *(const v4u*)(proj + (rowbase + tok) * NPROJ + (which ? COL_LA : COL_LW) + d * 64 + ch8 * 8); }
        rg[i] = val;
    }
}
__device__ __forceinline__ unsigned tanh_pk(unsigned w) { return pk2(tanh_fast(bf_lo(w)), tanh_fast(bf_hi(w))); }
__device__ __forceinline__ void scan_store_raw(LAS unsigned char* lds, int tid, const v4u (&rg)[3]) {
#pragma unroll
    for (int i = 0; i < 3; ++i) {
        const int q = tid + 512 * i;
        if (q < 816) { const int row = q / 24, rem = q - row * 24, which = rem >> 3, ch8 = rem & 7; *(LAS v4u*)(lds + CS_RAW + (which * 34 + row) * 128 + ch8 * 16) = rg[i]; }
        else if (q < 1328) { const int q2 = q - 816, row = q2 >> 4, rem = q2 & 15, which = rem >> 3, ch8 = rem & 7;
            if (which) *(LAS v4u*)(lds + CS_LOA + row * 144 + ch8 * 16) = rg[i];
            else { v4u t; t.x = tanh_pk(rg[i].x); t.y = tanh_pk(rg[i].y); t.z = tanh_pk(rg[i].z); t.w = tanh_pk(rg[i].w); *(LAS v4u*)(lds + CS_TLW + row * 144 + ch8 * 16) = t; } }
    }
}
__device__ __forceinline__ v2u pack4(f32x4 v) { return (v2u){pk2(v.x, v.y), pk2(v.z, v.w)}; }
__device__ __forceinline__ bf16 bfs(float v) { return (bf16)(pk2(v, 0.f) & 0xffffu); }
typedef v2u v2u_t;
__device__ __forceinline__ bf16x8 frag2(const LAS unsigned char* p0, const LAS unsigned char* p1) {
    const v2u a = *(const LAS v2u*)p0, b = *(const LAS v2u*)p1; const v4u w = (v4u){a.x, a.y, b.x, b.y}; return __builtin_bit_cast(bf16x8, w);
}
__device__ __forceinline__ bf16x8 frag_acc(f32x4 lo, f32x4 hi) { const v4u w = (v4u){pk2(lo.x, lo.y), pk2(lo.z, lo.w), pk2(hi.x, hi.y), pk2(hi.z, hi.w)}; return __builtin_bit_cast(bf16x8, w); }
__device__ __forceinline__ bf16x8 frag_zero() { const v4u w = (v4u){0u, 0u, 0u, 0u}; return __builtin_bit_cast(bf16x8, w); }
__device__ __forceinline__ void scan_prep_task(Frame& F, const bf16* proj, int chain, int tile, bool load_consts, bool have_next, int nchain, int ntile, v4u (&rg)[3], unsigned char* blob) {
    LAS unsigned char* lds = F.lds; const int tid = F.tid, lane = F.lane, wave = F.wave;
    const int b = chain >> 4, h = (chain >> 1) & 7, d = chain & 1, nb = nchain >> 4, nh = (nchain >> 1) & 7, nd = nchain & 1;
    if (load_consts) {
        __syncthreads();
        LAS float* C = (LAS float*)(lds + CS_CONST);
        if (tid < 384) { const int pn = tid / 192, r = tid - pn * 192, which = r >> 6, c = r & 63; C[pn * 192 + which * 64 + c] = F.in[I_TMU][(pn * 3 + which) * 512 + h * 64 + c]; }
        else if (tid < 448) { const int c = tid - 384; C[384 + c] = F.in[I_KK][h * 64 + c]; C[448 + c] = F.in[I_KA][h * 64 + c]; }
        else { const int c = tid - 448; C[512 + c] = F.in[I_DW0][d * 512 + h * 64 + c]; C[576 + c] = F.in[I_A0][d * 512 + h * 64 + c]; }
        const float* w2 = F.in[I_DW2] + (size_t)d * 64 * 512 + h * 64; const float* a2 = F.in[I_A2] + (size_t)d * 64 * 512 + h * 64;
#pragma unroll
        for (int i = 0; i < 8; ++i) { const int idx = tid + 512 * i, j = idx >> 6, c = idx & 63;
            *(LAS bf16*)(lds + CS_W2T + c * 144 + j * 2) = bfs(w2[j * 512 + c]);
            *(LAS bf16*)(lds + CS_A2T + c * 144 + j * 2) = bfs(a2[j * 512 + c]); }
    }
    {
            scan_store_raw(lds, tid, rg);
            __syncthreads();
            if (have_next) scan_issue_loads(proj, nb, nh, nd, ntile, tid, rg);
            if (wave < 4) {
                const int mat = wave >> 1, nt = wave & 1, r = lane & 31, hh = lane >> 5;
                const LAS unsigned char* Ab = lds + (mat ? CS_LOA : CS_TLW) + r * 144 + hh * 16;
                const LAS unsigned char* Bb = lds + (mat ? CS_A2T : CS_W2T) + (nt * 32 + r) * 144 + hh * 16;
                f32x16 acc;
#pragma unroll
                for (int i = 0; i < 16; ++i) acc[i] = 0.f;
#pragma unroll
                for (int ks = 0; ks < 4; ++ks) { const bf16x8 a = *(const LAS bf16x8*)(Ab + ks * 32), bb = *(const LAS bf16x8*)(Bb + ks * 32); acc = __builtin_amdgcn_mfma_f32_32x32x16_bf16(a, bb, acc, 0, 0, 0); }
                LAS float* LG = (LAS float*)(lds + CS_LG) + mat * 2048 + nt * 32 + r;
#pragma unroll
                for (int i = 0; i < 16; ++i) LG[((i & 3) + 8 * (i >> 2) + 4 * hh) * 64] = acc[i];
            }
            __syncthreads();
            const int tok = tid >> 4, cq = tid & 15, c0 = cq * 4, s = d == 0 ? tok : 31 - tok;
            f32x4 rs, vs, kd, kk, kka, ev;
            { const LAS float* C = (const LAS float*)(lds + CS_CONST);
              f32x4 xs[3];
#pragma unroll
              for (int which = 0; which < 3; ++which) {
                  const LAS unsigned char* rp = lds + CS_RAW + (which * 34 + tok) * 128 + c0 * 2;
                  const v2u p = *(const LAS v2u*)rp, x = *(const LAS v2u*)(rp + 128), n = *(const LAS v2u*)(rp + 256);
                  const f32x4 mp = *(const LAS f32x4*)(C + which * 64 + c0), mn = *(const LAS f32x4*)(C + 192 + which * 64 + c0);
                  const f32x4 xp = (f32x4){bf_lo(p.x), bf_hi(p.x), bf_lo(p.y), bf_hi(p.y)}, xc = (f32x4){bf_lo(x.x), bf_hi(x.x), bf_lo(x.y), bf_hi(x.y)}, xn = (f32x4){bf_lo(n.x), bf_hi(n.x), bf_lo(n.y), bf_hi(n.y)};
                  xs[which] = xc + mp * (xp - xc) + mn * (xn - xc); }
              const f32x4 kkc = *(const LAS f32x4*)(C + 384 + c0), kac = *(const LAS f32x4*)(C + 448 + c0), w0 = *(const LAS f32x4*)(C + 512 + c0), a0 = *(const LAS f32x4*)(C + 576 + c0);
              kk = xs[1] * kkc;
              const float ss = rowsum16(kk.x * kk.x + kk.y * kk.y + kk.z * kk.z + kk.w * kk.w);
              kk = kk * __builtin_amdgcn_rsqf(ss + 1e-12f);
              const f32x4 uw = *(const LAS f32x4*)(lds + CS_LG + (tok * 64 + c0) * 4) + w0, ua = *(const LAS f32x4*)(lds + CS_LG + 8192 + (tok * 64 + c0) * 4) + a0;
              f32x4 av;
#pragma unroll
              for (int e = 0; e < 4; ++e) { ev[e] = 0.60653066f * sigmoidf(uw[e]); av[e] = sigmoidf(ua[e]); }
              kd = xs[1] * (1.f + (av - 1.f) * kac); kka = kk * av; rs = xs[0]; vs = xs[2];
              *(LAS f32x4*)(lds + CS_E + (s * 64 + c0) * 4) = ev; }
            __syncthreads();
            { const int cb = s & 16, sl = s & 15;
              f32x4 cum = (f32x4){0.f, 0.f, 0.f, 0.f}, tot = cum;
#pragma unroll
              for (int ii = 0; ii < 16; ++ii) { const f32x4 e4 = *(const LAS f32x4*)(lds + CS_E + ((cb + ii) * 64 + c0) * 4); tot = tot + e4; if (ii <= sl) cum = cum + e4; }
              f32x4 g, gm1, gi, ge, gt;
#pragma unroll
              for (int e = 0; e < 4; ++e) { g[e] = fast_exp(-cum[e]); gm1[e] = fast_exp(ev[e] - cum[e]); gi[e] = fast_exp(cum[e]); ge[e] = fast_exp(cum[e] - tot[e]); gt[e] = fast_exp(-tot[e]); }
              const f32x4 ah = gm1 * kk, bh = kka * gi, kh = kd * gi, rh = g * rs, kg = kd * ge, bg = kka * ge;
              *(LAS v2u*)(lds + CS_AH + s * 144 + c0 * 2) = pack4(ah); *(LAS v2u*)(lds + CS_BH + s * 144 + c0 * 2) = pack4(bh);
              *(LAS v2u*)(lds + CS_KH + s * 144 + c0 * 2) = pack4(kh); *(LAS v2u*)(lds + CS_RH + s * 144 + c0 * 2) = pack4(rh);
#pragma unroll
              for (int e = 0; e < 4; ++e) { *(LAS bf16*)(lds + CS_AHC + (c0 + e) * 80 + s * 2) = bfs(ah[e]); *(LAS bf16*)(lds + CS_KGC + (c0 + e) * 80 + s * 2) = bfs(kg[e]); *(LAS bf16*)(lds + CS_BGC + (c0 + e) * 80 + s * 2) = bfs(-bg[e]); }
#pragma unroll
              for (int e = 0; e < 4; ++e) *(LAS bf16*)(lds + CS_VT + (c0 + e) * 80 + s * 2) = bfs(vs[e]);
              if (sl == 15) *(LAS f32x4*)(lds + CS_GC + ((s >> 4) * 64 + c0) * 4) = gt; }
            __syncthreads();
            if (wave < 4) {
                const int r = lane & 31, hh = lane >> 5;
                const LAS unsigned char* Ab = lds + ((wave == 0 || wave == 3) ? CS_BH : CS_KH) + r * 144 + hh * 16;
                const LAS unsigned char* Bb = lds + (wave < 2 ? CS_AH : CS_RH) + r * 144 + hh * 16;
                f32x16 acc;
#pragma unroll
                for (int i = 0; i < 16; ++i) acc[i] = 0.f;
#pragma unroll
                for (int ks = 0; ks < 4; ++ks) { const bf16x8 a = *(const LAS bf16x8*)(Ab + ks * 32), bb = *(const LAS bf16x8*)(Bb + ks * 32); acc = __builtin_amdgcn_mfma_f32_32x32x16_bf16(a, bb, acc, 0, 0, 0); }
                const int t = r;
#pragma unroll
                for (int i = 0; i < 16; ++i) { const int j = (i & 3) + 8 * (i >> 2) + 4 * hh; const bool same = (j >> 4) == (t >> 4);
                    const bool keep = same && (wave < 2 ? (j < t) : (j <= t)); acc[i] = keep ? acc[i] : 0.f; }
                if (wave == 0) {
#pragma unroll
                    for (int i = 0; i < 16; ++i) { const int j = (i & 3) + 8 * (i >> 2) + 4 * hh; *(LAS float*)(lds + CS_NBA + (t * 36 + j) * 4) = acc[i]; } }
                else if (wave == 1) {
#pragma unroll
                    for (int i = 0; i < 16; ++i) { const int j = (i & 3) + 8 * (i >> 2) + 4 * hh; *(LAS bf16*)(lds + CS_NKA + j * 80 + t * 2) = bfs(acc[i]); } }
                else { const float sg = wave == 2 ? 1.f : -1.f; const int base = wave == 2 ? CS_MKR : CS_MBR;
#pragma unroll
                    for (int q4 = 0; q4 < 4; ++q4) *(LAS v2u*)(lds + base + t * 80 + (8 * q4 + 4 * hh) * 2) = pack4((f32x4){sg * acc[4 * q4], sg * acc[4 * q4 + 1], sg * acc[4 * q4 + 2], sg * acc[4 * q4 + 3]}); }
            }
            __syncthreads();
            if (wave == 0 && lane < 32) {
                const int blk = lane >> 4, i = lane & 15;
                float Tr[16];
#pragma unroll
                for (int t = 0; t < 16; ++t) {
                    float acc = (t == i) ? 1.f : 0.f;
                    const LAS float* np = (const LAS float*)(lds + CS_NBA) + (16 * blk + t) * 36 + 16 * blk;
#pragma unroll
                    for (int j = 0; j < t; ++j) acc -= Tr[j] * np[j];
                    Tr[t] = acc;
                }
#pragma unroll
                for (int t = 0; t < 16; ++t) { *(LAS bf16*)(lds + CS_TT + (16 * blk + t) * 80 + (16 * blk + i) * 2) = bfs(Tr[t]); *(LAS bf16*)(lds + CS_TT + (16 * blk + t) * 80 + (16 * (1 - blk) + i) * 2) = (bf16)0; }
            }
            __syncthreads();
            if (wave < 3) {
                const int r = lane & 31, hh = lane >> 5;
                const LAS unsigned char* Ab = lds + (wave < 2 ? CS_AHC + (32 * wave + r) * 80 : CS_NKA + r * 80) + hh * 16;
                const LAS unsigned char* Bb = lds + CS_TT + r * 80 + hh * 16;
                f32x16 acc;
#pragma unroll
                for (int i = 0; i < 16; ++i) acc[i] = 0.f;
#pragma unroll
                for (int ks = 0; ks < 2; ++ks) { const bf16x8 a = *(const LAS bf16x8*)(Ab + ks * 32), bb = *(const LAS bf16x8*)(Bb + ks * 32); acc = __builtin_amdgcn_mfma_f32_32x32x16_bf16(a, bb, acc, 0, 0, 0); }
                const int t = r;
#pragma unroll
                for (int q4 = 0; q4 < 4; ++q4) { const v2u pk = pack4((f32x4){acc[4 * q4], acc[4 * q4 + 1], acc[4 * q4 + 2], acc[4 * q4 + 3]});
                    if (wave < 2) *(LAS v2u*)(lds + CS_APT + t * 144 + (32 * wave + 8 * q4 + 4 * hh) * 2) = pk;
                    else *(LAS v2u*)(lds + CS_NPT + t * 80 + (8 * q4 + 4 * hh) * 2) = pk; }
            }
            __syncthreads();
#pragma unroll
            for (int i = 0; i < 4; ++i) { const int idx = tid + 512 * i; *(v4u*)(blob + idx * 16) = *(const LAS v4u*)(lds + idx * 16); }
    }
}
__device__ __forceinline__ void scan_state_round(Frame& F, int chain, int t0, int t1, const unsigned char* blobs, f32x4 (&Z)[4]) {
    LAS unsigned char* lds = F.lds; const int tid = F.tid, lane = F.lane, wave = F.wave;
    const int b = chain >> 4, h = (chain >> 1) & 7, d = chain & 1;
    float* yscr = F.out;
    v4u bg[4];
    __syncthreads();
#pragma unroll
    for (int i = 0; i < 4; ++i) bg[i] = *(const v4u*)(blobs + (tid + 512 * i) * 16);
#pragma unroll
    for (int i = 0; i < 4; ++i) *(LAS v4u*)(lds + (tid + 512 * i) * 16) = bg[i];
    __syncthreads();
    for (int tile = t0; tile < t1; ++tile) {
        const bool isctx = tile < TC / 32; const int L = isctx ? TC : T; const int jt = isctx ? tile : tile - TC / 32;
        const int tlo = d == 0 ? 32 * jt : L - 32 * (jt + 1);
        const LAS unsigned char* bl = lds + ((tile - t0) & 1) * BL_BYTES;
        if (tile + 1 < t1) {
#pragma unroll
            for (int i = 0; i < 4; ++i) bg[i] = *(const v4u*)(blobs + (size_t)(tile + 1 - t0) * BL_BYTES + (tid + 512 * i) * 16); }
            if (wave < 4) {
                const int n = lane & 15, g = lane >> 4;
                const bf16x8 bvt = *(const LAS bf16x8*)(bl + BL_VT + (16 * wave + n) * 80 + g * 16);
                f32x4 U[2]; U[0] = (f32x4){0.f, 0.f, 0.f, 0.f}; U[1] = U[0];
#pragma unroll
                for (int cc = 0; cc < 2; ++cc) {
                    const int trow = 16 * cc + n;
                    const bf16x8 bz01 = frag_acc(Z[0], Z[1]), bz23 = frag_acc(Z[2], Z[3]);
                    { const LAS unsigned char* ap = bl + BL_APT + trow * 144;
                      f32x4 u = __builtin_amdgcn_mfma_f32_16x16x32_bf16(frag2(ap + (4 * g) * 2, ap + (16 + 4 * g) * 2), bz01, (f32x4){0.f, 0.f, 0.f, 0.f}, 0, 0, 0);
                      u = __builtin_amdgcn_mfma_f32_16x16x32_bf16(frag2(ap + (32 + 4 * g) * 2, ap + (48 + 4 * g) * 2), bz23, u, 0, 0, 0);
                      u = __builtin_amdgcn_mfma_f32_16x16x32_bf16(*(const LAS bf16x8*)(bl + BL_NPT + trow * 80 + g * 16), bvt, u, 0, 0, 0);
                      U[cc] = u; }
                    const bf16x8 bu = frag_acc(U[0], U[1]);
                    if (!isctx) { const LAS unsigned char* rp = bl + BL_RH + trow * 144;
                      f32x4 y = __builtin_amdgcn_mfma_f32_16x16x32_bf16(frag2(rp + (4 * g) * 2, rp + (16 + 4 * g) * 2), bz01, (f32x4){0.f, 0.f, 0.f, 0.f}, 0, 0, 0);
                      y = __builtin_amdgcn_mfma_f32_16x16x32_bf16(frag2(rp + (32 + 4 * g) * 2, rp + (48 + 4 * g) * 2), bz23, y, 0, 0, 0);
                      y = __builtin_amdgcn_mfma_f32_16x16x32_bf16(*(const LAS bf16x8*)(bl + BL_MKR + trow * 80 + g * 16), bvt, y, 0, 0, 0);
                      const LAS unsigned char* mp = bl + BL_MBR + trow * 80;
                      y = __builtin_amdgcn_mfma_f32_16x16x32_bf16(frag2(mp + (4 * g) * 2, mp + (16 + 4 * g) * 2), bu, y, 0, 0, 0);
#pragma unroll
                      for (int i = 0; i < 4; ++i) *(LAS float*)(lds + GS_YS + ((16 * cc + 4 * g + i) * 64 + 16 * wave + n) * 4) = y[i]; }
#pragma unroll
                    for (int kt = 0; kt < 4; ++kt) {
                        const f32x4 gc = *(const LAS f32x4*)(bl + BL_GC + (cc * 64 + 16 * kt + 4 * g) * 4);
                        bf16x8 ka = *(const LAS bf16x8*)(bl + BL_KGC + (16 * kt + n) * 80 + g * 16);
                        if ((g >> 1) != cc) ka = frag_zero();
                        const LAS unsigned char* bp = bl + BL_BGC + (16 * kt + n) * 80;
                        const v2u b0 = *(const LAS v2u*)(bp + (4 * g) * 2), b1 = *(const LAS v2u*)(bp + (16 + 4 * g) * 2);
                        const v4u bw = cc == 0 ? (v4u){b0.x, b0.y, 0u, 0u} : (v4u){0u, 0u, b1.x, b1.y};
                        f32x4 z = Z[kt] * gc;
                        z = __builtin_amdgcn_mfma_f32_16x16x32_bf16(ka, bvt, z, 0, 0, 0);
                        z = __builtin_amdgcn_mfma_f32_16x16x32_bf16(__builtin_bit_cast(bf16x8, bw), bu, z, 0, 0, 0);
                        Z[kt] = z;
                    }
                }
            }
        __syncthreads();
        if (!isctx) { const int s2 = tid >> 4, part = tid & 15; const int tk = d == 0 ? tlo + s2 : tlo + 31 - s2;
            *(f32x4*)(yscr + ((size_t)(b * T + tk)) * D + d * 512 + h * 64 + part * 4) = *(const LAS f32x4*)(lds + GS_YS + (s2 * 64 + part * 4) * 4); }
        if (tile + 1 < t1) {
#pragma unroll
            for (int i = 0; i < 4; ++i) *(LAS v4u*)(lds + ((tile + 1 - t0) & 1) * BL_BYTES + (tid + 512 * i) * 16) = bg[i]; }
        __syncthreads();
    }
}
template <int LEVEL> __device__ __forceinline__ void p3_scan(Frame& F, const XcdBarrier& bar) {
    const bf16* proj = (const bf16*)(F.ws + WS_PROJ);
    const bool state_role = F.bid < 64;
    f32x4 Z[4];
#pragma unroll
    for (int kt = 0; kt < 4; ++kt) Z[kt] = (f32x4){0.f, 0.f, 0.f, 0.f};
    for (int step = 0; step <= SC_NROUND; ++step) {
        if (step >= 1 && state_role) {
            const int r = step - 1, t0 = r * SC_RT, t1 = (t0 + SC_RT < SC_NTILE) ? t0 + SC_RT : SC_NTILE;
            scan_state_round(F, F.bid, t0, t1, F.ws + ((r & 1) ? WS_BLOB1 : WS_BLOB0) + (size_t)F.bid * SC_RT * BL_BYTES, Z);
        }
        const bool prep_here = step < SC_NROUND && (step == 0 || !state_role);
        if (prep_here) {
            const int t0 = step * SC_RT, nt = (t0 + SC_RT < SC_NTILE) ? SC_RT : SC_NTILE - t0, ntask = 64 * nt;
            const int P = step == 0 ? F.G : F.G - 64, p = step == 0 ? F.bid : F.bid - 64;
            const int k0 = (int)((long)ntask * p / P), k1 = (int)((long)ntask * (p + 1) / P);
            unsigned char* base = F.ws + ((step & 1) ? WS_BLOB1 : WS_BLOB0);
            v4u rg[3];
            if (k0 < k1) scan_issue_loads(proj, (k0 / nt) >> 4, ((k0 / nt) >> 1) & 7, (k0 / nt) & 1, t0 + k0 % nt, F.tid, rg);
            int prev_chain = -1;
            for (int k = k0; k < k1; ++k) {
                const int chain = k / nt, tl = k % nt, kn = k + 1, nchain = kn / nt, ntl = kn % nt;
                scan_prep_task(F, proj, chain, t0 + tl, chain != prev_chain, kn < k1, nchain, t0 + ntl, rg, base + ((size_t)chain * SC_RT + tl) * BL_BYTES);
                prev_chain = chain;
            }
        }
        if (step < SC_NROUND) xcd_barrier(bar);
    }
}
__device__ __forceinline__ void p4_mix(Frame& F) {
    LAS unsigned char* lds = F.lds; const int tid = F.tid;
    const bf16* proj = (const bf16*)(F.ws + WS_PROJ); bf16* cat = (bf16*)(F.ws + WS_HX); const float* yscr = F.out;
    LAS float* SG = (LAS float*)lds;
    LAS bf16* GT = (LAS bf16*)(lds + 32768);
    for (int unit = F.bid; unit < MX / 64; unit += F.G) {
        const size_t row0 = (size_t)unit * 64; const int tb0 = (unit * 64) & (T - 1);
        __syncthreads();
#pragma unroll
        for (int i = 0; i < 2; ++i) { const int ck = tid + 512 * i, tok = ck >> 4, j0 = (ck & 15) * 8;
            const v4u w = *(const v4u*)(proj + (row0 + tok) * NPROJ + COL_G + j0);
            SG[(j0 + 0) * 64 + tok] = sigmoidf(bf_lo(w.x)); SG[(j0 + 1) * 64 + tok] = sigmoidf(bf_hi(w.x)); SG[(j0 + 2) * 64 + tok] = sigmoidf(bf_lo(w.y)); SG[(j0 + 3) * 64 + tok] = sigmoidf(bf_hi(w.y));
            SG[(j0 + 4) * 64 + tok] = sigmoidf(bf_lo(w.z)); SG[(j0 + 5) * 64 + tok] = sigmoidf(bf_hi(w.z)); SG[(j0 + 6) * 64 + tok] = sigmoidf(bf_lo(w.w)); SG[(j0 + 7) * 64 + tok] = sigmoidf(bf_hi(w.w)); }
        __syncthreads();
        { float acc[64];
#pragma unroll
          for (int i = 0; i < 64; ++i) acc[i] = 0.f;
          const float* gw = F.in[I_GW2] + tid;
#pragma unroll 2
          for (int j = 0; j < 128; ++j) { const float wv = gw[j * 512];
#pragma unroll
              for (int tq = 0; tq < 16; ++tq) { const f32x4 s4 = *(const LAS f32x4*)(SG + j * 64 + tq * 4);
                  acc[4 * tq] += s4.x * wv; acc[4 * tq + 1] += s4.y * wv; acc[4 * tq + 2] += s4.z * wv; acc[4 * tq + 3] += s4.w * wv; } }
#pragma unroll
          for (int i = 0; i < 64; ++i) GT[i * 512 + tid] = (bf16)(pk2(acc[i], 0.f) & 0xffffu); }
        __syncthreads();
        if (tid < 256) {
            const int c = 2 * tid; const float* cw = F.in[I_CONVW];
            const f32x2 w0 = *(const f32x2*)(cw + c), w1 = *(const f32x2*)(cw + 512 + c), w2 = *(const f32x2*)(cw + 1024 + c);
            const bf16* pr = proj + row0 * NPROJ + c;
            f32x2 zp = (f32x2){0.f, 0.f}, zc, zn;
            { const unsigned g = *(const unsigned*)(pr + COL_XG), x = *(const unsigned*)(pr + COL_XC); zc = (f32x2){bf_lo(g) * bf_lo(x), bf_hi(g) * bf_hi(x)}; }
            for (int t = 0; t < 64; ++t) {
                if (t < 63) { const unsigned g = *(const unsigned*)(pr + (size_t)(t + 1) * NPROJ + COL_XG), x = *(const unsigned*)(pr + (size_t)(t + 1) * NPROJ + COL_XC); zn = (f32x2){bf_lo(g) * bf_lo(x), bf_hi(g) * bf_hi(x)}; }
                else zn = (f32x2){0.f, 0.f};
                const unsigned xb = *(const unsigned*)(pr + (size_t)t * NPROJ + COL_XB);
                const f32x2 z = w0 * zp + w1 * zc + w2 * zn;
                *(unsigned*)(cat + (row0 + t) * D + c) = pk2(bf_lo(xb) * z.x, bf_hi(xb) * z.y);
                zp = zc; zc = zn;
            }
        } else {
            const int ri = tid - 256, c = 2 * ri, h = ri >> 5;
            const f32x2 mpr = *(const f32x2*)(F.in[I_TMU] + 0 * 512 + c), mpk = *(const f32x2*)(F.in[I_TMU] + 1 * 512 + c), mpv = *(const f32x2*)(F.in[I_TMU] + 2 * 512 + c);
            const f32x2 mnr = *(const f32x2*)(F.in[I_TMU] + 3 * 512 + c), mnk = *(const f32x2*)(F.in[I_TMU] + 4 * 512 + c), mnv = *(const f32x2*)(F.in[I_TMU] + 5 * 512 + c);
            const f32x2 rk = *(const f32x2*)(F.in[I_RK] + c), lg = *(const f32x2*)(F.in[I_LNG] + c), lb = *(const f32x2*)(F.in[I_LNB] + c);
            const bf16* pr = proj + row0 * NPROJ + c;
            f32x2 rp, kp, vp, rc, kc, vc, rn, kn, vn;
#define LD2(dst, ptr) do { const unsigned _w = *(const unsigned*)(ptr); dst = (f32x2){bf_lo(_w), bf_hi(_w)}; } while (0)
            if (tb0 > 0) { LD2(rp, pr - NPROJ + COL_R); LD2(kp, pr - NPROJ + COL_K); LD2(vp, pr - NPROJ + COL_V); } else { rp = kp = vp = (f32x2){0.f, 0.f}; }
            LD2(rc, pr + COL_R); LD2(kc, pr + COL_K); LD2(vc, pr + COL_V);
            for (int t = 0; t < 64; ++t) {
                if (tb0 + t + 1 < T) { const bf16* pn = pr + (size_t)(t + 1) * NPROJ; LD2(rn, pn + COL_R); LD2(kn, pn + COL_K); LD2(vn, pn + COL_V); } else { rn = kn = vn = (f32x2){0.f, 0.f}; }
                const f32x2 rs = rc + mpr * (rp - rc) + mnr * (rn - rc), ks = kc + mpk * (kp - kc) + mnk * (kn - kc), vs = vc + mpv * (vp - vc) + mnv * (vn - vc);
                const float* yr = yscr + (row0 + t) * D + c;
                const f32x2 y = *(const f32x2*)yr + *(const f32x2*)(yr + 512);
                const float mu = half_sum32(y.x + y.y) * (1.f / 64.f);
                const f32x2 yc = y - mu;
                const float var = half_sum32(yc.x * yc.x + yc.y * yc.y) * (1.f / 64.f);
                const float bon = half_sum32(rs.x * ks.x * rk.x + rs.y * ks.y * rk.y);
                const f32x2 yn = yc * __builtin_amdgcn_rsqf(var + LNX_EPS) * lg + lb + bon * vs;
                const unsigned gt = *(const LAS unsigned*)(GT + t * 512 + c);
                *(unsigned*)(cat + (row0 + t) * D + 512 + c) = pk2(yn.x * bf_lo(gt), yn.y * bf_hi(gt));
                rp = rc; kp = kc; vp = vc; rc = rn; kc = kn; vc = vn;
            }
#undef LD2
        }
    }
}

__device__ __forceinline__ void p6_mid(Frame& F) {
    const float* mod = (const float*)(F.ws + WS_MOD); const float* ng = F.in[I_NG];
    const float* yx = (const float*)(F.ws + WS_PROJ); bf16* hx2 = (bf16*)(F.ws + WS_HX);
    for (int m = F.bid * NWAVES + F.wave; m < MX; m += F.G * NWAVES) {
        const float* mr = mod + (m >> 12) * NMOD;
        f32x4 v[4], xv[4]; float ss = 0.f;
#pragma unroll
        for (int j = 0; j < 4; ++j) { v[j] = *(const f32x4*)(yx + (size_t)m * D + j * 256 + F.lane * 4); xv[j] = *(const f32x4*)(F.in[I_X] + (size_t)m * D + j * 256 + F.lane * 4);
            ss += v[j].x * v[j].x + v[j].y * v[j].y + v[j].z * v[j].z + v[j].w * v[j].w; }
        const float rstd = __builtin_amdgcn_rsqf(wave_sum(ss) * (1.f / D) + NORM_EPS);
        float ss2 = 0.f;
#pragma unroll
        for (int j = 0; j < 4; ++j) { const int c = j * 256 + F.lane * 4;
            const f32x4 g1 = *(const f32x4*)(ng + D + c), gt = *(const f32x4*)(mr + 2 * D + c);
            xv[j] = xv[j] + gt * (v[j] * rstd * g1);
            *(f32x4*)(F.out + (size_t)m * D + c) = xv[j];
            ss2 += xv[j].x * xv[j].x + xv[j].y * xv[j].y + xv[j].z * xv[j].z + xv[j].w * xv[j].w; }
        const float rstd2 = __builtin_amdgcn_rsqf(wave_sum(ss2) * (1.f / D) + NORM_EPS);
#pragma unroll
        for (int j = 0; j < 4; ++j) { const int c = j * 256 + F.lane * 4;
            const f32x4 g2 = *(const f32x4*)(ng + 2 * D + c), sh = *(const f32x4*)(mr + 3 * D + c), sc = *(const f32x4*)(mr + 4 * D + c);
            const f32x4 o = xv[j] * rstd2 * g2 * (1.f + sc) + sh;
            *(v2u*)(hx2 + (size_t)m * D + c) = (v2u){pk2(o.x, o.y), pk2(o.z, o.w)}; }
    }
}
__device__ __forceinline__ float gelu_erf(float x) { return 0.5f * x * (1.f + erff(x * 0.70710678118f)); }
__device__ __forceinline__ float dot2bf(unsigned a, unsigned b, float c) {
    typedef __bf16 bf2 __attribute__((ext_vector_type(2)));
    return __builtin_amdgcn_fdot2_f32_bf16(__builtin_bit_cast(bf2, a), __builtin_bit_cast(bf2, b), c, false);
}
__device__ __forceinline__ unsigned uminu(unsigned a, unsigned b) { return a < b ? a : b; }
__device__ __forceinline__ void ce_desc(unsigned& x, unsigned& y) { const unsigned hi = umaxu(x, y), lo = uminu(x, y); x = hi; y = lo; }
template <int N> __device__ __forceinline__ void bitonic_sort_desc(unsigned (&a)[N]) {
#pragma unroll
    for (int k = 2; k <= N; k <<= 1)
#pragma unroll
        for (int j = k >> 1; j > 0; j >>= 1)
#pragma unroll
            for (int i = 0; i < N; ++i) { const int l = i ^ j; if (l > i) { if ((i & k) == 0) ce_desc(a[i], a[l]); else ce_desc(a[l], a[i]); } }
}
template <int N> __device__ __forceinline__ void bitonic_merge_desc(unsigned (&a)[N]) {
#pragma unroll
    for (int j = N >> 1; j > 0; j >>= 1)
#pragma unroll
        for (int i = 0; i < N; ++i) { const int l = i ^ j; if (l > i) ce_desc(a[i], a[l]); }
}
__device__ __forceinline__ void p8a_route(Frame& F) {
    const int lane = F.lane, wave = F.wave, part = lane & 3, L = lane >> 2, side = L & 1;
    LAS unsigned char* WL = F.lds + 1024 + wave * 1024;
    LAS unsigned char* TAB = F.lds;
    const float* scores = (const float*)(F.ws + WS_PROJ);
    unsigned short* exl = (unsigned short*)(F.ws + WS_EXL); float* gl = (float*)(F.ws + WS_GL);
    __syncthreads();
    if (F.tid < 64) { int l = F.tid, i = 0; for (; i < 16; ++i) { const int n = 16 / (i + 1); if (l < n) break; l -= n; } TAB[F.tid] = (unsigned char)(i < 16 ? i * 16 + l : 0); }
    __syncthreads();
    for (int m = F.bid * NWAVES + wave; m < MX; m += F.G * NWAVES) {
        const float* lp = scores + (size_t)m * NSC + L * 128 + part * 32;
        unsigned lo16[16], hi16[16];
#pragma unroll
        for (int q = 0; q < 4; ++q) { const f32x4 v = *(const f32x4*)(lp + 4 * q), w = *(const f32x4*)(lp + 16 + 4 * q);
#pragma unroll
            for (int e = 0; e < 4; ++e) { lo16[4 * q + e] = (f2key(v[e]) & ~127u) | (unsigned)(127 - part * 32 - (4 * q + e)); hi16[4 * q + e] = (f2key(w[e]) & ~127u) | (unsigned)(127 - part * 32 - 16 - (4 * q + e)); } }
        bitonic_sort_desc<16>(lo16); bitonic_sort_desc<16>(hi16);
        unsigned r[16];
#pragma unroll
        for (int i = 0; i < 16; ++i) r[i] = umaxu(lo16[i], hi16[15 - i]);
        bitonic_merge_desc<16>(r);
        { unsigned c[16];
#pragma unroll
          for (int i = 0; i < 16; ++i) c[i] = umaxu(r[i], dppu<0xB1>(r[15 - i]));
          bitonic_merge_desc<16>(c);
#pragma unroll
          for (int i = 0; i < 16; ++i) r[i] = umaxu(c[i], dppu<0x4E>(c[15 - i]));
          bitonic_merge_desc<16>(r); }
        if (part == 0) {
#pragma unroll
            for (int i = 0; i < 16; ++i) WL[L * 16 + i] = (unsigned char)(127u - (r[i] & 127u)); }
        float fa[16], fb[16];
#pragma unroll
        for (int i = 0; i < 16; ++i) { const unsigned up = dppu<0x104>(r[i]), dn = dppu<0x114>(r[i]);
            const unsigned av = side ? dn : r[i], bv = side ? r[i] : up; fa[i] = key2f(av & ~127u); fb[i] = key2f(bv & ~127u); }
        unsigned R[16];
#pragma unroll
        for (int j = 0; j < 16; ++j) R[j] = (f2key(fa[0] + fb[j]) & ~63u) | (unsigned)(63 - j);
        { int code = 16;
#pragma unroll
          for (int i = 1; i < 16; ++i) {
#pragma unroll
              for (int j = 0; j < 16; ++j) { if ((i + 1) * (j + 1) <= 16) {
                  const unsigned x = (f2key(fa[i] + fb[j]) & ~63u) | (unsigned)(63 - code); const int p0 = (i + 1) * (j + 1) - 1;
#pragma unroll
                  for (int p = 15; p > p0; --p) R[p] = umaxu(R[p], uminu(R[p - 1], x));
                  R[p0] = umaxu(R[p0], x); ++code; } } } }
        if ((lane & 7) == 0) {
#pragma unroll
            for (int k = 0; k < 16; ++k) *(LAS unsigned*)(WL + 256 + ((lane >> 3) * 16 + k) * 4) = R[k]; }
        LDS_WAIT();
#pragma unroll
        for (int half = 0; half < 2; ++half) { const int e = lane + 64 * half, hd = e >> 4;
            const unsigned rk = *(const LAS unsigned*)(WL + 256 + e * 4); const int ij = TAB[63 - (int)(rk & 63u)];
            const int idx0 = WL[(2 * hd) * 16 + (ij >> 4)], idx1 = WL[(2 * hd + 1) * 16 + (ij & 15)];
            const float scv = key2f(rk & ~63u);
            float mx = scv; mx = fmaxf(mx, dppf<0xB1>(mx)); mx = fmaxf(mx, dppf<0x4E>(mx)); mx = fmaxf(mx, dppf<0x141>(mx)); mx = fmaxf(mx, dppf<0x140>(mx));
            const float ev = fast_exp(scv - mx); const float den = rowsum16(ev);
            exl[(size_t)m * 128 + e] = (unsigned short)(idx0 * 128 + idx1); gl[(size_t)m * 128 + e] = ev * fast_rcp(den); }
        LDS_WAIT();
    }
}
__device__ __forceinline__ void p9_upass(Frame& F) {
    const int lane = F.lane, wave = F.wave, x = F.bid & 7, r = F.bid >> 3, nr = F.G >> 3, g = lane >> 4, q = lane & 15;
    LAS unsigned short* EXW = (LAS unsigned short*)(F.lds + wave * 256);
    const unsigned* exl32 = (const unsigned*)(F.ws + WS_EXL); const bf16* hx2 = (const bf16*)(F.ws + WS_HX);
    const unsigned char* U = F.ws + WS_U + 256 * x + 16 * q; float* part = (float*)(F.ws + WS_PART) + (size_t)x * MX * 128;
    for (int m = r + nr * wave; m < MX; m += nr * NWAVES) {
        *(LAS unsigned*)(EXW + 2 * lane) = exl32[(size_t)m * 64 + lane];
        const v4u hs = *(const v4u*)(hx2 + (size_t)m * D + 128 * x + 8 * q);
        LDS_WAIT();
        float keep[2];
#pragma unroll
        for (int j = 0; j < 2; ++j) {
            float kp = 0.f;
#pragma unroll
            for (int i0 = 0; i0 < 16; i0 += 8) {
                v4u uu[8];
#pragma unroll
                for (int i = 0; i < 8; ++i) { const unsigned ex = EXW[64 * j + 4 * (i0 + i) + g]; uu[i] = *(const v4u*)(U + (size_t)ex * 2048); }
#pragma unroll
                for (int i = 0; i < 8; ++i) { float p = dot2bf(uu[i].x, hs.x, 0.f); p = dot2bf(uu[i].y, hs.y, p); p = dot2bf(uu[i].z, hs.z, p); p = dot2bf(uu[i].w, hs.w, p);
                    p = rowsum16(p); kp = (q == i0 + i) ? p : kp; }
            }
            keep[j] = kp;
        }
        part[(size_t)m * 128 + 4 * q + g] = keep[0]; part[(size_t)m * 128 + 64 + 4 * q + g] = keep[1];
        LDS_WAIT();
    }
}
__device__ __forceinline__ void p10_combine(Frame& F) {
    const float* __restrict__ part = (const float*)(F.ws + WS_PART); const float* __restrict__ gl = (const float*)(F.ws + WS_GL);
    const unsigned short* __restrict__ exl = (const unsigned short*)(F.ws + WS_EXL); unsigned* __restrict__ plt = (unsigned*)(F.ws + WS_PL);
    LAS unsigned* TL = (LAS unsigned*)F.lds;
    for (int unit = F.bid; unit < MX / 64; unit += F.G) {
        const int m0 = unit * 64;
        __syncthreads();
#pragma unroll 4
        for (int i = 0; i < 16; ++i) { const int idx = F.tid + 512 * i, ml = idx >> 7, k = idx & 127; const size_t gi = (size_t)(m0 + ml) * 128 + k;
            float s = part[gi];
#pragma unroll
            for (int x = 1; x < 8; ++x) s += part[(size_t)x * MX * 128 + gi];
            TL[k * 65 + ml] = (unsigned)exl[gi] | (pk2(0.f, gl[gi] * gelu_erf(s)) & 0xffff0000u); }
        __syncthreads();
#pragma unroll 4
        for (int i = 0; i < 16; ++i) { const int idx = F.tid + 512 * i, k = idx >> 6, ml = idx & 63; plt[(size_t)k * MX + m0 + ml] = TL[k * 65 + ml]; }
    }
}
template <int MODE> __device__ __forceinline__ void p11_vpass(Frame& F) {
    const int lane = F.lane, wave = F.wave;
    const unsigned* __restrict__ plt = (const unsigned*)(F.ws + WS_PL); float* __restrict__ po = (float*)(F.ws + WS_PO);
    for (int cg = F.bid; cg < 256; cg += F.G) {
        const int c0 = 128 * (cg & 7) + 4 * (cg >> 3);
        __syncthreads();
        if (MODE != 2) for (int e = F.tid; e < NEXP; e += 512) { const f32x4 vv = *(const f32x4*)(F.in[I_PV] + (size_t)e * D + c0); *(LAS v2u*)(F.lds + e * 8) = (v2u){pk2(vv.x, vv.y), pk2(vv.z, vv.w)}; }
        __syncthreads();
        if (MODE != 1) for (int mg = wave; mg < MX / 64; mg += NWAVES) {
            const unsigned* __restrict__ pg = plt + mg * 64;
            f32x4 acc = (f32x4){0.f, 0.f, 0.f, 0.f};
#pragma unroll 2
            for (int k0 = 0; k0 < 128; k0 += 8) {
                unsigned p[8];
#pragma unroll
                for (int i = 0; i < 8; ++i) p[i] = pg[(size_t)(k0 + i) * MX + lane];
#pragma unroll
                for (int i = 0; i < 8; ++i) { const v2u vv = *(const LAS v2u*)(unsigned)((p[i] & 0xffffu) << 3); const float cf = bf_hi(p[i]);
                    acc.x += cf * bf_lo(vv.x); acc.y += cf * bf_hi(vv.x); acc.z += cf * bf_lo(vv.y); acc.w += cf * bf_hi(vv.y); }
            }
            *(f32x4*)(po + (size_t)(mg * 64 + lane) * D + c0) = acc;
        }
    }
}
__device__ __forceinline__ void p12_final(Frame& F) {
    const float* mod = (const float*)(F.ws + WS_MOD); const float* ng3 = F.in[I_NG] + 3 * D; const float* po = (const float*)(F.ws + WS_PO);
    for (int m = F.bid * NWAVES + F.wave; m < MX; m += F.G * NWAVES) {
        const float* gt2 = mod + (m >> 12) * NMOD + 5 * D;
        f32x4 v[4]; float ss = 0.f;
#pragma unroll
        for (int j = 0; j < 4; ++j) { v[j] = *(const f32x4*)(po + (size_t)m * D + j * 256 + F.lane * 4); ss += v[j].x * v[j].x + v[j].y * v[j].y + v[j].z * v[j].z + v[j].w * v[j].w; }
        const float rstd = __builtin_amdgcn_rsqf(wave_sum(ss) * (1.f / D) + NORM_EPS);
#pragma unroll
        for (int j = 0; j < 4; ++j) { const int c = j * 256 + F.lane * 4; float* op = F.out + (size_t)m * D + c;
            const f32x4 x1 = *(const f32x4*)op, g = *(const f32x4*)(ng3 + c), gt = *(const f32x4*)(gt2 + c);
            *(f32x4*)op = x1 + gt * (v[j] * rstd * g); }
    }
}
struct Args { const float* in[25]; float* out; unsigned char* ws; int ph_lo, ph_hi; };
__global__ void __launch_bounds__(NWAVES * 64, 2) mk_fwd(Args args) {
    extern __shared__ __attribute__((aligned(16))) unsigned char lds_raw[];
    Frame F;
    F.lds = (LAS unsigned char*)lds_raw;
    F.MISC = (volatile LAS unsigned*)(F.lds + MISC_OFF);
    F.tid = threadIdx.x; F.lane = F.tid & 63; F.wave = __builtin_amdgcn_readfirstlane(F.tid >> 6);
    F.G = gridDim.x; F.bid = blockIdx.x;
#pragma unroll
    for (int i = 0; i < 25; ++i) F.in[i] = args.in[i];
    F.out = args.out; F.ws = args.ws; F.ctl = (gu32*)(args.ws + WS_CTL);
    for (int u = F.tid; u < (LDS_BYTES - LDSCTL_OFF) / 4; u += NWAVES * 64) ((LAS unsigned*)(F.lds + LDSCTL_OFF))[u] = 0u;
    __syncthreads();
    const int lo = args.ph_lo, hi = args.ph_hi;
    XcdBarrier bar; bar.bar = (unsigned*)(F.ctl + CW_BAR); bar.x = 0; bar.st = nullptr;
    if (hi - lo > 1) bar = xcd_barrier_post((unsigned*)(F.ctl + CW_BAR), F.MISC + 8);
#ifndef PROBE_LO
#define PROBE_LO -1
#define PROBE_HI -1
#endif
#define IN(k) (lo <= (k) && (k) < hi)
#define SEAM(k) do { if (IN(k) && IN((k) + 1)) xcd_barrier(bar); } while (0)
#define PH0 { p0_prep(F); }
#define PH1 { p1_hx(F); }
#define PH2 { pg8::Gemm g{(const pg8::bf16_t*)(F.ws + WS_HX), (const pg8::bf16_t*)(F.ws + WS_WINT), MA, NPROJ_PAD, D}; pg8::StaticOrder S; S.init(MA, NPROJ_PAD, F.G, F.bid); \
        pg8::EpiProj E{(pg8::bf16_t*)(F.ws + WS_PROJ), NPROJ, NPROJ}; \
        pg8::gemm_phase<pg8::EpiProj, pg8::StaticOrder, PG8_ALIGN, PG8_SP2>(F.lds, g, S, E); }
#define PH3 { p3_scan<0>(F, bar); }
#define PH4 { p4_mix(F); }
#define PH5 { pg8::Gemm g{(const pg8::bf16_t*)(F.ws + WS_HX), (const pg8::bf16_t*)(F.ws + WS_WOUTT), MX, D, D}; pg8::StaticOrder S; S.init(MX, D, F.G, F.bid); \
        pg8::EpiF32 E{(float*)(F.ws + WS_PROJ), D}; \
        pg8::gemm_phase<pg8::EpiF32, pg8::StaticOrder, PG8_ALIGN, PG8_SP2>(F.lds, g, S, E); }
#define PH6 { p6_mid(F); }
#define PH7 { pg8::Gemm g{(const pg8::bf16_t*)(F.ws + WS_HX), (const pg8::bf16_t*)(F.ws + WS_WEFFT), MX, NSC, D}; pg8::StaticOrder S; S.init(MX, NSC, F.G, F.bid); \
        pg8::EpiF32 E{(float*)(F.ws + WS_PROJ), NSC}; \
        pg8::gemm_phase<pg8::EpiF32, pg8::StaticOrder, PG8_ALIGN, PG8_SP2>(F.lds, g, S, E); }
#define PH8 { p8a_route(F); }
#define PH9 { p9_upass(F); }
#define PH10 { p10_combine(F); }
#define PH11 { p11_vpass<0>(F); }
#define PH12 { p12_final(F); }
#define PRB(k, body) if constexpr (PROBE_LO <= (k) && (k) <= PROBE_HI) { xcd_barrier(bar); body }
    if (IN(0)) PH0 PRB(0, PH0) SEAM(0);
    if (IN(1)) PH1 PRB(1, PH1) SEAM(1);
    if (IN(2)) PH2 PRB(2, PH2) SEAM(2);
    if (IN(3)) PH3 PRB(3, PH3) SEAM(3);
    if (IN(4)) PH4 PRB(4, PH4) SEAM(4);
    if (IN(5)) PH5 PRB(5, PH5) SEAM(5);
    if (IN(6)) PH6 PRB(6, PH6) SEAM(6);
    if (IN(7)) PH7 PRB(7, PH7) SEAM(7);
    if (IN(8)) PH8 PRB(8, PH8) SEAM(8);
    if (IN(9)) PH9 PRB(9, PH9) SEAM(9);
    if (IN(10)) PH10 PRB(10, PH10) SEAM(10);
    if constexpr (PROBE_LO == 111) { p11_vpass<1>(F); xcd_barrier(bar); }
    if constexpr (PROBE_LO == 112) { p11_vpass<2>(F); xcd_barrier(bar); }
    if (IN(11)) PH11 PRB(11, PH11) SEAM(11);
    if (IN(12)) PH12
#undef IN
#undef SEAM
}

extern "C" void kernel_launch(void* const* d_in, const int* in_sizes, int n_in, void* d_out, int out_size, void* d_ws, size_t ws_size, hipStream_t stream) {
    static int grid = 0;
    if (grid == 0) {
        if (n_in != 25 || in_sizes[0] != MX * D || out_size != MX * D || ws_size < WS_END) { fprintf(stderr, "kernel_launch: unexpected problem (n_in %d, in0 %d, out %d, ws %zu); nothing launched\n", n_in, n_in > 0 ? in_sizes[0] : -1, out_size, ws_size); grid = -1; return; }
        int dev = 0, cus = 0, per_cu = 0;
        if (hipGetDevice(&dev) != hipSuccess || hipDeviceGetAttribute(&cus, hipDeviceAttributeMultiprocessorCount, dev) != hipSuccess) { fprintf(stderr, "kernel_launch: device query failed\n"); grid = -1; return; }
        if (hipFuncSetAttribute((const void*)mk_fwd, hipFuncAttributeMaxDynamicSharedMemorySize, LDS_BYTES) != hipSuccess) { fprintf(stderr, "kernel_launch: hipFuncSetAttribute failed\n"); grid = -1; return; }
        if (hipOccupancyMaxActiveBlocksPerMultiprocessor(&per_cu, (const void*)mk_fwd, NWAVES * 64, LDS_BYTES) != hipSuccess || per_cu < 1) fprintf(stderr, "kernel_launch: occupancy query reports %d workgroups per CU\n", per_cu);
        (void)hipGetLastError();
        grid = cus;
    }
    if (grid < 0) return;
    if (hipMemsetAsync((char*)d_ws + WS_CTL, 0, CTL_ZERO_BYTES, stream) != hipSuccess) { fprintf(stderr, "kernel_launch: memset failed\n"); return; }
    Args a{};
    for (int i = 0; i < 25; ++i) a.in[i] = (const float*)d_in[i];
    a.out = (float*)d_out; a.ws = (unsigned char*)d_ws;
    if (MK_N_LAUNCHES == 1) { a.ph_lo = 0; a.ph_hi = NPH; hipLaunchKernelGGL(mk_fwd, dim3(grid), dim3(NWAVES * 64), LDS_BYTES, stream, a); }
    else for (int p = 0; p < NPH; ++p) { a.ph_lo = p; a.ph_hi = p + 1; hipLaunchKernelGGL(mk_fwd, dim3(grid), dim3(NWAVES * 64), LDS_BYTES, stream, a); }
    const hipError_t le = hipPeekAtLastError();
    if (le != hipSuccess) fprintf(stderr, "kernel_launch: launch failed: %s\n", hipGetErrorName(le));
}
```

```cpp
#include <hip/hip_runtime.h>
#include <cstdio>
#include <cstdint>
namespace pg8 {
#define PG8_LAS __attribute__((address_space(3)))
typedef unsigned short bf16_t;
typedef short bf16x8 __attribute__((ext_vector_type(8)));
typedef float f32x4 __attribute__((ext_vector_type(4)));
typedef unsigned u32x4 __attribute__((ext_vector_type(4)));
constexpr int BM = 256, BK = 64, HALF = 128, HTB = HALF * BK * 2  , STAGE_BYTES = 8 * HTB, NXCD = 8, WGM = 8;

__host__ __device__ __forceinline__ int lds_byte(int r, int c) { const int st = (r >> 4) * 2 + (c >> 5), rr = r & 15, cc = c & 31, ob = rr * 64 + cc * 2; return st * 1024 + (ob ^ (((ob >> 9) & 1) << 5)); }
__host__ __device__ __forceinline__ void stage_rc(int b, int& R, int& C) { const int st = b / 1024, sb = b % 1024, swz = sb ^ (((sb >> 9) & 1) << 5); R = (st >> 1) * 16 + swz / 64; C = (st & 1) * 32 + (swz % 64) / 2; }
__host__ __device__ __forceinline__ int perm32(int rho) { const int n = rho >> 4, i = rho & 15; return 8 * (i >> 2) + 4 * n + (i & 3); }

struct Unit { int pm, pn; };
struct Gemm { const bf16_t* A; const bf16_t* Bt; int M, N, K; };

struct StaticOrder {
    int nM, nN, nwg, G, c;
    __host__ __device__ void init(int M, int N, int G_, int c_) { nM = M / BM; nN = N / BM; nwg = nM * nN; G = G_; c = c_; }
    __host__ __device__ bool next(int i, Unit& u) const {
        const long L = (long)i * G + c; if (L >= nwg) return false;
        int wgid = (int)L; { const int q = nwg / NXCD, r = nwg % NXCD, xcd = wgid % NXCD, off = wgid / NXCD; wgid = (xcd < r ? xcd * (q + 1) : r * (q + 1) + (xcd - r) * q) + off; }
        const int nig = WGM * nN, gid = wgid / nig, fm = gid * WGM, gsz = (nM - fm) < WGM ? (nM - fm) : WGM;
        u.pm = fm + ((wgid % nig) % gsz); u.pn = (wgid % nig) / gsz; return true;
    }
    __device__ __forceinline__ void a_ready(const Unit&) const {}
    __device__ __forceinline__ void done(const Unit&) const {}
};

__device__ __forceinline__ unsigned cvt_pk_bf16(float lo, float hi) { unsigned r; asm volatile("v_cvt_pk_bf16_f32 %0, %1, %2" : "=v"(r) : "v"(lo), "v"(hi)); return r; }
typedef float f32x2 __attribute__((ext_vector_type(2)));
__device__ __forceinline__ f32x2 gelu_pk(f32x2 v) {
    const f32x2 av = __builtin_elementwise_abs(v), d = av * 0.2316418882f + 1.0f;
    f32x2 t; t.x = __builtin_amdgcn_rcpf(d.x); t.y = __builtin_amdgcn_rcpf(d.y);
    f32x2 q = t * 0.5307027145f + (-0.7265760135f); q = q * t + 0.7107068705f; q = q * t + (-0.142248368f); q = q * t + 0.127414796f; q = q * t;
    const f32x2 s = (v * v) * (-0.72134752044f);
    f32x2 e; e.x = __builtin_amdgcn_exp2f(s.x); e.y = __builtin_amdgcn_exp2f(s.y);
    const f32x2 m = v * (q * e), r = v - m;
    f32x2 o; o.x = v.x < 0.f ? m.x : r.x; o.y = v.y < 0.f ? m.y : r.y; return o;
}

template <int ACT  > struct EpiBf16 {
    static constexpr bool PERM = true, AFTER_DRAIN = false; static_assert(ACT == 0 || ACT == 1, "EpiBf16: ACT is 0 (none) or 1 (gelu_pk)");
    bf16_t* O; int ldc; const float* bias; int split_cols; size_t split_stride; float scale0;
    __device__ __forceinline__ void operator()(const f32x4 (&acc)[2][2][4][2], const Unit& u, int wr, int wc, int fr, int fq) const {
        const int row0 = u.pm * BM + wr * 64 + fr; int colt = u.pn * BM; bf16_t* base = O;
        float sc = 1.f; if (split_cols) { const int t = colt / split_cols; base += (size_t)t * split_stride; colt -= t * split_cols; if (t == 0) sc = scale0; }
        const int col0 = colt + wc * 32 + 8 * fq, bcol0 = u.pn * BM + wc * 32 + 8 * fq;
        f32x4 bv[2][2];
#pragma unroll
        for (int bj = 0; bj < 2; ++bj)
#pragma unroll
            for (int n = 0; n < 2; ++n) bv[bj][n] = bias ? *(const f32x4*)(bias + bcol0 + bj * HALF + 4 * n) : (f32x4){0.f, 0.f, 0.f, 0.f};
#pragma unroll
        for (int ai = 0; ai < 2; ++ai)
#pragma unroll
            for (int m = 0; m < 4; ++m) { bf16_t* rowp = base + (size_t)(row0 + ai * HALF + m * 16) * ldc + col0;
#pragma unroll
                for (int bj = 0; bj < 2; ++bj) { f32x4 v0 = acc[ai][bj][m][0] + bv[bj][0], v1 = acc[ai][bj][m][1] + bv[bj][1];
                    if (ACT == 1) { f32x2 a = gelu_pk((f32x2){v0[0], v0[1]}), b = gelu_pk((f32x2){v0[2], v0[3]}), c = gelu_pk((f32x2){v1[0], v1[1]}), d = gelu_pk((f32x2){v1[2], v1[3]});
                        v0 = (f32x4){a.x, a.y, b.x, b.y}; v1 = (f32x4){c.x, c.y, d.x, d.y}; }
                    v0 = v0 * sc; v1 = v1 * sc; u32x4 w; w.x = cvt_pk_bf16(v0[0], v0[1]); w.y = cvt_pk_bf16(v0[2], v0[3]); w.z = cvt_pk_bf16(v1[0], v1[1]); w.w = cvt_pk_bf16(v1[2], v1[3]);
                    *(u32x4*)(rowp + bj * HALF) = w; } }
    }
};

struct EpiF32 {
    static constexpr bool PERM = false, AFTER_DRAIN = false;
    float* C; int ldc;
    __device__ __forceinline__ void operator()(const f32x4 (&acc)[2][2][4][2], const Unit& u, int wr, int wc, int fr, int fq) const {
        const int row0 = u.pm * BM + wr * 64 + fr, col0 = u.pn * BM + wc * 32 + 4 * fq;
#pragma unroll
        for (int ai = 0; ai < 2; ++ai)
#pragma unroll
            for (int m = 0; m < 4; ++m) { float* rowp = C + (size_t)(row0 + ai * HALF + m * 16) * ldc + col0;
#pragma unroll
                for (int bj = 0; bj < 2; ++bj)
#pragma unroll
                    for (int n = 0; n < 2; ++n) *(f32x4*)(rowp + bj * HALF + n * 16) = acc[ai][bj][m][n]; }
    }
};
struct EpiProj {
    static constexpr bool PERM = true, AFTER_DRAIN = false;
    bf16_t* O; int ldc; int ncols;
    __device__ __forceinline__ void operator()(const f32x4 (&acc)[2][2][4][2], const Unit& u, int wr, int wc, int fr, int fq) const {
        const int row0 = u.pm * BM + wr * 64 + fr; const int col0 = u.pn * BM + wc * 32 + 8 * fq;
#pragma unroll
        for (int ai = 0; ai < 2; ++ai)
#pragma unroll
            for (int m = 0; m < 4; ++m) { bf16_t* rowp = O + (size_t)(row0 + ai * HALF + m * 16) * ldc + col0;
#pragma unroll
                for (int bj = 0; bj < 2; ++bj) { const f32x4 v0 = acc[ai][bj][m][0], v1 = acc[ai][bj][m][1];
                    u32x4 w; w.x = cvt_pk_bf16(v0[0], v0[1]); w.y = cvt_pk_bf16(v0[2], v0[3]); w.z = cvt_pk_bf16(v1[0], v1[1]); w.w = cvt_pk_bf16(v1[2], v1[3]);
                    if (col0 + bj * HALF < ncols) *(u32x4*)(rowp + bj * HALF) = w; } }
    }
};
template <class Epi, class Sched, bool ALIGN_EPI = false, bool SP2 = false>
__device__ __forceinline__ void gemm_phase(PG8_LAS unsigned char* lds, const Gemm g, const Sched& S, const Epi& E) {
    const int tid = threadIdx.x, wid = __builtin_amdgcn_readfirstlane(tid >> 6), lane = tid & 63, wr = wid >> 2, wc = wid & 3, fr = lane & 15, fq = lane >> 4;
    const int K = g.K, nt = K / BK;
    unsigned voffA[2], voffB[2];
#pragma unroll
    for (int i = 0; i < 2; ++i) { int R, C; stage_rc(tid * 16 + i * 8192, R, C); const int Rb = Epi::PERM ? ((R & ~31) + perm32(R & 31)) : R;
        voffA[i] = (unsigned)(R * K + C) * 2u; voffB[i] = (unsigned)(Rb * K + C) * 2u; }
    const size_t kstep = (size_t)(BK * 2);
    const size_t hstep = (size_t)HALF * K * 2;
    const size_t tstep = 2 * hstep;
    const unsigned ldsw = (unsigned)wid * 1024u;
    const int aoff = lds_byte(wr * 64 + fr, fq * 8), boff = lds_byte(wc * 32 + fr, fq * 8);
#define PG8_SA(b, h) (((b) * 2 + (h)) * HTB)
#define PG8_SB(b, h) ((4 + (b) * 2 + (h)) * HTB)
#define PG8_STAGE(bufoff, gbase, voff) do { _Pragma("unroll") for (int _i = 0; _i < 2; ++_i) \
        __builtin_amdgcn_global_load_lds((const unsigned*)((const char*)(gbase) + (voff)[_i]), (PG8_LAS unsigned*)(lds + (bufoff) + ldsw + _i * 8192), 16, 0, 0); } while (0)
#define PG8_LDA(dst, b, h) do { _Pragma("unroll") for (int m = 0; m < 4; ++m) _Pragma("unroll") for (int k = 0; k < 2; ++k) dst[m][k] = *(const PG8_LAS bf16x8*)(lds + PG8_SA(b, h) + aoff + m * 2048 + k * 1024); } while (0)
#define PG8_LDB(dst, b, h) do { _Pragma("unroll") for (int n = 0; n < 2; ++n) _Pragma("unroll") for (int k = 0; k < 2; ++k) dst[n][k] = *(const PG8_LAS bf16x8*)(lds + PG8_SB(b, h) + boff + n * 2048 + k * 1024); } while (0)
#define PG8_MMA(ai, bj, At, Bt) do { __builtin_amdgcn_s_setprio(1); _Pragma("unroll") for (int m = 0; m < 4; ++m) _Pragma("unroll") for (int n = 0; n < 2; ++n) _Pragma("unroll") for (int k = 0; k < 2; ++k) \
        acc[ai][bj][m][n] = __builtin_amdgcn_mfma_f32_16x16x32_bf16(Bt[n][k], At[m][k], acc[ai][bj][m][n], 0, 0, 0); __builtin_amdgcn_s_setprio(0); } while (0)
#define PG8_WAIT_V(n) asm volatile("s_waitcnt vmcnt(" #n ")" ::: "memory")
#define PG8_WAIT_L(n) asm volatile("s_waitcnt lgkmcnt(" #n ")" ::: "memory")
#define PG8_BAR __builtin_amdgcn_s_barrier()
#define PG8_SCHED __builtin_amdgcn_sched_barrier(0)
    Unit cur, nxt; int ui = 0;
    if (!S.next(0, cur)) return;
    f32x4 acc[2][2][4][2];
#pragma unroll
    for (int a = 0; a < 2; ++a)
#pragma unroll
        for (int b = 0; b < 2; ++b)
#pragma unroll
            for (int m = 0; m < 4; ++m)
#pragma unroll
                for (int n = 0; n < 2; ++n) acc[a][b][m][n] = (f32x4){0.f, 0.f, 0.f, 0.f};
    bf16x8 At[4][2], B0[2][2], B1[2][2];
    const char* cA = (const char*)g.A + (size_t)cur.pm * tstep; const char* cB = (const char*)g.Bt + (size_t)cur.pn * tstep;
    S.a_ready(cur);
    if constexpr (SP2) {
        PG8_STAGE(PG8_SB(0, 0), cB, voffB); PG8_STAGE(PG8_SB(0, 1), cB + hstep, voffB); PG8_STAGE(PG8_SA(0, 0), cA, voffA); PG8_STAGE(PG8_SA(0, 1), cA + hstep, voffA);
        if (wr == 1) PG8_BAR;
        PG8_WAIT_V(2); PG8_BAR;
        PG8_STAGE(PG8_SB(1, 0), cB + kstep, voffB); PG8_STAGE(PG8_SA(1, 0), cA + kstep, voffA); PG8_STAGE(PG8_SB(1, 1), cB + hstep + kstep, voffB);
        PG8_WAIT_V(6); PG8_BAR;
    } else {
        PG8_STAGE(PG8_SB(0, 0), cB, voffB); PG8_STAGE(PG8_SA(0, 0), cA, voffA); PG8_STAGE(PG8_SB(0, 1), cB + hstep, voffB); PG8_STAGE(PG8_SA(0, 1), cA + hstep, voffA);
        if (wr == 1) PG8_BAR;
        PG8_WAIT_V(4); PG8_BAR;
        PG8_STAGE(PG8_SB(1, 0), cB + kstep, voffB); PG8_STAGE(PG8_SA(1, 0), cA + kstep, voffA); PG8_STAGE(PG8_SB(1, 1), cB + hstep + kstep, voffB);
        PG8_WAIT_V(6); PG8_BAR;
    }
    for (;;) {
        const bool has_next = S.next(ui + 1, nxt);
        const char* nA = has_next ? (const char*)g.A + (size_t)nxt.pm * tstep : cA; const char* nB = has_next ? (const char*)g.Bt + (size_t)nxt.pn * tstep : cB;
        for (int t = 0; t < nt; t += 2) {
            const bool last = (t == nt - 2);
            const char* a1 = cA + (size_t)(t + 1) * kstep;
            const char* a2 = last ? nA : cA + (size_t)(t + 2) * kstep; const char* b2 = last ? nB : cB + (size_t)(t + 2) * kstep;
            const char* a3 = a2 + kstep; const char* b3 = b2 + kstep;
            if (last && has_next) S.a_ready(nxt);
            if constexpr (SP2) {
            PG8_LDB(B0, 0, 0); PG8_LDB(B1, 0, 1); PG8_SCHED; PG8_LDA(At, 0, 0); PG8_STAGE(PG8_SA(1, 1), a1 + hstep, voffA);
            PG8_WAIT_V(8); PG8_WAIT_L(0); PG8_BAR; PG8_MMA(0, 0, At, B0); PG8_MMA(0, 1, At, B1); PG8_BAR; PG8_SCHED;
            PG8_LDA(At, 0, 1); PG8_STAGE(PG8_SB(0, 0), b2, voffB); PG8_STAGE(PG8_SB(0, 1), b2 + hstep, voffB); PG8_STAGE(PG8_SA(0, 0), a2, voffA);
            PG8_WAIT_V(8); PG8_WAIT_L(0); PG8_BAR; PG8_MMA(1, 0, At, B0); PG8_MMA(1, 1, At, B1); PG8_BAR; PG8_SCHED;
            PG8_LDB(B0, 1, 0); PG8_LDB(B1, 1, 1); PG8_SCHED; PG8_LDA(At, 1, 0); PG8_STAGE(PG8_SA(0, 1), a2 + hstep, voffA);
            PG8_WAIT_V(8); PG8_WAIT_L(0); PG8_BAR; PG8_MMA(0, 0, At, B0); PG8_MMA(0, 1, At, B1); PG8_BAR; PG8_SCHED;
            PG8_LDA(At, 1, 1); PG8_STAGE(PG8_SB(1, 0), b3, voffB); PG8_STAGE(PG8_SB(1, 1), b3 + hstep, voffB); PG8_STAGE(PG8_SA(1, 0), a3, voffA);
            PG8_WAIT_V(8); PG8_WAIT_L(0); PG8_BAR; PG8_MMA(1, 0, At, B0); PG8_MMA(1, 1, At, B1); PG8_BAR; PG8_SCHED;
            } else {
            PG8_LDB(B0, 0, 0); PG8_SCHED; PG8_LDA(At, 0, 0); PG8_STAGE(PG8_SA(1, 1), a1 + hstep, voffA);
            PG8_WAIT_L(8); PG8_BAR; PG8_WAIT_L(0); PG8_MMA(0, 0, At, B0); PG8_BAR; PG8_SCHED;
            PG8_LDB(B1, 0, 1); PG8_STAGE(PG8_SB(0, 0), b2, voffB);
            PG8_BAR; PG8_WAIT_L(0); PG8_MMA(0, 1, At, B1); PG8_BAR;
            PG8_LDA(At, 0, 1); PG8_STAGE(PG8_SA(0, 0), a2, voffA);
            PG8_BAR; PG8_WAIT_L(0); PG8_MMA(1, 0, At, B0); PG8_BAR; PG8_SCHED;
            PG8_STAGE(PG8_SB(0, 1), b2 + hstep, voffB);
            PG8_WAIT_V(6); PG8_BAR; PG8_MMA(1, 1, At, B1); PG8_BAR;
            PG8_LDB(B0, 1, 0); PG8_SCHED; PG8_LDA(At, 1, 0); PG8_STAGE(PG8_SA(0, 1), a2 + hstep, voffA);
            PG8_WAIT_L(8); PG8_BAR; PG8_WAIT_L(0); PG8_MMA(0, 0, At, B0); PG8_BAR; PG8_SCHED;
            PG8_LDB(B1, 1, 1); PG8_STAGE(PG8_SB(1, 0), b3, voffB);
            PG8_BAR; PG8_WAIT_L(0); PG8_MMA(0, 1, At, B1); PG8_BAR;
            PG8_LDA(At, 1, 1); PG8_STAGE(PG8_SA(1, 0), a3, voffA);
            PG8_BAR; PG8_WAIT_L(0); PG8_MMA(1, 0, At, B0); PG8_BAR; PG8_SCHED;
            PG8_STAGE(PG8_SB(1, 1), b3 + hstep, voffB);
            PG8_WAIT_V(6); PG8_BAR; PG8_MMA(1, 1, At, B1); PG8_BAR;
            }
        }
        if constexpr (ALIGN_EPI) { if (wr == 0) PG8_BAR; }
        if constexpr (!Epi::AFTER_DRAIN) { E(acc, cur, wr, wc, fr, fq); S.done(cur); }
        if (!has_next) break;
#pragma unroll
        for (int a = 0; a < 2; ++a)
#pragma unroll
            for (int b = 0; b < 2; ++b)
#pragma unroll
                for (int m = 0; m < 4; ++m)
#pragma unroll
                    for (int n = 0; n < 2; ++n) acc[a][b][m][n] = (f32x4){0.f, 0.f, 0.f, 0.f};
        cur = nxt; cA = nA; cB = nB; ++ui;
        if constexpr (ALIGN_EPI) { if (wr == 1) PG8_BAR; }
    }
    PG8_WAIT_V(0);
    if constexpr (!ALIGN_EPI) { if (wr == 0) PG8_BAR; }
    PG8_BAR;
    if constexpr (Epi::AFTER_DRAIN) { E.fused(acc, cur, wr, wc, fr, fq, lds, wid, lane); S.done(cur); }
#undef PG8_SA
#undef PG8_SB
#undef PG8_STAGE
#undef PG8_LDA
#undef PG8_LDB
#undef PG8_MMA
#undef PG8_WAIT_V
#undef PG8_WAIT_L
#undef PG8_BAR
#undef PG8_SCHED
}
}
#ifndef PG8_SP2
#define PG8_SP2 true
#endif
#ifndef PG8_ALIGN
#define PG8_ALIGN true
#endif
constexpr int NWAVES = 8;
constexpr int D = 1024, NB = 4, T = 4096, TC = 256;
constexpr int MX = NB * T, MC = NB * TC, MA = MX + MC;
constexpr int NPROJ = 3456, NPROJ_PAD = 3584;
constexpr int COL_XB = 0, COL_XG = 512, COL_XC = 1024, COL_R = 1536, COL_K = 2048, COL_V = 2560, COL_G = 3072, COL_LW = 3200, COL_LA = 3328;
constexpr int NMOD = 6 * D;
constexpr int NEXP = 16384, NSC = 2048;
constexpr float NORM_EPS = 1e-6f, LNX_EPS = 64e-5f;
#ifndef MK_N_LAUNCHES
#define MK_N_LAUNCHES 1
#endif
constexpr int NPH = 13;
constexpr size_t MiB = 1u << 20;
constexpr size_t WS_CTL = 0, CTL_ZERO_BYTES = 64 * 1024;
constexpr size_t WS_MOD = 3 * MiB;
constexpr size_t WS_WINT = 6 * MiB;
constexpr size_t WS_WOUTT = 13 * MiB;
constexpr size_t WS_WEFFT = 15 * MiB;
constexpr size_t WS_U = 20 * MiB, WS_V = 52 * MiB;
constexpr size_t WS_HX = 84 * MiB;
constexpr size_t WS_PROJ = 118 * MiB;
constexpr size_t WS_END = 246 * MiB;
constexpr size_t WS_EXL = WS_V, WS_GL = WS_V + 4 * MiB, WS_PL = WS_V + 12 * MiB;
constexpr size_t WS_BLOB0 = WS_V, WS_BLOB1 = WS_HX;
constexpr size_t WS_PART = WS_PROJ, WS_PO = WS_PROJ + 64 * MiB;
static_assert(WS_PROJ + (size_t)MA * NPROJ * 2 <= WS_END && WS_PROJ + (size_t)MX * NSC * 4 <= WS_END && WS_HX + (size_t)MA * D * 2 <= WS_PROJ, "d_ws map");
constexpr int CW_BAR = 1024;
constexpr int RING_BYTES = 131072;
constexpr int LDSCTL_OFF = RING_BYTES, MISC_OFF = LDSCTL_OFF + 320;
constexpr int LDS_BYTES = 147456;

#define GAS __attribute__((address_space(1)))
#define LAS __attribute__((address_space(3)))
typedef unsigned short bf16;
typedef unsigned v4u __attribute__((ext_vector_type(4)));
typedef unsigned v2u __attribute__((ext_vector_type(2)));
typedef float f32x4 __attribute__((ext_vector_type(4)));
typedef float f32x2 __attribute__((ext_vector_type(2)));
typedef float f32x16 __attribute__((ext_vector_type(16)));
typedef short bf16x8 __attribute__((ext_vector_type(8)));
typedef GAS unsigned gu32;
#define RLX_AGENT __ATOMIC_RELAXED, __HIP_MEMORY_SCOPE_AGENT
#define LDS_WAIT() asm volatile("s_waitcnt lgkmcnt(0)" ::: "memory")
#define VM_WAIT() asm volatile("s_waitcnt vmcnt(0)" ::: "memory")
typedef __bf16 bf16v2 __attribute__((ext_vector_type(2)));
__device__ __forceinline__ unsigned pk2(float lo, float hi) { const f32x2 v = {lo, hi}; return __builtin_bit_cast(unsigned, __builtin_convertvector(v, bf16v2)); }
__device__ __forceinline__ float bf_lo(unsigned w) { return __builtin_bit_cast(float, w << 16); }
__device__ __forceinline__ float bf_hi(unsigned w) { return __builtin_bit_cast(float, w & 0xffff0000u); }
__device__ __forceinline__ float bf1(bf16 b) { return __builtin_bit_cast(float, (unsigned)b << 16); }
__device__ __forceinline__ float fast_exp(float x) { return __builtin_amdgcn_exp2f(x * 1.44269504089f); }
__device__ __forceinline__ float fast_rcp(float x) { return __builtin_amdgcn_rcpf(x); }
__device__ __forceinline__ float sigmoidf(float x) { return fast_rcp(1.f + fast_exp(-x)); }
__device__ __forceinline__ float tanh_fast(float x) { return 1.f - 2.f * fast_rcp(fast_exp(2.f * x) + 1.f); }
__device__ __forceinline__ float siluf(float x) { return x * sigmoidf(x); }
template <int CTRL> __device__ __forceinline__ float dppf(float x) { return __builtin_bit_cast(float, __builtin_amdgcn_update_dpp(0, __builtin_bit_cast(int, x), CTRL, 0xF, 0xF, false)); }
template <int CTRL> __device__ __forceinline__ unsigned dppu(unsigned x) { return (unsigned)__builtin_amdgcn_update_dpp(0, (int)x, CTRL, 0xF, 0xF, false); }
__device__ __forceinline__ float rowsum16(float x) { x += dppf<0xB1>(x); x += dppf<0x4E>(x); x += dppf<0x141>(x); x += dppf<0x140>(x); return x; }
__device__ __forceinline__ float wave_sum(float v) {
    v = rowsum16(v); v += __shfl_xor(v, 16); v += __shfl_xor(v, 32); return v;
}
__device__ __forceinline__ float half_sum32(float v) { v = rowsum16(v); v += __shfl_xor(v, 16); return v; }
__device__ __forceinline__ unsigned umaxu(unsigned a, unsigned b) { return a > b ? a : b; }
__device__ __forceinline__ unsigned wave_max_u32(unsigned x) {
    x = umaxu(x, dppu<0xB1>(x)); x = umaxu(x, dppu<0x4E>(x)); x = umaxu(x, dppu<0x141>(x)); x = umaxu(x, dppu<0x140>(x));
    const unsigned a = __builtin_amdgcn_readlane((int)x, 0), b = __builtin_amdgcn_readlane((int)x, 16), c = __builtin_amdgcn_readlane((int)x, 32), d = __builtin_amdgcn_readlane((int)x, 48);
    return umaxu(umaxu(a, b), umaxu(c, d));
}
__device__ __forceinline__ unsigned f2key(float f) { const unsigned u = __builtin_bit_cast(unsigned, f); return (u & 0x80000000u) ? ~u : (u | 0x80000000u); }
__device__ __forceinline__ float key2f(unsigned k) { const unsigned u = (k & 0x80000000u) ? (k ^ 0x80000000u) : ~k; return __builtin_bit_cast(float, u); }
#define XB_TMO      128
#define XB_XCNT(j)  (256  + 64 * (j))
#define XB_XSUB(j)  (1280 + 64 * (j))
#define XB_XGEN(j)  (2304 + 64 * (j))
#define XB_TOP      3328
#define XB_TOPGEN   3392
#define XCD_BAR_WORDS 3456
#define XB_SPIN_CAP (1u << 18)

__device__ __forceinline__ unsigned xb_ld(unsigned* p)              { return __hip_atomic_load(p, __ATOMIC_RELAXED, __HIP_MEMORY_SCOPE_AGENT); }
__device__ __forceinline__ unsigned xb_add(unsigned* p, unsigned v) { return __hip_atomic_fetch_add(p, v, __ATOMIC_RELAXED, __HIP_MEMORY_SCOPE_AGENT); }
__device__ __forceinline__ unsigned xb_xcc_id() { return (unsigned)__builtin_amdgcn_s_getreg((3 << 11) | 20) & 0xFu; }
#define XB_SPIN(cond, bar) do { unsigned _sp = 0; while (cond) { __builtin_amdgcn_s_sleep(1); \
    if ((++_sp & 255u) == 0u) { if (xb_ld(&(bar)[XB_TMO])) break; if (_sp > XB_SPIN_CAP) { atomicAdd(&(bar)[XB_TMO], 1u); break; } } } } while (0)

struct XcdBarrier {
    unsigned* bar; unsigned x;
    volatile LAS unsigned* st;
};

__device__ __forceinline__ XcdBarrier xcd_barrier_post(unsigned* bar, volatile LAS unsigned* st) {
    XcdBarrier b; b.bar = bar; b.x = xb_xcc_id(); b.st = st;
    if (threadIdx.x == 0) (void)xb_add(&bar[XB_XCNT(b.x)], 1u);
    return b;
}
__device__ __forceinline__ void xcd_barrier_complete(unsigned* bar, unsigned x, unsigned& nloc, unsigned& nx) {
    const unsigned G = gridDim.x * gridDim.y * gridDim.z;
    unsigned sum, cnt, mine, sp = 0u;
    for (;;) {
        sum = 0u; cnt = 0u; mine = 0u;
#pragma unroll
        for (unsigned j = 0; j < 16; ++j) { const unsigned c = xb_ld(&bar[XB_XCNT(j)]); sum += c; cnt += (c > 0u) ? 1u : 0u; mine = (j == x) ? c : mine; }
        if (sum == G) break;
        __builtin_amdgcn_s_sleep(1);
        if ((++sp & 255u) == 0u) { if (xb_ld(&bar[XB_TMO])) break; if (sp > XB_SPIN_CAP) { atomicAdd(&bar[XB_TMO], 1u); break; } }
    }
    nloc = mine > 0u ? mine : 1u; nx = cnt > 0u ? cnt : 1u;
}

__device__ __forceinline__ void xcd_barrier(const XcdBarrier& b) {
    asm volatile("s_waitcnt vmcnt(0)" ::: "memory");
    __syncthreads();
    if (threadIdx.x == 0) {
        unsigned* bar = b.bar;
        __builtin_amdgcn_s_waitcnt(0);
        unsigned nloc = b.st[0], nx = b.st[1];
        if (nloc == 0u) { xcd_barrier_complete(bar, b.x, nloc, nx); b.st[0] = nloc; b.st[1] = nx; }
        const unsigned old = xb_add(&bar[XB_XSUB(b.x)], 1u);
        const unsigned gen = old / nloc;
        if (old + 1u == (gen + 1u) * nloc) {
            __builtin_amdgcn_fence(__ATOMIC_RELEASE, "agent");
            asm volatile("s_waitcnt vmcnt(0)" ::: "memory");
            const unsigned og = xb_add(&bar[XB_TOP], 1u);
            const unsigned tg = og / nx;
            if (og + 1u == (tg + 1u) * nx) xb_add(&bar[XB_TOPGEN], 1u);
            else XB_SPIN(xb_ld(&bar[XB_TOPGEN]) == tg, bar);
            __builtin_amdgcn_fence(__ATOMIC_ACQUIRE, "agent");
            xb_add(&bar[XB_XGEN(b.x)], 1u);
            asm volatile("s_waitcnt vmcnt(0)" ::: "memory");
        } else {
            XB_SPIN(xb_ld(&bar[XB_XGEN(b.x)]) == gen, bar);
            __builtin_amdgcn_fence(__ATOMIC_ACQUIRE, "agent");
            asm volatile("s_waitcnt vmcnt(0)" ::: "memory");
        }
    }
    __syncthreads();
}
struct Frame {
    LAS unsigned char* lds;
    volatile LAS unsigned* MISC;
    gu32* ctl;
    int tid, lane, wave, G, bid;
    const float* in[25];
    float* out;
    unsigned char* ws;
};
enum { I_X = 0, I_C, I_CTX, I_CCTX, I_WMOD, I_BMOD, I_NG, I_WIN, I_WOUT, I_CONVW, I_TMU, I_DW0, I_DW2, I_A0, I_A2, I_GW2, I_KK, I_KA, I_RK, I_LNG, I_LNB, I_WQ, I_SUBK, I_PU, I_PV };

__device__ __forceinline__ void p0_transpose_item(const float* W, int K, int N, bf16* WT, LAS float* scr, int item, int lane) {
    const int nblk = N / 32, kb = item / nblk, nb = item % nblk, k0 = 64 * kb, n0 = 32 * nb;
#pragma unroll 8
    for (int i = 0; i < 32; ++i) { const int kk = 2 * i + (lane >> 5); scr[kk * 33 + (lane & 31)] = W[(size_t)(k0 + kk) * N + n0 + (lane & 31)]; }
    LDS_WAIT(); asm volatile("" ::: "memory");
    const int c = lane & 7;
#pragma unroll
    for (int j = 0; j < 4; ++j) { const int n = (lane >> 3) + 8 * j; const LAS float* s = scr + (8 * c) * 33 + n;
        v4u o; o.x = pk2(s[0 * 33], s[1 * 33]); o.y = pk2(s[2 * 33], s[3 * 33]); o.z = pk2(s[4 * 33], s[5 * 33]); o.w = pk2(s[6 * 33], s[7 * 33]);
        *(v4u*)(WT + (size_t)(n0 + n) * K + k0 + 8 * c) = o; }
    LDS_WAIT(); asm volatile("" ::: "memory");
}
__device__ __forceinline__ void p0_mod_item(Frame& F, int cb) {
    LAS float* S = (LAS float*)F.lds;
    LAS float* RED = (LAS float*)(F.lds + 32768);
    const float* c = F.in[I_C]; const float* cc = F.in[I_CCTX];
    for (int i = F.tid; i < 5 * D; i += 512) { const int r = i >> 10, k = i & 1023; const float v = (r < 4) ? c[r * D + k] : cc[k]; S[i] = siluf(v); }
    __syncthreads();
    const int col = F.tid & 63, kg = F.tid >> 6;
    const float* wp = F.in[I_WMOD] + (size_t)(kg * 128) * NMOD + cb * 64 + col;
    float a0 = 0.f, a1 = 0.f, a2 = 0.f, a3 = 0.f, a4 = 0.f;
#pragma unroll 8
    for (int k = 0; k < 128; ++k) { const float w = wp[(size_t)k * NMOD]; const int kk = kg * 128 + k;
        a0 += S[kk] * w; a1 += S[D + kk] * w; a2 += S[2 * D + kk] * w; a3 += S[3 * D + kk] * w; a4 += S[4 * D + kk] * w; }
    RED[(kg * 5 + 0) * 64 + col] = a0; RED[(kg * 5 + 1) * 64 + col] = a1; RED[(kg * 5 + 2) * 64 + col] = a2; RED[(kg * 5 + 3) * 64 + col] = a3; RED[(kg * 5 + 4) * 64 + col] = a4;
    __syncthreads();
    if (F.tid < 320) { const int r = F.tid >> 6, cl = F.tid & 63; float s = F.in[I_BMOD][cb * 64 + cl];
#pragma unroll
        for (int g = 0; g < 8; ++g) s += RED[(g * 5 + r) * 64 + cl];
        ((float*)(F.ws + WS_MOD))[r * NMOD + cb * 64 + cl] = s; }
    __syncthreads();
}
__device__ __forceinline__ void p0_weff_item(Frame& F, int item) {
    const int hs = item >> 4, kb = item & 15;
    LAS float* SK = (LAS float*)F.lds;
    LAS float* WQ = (LAS float*)(F.lds + 128 * 132 * 4);
    const float* sk = F.in[I_SUBK] + (size_t)hs * 128 * 128;
    const float* wq = F.in[I_WQ] + (size_t)(kb * 64) * 2048 + hs * 128;
#pragma unroll
    for (int i = 0; i < 8; ++i) { const int idx = F.tid + 512 * i, row = idx >> 5, c4 = idx & 31; const f32x4 v = *(const f32x4*)(sk + row * 128 + c4 * 4); *(LAS f32x4*)(SK + row * 132 + c4 * 4) = v; }
#pragma unroll
    for (int i = 0; i < 4; ++i) { const int idx = F.tid + 512 * i, row = idx >> 5, c4 = idx & 31; const f32x4 v = *(const f32x4*)(wq + (size_t)row * 2048 + c4 * 4); *(LAS f32x4*)(WQ + row * 132 + c4 * 4) = v; }
    __syncthreads();
    const int key = F.tid >> 2, kq = F.tid & 3;
    float acc[16];
#pragma unroll
    for (int i = 0; i < 16; ++i) acc[i] = 0.f;
    for (int d = 0; d < 128; d += 4) {
        const f32x4 a = *(const LAS f32x4*)(SK + key * 132 + d);
#pragma unroll
        for (int i = 0; i < 16; ++i) { const f32x4 b = *(const LAS f32x4*)(WQ + (4 * i + kq) * 132 + d); acc[i] += a.x * b.x + a.y * b.y + a.z * b.z + a.w * b.w; }
    }
    bf16* dst = (bf16*)(F.ws + WS_WEFFT) + (size_t)(hs * 128 + key) * D + kb * 64;
#pragma unroll
    for (int i = 0; i < 16; ++i) dst[4 * i + kq] = (bf16)(pk2(acc[i], 0.f) & 0xffffu);
    __syncthreads();
}
__device__ __forceinline__ void p0_prep(Frame& F) {
    for (int it = F.bid; it < 96 + 256; it += F.G) { if (it < 96) p0_mod_item(F, it); else p0_weff_item(F, it - 96); }
    LAS float* scr = (LAS float*)(F.lds + F.wave * 16384);
    const int gw = F.bid * NWAVES + F.wave, NGW = F.G * NWAVES;
    constexpr int I_IN = (D / 64) * (NPROJ / 32), I_OUT = (D / 64) * (D / 32);
    for (int it = gw; it < I_IN + I_OUT; it += NGW) {
        if (it < I_IN) p0_transpose_item(F.in[I_WIN], D, NPROJ, (bf16*)(F.ws + WS_WINT), scr, it, F.lane);
        else p0_transpose_item(F.in[I_WOUT], D, D, (bf16*)(F.ws + WS_WOUTT), scr, it - I_IN, F.lane);
    }
    { v4u* z = (v4u*)((bf16*)(F.ws + WS_WINT) + (size_t)NPROJ * D); const int n16 = (NPROJ_PAD - NPROJ) * D * 2 / 16;
      for (int i = F.bid * 512 + F.tid; i < n16; i += F.G * 512) z[i] = (v4u){0u, 0u, 0u, 0u}; }
    { const f32x4* pu = (const f32x4*)F.in[I_PU]; v4u* du = (v4u*)(F.ws + WS_U);
      const int n8 = NEXP * D / 8;
      for (int i = F.bid * 512 + F.tid; i < n8; i += F.G * 512) {
          const f32x4 a0 = pu[2 * i], a1 = pu[2 * i + 1];
          du[i] = (v4u){pk2(a0.x, a0.y), pk2(a0.z, a0.w), pk2(a1.x, a1.y), pk2(a1.z, a1.w)}; } }
}

__device__ __forceinline__ void p1_hx(Frame& F) {
    const float* mod = (const float*)(F.ws + WS_MOD); const float* ng = F.in[I_NG];
    bf16* hx = (bf16*)(F.ws + WS_HX);
    for (int m = F.bid * NWAVES + F.wave; m < MA; m += F.G * NWAVES) {
        const float* src = (m < MX) ? F.in[I_X] + (size_t)m * D : F.in[I_CTX] + (size_t)(m - MX) * D;
        const float* mr = mod + ((m < MX) ? (m >> 12) : 4) * NMOD;
        f32x4 v[4]; float ss = 0.f;
#pragma unroll
        for (int j = 0; j < 4; ++j) { v[j] = *(const f32x4*)(src + j * 256 + F.lane * 4); ss += v[j].x * v[j].x + v[j].y * v[j].y + v[j].z * v[j].z + v[j].w * v[j].w; }
        const float rstd = __builtin_amdgcn_rsqf(wave_sum(ss) * (1.f / D) + NORM_EPS);
#pragma unroll
        for (int j = 0; j < 4; ++j) { const int c = j * 256 + F.lane * 4;
            const f32x4 g = *(const f32x4*)(ng + c), sh = *(const f32x4*)(mr + c), sc = *(const f32x4*)(mr + D + c);
            const float o0 = v[j].x * rstd * g.x * (1.f + sc.x) + sh.x, o1 = v[j].y * rstd * g.y * (1.f + sc.y) + sh.y, o2 = v[j].z * rstd * g.z * (1.f + sc.z) + sh.z, o3 = v[j].w * rstd * g.w * (1.f + sc.w) + sh.w;
            *(v2u*)(hx + (size_t)m * D + c) = (v2u){pk2(o0, o1), pk2(o2, o3)}; }
    }
}
constexpr int BL_APT = 0, BL_NPT = 4608, BL_RH = 7168, BL_MKR = 11776, BL_MBR = 14336, BL_KGC = 16896, BL_BGC = 22016, BL_GC = 27136, BL_VT = 27648, BL_BYTES = 32768;
constexpr int CS_AH = 32768, CS_BH = 37376, CS_KH = 41984, CS_AHC = 46592, CS_E = 51712, CS_RAW = 59904, CS_TLW = 72960, CS_LOA = 77568, CS_W2T = 82176, CS_A2T = 91392,
              CS_LG = 100608, CS_NBA = 100608, CS_NKA = 105216, CS_TT = 107776, CS_CONST = 116992, CS_END = 119552;
constexpr int CS_RH = BL_RH, CS_KGC = BL_KGC, CS_BGC = BL_BGC, CS_VT = BL_VT, CS_GC = BL_GC, CS_APT = BL_APT, CS_NPT = BL_NPT, CS_MKR = BL_MKR, CS_MBR = BL_MBR;
constexpr int SC_NTILE = (TC + T) / 32, SC_RT = 16, SC_NROUND = (SC_NTILE + SC_RT - 1) / SC_RT;
constexpr int GS_YS = 65536;
__device__ __forceinline__ void scan_issue_loads(const bf16* proj, int b, int h, int d, int tile, int tid, v4u (&rg)[3]) {
    const bool isctx = tile < TC / 32; const int L = isctx ? TC : T; const int jt = isctx ? tile : tile - TC / 32;
    const size_t rowbase = isctx ? (size_t)(MX + b * TC) : (size_t)b * T;
    const int tlo = d == 0 ? 32 * jt : L - 32 * (jt + 1);
#pragma unroll
    for (int i = 0; i < 3; ++i) {
        const int q = tid + 512 * i; v4u val = (v4u){0u, 0u, 0u, 0u};
        if (q < 816) { const int row = q / 24, rem = q - row * 24, which = rem >> 3, ch8 = rem & 7; const int tok = tlo - 1 + row;
            if (tok >= 0 && tok < L) val = *(const v4u*)(proj + (rowbase + tok) * NPROJ + COL_R + which * 512 + h * 64 + ch8 * 8); }
        else if (q < 1328) { const int q2 = q - 816, row = q2 >> 4, rem = q2 & 15, which = rem >> 3, ch8 = rem & 7; const int tok = tlo + row;
            val = *(const v4u*)(proj + (rowbase + tok) * NPROJ + (which ? COL_LA : COL_LW) + d * 64 + ch8 * 8); }
        rg[i] = val;
    }
}
__device__ __forceinline__ unsigned tanh_pk(unsigned w) { return pk2(tanh_fast(bf_lo(w)), tanh_fast(bf_hi(w))); }
__device__ __forceinline__ void scan_store_raw(LAS unsigned char* lds, int tid, const v4u (&rg)[3]) {
#pragma unroll
    for (int i = 0; i < 3; ++i) {
        const int q = tid + 512 * i;
        if (q < 816) { const int row = q / 24, rem = q - row * 24, which = rem >> 3, ch8 = rem & 7; *(LAS v4u*)(lds + CS_RAW + (which * 34 + row) * 128 + ch8 * 16) = rg[i]; }
        else if (q < 1328) { const int q2 = q - 816, row = q2 >> 4, rem = q2 & 15, which = rem >> 3, ch8 = rem & 7;
            if (which) *(LAS v4u*)(lds + CS_LOA + row * 144 + ch8 * 16) = rg[i];
            else { v4u t; t.x = tanh_pk(rg[i].x); t.y = tanh_pk(rg[i].y); t.z = tanh_pk(rg[i].z); t.w = tanh_pk(rg[i].w); *(LAS v4u*)(lds + CS_TLW + row * 144 + ch8 * 16) = t; } }
    }
}
__device__ __forceinline__ v2u pack4(f32x4 v) { return (v2u){pk2(v.x, v.y), pk2(v.z, v.w)}; }
__device__ __forceinline__ bf16 bfs(float v) { return (bf16)(pk2(v, 0.f) & 0xffffu); }
typedef v2u v2u_t;
__device__ __forceinline__ bf16x8 frag2(const LAS unsigned char* p0, const LAS unsigned char* p1) {
    const v2u a = *(const LAS v2u*)p0, b = *(const LAS v2u*)p1; const v4u w = (v4u){a.x, a.y, b.x, b.y}; return __builtin_bit_cast(bf16x8, w);
}
__device__ __forceinline__ bf16x8 frag_acc(f32x4 lo, f32x4 hi) { const v4u w = (v4u){pk2(lo.x, lo.y), pk2(lo.z, lo.w), pk2(hi.x, hi.y), pk2(hi.z, hi.w)}; return __builtin_bit_cast(bf16x8, w); }
__device__ __forceinline__ bf16x8 frag_zero() { const v4u w = (v4u){0u, 0u, 0u, 0u}; return __builtin_bit_cast(bf16x8, w); }
__device__ __forceinline__ void scan_prep_task(Frame& F, const bf16* proj, int chain, int tile, bool load_consts, bool have_next, int nchain, int ntile, v4u (&rg)[3], unsigned char* blob) {
    LAS unsigned char* lds = F.lds; const int tid = F.tid, lane = F.lane, wave = F.wave;
    const int b = chain >> 4, h = (chain >> 1) & 7, d = chain & 1, nb = nchain >> 4, nh = (nchain >> 1) & 7, nd = nchain & 1;
    if (load_consts) {
        __syncthreads();
        LAS float* C = (LAS float*)(lds + CS_CONST);
        if (tid < 384) { const int pn = tid / 192, r = tid - pn * 192, which = r >> 6, c = r & 63; C[pn * 192 + which * 64 + c] = F.in[I_TMU][(pn * 3 + which) * 512 + h * 64 + c]; }
        else if (tid < 448) { const int c = tid - 384; C[384 + c] = F.in[I_KK][h * 64 + c]; C[448 + c] = F.in[I_KA][h * 64 + c]; }
        else { const int c = tid - 448; C[512 + c] = F.in[I_DW0][d * 512 + h * 64 + c]; C[576 + c] = F.in[I_A0][d * 512 + h * 64 + c]; }
        const float* w2 = F.in[I_DW2] + (size_t)d * 64 * 512 + h * 64; const float* a2 = F.in[I_A2] + (size_t)d * 64 * 512 + h * 64;
#pragma unroll
        for (int i = 0; i < 8; ++i) { const int idx = tid + 512 * i, j = idx >> 6, c = idx & 63;
            *(LAS bf16*)(lds + CS_W2T + c * 144 + j * 2) = bfs(w2[j * 512 + c]);
            *(LAS bf16*)(lds + CS_A2T + c * 144 + j * 2) = bfs(a2[j * 512 + c]); }
    }
    {
            scan_store_raw(lds, tid, rg);
            __syncthreads();
            if (have_next) scan_issue_loads(proj, nb, nh, nd, ntile, tid, rg);
            if (wave < 4) {
                const int mat = wave >> 1, nt = wave & 1, r = lane & 31, hh = lane >> 5;
                const LAS unsigned char* Ab = lds + (mat ? CS_LOA : CS_TLW) + r * 144 + hh * 16;
                const LAS unsigned char* Bb = lds + (mat ? CS_A2T : CS_W2T) + (nt * 32 + r) * 144 + hh * 16;
                f32x16 acc;
#pragma unroll
                for (int i = 0; i < 16; ++i) acc[i] = 0.f;
#pragma unroll
                for (int ks = 0; ks < 4; ++ks) { const bf16x8 a = *(const LAS bf16x8*)(Ab + ks * 32), bb = *(const LAS bf16x8*)(Bb + ks * 32); acc = __builtin_amdgcn_mfma_f32_32x32x16_bf16(a, bb, acc, 0, 0, 0); }
                LAS float* LG = (LAS float*)(lds + CS_LG) + mat * 2048 + nt * 32 + r;
#pragma unroll
                for (int i = 0; i < 16; ++i) LG[((i & 3) + 8 * (i >> 2) + 4 * hh) * 64] = acc[i];
            }
            __syncthreads();
            const int tok = tid >> 4, cq = tid & 15, c0 = cq * 4, s = d == 0 ? tok : 31 - tok;
            f32x4 rs, vs, kd, kk, kka, ev;
            { const LAS float* C = (const LAS float*)(lds + CS_CONST);
              f32x4 xs[3];
#pragma unroll
              for (int which = 0; which < 3; ++which) {
                  const LAS unsigned char* rp = lds + CS_RAW + (which * 34 + tok) * 128 + c0 * 2;
                  const v2u p = *(const LAS v2u*)rp, x = *(const LAS v2u*)(rp + 128), n = *(const LAS v2u*)(rp + 256);
                  const f32x4 mp = *(const LAS f32x4*)(C + which * 64 + c0), mn = *(const LAS f32x4*)(C + 192 + which * 64 + c0);
                  const f32x4 xp = (f32x4){bf_lo(p.x), bf_hi(p.x), bf_lo(p.y), bf_hi(p.y)}, xc = (f32x4){bf_lo(x.x), bf_hi(x.x), bf_lo(x.y), bf_hi(x.y)}, xn = (f32x4){bf_lo(n.x), bf_hi(n.x), bf_lo(n.y), bf_hi(n.y)};
                  xs[which] = xc + mp * (xp - xc) + mn * (xn - xc); }
              const f32x4 kkc = *(const LAS f32x4*)(C + 384 + c0), kac = *(const LAS f32x4*)(C + 448 + c0), w0 = *(const LAS f32x4*)(C + 512 + c0), a0 = *(const LAS f32x4*)(C + 576 + c0);
              kk = xs[1] * kkc;
              const float ss = rowsum16(kk.x * kk.x + kk.y * kk.y + kk.z * kk.z + kk.w * kk.w);
              kk = kk * __builtin_amdgcn_rsqf(ss + 1e-12f);
              const f32x4 uw = *(const LAS f32x4*)(lds + CS_LG + (tok * 64 + c0) * 4) + w0, ua = *(const LAS f32x4*)(lds + CS_LG + 8192 + (tok * 64 + c0) * 4) + a0;
              f32x4 av;
#pragma unroll
              for (int e = 0; e < 4; ++e) { ev[e] = 0.60653066f * sigmoidf(uw[e]); av[e] = sigmoidf(ua[e]); }
              kd = xs[1] * (1.f + (av - 1.f) * kac); kka = kk * av; rs = xs[0]; vs = xs[2];
              *(LAS f32x4*)(lds + CS_E + (s * 64 + c0) * 4) = ev; }
            __syncthreads();
            { const int cb = s & 16, sl = s & 15;
              f32x4 cum = (f32x4){0.f, 0.f, 0.f, 0.f}, tot = cum;
#pragma unroll
              for (int ii = 0; ii < 16; ++ii) { const f32x4 e4 = *(const LAS f32x4*)(lds + CS_E + ((cb + ii) * 64 + c0) * 4); tot = tot + e4; if (ii <= sl) cum = cum + e4; }
              f32x4 g, gm1, gi, ge, gt;
#pragma unroll
              for (int e = 0; e < 4; ++e) { g[e] = fast_exp(-cum[e]); gm1[e] = fast_exp(ev[e] - cum[e]); gi[e] = fast_exp(cum[e]); ge[e] = fast_exp(cum[e] - tot[e]); gt[e] = fast_exp(-tot[e]); }
              const f32x4 ah = gm1 * kk, bh = kka * gi, kh = kd * gi, rh = g * rs, kg = kd * ge, bg = kka * ge;
              *(LAS v2u*)(lds + CS_AH + s * 144 + c0 * 2) = pack4(ah); *(LAS v2u*)(lds + CS_BH + s * 144 + c0 * 2) = pack4(bh);
              *(LAS v2u*)(lds + CS_KH + s * 144 + c0 * 2) = pack4(kh); *(LAS v2u*)(lds + CS_RH + s * 144 + c0 * 2) = pack4(rh);
#pragma unroll
              for (int e = 0; e < 4; ++e) { *(LAS bf16*)(lds + CS_AHC + (c0 + e) * 80 + s * 2) = bfs(ah[e]); *(LAS bf16*)(lds + CS_KGC + (c0 + e) * 80 + s * 2) = bfs(kg[e]); *(LAS bf16*)(lds + CS_BGC + (c0 + e) * 80 + s * 2) = bfs(-bg[e]); }
#pragma unroll
              for (int e = 0; e < 4; ++e) *(LAS bf16*)(lds + CS_VT + (c0 + e) * 80 + s * 2) = bfs(vs[e]);
              if (sl == 15) *(LAS f32x4*)(lds + CS_GC + ((s >> 4) * 64 + c0) * 4) = gt; }
            __syncthreads();
            if (wave < 4) {
                const int r = lane & 31, hh = lane >> 5;
                const LAS unsigned char* Ab = lds + ((wave == 0 || wave == 3) ? CS_BH : CS_KH) + r * 144 + hh * 16;
                const LAS unsigned char* Bb = lds + (wave < 2 ? CS_AH : CS_RH) + r * 144 + hh * 16;
                f32x16 acc;
#pragma unroll
                for (int i = 0; i < 16; ++i) acc[i] = 0.f;
#pragma unroll
                for (int ks = 0; ks < 4; ++ks) { const bf16x8 a = *(const LAS bf16x8*)(Ab + ks * 32), bb = *(const LAS bf16x8*)(Bb + ks * 32); acc = __builtin_amdgcn_mfma_f32_32x32x16_bf16(a, bb, acc, 0, 0, 0); }
                const int t = r;
#pragma unroll
                for (int i = 0; i < 16; ++i) { const int j = (i & 3) + 8 * (i >> 2) + 4 * hh; const bool same = (j >> 4) == (t >> 4);
                    const bool keep = same && (wave < 2 ? (j < t) : (j <= t)); acc[i] = keep ? acc[i] : 0.f; }
                if (wave == 0) {
#pragma unroll
                    for (int i = 0; i < 16; ++i) { const int j = (i & 3) + 8 * (i >> 2) + 4 * hh; *(LAS float*)(lds + CS_NBA + (t * 36 + j) * 4) = acc[i]; } }
                else if (wave == 1) {
#pragma unroll
                    for (int i = 0; i < 16; ++i) { const int j = (i & 3) + 8 * (i >> 2) + 4 * hh; *(LAS bf16*)(lds + CS_NKA + j * 80 + t * 2) = bfs(acc[i]); } }
                else { const float sg = wave == 2 ? 1.f : -1.f; const int base = wave == 2 ? CS_MKR : CS_MBR;
#pragma unroll
                    for (int q4 = 0; q4 < 4; ++q4) *(LAS v2u*)(lds + base + t * 80 + (8 * q4 + 4 * hh) * 2) = pack4((f32x4){sg * acc[4 * q4], sg * acc[4 * q4 + 1], sg * acc[4 * q4 + 2], sg * acc[4 * q4 + 3]}); }
            }
            __syncthreads();
            if (wave == 0 && lane < 32) {
                const int blk = lane >> 4, i = lane & 15;
                float Tr[16];
#pragma unroll
                for (int t = 0; t < 16; ++t) {
                    float acc = (t == i) ? 1.f : 0.f;
                    const LAS float* np = (const LAS float*)(lds + CS_NBA) + (16 * blk + t) * 36 + 16 * blk;
#pragma unroll
                    for (int j = 0; j < t; ++j) acc -= Tr[j] * np[j];
                    Tr[t] = acc;
                }
#pragma unroll
                for (int t = 0; t < 16; ++t) { *(LAS bf16*)(lds + CS_TT + (16 * blk + t) * 80 + (16 * blk + i) * 2) = bfs(Tr[t]); *(LAS bf16*)(lds + CS_TT + (16 * blk + t) * 80 + (16 * (1 - blk) + i) * 2) = (bf16)0; }
            }
            __syncthreads();
            if (wave < 3) {
                const int r = lane & 31, hh = lane >> 5;
                const LAS unsigned char* Ab = lds + (wave < 2 ? CS_AHC + (32 * wave + r) * 80 : CS_NKA + r * 80) + hh * 16;
                const LAS unsigned char* Bb = lds + CS_TT + r * 80 + hh * 16;
                f32x16 acc;
#pragma unroll
                for (int i = 0; i < 16; ++i) acc[i] = 0.f;
#pragma unroll
                for (int ks = 0; ks < 2; ++ks) { const bf16x8 a = *(const LAS bf16x8*)(Ab + ks * 32), bb = *(const LAS bf16x8*)(Bb + ks * 32); acc = __builtin_amdgcn_mfma_f32_32x32x16_bf16(a, bb, acc, 0, 0, 0); }
                const int t = r;
#pragma unroll
                for (int q4 = 0; q4 < 4; ++q4) { const v2u pk = pack4((f32x4){acc[4 * q4], acc[4 * q4 + 1], acc[4 * q4 + 2], acc[4 * q4 + 3]});
                    if (wave < 2) *(LAS v2u*)(lds + CS_APT + t * 144 + (32 * wave + 8 * q4 + 4 * hh) * 2) = pk;
                    else *(LAS v2u*)(lds + CS_NPT + t * 80 + (8 * q4 + 4 * hh) * 2) = pk; }
            }
            __syncthreads();
#pragma unroll
            for (int i = 0; i < 4; ++i) { const int idx = tid + 512 * i; *(v4u*)(blob + idx * 16) = *(const LAS v4u*)(lds + idx * 16); }
    }
}
__device__ __forceinline__ void scan_state_round(Frame& F, int chain, int t0, int t1, const unsigned char* blobs, f32x4 (&Z)[4]) {
    LAS unsigned char* lds = F.lds; const int tid = F.tid, lane = F.lane, wave = F.wave;
    const int b = chain >> 4, h = (chain >> 1) & 7, d = chain & 1;
    float* yscr = F.out;
    v4u bg[4];
    __syncthreads();
#pragma unroll
    for (int i = 0; i < 4; ++i) bg[i] = *(const v4u*)(blobs + (tid + 512 * i) * 16);
#pragma unroll
    for (int i = 0; i < 4; ++i) *(LAS v4u*)(lds + (tid + 512 * i) * 16) = bg[i];
    __syncthreads();
    for (int tile = t0; tile < t1; ++tile) {
        const bool isctx = tile < TC / 32; const int L = isctx ? TC : T; const int jt = isctx ? tile : tile - TC / 32;
        const int tlo = d == 0 ? 32 * jt : L - 32 * (jt + 1);
        const LAS unsigned char* bl = lds + ((tile - t0) & 1) * BL_BYTES;
        if (tile + 1 < t1) {
#pragma unroll
            for (int i = 0; i < 4; ++i) bg[i] = *(const v4u*)(blobs + (size_t)(tile + 1 - t0) * BL_BYTES + (tid + 512 * i) * 16); }
            if (wave < 4) {
                const int n = lane & 15, g = lane >> 4;
                const bf16x8 bvt = *(const LAS bf16x8*)(bl + BL_VT + (16 * wave + n) * 80 + g * 16);
                f32x4 U[2]; U[0] = (f32x4){0.f, 0.f, 0.f, 0.f}; U[1] = U[0];
#pragma unroll
                for (int cc = 0; cc < 2; ++cc) {
                    const int trow = 16 * cc + n;
                    const bf16x8 bz01 = frag_acc(Z[0], Z[1]), bz23 = frag_acc(Z[2], Z[3]);
                    { const LAS unsigned char* ap = bl + BL_APT + trow * 144;
                      f32x4 u = __builtin_amdgcn_mfma_f32_16x16x32_bf16(frag2(ap + (4 * g) * 2, ap + (16 + 4 * g) * 2), bz01, (f32x4){0.f, 0.f, 0.f, 0.f}, 0, 0, 0);
                      u = __builtin_amdgcn_mfma_f32_16x16x32_bf16(frag2(ap + (32 + 4 * g) * 2, ap + (48 + 4 * g) * 2), bz23, u, 0, 0, 0);
                      u = __builtin_amdgcn_mfma_f32_16x16x32_bf16(*(const LAS bf16x8*)(bl + BL_NPT + trow * 80 + g * 16), bvt, u, 0, 0, 0);
                      U[cc] = u; }
                    const bf16x8 bu = frag_acc(U[0], U[1]);
                    if (!isctx) { const LAS unsigned char* rp = bl + BL_RH + trow * 144;
                      f32x4 y = __builtin_amdgcn_mfma_f32_16x16x32_bf16(frag2(rp + (4 * g) * 2, rp + (16 + 4 * g) * 2), bz01, (f32x4){0.f, 0.f, 0.f, 0.f}, 0, 0, 0);
                      y = __builtin_amdgcn_mfma_f32_16x16x32_bf16(frag2(rp + (32 + 4 * g) * 2, rp + (48 + 4 * g) * 2), bz23, y, 0, 0, 0);
                      y = __builtin_amdgcn_mfma_f32_16x16x32_bf16(*(const LAS bf16x8*)(bl + BL_MKR + trow * 80 + g * 16), bvt, y, 0, 0, 0);
                      const LAS unsigned char* mp = bl + BL_MBR + trow * 80;
                      y = __builtin_amdgcn_mfma_f32_16x16x32_bf16(frag2(mp + (4 * g) * 2, mp + (16 + 4 * g) * 2), bu, y, 0, 0, 0);
#pragma unroll
                      for (int i = 0; i < 4; ++i) *(LAS float*)(lds + GS_YS + ((16 * cc + 4 * g + i) * 64 + 16 * wave + n) * 4) = y[i]; }
#pragma unroll
                    for (int kt = 0; kt < 4; ++kt) {
                        const f32x4 gc = *(const LAS f32x4*)(bl + BL_GC + (cc * 64 + 16 * kt + 4 * g) * 4);
                        bf16x8 ka = *(const LAS bf16x8*)(bl + BL_KGC + (16 * kt + n) * 80 + g * 16);
                        if ((g >> 1) != cc) ka = frag_zero();
                        const LAS unsigned char* bp = bl + BL_BGC + (16 * kt + n) * 80;
                        const v2u b0 = *(const LAS v2u*)(bp + (4 * g) * 2), b1 = *(const LAS v2u*)(bp + (16 + 4 * g) * 2);
                        const v4u bw = cc == 0 ? (v4u){b0.x, b0.y, 0u, 0u} : (v4u){0u, 0u, b1.x, b1.y};
                        f32x4 z = Z[kt] * gc;
                        z = __builtin_amdgcn_mfma_f32_16x16x32_bf16(ka, bvt, z, 0, 0, 0);
                        z = __builtin_amdgcn_mfma_f32_16x16x32_bf16(__builtin_bit_cast(bf16x8, bw), bu, z, 0, 0, 0);
                        Z[kt] = z;
                    }
                }
            }
        __syncthreads();
        if (!isctx) { const int s2 = tid >> 4, part = tid & 15; const int tk = d == 0 ? tlo + s2 : tlo + 31 - s2;
            *(f32x4*)(yscr + ((size_t)(b * T + tk)) * D + d * 512 + h * 64 + part * 4) = *(const LAS f32x4*)(lds + GS_YS + (s2 * 64 + part * 4) * 4); }
        if (tile + 1 < t1) {
#pragma unroll
            for (int i = 0; i < 4; ++i) *(LAS v4u*)(lds + ((tile + 1 - t0) & 1) * BL_BYTES + (tid + 512 * i) * 16) = bg[i]; }
        __syncthreads();
    }
}
template <int LEVEL> __device__ __forceinline__ void p3_scan(Frame& F, const XcdBarrier& bar) {
    const bf16* proj = (const bf16*)(F.ws + WS_PROJ);
    const bool state_role = F.bid < 64;
    f32x4 Z[4];
#pragma unroll
    for (int kt = 0; kt < 4; ++kt) Z[kt] = (f32x4){0.f, 0.f, 0.f, 0.f};
    for (int step = 0; step <= SC_NROUND; ++step) {
        if (step >= 1 && state_role) {
            const int r = step - 1, t0 = r * SC_RT, t1 = (t0 + SC_RT < SC_NTILE) ? t0 + SC_RT : SC_NTILE;
            scan_state_round(F, F.bid, t0, t1, F.ws + ((r & 1) ? WS_BLOB1 : WS_BLOB0) + (size_t)F.bid * SC_RT * BL_BYTES, Z);
        }
        const bool prep_here = step < SC_NROUND && (step == 0 || !state_role);
        if (prep_here) {
            const int t0 = step * SC_RT, nt = (t0 + SC_RT < SC_NTILE) ? SC_RT : SC_NTILE - t0, ntask = 64 * nt;
            const int P = step == 0 ? F.G : F.G - 64, p = step == 0 ? F.bid : F.bid - 64;
            const int k0 = (int)((long)ntask * p / P), k1 = (int)((long)ntask * (p + 1) / P);
            unsigned char* base = F.ws + ((step & 1) ? WS_BLOB1 : WS_BLOB0);
            v4u rg[3];
            if (k0 < k1) scan_issue_loads(proj, (k0 / nt) >> 4, ((k0 / nt) >> 1) & 7, (k0 / nt) & 1, t0 + k0 % nt, F.tid, rg);
            int prev_chain = -1;
            for (int k = k0; k < k1; ++k) {
                const int chain = k / nt, tl = k % nt, kn = k + 1, nchain = kn / nt, ntl = kn % nt;
                scan_prep_task(F, proj, chain, t0 + tl, chain != prev_chain, kn < k1, nchain, t0 + ntl, rg, base + ((size_t)chain * SC_RT + tl) * BL_BYTES);
                prev_chain = chain;
            }
        }
        if (step < SC_NROUND) xcd_barrier(bar);
    }
}
__device__ __forceinline__ void p4_mix(Frame& F) {
    LAS unsigned char* lds = F.lds; const int tid = F.tid;
    const bf16* proj = (const bf16*)(F.ws + WS_PROJ); bf16* cat = (bf16*)(F.ws + WS_HX); const float* yscr = F.out;
    LAS float* SG = (LAS float*)lds;
    LAS bf16* GT = (LAS bf16*)(lds + 32768);
    for (int unit = F.bid; unit < MX / 64; unit += F.G) {
        const size_t row0 = (size_t)unit * 64; const int tb0 = (unit * 64) & (T - 1);
        __syncthreads();
#pragma unroll
        for (int i = 0; i < 2; ++i) { const int ck = tid + 512 * i, tok = ck >> 4, j0 = (ck & 15) * 8;
            const v4u w = *(const v4u*)(proj + (row0 + tok) * NPROJ + COL_G + j0);
            SG[(j0 + 0) * 64 + tok] = sigmoidf(bf_lo(w.x)); SG[(j0 + 1) * 64 + tok] = sigmoidf(bf_hi(w.x)); SG[(j0 + 2) * 64 + tok] = sigmoidf(bf_lo(w.y)); SG[(j0 + 3) * 64 + tok] = sigmoidf(bf_hi(w.y));
            SG[(j0 + 4) * 64 + tok] = sigmoidf(bf_lo(w.z)); SG[(j0 + 5) * 64 + tok] = sigmoidf(bf_hi(w.z)); SG[(j0 + 6) * 64 + tok] = sigmoidf(bf_lo(w.w)); SG[(j0 + 7) * 64 + tok] = sigmoidf(bf_hi(w.w)); }
        __syncthreads();
        { float acc[64];
#pragma unroll
          for (int i = 0; i < 64; ++i) acc[i] = 0.f;
          const float* gw = F.in[I_GW2] + tid;
#pragma unroll 2
          for (int j = 0; j < 128; ++j) { const float wv = gw[j * 512];
#pragma unroll
              for (int tq = 0; tq < 16; ++tq) { const f32x4 s4 = *(const LAS f32x4*)(SG + j * 64 + tq * 4);
                  acc[4 * tq] += s4.x * wv; acc[4 * tq + 1] += s4.y * wv; acc[4 * tq + 2] += s4.z * wv; acc[4 * tq + 3] += s4.w * wv; } }
#pragma unroll
          for (int i = 0; i < 64; ++i) GT[i * 512 + tid] = (bf16)(pk2(acc[i], 0.f) & 0xffffu); }
        __syncthreads();
        if (tid < 256) {
            const int c = 2 * tid; const float* cw = F.in[I_CONVW];
            const f32x2 w0 = *(const f32x2*)(cw + c), w1 = *(const f32x2*)(cw + 512 + c), w2 = *(const f32x2*)(cw + 1024 + c);
            const bf16* pr = proj + row0 * NPROJ + c;
            f32x2 zp = (f32x2){0.f, 0.f}, zc, zn;
            { const unsigned g = *(const unsigned*)(pr + COL_XG), x = *(const unsigned*)(pr + COL_XC); zc = (f32x2){bf_lo(g) * bf_lo(x), bf_hi(g) * bf_hi(x)}; }
            for (int t = 0; t < 64; ++t) {
                if (t < 63) { const unsigned g = *(const unsigned*)(pr + (size_t)(t + 1) * NPROJ + COL_XG), x = *(const unsigned*)(pr + (size_t)(t + 1) * NPROJ + COL_XC); zn = (f32x2){bf_lo(g) * bf_lo(x), bf_hi(g) * bf_hi(x)}; }
                else zn = (f32x2){0.f, 0.f};
                const unsigned xb = *(const unsigned*)(pr + (size_t)t * NPROJ + COL_XB);
                const f32x2 z = w0 * zp + w1 * zc + w2 * zn;
                *(unsigned*)(cat + (row0 + t) * D + c) = pk2(bf_lo(xb) * z.x, bf_hi(xb) * z.y);
                zp = zc; zc = zn;
            }
        } else {
            const int ri = tid - 256, c = 2 * ri, h = ri >> 5;
            const f32x2 mpr = *(const f32x2*)(F.in[I_TMU] + 0 * 512 + c), mpk = *(const f32x2*)(F.in[I_TMU] + 1 * 512 + c), mpv = *(const f32x2*)(F.in[I_TMU] + 2 * 512 + c);
            const f32x2 mnr = *(const f32x2*)(F.in[I_TMU] + 3 * 512 + c), mnk = *(const f32x2*)(F.in[I_TMU] + 4 * 512 + c), mnv = *(const f32x2*)(F.in[I_TMU] + 5 * 512 + c);
            const f32x2 rk = *(const f32x2*)(F.in[I_RK] + c), lg = *(const f32x2*)(F.in[I_LNG] + c), lb = *(const f32x2*)(F.in[I_LNB] + c);
            const bf16* pr = proj + row0 * NPROJ + c;
            f32x2 rp, kp, vp, rc, kc, vc, rn, kn, vn;
#define LD2(dst, ptr) do { const unsigned _w = *(const unsigned*)(ptr); dst = (f32x2){bf_lo(_w), bf_hi(_w)}; } while (0)
            if (tb0 > 0) { LD2(rp, pr - NPROJ + COL_R); LD2(kp, pr - NPROJ + COL_K); LD2(vp, pr - NPROJ + COL_V); } else { rp = kp = vp = (f32x2){0.f, 0.f}; }
            LD2(rc, pr + COL_R); LD2(kc, pr + COL_K); LD2(vc, pr + COL_V);
            for (int t = 0; t < 64; ++t) {
                if (tb0 + t + 1 < T) { const bf16* pn = pr + (size_t)(t + 1) * NPROJ; LD2(rn, pn + COL_R); LD2(kn, pn + COL_K); LD2(vn, pn + COL_V); } else { rn = kn = vn = (f32x2){0.f, 0.f}; }
                const f32x2 rs = rc + mpr * (rp - rc) + mnr * (rn - rc), ks = kc + mpk * (kp - kc) + mnk * (kn - kc), vs = vc + mpv * (vp - vc) + mnv * (vn - vc);
                const float* yr = yscr + (row0 + t) * D + c;
                const f32x2 y = *(const f32x2*)yr + *(const f32x2*)(yr + 512);
                const float mu = half_sum32(y.x + y.y) * (1.f / 64.f);
                const f32x2 yc = y - mu;
                const float var = half_sum32(yc.x * yc.x + yc.y * yc.y) * (1.f / 64.f);
                const float bon = half_sum32(rs.x * ks.x * rk.x + rs.y * ks.y * rk.y);
                const f32x2 yn = yc * __builtin_amdgcn_rsqf(var + LNX_EPS) * lg + lb + bon * vs;
                const unsigned gt = *(const LAS unsigned*)(GT + t * 512 + c);
                *(unsigned*)(cat + (row0 + t) * D + 512 + c) = pk2(yn.x * bf_lo(gt), yn.y * bf_hi(gt));
                rp = rc; kp = kc; vp = vc; rc = rn; kc = kn; vc = vn;
            }
#undef LD2
        }
    }
}

__device__ __forceinline__ void p6_mid(Frame& F) {
    const float* mod = (const float*)(F.ws + WS_MOD); const float* ng = F.in[I_NG];
    const float* yx = (const float*)(F.ws + WS_PROJ); bf16* hx2 = (bf16*)(F.ws + WS_HX);
    for (int m = F.bid * NWAVES + F.wave; m < MX; m += F.G * NWAVES) {
        const float* mr = mod + (m >> 12) * NMOD;
        f32x4 v[4], xv[4]; float ss = 0.f;
#pragma unroll
        for (int j = 0; j < 4; ++j) { v[j] = *(const f32x4*)(yx + (size_t)m * D + j * 256 + F.lane * 4); xv[j] = *(const f32x4*)(F.in[I_X] + (size_t)m * D + j * 256 + F.lane * 4);
            ss += v[j].x * v[j].x + v[j].y * v[j].y + v[j].z * v[j].z + v[j].w * v[j].w; }
        const float rstd = __builtin_amdgcn_rsqf(wave_sum(ss) * (1.f / D) + NORM_EPS);
        float ss2 = 0.f;
#pragma unroll
        for (int j = 0; j < 4; ++j) { const int c = j * 256 + F.lane * 4;
            const f32x4 g1 = *(const f32x4*)(ng + D + c), gt = *(const f32x4*)(mr + 2 * D + c);
            xv[j] = xv[j] + gt * (v[j] * rstd * g1);
            *(f32x4*)(F.out + (size_t)m * D + c) = xv[j];
            ss2 += xv[j].x * xv[j].x + xv[j].y * xv[j].y + xv[j].z * xv[j].z + xv[j].w * xv[j].w; }
        const float rstd2 = __builtin_amdgcn_rsqf(wave_sum(ss2) * (1.f / D) + NORM_EPS);
#pragma unroll
        for (int j = 0; j < 4; ++j) { const int c = j * 256 + F.lane * 4;
            const f32x4 g2 = *(const f32x4*)(ng + 2 * D + c), sh = *(const f32x4*)(mr + 3 * D + c), sc = *(const f32x4*)(mr + 4 * D + c);
            const f32x4 o = xv[j] * rstd2 * g2 * (1.f + sc) + sh;
            *(v2u*)(hx2 + (size_t)m * D + c) = (v2u){pk2(o.x, o.y), pk2(o.z, o.w)}; }
    }
}
__device__ __forceinline__ float gelu_erf(float x) { return 0.5f * x * (1.f + erff(x * 0.70710678118f)); }
__device__ __forceinline__ float dot2bf(unsigned a, unsigned b, float c) {
    typedef __bf16 bf2 __attribute__((ext_vector_type(2)));
    return __builtin_amdgcn_fdot2_f32_bf16(__builtin_bit_cast(bf2, a), __builtin_bit_cast(bf2, b), c, false);
}
__device__ __forceinline__ unsigned uminu(unsigned a, unsigned b) { return a < b ? a : b; }
__device__ __forceinline__ void ce_desc(unsigned& x, unsigned& y) { const unsigned hi = umaxu(x, y), lo = uminu(x, y); x = hi; y = lo; }
template <int N> __device__ __forceinline__ void bitonic_sort_desc(unsigned (&a)[N]) {
#pragma unroll
    for (int k = 2; k <= N; k <<= 1)
#pragma unroll
        for (int j = k >> 1; j > 0; j >>= 1)
#pragma unroll
            for (int i = 0; i < N; ++i) { const int l = i ^ j; if (l > i) { if ((i & k) == 0) ce_desc(a[i], a[l]); else ce_desc(a[l], a[i]); } }
}
template <int N> __device__ __forceinline__ void bitonic_merge_desc(unsigned (&a)[N]) {
#pragma unroll
    for (int j = N >> 1; j > 0; j >>= 1)
#pragma unroll
        for (int i = 0; i < N; ++i) { const int l = i ^ j; if (l > i) ce_desc(a[i], a[l]); }
}
__device__ __forceinline__ void p8a_route(Frame& F) {
    const int lane = F.lane, wave = F.wave, part = lane & 3, L = lane >> 2, side = L & 1;
    LAS unsigned char* WL = F.lds + 1024 + wave * 1024;
    LAS unsigned char* TAB = F.lds;
    const float* scores = (const float*)(F.ws + WS_PROJ);
    unsigned short* exl = (unsigned short*)(F.ws + WS_EXL); float* gl = (float*)(F.ws + WS_GL);
    __syncthreads();
    if (F.tid < 64) { int l = F.tid, i = 0; for (; i < 16; ++i) { const int n = 16 / (i + 1); if (l < n) break; l -= n; } TAB[F.tid] = (unsigned char)(i < 16 ? i * 16 + l : 0); }
    __syncthreads();
    for (int m = F.bid * NWAVES + wave; m < MX; m += F.G * NWAVES) {
        const float* lp = scores + (size_t)m * NSC + L * 128 + part * 32;
        unsigned lo16[16], hi16[16];
#pragma unroll
        for (int q = 0; q < 4; ++q) { const f32x4 v = *(const f32x4*)(lp + 4 * q), w = *(const f32x4*)(lp + 16 + 4 * q);
#pragma unroll
            for (int e = 0; e < 4; ++e) { lo16[4 * q + e] = (f2key(v[e]) & ~127u) | (unsigned)(127 - part * 32 - (4 * q + e)); hi16[4 * q + e] = (f2key(w[e]) & ~127u) | (unsigned)(127 - part * 32 - 16 - (4 * q + e)); } }
        bitonic_sort_desc<16>(lo16); bitonic_sort_desc<16>(hi16);
        unsigned r[16];
#pragma unroll
        for (int i = 0; i < 16; ++i) r[i] = umaxu(lo16[i], hi16[15 - i]);
        bitonic_merge_desc<16>(r);
        { unsigned c[16];
#pragma unroll
          for (int i = 0; i < 16; ++i) c[i] = umaxu(r[i], dppu<0xB1>(r[15 - i]));
          bitonic_merge_desc<16>(c);
#pragma unroll
          for (int i = 0; i < 16; ++i) r[i] = umaxu(c[i], dppu<0x4E>(c[15 - i]));
          bitonic_merge_desc<16>(r); }
        if (part == 0) {
#pragma unroll
            for (int i = 0; i < 16; ++i) WL[L * 16 + i] = (unsigned char)(127u - (r[i] & 127u)); }
        float fa[16], fb[16];
#pragma unroll
        for (int i = 0; i < 16; ++i) { const unsigned up = dppu<0x104>(r[i]), dn = dppu<0x114>(r[i]);
            const unsigned av = side ? dn : r[i], bv = side ? r[i] : up; fa[i] = key2f(av & ~127u); fb[i] = key2f(bv & ~127u); }
        unsigned R[16];
#pragma unroll
        for (int j = 0; j < 16; ++j) R[j] = (f2key(fa[0] + fb[j]) & ~63u) | (unsigned)(63 - j);
        { int code = 16;
#pragma unroll
          for (int i = 1; i < 16; ++i) {
#pragma unroll
              for (int j = 0; j < 16; ++j) { if ((i + 1) * (j + 1) <= 16) {
                  const unsigned x = (f2key(fa[i] + fb[j]) & ~63u) | (unsigned)(63 - code); const int p0 = (i + 1) * (j + 1) - 1;
#pragma unroll
                  for (int p = 15; p > p0; --p) R[p] = umaxu(R[p], uminu(R[p - 1], x));
                  R[p0] = umaxu(R[p0], x); ++code; } } } }
        if ((lane & 7) == 0) {
#pragma unroll
            for (int k = 0; k < 16; ++k) *(LAS unsigned*)(WL + 256 + ((lane >> 3) * 16 + k) * 4) = R[k]; }
        LDS_WAIT();
#pragma unroll
        for (int half = 0; half < 2; ++half) { const int e = lane + 64 * half, hd = e >> 4;
            const unsigned rk = *(const LAS unsigned*)(WL + 256 + e * 4); const int ij = TAB[63 - (int)(rk & 63u)];
            const int idx0 = WL[(2 * hd) * 16 + (ij >> 4)], idx1 = WL[(2 * hd + 1) * 16 + (ij & 15)];
            const float scv = key2f(rk & ~63u);
            float mx = scv; mx = fmaxf(mx, dppf<0xB1>(mx)); mx = fmaxf(mx, dppf<0x4E>(mx)); mx = fmaxf(mx, dppf<0x141>(mx)); mx = fmaxf(mx, dppf<0x140>(mx));
            const float ev = fast_exp(scv - mx); const float den = rowsum16(ev);
            exl[(size_t)m * 128 + e] = (unsigned short)(idx0 * 128 + idx1); gl[(size_t)m * 128 + e] = ev * fast_rcp(den); }
        LDS_WAIT();
    }
}
__device__ __forceinline__ void p9_upass(Frame& F) {
    const int lane = F.lane, wave = F.wave, x = F.bid & 7, r = F.bid >> 3, nr = F.G >> 3, g = lane >> 4, q = lane & 15;
    LAS unsigned short* EXW = (LAS unsigned short*)(F.lds + wave * 256);
    const unsigned* exl32 = (const unsigned*)(F.ws + WS_EXL); const bf16* hx2 = (const bf16*)(F.ws + WS_HX);
    const unsigned char* U = F.ws + WS_U + 256 * x + 16 * q; float* part = (float*)(F.ws + WS_PART) + (size_t)x * MX * 128;
    for (int m = r + nr * wave; m < MX; m += nr * NWAVES) {
        *(LAS unsigned*)(EXW + 2 * lane) = exl32[(size_t)m * 64 + lane];
        const v4u hs = *(const v4u*)(hx2 + (size_t)m * D + 128 * x + 8 * q);
        LDS_WAIT();
        float keep[2];
#pragma unroll
        for (int j = 0; j < 2; ++j) {
            float kp = 0.f;
#pragma unroll
            for (int i0 = 0; i0 < 16; i0 += 8) {
                v4u uu[8];
#pragma unroll
                for (int i = 0; i < 8; ++i) { const unsigned ex = EXW[64 * j + 4 * (i0 + i) + g]; uu[i] = *(const v4u*)(U + (size_t)ex * 2048); }
#pragma unroll
                for (int i = 0; i < 8; ++i) { float p = dot2bf(uu[i].x, hs.x, 0.f); p = dot2bf(uu[i].y, hs.y, p); p = dot2bf(uu[i].z, hs.z, p); p = dot2bf(uu[i].w, hs.w, p);
                    p = rowsum16(p); kp = (q == i0 + i) ? p : kp; }
            }
            keep[j] = kp;
        }
        part[(size_t)m * 128 + 4 * q + g] = keep[0]; part[(size_t)m * 128 + 64 + 4 * q + g] = keep[1];
        LDS_WAIT();
    }
}
__device__ __forceinline__ void p10_combine(Frame& F) {
    const float* __restrict__ part = (const float*)(F.ws + WS_PART); const float* __restrict__ gl = (const float*)(F.ws + WS_GL);
    const unsigned short* __restrict__ exl = (const unsigned short*)(F.ws + WS_EXL); unsigned* __restrict__ plt = (unsigned*)(F.ws + WS_PL);
    LAS unsigned* TL = (LAS unsigned*)F.lds;
    for (int unit = F.bid; unit < MX / 64; unit += F.G) {
        const int m0 = unit * 64;
        __syncthreads();
#pragma unroll 4
        for (int i = 0; i < 16; ++i) { const int idx = F.tid + 512 * i, ml = idx >> 7, k = idx & 127; const size_t gi = (size_t)(m0 + ml) * 128 + k;
            float s = part[gi];
#pragma unroll
            for (int x = 1; x < 8; ++x) s += part[(size_t)x * MX * 128 + gi];
            TL[k * 65 + ml] = (unsigned)exl[gi] | ((unsigned)__builtin_bit_cast(unsigned short, (_Float16)(gl[gi] * gelu_erf(s))) << 16); }
        __syncthreads();
#pragma unroll 4
        for (int i = 0; i < 16; ++i) { const int idx = F.tid + 512 * i, k = idx >> 6, ml = idx & 63; plt[(size_t)k * MX + m0 + ml] = TL[k * 65 + ml]; }
    }
}
typedef _Float16 h2_t __attribute__((ext_vector_type(2)));
typedef _Float16 h4_t __attribute__((ext_vector_type(4)));
template <int MODE> __device__ __forceinline__ void p11_vpass(Frame& F) {
    const int lane = F.lane, wave = F.wave;
    const unsigned* __restrict__ plt = (const unsigned*)(F.ws + WS_PL); float* __restrict__ po = (float*)(F.ws + WS_PO);
    for (int cg = F.bid; cg < 256; cg += F.G) {
        const int c0 = 128 * (cg & 7) + 4 * (cg >> 3);
        __syncthreads();
        for (int e = F.tid; e < NEXP; e += 512) { const f32x4 vv = *(const f32x4*)(F.in[I_PV] + (size_t)e * D + c0);
            const h2_t a = {(_Float16)vv.x, (_Float16)vv.y}, b = {(_Float16)vv.z, (_Float16)vv.w};
            *(LAS v2u*)(F.lds + e * 8) = (v2u){__builtin_bit_cast(unsigned, a), __builtin_bit_cast(unsigned, b)}; }
        __syncthreads();
        for (int mg = wave; mg < MX / 64; mg += NWAVES) {
            const unsigned* __restrict__ pg = plt + mg * 64;
            f32x4 acc = (f32x4){0.f, 0.f, 0.f, 0.f};
#pragma unroll 2
            for (int k0 = 0; k0 < 128; k0 += 8) {
                unsigned p[8];
#pragma unroll
                for (int i = 0; i < 8; ++i) p[i] = pg[(size_t)(k0 + i) * MX + lane];
                h2_t a01 = {(_Float16)0.f, (_Float16)0.f}, a23 = a01;
#pragma unroll
                for (int i = 0; i < 8; ++i) { const h4_t hv = *(const LAS h4_t*)(unsigned)((p[i] & 0xffffu) << 3);
                    const _Float16 cf = __builtin_bit_cast(_Float16, (unsigned short)(p[i] >> 16)); const h2_t c2 = {cf, cf};
                    a01 = __builtin_shufflevector(hv, hv, 0, 1) * c2 + a01; a23 = __builtin_shufflevector(hv, hv, 2, 3) * c2 + a23; }
                acc.x += (float)a01.x; acc.y += (float)a01.y; acc.z += (float)a23.x; acc.w += (float)a23.y;
            }
            *(f32x4*)(po + (size_t)(mg * 64 + lane) * D + c0) = acc;
        }
    }
}
__device__ __forceinline__ void p12_final(Frame& F) {
    const float* mod = (const float*)(F.ws + WS_MOD); const float* ng3 = F.in[I_NG] + 3 * D; const float* po = (const float*)(F.ws + WS_PO);
    for (int m = F.bid * NWAVES + F.wave; m < MX; m += F.G * NWAVES) {
        const float* gt2 = mod + (m >> 12) * NMOD + 5 * D;
        f32x4 v[4]; float ss = 0.f;
#pragma unroll
        for (int j = 0; j < 4; ++j) { v[j] = *(const f32x4*)(po + (size_t)m * D + j * 256 + F.lane * 4); ss += v[j].x * v[j].x + v[j].y * v[j].y + v[j].z * v[j].z + v[j].w * v[j].w; }
        const float rstd = __builtin_amdgcn_rsqf(wave_sum(ss) * (1.f / D) + NORM_EPS);
#pragma unroll
        for (int j = 0; j < 4; ++j) { const int c = j * 256 + F.lane * 4; float* op = F.out + (size_t)m * D + c;
            const f32x4 x1 = *(const f32x4*)op, g = *(const f32x4*)(ng3 + c), gt = *(const f32x4*)(gt2 + c);
            *(f32x4*)op = x1 + gt * (v[j] * rstd * g); }
    }
}
struct Args { const float* in[25]; float* out; unsigned char* ws; int ph_lo, ph_hi; };
__global__ void __launch_bounds__(NWAVES * 64, 2) mk_fwd(Args args) {
    extern __shared__ __attribute__((aligned(16))) unsigned char lds_raw[];
    Frame F;
    F.lds = (LAS unsigned char*)lds_raw;
    F.MISC = (volatile LAS unsigned*)(F.lds + MISC_OFF);
    F.tid = threadIdx.x; F.lane = F.tid & 63; F.wave = __builtin_amdgcn_readfirstlane(F.tid >> 6);
    F.G = gridDim.x; F.bid = blockIdx.x;
#pragma unroll
    for (int i = 0; i < 25; ++i) F.in[i] = args.in[i];
    F.out = args.out; F.ws = args.ws; F.ctl = (gu32*)(args.ws + WS_CTL);
    for (int u = F.tid; u < (LDS_BYTES - LDSCTL_OFF) / 4; u += NWAVES * 64) ((LAS unsigned*)(F.lds + LDSCTL_OFF))[u] = 0u;
    __syncthreads();
    const int lo = args.ph_lo, hi = args.ph_hi;
    XcdBarrier bar; bar.bar = (unsigned*)(F.ctl + CW_BAR); bar.x = 0; bar.st = nullptr;
    if (hi - lo > 1) bar = xcd_barrier_post((unsigned*)(F.ctl + CW_BAR), F.MISC + 8);
#ifndef PROBE_LO
#define PROBE_LO -1
#define PROBE_HI -1
#endif
#define IN(k) (lo <= (k) && (k) < hi)
#define SEAM(k) do { if (IN(k) && IN((k) + 1)) xcd_barrier(bar); } while (0)
#define PH0 { p0_prep(F); }
#define PH1 { p1_hx(F); }
#define PH2 { pg8::Gemm g{(const pg8::bf16_t*)(F.ws + WS_HX), (const pg8::bf16_t*)(F.ws + WS_WINT), MA, NPROJ_PAD, D}; pg8::StaticOrder S; S.init(MA, NPROJ_PAD, F.G, F.bid); \
        pg8::EpiProj E{(pg8::bf16_t*)(F.ws + WS_PROJ), NPROJ, NPROJ}; \
        pg8::gemm_phase<pg8::EpiProj, pg8::StaticOrder, PG8_ALIGN, PG8_SP2>(F.lds, g, S, E); }
#define PH3 { p3_scan<0>(F, bar); }
#define PH4 { p4_mix(F); }
#define PH5 { pg8::Gemm g{(const pg8::bf16_t*)(F.ws + WS_HX), (const pg8::bf16_t*)(F.ws + WS_WOUTT), MX, D, D}; pg8::StaticOrder S; S.init(MX, D, F.G, F.bid); \
        pg8::EpiF32 E{(float*)(F.ws + WS_PROJ), D}; \
        pg8::gemm_phase<pg8::EpiF32, pg8::StaticOrder, PG8_ALIGN, PG8_SP2>(F.lds, g, S, E); }
#define PH6 { p6_mid(F); }
#define PH7 { pg8::Gemm g{(const pg8::bf16_t*)(F.ws + WS_HX), (const pg8::bf16_t*)(F.ws + WS_WEFFT), MX, NSC, D}; pg8::StaticOrder S; S.init(MX, NSC, F.G, F.bid); \
        pg8::EpiF32 E{(float*)(F.ws + WS_PROJ), NSC}; \
        pg8::gemm_phase<pg8::EpiF32, pg8::StaticOrder, PG8_ALIGN, PG8_SP2>(F.lds, g, S, E); }
#define PH8 { p8a_route(F); }
#define PH9 { p9_upass(F); }
#define PH10 { p10_combine(F); }
#define PH11 { p11_vpass<0>(F); }
#define PH12 { p12_final(F); }
#define PRB(k, body) if constexpr (PROBE_LO <= (k) && (k) <= PROBE_HI) { xcd_barrier(bar); body }
    if (IN(0)) PH0 PRB(0, PH0) SEAM(0);
    if (IN(1)) PH1 PRB(1, PH1) SEAM(1);
    if (IN(2)) PH2 PRB(2, PH2) SEAM(2);
    if (IN(3)) PH3 PRB(3, PH3) SEAM(3);
    if (IN(4)) PH4 PRB(4, PH4) SEAM(4);
    if (IN(5)) PH5 PRB(5, PH5) SEAM(5);
    if (IN(6)) PH6 PRB(6, PH6) SEAM(6);
    if (IN(7)) PH7 PRB(7, PH7) SEAM(7);
    if (IN(8)) PH8 PRB(8, PH8) SEAM(8);
    if (IN(9)) PH9 PRB(9, PH9) SEAM(9);
    if (IN(10)) PH10 PRB(10, PH10) SEAM(10);
    if constexpr (PROBE_LO == 111) { p11_vpass<1>(F); xcd_barrier(bar); }
    if constexpr (PROBE_LO == 112) { p11_vpass<2>(F); xcd_barrier(bar); }
    if (IN(11)) PH11 PRB(11, PH11) SEAM(11);
    if (IN(12)) PH12
#undef IN
#undef SEAM
}

extern "C" void kernel_launch(void* const* d_in, const int* in_sizes, int n_in, void* d_out, int out_size, void* d_ws, size_t ws_size, hipStream_t stream) {
    static int grid = 0;
    if (grid == 0) {
        if (n_in != 25 || in_sizes[0] != MX * D || out_size != MX * D || ws_size < WS_END) { fprintf(stderr, "kernel_launch: unexpected problem (n_in %d, in0 %d, out %d, ws %zu); nothing launched\n", n_in, n_in > 0 ? in_sizes[0] : -1, out_size, ws_size); grid = -1; return; }
        int dev = 0, cus = 0, per_cu = 0;
        if (hipGetDevice(&dev) != hipSuccess || hipDeviceGetAttribute(&cus, hipDeviceAttributeMultiprocessorCount, dev) != hipSuccess) { fprintf(stderr, "kernel_launch: device query failed\n"); grid = -1; return; }
        if (hipFuncSetAttribute((const void*)mk_fwd, hipFuncAttributeMaxDynamicSharedMemorySize, LDS_BYTES) != hipSuccess) { fprintf(stderr, "kernel_launch: hipFuncSetAttribute failed\n"); grid = -1; return; }
        if (hipOccupancyMaxActiveBlocksPerMultiprocessor(&per_cu, (const void*)mk_fwd, NWAVES * 64, LDS_BYTES) != hipSuccess || per_cu < 1) fprintf(stderr, "kernel_launch: occupancy query reports %d workgroups per CU\n", per_cu);
        (void)hipGetLastError();
        grid = cus;
    }
    if (grid < 0) return;
    if (hipMemsetAsync((char*)d_ws + WS_CTL, 0, CTL_ZERO_BYTES, stream) != hipSuccess) { fprintf(stderr, "kernel_launch: memset failed\n"); return; }
    Args a{};
    for (int i = 0; i < 25; ++i) a.in[i] = (const float*)d_in[i];
    a.out = (float*)d_out; a.ws = (unsigned char*)d_ws;
    if (MK_N_LAUNCHES == 1) { a.ph_lo = 0; a.ph_hi = NPH; hipLaunchKernelGGL(mk_fwd, dim3(grid), dim3(NWAVES * 64), LDS_BYTES, stream, a); }
    else for (int p = 0; p < NPH; ++p) { a.ph_lo = p; a.ph_hi = p + 1; hipLaunchKernelGGL(mk_fwd, dim3(grid), dim3(NWAVES * 64), LDS_BYTES, stream, a); }
    const hipError_t le = hipPeekAtLastError();
    if (le != hipSuccess) fprintf(stderr, "kernel_launch: launch failed: %s\n", hipGetErrorName(le));
}
```

```cpp
#include <hip/hip_runtime.h>
#include <cstdio>
#include <cstdint>
namespace pg8 {
#define PG8_LAS __attribute__((address_space(3)))
typedef unsigned short bf16_t;
typedef short bf16x8 __attribute__((ext_vector_type(8)));
typedef float f32x4 __attribute__((ext_vector_type(4)));
typedef unsigned u32x4 __attribute__((ext_vector_type(4)));
constexpr int BM = 256, BK = 64, HALF = 128, HTB = HALF * BK * 2  , STAGE_BYTES = 8 * HTB, NXCD = 8, WGM = 8;

__host__ __device__ __forceinline__ int lds_byte(int r, int c) { const int st = (r >> 4) * 2 + (c >> 5), rr = r & 15, cc = c & 31, ob = rr * 64 + cc * 2; return st * 1024 + (ob ^ (((ob >> 9) & 1) << 5)); }
__host__ __device__ __forceinline__ void stage_rc(int b, int& R, int& C) { const int st = b / 1024, sb = b % 1024, swz = sb ^ (((sb >> 9) & 1) << 5); R = (st >> 1) * 16 + swz / 64; C = (st & 1) * 32 + (swz % 64) / 2; }
__host__ __device__ __forceinline__ int perm32(int rho) { const int n = rho >> 4, i = rho & 15; return 8 * (i >> 2) + 4 * n + (i & 3); }

struct Unit { int pm, pn; };
struct Gemm { const bf16_t* A; const bf16_t* Bt; int M, N, K; };

struct StaticOrder {
    int nM, nN, nwg, G, c;
    __host__ __device__ void init(int M, int N, int G_, int c_) { nM = M / BM; nN = N / BM; nwg = nM * nN; G = G_; c = c_; }
    __host__ __device__ bool next(int i, Unit& u) const {
        const long L = (long)i * G + c; if (L >= nwg) return false;
        int wgid = (int)L; { const int q = nwg / NXCD, r = nwg % NXCD, xcd = wgid % NXCD, off = wgid / NXCD; wgid = (xcd < r ? xcd * (q + 1) : r * (q + 1) + (xcd - r) * q) + off; }
        const int nig = WGM * nN, gid = wgid / nig, fm = gid * WGM, gsz = (nM - fm) < WGM ? (nM - fm) : WGM;
        u.pm = fm + ((wgid % nig) % gsz); u.pn = (wgid % nig) / gsz; return true;
    }
    __device__ __forceinline__ void a_ready(const Unit&) const {}
    __device__ __forceinline__ void done(const Unit&) const {}
};

__device__ __forceinline__ unsigned cvt_pk_bf16(float lo, float hi) { unsigned r; asm volatile("v_cvt_pk_bf16_f32 %0, %1, %2" : "=v"(r) : "v"(lo), "v"(hi)); return r; }
typedef float f32x2 __attribute__((ext_vector_type(2)));
__device__ __forceinline__ f32x2 gelu_pk(f32x2 v) {
    const f32x2 av = __builtin_elementwise_abs(v), d = av * 0.2316418882f + 1.0f;
    f32x2 t; t.x = __builtin_amdgcn_rcpf(d.x); t.y = __builtin_amdgcn_rcpf(d.y);
    f32x2 q = t * 0.5307027145f + (-0.7265760135f); q = q * t + 0.7107068705f; q = q * t + (-0.142248368f); q = q * t + 0.127414796f; q = q * t;
    const f32x2 s = (v * v) * (-0.72134752044f);
    f32x2 e; e.x = __builtin_amdgcn_exp2f(s.x); e.y = __builtin_amdgcn_exp2f(s.y);
    const f32x2 m = v * (q * e), r = v - m;
    f32x2 o; o.x = v.x < 0.f ? m.x : r.x; o.y = v.y < 0.f ? m.y : r.y; return o;
}

template <int ACT  > struct EpiBf16 {
    static constexpr bool PERM = true, AFTER_DRAIN = false; static_assert(ACT == 0 || ACT == 1, "EpiBf16: ACT is 0 (none) or 1 (gelu_pk)");
    bf16_t* O; int ldc; const float* bias; int split_cols; size_t split_stride; float scale0;
    __device__ __forceinline__ void operator()(const f32x4 (&acc)[2][2][4][2], const Unit& u, int wr, int wc, int fr, int fq) const {
        const int row0 = u.pm * BM + wr * 64 + fr; int colt = u.pn * BM; bf16_t* base = O;
        float sc = 1.f; if (split_cols) { const int t = colt / split_cols; base += (size_t)t * split_stride; colt -= t * split_cols; if (t == 0) sc = scale0; }
        const int col0 = colt + wc * 32 + 8 * fq, bcol0 = u.pn * BM + wc * 32 + 8 * fq;
        f32x4 bv[2][2];
#pragma unroll
        for (int bj = 0; bj < 2; ++bj)
#pragma unroll
            for (int n = 0; n < 2; ++n) bv[bj][n] = bias ? *(const f32x4*)(bias + bcol0 + bj * HALF + 4 * n) : (f32x4){0.f, 0.f, 0.f, 0.f};
#pragma unroll
        for (int ai = 0; ai < 2; ++ai)
#pragma unroll
            for (int m = 0; m < 4; ++m) { bf16_t* rowp = base + (size_t)(row0 + ai * HALF + m * 16) * ldc + col0;
#pragma unroll
                for (int bj = 0; bj < 2; ++bj) { f32x4 v0 = acc[ai][bj][m][0] + bv[bj][0], v1 = acc[ai][bj][m][1] + bv[bj][1];
                    if (ACT == 1) { f32x2 a = gelu_pk((f32x2){v0[0], v0[1]}), b = gelu_pk((f32x2){v0[2], v0[3]}), c = gelu_pk((f32x2){v1[0], v1[1]}), d = gelu_pk((f32x2){v1[2], v1[3]});
                        v0 = (f32x4){a.x, a.y, b.x, b.y}; v1 = (f32x4){c.x, c.y, d.x, d.y}; }
                    v0 = v0 * sc; v1 = v1 * sc; u32x4 w; w.x = cvt_pk_bf16(v0[0], v0[1]); w.y = cvt_pk_bf16(v0[2], v0[3]); w.z = cvt_pk_bf16(v1[0], v1[1]); w.w = cvt_pk_bf16(v1[2], v1[3]);
                    *(u32x4*)(rowp + bj * HALF) = w; } }
    }
};

struct EpiF32 {
    static constexpr bool PERM = false, AFTER_DRAIN = false;
    float* C; int ldc;
    __device__ __forceinline__ void operator()(const f32x4 (&acc)[2][2][4][2], const Unit& u, int wr, int wc, int fr, int fq) const {
        const int row0 = u.pm * BM + wr * 64 + fr, col0 = u.pn * BM + wc * 32 + 4 * fq;
#pragma unroll
        for (int ai = 0; ai < 2; ++ai)
#pragma unroll
            for (int m = 0; m < 4; ++m) { float* rowp = C + (size_t)(row0 + ai * HALF + m * 16) * ldc + col0;
#pragma unroll
                for (int bj = 0; bj < 2; ++bj)
#pragma unroll
                    for (int n = 0; n < 2; ++n) *(f32x4*)(rowp + bj * HALF + n * 16) = acc[ai][bj][m][n]; }
    }
};
struct EpiProj {
    static constexpr bool PERM = true, AFTER_DRAIN = false;
    bf16_t* O; int ldc; int ncols;
    __device__ __forceinline__ void operator()(const f32x4 (&acc)[2][2][4][2], const Unit& u, int wr, int wc, int fr, int fq) const {
        const int row0 = u.pm * BM + wr * 64 + fr; const int col0 = u.pn * BM + wc * 32 + 8 * fq;
#pragma unroll
        for (int ai = 0; ai < 2; ++ai)
#pragma unroll
            for (int m = 0; m < 4; ++m) { bf16_t* rowp = O + (size_t)(row0 + ai * HALF + m * 16) * ldc + col0;
#pragma unroll
                for (int bj = 0; bj < 2; ++bj) { const f32x4 v0 = acc[ai][bj][m][0], v1 = acc[ai][bj][m][1];
                    u32x4 w; w.x = cvt_pk_bf16(v0[0], v0[1]); w.y = cvt_pk_bf16(v0[2], v0[3]); w.z = cvt_pk_bf16(v1[0], v1[1]); w.w = cvt_pk_bf16(v1[2], v1[3]);
                    if (col0 + bj * HALF < ncols) *(u32x4*)(rowp + bj * HALF) = w; } }
    }
};
template <class Epi, class Sched, bool ALIGN_EPI = false, bool SP2 = false>
__device__ __forceinline__ void gemm_phase(PG8_LAS unsigned char* lds, const Gemm g, const Sched& S, const Epi& E) {
    const int tid = threadIdx.x, wid = __builtin_amdgcn_readfirstlane(tid >> 6), lane = tid & 63, wr = wid >> 2, wc = wid & 3, fr = lane & 15, fq = lane >> 4;
    const int K = g.K, nt = K / BK;
    unsigned voffA[2], voffB[2];
#pragma unroll
    for (int i = 0; i < 2; ++i) { int R, C; stage_rc(tid * 16 + i * 8192, R, C); const int Rb = Epi::PERM ? ((R & ~31) + perm32(R & 31)) : R;
        voffA[i] = (unsigned)(R * K + C) * 2u; voffB[i] = (unsigned)(Rb * K + C) * 2u; }
    const size_t kstep = (size_t)(BK * 2);
    const size_t hstep = (size_t)HALF * K * 2;
    const size_t tstep = 2 * hstep;
    const unsigned ldsw = (unsigned)wid * 1024u;
    const int aoff = lds_byte(wr * 64 + fr, fq * 8), boff = lds_byte(wc * 32 + fr, fq * 8);
#define PG8_SA(b, h) (((b) * 2 + (h)) * HTB)
#define PG8_SB(b, h) ((4 + (b) * 2 + (h)) * HTB)
#define PG8_STAGE(bufoff, gbase, voff) do { _Pragma("unroll") for (int _i = 0; _i < 2; ++_i) \
        __builtin_amdgcn_global_load_lds((const unsigned*)((const char*)(gbase) + (voff)[_i]), (PG8_LAS unsigned*)(lds + (bufoff) + ldsw + _i * 8192), 16, 0, 0); } while (0)
#define PG8_LDA(dst, b, h) do { _Pragma("unroll") for (int m = 0; m < 4; ++m) _Pragma("unroll") for (int k = 0; k < 2; ++k) dst[m][k] = *(const PG8_LAS bf16x8*)(lds + PG8_SA(b, h) + aoff + m * 2048 + k * 1024); } while (0)
#define PG8_LDB(dst, b, h) do { _Pragma("unroll") for (int n = 0; n < 2; ++n) _Pragma("unroll") for (int k = 0; k < 2; ++k) dst[n][k] = *(const PG8_LAS bf16x8*)(lds + PG8_SB(b, h) + boff + n * 2048 + k * 1024); } while (0)
#define PG8_MMA(ai, bj, At, Bt) do { __builtin_amdgcn_s_setprio(1); _Pragma("unroll") for (int m = 0; m < 4; ++m) _Pragma("unroll") for (int n = 0; n < 2; ++n) _Pragma("unroll") for (int k = 0; k < 2; ++k) \
        acc[ai][bj][m][n] = __builtin_amdgcn_mfma_f32_16x16x32_bf16(Bt[n][k], At[m][k], acc[ai][bj][m][n], 0, 0, 0); __builtin_amdgcn_s_setprio(0); } while (0)
#define PG8_WAIT_V(n) asm volatile("s_waitcnt vmcnt(" #n ")" ::: "memory")
#define PG8_WAIT_L(n) asm volatile("s_waitcnt lgkmcnt(" #n ")" ::: "memory")
#define PG8_BAR __builtin_amdgcn_s_barrier()
#define PG8_SCHED __builtin_amdgcn_sched_barrier(0)
    Unit cur, nxt; int ui = 0;
    if (!S.next(0, cur)) return;
    f32x4 acc[2][2][4][2];
#pragma unroll
    for (int a = 0; a < 2; ++a)
#pragma unroll
        for (int b = 0; b < 2; ++b)
#pragma unroll
            for (int m = 0; m < 4; ++m)
#pragma unroll
                for (int n = 0; n < 2; ++n) acc[a][b][m][n] = (f32x4){0.f, 0.f, 0.f, 0.f};
    bf16x8 At[4][2], B0[2][2], B1[2][2];
    const char* cA = (const char*)g.A + (size_t)cur.pm * tstep; const char* cB = (const char*)g.Bt + (size_t)cur.pn * tstep;
    S.a_ready(cur);
    if constexpr (SP2) {
        PG8_STAGE(PG8_SB(0, 0), cB, voffB); PG8_STAGE(PG8_SB(0, 1), cB + hstep, voffB); PG8_STAGE(PG8_SA(0, 0), cA, voffA); PG8_STAGE(PG8_SA(0, 1), cA + hstep, voffA);
        if (wr == 1) PG8_BAR;
        PG8_WAIT_V(2); PG8_BAR;
        PG8_STAGE(PG8_SB(1, 0), cB + kstep, voffB); PG8_STAGE(PG8_SA(1, 0), cA + kstep, voffA); PG8_STAGE(PG8_SB(1, 1), cB + hstep + kstep, voffB);
        PG8_WAIT_V(6); PG8_BAR;
    } else {
        PG8_STAGE(PG8_SB(0, 0), cB, voffB); PG8_STAGE(PG8_SA(0, 0), cA, voffA); PG8_STAGE(PG8_SB(0, 1), cB + hstep, voffB); PG8_STAGE(PG8_SA(0, 1), cA + hstep, voffA);
        if (wr == 1) PG8_BAR;
        PG8_WAIT_V(4); PG8_BAR;
        PG8_STAGE(PG8_SB(1, 0), cB + kstep, voffB); PG8_STAGE(PG8_SA(1, 0), cA + kstep, voffA); PG8_STAGE(PG8_SB(1, 1), cB + hstep + kstep, voffB);
        PG8_WAIT_V(6); PG8_BAR;
    }
    for (;;) {
        const bool has_next = S.next(ui + 1, nxt);
        const char* nA = has_next ? (const char*)g.A + (size_t)nxt.pm * tstep : cA; const char* nB = has_next ? (const char*)g.Bt + (size_t)nxt.pn * tstep : cB;
        for (int t = 0; t < nt; t += 2) {
            const bool last = (t == nt - 2);
            const char* a1 = cA + (size_t)(t + 1) * kstep;
            const char* a2 = last ? nA : cA + (size_t)(t + 2) * kstep; const char* b2 = last ? nB : cB + (size_t)(t + 2) * kstep;
            const char* a3 = a2 + kstep; const char* b3 = b2 + kstep;
            if (last && has_next) S.a_ready(nxt);
            if constexpr (SP2) {
            PG8_LDB(B0, 0, 0); PG8_LDB(B1, 0, 1); PG8_SCHED; PG8_LDA(At, 0, 0); PG8_STAGE(PG8_SA(1, 1), a1 + hstep, voffA);
            PG8_WAIT_V(8); PG8_WAIT_L(0); PG8_BAR; PG8_MMA(0, 0, At, B0); PG8_MMA(0, 1, At, B1); PG8_BAR; PG8_SCHED;
            PG8_LDA(At, 0, 1); PG8_STAGE(PG8_SB(0, 0), b2, voffB); PG8_STAGE(PG8_SB(0, 1), b2 + hstep, voffB); PG8_STAGE(PG8_SA(0, 0), a2, voffA);
            PG8_WAIT_V(8); PG8_WAIT_L(0); PG8_BAR; PG8_MMA(1, 0, At, B0); PG8_MMA(1, 1, At, B1); PG8_BAR; PG8_SCHED;
            PG8_LDB(B0, 1, 0); PG8_LDB(B1, 1, 1); PG8_SCHED; PG8_LDA(At, 1, 0); PG8_STAGE(PG8_SA(0, 1), a2 + hstep, voffA);
            PG8_WAIT_V(8); PG8_WAIT_L(0); PG8_BAR; PG8_MMA(0, 0, At, B0); PG8_MMA(0, 1, At, B1); PG8_BAR; PG8_SCHED;
            PG8_LDA(At, 1, 1); PG8_STAGE(PG8_SB(1, 0), b3, voffB); PG8_STAGE(PG8_SB(1, 1), b3 + hstep, voffB); PG8_STAGE(PG8_SA(1, 0), a3, voffA);
            PG8_WAIT_V(8); PG8_WAIT_L(0); PG8_BAR; PG8_MMA(1, 0, At, B0); PG8_MMA(1, 1, At, B1); PG8_BAR; PG8_SCHED;
            } else {
            PG8_LDB(B0, 0, 0); PG8_SCHED; PG8_LDA(At, 0, 0); PG8_STAGE(PG8_SA(1, 1), a1 + hstep, voffA);
            PG8_WAIT_L(8); PG8_BAR; PG8_WAIT_L(0); PG8_MMA(0, 0, At, B0); PG8_BAR; PG8_SCHED;
            PG8_LDB(B1, 0, 1); PG8_STAGE(PG8_SB(0, 0), b2, voffB);
            PG8_BAR; PG8_WAIT_L(0); PG8_MMA(0, 1, At, B1); PG8_BAR;
            PG8_LDA(At, 0, 1); PG8_STAGE(PG8_SA(0, 0), a2, voffA);
            PG8_BAR; PG8_WAIT_L(0); PG8_MMA(1, 0, At, B0); PG8_BAR; PG8_SCHED;
            PG8_STAGE(PG8_SB(0, 1), b2 + hstep, voffB);
            PG8_WAIT_V(6); PG8_BAR; PG8_MMA(1, 1, At, B1); PG8_BAR;
            PG8_LDB(B0, 1, 0); PG8_SCHED; PG8_LDA(At, 1, 0); PG8_STAGE(PG8_SA(0, 1), a2 + hstep, voffA);
            PG8_WAIT_L(8); PG8_BAR; PG8_WAIT_L(0); PG8_MMA(0, 0, At, B0); PG8_BAR; PG8_SCHED;
            PG8_LDB(B1, 1, 1); PG8_STAGE(PG8_SB(1, 0), b3, voffB);
            PG8_BAR; PG8_WAIT_L(0); PG8_MMA(0, 1, At, B1); PG8_BAR;
            PG8_LDA(At, 1, 1); PG8_STAGE(PG8_SA(1, 0), a3, voffA);
            PG8_BAR; PG8_WAIT_L(0); PG8_MMA(1, 0, At, B0); PG8_BAR; PG8_SCHED;
            PG8_STAGE(PG8_SB(1, 1), b3 + hstep, voffB);
            PG8_WAIT_V(6); PG8_BAR; PG8_MMA(1, 1, At, B1); PG8_BAR;
            }
        }
        if constexpr (ALIGN_EPI) { if (wr == 0) PG8_BAR; }
        if constexpr (!Epi::AFTER_DRAIN) { E(acc, cur, wr, wc, fr, fq); S.done(cur); }
        if (!has_next) break;
#pragma unroll
        for (int a = 0; a < 2; ++a)
#pragma unroll
            for (int b = 0; b < 2; ++b)
#pragma unroll
                for (int m = 0; m < 4; ++m)
#pragma unroll
                    for (int n = 0; n < 2; ++n) acc[a][b][m][n] = (f32x4){0.f, 0.f, 0.f, 0.f};
        cur = nxt; cA = nA; cB = nB; ++ui;
        if constexpr (ALIGN_EPI) { if (wr == 1) PG8_BAR; }
    }
    PG8_WAIT_V(0);
    if constexpr (!ALIGN_EPI) { if (wr == 0) PG8_BAR; }
    PG8_BAR;
    if constexpr (Epi::AFTER_DRAIN) { E.fused(acc, cur, wr, wc, fr, fq, lds, wid, lane); S.done(cur); }
#undef PG8_SA
#undef PG8_SB
#undef PG8_STAGE
#undef PG8_LDA
#undef PG8_LDB
#undef PG8_MMA
#undef PG8_WAIT_V
#undef PG8_WAIT_L
#undef PG8_BAR
#undef PG8_SCHED
}
}
#ifndef PG8_SP2
#define PG8_SP2 true
#endif
#ifndef PG8_ALIGN
#define PG8_ALIGN true
#endif
constexpr int NWAVES = 8;
constexpr int D = 1024, NB = 4, T = 4096, TC = 256;
constexpr int MX = NB * T, MC = NB * TC, MA = MX + MC;
constexpr int NPROJ = 3456, NPROJ_PAD = 3584;
constexpr int COL_XB = 0, COL_XG = 512, COL_XC = 1024, COL_R = 1536, COL_K = 2048, COL_V = 2560, COL_G = 3072, COL_LW = 3200, COL_LA = 3328;
constexpr int NMOD = 6 * D;
constexpr int NEXP = 16384, NSC = 2048;
constexpr float NORM_EPS = 1e-6f, LNX_EPS = 64e-5f;
#ifndef MK_N_LAUNCHES
#define MK_N_LAUNCHES 1
#endif
constexpr int NPH = 13;
constexpr size_t MiB = 1u << 20;
constexpr size_t WS_CTL = 0, CTL_ZERO_BYTES = 64 * 1024;
constexpr size_t WS_MOD = 3 * MiB;
constexpr size_t WS_WINT = 6 * MiB;
constexpr size_t WS_WOUTT = 13 * MiB;
constexpr size_t WS_WEFFT = 15 * MiB;
constexpr size_t WS_U = 20 * MiB, WS_V = 52 * MiB;
constexpr size_t WS_HX = 84 * MiB;
constexpr size_t WS_PROJ = 118 * MiB;
constexpr size_t WS_END = 246 * MiB;
constexpr size_t WS_EXL = WS_V, WS_GL = WS_V + 4 * MiB, WS_PL = WS_V + 12 * MiB;
constexpr size_t WS_BLOB0 = WS_V, WS_BLOB1 = WS_HX;
constexpr size_t WS_PART = WS_PROJ, WS_PO = WS_PROJ + 64 * MiB;
static_assert(WS_PROJ + (size_t)MA * NPROJ * 2 <= WS_END && WS_PROJ + (size_t)MX * NSC * 4 <= WS_END && WS_HX + (size_t)MA * D * 2 <= WS_PROJ, "d_ws map");
constexpr int CW_BAR = 1024;
constexpr int RING_BYTES = 131072;
constexpr int LDSCTL_OFF = RING_BYTES, MISC_OFF = LDSCTL_OFF + 320;
constexpr int LDS_BYTES = 147456;

#define GAS __attribute__((address_space(1)))
#define LAS __attribute__((address_space(3)))
typedef unsigned short bf16;
typedef unsigned v4u __attribute__((ext_vector_type(4)));
typedef unsigned v2u __attribute__((ext_vector_type(2)));
typedef float f32x4 __attribute__((ext_vector_type(4)));
typedef float f32x2 __attribute__((ext_vector_type(2)));
typedef float f32x16 __attribute__((ext_vector_type(16)));
typedef short bf16x8 __attribute__((ext_vector_type(8)));
typedef GAS unsigned gu32;
#define RLX_AGENT __ATOMIC_RELAXED, __HIP_MEMORY_SCOPE_AGENT
#define LDS_WAIT() asm volatile("s_waitcnt lgkmcnt(0)" ::: "memory")
#define VM_WAIT() asm volatile("s_waitcnt vmcnt(0)" ::: "memory")
typedef __bf16 bf16v2 __attribute__((ext_vector_type(2)));
__device__ __forceinline__ unsigned pk2(float lo, float hi) { const f32x2 v = {lo, hi}; return __builtin_bit_cast(unsigned, __builtin_convertvector(v, bf16v2)); }
__device__ __forceinline__ float bf_lo(unsigned w) { return __builtin_bit_cast(float, w << 16); }
__device__ __forceinline__ float bf_hi(unsigned w) { return __builtin_bit_cast(float, w & 0xffff0000u); }
__device__ __forceinline__ float bf1(bf16 b) { return __builtin_bit_cast(float, (unsigned)b << 16); }
__device__ __forceinline__ float fast_exp(float x) { return __builtin_amdgcn_exp2f(x * 1.44269504089f); }
__device__ __forceinline__ float fast_rcp(float x) { return __builtin_amdgcn_rcpf(x); }
__device__ __forceinline__ float sigmoidf(float x) { return fast_rcp(1.f + fast_exp(-x)); }
__device__ __forceinline__ float tanh_fast(float x) { return 1.f - 2.f * fast_rcp(fast_exp(2.f * x) + 1.f); }
__device__ __forceinline__ float siluf(float x) { return x * sigmoidf(x); }
template <int CTRL> __device__ __forceinline__ float dppf(float x) { return __builtin_bit_cast(float, __builtin_amdgcn_update_dpp(0, __builtin_bit_cast(int, x), CTRL, 0xF, 0xF, false)); }
template <int CTRL> __device__ __forceinline__ unsigned dppu(unsigned x) { return (unsigned)__builtin_amdgcn_update_dpp(0, (int)x, CTRL, 0xF, 0xF, false); }
__device__ __forceinline__ float rowsum16(float x) { x += dppf<0xB1>(x); x += dppf<0x4E>(x); x += dppf<0x141>(x); x += dppf<0x140>(x); return x; }
__device__ __forceinline__ float wave_sum(float v) {
    v = rowsum16(v); v += __shfl_xor(v, 16); v += __shfl_xor(v, 32); return v;
}
__device__ __forceinline__ float half_sum32(float v) { v = rowsum16(v); v += __shfl_xor(v, 16); return v; }
__device__ __forceinline__ unsigned umaxu(unsigned a, unsigned b) { return a > b ? a : b; }
__device__ __forceinline__ unsigned wave_max_u32(unsigned x) {
    x = umaxu(x, dppu<0xB1>(x)); x = umaxu(x, dppu<0x4E>(x)); x = umaxu(x, dppu<0x141>(x)); x = umaxu(x, dppu<0x140>(x));
    const unsigned a = __builtin_amdgcn_readlane((int)x, 0), b = __builtin_amdgcn_readlane((int)x, 16), c = __builtin_amdgcn_readlane((int)x, 32), d = __builtin_amdgcn_readlane((int)x, 48);
    return umaxu(umaxu(a, b), umaxu(c, d));
}
__device__ __forceinline__ unsigned f2key(float f) { const unsigned u = __builtin_bit_cast(unsigned, f); return (u & 0x80000000u) ? ~u : (u | 0x80000000u); }
__device__ __forceinline__ float key2f(unsigned k) { const unsigned u = (k & 0x80000000u) ? (k ^ 0x80000000u) : ~k; return __builtin_bit_cast(float, u); }
#define XB_TMO      128
#define XB_XCNT(j)  (256  + 64 * (j))
#define XB_XSUB(j)  (1280 + 64 * (j))
#define XB_XGEN(j)  (2304 + 64 * (j))
#define XB_TOP      3328
#define XB_TOPGEN   3392
#define XCD_BAR_WORDS 3456
#define XB_SPIN_CAP (1u << 18)

__device__ __forceinline__ unsigned xb_ld(unsigned* p)              { return __hip_atomic_load(p, __ATOMIC_RELAXED, __HIP_MEMORY_SCOPE_AGENT); }
__device__ __forceinline__ unsigned xb_add(unsigned* p, unsigned v) { return __hip_atomic_fetch_add(p, v, __ATOMIC_RELAXED, __HIP_MEMORY_SCOPE_AGENT); }
__device__ __forceinline__ unsigned xb_xcc_id() { return (unsigned)__builtin_amdgcn_s_getreg((3 << 11) | 20) & 0xFu; }
#define XB_SPIN(cond, bar) do { unsigned _sp = 0; while (cond) { __builtin_amdgcn_s_sleep(1); \
    if ((++_sp & 255u) == 0u) { if (xb_ld(&(bar)[XB_TMO])) break; if (_sp > XB_SPIN_CAP) { atomicAdd(&(bar)[XB_TMO], 1u); break; } } } } while (0)

struct XcdBarrier {
    unsigned* bar; unsigned x;
    volatile LAS unsigned* st;
};

__device__ __forceinline__ XcdBarrier xcd_barrier_post(unsigned* bar, volatile LAS unsigned* st) {
    XcdBarrier b; b.bar = bar; b.x = xb_xcc_id(); b.st = st;
    if (threadIdx.x == 0) (void)xb_add(&bar[XB_XCNT(b.x)], 1u);
    return b;
}
__device__ __forceinline__ void xcd_barrier_complete(unsigned* bar, unsigned x, unsigned& nloc, unsigned& nx) {
    const unsigned G = gridDim.x * gridDim.y * gridDim.z;
    unsigned sum, cnt, mine, sp = 0u;
    for (;;) {
        sum = 0u; cnt = 0u; mine = 0u;
#pragma unroll
        for (unsigned j = 0; j < 16; ++j) { const unsigned c = xb_ld(&bar[XB_XCNT(j)]); sum += c; cnt += (c > 0u) ? 1u : 0u; mine = (j == x) ? c : mine; }
        if (sum == G) break;
        __builtin_amdgcn_s_sleep(1);
        if ((++sp & 255u) == 0u) { if (xb_ld(&bar[XB_TMO])) break; if (sp > XB_SPIN_CAP) { atomicAdd(&bar[XB_TMO], 1u); break; } }
    }
    nloc = mine > 0u ? mine : 1u; nx = cnt > 0u ? cnt : 1u;
}

__device__ __forceinline__ void xcd_barrier(const XcdBarrier& b) {
    asm volatile("s_waitcnt vmcnt(0)" ::: "memory");
    __syncthreads();
    if (threadIdx.x == 0) {
        unsigned* bar = b.bar;
        __builtin_amdgcn_s_waitcnt(0);
        unsigned nloc = b.st[0], nx = b.st[1];
        if (nloc == 0u) { xcd_barrier_complete(bar, b.x, nloc, nx); b.st[0] = nloc; b.st[1] = nx; }
        const unsigned old = xb_add(&bar[XB_XSUB(b.x)], 1u);
        const unsigned gen = old / nloc;
        if (old + 1u == (gen + 1u) * nloc) {
            __builtin_amdgcn_fence(__ATOMIC_RELEASE, "agent");
            asm volatile("s_waitcnt vmcnt(0)" ::: "memory");
            const unsigned og = xb_add(&bar[XB_TOP], 1u);
            const unsigned tg = og / nx;
            if (og + 1u == (tg + 1u) * nx) xb_add(&bar[XB_TOPGEN], 1u);
            else XB_SPIN(xb_ld(&bar[XB_TOPGEN]) == tg, bar);
            __builtin_amdgcn_fence(__ATOMIC_ACQUIRE, "agent");
            xb_add(&bar[XB_XGEN(b.x)], 1u);
            asm volatile("s_waitcnt vmcnt(0)" ::: "memory");
        } else {
            XB_SPIN(xb_ld(&bar[XB_XGEN(b.x)]) == gen, bar);
            __builtin_amdgcn_fence(__ATOMIC_ACQUIRE, "agent");
            asm volatile("s_waitcnt vmcnt(0)" ::: "memory");
        }
    }
    __syncthreads();
}
struct Frame {
    LAS unsigned char* lds;
    volatile LAS unsigned* MISC;
    gu32* ctl;
    int tid, lane, wave, G, bid;
    const float* in[25];
    float* out;
    unsigned char* ws;
};
enum { I_X = 0, I_C, I_CTX, I_CCTX, I_WMOD, I_BMOD, I_NG, I_WIN, I_WOUT, I_CONVW, I_TMU, I_DW0, I_DW2, I_A0, I_A2, I_GW2, I_KK, I_KA, I_RK, I_LNG, I_LNB, I_WQ, I_SUBK, I_PU, I_PV };

__device__ __forceinline__ void p0_transpose_item(const float* W, int K, int N, bf16* WT, LAS float* scr, int item, int lane) {
    const int nblk = N / 32, kb = item / nblk, nb = item % nblk, k0 = 64 * kb, n0 = 32 * nb;
#pragma unroll 8
    for (int i = 0; i < 32; ++i) { const int kk = 2 * i + (lane >> 5); scr[kk * 33 + (lane & 31)] = W[(size_t)(k0 + kk) * N + n0 + (lane & 31)]; }
    LDS_WAIT(); asm volatile("" ::: "memory");
    const int c = lane & 7;
#pragma unroll
    for (int j = 0; j < 4; ++j) { const int n = (lane >> 3) + 8 * j; const LAS float* s = scr + (8 * c) * 33 + n;
        v4u o; o.x = pk2(s[0 * 33], s[1 * 33]); o.y = pk2(s[2 * 33], s[3 * 33]); o.z = pk2(s[4 * 33], s[5 * 33]); o.w = pk2(s[6 * 33], s[7 * 33]);
        *(v4u*)(WT + (size_t)(n0 + n) * K + k0 + 8 * c) = o; }
    LDS_WAIT(); asm volatile("" ::: "memory");
}
__device__ __forceinline__ void p0_mod_item(Frame& F, int cb) {
    LAS float* S = (LAS float*)F.lds;
    LAS float* RED = (LAS float*)(F.lds + 32768);
    const float* c = F.in[I_C]; const float* cc = F.in[I_CCTX];
    for (int i = F.tid; i < 5 * D; i += 512) { const int r = i >> 10, k = i & 1023; const float v = (r < 4) ? c[r * D + k] : cc[k]; S[i] = siluf(v); }
    __syncthreads();
    const int col = F.tid & 63, kg = F.tid >> 6;
    const float* wp = F.in[I_WMOD] + (size_t)(kg * 128) * NMOD + cb * 64 + col;
    float a0 = 0.f, a1 = 0.f, a2 = 0.f, a3 = 0.f, a4 = 0.f;
#pragma unroll 8
    for (int k = 0; k < 128; ++k) { const float w = wp[(size_t)k * NMOD]; const int kk = kg * 128 + k;
        a0 += S[kk] * w; a1 += S[D + kk] * w; a2 += S[2 * D + kk] * w; a3 += S[3 * D + kk] * w; a4 += S[4 * D + kk] * w; }
    RED[(kg * 5 + 0) * 64 + col] = a0; RED[(kg * 5 + 1) * 64 + col] = a1; RED[(kg * 5 + 2) * 64 + col] = a2; RED[(kg * 5 + 3) * 64 + col] = a3; RED[(kg * 5 + 4) * 64 + col] = a4;
    __syncthreads();
    if (F.tid < 320) { const int r = F.tid >> 6, cl = F.tid & 63; float s = F.in[I_BMOD][cb * 64 + cl];
#pragma unroll
        for (int g = 0; g < 8; ++g) s += RED[(g * 5 + r) * 64 + cl];
        ((float*)(F.ws + WS_MOD))[r * NMOD + cb * 64 + cl] = s; }
    __syncthreads();
}
__device__ __forceinline__ void p0_weff_item(Frame& F, int item) {
    const int hs = item >> 4, kb = item & 15;
    LAS float* SK = (LAS float*)F.lds;
    LAS float* WQ = (LAS float*)(F.lds + 128 * 132 * 4);
    const float* sk = F.in[I_SUBK] + (size_t)hs * 128 * 128;
    const float* wq = F.in[I_WQ] + (size_t)(kb * 64) * 2048 + hs * 128;
#pragma unroll
    for (int i = 0; i < 8; ++i) { const int idx = F.tid + 512 * i, row = idx >> 5, c4 = idx & 31; const f32x4 v = *(const f32x4*)(sk + row * 128 + c4 * 4); *(LAS f32x4*)(SK + row * 132 + c4 * 4) = v; }
#pragma unroll
    for (int i = 0; i < 4; ++i) { const int idx = F.tid + 512 * i, row = idx >> 5, c4 = idx & 31; const f32x4 v = *(const f32x4*)(wq + (size_t)row * 2048 + c4 * 4); *(LAS f32x4*)(WQ + row * 132 + c4 * 4) = v; }
    __syncthreads();
    const int key = F.tid >> 2, kq = F.tid & 3;
    float acc[16];
#pragma unroll
    for (int i = 0; i < 16; ++i) acc[i] = 0.f;
    for (int d = 0; d < 128; d += 4) {
        const f32x4 a = *(const LAS f32x4*)(SK + key * 132 + d);
#pragma unroll
        for (int i = 0; i < 16; ++i) { const f32x4 b = *(const LAS f32x4*)(WQ + (4 * i + kq) * 132 + d); acc[i] += a.x * b.x + a.y * b.y + a.z * b.z + a.w * b.w; }
    }
    bf16* dst = (bf16*)(F.ws + WS_WEFFT) + (size_t)(hs * 128 + key) * D + kb * 64;
#pragma unroll
    for (int i = 0; i < 16; ++i) dst[4 * i + kq] = (bf16)(pk2(acc[i], 0.f) & 0xffffu);
    __syncthreads();
}
__device__ __forceinline__ void p0_prep(Frame& F) {
    for (int it = F.bid; it < 96 + 256; it += F.G) { if (it < 96) p0_mod_item(F, it); else p0_weff_item(F, it - 96); }
    LAS float* scr = (LAS float*)(F.lds + F.wave * 16384);
    const int gw = F.bid * NWAVES + F.wave, NGW = F.G * NWAVES;
    constexpr int I_IN = (D / 64) * (NPROJ / 32), I_OUT = (D / 64) * (D / 32);
    for (int it = gw; it < I_IN + I_OUT; it += NGW) {
        if (it < I_IN) p0_transpose_item(F.in[I_WIN], D, NPROJ, (bf16*)(F.ws + WS_WINT), scr, it, F.lane);
        else p0_transpose_item(F.in[I_WOUT], D, D, (bf16*)(F.ws + WS_WOUTT), scr, it - I_IN, F.lane);
    }
    { v4u* z = (v4u*)((bf16*)(F.ws + WS_WINT) + (size_t)NPROJ * D); const int n16 = (NPROJ_PAD - NPROJ) * D * 2 / 16;
      for (int i = F.bid * 512 + F.tid; i < n16; i += F.G * 512) z[i] = (v4u){0u, 0u, 0u, 0u}; }
    { const f32x4* pu = (const f32x4*)F.in[I_PU]; v2u* du = (v2u*)(F.ws + WS_U);
      const int n8 = NEXP * D / 8;
      for (int i = F.bid * 512 + F.tid; i < n8; i += F.G * 512) {
          const f32x4 a0 = pu[2 * i] * 32.f, a1 = pu[2 * i + 1] * 32.f;
          int w0 = __builtin_amdgcn_cvt_pk_fp8_f32(a0.x, a0.y, 0, false); w0 = __builtin_amdgcn_cvt_pk_fp8_f32(a0.z, a0.w, w0, true);
          int w1 = __builtin_amdgcn_cvt_pk_fp8_f32(a1.x, a1.y, 0, false); w1 = __builtin_amdgcn_cvt_pk_fp8_f32(a1.z, a1.w, w1, true);
          du[i] = (v2u){(unsigned)w0, (unsigned)w1}; } }
}

__device__ __forceinline__ void p1_hx(Frame& F) {
    const float* mod = (const float*)(F.ws + WS_MOD); const float* ng = F.in[I_NG];
    bf16* hx = (bf16*)(F.ws + WS_HX);
    for (int m = F.bid * NWAVES + F.wave; m < MA; m += F.G * NWAVES) {
        const float* src = (m < MX) ? F.in[I_X] + (size_t)m * D : F.in[I_CTX] + (size_t)(m - MX) * D;
        const float* mr = mod + ((m < MX) ? (m >> 12) : 4) * NMOD;
        f32x4 v[4]; float ss = 0.f;
#pragma unroll
        for (int j = 0; j < 4; ++j) { v[j] = *(const f32x4*)(src + j * 256 + F.lane * 4); ss += v[j].x * v[j].x + v[j].y * v[j].y + v[j].z * v[j].z + v[j].w * v[j].w; }
        const float rstd = __builtin_amdgcn_rsqf(wave_sum(ss) * (1.f / D) + NORM_EPS);
#pragma unroll
        for (int j = 0; j < 4; ++j) { const int c = j * 256 + F.lane * 4;
            const f32x4 g = *(const f32x4*)(ng + c), sh = *(const f32x4*)(mr + c), sc = *(const f32x4*)(mr + D + c);
            const float o0 = v[j].x * rstd * g.x * (1.f + sc.x) + sh.x, o1 = v[j].y * rstd * g.y * (1.f + sc.y) + sh.y, o2 = v[j].z * rstd * g.z * (1.f + sc.z) + sh.z, o3 = v[j].w * rstd * g.w * (1.f + sc.w) + sh.w;
            *(v2u*)(hx + (size_t)m * D + c) = (v2u){pk2(o0, o1), pk2(o2, o3)}; }
    }
}
constexpr int BL_APT = 0, BL_NPT = 4608, BL_RH = 7168, BL_MKR = 11776, BL_MBR = 14336, BL_KGC = 16896, BL_BGC = 22016, BL_GC = 27136, BL_VT = 27648, BL_BYTES = 32768;
constexpr int CS_AH = 32768, CS_BH = 37376, CS_KH = 41984, CS_AHC = 46592, CS_E = 51712, CS_RAW = 59904, CS_TLW = 72960, CS_LOA = 77568, CS_W2T = 82176, CS_A2T = 91392,
              CS_LG = 100608, CS_NBA = 100608, CS_NKA = 105216, CS_TT = 107776, CS_CONST = 116992, CS_END = 119552;
constexpr int CS_RH = BL_RH, CS_KGC = BL_KGC, CS_BGC = BL_BGC, CS_VT = BL_VT, CS_GC = BL_GC, CS_APT = BL_APT, CS_NPT = BL_NPT, CS_MKR = BL_MKR, CS_MBR = BL_MBR;
constexpr int SC_NTILE = (TC + T) / 32, SC_RT = 16, SC_NROUND = (SC_NTILE + SC_RT - 1) / SC_RT;
constexpr int GS_YS = 65536;
__device__ __forceinline__ void scan_issue_loads(const bf16* proj, int b, int h, int d, int tile, int tid, v4u (&rg)[3]) {
    const bool isctx = tile < TC / 32; const int L = isctx ? TC : T; const int jt = isctx ? tile : tile - TC / 32;
    const size_t rowbase = isctx ? (size_t)(MX + b * TC) : (size_t)b * T;
    const int tlo = d == 0 ? 32 * jt : L - 32 * (jt + 1);
#pragma unroll
    for (int i = 0; i < 3; ++i) {
        const int q = tid + 512 * i; v4u val = (v4u){0u, 0u, 0u, 0u};
        if (q < 816) { const int row = q / 24, rem = q - row * 24, which = rem >> 3, ch8 = rem & 7; const int tok = tlo - 1 + row;
            if (tok >= 0 && tok < L) val = *(const v4u*)(proj + (rowbase + tok) * NPROJ + COL_R + which * 512 + h * 64 + ch8 * 8); }
        else if (q < 1328) { const int q2 = q - 816, row = q2 >> 4, rem = q2 & 15, which = rem >> 3, ch8 = rem & 7; const int tok = tlo + row;
            val = *(const v4u*)(proj + (rowbase + tok) * NPROJ + (which ? COL_LA : COL_LW) + d * 64 + ch8 * 8); }
        rg[i] = val;
    }
}
__device__ __forceinline__ unsigned tanh_pk(unsigned w) { return pk2(tanh_fast(bf_lo(w)), tanh_fast(bf_hi(w))); }
__device__ __forceinline__ void scan_store_raw(LAS unsigned char* lds, int tid, const v4u (&rg)[3]) {
#pragma unroll
    for (int i = 0; i < 3; ++i) {
        const int q = tid + 512 * i;
        if (q < 816) { const int row = q / 24, rem = q - row * 24, which = rem >> 3, ch8 = rem & 7; *(LAS v4u*)(lds + CS_RAW + (which * 34 + row) * 128 + ch8 * 16) = rg[i]; }
        else if (q < 1328) { const int q2 = q - 816, row = q2 >> 4, rem = q2 & 15, which = rem >> 3, ch8 = rem & 7;
            if (which) *(LAS v4u*)(lds + CS_LOA + row * 144 + ch8 * 16) = rg[i];
            else { v4u t; t.x = tanh_pk(rg[i].x); t.y = tanh_pk(rg[i].y); t.z = tanh_pk(rg[i].z); t.w = tanh_pk(rg[i].w); *(LAS v4u*)(lds + CS_TLW + row * 144 + ch8 * 16) = t; } }
    }
}
__device__ __forceinline__ v2u pack4(f32x4 v) { return (v2u){pk2(v.x, v.y), pk2(v.z, v.w)}; }
__device__ __forceinline__ bf16 bfs(float v) { return (bf16)(pk2(v, 0.f) & 0xffffu); }
typedef v2u v2u_t;
__device__ __forceinline__ bf16x8 frag2(const LAS unsigned char* p0, const LAS unsigned char* p1) {
    const v2u a = *(const LAS v2u*)p0, b = *(const LAS v2u*)p1; const v4u w = (v4u){a.x, a.y, b.x, b.y}; return __builtin_bit_cast(bf16x8, w);
}
__device__ __forceinline__ bf16x8 frag_acc(f32x4 lo, f32x4 hi) { const v4u w = (v4u){pk2(lo.x, lo.y), pk2(lo.z, lo.w), pk2(hi.x, hi.y), pk2(hi.z, hi.w)}; return __builtin_bit_cast(bf16x8, w); }
__device__ __forceinline__ bf16x8 frag_zero() { const v4u w = (v4u){0u, 0u, 0u, 0u}; return __builtin_bit_cast(bf16x8, w); }
__device__ __forceinline__ void scan_prep_task(Frame& F, const bf16* proj, int chain, int tile, bool load_consts, bool have_next, int nchain, int ntile, v4u (&rg)[3], unsigned char* blob) {
    LAS unsigned char* lds = F.lds; const int tid = F.tid, lane = F.lane, wave = F.wave;
    const int b = chain >> 4, h = (chain >> 1) & 7, d = chain & 1, nb = nchain >> 4, nh = (nchain >> 1) & 7, nd = nchain & 1;
    if (load_consts) {
        __syncthreads();
        LAS float* C = (LAS float*)(lds + CS_CONST);
        if (tid < 384) { const int pn = tid / 192, r = tid - pn * 192, which = r >> 6, c = r & 63; C[pn * 192 + which * 64 + c] = F.in[I_TMU][(pn * 3 + which) * 512 + h * 64 + c]; }
        else if (tid < 448) { const int c = tid - 384; C[384 + c] = F.in[I_KK][h * 64 + c]; C[448 + c] = F.in[I_KA][h * 64 + c]; }
        else { const int c = tid - 448; C[512 + c] = F.in[I_DW0][d * 512 + h * 64 + c]; C[576 + c] = F.in[I_A0][d * 512 + h * 64 + c]; }
        const float* w2 = F.in[I_DW2] + (size_t)d * 64 * 512 + h * 64; const float* a2 = F.in[I_A2] + (size_t)d * 64 * 512 + h * 64;
#pragma unroll
        for (int i = 0; i < 8; ++i) { const int idx = tid + 512 * i, j = idx >> 6, c = idx & 63;
            *(LAS bf16*)(lds + CS_W2T + c * 144 + j * 2) = bfs(w2[j * 512 + c]);
            *(LAS bf16*)(lds + CS_A2T + c * 144 + j * 2) = bfs(a2[j * 512 + c]); }
    }
    {
            scan_store_raw(lds, tid, rg);
            __syncthreads();
            if (have_next) scan_issue_loads(proj, nb, nh, nd, ntile, tid, rg);
            if (wave < 4) {
                const int mat = wave >> 1, nt = wave & 1, r = lane & 31, hh = lane >> 5;
                const LAS unsigned char* Ab = lds + (mat ? CS_LOA : CS_TLW) + r * 144 + hh * 16;
                const LAS unsigned char* Bb = lds + (mat ? CS_A2T : CS_W2T) + (nt * 32 + r) * 144 + hh * 16;
                f32x16 acc;
#pragma unroll
                for (int i = 0; i < 16; ++i) acc[i] = 0.f;
#pragma unroll
                for (int ks = 0; ks < 4; ++ks) { const bf16x8 a = *(const LAS bf16x8*)(Ab + ks * 32), bb = *(const LAS bf16x8*)(Bb + ks * 32); acc = __builtin_amdgcn_mfma_f32_32x32x16_bf16(a, bb, acc, 0, 0, 0); }
                LAS float* LG = (LAS float*)(lds + CS_LG) + mat * 2048 + nt * 32 + r;
#pragma unroll
                for (int i = 0; i < 16; ++i) LG[((i & 3) + 8 * (i >> 2) + 4 * hh) * 64] = acc[i];
            }
            __syncthreads();
            const int tok = tid >> 4, cq = tid & 15, c0 = cq * 4, s = d == 0 ? tok : 31 - tok;
            f32x4 rs, vs, kd, kk, kka, ev;
            { const LAS float* C = (const LAS float*)(lds + CS_CONST);
              f32x4 xs[3];
#pragma unroll
              for (int which = 0; which < 3; ++which) {
                  const LAS unsigned char* rp = lds + CS_RAW + (which * 34 + tok) * 128 + c0 * 2;
                  const v2u p = *(const LAS v2u*)rp, x = *(const LAS v2u*)(rp + 128), n = *(const LAS v2u*)(rp + 256);
                  const f32x4 mp = *(const LAS f32x4*)(C + which * 64 + c0), mn = *(const LAS f32x4*)(C + 192 + which * 64 + c0);
                  const f32x4 xp = (f32x4){bf_lo(p.x), bf_hi(p.x), bf_lo(p.y), bf_hi(p.y)}, xc = (f32x4){bf_lo(x.x), bf_hi(x.x), bf_lo(x.y), bf_hi(x.y)}, xn = (f32x4){bf_lo(n.x), bf_hi(n.x), bf_lo(n.y), bf_hi(n.y)};
                  xs[which] = xc + mp * (xp - xc) + mn * (xn - xc); }
              const f32x4 kkc = *(const LAS f32x4*)(C + 384 + c0), kac = *(const LAS f32x4*)(C + 448 + c0), w0 = *(const LAS f32x4*)(C + 512 + c0), a0 = *(const LAS f32x4*)(C + 576 + c0);
              kk = xs[1] * kkc;
              const float ss = rowsum16(kk.x * kk.x + kk.y * kk.y + kk.z * kk.z + kk.w * kk.w);
              kk = kk * __builtin_amdgcn_rsqf(ss + 1e-12f);
              const f32x4 uw = *(const LAS f32x4*)(lds + CS_LG + (tok * 64 + c0) * 4) + w0, ua = *(const LAS f32x4*)(lds + CS_LG + 8192 + (tok * 64 + c0) * 4) + a0;
              f32x4 av;
#pragma unroll
              for (int e = 0; e < 4; ++e) { ev[e] = 0.60653066f * sigmoidf(uw[e]); av[e] = sigmoidf(ua[e]); }
              kd = xs[1] * (1.f + (av - 1.f) * kac); kka = kk * av; rs = xs[0]; vs = xs[2];
              *(LAS f32x4*)(lds + CS_E + (s * 64 + c0) * 4) = ev; }
            __syncthreads();
            { const int cb = s & 16, sl = s & 15;
              f32x4 cum = (f32x4){0.f, 0.f, 0.f, 0.f}, tot = cum;
#pragma unroll
              for (int ii = 0; ii < 16; ++ii) { const f32x4 e4 = *(const LAS f32x4*)(lds + CS_E + ((cb + ii) * 64 + c0) * 4); tot = tot + e4; if (ii <= sl) cum = cum + e4; }
              f32x4 g, gm1, gi, ge, gt;
#pragma unroll
              for (int e = 0; e < 4; ++e) { g[e] = fast_exp(-cum[e]); gm1[e] = fast_exp(ev[e] - cum[e]); gi[e] = fast_exp(cum[e]); ge[e] = fast_exp(cum[e] - tot[e]); gt[e] = fast_exp(-tot[e]); }
              const f32x4 ah = gm1 * kk, bh = kka * gi, kh = kd * gi, rh = g * rs, kg = kd * ge, bg = kka * ge;
              *(LAS v2u*)(lds + CS_AH + s * 144 + c0 * 2) = pack4(ah); *(LAS v2u*)(lds + CS_BH + s * 144 + c0 * 2) = pack4(bh);
              *(LAS v2u*)(lds + CS_KH + s * 144 + c0 * 2) = pack4(kh); *(LAS v2u*)(lds + CS_RH + s * 144 + c0 * 2) = pack4(rh);
#pragma unroll
              for (int e = 0; e < 4; ++e) { *(LAS bf16*)(lds + CS_AHC + (c0 + e) * 80 + s * 2) = bfs(ah[e]); *(LAS bf16*)(lds + CS_KGC + (c0 + e) * 80 + s * 2) = bfs(kg[e]); *(LAS bf16*)(lds + CS_BGC + (c0 + e) * 80 + s * 2) = bfs(-bg[e]); }
#pragma unroll
              for (int e = 0; e < 4; ++e) *(LAS bf16*)(lds + CS_VT + (c0 + e) * 80 + s * 2) = bfs(vs[e]);
              if (sl == 15) *(LAS f32x4*)(lds + CS_GC + ((s >> 4) * 64 + c0) * 4) = gt; }
            __syncthreads();
            if (wave < 4) {
                const int r = lane & 31, hh = lane >> 5;
                const LAS unsigned char* Ab = lds + ((wave == 0 || wave == 3) ? CS_BH : CS_KH) + r * 144 + hh * 16;
                const LAS unsigned char* Bb = lds + (wave < 2 ? CS_AH : CS_RH) + r * 144 + hh * 16;
                f32x16 acc;
#pragma unroll
                for (int i = 0; i < 16; ++i) acc[i] = 0.f;
#pragma unroll
                for (int ks = 0; ks < 4; ++ks) { const bf16x8 a = *(const LAS bf16x8*)(Ab + ks * 32), bb = *(const LAS bf16x8*)(Bb + ks * 32); acc = __builtin_amdgcn_mfma_f32_32x32x16_bf16(a, bb, acc, 0, 0, 0); }
                const int t = r;
#pragma unroll
                for (int i = 0; i < 16; ++i) { const int j = (i & 3) + 8 * (i >> 2) + 4 * hh; const bool same = (j >> 4) == (t >> 4);
                    const bool keep = same && (wave < 2 ? (j < t) : (j <= t)); acc[i] = keep ? acc[i] : 0.f; }
                if (wave == 0) {
#pragma unroll
                    for (int i = 0; i < 16; ++i) { const int j = (i & 3) + 8 * (i >> 2) + 4 * hh; *(LAS float*)(lds + CS_NBA + (t * 36 + j) * 4) = acc[i]; } }
                else if (wave == 1) {
#pragma unroll
                    for (int i = 0; i < 16; ++i) { const int j = (i & 3) + 8 * (i >> 2) + 4 * hh; *(LAS bf16*)(lds + CS_NKA + j * 80 + t * 2) = bfs(acc[i]); } }
                else { const float sg = wave == 2 ? 1.f : -1.f; const int base = wave == 2 ? CS_MKR : CS_MBR;
#pragma unroll
                    for (int q4 = 0; q4 < 4; ++q4) *(LAS v2u*)(lds + base + t * 80 + (8 * q4 + 4 * hh) * 2) = pack4((f32x4){sg * acc[4 * q4], sg * acc[4 * q4 + 1], sg * acc[4 * q4 + 2], sg * acc[4 * q4 + 3]}); }
            }
            __syncthreads();
            if (wave == 0 && lane < 32) {
                const int blk = lane >> 4, i = lane & 15;
                float Tr[16];
#pragma unroll
                for (int t = 0; t < 16; ++t) {
                    float acc = (t == i) ? 1.f : 0.f;
                    const LAS float* np = (const LAS float*)(lds + CS_NBA) + (16 * blk + t) * 36 + 16 * blk;
#pragma unroll
                    for (int j = 0; j < t; ++j) acc -= Tr[j] * np[j];
                    Tr[t] = acc;
                }
#pragma unroll
                for (int t = 0; t < 16; ++t) { *(LAS bf16*)(lds + CS_TT + (16 * blk + t) * 80 + (16 * blk + i) * 2) = bfs(Tr[t]); *(LAS bf16*)(lds + CS_TT + (16 * blk + t) * 80 + (16 * (1 - blk) + i) * 2) = (bf16)0; }
            }
            __syncthreads();
            if (wave < 3) {
                const int r = lane & 31, hh = lane >> 5;
                const LAS unsigned char* Ab = lds + (wave < 2 ? CS_AHC + (32 * wave + r) * 80 : CS_NKA + r * 80) + hh * 16;
                const LAS unsigned char* Bb = lds + CS_TT + r * 80 + hh * 16;
                f32x16 acc;
#pragma unroll
                for (int i = 0; i < 16; ++i) acc[i] = 0.f;
#pragma unroll
                for (int ks = 0; ks < 2; ++ks) { const bf16x8 a = *(const LAS bf16x8*)(Ab + ks * 32), bb = *(const LAS bf16x8*)(Bb + ks * 32); acc = __builtin_amdgcn_mfma_f32_32x32x16_bf16(a, bb, acc, 0, 0, 0); }
                const int t = r;
#pragma unroll
                for (int q4 = 0; q4 < 4; ++q4) { const v2u pk = pack4((f32x4){acc[4 * q4], acc[4 * q4 + 1], acc[4 * q4 + 2], acc[4 * q4 + 3]});
                    if (wave < 2) *(LAS v2u*)(lds + CS_APT + t * 144 + (32 * wave + 8 * q4 + 4 * hh) * 2) = pk;
                    else *(LAS v2u*)(lds + CS_NPT + t * 80 + (8 * q4 + 4 * hh) * 2) = pk; }
            }
            __syncthreads();
#pragma unroll
            for (int i = 0; i < 4; ++i) { const int idx = tid + 512 * i; *(v4u*)(blob + idx * 16) = *(const LAS v4u*)(lds + idx * 16); }
    }
}
__device__ __forceinline__ void scan_state_round(Frame& F, int chain, int t0, int t1, const unsigned char* blobs, f32x4 (&Z)[4]) {
    LAS unsigned char* lds = F.lds; const int tid = F.tid, lane = F.lane, wave = F.wave;
    const int b = chain >> 4, h = (chain >> 1) & 7, d = chain & 1;
    float* yscr = F.out;
    v4u bg[4];
    __syncthreads();
#pragma unroll
    for (int i = 0; i < 4; ++i) bg[i] = *(const v4u*)(blobs + (tid + 512 * i) * 16);
#pragma unroll
    for (int i = 0; i < 4; ++i) *(LAS v4u*)(lds + (tid + 512 * i) * 16) = bg[i];
    __syncthreads();
    for (int tile = t0; tile < t1; ++tile) {
        const bool isctx = tile < TC / 32; const int L = isctx ? TC : T; const int jt = isctx ? tile : tile - TC / 32;
        const int tlo = d == 0 ? 32 * jt : L - 32 * (jt + 1);
        const LAS unsigned char* bl = lds + ((tile - t0) & 1) * BL_BYTES;
        if (tile + 1 < t1) {
#pragma unroll
            for (int i = 0; i < 4; ++i) bg[i] = *(const v4u*)(blobs + (size_t)(tile + 1 - t0) * BL_BYTES + (tid + 512 * i) * 16); }
            if (wave < 4) {
                const int n = lane & 15, g = lane >> 4;
                const bf16x8 bvt = *(const LAS bf16x8*)(bl + BL_VT + (16 * wave + n) * 80 + g * 16);
                f32x4 U[2]; U[0] = (f32x4){0.f, 0.f, 0.f, 0.f}; U[1] = U[0];
#pragma unroll
                for (int cc = 0; cc < 2; ++cc) {
                    const int trow = 16 * cc + n;
                    const bf16x8 bz01 = frag_acc(Z[0], Z[1]), bz23 = frag_acc(Z[2], Z[3]);
                    { const LAS unsigned char* ap = bl + BL_APT + trow * 144;
                      f32x4 u = __builtin_amdgcn_mfma_f32_16x16x32_bf16(frag2(ap + (4 * g) * 2, ap + (16 + 4 * g) * 2), bz01, (f32x4){0.f, 0.f, 0.f, 0.f}, 0, 0, 0);
                      u = __builtin_amdgcn_mfma_f32_16x16x32_bf16(frag2(ap + (32 + 4 * g) * 2, ap + (48 + 4 * g) * 2), bz23, u, 0, 0, 0);
                      u = __builtin_amdgcn_mfma_f32_16x16x32_bf16(*(const LAS bf16x8*)(bl + BL_NPT + trow * 80 + g * 16), bvt, u, 0, 0, 0);
                      U[cc] = u; }
                    const bf16x8 bu = frag_acc(U[0], U[1]);
                    if (!isctx) { const LAS unsigned char* rp = bl + BL_RH + trow * 144;
                      f32x4 y = __builtin_amdgcn_mfma_f32_16x16x32_bf16(frag2(rp + (4 * g) * 2, rp + (16 + 4 * g) * 2), bz01, (f32x4){0.f, 0.f, 0.f, 0.f}, 0, 0, 0);
                      y = __builtin_amdgcn_mfma_f32_16x16x32_bf16(frag2(rp + (32 + 4 * g) * 2, rp + (48 + 4 * g) * 2), bz23, y, 0, 0, 0);
                      y = __builtin_amdgcn_mfma_f32_16x16x32_bf16(*(const LAS bf16x8*)(bl + BL_MKR + trow * 80 + g * 16), bvt, y, 0, 0, 0);
                      const LAS unsigned char* mp = bl + BL_MBR + trow * 80;
                      y = __builtin_amdgcn_mfma_f32_16x16x32_bf16(frag2(mp + (4 * g) * 2, mp + (16 + 4 * g) * 2), bu, y, 0, 0, 0);
#pragma unroll
                      for (int i = 0; i < 4; ++i) *(LAS float*)(lds + GS_YS + ((16 * cc + 4 * g + i) * 64 + 16 * wave + n) * 4) = y[i]; }
#pragma unroll
                    for (int kt = 0; kt < 4; ++kt) {
                        const f32x4 gc = *(const LAS f32x4*)(bl + BL_GC + (cc * 64 + 16 * kt + 4 * g) * 4);
                        bf16x8 ka = *(const LAS bf16x8*)(bl + BL_KGC + (16 * kt + n) * 80 + g * 16);
                        if ((g >> 1) != cc) ka = frag_zero();
                        const LAS unsigned char* bp = bl + BL_BGC + (16 * kt + n) * 80;
                        const v2u b0 = *(const LAS v2u*)(bp + (4 * g) * 2), b1 = *(const LAS v2u*)(bp + (16 + 4 * g) * 2);
                        const v4u bw = cc == 0 ? (v4u){b0.x, b0.y, 0u, 0u} : (v4u){0u, 0u, b1.x, b1.y};
                        f32x4 z = Z[kt] * gc;
                        z = __builtin_amdgcn_mfma_f32_16x16x32_bf16(ka, bvt, z, 0, 0, 0);
                        z = __builtin_amdgcn_mfma_f32_16x16x32_bf16(__builtin_bit_cast(bf16x8, bw), bu, z, 0, 0, 0);
                        Z[kt] = z;
                    }
                }
            }
        __syncthreads();
        if (!isctx) { const int s2 = tid >> 4, part = tid & 15; const int tk = d == 0 ? tlo + s2 : tlo + 31 - s2;
            *(f32x4*)(yscr + ((size_t)(b * T + tk)) * D + d * 512 + h * 64 + part * 4) = *(const LAS f32x4*)(lds + GS_YS + (s2 * 64 + part * 4) * 4); }
        if (tile + 1 < t1) {
#pragma unroll
            for (int i = 0; i < 4; ++i) *(LAS v4u*)(lds + ((tile + 1 - t0) & 1) * BL_BYTES + (tid + 512 * i) * 16) = bg[i]; }
        __syncthreads();
    }
}
template <int LEVEL> __device__ __forceinline__ void p3_scan(Frame& F, const XcdBarrier& bar) {
    const bf16* proj = (const bf16*)(F.ws + WS_PROJ);
    const bool state_role = F.bid < 64;
    f32x4 Z[4];
#pragma unroll
    for (int kt = 0; kt < 4; ++kt) Z[kt] = (f32x4){0.f, 0.f, 0.f, 0.f};
    for (int step = 0; step <= SC_NROUND; ++step) {
        if (step >= 1 && state_role) {
            const int r = step - 1, t0 = r * SC_RT, t1 = (t0 + SC_RT < SC_NTILE) ? t0 + SC_RT : SC_NTILE;
            scan_state_round(F, F.bid, t0, t1, F.ws + ((r & 1) ? WS_BLOB1 : WS_BLOB0) + (size_t)F.bid * SC_RT * BL_BYTES, Z);
        }
        const bool prep_here = step < SC_NROUND && (step == 0 || !state_role);
        if (prep_here) {
            const int t0 = step * SC_RT, nt = (t0 + SC_RT < SC_NTILE) ? SC_RT : SC_NTILE - t0, ntask = 64 * nt;
            const int P = step == 0 ? F.G : F.G - 64, p = step == 0 ? F.bid : F.bid - 64;
            const int k0 = (int)((long)ntask * p / P), k1 = (int)((long)ntask * (p + 1) / P);
            unsigned char* base = F.ws + ((step & 1) ? WS_BLOB1 : WS_BLOB0);
            v4u rg[3];
            if (k0 < k1) scan_issue_loads(proj, (k0 / nt) >> 4, ((k0 / nt) >> 1) & 7, (k0 / nt) & 1, t0 + k0 % nt, F.tid, rg);
            int prev_chain = -1;
            for (int k = k0; k < k1; ++k) {
                const int chain = k / nt, tl = k % nt, kn = k + 1, nchain = kn / nt, ntl = kn % nt;
                scan_prep_task(F, proj, chain, t0 + tl, chain != prev_chain, kn < k1, nchain, t0 + ntl, rg, base + ((size_t)chain * SC_RT + tl) * BL_BYTES);
                prev_chain = chain;
            }
        }
        if (step < SC_NROUND) xcd_barrier(bar);
    }
}
__device__ __forceinline__ void p4_mix(Frame& F) {
    LAS unsigned char* lds = F.lds; const int tid = F.tid;
    const bf16* proj = (const bf16*)(F.ws + WS_PROJ); bf16* cat = (bf16*)(F.ws + WS_HX); const float* yscr = F.out;
    LAS float* SG = (LAS float*)lds;
    LAS bf16* GT = (LAS bf16*)(lds + 32768);
    for (int unit = F.bid; unit < MX / 64; unit += F.G) {
        const size_t row0 = (size_t)unit * 64; const int tb0 = (unit * 64) & (T - 1);
        __syncthreads();
#pragma unroll
        for (int i = 0; i < 2; ++i) { const int ck = tid + 512 * i, tok = ck >> 4, j0 = (ck & 15) * 8;
            const v4u w = *(const v4u*)(proj + (row0 + tok) * NPROJ + COL_G + j0);
            SG[(j0 + 0) * 64 + tok] = sigmoidf(bf_lo(w.x)); SG[(j0 + 1) * 64 + tok] = sigmoidf(bf_hi(w.x)); SG[(j0 + 2) * 64 + tok] = sigmoidf(bf_lo(w.y)); SG[(j0 + 3) * 64 + tok] = sigmoidf(bf_hi(w.y));
            SG[(j0 + 4) * 64 + tok] = sigmoidf(bf_lo(w.z)); SG[(j0 + 5) * 64 + tok] = sigmoidf(bf_hi(w.z)); SG[(j0 + 6) * 64 + tok] = sigmoidf(bf_lo(w.w)); SG[(j0 + 7) * 64 + tok] = sigmoidf(bf_hi(w.w)); }
        __syncthreads();
        { float acc[64];
#pragma unroll
          for (int i = 0; i < 64; ++i) acc[i] = 0.f;
          const float* gw = F.in[I_GW2] + tid;
#pragma unroll 2
          for (int j = 0; j < 128; ++j) { const float wv = gw[j * 512];
#pragma unroll
              for (int tq = 0; tq < 16; ++tq) { const f32x4 s4 = *(const LAS f32x4*)(SG + j * 64 + tq * 4);
                  acc[4 * tq] += s4.x * wv; acc[4 * tq + 1] += s4.y * wv; acc[4 * tq + 2] += s4.z * wv; acc[4 * tq + 3] += s4.w * wv; } }
#pragma unroll
          for (int i = 0; i < 64; ++i) GT[i * 512 + tid] = (bf16)(pk2(acc[i], 0.f) & 0xffffu); }
        __syncthreads();
        if (tid < 256) {
            const int c = 2 * tid; const float* cw = F.in[I_CONVW];
            const f32x2 w0 = *(const f32x2*)(cw + c), w1 = *(const f32x2*)(cw + 512 + c), w2 = *(const f32x2*)(cw + 1024 + c);
            const bf16* pr = proj + row0 * NPROJ + c;
            f32x2 zp = (f32x2){0.f, 0.f}, zc, zn;
            { const unsigned g = *(const unsigned*)(pr + COL_XG), x = *(const unsigned*)(pr + COL_XC); zc = (f32x2){bf_lo(g) * bf_lo(x), bf_hi(g) * bf_hi(x)}; }
            for (int t = 0; t < 64; ++t) {
                if (t < 63) { const unsigned g = *(const unsigned*)(pr + (size_t)(t + 1) * NPROJ + COL_XG), x = *(const unsigned*)(pr + (size_t)(t + 1) * NPROJ + COL_XC); zn = (f32x2){bf_lo(g) * bf_lo(x), bf_hi(g) * bf_hi(x)}; }
                else zn = (f32x2){0.f, 0.f};
                const unsigned xb = *(const unsigned*)(pr + (size_t)t * NPROJ + COL_XB);
                const f32x2 z = w0 * zp + w1 * zc + w2 * zn;
                *(unsigned*)(cat + (row0 + t) * D + c) = pk2(bf_lo(xb) * z.x, bf_hi(xb) * z.y);
                zp = zc; zc = zn;
            }
        } else {
            const int ri = tid - 256, c = 2 * ri, h = ri >> 5;
            const f32x2 mpr = *(const f32x2*)(F.in[I_TMU] + 0 * 512 + c), mpk = *(const f32x2*)(F.in[I_TMU] + 1 * 512 + c), mpv = *(const f32x2*)(F.in[I_TMU] + 2 * 512 + c);
            const f32x2 mnr = *(const f32x2*)(F.in[I_TMU] + 3 * 512 + c), mnk = *(const f32x2*)(F.in[I_TMU] + 4 * 512 + c), mnv = *(const f32x2*)(F.in[I_TMU] + 5 * 512 + c);
            const f32x2 rk = *(const f32x2*)(F.in[I_RK] + c), lg = *(const f32x2*)(F.in[I_LNG] + c), lb = *(const f32x2*)(F.in[I_LNB] + c);
            const bf16* pr = proj + row0 * NPROJ + c;
            f32x2 rp, kp, vp, rc, kc, vc, rn, kn, vn;
#define LD2(dst, ptr) do { const unsigned _w = *(const unsigned*)(ptr); dst = (f32x2){bf_lo(_w), bf_hi(_w)}; } while (0)
            if (tb0 > 0) { LD2(rp, pr - NPROJ + COL_R); LD2(kp, pr - NPROJ + COL_K); LD2(vp, pr - NPROJ + COL_V); } else { rp = kp = vp = (f32x2){0.f, 0.f}; }
            LD2(rc, pr + COL_R); LD2(kc, pr + COL_K); LD2(vc, pr + COL_V);
            for (int t = 0; t < 64; ++t) {
                if (tb0 + t + 1 < T) { const bf16* pn = pr + (size_t)(t + 1) * NPROJ; LD2(rn, pn + COL_R); LD2(kn, pn + COL_K); LD2(vn, pn + COL_V); } else { rn = kn = vn = (f32x2){0.f, 0.f}; }
                const f32x2 rs = rc + mpr * (rp - rc) + mnr * (rn - rc), ks = kc + mpk * (kp - kc) + mnk * (kn - kc), vs = vc + mpv * (vp - vc) + mnv * (vn - vc);
                const float* yr = yscr + (row0 + t) * D + c;
                const f32x2 y = *(const f32x2*)yr + *(const f32x2*)(yr + 512);
                const float mu = half_sum32(y.x + y.y) * (1.f / 64.f);
                const f32x2 yc = y - mu;
                const float var = half_sum32(yc.x * yc.x + yc.y * yc.y) * (1.f / 64.f);
                const float bon = half_sum32(rs.x * ks.x * rk.x + rs.y * ks.y * rk.y);
                const f32x2 yn = yc * __builtin_amdgcn_rsqf(var + LNX_EPS) * lg + lb + bon * vs;
                const unsigned gt = *(const LAS unsigned*)(GT + t * 512 + c);
                *(unsigned*)(cat + (row0 + t) * D + 512 + c) = pk2(yn.x * bf_lo(gt), yn.y * bf_hi(gt));
                rp = rc; kp = kc; vp = vc; rc = rn; kc = kn; vc = vn;
            }
#undef LD2
        }
    }
}

__device__ __forceinline__ void p6_mid(Frame& F) {
    const float* mod = (const float*)(F.ws + WS_MOD); const float* ng = F.in[I_NG];
    const float* yx = (const float*)(F.ws + WS_PROJ); bf16* hx2 = (bf16*)(F.ws + WS_HX);
    for (int m = F.bid * NWAVES + F.wave; m < MX; m += F.G * NWAVES) {
        const float* mr = mod + (m >> 12) * NMOD;
        f32x4 v[4], xv[4]; float ss = 0.f;
#pragma unroll
        for (int j = 0; j < 4; ++j) { v[j] = *(const f32x4*)(yx + (size_t)m * D + j * 256 + F.lane * 4); xv[j] = *(const f32x4*)(F.in[I_X] + (size_t)m * D + j * 256 + F.lane * 4);
            ss += v[j].x * v[j].x + v[j].y * v[j].y + v[j].z * v[j].z + v[j].w * v[j].w; }
        const float rstd = __builtin_amdgcn_rsqf(wave_sum(ss) * (1.f / D) + NORM_EPS);
        float ss2 = 0.f;
#pragma unroll
        for (int j = 0; j < 4; ++j) { const int c = j * 256 + F.lane * 4;
            const f32x4 g1 = *(const f32x4*)(ng + D + c), gt = *(const f32x4*)(mr + 2 * D + c);
            xv[j] = xv[j] + gt * (v[j] * rstd * g1);
            *(f32x4*)(F.out + (size_t)m * D + c) = xv[j];
            ss2 += xv[j].x * xv[j].x + xv[j].y * xv[j].y + xv[j].z * xv[j].z + xv[j].w * xv[j].w; }
        const float rstd2 = __builtin_amdgcn_rsqf(wave_sum(ss2) * (1.f / D) + NORM_EPS);
#pragma unroll
        for (int j = 0; j < 4; ++j) { const int c = j * 256 + F.lane * 4;
            const f32x4 g2 = *(const f32x4*)(ng + 2 * D + c), sh = *(const f32x4*)(mr + 3 * D + c), sc = *(const f32x4*)(mr + 4 * D + c);
            const f32x4 o = xv[j] * rstd2 * g2 * (1.f + sc) + sh;
            *(v2u*)(hx2 + (size_t)m * D + c) = (v2u){pk2(o.x, o.y), pk2(o.z, o.w)}; }
    }
}
__device__ __forceinline__ float gelu_erf(float x) { return 0.5f * x * (1.f + erff(x * 0.70710678118f)); }
__device__ __forceinline__ float dot2bf(unsigned a, unsigned b, float c) {
    typedef __bf16 bf2 __attribute__((ext_vector_type(2)));
    return __builtin_amdgcn_fdot2_f32_bf16(__builtin_bit_cast(bf2, a), __builtin_bit_cast(bf2, b), c, false);
}
__device__ __forceinline__ unsigned uminu(unsigned a, unsigned b) { return a < b ? a : b; }
__device__ __forceinline__ void ce_desc(unsigned& x, unsigned& y) { const unsigned hi = umaxu(x, y), lo = uminu(x, y); x = hi; y = lo; }
template <int N> __device__ __forceinline__ void bitonic_sort_desc(unsigned (&a)[N]) {
#pragma unroll
    for (int k = 2; k <= N; k <<= 1)
#pragma unroll
        for (int j = k >> 1; j > 0; j >>= 1)
#pragma unroll
            for (int i = 0; i < N; ++i) { const int l = i ^ j; if (l > i) { if ((i & k) == 0) ce_desc(a[i], a[l]); else ce_desc(a[l], a[i]); } }
}
template <int N> __device__ __forceinline__ void bitonic_merge_desc(unsigned (&a)[N]) {
#pragma unroll
    for (int j = N >> 1; j > 0; j >>= 1)
#pragma unroll
        for (int i = 0; i < N; ++i) { const int l = i ^ j; if (l > i) ce_desc(a[i], a[l]); }
}
__device__ __forceinline__ void p8a_route(Frame& F) {
    const int lane = F.lane, wave = F.wave, part = lane & 3, L = lane >> 2, side = L & 1;
    LAS unsigned char* WL = F.lds + 1024 + wave * 1024;
    LAS unsigned char* TAB = F.lds;
    const float* scores = (const float*)(F.ws + WS_PROJ);
    unsigned short* exl = (unsigned short*)(F.ws + WS_EXL); float* gl = (float*)(F.ws + WS_GL);
    __syncthreads();
    if (F.tid < 64) { int l = F.tid, i = 0; for (; i < 16; ++i) { const int n = 16 / (i + 1); if (l < n) break; l -= n; } TAB[F.tid] = (unsigned char)(i < 16 ? i * 16 + l : 0); }
    __syncthreads();
    for (int m = F.bid * NWAVES + wave; m < MX; m += F.G * NWAVES) {
        const float* lp = scores + (size_t)m * NSC + L * 128 + part * 32;
        unsigned lo16[16], hi16[16];
#pragma unroll
        for (int q = 0; q < 4; ++q) { const f32x4 v = *(const f32x4*)(lp + 4 * q), w = *(const f32x4*)(lp + 16 + 4 * q);
#pragma unroll
            for (int e = 0; e < 4; ++e) { lo16[4 * q + e] = (f2key(v[e]) & ~127u) | (unsigned)(127 - part * 32 - (4 * q + e)); hi16[4 * q + e] = (f2key(w[e]) & ~127u) | (unsigned)(127 - part * 32 - 16 - (4 * q + e)); } }
        bitonic_sort_desc<16>(lo16); bitonic_sort_desc<16>(hi16);
        unsigned r[16];
#pragma unroll
        for (int i = 0; i < 16; ++i) r[i] = umaxu(lo16[i], hi16[15 - i]);
        bitonic_merge_desc<16>(r);
        { unsigned c[16];
#pragma unroll
          for (int i = 0; i < 16; ++i) c[i] = umaxu(r[i], dppu<0xB1>(r[15 - i]));
          bitonic_merge_desc<16>(c);
#pragma unroll
          for (int i = 0; i < 16; ++i) r[i] = umaxu(c[i], dppu<0x4E>(c[15 - i]));
          bitonic_merge_desc<16>(r); }
        if (part == 0) {
#pragma unroll
            for (int i = 0; i < 16; ++i) WL[L * 16 + i] = (unsigned char)(127u - (r[i] & 127u)); }
        float fa[16], fb[16];
#pragma unroll
        for (int i = 0; i < 16; ++i) { const unsigned up = dppu<0x104>(r[i]), dn = dppu<0x114>(r[i]);
            const unsigned av = side ? dn : r[i], bv = side ? r[i] : up; fa[i] = key2f(av & ~127u); fb[i] = key2f(bv & ~127u); }
        unsigned R[16];
#pragma unroll
        for (int j = 0; j < 16; ++j) R[j] = (f2key(fa[0] + fb[j]) & ~63u) | (unsigned)(63 - j);
        { int code = 16;
#pragma unroll
          for (int i = 1; i < 16; ++i) {
#pragma unroll
              for (int j = 0; j < 16; ++j) { if ((i + 1) * (j + 1) <= 16) {
                  const unsigned x = (f2key(fa[i] + fb[j]) & ~63u) | (unsigned)(63 - code); const int p0 = (i + 1) * (j + 1) - 1;
#pragma unroll
                  for (int p = 15; p > p0; --p) R[p] = umaxu(R[p], uminu(R[p - 1], x));
                  R[p0] = umaxu(R[p0], x); ++code; } } } }
        if ((lane & 7) == 0) {
#pragma unroll
            for (int k = 0; k < 16; ++k) *(LAS unsigned*)(WL + 256 + ((lane >> 3) * 16 + k) * 4) = R[k]; }
        LDS_WAIT();
#pragma unroll
        for (int half = 0; half < 2; ++half) { const int e = lane + 64 * half, hd = e >> 4;
            const unsigned rk = *(const LAS unsigned*)(WL + 256 + e * 4); const int ij = TAB[63 - (int)(rk & 63u)];
            const int idx0 = WL[(2 * hd) * 16 + (ij >> 4)], idx1 = WL[(2 * hd + 1) * 16 + (ij & 15)];
            const float scv = key2f(rk & ~63u);
            float mx = scv; mx = fmaxf(mx, dppf<0xB1>(mx)); mx = fmaxf(mx, dppf<0x4E>(mx)); mx = fmaxf(mx, dppf<0x141>(mx)); mx = fmaxf(mx, dppf<0x140>(mx));
            const float ev = fast_exp(scv - mx); const float den = rowsum16(ev);
            exl[(size_t)m * 128 + e] = (unsigned short)(idx0 * 128 + idx1); gl[(size_t)m * 128 + e] = ev * fast_rcp(den); }
        LDS_WAIT();
    }
}
__device__ __forceinline__ void p9_upass(Frame& F) {
    const int lane = F.lane, wave = F.wave, x = F.bid & 7, r = F.bid >> 3, nr = F.G >> 3, g = lane >> 3, q = lane & 7;
    LAS unsigned short* EXW = (LAS unsigned short*)(F.lds + wave * 256);
    const unsigned* exl32 = (const unsigned*)(F.ws + WS_EXL); const bf16* hx2 = (const bf16*)(F.ws + WS_HX);
    const unsigned char* U = F.ws + WS_U + 128 * x + 16 * q; float* part = (float*)(F.ws + WS_PART) + (size_t)x * MX * 128;
    for (int m = r + nr * wave; m < MX; m += nr * NWAVES) {
        *(LAS unsigned*)(EXW + 2 * lane) = exl32[(size_t)m * 64 + lane];
        const v4u h0 = *(const v4u*)(hx2 + (size_t)m * D + 128 * x + 16 * q), h1 = *(const v4u*)(hx2 + (size_t)m * D + 128 * x + 16 * q + 8);
        float hf[16];
        hf[0] = bf_lo(h0.x); hf[1] = bf_hi(h0.x); hf[2] = bf_lo(h0.y); hf[3] = bf_hi(h0.y); hf[4] = bf_lo(h0.z); hf[5] = bf_hi(h0.z); hf[6] = bf_lo(h0.w); hf[7] = bf_hi(h0.w);
        hf[8] = bf_lo(h1.x); hf[9] = bf_hi(h1.x); hf[10] = bf_lo(h1.y); hf[11] = bf_hi(h1.y); hf[12] = bf_lo(h1.z); hf[13] = bf_hi(h1.z); hf[14] = bf_lo(h1.w); hf[15] = bf_hi(h1.w);
        LDS_WAIT();
        float keep[2];
#pragma unroll
        for (int j = 0; j < 2; ++j) {
            float kp = 0.f;
            v4u uu[8];
#pragma unroll
            for (int i = 0; i < 8; ++i) { const unsigned ex = EXW[64 * j + 8 * i + g]; uu[i] = *(const v4u*)(U + (size_t)ex * 1024); }
#pragma unroll
            for (int i = 0; i < 8; ++i) { float p = 0.f;
#pragma unroll
                for (int w = 0; w < 4; ++w) { const f32x2 lo = __builtin_amdgcn_cvt_pk_f32_fp8((int)uu[i][w], false), hi = __builtin_amdgcn_cvt_pk_f32_fp8((int)uu[i][w], true);
                    p += lo.x * hf[4 * w] + lo.y * hf[4 * w + 1] + hi.x * hf[4 * w + 2] + hi.y * hf[4 * w + 3]; }
                p += dppf<0xB1>(p); p += dppf<0x4E>(p); p += dppf<0x141>(p);
                kp = (q == i) ? p : kp; }
            keep[j] = kp * (1.f / 32.f);
        }
        part[(size_t)m * 128 + 8 * q + g] = keep[0]; part[(size_t)m * 128 + 64 + 8 * q + g] = keep[1];
        LDS_WAIT();
    }
}
__device__ __forceinline__ void p10_combine(Frame& F) {
    const float* __restrict__ part = (const float*)(F.ws + WS_PART); const float* __restrict__ gl = (const float*)(F.ws + WS_GL);
    const unsigned short* __restrict__ exl = (const unsigned short*)(F.ws + WS_EXL); unsigned* __restrict__ plt = (unsigned*)(F.ws + WS_PL);
    LAS unsigned* TL = (LAS unsigned*)F.lds;
    for (int unit = F.bid; unit < MX / 64; unit += F.G) {
        const int m0 = unit * 64;
        __syncthreads();
#pragma unroll 4
        for (int i = 0; i < 16; ++i) { const int idx = F.tid + 512 * i, ml = idx >> 7, k = idx & 127; const size_t gi = (size_t)(m0 + ml) * 128 + k;
            float s = part[gi];
#pragma unroll
            for (int x = 1; x < 8; ++x) s += part[(size_t)x * MX * 128 + gi];
            TL[k * 65 + ml] = (unsigned)exl[gi] | ((unsigned)__builtin_bit_cast(unsigned short, (_Float16)(gl[gi] * gelu_erf(s))) << 16); }
        __syncthreads();
#pragma unroll 4
        for (int i = 0; i < 16; ++i) { const int idx = F.tid + 512 * i, k = idx >> 6, ml = idx & 63; plt[(size_t)k * MX + m0 + ml] = TL[k * 65 + ml]; }
    }
}
typedef _Float16 h2_t __attribute__((ext_vector_type(2)));
typedef _Float16 h4_t __attribute__((ext_vector_type(4)));
template <int MODE> __device__ __forceinline__ void p11_vpass(Frame& F) {
    const int lane = F.lane, wave = F.wave;
    const unsigned* __restrict__ plt = (const unsigned*)(F.ws + WS_PL); float* __restrict__ po = (float*)(F.ws + WS_PO);
    for (int cg = F.bid; cg < 256; cg += F.G) {
        const int c0 = 128 * (cg & 7) + 4 * (cg >> 3);
        __syncthreads();
        for (int e = F.tid; e < NEXP; e += 512) { const f32x4 vv = *(const f32x4*)(F.in[I_PV] + (size_t)e * D + c0);
            const h2_t a = {(_Float16)vv.x, (_Float16)vv.y}, b = {(_Float16)vv.z, (_Float16)vv.w};
            *(LAS v2u*)(F.lds + e * 8) = (v2u){__builtin_bit_cast(unsigned, a), __builtin_bit_cast(unsigned, b)}; }
        __syncthreads();
        for (int mg = wave; mg < MX / 64; mg += NWAVES) {
            const unsigned* __restrict__ pg = plt + mg * 64;
            f32x4 acc = (f32x4){0.f, 0.f, 0.f, 0.f};
#pragma unroll 2
            for (int k0 = 0; k0 < 128; k0 += 8) {
                unsigned p[8];
#pragma unroll
                for (int i = 0; i < 8; ++i) p[i] = pg[(size_t)(k0 + i) * MX + lane];
                h2_t a01 = {(_Float16)0.f, (_Float16)0.f}, a23 = a01;
#pragma unroll
                for (int i = 0; i < 8; ++i) { const h4_t hv = *(const LAS h4_t*)(unsigned)((p[i] & 0xffffu) << 3);
                    const _Float16 cf = __builtin_bit_cast(_Float16, (unsigned short)(p[i] >> 16)); const h2_t c2 = {cf, cf};
                    a01 = __builtin_shufflevector(hv, hv, 0, 1) * c2 + a01; a23 = __builtin_shufflevector(hv, hv, 2, 3) * c2 + a23; }
                acc.x += (float)a01.x; acc.y += (float)a01.y; acc.z += (float)a23.x; acc.w += (float)a23.y;
            }
            *(f32x4*)(po + (size_t)(mg * 64 + lane) * D + c0) = acc;
        }
    }
}
__device__ __forceinline__ void p12_final(Frame& F) {
    const float* mod = (const float*)(F.ws + WS_MOD); const float* ng3 = F.in[I_NG] + 3 * D; const float* po = (const float*)(F.ws + WS_PO);
    for (int m = F.bid * NWAVES + F.wave; m < MX; m += F.G * NWAVES) {
        const float* gt2 = mod + (m >> 12) * NMOD + 5 * D;
        f32x4 v[4]; float ss = 0.f;
#pragma unroll
        for (int j = 0; j < 4; ++j) { v[j] = *(const f32x4*)(po + (size_t)m * D + j * 256 + F.lane * 4); ss += v[j].x * v[j].x + v[j].y * v[j].y + v[j].z * v[j].z + v[j].w * v[j].w; }
        const float rstd = __builtin_amdgcn_rsqf(wave_sum(ss) * (1.f / D) + NORM_EPS);
#pragma unroll
        for (int j = 0; j < 4; ++j) { const int c = j * 256 + F.lane * 4; float* op = F.out + (size_t)m * D + c;
            const f32x4 x1 = *(const f32x4*)op, g = *(const f32x4*)(ng3 + c), gt = *(const f32x4*)(gt2 + c);
            *(f32x4*)op = x1 + gt * (v[j] * rstd * g); }
    }
}
struct Args { const float* in[25]; float* out; unsigned char* ws; int ph_lo, ph_hi; };
__global__ void __launch_bounds__(NWAVES * 64, 2) mk_fwd(Args args) {
    extern __shared__ __attribute__((aligned(16))) unsigned char lds_raw[];
    Frame F;
    F.lds = (LAS unsigned char*)lds_raw;
    F.MISC = (volatile LAS unsigned*)(F.lds + MISC_OFF);
    F.tid = threadIdx.x; F.lane = F.tid & 63; F.wave = __builtin_amdgcn_readfirstlane(F.tid >> 6);
    F.G = gridDim.x; F.bid = blockIdx.x;
#pragma unroll
    for (int i = 0; i < 25; ++i) F.in[i] = args.in[i];
    F.out = args.out; F.ws = args.ws; F.ctl = (gu32*)(args.ws + WS_CTL);
    for (int u = F.tid; u < (LDS_BYTES - LDSCTL_OFF) / 4; u += NWAVES * 64) ((LAS unsigned*)(F.lds + LDSCTL_OFF))[u] = 0u;
    __syncthreads();
    const int lo = args.ph_lo, hi = args.ph_hi;
    XcdBarrier bar; bar.bar = (unsigned*)(F.ctl + CW_BAR); bar.x = 0; bar.st = nullptr;
    if (hi - lo > 1) bar = xcd_barrier_post((unsigned*)(F.ctl + CW_BAR), F.MISC + 8);
#ifndef PROBE_LO
#define PROBE_LO -1
#define PROBE_HI -1
#endif
#define IN(k) (lo <= (k) && (k) < hi)
#define SEAM(k) do { if (IN(k) && IN((k) + 1)) xcd_barrier(bar); } while (0)
#define PH0 { p0_prep(F); }
#define PH1 { p1_hx(F); }
#define PH2 { pg8::Gemm g{(const pg8::bf16_t*)(F.ws + WS_HX), (const pg8::bf16_t*)(F.ws + WS_WINT), MA, NPROJ_PAD, D}; pg8::StaticOrder S; S.init(MA, NPROJ_PAD, F.G, F.bid); \
        pg8::EpiProj E{(pg8::bf16_t*)(F.ws + WS_PROJ), NPROJ, NPROJ}; \
        pg8::gemm_phase<pg8::EpiProj, pg8::StaticOrder, PG8_ALIGN, PG8_SP2>(F.lds, g, S, E); }
#define PH3 { p3_scan<0>(F, bar); }
#define PH4 { p4_mix(F); }
#define PH5 { pg8::Gemm g{(const pg8::bf16_t*)(F.ws + WS_HX), (const pg8::bf16_t*)(F.ws + WS_WOUTT), MX, D, D}; pg8::StaticOrder S; S.init(MX, D, F.G, F.bid); \
        pg8::EpiF32 E{(float*)(F.ws + WS_PROJ), D}; \
        pg8::gemm_phase<pg8::EpiF32, pg8::StaticOrder, PG8_ALIGN, PG8_SP2>(F.lds, g, S, E); }
#define PH6 { p6_mid(F); }
#define PH7 { pg8::Gemm g{(const pg8::bf16_t*)(F.ws + WS_HX), (const pg8::bf16_t*)(F.ws + WS_WEFFT), MX, NSC, D}; pg8::StaticOrder S; S.init(MX, NSC, F.G, F.bid); \
        pg8::EpiF32 E{(float*)(F.ws + WS_PROJ), NSC}; \
        pg8::gemm_phase<pg8::EpiF32, pg8::StaticOrder, PG8_ALIGN, PG8_SP2>(F.lds, g, S, E); }
#define PH8 { p8a_route(F); }
#define PH9 { p9_upass(F); }
#define PH10 { p10_combine(F); }
#define PH11 { p11_vpass<0>(F); }
#define PH12 { p12_final(F); }
#define PRB(k, body) if constexpr (PROBE_LO <= (k) && (k) <= PROBE_HI) { xcd_barrier(bar); body }
    if (IN(0)) PH0 PRB(0, PH0) SEAM(0);
    if (IN(1)) PH1 PRB(1, PH1) SEAM(1);
    if (IN(2)) PH2 PRB(2, PH2) SEAM(2);
    if (IN(3)) PH3 PRB(3, PH3) SEAM(3);
    if (IN(4)) PH4 PRB(4, PH4) SEAM(4);
    if (IN(5)) PH5 PRB(5, PH5) SEAM(5);
    if (IN(6)) PH6 PRB(6, PH6) SEAM(6);
    if (IN(7)) PH7 PRB(7, PH7) SEAM(7);
    if (IN(8)) PH8 PRB(8, PH8) SEAM(8);
    if (IN(9)) PH9 PRB(9, PH9) SEAM(9);
    if (IN(10)) PH10 PRB(10, PH10) SEAM(10);
    if constexpr (PROBE_LO == 111) { p11_vpass<1>(F); xcd_barrier(bar); }
    if constexpr (PROBE_LO == 112) { p11_vpass<2>(F); xcd_barrier(bar); }
    if (IN(11)) PH11 PRB(11, PH11) SEAM(11);
    if (IN(12)) PH12
#undef IN
#undef SEAM
}

extern "C" void kernel_launch(void* const* d_in, const int* in_sizes, int n_in, void* d_out, int out_size, void* d_ws, size_t ws_size, hipStream_t stream) {
    static int grid = 0;
    if (grid == 0) {
        if (n_in != 25 || in_sizes[0] != MX * D || out_size != MX * D || ws_size < WS_END) { fprintf(stderr, "kernel_launch: unexpected problem (n_in %d, in0 %d, out %d, ws %zu); nothing launched\n", n_in, n_in > 0 ? in_sizes[0] : -1, out_size, ws_size); grid = -1; return; }
        int dev = 0, cus = 0, per_cu = 0;
        if (hipGetDevice(&dev) != hipSuccess || hipDeviceGetAttribute(&cus, hipDeviceAttributeMultiprocessorCount, dev) != hipSuccess) { fprintf(stderr, "kernel_launch: device query failed\n"); grid = -1; return; }
        if (hipFuncSetAttribute((const void*)mk_fwd, hipFuncAttributeMaxDynamicSharedMemorySize, LDS_BYTES) != hipSuccess) { fprintf(stderr, "kernel_launch: hipFuncSetAttribute failed\n"); grid = -1; return; }
        if (hipOccupancyMaxActiveBlocksPerMultiprocessor(&per_cu, (const void*)mk_fwd, NWAVES * 64, LDS_BYTES) != hipSuccess || per_cu < 1) fprintf(stderr, "kernel_launch: occupancy query reports %d workgroups per CU\n", per_cu);
        (void)hipGetLastError();
        grid = cus;
    }
    if (grid < 0) return;
    if (hipMemsetAsync((char*)d_ws + WS_CTL, 0, CTL_ZERO_BYTES, stream) != hipSuccess) { fprintf(stderr, "kernel_launch: memset failed\n"); return; }
    Args a{};
    for (int i = 0; i < 25; ++i) a.in[i] = (const float*)d_in[i];
    a.out = (float*)d_out; a.ws = (unsigned char*)d_ws;
    if (MK_N_LAUNCHES == 1) { a.ph_lo = 0; a.ph_hi = NPH; hipLaunchKernelGGL(mk_fwd, dim3(grid), dim3(NWAVES * 64), LDS_BYTES, stream, a); }
    else for (int p = 0; p < NPH; ++p) { a.ph_lo = p; a.ph_hi = p + 1; hipLaunchKernelGGL(mk_fwd, dim3(grid), dim3(NWAVES * 64), LDS_BYTES, stream, a); }
    const hipError_t le = hipPeekAtLastError();
    if (le != hipSuccess) fprintf(stderr, "kernel_launch: launch failed: %s\n", hipGetErrorName(le));
}
```

```cpp
#include <hip/hip_runtime.h>
#include <cstdio>
#include <cstdint>
namespace pg8 {
#define PG8_LAS __attribute__((address_space(3)))
typedef unsigned short bf16_t;
typedef short bf16x8 __attribute__((ext_vector_type(8)));
typedef float f32x4 __attribute__((ext_vector_type(4)));
typedef unsigned u32x4 __attribute__((ext_vector_type(4)));
constexpr int BM = 256, BK = 64, HALF = 128, HTB = HALF * BK * 2  , STAGE_BYTES = 8 * HTB, NXCD = 8, WGM = 8;

__host__ __device__ __forceinline__ int lds_byte(int r, int c) { const int st = (r >> 4) * 2 + (c >> 5), rr = r & 15, cc = c & 31, ob = rr * 64 + cc * 2; return st * 1024 + (ob ^ (((ob >> 9) & 1) << 5)); }
__host__ __device__ __forceinline__ void stage_rc(int b, int& R, int& C) { const int st = b / 1024, sb = b % 1024, swz = sb ^ (((sb >> 9) & 1) << 5); R = (st >> 1) * 16 + swz / 64; C = (st & 1) * 32 + (swz % 64) / 2; }
__host__ __device__ __forceinline__ int perm32(int rho) { const int n = rho >> 4, i = rho & 15; return 8 * (i >> 2) + 4 * n + (i & 3); }

struct Unit { int pm, pn; };
struct Gemm { const bf16_t* A; const bf16_t* Bt; int M, N, K; };

struct StaticOrder {
    int nM, nN, nwg, G, c;
    __host__ __device__ void init(int M, int N, int G_, int c_) { nM = M / BM; nN = N / BM; nwg = nM * nN; G = G_; c = c_; }
    __host__ __device__ bool next(int i, Unit& u) const {
        const long L = (long)i * G + c; if (L >= nwg) return false;
        int wgid = (int)L; { const int q = nwg / NXCD, r = nwg % NXCD, xcd = wgid % NXCD, off = wgid / NXCD; wgid = (xcd < r ? xcd * (q + 1) : r * (q + 1) + (xcd - r) * q) + off; }
        const int nig = WGM * nN, gid = wgid / nig, fm = gid * WGM, gsz = (nM - fm) < WGM ? (nM - fm) : WGM;
        u.pm = fm + ((wgid % nig) % gsz); u.pn = (wgid % nig) / gsz; return true;
    }
    __device__ __forceinline__ void a_ready(const Unit&) const {}
    __device__ __forceinline__ void done(const Unit&) const {}
};

__device__ __forceinline__ unsigned cvt_pk_bf16(float lo, float hi) { unsigned r; asm volatile("v_cvt_pk_bf16_f32 %0, %1, %2" : "=v"(r) : "v"(lo), "v"(hi)); return r; }
typedef float f32x2 __attribute__((ext_vector_type(2)));
__device__ __forceinline__ f32x2 gelu_pk(f32x2 v) {
    const f32x2 av = __builtin_elementwise_abs(v), d = av * 0.2316418882f + 1.0f;
    f32x2 t; t.x = __builtin_amdgcn_rcpf(d.x); t.y = __builtin_amdgcn_rcpf(d.y);
    f32x2 q = t * 0.5307027145f + (-0.7265760135f); q = q * t + 0.7107068705f; q = q * t + (-0.142248368f); q = q * t + 0.127414796f; q = q * t;
    const f32x2 s = (v * v) * (-0.72134752044f);
    f32x2 e; e.x = __builtin_amdgcn_exp2f(s.x); e.y = __builtin_amdgcn_exp2f(s.y);
    const f32x2 m = v * (q * e), r = v - m;
    f32x2 o; o.x = v.x < 0.f ? m.x : r.x; o.y = v.y < 0.f ? m.y : r.y; return o;
}

template <int ACT  > struct EpiBf16 {
    static constexpr bool PERM = true, AFTER_DRAIN = false; static_assert(ACT == 0 || ACT == 1, "EpiBf16: ACT is 0 (none) or 1 (gelu_pk)");
    bf16_t* O; int ldc; const float* bias; int split_cols; size_t split_stride; float scale0;
    __device__ __forceinline__ void operator()(const f32x4 (&acc)[2][2][4][2], const Unit& u, int wr, int wc, int fr, int fq) const {
        const int row0 = u.pm * BM + wr * 64 + fr; int colt = u.pn * BM; bf16_t* base = O;
        float sc = 1.f; if (split_cols) { const int t = colt / split_cols; base += (size_t)t * split_stride; colt -= t * split_cols; if (t == 0) sc = scale0; }
        const int col0 = colt + wc * 32 + 8 * fq, bcol0 = u.pn * BM + wc * 32 + 8 * fq;
        f32x4 bv[2][2];
#pragma unroll
        for (int bj = 0; bj < 2; ++bj)
#pragma unroll
            for (int n = 0; n < 2; ++n) bv[bj][n] = bias ? *(const f32x4*)(bias + bcol0 + bj * HALF + 4 * n) : (f32x4){0.f, 0.f, 0.f, 0.f};
#pragma unroll
        for (int ai = 0; ai < 2; ++ai)
#pragma unroll
            for (int m = 0; m < 4; ++m) { bf16_t* rowp = base + (size_t)(row0 + ai * HALF + m * 16) * ldc + col0;
#pragma unroll
                for (int bj = 0; bj < 2; ++bj) { f32x4 v0 = acc[ai][bj][m][0] + bv[bj][0], v1 = acc[ai][bj][m][1] + bv[bj][1];
                    if (ACT == 1) { f32x2 a = gelu_pk((f32x2){v0[0], v0[1]}), b = gelu_pk((f32x2){v0[2], v0[3]}), c = gelu_pk((f32x2){v1[0], v1[1]}), d = gelu_pk((f32x2){v1[2], v1[3]});
                        v0 = (f32x4){a.x, a.y, b.x, b.y}; v1 = (f32x4){c.x, c.y, d.x, d.y}; }
                    v0 = v0 * sc; v1 = v1 * sc; u32x4 w; w.x = cvt_pk_bf16(v0[0], v0[1]); w.y = cvt_pk_bf16(v0[2], v0[3]); w.z = cvt_pk_bf16(v1[0], v1[1]); w.w = cvt_pk_bf16(v1[2], v1[3]);
                    *(u32x4*)(rowp + bj * HALF) = w; } }
    }
};

struct EpiF32 {
    static constexpr bool PERM = false, AFTER_DRAIN = false;
    float* C; int ldc;
    __device__ __forceinline__ void operator()(const f32x4 (&acc)[2][2][4][2], const Unit& u, int wr, int wc, int fr, int fq) const {
        const int row0 = u.pm * BM + wr * 64 + fr, col0 = u.pn * BM + wc * 32 + 4 * fq;
#pragma unroll
        for (int ai = 0; ai < 2; ++ai)
#pragma unroll
            for (int m = 0; m < 4; ++m) { float* rowp = C + (size_t)(row0 + ai * HALF + m * 16) * ldc + col0;
#pragma unroll
                for (int bj = 0; bj < 2; ++bj)
#pragma unroll
                    for (int n = 0; n < 2; ++n) *(f32x4*)(rowp + bj * HALF + n * 16) = acc[ai][bj][m][n]; }
    }
};
struct EpiProj {
    static constexpr bool PERM = true, AFTER_DRAIN = false;
    bf16_t* O; int ldc; int ncols;
    __device__ __forceinline__ void operator()(const f32x4 (&acc)[2][2][4][2], const Unit& u, int wr, int wc, int fr, int fq) const {
        const int row0 = u.pm * BM + wr * 64 + fr; const int col0 = u.pn * BM + wc * 32 + 8 * fq;
#pragma unroll
        for (int ai = 0; ai < 2; ++ai)
#pragma unroll
            for (int m = 0; m < 4; ++m) { bf16_t* rowp = O + (size_t)(row0 + ai * HALF + m * 16) * ldc + col0;
#pragma unroll
                for (int bj = 0; bj < 2; ++bj) { const f32x4 v0 = acc[ai][bj][m][0], v1 = acc[ai][bj][m][1];
                    u32x4 w; w.x = cvt_pk_bf16(v0[0], v0[1]); w.y = cvt_pk_bf16(v0[2], v0[3]); w.z = cvt_pk_bf16(v1[0], v1[1]); w.w = cvt_pk_bf16(v1[2], v1[3]);
                    if (col0 + bj * HALF < ncols) *(u32x4*)(rowp + bj * HALF) = w; } }
    }
};
template <class Epi, class Sched, bool ALIGN_EPI = false, bool SP2 = false>
__device__ __forceinline__ void gemm_phase(PG8_LAS unsigned char* lds, const Gemm g, const Sched& S, const Epi& E) {
    const int tid = threadIdx.x, wid = __builtin_amdgcn_readfirstlane(tid >> 6), lane = tid & 63, wr = wid >> 2, wc = wid & 3, fr = lane & 15, fq = lane >> 4;
    const int K = g.K, nt = K / BK;
    unsigned voffA[2], voffB[2];
#pragma unroll
    for (int i = 0; i < 2; ++i) { int R, C; stage_rc(tid * 16 + i * 8192, R, C); const int Rb = Epi::PERM ? ((R & ~31) + perm32(R & 31)) : R;
        voffA[i] = (unsigned)(R * K + C) * 2u; voffB[i] = (unsigned)(Rb * K + C) * 2u; }
    const size_t kstep = (size_t)(BK * 2);
    const size_t hstep = (size_t)HALF * K * 2;
    const size_t tstep = 2 * hstep;
    const unsigned ldsw = (unsigned)wid * 1024u;
    const int aoff = lds_byte(wr * 64 + fr, fq * 8), boff = lds_byte(wc * 32 + fr, fq * 8);
#define PG8_SA(b, h) (((b) * 2 + (h)) * HTB)
#define PG8_SB(b, h) ((4 + (b) * 2 + (h)) * HTB)
#define PG8_STAGE(bufoff, gbase, voff) do { _Pragma("unroll") for (int _i = 0; _i < 2; ++_i) \
        __builtin_amdgcn_global_load_lds((const unsigned*)((const char*)(gbase) + (voff)[_i]), (PG8_LAS unsigned*)(lds + (bufoff) + ldsw + _i * 8192), 16, 0, 0); } while (0)
#define PG8_LDA(dst, b, h) do { _Pragma("unroll") for (int m = 0; m < 4; ++m) _Pragma("unroll") for (int k = 0; k < 2; ++k) dst[m][k] = *(const PG8_LAS bf16x8*)(lds + PG8_SA(b, h) + aoff + m * 2048 + k * 1024); } while (0)
#define PG8_LDB(dst, b, h) do { _Pragma("unroll") for (int n = 0; n < 2; ++n) _Pragma("unroll") for (int k = 0; k < 2; ++k) dst[n][k] = *(const PG8_LAS bf16x8*)(lds + PG8_SB(b, h) + boff + n * 2048 + k * 1024); } while (0)
#define PG8_MMA(ai, bj, At, Bt) do { __builtin_amdgcn_s_setprio(1); _Pragma("unroll") for (int m = 0; m < 4; ++m) _Pragma("unroll") for (int n = 0; n < 2; ++n) _Pragma("unroll") for (int k = 0; k < 2; ++k) \
        acc[ai][bj][m][n] = __builtin_amdgcn_mfma_f32_16x16x32_bf16(Bt[n][k], At[m][k], acc[ai][bj][m][n], 0, 0, 0); __builtin_amdgcn_s_setprio(0); } while (0)
#define PG8_WAIT_V(n) asm volatile("s_waitcnt vmcnt(" #n ")" ::: "memory")
#define PG8_WAIT_L(n) asm volatile("s_waitcnt lgkmcnt(" #n ")" ::: "memory")
#define PG8_BAR __builtin_amdgcn_s_barrier()
#define PG8_SCHED __builtin_amdgcn_sched_barrier(0)
    Unit cur, nxt; int ui = 0;
    if (!S.next(0, cur)) return;
    f32x4 acc[2][2][4][2];
#pragma unroll
    for (int a = 0; a < 2; ++a)
#pragma unroll
        for (int b = 0; b < 2; ++b)
#pragma unroll
            for (int m = 0; m < 4; ++m)
#pragma unroll
                for (int n = 0; n < 2; ++n) acc[a][b][m][n] = (f32x4){0.f, 0.f, 0.f, 0.f};
    bf16x8 At[4][2], B0[2][2], B1[2][2];
    const char* cA = (const char*)g.A + (size_t)cur.pm * tstep; const char* cB = (const char*)g.Bt + (size_t)cur.pn * tstep;
    S.a_ready(cur);
    if constexpr (SP2) {
        PG8_STAGE(PG8_SB(0, 0), cB, voffB); PG8_STAGE(PG8_SB(0, 1), cB + hstep, voffB); PG8_STAGE(PG8_SA(0, 0), cA, voffA); PG8_STAGE(PG8_SA(0, 1), cA + hstep, voffA);
        if (wr == 1) PG8_BAR;
        PG8_WAIT_V(2); PG8_BAR;
        PG8_STAGE(PG8_SB(1, 0), cB + kstep, voffB); PG8_STAGE(PG8_SA(1, 0), cA + kstep, voffA); PG8_STAGE(PG8_SB(1, 1), cB + hstep + kstep, voffB);
        PG8_WAIT_V(6); PG8_BAR;
    } else {
        PG8_STAGE(PG8_SB(0, 0), cB, voffB); PG8_STAGE(PG8_SA(0, 0), cA, voffA); PG8_STAGE(PG8_SB(0, 1), cB + hstep, voffB); PG8_STAGE(PG8_SA(0, 1), cA + hstep, voffA);
        if (wr == 1) PG8_BAR;
        PG8_WAIT_V(4); PG8_BAR;
        PG8_STAGE(PG8_SB(1, 0), cB + kstep, voffB); PG8_STAGE(PG8_SA(1, 0), cA + kstep, voffA); PG8_STAGE(PG8_SB(1, 1), cB + hstep + kstep, voffB);
        PG8_WAIT_V(6); PG8_BAR;
    }
    for (;;) {
        const bool has_next = S.next(ui + 1, nxt);
        const char* nA = has_next ? (const char*)g.A + (size_t)nxt.pm * tstep : cA; const char* nB = has_next ? (const char*)g.Bt + (size_t)nxt.pn * tstep : cB;
        for (int t = 0; t < nt; t += 2) {
            const bool last = (t == nt - 2);
            const char* a1 = cA + (size_t)(t + 1) * kstep;
            const char* a2 = last ? nA : cA + (size_t)(t + 2) * kstep; const char* b2 = last ? nB : cB + (size_t)(t + 2) * kstep;
            const char* a3 = a2 + kstep; const char* b3 = b2 + kstep;
            if (last && has_next) S.a_ready(nxt);
            if constexpr (SP2) {
            PG8_LDB(B0, 0, 0); PG8_LDB(B1, 0, 1); PG8_SCHED; PG8_LDA(At, 0, 0); PG8_STAGE(PG8_SA(1, 1), a1 + hstep, voffA);
            PG8_WAIT_V(8); PG8_WAIT_L(0); PG8_BAR; PG8_MMA(0, 0, At, B0); PG8_MMA(0, 1, At, B1); PG8_BAR; PG8_SCHED;
            PG8_LDA(At, 0, 1); PG8_STAGE(PG8_SB(0, 0), b2, voffB); PG8_STAGE(PG8_SB(0, 1), b2 + hstep, voffB); PG8_STAGE(PG8_SA(0, 0), a2, voffA);
            PG8_WAIT_V(8); PG8_WAIT_L(0); PG8_BAR; PG8_MMA(1, 0, At, B0); PG8_MMA(1, 1, At, B1); PG8_BAR; PG8_SCHED;
            PG8_LDB(B0, 1, 0); PG8_LDB(B1, 1, 1); PG8_SCHED; PG8_LDA(At, 1, 0); PG8_STAGE(PG8_SA(0, 1), a2 + hstep, voffA);
            PG8_WAIT_V(8); PG8_WAIT_L(0); PG8_BAR; PG8_MMA(0, 0, At, B0); PG8_MMA(0, 1, At, B1); PG8_BAR; PG8_SCHED;
            PG8_LDA(At, 1, 1); PG8_STAGE(PG8_SB(1, 0), b3, voffB); PG8_STAGE(PG8_SB(1, 1), b3 + hstep, voffB); PG8_STAGE(PG8_SA(1, 0), a3, voffA);
            PG8_WAIT_V(8); PG8_WAIT_L(0); PG8_BAR; PG8_MMA(1, 0, At, B0); PG8_MMA(1, 1, At, B1); PG8_BAR; PG8_SCHED;
            } else {
            PG8_LDB(B0, 0, 0); PG8_SCHED; PG8_LDA(At, 0, 0); PG8_STAGE(PG8_SA(1, 1), a1 + hstep, voffA);
            PG8_WAIT_L(8); PG8_BAR; PG8_WAIT_L(0); PG8_MMA(0, 0, At, B0); PG8_BAR; PG8_SCHED;
            PG8_LDB(B1, 0, 1); PG8_STAGE(PG8_SB(0, 0), b2, voffB);
            PG8_BAR; PG8_WAIT_L(0); PG8_MMA(0, 1, At, B1); PG8_BAR;
            PG8_LDA(At, 0, 1); PG8_STAGE(PG8_SA(0, 0), a2, voffA);
            PG8_BAR; PG8_WAIT_L(0); PG8_MMA(1, 0, At, B0); PG8_BAR; PG8_SCHED;
            PG8_STAGE(PG8_SB(0, 1), b2 + hstep, voffB);
            PG8_WAIT_V(6); PG8_BAR; PG8_MMA(1, 1, At, B1); PG8_BAR;
            PG8_LDB(B0, 1, 0); PG8_SCHED; PG8_LDA(At, 1, 0); PG8_STAGE(PG8_SA(0, 1), a2 + hstep, voffA);
            PG8_WAIT_L(8); PG8_BAR; PG8_WAIT_L(0); PG8_MMA(0, 0, At, B0); PG8_BAR; PG8_SCHED;
            PG8_LDB(B1, 1, 1); PG8_STAGE(PG8_SB(1, 0), b3, voffB);
            PG8_BAR; PG8_WAIT_L(0); PG8_MMA(0, 1, At, B1); PG8_BAR;
            PG8_LDA(At, 1, 1); PG8_STAGE(PG8_SA(1, 0), a3, voffA);
            PG8_BAR; PG8_WAIT_L(0); PG8_MMA(1, 0, At, B0); PG8_BAR; PG8_SCHED;
            PG8_STAGE(PG8_SB(1, 1), b3 + hstep, voffB);
            PG8_WAIT_V(6); PG8_BAR; PG8_MMA(1, 1, At, B1); PG8_BAR;
            }
        }
        if constexpr (ALIGN_EPI) { if (wr == 0) PG8_BAR; }
        if constexpr (!Epi::AFTER_DRAIN) { E(acc, cur, wr, wc, fr, fq); S.done(cur); }
        if (!has_next) break;
#pragma unroll
        for (int a = 0; a < 2; ++a)
#pragma unroll
            for (int b = 0; b < 2; ++b)
#pragma unroll
                for (int m = 0; m < 4; ++m)
#pragma unroll
                    for (int n = 0; n < 2; ++n) acc[a][b][m][n] = (f32x4){0.f, 0.f, 0.f, 0.f};
        cur = nxt; cA = nA; cB = nB; ++ui;
        if constexpr (ALIGN_EPI) { if (wr == 1) PG8_BAR; }
    }
    PG8_WAIT_V(0);
    if constexpr (!ALIGN_EPI) { if (wr == 0) PG8_BAR; }
    PG8_BAR;
    if constexpr (Epi::AFTER_DRAIN) { E.fused(acc, cur, wr, wc, fr, fq, lds, wid, lane); S.done(cur); }
#undef PG8_SA
#undef PG8_SB
#undef PG8_STAGE
#undef PG8_LDA
#undef PG8_LDB
#undef PG8_MMA
#undef PG8_WAIT_V
#undef PG8_WAIT_L
#undef PG8_BAR
#undef PG8_SCHED
}
}
#ifndef PG8_SP2
#define PG8_SP2 true
#endif
#ifndef PG8_ALIGN
#define PG8_ALIGN true
#endif
constexpr int NWAVES = 8;
constexpr int D = 1024, NB = 4, T = 4096, TC = 256;
constexpr int MX = NB * T, MC = NB * TC, MA = MX + MC;
constexpr int NPROJ = 3456, NPROJ_PAD = 3584;
constexpr int COL_XB = 0, COL_XG = 512, COL_XC = 1024, COL_R = 1536, COL_K = 2048, COL_V = 2560, COL_G = 3072, COL_LW = 3200, COL_LA = 3328;
constexpr int NMOD = 6 * D;
constexpr int NEXP = 16384, NSC = 2048;
constexpr float NORM_EPS = 1e-6f, LNX_EPS = 64e-5f;
#ifndef MK_N_LAUNCHES
#define MK_N_LAUNCHES 1
#endif
constexpr int NPH = 13;
constexpr size_t MiB = 1u << 20;
constexpr size_t WS_CTL = 0, CTL_ZERO_BYTES = 64 * 1024;
constexpr size_t WS_MOD = 3 * MiB;
constexpr size_t WS_WINT = 6 * MiB;
constexpr size_t WS_WOUTT = 13 * MiB;
constexpr size_t WS_WEFFT = 15 * MiB;
constexpr size_t WS_GWT = 19 * MiB;
constexpr size_t WS_U = 20 * MiB, WS_V = 52 * MiB;
constexpr size_t WS_HX = 84 * MiB;
constexpr size_t WS_PROJ = 118 * MiB;
constexpr size_t WS_END = 246 * MiB;
constexpr size_t WS_EXL = WS_V, WS_GL = WS_V + 4 * MiB, WS_PL = WS_V + 12 * MiB;
constexpr size_t WS_BLOB0 = WS_V, WS_BLOB1 = WS_HX;
constexpr size_t WS_PART = WS_PROJ, WS_PO = WS_PROJ + 64 * MiB;
static_assert(WS_PROJ + (size_t)MA * NPROJ * 2 <= WS_END && WS_PROJ + (size_t)MX * NSC * 4 <= WS_END && WS_HX + (size_t)MA * D * 2 <= WS_PROJ, "d_ws map");
constexpr int CW_BAR = 1024;
constexpr int RING_BYTES = 131072;
constexpr int LDSCTL_OFF = RING_BYTES, MISC_OFF = LDSCTL_OFF + 320;
constexpr int LDS_BYTES = 147456;

#define GAS __attribute__((address_space(1)))
#define LAS __attribute__((address_space(3)))
typedef unsigned short bf16;
typedef unsigned v4u __attribute__((ext_vector_type(4)));
typedef unsigned v2u __attribute__((ext_vector_type(2)));
typedef float f32x4 __attribute__((ext_vector_type(4)));
typedef float f32x2 __attribute__((ext_vector_type(2)));
typedef float f32x16 __attribute__((ext_vector_type(16)));
typedef short bf16x8 __attribute__((ext_vector_type(8)));
typedef GAS unsigned gu32;
#define RLX_AGENT __ATOMIC_RELAXED, __HIP_MEMORY_SCOPE_AGENT
#define LDS_WAIT() asm volatile("s_waitcnt lgkmcnt(0)" ::: "memory")
#define VM_WAIT() asm volatile("s_waitcnt vmcnt(0)" ::: "memory")
typedef __bf16 bf16v2 __attribute__((ext_vector_type(2)));
__device__ __forceinline__ unsigned pk2(float lo, float hi) { const f32x2 v = {lo, hi}; return __builtin_bit_cast(unsigned, __builtin_convertvector(v, bf16v2)); }
__device__ __forceinline__ float bf_lo(unsigned w) { return __builtin_bit_cast(float, w << 16); }
__device__ __forceinline__ float bf_hi(unsigned w) { return __builtin_bit_cast(float, w & 0xffff0000u); }
__device__ __forceinline__ float bf1(bf16 b) { return __builtin_bit_cast(float, (unsigned)b << 16); }
__device__ __forceinline__ float fast_exp(float x) { return __builtin_amdgcn_exp2f(x * 1.44269504089f); }
__device__ __forceinline__ float fast_rcp(float x) { return __builtin_amdgcn_rcpf(x); }
__device__ __forceinline__ float sigmoidf(float x) { return fast_rcp(1.f + fast_exp(-x)); }
__device__ __forceinline__ float tanh_fast(float x) { return 1.f - 2.f * fast_rcp(fast_exp(2.f * x) + 1.f); }
__device__ __forceinline__ float siluf(float x) { return x * sigmoidf(x); }
template <int CTRL> __device__ __forceinline__ float dppf(float x) { return __builtin_bit_cast(float, __builtin_amdgcn_update_dpp(0, __builtin_bit_cast(int, x), CTRL, 0xF, 0xF, false)); }
template <int CTRL> __device__ __forceinline__ unsigned dppu(unsigned x) { return (unsigned)__builtin_amdgcn_update_dpp(0, (int)x, CTRL, 0xF, 0xF, false); }
__device__ __forceinline__ float rowsum16(float x) { x += dppf<0xB1>(x); x += dppf<0x4E>(x); x += dppf<0x141>(x); x += dppf<0x140>(x); return x; }
__device__ __forceinline__ float wave_sum(float v) {
    v = rowsum16(v); v += __shfl_xor(v, 16); v += __shfl_xor(v, 32); return v;
}
__device__ __forceinline__ float half_sum32(float v) { v = rowsum16(v); v += __shfl_xor(v, 16); return v; }
__device__ __forceinline__ unsigned umaxu(unsigned a, unsigned b) { return a > b ? a : b; }
__device__ __forceinline__ unsigned wave_max_u32(unsigned x) {
    x = umaxu(x, dppu<0xB1>(x)); x = umaxu(x, dppu<0x4E>(x)); x = umaxu(x, dppu<0x141>(x)); x = umaxu(x, dppu<0x140>(x));
    const unsigned a = __builtin_amdgcn_readlane((int)x, 0), b = __builtin_amdgcn_readlane((int)x, 16), c = __builtin_amdgcn_readlane((int)x, 32), d = __builtin_amdgcn_readlane((int)x, 48);
    return umaxu(umaxu(a, b), umaxu(c, d));
}
__device__ __forceinline__ unsigned f2key(float f) { const unsigned u = __builtin_bit_cast(unsigned, f); return (u & 0x80000000u) ? ~u : (u | 0x80000000u); }
__device__ __forceinline__ float key2f(unsigned k) { const unsigned u = (k & 0x80000000u) ? (k ^ 0x80000000u) : ~k; return __builtin_bit_cast(float, u); }
#define XB_TMO      128
#define XB_XCNT(j)  (256  + 64 * (j))
#define XB_XSUB(j)  (1280 + 64 * (j))
#define XB_XGEN(j)  (2304 + 64 * (j))
#define XB_TOP      3328
#define XB_TOPGEN   3392
#define XCD_BAR_WORDS 3456
#define XB_SPIN_CAP (1u << 18)

__device__ __forceinline__ unsigned xb_ld(unsigned* p)              { return __hip_atomic_load(p, __ATOMIC_RELAXED, __HIP_MEMORY_SCOPE_AGENT); }
__device__ __forceinline__ unsigned xb_add(unsigned* p, unsigned v) { return __hip_atomic_fetch_add(p, v, __ATOMIC_RELAXED, __HIP_MEMORY_SCOPE_AGENT); }
__device__ __forceinline__ unsigned xb_xcc_id() { return (unsigned)__builtin_amdgcn_s_getreg((3 << 11) | 20) & 0xFu; }
#define XB_SPIN(cond, bar) do { unsigned _sp = 0; while (cond) { __builtin_amdgcn_s_sleep(1); \
    if ((++_sp & 255u) == 0u) { if (xb_ld(&(bar)[XB_TMO])) break; if (_sp > XB_SPIN_CAP) { atomicAdd(&(bar)[XB_TMO], 1u); break; } } } } while (0)

struct XcdBarrier {
    unsigned* bar; unsigned x;
    volatile LAS unsigned* st;
};

__device__ __forceinline__ XcdBarrier xcd_barrier_post(unsigned* bar, volatile LAS unsigned* st) {
    XcdBarrier b; b.bar = bar; b.x = xb_xcc_id(); b.st = st;
    if (threadIdx.x == 0) (void)xb_add(&bar[XB_XCNT(b.x)], 1u);
    return b;
}
__device__ __forceinline__ void xcd_barrier_complete(unsigned* bar, unsigned x, unsigned& nloc, unsigned& nx) {
    const unsigned G = gridDim.x * gridDim.y * gridDim.z;
    unsigned sum, cnt, mine, sp = 0u;
    for (;;) {
        sum = 0u; cnt = 0u; mine = 0u;
#pragma unroll
        for (unsigned j = 0; j < 16; ++j) { const unsigned c = xb_ld(&bar[XB_XCNT(j)]); sum += c; cnt += (c > 0u) ? 1u : 0u; mine = (j == x) ? c : mine; }
        if (sum == G) break;
        __builtin_amdgcn_s_sleep(1);
        if ((++sp & 255u) == 0u) { if (xb_ld(&bar[XB_TMO])) break; if (sp > XB_SPIN_CAP) { atomicAdd(&bar[XB_TMO], 1u); break; } }
    }
    nloc = mine > 0u ? mine : 1u; nx = cnt > 0u ? cnt : 1u;
}

__device__ __forceinline__ void xcd_barrier(const XcdBarrier& b) {
    asm volatile("s_waitcnt vmcnt(0)" ::: "memory");
    __syncthreads();
    if (threadIdx.x == 0) {
        unsigned* bar = b.bar;
        __builtin_amdgcn_s_waitcnt(0);
        unsigned nloc = b.st[0], nx = b.st[1];
        if (nloc == 0u) { xcd_barrier_complete(bar, b.x, nloc, nx); b.st[0] = nloc; b.st[1] = nx; }
        const unsigned old = xb_add(&bar[XB_XSUB(b.x)], 1u);
        const unsigned gen = old / nloc;
        if (old + 1u == (gen + 1u) * nloc) {
            __builtin_amdgcn_fence(__ATOMIC_RELEASE, "agent");
            asm volatile("s_waitcnt vmcnt(0)" ::: "memory");
            const unsigned og = xb_add(&bar[XB_TOP], 1u);
            const unsigned tg = og / nx;
            if (og + 1u == (tg + 1u) * nx) xb_add(&bar[XB_TOPGEN], 1u);
            else XB_SPIN(xb_ld(&bar[XB_TOPGEN]) == tg, bar);
            __builtin_amdgcn_fence(__ATOMIC_ACQUIRE, "agent");
            xb_add(&bar[XB_XGEN(b.x)], 1u);
            asm volatile("s_waitcnt vmcnt(0)" ::: "memory");
        } else {
            XB_SPIN(xb_ld(&bar[XB_XGEN(b.x)]) == gen, bar);
            __builtin_amdgcn_fence(__ATOMIC_ACQUIRE, "agent");
            asm volatile("s_waitcnt vmcnt(0)" ::: "memory");
        }
    }
    __syncthreads();
}
struct Frame {
    LAS unsigned char* lds;
    volatile LAS unsigned* MISC;
    gu32* ctl;
    int tid, lane, wave, G, bid;
    const float* in[25];
    float* out;
    unsigned char* ws;
};
enum { I_X = 0, I_C, I_CTX, I_CCTX, I_WMOD, I_BMOD, I_NG, I_WIN, I_WOUT, I_CONVW, I_TMU, I_DW0, I_DW2, I_A0, I_A2, I_GW2, I_KK, I_KA, I_RK, I_LNG, I_LNB, I_WQ, I_SUBK, I_PU, I_PV };

__device__ __forceinline__ void p0_transpose_item(const float* W, int K, int N, bf16* WT, LAS float* scr, int item, int lane) {
    const int nblk = N / 32, kb = item / nblk, nb = item % nblk, k0 = 64 * kb, n0 = 32 * nb;
#pragma unroll 8
    for (int i = 0; i < 32; ++i) { const int kk = 2 * i + (lane >> 5); scr[kk * 33 + (lane & 31)] = W[(size_t)(k0 + kk) * N + n0 + (lane & 31)]; }
    LDS_WAIT(); asm volatile("" ::: "memory");
    const int c = lane & 7;
#pragma unroll
    for (int j = 0; j < 4; ++j) { const int n = (lane >> 3) + 8 * j; const LAS float* s = scr + (8 * c) * 33 + n;
        v4u o; o.x = pk2(s[0 * 33], s[1 * 33]); o.y = pk2(s[2 * 33], s[3 * 33]); o.z = pk2(s[4 * 33], s[5 * 33]); o.w = pk2(s[6 * 33], s[7 * 33]);
        *(v4u*)(WT + (size_t)(n0 + n) * K + k0 + 8 * c) = o; }
    LDS_WAIT(); asm volatile("" ::: "memory");
}
__device__ __forceinline__ void p0_mod_item(Frame& F, int cb) {
    LAS float* S = (LAS float*)F.lds;
    LAS float* RED = (LAS float*)(F.lds + 32768);
    const float* c = F.in[I_C]; const float* cc = F.in[I_CCTX];
    for (int i = F.tid; i < 5 * D; i += 512) { const int r = i >> 10, k = i & 1023; const float v = (r < 4) ? c[r * D + k] : cc[k]; S[i] = siluf(v); }
    __syncthreads();
    const int col = F.tid & 63, kg = F.tid >> 6;
    const float* wp = F.in[I_WMOD] + (size_t)(kg * 128) * NMOD + cb * 64 + col;
    float a0 = 0.f, a1 = 0.f, a2 = 0.f, a3 = 0.f, a4 = 0.f;
#pragma unroll 8
    for (int k = 0; k < 128; ++k) { const float w = wp[(size_t)k * NMOD]; const int kk = kg * 128 + k;
        a0 += S[kk] * w; a1 += S[D + kk] * w; a2 += S[2 * D + kk] * w; a3 += S[3 * D + kk] * w; a4 += S[4 * D + kk] * w; }
    RED[(kg * 5 + 0) * 64 + col] = a0; RED[(kg * 5 + 1) * 64 + col] = a1; RED[(kg * 5 + 2) * 64 + col] = a2; RED[(kg * 5 + 3) * 64 + col] = a3; RED[(kg * 5 + 4) * 64 + col] = a4;
    __syncthreads();
    if (F.tid < 320) { const int r = F.tid >> 6, cl = F.tid & 63; float s = F.in[I_BMOD][cb * 64 + cl];
#pragma unroll
        for (int g = 0; g < 8; ++g) s += RED[(g * 5 + r) * 64 + cl];
        ((float*)(F.ws + WS_MOD))[r * NMOD + cb * 64 + cl] = s; }
    __syncthreads();
}
__device__ __forceinline__ void p0_weff_item(Frame& F, int item) {
    const int hs = item >> 4, kb = item & 15;
    LAS float* SK = (LAS float*)F.lds;
    LAS float* WQ = (LAS float*)(F.lds + 128 * 132 * 4);
    const float* sk = F.in[I_SUBK] + (size_t)hs * 128 * 128;
    const float* wq = F.in[I_WQ] + (size_t)(kb * 64) * 2048 + hs * 128;
#pragma unroll
    for (int i = 0; i < 8; ++i) { const int idx = F.tid + 512 * i, row = idx >> 5, c4 = idx & 31; const f32x4 v = *(const f32x4*)(sk + row * 128 + c4 * 4); *(LAS f32x4*)(SK + row * 132 + c4 * 4) = v; }
#pragma unroll
    for (int i = 0; i < 4; ++i) { const int idx = F.tid + 512 * i, row = idx >> 5, c4 = idx & 31; const f32x4 v = *(const f32x4*)(wq + (size_t)row * 2048 + c4 * 4); *(LAS f32x4*)(WQ + row * 132 + c4 * 4) = v; }
    __syncthreads();
    const int key = F.tid >> 2, kq = F.tid & 3;
    float acc[16];
#pragma unroll
    for (int i = 0; i < 16; ++i) acc[i] = 0.f;
    for (int d = 0; d < 128; d += 4) {
        const f32x4 a = *(const LAS f32x4*)(SK + key * 132 + d);
#pragma unroll
        for (int i = 0; i < 16; ++i) { const f32x4 b = *(const LAS f32x4*)(WQ + (4 * i + kq) * 132 + d); acc[i] += a.x * b.x + a.y * b.y + a.z * b.z + a.w * b.w; }
    }
    bf16* dst = (bf16*)(F.ws + WS_WEFFT) + (size_t)(hs * 128 + key) * D + kb * 64;
#pragma unroll
    for (int i = 0; i < 16; ++i) dst[4 * i + kq] = (bf16)(pk2(acc[i], 0.f) & 0xffffu);
    __syncthreads();
}
__device__ __forceinline__ void p0_prep(Frame& F) {
    for (int it = F.bid; it < 96 + 256; it += F.G) { if (it < 96) p0_mod_item(F, it); else p0_weff_item(F, it - 96); }
    LAS float* scr = (LAS float*)(F.lds + F.wave * 16384);
    const int gw = F.bid * NWAVES + F.wave, NGW = F.G * NWAVES;
    constexpr int I_IN = (D / 64) * (NPROJ / 32), I_OUT = (D / 64) * (D / 32), I_GW = (128 / 64) * (512 / 32);
    for (int it = gw; it < I_IN + I_OUT + I_GW; it += NGW) {
        if (it < I_IN) p0_transpose_item(F.in[I_WIN], D, NPROJ, (bf16*)(F.ws + WS_WINT), scr, it, F.lane);
        else if (it < I_IN + I_OUT) p0_transpose_item(F.in[I_WOUT], D, D, (bf16*)(F.ws + WS_WOUTT), scr, it - I_IN, F.lane);
        else p0_transpose_item(F.in[I_GW2], 128, 512, (bf16*)(F.ws + WS_GWT), scr, it - I_IN - I_OUT, F.lane);
    }
    { v4u* z = (v4u*)((bf16*)(F.ws + WS_WINT) + (size_t)NPROJ * D); const int n16 = (NPROJ_PAD - NPROJ) * D * 2 / 16;
      for (int i = F.bid * 512 + F.tid; i < n16; i += F.G * 512) z[i] = (v4u){0u, 0u, 0u, 0u}; }
    { const f32x4* pu = (const f32x4*)F.in[I_PU]; v2u* du = (v2u*)(F.ws + WS_U);
      const int n8 = NEXP * D / 8;
      for (int i = F.bid * 512 + F.tid; i < n8; i += F.G * 512) {
          const f32x4 a0 = pu[2 * i] * 32.f, a1 = pu[2 * i + 1] * 32.f;
          int w0 = __builtin_amdgcn_cvt_pk_fp8_f32(a0.x, a0.y, 0, false); w0 = __builtin_amdgcn_cvt_pk_fp8_f32(a0.z, a0.w, w0, true);
          int w1 = __builtin_amdgcn_cvt_pk_fp8_f32(a1.x, a1.y, 0, false); w1 = __builtin_amdgcn_cvt_pk_fp8_f32(a1.z, a1.w, w1, true);
          du[i] = (v2u){(unsigned)w0, (unsigned)w1}; } }
}

__device__ __forceinline__ void p1_hx(Frame& F) {
    const float* mod = (const float*)(F.ws + WS_MOD); const float* ng = F.in[I_NG];
    bf16* hx = (bf16*)(F.ws + WS_HX);
    for (int m = F.bid * NWAVES + F.wave; m < MA; m += F.G * NWAVES) {
        const float* src = (m < MX) ? F.in[I_X] + (size_t)m * D : F.in[I_CTX] + (size_t)(m - MX) * D;
        const float* mr = mod + ((m < MX) ? (m >> 12) : 4) * NMOD;
        f32x4 v[4]; float ss = 0.f;
#pragma unroll
        for (int j = 0; j < 4; ++j) { v[j] = *(const f32x4*)(src + j * 256 + F.lane * 4); ss += v[j].x * v[j].x + v[j].y * v[j].y + v[j].z * v[j].z + v[j].w * v[j].w; }
        const float rstd = __builtin_amdgcn_rsqf(wave_sum(ss) * (1.f / D) + NORM_EPS);
#pragma unroll
        for (int j = 0; j < 4; ++j) { const int c = j * 256 + F.lane * 4;
            const f32x4 g = *(const f32x4*)(ng + c), sh = *(const f32x4*)(mr + c), sc = *(const f32x4*)(mr + D + c);
            const float o0 = v[j].x * rstd * g.x * (1.f + sc.x) + sh.x, o1 = v[j].y * rstd * g.y * (1.f + sc.y) + sh.y, o2 = v[j].z * rstd * g.z * (1.f + sc.z) + sh.z, o3 = v[j].w * rstd * g.w * (1.f + sc.w) + sh.w;
            *(v2u*)(hx + (size_t)m * D + c) = (v2u){pk2(o0, o1), pk2(o2, o3)}; }
    }
}
constexpr int BL_APT = 0, BL_NPT = 4608, BL_RH = 7168, BL_MKR = 11776, BL_MBR = 14336, BL_KGC = 16896, BL_BGC = 22016, BL_GC = 27136, BL_VT = 27648, BL_BYTES = 32768;
constexpr int CS_AH = 32768, CS_BH = 37376, CS_KH = 41984, CS_AHC = 46592, CS_E = 51712, CS_RAW = 59904, CS_TLW = 72960, CS_LOA = 77568, CS_W2T = 82176, CS_A2T = 91392,
              CS_LG = 100608, CS_NBA = 100608, CS_NKA = 105216, CS_TT = 107776, CS_CONST = 116992, CS_END = 119552;
constexpr int CS_RH = BL_RH, CS_KGC = BL_KGC, CS_BGC = BL_BGC, CS_VT = BL_VT, CS_GC = BL_GC, CS_APT = BL_APT, CS_NPT = BL_NPT, CS_MKR = BL_MKR, CS_MBR = BL_MBR;
constexpr int SC_NTILE = (TC + T) / 32, SC_RT = 16, SC_NROUND = (SC_NTILE + SC_RT - 1) / SC_RT;
constexpr int GS_YS = 65536;
__device__ __forceinline__ void scan_issue_loads(const bf16* proj, int b, int h, int d, int tile, int tid, v4u (&rg)[3]) {
    const bool isctx = tile < TC / 32; const int L = isctx ? TC : T; const int jt = isctx ? tile : tile - TC / 32;
    const size_t rowbase = isctx ? (size_t)(MX + b * TC) : (size_t)b * T;
    const int tlo = d == 0 ? 32 * jt : L - 32 * (jt + 1);
#pragma unroll
    for (int i = 0; i < 3; ++i) {
        const int q = tid + 512 * i; v4u val = (v4u){0u, 0u, 0u, 0u};
        if (q < 816) { const int row = q / 24, rem = q - row * 24, which = rem >> 3, ch8 = rem & 7; const int tok = tlo - 1 + row;
            if (tok >= 0 && tok < L) val = *(const v4u*)(proj + (rowbase + tok) * NPROJ + COL_R + which * 512 + h * 64 + ch8 * 8); }
        else if (q < 1328) { const int q2 = q - 816, row = q2 >> 4, rem = q2 & 15, which = rem >> 3, ch8 = rem & 7; const int tok = tlo + row;
            val = *(const v4u*)(proj + (rowbase + tok) * NPROJ + (which ? COL_LA : COL_LW) + d * 64 + ch8 * 8); }
        rg[i] = val;
    }
}
__device__ __forceinline__ unsigned tanh_pk(unsigned w) { return pk2(tanh_fast(bf_lo(w)), tanh_fast(bf_hi(w))); }
__device__ __forceinline__ void scan_store_raw(LAS unsigned char* lds, int tid, const v4u (&rg)[3]) {
#pragma unroll
    for (int i = 0; i < 3; ++i) {
        const int q = tid + 512 * i;
        if (q < 816) { const int row = q / 24, rem = q - row * 24, which = rem >> 3, ch8 = rem & 7; *(LAS v4u*)(lds + CS_RAW + (which * 34 + row) * 128 + ch8 * 16) = rg[i]; }
        else if (q < 1328) { const int q2 = q - 816, row = q2 >> 4, rem = q2 & 15, which = rem >> 3, ch8 = rem & 7;
            if (which) *(LAS v4u*)(lds + CS_LOA + row * 144 + ch8 * 16) = rg[i];
            else { v4u t; t.x = tanh_pk(rg[i].x); t.y = tanh_pk(rg[i].y); t.z = tanh_pk(rg[i].z); t.w = tanh_pk(rg[i].w); *(LAS v4u*)(lds + CS_TLW + row * 144 + ch8 * 16) = t; } }
    }
}
__device__ __forceinline__ v2u pack4(f32x4 v) { return (v2u){pk2(v.x, v.y), pk2(v.z, v.w)}; }
__device__ __forceinline__ bf16 bfs(float v) { return (bf16)(pk2(v, 0.f) & 0xffffu); }
typedef v2u v2u_t;
__device__ __forceinline__ bf16x8 frag2(const LAS unsigned char* p0, const LAS unsigned char* p1) {
    const v2u a = *(const LAS v2u*)p0, b = *(const LAS v2u*)p1; const v4u w = (v4u){a.x, a.y, b.x, b.y}; return __builtin_bit_cast(bf16x8, w);
}
__device__ __forceinline__ bf16x8 frag_acc(f32x4 lo, f32x4 hi) { const v4u w = (v4u){pk2(lo.x, lo.y), pk2(lo.z, lo.w), pk2(hi.x, hi.y), pk2(hi.z, hi.w)}; return __builtin_bit_cast(bf16x8, w); }
__device__ __forceinline__ bf16x8 frag_zero() { const v4u w = (v4u){0u, 0u, 0u, 0u}; return __builtin_bit_cast(bf16x8, w); }
__device__ __forceinline__ void scan_prep_task(Frame& F, const bf16* proj, int chain, int tile, bool load_consts, bool have_next, int nchain, int ntile, v4u (&rg)[3], unsigned char* blob) {
    LAS unsigned char* lds = F.lds; const int tid = F.tid, lane = F.lane, wave = F.wave;
    const int b = chain >> 4, h = (chain >> 1) & 7, d = chain & 1, nb = nchain >> 4, nh = (nchain >> 1) & 7, nd = nchain & 1;
    if (load_consts) {
        __syncthreads();
        LAS float* C = (LAS float*)(lds + CS_CONST);
        if (tid < 384) { const int pn = tid / 192, r = tid - pn * 192, which = r >> 6, c = r & 63; C[pn * 192 + which * 64 + c] = F.in[I_TMU][(pn * 3 + which) * 512 + h * 64 + c]; }
        else if (tid < 448) { const int c = tid - 384; C[384 + c] = F.in[I_KK][h * 64 + c]; C[448 + c] = F.in[I_KA][h * 64 + c]; }
        else { const int c = tid - 448; C[512 + c] = F.in[I_DW0][d * 512 + h * 64 + c]; C[576 + c] = F.in[I_A0][d * 512 + h * 64 + c]; }
        const float* w2 = F.in[I_DW2] + (size_t)d * 64 * 512 + h * 64; const float* a2 = F.in[I_A2] + (size_t)d * 64 * 512 + h * 64;
#pragma unroll
        for (int i = 0; i < 8; ++i) { const int idx = tid + 512 * i, j = idx >> 6, c = idx & 63;
            *(LAS bf16*)(lds + CS_W2T + c * 144 + j * 2) = bfs(w2[j * 512 + c]);
            *(LAS bf16*)(lds + CS_A2T + c * 144 + j * 2) = bfs(a2[j * 512 + c]); }
    }
    {
            scan_store_raw(lds, tid, rg);
            __syncthreads();
            if (have_next) scan_issue_loads(proj, nb, nh, nd, ntile, tid, rg);
            if (wave < 4) {
                const int mat = wave >> 1, nt = wave & 1, r = lane & 31, hh = lane >> 5;
                const LAS unsigned char* Ab = lds + (mat ? CS_LOA : CS_TLW) + r * 144 + hh * 16;
                const LAS unsigned char* Bb = lds + (mat ? CS_A2T : CS_W2T) + (nt * 32 + r) * 144 + hh * 16;
                f32x16 acc;
#pragma unroll
                for (int i = 0; i < 16; ++i) acc[i] = 0.f;
#pragma unroll
                for (int ks = 0; ks < 4; ++ks) { const bf16x8 a = *(const LAS bf16x8*)(Ab + ks * 32), bb = *(const LAS bf16x8*)(Bb + ks * 32); acc = __builtin_amdgcn_mfma_f32_32x32x16_bf16(a, bb, acc, 0, 0, 0); }
                LAS float* LG = (LAS float*)(lds + CS_LG) + mat * 2048 + nt * 32 + r;
#pragma unroll
                for (int i = 0; i < 16; ++i) LG[((i & 3) + 8 * (i >> 2) + 4 * hh) * 64] = acc[i];
            }
            __syncthreads();
            const int tok = tid >> 4, cq = tid & 15, c0 = cq * 4, s = d == 0 ? tok : 31 - tok;
            f32x4 rs, vs, kd, kk, kka, ev;
            { const LAS float* C = (const LAS float*)(lds + CS_CONST);
              f32x4 xs[3];
#pragma unroll
              for (int which = 0; which < 3; ++which) {
                  const LAS unsigned char* rp = lds + CS_RAW + (which * 34 + tok) * 128 + c0 * 2;
                  const v2u p = *(const LAS v2u*)rp, x = *(const LAS v2u*)(rp + 128), n = *(const LAS v2u*)(rp + 256);
                  const f32x4 mp = *(const LAS f32x4*)(C + which * 64 + c0), mn = *(const LAS f32x4*)(C + 192 + which * 64 + c0);
                  const f32x4 xp = (f32x4){bf_lo(p.x), bf_hi(p.x), bf_lo(p.y), bf_hi(p.y)}, xc = (f32x4){bf_lo(x.x), bf_hi(x.x), bf_lo(x.y), bf_hi(x.y)}, xn = (f32x4){bf_lo(n.x), bf_hi(n.x), bf_lo(n.y), bf_hi(n.y)};
                  xs[which] = xc + mp * (xp - xc) + mn * (xn - xc); }
              const f32x4 kkc = *(const LAS f32x4*)(C + 384 + c0), kac = *(const LAS f32x4*)(C + 448 + c0), w0 = *(const LAS f32x4*)(C + 512 + c0), a0 = *(const LAS f32x4*)(C + 576 + c0);
              kk = xs[1] * kkc;
              const float ss = rowsum16(kk.x * kk.x + kk.y * kk.y + kk.z * kk.z + kk.w * kk.w);
              kk = kk * __builtin_amdgcn_rsqf(ss + 1e-12f);
              const f32x4 uw = *(const LAS f32x4*)(lds + CS_LG + (tok * 64 + c0) * 4) + w0, ua = *(const LAS f32x4*)(lds + CS_LG + 8192 + (tok * 64 + c0) * 4) + a0;
              f32x4 av;
#pragma unroll
              for (int e = 0; e < 4; ++e) { ev[e] = 0.60653066f * sigmoidf(uw[e]); av[e] = sigmoidf(ua[e]); }
              kd = xs[1] * (1.f + (av - 1.f) * kac); kka = kk * av; rs = xs[0]; vs = xs[2];
              *(LAS f32x4*)(lds + CS_E + (s * 64 + c0) * 4) = ev; }
            __syncthreads();
            { const int cb = s & 16, sl = s & 15;
              f32x4 cum = (f32x4){0.f, 0.f, 0.f, 0.f}, tot = cum;
#pragma unroll
              for (int ii = 0; ii < 16; ++ii) { const f32x4 e4 = *(const LAS f32x4*)(lds + CS_E + ((cb + ii) * 64 + c0) * 4); tot = tot + e4; if (ii <= sl) cum = cum + e4; }
              f32x4 g, gm1, gi, ge, gt;
#pragma unroll
              for (int e = 0; e < 4; ++e) { g[e] = fast_exp(-cum[e]); gm1[e] = fast_exp(ev[e] - cum[e]); gi[e] = fast_exp(cum[e]); ge[e] = fast_exp(cum[e] - tot[e]); gt[e] = fast_exp(-tot[e]); }
              const f32x4 ah = gm1 * kk, bh = kka * gi, kh = kd * gi, rh = g * rs, kg = kd * ge, bg = kka * ge;
              *(LAS v2u*)(lds + CS_AH + s * 144 + c0 * 2) = pack4(ah); *(LAS v2u*)(lds + CS_BH + s * 144 + c0 * 2) = pack4(bh);
              *(LAS v2u*)(lds + CS_KH + s * 144 + c0 * 2) = pack4(kh); *(LAS v2u*)(lds + CS_RH + s * 144 + c0 * 2) = pack4(rh);
#pragma unroll
              for (int e = 0; e < 4; ++e) { *(LAS bf16*)(lds + CS_AHC + (c0 + e) * 80 + s * 2) = bfs(ah[e]); *(LAS bf16*)(lds + CS_KGC + (c0 + e) * 80 + s * 2) = bfs(kg[e]); *(LAS bf16*)(lds + CS_BGC + (c0 + e) * 80 + s * 2) = bfs(-bg[e]); }
#pragma unroll
              for (int e = 0; e < 4; ++e) *(LAS bf16*)(lds + CS_VT + (c0 + e) * 80 + s * 2) = bfs(vs[e]);
              if (sl == 15) *(LAS f32x4*)(lds + CS_GC + ((s >> 4) * 64 + c0) * 4) = gt; }
            __syncthreads();
            if (wave < 4) {
                const int r = lane & 31, hh = lane >> 5;
                const LAS unsigned char* Ab = lds + ((wave == 0 || wave == 3) ? CS_BH : CS_KH) + r * 144 + hh * 16;
                const LAS unsigned char* Bb = lds + (wave < 2 ? CS_AH : CS_RH) + r * 144 + hh * 16;
                f32x16 acc;
#pragma unroll
                for (int i = 0; i < 16; ++i) acc[i] = 0.f;
#pragma unroll
                for (int ks = 0; ks < 4; ++ks) { const bf16x8 a = *(const LAS bf16x8*)(Ab + ks * 32), bb = *(const LAS bf16x8*)(Bb + ks * 32); acc = __builtin_amdgcn_mfma_f32_32x32x16_bf16(a, bb, acc, 0, 0, 0); }
                const int t = r;
#pragma unroll
                for (int i = 0; i < 16; ++i) { const int j = (i & 3) + 8 * (i >> 2) + 4 * hh; const bool same = (j >> 4) == (t >> 4);
                    const bool keep = same && (wave < 2 ? (j < t) : (j <= t)); acc[i] = keep ? acc[i] : 0.f; }
                if (wave == 0) {
#pragma unroll
                    for (int i = 0; i < 16; ++i) { const int j = (i & 3) + 8 * (i >> 2) + 4 * hh; *(LAS float*)(lds + CS_NBA + (t * 36 + j) * 4) = acc[i]; } }
                else if (wave == 1) {
#pragma unroll
                    for (int i = 0; i < 16; ++i) { const int j = (i & 3) + 8 * (i >> 2) + 4 * hh; *(LAS bf16*)(lds + CS_NKA + j * 80 + t * 2) = bfs(acc[i]); } }
                else { const float sg = wave == 2 ? 1.f : -1.f; const int base = wave == 2 ? CS_MKR : CS_MBR;
#pragma unroll
                    for (int q4 = 0; q4 < 4; ++q4) *(LAS v2u*)(lds + base + t * 80 + (8 * q4 + 4 * hh) * 2) = pack4((f32x4){sg * acc[4 * q4], sg * acc[4 * q4 + 1], sg * acc[4 * q4 + 2], sg * acc[4 * q4 + 3]}); }
            }
            __syncthreads();
            if (wave == 0 && lane < 32) {
                const int blk = lane >> 4, i = lane & 15;
                float Tr[16];
#pragma unroll
                for (int t = 0; t < 16; ++t) {
                    float acc = (t == i) ? 1.f : 0.f;
                    const LAS float* np = (const LAS float*)(lds + CS_NBA) + (16 * blk + t) * 36 + 16 * blk;
#pragma unroll
                    for (int j = 0; j < t; ++j) acc -= Tr[j] * np[j];
                    Tr[t] = acc;
                }
#pragma unroll
                for (int t = 0; t < 16; ++t) { *(LAS bf16*)(lds + CS_TT + (16 * blk + t) * 80 + (16 * blk + i) * 2) = bfs(Tr[t]); *(LAS bf16*)(lds + CS_TT + (16 * blk + t) * 80 + (16 * (1 - blk) + i) * 2) = (bf16)0; }
            }
            __syncthreads();
            if (wave < 3) {
                const int r = lane & 31, hh = lane >> 5;
                const LAS unsigned char* Ab = lds + (wave < 2 ? CS_AHC + (32 * wave + r) * 80 : CS_NKA + r * 80) + hh * 16;
                const LAS unsigned char* Bb = lds + CS_TT + r * 80 + hh * 16;
                f32x16 acc;
#pragma unroll
                for (int i = 0; i < 16; ++i) acc[i] = 0.f;
#pragma unroll
                for (int ks = 0; ks < 2; ++ks) { const bf16x8 a = *(const LAS bf16x8*)(Ab + ks * 32), bb = *(const LAS bf16x8*)(Bb + ks * 32); acc = __builtin_amdgcn_mfma_f32_32x32x16_bf16(a, bb, acc, 0, 0, 0); }
                const int t = r;
#pragma unroll
                for (int q4 = 0; q4 < 4; ++q4) { const v2u pk = pack4((f32x4){acc[4 * q4], acc[4 * q4 + 1], acc[4 * q4 + 2], acc[4 * q4 + 3]});
                    if (wave < 2) *(LAS v2u*)(lds + CS_APT + t * 144 + (32 * wave + 8 * q4 + 4 * hh) * 2) = pk;
                    else *(LAS v2u*)(lds + CS_NPT + t * 80 + (8 * q4 + 4 * hh) * 2) = pk; }
            }
            __syncthreads();
#pragma unroll
            for (int i = 0; i < 4; ++i) { const int idx = tid + 512 * i; *(v4u*)(blob + idx * 16) = *(const LAS v4u*)(lds + idx * 16); }
    }
}
__device__ __forceinline__ void scan_state_round(Frame& F, int chain, int t0, int t1, const unsigned char* blobs, f32x4 (&Z)[4]) {
    LAS unsigned char* lds = F.lds; const int tid = F.tid, lane = F.lane, wave = F.wave;
    const int b = chain >> 4, h = (chain >> 1) & 7, d = chain & 1;
    float* yscr = F.out;
    v4u bg[4];
    __syncthreads();
#pragma unroll
    for (int i = 0; i < 4; ++i) bg[i] = *(const v4u*)(blobs + (tid + 512 * i) * 16);
#pragma unroll
    for (int i = 0; i < 4; ++i) *(LAS v4u*)(lds + (tid + 512 * i) * 16) = bg[i];
    __syncthreads();
    for (int tile = t0; tile < t1; ++tile) {
        const bool isctx = tile < TC / 32; const int L = isctx ? TC : T; const int jt = isctx ? tile : tile - TC / 32;
        const int tlo = d == 0 ? 32 * jt : L - 32 * (jt + 1);
        const LAS unsigned char* bl = lds + ((tile - t0) & 1) * BL_BYTES;
        if (tile + 1 < t1) {
#pragma unroll
            for (int i = 0; i < 4; ++i) bg[i] = *(const v4u*)(blobs + (size_t)(tile + 1 - t0) * BL_BYTES + (tid + 512 * i) * 16); }
            if (wave < 4) {
                const int n = lane & 15, g = lane >> 4;
                const bf16x8 bvt = *(const LAS bf16x8*)(bl + BL_VT + (16 * wave + n) * 80 + g * 16);
                f32x4 U[2]; U[0] = (f32x4){0.f, 0.f, 0.f, 0.f}; U[1] = U[0];
#pragma unroll
                for (int cc = 0; cc < 2; ++cc) {
                    const int trow = 16 * cc + n;
                    const bf16x8 bz01 = frag_acc(Z[0], Z[1]), bz23 = frag_acc(Z[2], Z[3]);
                    { const LAS unsigned char* ap = bl + BL_APT + trow * 144;
                      f32x4 u = __builtin_amdgcn_mfma_f32_16x16x32_bf16(frag2(ap + (4 * g) * 2, ap + (16 + 4 * g) * 2), bz01, (f32x4){0.f, 0.f, 0.f, 0.f}, 0, 0, 0);
                      u = __builtin_amdgcn_mfma_f32_16x16x32_bf16(frag2(ap + (32 + 4 * g) * 2, ap + (48 + 4 * g) * 2), bz23, u, 0, 0, 0);
                      u = __builtin_amdgcn_mfma_f32_16x16x32_bf16(*(const LAS bf16x8*)(bl + BL_NPT + trow * 80 + g * 16), bvt, u, 0, 0, 0);
                      U[cc] = u; }
                    const bf16x8 bu = frag_acc(U[0], U[1]);
                    if (!isctx) { const LAS unsigned char* rp = bl + BL_RH + trow * 144;
                      f32x4 y = __builtin_amdgcn_mfma_f32_16x16x32_bf16(frag2(rp + (4 * g) * 2, rp + (16 + 4 * g) * 2), bz01, (f32x4){0.f, 0.f, 0.f, 0.f}, 0, 0, 0);
                      y = __builtin_amdgcn_mfma_f32_16x16x32_bf16(frag2(rp + (32 + 4 * g) * 2, rp + (48 + 4 * g) * 2), bz23, y, 0, 0, 0);
                      y = __builtin_amdgcn_mfma_f32_16x16x32_bf16(*(const LAS bf16x8*)(bl + BL_MKR + trow * 80 + g * 16), bvt, y, 0, 0, 0);
                      const LAS unsigned char* mp = bl + BL_MBR + trow * 80;
                      y = __builtin_amdgcn_mfma_f32_16x16x32_bf16(frag2(mp + (4 * g) * 2, mp + (16 + 4 * g) * 2), bu, y, 0, 0, 0);
#pragma unroll
                      for (int i = 0; i < 4; ++i) *(LAS float*)(lds + GS_YS + ((16 * cc + 4 * g + i) * 64 + 16 * wave + n) * 4) = y[i]; }
#pragma unroll
                    for (int kt = 0; kt < 4; ++kt) {
                        const f32x4 gc = *(const LAS f32x4*)(bl + BL_GC + (cc * 64 + 16 * kt + 4 * g) * 4);
                        bf16x8 ka = *(const LAS bf16x8*)(bl + BL_KGC + (16 * kt + n) * 80 + g * 16);
                        if ((g >> 1) != cc) ka = frag_zero();
                        const LAS unsigned char* bp = bl + BL_BGC + (16 * kt + n) * 80;
                        const v2u b0 = *(const LAS v2u*)(bp + (4 * g) * 2), b1 = *(const LAS v2u*)(bp + (16 + 4 * g) * 2);
                        const v4u bw = cc == 0 ? (v4u){b0.x, b0.y, 0u, 0u} : (v4u){0u, 0u, b1.x, b1.y};
                        f32x4 z = Z[kt] * gc;
                        z = __builtin_amdgcn_mfma_f32_16x16x32_bf16(ka, bvt, z, 0, 0, 0);
                        z = __builtin_amdgcn_mfma_f32_16x16x32_bf16(__builtin_bit_cast(bf16x8, bw), bu, z, 0, 0, 0);
                        Z[kt] = z;
                    }
                }
            }
        __syncthreads();
        if (!isctx) { const int s2 = tid >> 4, part = tid & 15; const int tk = d == 0 ? tlo + s2 : tlo + 31 - s2;
            *(f32x4*)(yscr + ((size_t)(b * T + tk)) * D + d * 512 + h * 64 + part * 4) = *(const LAS f32x4*)(lds + GS_YS + (s2 * 64 + part * 4) * 4); }
        if (tile + 1 < t1) {
#pragma unroll
            for (int i = 0; i < 4; ++i) *(LAS v4u*)(lds + ((tile + 1 - t0) & 1) * BL_BYTES + (tid + 512 * i) * 16) = bg[i]; }
        __syncthreads();
    }
}
template <int LEVEL> __device__ __forceinline__ void p3_scan(Frame& F, const XcdBarrier& bar) {
    const bf16* proj = (const bf16*)(F.ws + WS_PROJ);
    const bool state_role = F.bid < 64;
    f32x4 Z[4];
#pragma unroll
    for (int kt = 0; kt < 4; ++kt) Z[kt] = (f32x4){0.f, 0.f, 0.f, 0.f};
    for (int step = 0; step <= SC_NROUND; ++step) {
        if (step >= 1 && state_role) {
            const int r = step - 1, t0 = r * SC_RT, t1 = (t0 + SC_RT < SC_NTILE) ? t0 + SC_RT : SC_NTILE;
            scan_state_round(F, F.bid, t0, t1, F.ws + ((r & 1) ? WS_BLOB1 : WS_BLOB0) + (size_t)F.bid * SC_RT * BL_BYTES, Z);
        }
        const bool prep_here = step < SC_NROUND && (step == 0 || !state_role);
        if (prep_here) {
            const int t0 = step * SC_RT, nt = (t0 + SC_RT < SC_NTILE) ? SC_RT : SC_NTILE - t0, ntask = 64 * nt;
            const int P = step == 0 ? F.G : F.G - 64, p = step == 0 ? F.bid : F.bid - 64;
            const int k0 = (int)((long)ntask * p / P), k1 = (int)((long)ntask * (p + 1) / P);
            unsigned char* base = F.ws + ((step & 1) ? WS_BLOB1 : WS_BLOB0);
            v4u rg[3];
            if (k0 < k1) scan_issue_loads(proj, (k0 / nt) >> 4, ((k0 / nt) >> 1) & 7, (k0 / nt) & 1, t0 + k0 % nt, F.tid, rg);
            int prev_chain = -1;
            for (int k = k0; k < k1; ++k) {
                const int chain = k / nt, tl = k % nt, kn = k + 1, nchain = kn / nt, ntl = kn % nt;
                scan_prep_task(F, proj, chain, t0 + tl, chain != prev_chain, kn < k1, nchain, t0 + ntl, rg, base + ((size_t)chain * SC_RT + tl) * BL_BYTES);
                prev_chain = chain;
            }
        }
        if (step < SC_NROUND) xcd_barrier(bar);
    }
}
constexpr int P4_SG = 0, P4_GT = 17408, P4_CST = 17408 + 64 * 1040, P4_END = P4_CST + 12 * 2048;
__device__ __forceinline__ f32x4 ldq(const LAS float* p) { return *(const LAS f32x4*)p; }
__device__ __forceinline__ void unpack8(v4u w, float (&o)[8]) { o[0] = bf_lo(w.x); o[1] = bf_hi(w.x); o[2] = bf_lo(w.y); o[3] = bf_hi(w.y); o[4] = bf_lo(w.z); o[5] = bf_hi(w.z); o[6] = bf_lo(w.w); o[7] = bf_hi(w.w); }
__device__ __forceinline__ float sum8lanes(float p) { p += dppf<0xB1>(p); p += dppf<0x4E>(p); p += dppf<0x141>(p); return p; }
__device__ __forceinline__ void p4_mix(Frame& F) {
    LAS unsigned char* lds = F.lds; const int tid = F.tid, lane = F.lane, wave = F.wave;
    const bf16* proj = (const bf16*)(F.ws + WS_PROJ); bf16* cat = (bf16*)(F.ws + WS_HX); const float* yscr = F.out; const bf16* gwt = (const bf16*)(F.ws + WS_GWT);
    LAS float* CST = (LAS float*)(lds + P4_CST);
    __syncthreads();
    for (int i = tid; i < 12 * 512; i += 512) { const int row = i >> 9, c = i & 511;
        CST[i] = row < 6 ? F.in[I_TMU][row * 512 + c] : row == 6 ? F.in[I_RK][c] : row == 7 ? F.in[I_LNG][c] : row == 8 ? F.in[I_LNB][c] : F.in[I_CONVW][(row - 9) * 512 + c]; }
    for (int unit = F.bid; unit < MX / 64; unit += F.G) {
        const size_t row0 = (size_t)unit * 64; const int tb0 = (unit * 64) & (T - 1);
        __syncthreads();
#pragma unroll
        for (int i = 0; i < 2; ++i) { const int ck = tid + 512 * i, tok = ck >> 4, j0 = (ck & 15) * 8;
            const v4u w = *(const v4u*)(proj + (row0 + tok) * NPROJ + COL_G + j0);
            v4u o; o.x = pk2(sigmoidf(bf_lo(w.x)), sigmoidf(bf_hi(w.x))); o.y = pk2(sigmoidf(bf_lo(w.y)), sigmoidf(bf_hi(w.y))); o.z = pk2(sigmoidf(bf_lo(w.z)), sigmoidf(bf_hi(w.z))); o.w = pk2(sigmoidf(bf_lo(w.w)), sigmoidf(bf_hi(w.w)));
            *(LAS v4u*)(lds + P4_SG + tok * 272 + j0 * 2) = o; }
        __syncthreads();
        { const int r = lane & 31, hh = lane >> 5;
#pragma unroll
          for (int nt = 0; nt < 2; ++nt) {
              const bf16* bp = gwt + (size_t)(64 * wave + 32 * nt + r) * 128 + hh * 8;
              bf16x8 bfr[8];
#pragma unroll
              for (int ks = 0; ks < 8; ++ks) bfr[ks] = *(const bf16x8*)(bp + ks * 16);
#pragma unroll
              for (int mt = 0; mt < 2; ++mt) {
                  f32x16 acc;
#pragma unroll
                  for (int i = 0; i < 16; ++i) acc[i] = 0.f;
#pragma unroll
                  for (int ks = 0; ks < 8; ++ks) { const bf16x8 a = *(const LAS bf16x8*)(lds + P4_SG + (32 * mt + r) * 272 + ks * 32 + hh * 16); acc = __builtin_amdgcn_mfma_f32_32x32x16_bf16(a, bfr[ks], acc, 0, 0, 0); }
#pragma unroll
                  for (int i = 0; i < 16; ++i) *(LAS bf16*)(lds + P4_GT + (32 * mt + (i & 3) + 8 * (i >> 2) + 4 * hh) * 1040 + (64 * wave + 32 * nt + r) * 2) = (bf16)(pk2(acc[i], 0.f) & 0xffffu);
              } } }
        __syncthreads();
        const int gq = tid & 63, c0 = gq * 8;
#pragma unroll 2
        for (int n = 0; n < 8; ++n) { const int t = 8 * n + (tid >> 6); const int tb = tb0 + t;
            const bf16* pr = proj + (row0 + t) * NPROJ + c0;
            float xs[3][8];
#pragma unroll
            for (int which = 0; which < 3; ++which) { const int col = COL_R + which * 512;
                float xc[8], xp[8], xn[8];
                unpack8(*(const v4u*)(pr + col), xc);
                if (tb > 0) unpack8(*(const v4u*)(pr - NPROJ + col), xp); else {
#pragma unroll
                    for (int e = 0; e < 8; ++e) xp[e] = 0.f; }
                if (tb + 1 < T) unpack8(*(const v4u*)(pr + NPROJ + col), xn); else {
#pragma unroll
                    for (int e = 0; e < 8; ++e) xn[e] = 0.f; }
                const f32x4 mp0 = ldq(CST + which * 512 + c0), mp1 = ldq(CST + which * 512 + c0 + 4), mn0 = ldq(CST + (3 + which) * 512 + c0), mn1 = ldq(CST + (3 + which) * 512 + c0 + 4);
#pragma unroll
                for (int e = 0; e < 8; ++e) { const float mp = e < 4 ? mp0[e & 3] : mp1[e & 3], mn = e < 4 ? mn0[e & 3] : mn1[e & 3]; xs[which][e] = xc[e] + mp * (xp[e] - xc[e]) + mn * (xn[e] - xc[e]); } }
            const float* yr = yscr + (row0 + t) * D + c0;
            const f32x4 ya = *(const f32x4*)yr + *(const f32x4*)(yr + 512), yb = *(const f32x4*)(yr + 4) + *(const f32x4*)(yr + 516);
            float y[8] = {ya.x, ya.y, ya.z, ya.w, yb.x, yb.y, yb.z, yb.w};
            float sm = 0.f, sb = 0.f;
            const f32x4 rk0 = ldq(CST + 6 * 512 + c0), rk1 = ldq(CST + 6 * 512 + c0 + 4);
#pragma unroll
            for (int e = 0; e < 8; ++e) { sm += y[e]; sb += xs[0][e] * xs[1][e] * (e < 4 ? rk0[e & 3] : rk1[e & 3]); }
            const float mu = sum8lanes(sm) * (1.f / 64.f); const float bon = sum8lanes(sb);
            float sv = 0.f;
#pragma unroll
            for (int e = 0; e < 8; ++e) { y[e] -= mu; sv += y[e] * y[e]; }
            const float rstd = __builtin_amdgcn_rsqf(sum8lanes(sv) * (1.f / 64.f) + LNX_EPS);
            const f32x4 lg0 = ldq(CST + 7 * 512 + c0), lg1 = ldq(CST + 7 * 512 + c0 + 4), lb0 = ldq(CST + 8 * 512 + c0), lb1 = ldq(CST + 8 * 512 + c0 + 4);
            float gt[8]; unpack8(*(const LAS v4u*)(lds + P4_GT + t * 1040 + c0 * 2), gt);
            float o[8];
#pragma unroll
            for (int e = 0; e < 8; ++e) o[e] = (y[e] * rstd * (e < 4 ? lg0[e & 3] : lg1[e & 3]) + (e < 4 ? lb0[e & 3] : lb1[e & 3]) + bon * xs[2][e]) * gt[e];
            *(v4u*)(cat + (row0 + t) * D + 512 + c0) = (v4u){pk2(o[0], o[1]), pk2(o[2], o[3]), pk2(o[4], o[5]), pk2(o[6], o[7])};
        }
#pragma unroll 2
        for (int n = 0; n < 8; ++n) { const int t = 8 * n + (tid >> 6);
            const bf16* pr = proj + (row0 + t) * NPROJ + c0;
            float zc[8], zp[8], zn[8], g8[8], x8[8], xb[8];
            unpack8(*(const v4u*)(pr + COL_XG), g8); unpack8(*(const v4u*)(pr + COL_XC), x8);
#pragma unroll
            for (int e = 0; e < 8; ++e) zc[e] = g8[e] * x8[e];
            if (t > 0) { unpack8(*(const v4u*)(pr - NPROJ + COL_XG), g8); unpack8(*(const v4u*)(pr - NPROJ + COL_XC), x8);
#pragma unroll
                for (int e = 0; e < 8; ++e) zp[e] = g8[e] * x8[e]; } else {
#pragma unroll
                for (int e = 0; e < 8; ++e) zp[e] = 0.f; }
            if (t < 63) { unpack8(*(const v4u*)(pr + NPROJ + COL_XG), g8); unpack8(*(const v4u*)(pr + NPROJ + COL_XC), x8);
#pragma unroll
                for (int e = 0; e < 8; ++e) zn[e] = g8[e] * x8[e]; } else {
#pragma unroll
                for (int e = 0; e < 8; ++e) zn[e] = 0.f; }
            unpack8(*(const v4u*)(pr + COL_XB), xb);
            const f32x4 w00 = ldq(CST + 9 * 512 + c0), w01 = ldq(CST + 9 * 512 + c0 + 4), w10 = ldq(CST + 10 * 512 + c0), w11 = ldq(CST + 10 * 512 + c0 + 4), w20 = ldq(CST + 11 * 512 + c0), w21 = ldq(CST + 11 * 512 + c0 + 4);
            float o[8];
#pragma unroll
            for (int e = 0; e < 8; ++e) o[e] = xb[e] * ((e < 4 ? w00[e & 3] : w01[e & 3]) * zp[e] + (e < 4 ? w10[e & 3] : w11[e & 3]) * zc[e] + (e < 4 ? w20[e & 3] : w21[e & 3]) * zn[e]);
            *(v4u*)(cat + (row0 + t) * D + c0) = (v4u){pk2(o[0], o[1]), pk2(o[2], o[3]), pk2(o[4], o[5]), pk2(o[6], o[7])};
        }
    }
}

__device__ __forceinline__ void p6_mid(Frame& F) {
    const float* mod = (const float*)(F.ws + WS_MOD); const float* ng = F.in[I_NG];
    const float* yx = (const float*)(F.ws + WS_PROJ); bf16* hx2 = (bf16*)(F.ws + WS_HX);
    for (int m = F.bid * NWAVES + F.wave; m < MX; m += F.G * NWAVES) {
        const float* mr = mod + (m >> 12) * NMOD;
        f32x4 v[4], xv[4]; float ss = 0.f;
#pragma unroll
        for (int j = 0; j < 4; ++j) { v[j] = *(const f32x4*)(yx + (size_t)m * D + j * 256 + F.lane * 4); xv[j] = *(const f32x4*)(F.in[I_X] + (size_t)m * D + j * 256 + F.lane * 4);
            ss += v[j].x * v[j].x + v[j].y * v[j].y + v[j].z * v[j].z + v[j].w * v[j].w; }
        const float rstd = __builtin_amdgcn_rsqf(wave_sum(ss) * (1.f / D) + NORM_EPS);
        float ss2 = 0.f;
#pragma unroll
        for (int j = 0; j < 4; ++j) { const int c = j * 256 + F.lane * 4;
            const f32x4 g1 = *(const f32x4*)(ng + D + c), gt = *(const f32x4*)(mr + 2 * D + c);
            xv[j] = xv[j] + gt * (v[j] * rstd * g1);
            *(f32x4*)(F.out + (size_t)m * D + c) = xv[j];
            ss2 += xv[j].x * xv[j].x + xv[j].y * xv[j].y + xv[j].z * xv[j].z + xv[j].w * xv[j].w; }
        const float rstd2 = __builtin_amdgcn_rsqf(wave_sum(ss2) * (1.f / D) + NORM_EPS);
#pragma unroll
        for (int j = 0; j < 4; ++j) { const int c = j * 256 + F.lane * 4;
            const f32x4 g2 = *(const f32x4*)(ng + 2 * D + c), sh = *(const f32x4*)(mr + 3 * D + c), sc = *(const f32x4*)(mr + 4 * D + c);
            const f32x4 o = xv[j] * rstd2 * g2 * (1.f + sc) + sh;
            *(v2u*)(hx2 + (size_t)m * D + c) = (v2u){pk2(o.x, o.y), pk2(o.z, o.w)}; }
    }
}
__device__ __forceinline__ float gelu_erf(float x) { return 0.5f * x * (1.f + erff(x * 0.70710678118f)); }
__device__ __forceinline__ float dot2bf(unsigned a, unsigned b, float c) {
    typedef __bf16 bf2 __attribute__((ext_vector_type(2)));
    return __builtin_amdgcn_fdot2_f32_bf16(__builtin_bit_cast(bf2, a), __builtin_bit_cast(bf2, b), c, false);
}
__device__ __forceinline__ unsigned uminu(unsigned a, unsigned b) { return a < b ? a : b; }
__device__ __forceinline__ void ce_desc(unsigned& x, unsigned& y) { const unsigned hi = umaxu(x, y), lo = uminu(x, y); x = hi; y = lo; }
template <int N> __device__ __forceinline__ void bitonic_sort_desc(unsigned (&a)[N]) {
#pragma unroll
    for (int k = 2; k <= N; k <<= 1)
#pragma unroll
        for (int j = k >> 1; j > 0; j >>= 1)
#pragma unroll
            for (int i = 0; i < N; ++i) { const int l = i ^ j; if (l > i) { if ((i & k) == 0) ce_desc(a[i], a[l]); else ce_desc(a[l], a[i]); } }
}
template <int N> __device__ __forceinline__ void bitonic_merge_desc(unsigned (&a)[N]) {
#pragma unroll
    for (int j = N >> 1; j > 0; j >>= 1)
#pragma unroll
        for (int i = 0; i < N; ++i) { const int l = i ^ j; if (l > i) ce_desc(a[i], a[l]); }
}
__device__ __forceinline__ void p8a_route(Frame& F) {
    const int lane = F.lane, wave = F.wave, part = lane & 3, L = lane >> 2, side = L & 1;
    LAS unsigned char* WL = F.lds + 1024 + wave * 1024;
    LAS unsigned char* TAB = F.lds;
    const float* scores = (const float*)(F.ws + WS_PROJ);
    unsigned short* exl = (unsigned short*)(F.ws + WS_EXL); float* gl = (float*)(F.ws + WS_GL);
    __syncthreads();
    if (F.tid < 64) { int l = F.tid, i = 0; for (; i < 16; ++i) { const int n = 16 / (i + 1); if (l < n) break; l -= n; } TAB[F.tid] = (unsigned char)(i < 16 ? i * 16 + l : 0); }
    __syncthreads();
    for (int m = F.bid * NWAVES + wave; m < MX; m += F.G * NWAVES) {
        const float* lp = scores + (size_t)m * NSC + L * 128 + part * 32;
        unsigned lo16[16], hi16[16];
#pragma unroll
        for (int q = 0; q < 4; ++q) { const f32x4 v = *(const f32x4*)(lp + 4 * q), w = *(const f32x4*)(lp + 16 + 4 * q);
#pragma unroll
            for (int e = 0; e < 4; ++e) { lo16[4 * q + e] = (f2key(v[e]) & ~127u) | (unsigned)(127 - part * 32 - (4 * q + e)); hi16[4 * q + e] = (f2key(w[e]) & ~127u) | (unsigned)(127 - part * 32 - 16 - (4 * q + e)); } }
        bitonic_sort_desc<16>(lo16); bitonic_sort_desc<16>(hi16);
        unsigned r[16];
#pragma unroll
        for (int i = 0; i < 16; ++i) r[i] = umaxu(lo16[i], hi16[15 - i]);
        bitonic_merge_desc<16>(r);
        { unsigned c[16];
#pragma unroll
          for (int i = 0; i < 16; ++i) c[i] = umaxu(r[i], dppu<0xB1>(r[15 - i]));
          bitonic_merge_desc<16>(c);
#pragma unroll
          for (int i = 0; i < 16; ++i) r[i] = umaxu(c[i], dppu<0x4E>(c[15 - i]));
          bitonic_merge_desc<16>(r); }
        if (part == 0) {
#pragma unroll
            for (int i = 0; i < 16; ++i) WL[L * 16 + i] = (unsigned char)(127u - (r[i] & 127u)); }
        float fa[16], fb[16];
#pragma unroll
        for (int i = 0; i < 16; ++i) { const unsigned up = dppu<0x104>(r[i]), dn = dppu<0x114>(r[i]);
            const unsigned av = side ? dn : r[i], bv = side ? r[i] : up; fa[i] = key2f(av & ~127u); fb[i] = key2f(bv & ~127u); }
        unsigned R[16];
#pragma unroll
        for (int j = 0; j < 16; ++j) R[j] = (f2key(fa[0] + fb[j]) & ~63u) | (unsigned)(63 - j);
        { int code = 16;
#pragma unroll
          for (int i = 1; i < 16; ++i) {
#pragma unroll
              for (int j = 0; j < 16; ++j) { if ((i + 1) * (j + 1) <= 16) {
                  const unsigned x = (f2key(fa[i] + fb[j]) & ~63u) | (unsigned)(63 - code); const int p0 = (i + 1) * (j + 1) - 1;
#pragma unroll
                  for (int p = 15; p > p0; --p) R[p] = umaxu(R[p], uminu(R[p - 1], x));
                  R[p0] = umaxu(R[p0], x); ++code; } } } }
        if ((lane & 7) == 0) {
#pragma unroll
            for (int k = 0; k < 16; ++k) *(LAS unsigned*)(WL + 256 + ((lane >> 3) * 16 + k) * 4) = R[k]; }
        LDS_WAIT();
#pragma unroll
        for (int half = 0; half < 2; ++half) { const int e = lane + 64 * half, hd = e >> 4;
            const unsigned rk = *(const LAS unsigned*)(WL + 256 + e * 4); const int ij = TAB[63 - (int)(rk & 63u)];
            const int idx0 = WL[(2 * hd) * 16 + (ij >> 4)], idx1 = WL[(2 * hd + 1) * 16 + (ij & 15)];
            const float scv = key2f(rk & ~63u);
            float mx = scv; mx = fmaxf(mx, dppf<0xB1>(mx)); mx = fmaxf(mx, dppf<0x4E>(mx)); mx = fmaxf(mx, dppf<0x141>(mx)); mx = fmaxf(mx, dppf<0x140>(mx));
            const float ev = fast_exp(scv - mx); const float den = rowsum16(ev);
            exl[(size_t)m * 128 + e] = (unsigned short)(idx0 * 128 + idx1); gl[(size_t)m * 128 + e] = ev * fast_rcp(den); }
        LDS_WAIT();
    }
}
__device__ __forceinline__ void p9_upass(Frame& F) {
    const int lane = F.lane, wave = F.wave, x = F.bid & 7, r = F.bid >> 3, nr = F.G >> 3, g = lane >> 3, q = lane & 7;
    LAS unsigned short* EXW = (LAS unsigned short*)(F.lds + wave * 256);
    const unsigned* exl32 = (const unsigned*)(F.ws + WS_EXL); const bf16* hx2 = (const bf16*)(F.ws + WS_HX);
    const unsigned char* U = F.ws + WS_U + 128 * x + 16 * q; float* part = (float*)(F.ws + WS_PART) + (size_t)x * MX * 128;
    for (int m = r + nr * wave; m < MX; m += nr * NWAVES) {
        *(LAS unsigned*)(EXW + 2 * lane) = exl32[(size_t)m * 64 + lane];
        const v4u h0 = *(const v4u*)(hx2 + (size_t)m * D + 128 * x + 16 * q), h1 = *(const v4u*)(hx2 + (size_t)m * D + 128 * x + 16 * q + 8);
        float hf[16];
        hf[0] = bf_lo(h0.x); hf[1] = bf_hi(h0.x); hf[2] = bf_lo(h0.y); hf[3] = bf_hi(h0.y); hf[4] = bf_lo(h0.z); hf[5] = bf_hi(h0.z); hf[6] = bf_lo(h0.w); hf[7] = bf_hi(h0.w);
        hf[8] = bf_lo(h1.x); hf[9] = bf_hi(h1.x); hf[10] = bf_lo(h1.y); hf[11] = bf_hi(h1.y); hf[12] = bf_lo(h1.z); hf[13] = bf_hi(h1.z); hf[14] = bf_lo(h1.w); hf[15] = bf_hi(h1.w);
        LDS_WAIT();
        float keep[2];
#pragma unroll
        for (int j = 0; j < 2; ++j) {
            float kp = 0.f;
            v4u uu[8];
#pragma unroll
            for (int i = 0; i < 8; ++i) { const unsigned ex = EXW[64 * j + 8 * i + g]; uu[i] = *(const v4u*)(U + (size_t)ex * 1024); }
#pragma unroll
            for (int i = 0; i < 8; ++i) { float p = 0.f;
#pragma unroll
                for (int w = 0; w < 4; ++w) { const f32x2 lo = __builtin_amdgcn_cvt_pk_f32_fp8((int)uu[i][w], false), hi = __builtin_amdgcn_cvt_pk_f32_fp8((int)uu[i][w], true);
                    p += lo.x * hf[4 * w] + lo.y * hf[4 * w + 1] + hi.x * hf[4 * w + 2] + hi.y * hf[4 * w + 3]; }
                p += dppf<0xB1>(p); p += dppf<0x4E>(p); p += dppf<0x141>(p);
                kp = (q == i) ? p : kp; }
            keep[j] = kp * (1.f / 32.f);
        }
        part[(size_t)m * 128 + 8 * q + g] = keep[0]; part[(size_t)m * 128 + 64 + 8 * q + g] = keep[1];
        LDS_WAIT();
    }
}
__device__ __forceinline__ void p10_combine(Frame& F) {
    const float* __restrict__ part = (const float*)(F.ws + WS_PART); const float* __restrict__ gl = (const float*)(F.ws + WS_GL);
    const unsigned short* __restrict__ exl = (const unsigned short*)(F.ws + WS_EXL); unsigned* __restrict__ plt = (unsigned*)(F.ws + WS_PL);
    LAS unsigned* TL = (LAS unsigned*)F.lds;
    for (int unit = F.bid; unit < MX / 64; unit += F.G) {
        const int m0 = unit * 64;
        __syncthreads();
#pragma unroll 4
        for (int i = 0; i < 16; ++i) { const int idx = F.tid + 512 * i, ml = idx >> 7, k = idx & 127; const size_t gi = (size_t)(m0 + ml) * 128 + k;
            float s = part[gi];
#pragma unroll
            for (int x = 1; x < 8; ++x) s += part[(size_t)x * MX * 128 + gi];
            TL[k * 65 + ml] = (unsigned)exl[gi] | ((unsigned)__builtin_bit_cast(unsigned short, (_Float16)(gl[gi] * gelu_erf(s))) << 16); }
        __syncthreads();
#pragma unroll 4
        for (int i = 0; i < 16; ++i) { const int idx = F.tid + 512 * i, k = idx >> 6, ml = idx & 63; plt[(size_t)k * MX + m0 + ml] = TL[k * 65 + ml]; }
    }
}
typedef _Float16 h2_t __attribute__((ext_vector_type(2)));
typedef _Float16 h4_t __attribute__((ext_vector_type(4)));
template <int MODE> __device__ __forceinline__ void p11_vpass(Frame& F) {
    const int lane = F.lane, wave = F.wave;
    const unsigned* __restrict__ plt = (const unsigned*)(F.ws + WS_PL); float* __restrict__ po = (float*)(F.ws + WS_PO);
    for (int cg = F.bid; cg < 256; cg += F.G) {
        const int c0 = 128 * (cg & 7) + 4 * (cg >> 3);
        __syncthreads();
        for (int e = F.tid; e < NEXP; e += 512) { const f32x4 vv = *(const f32x4*)(F.in[I_PV] + (size_t)e * D + c0);
            const h2_t a = {(_Float16)vv.x, (_Float16)vv.y}, b = {(_Float16)vv.z, (_Float16)vv.w};
            *(LAS v2u*)(F.lds + e * 8) = (v2u){__builtin_bit_cast(unsigned, a), __builtin_bit_cast(unsigned, b)}; }
        __syncthreads();
        for (int mg = wave; mg < MX / 64; mg += NWAVES) {
            const unsigned* __restrict__ pg = plt + mg * 64;
            f32x4 acc = (f32x4){0.f, 0.f, 0.f, 0.f};
#pragma unroll 2
            for (int k0 = 0; k0 < 128; k0 += 8) {
                unsigned p[8];
#pragma unroll
                for (int i = 0; i < 8; ++i) p[i] = pg[(size_t)(k0 + i) * MX + lane];
                h2_t a01 = {(_Float16)0.f, (_Float16)0.f}, a23 = a01;
#pragma unroll
                for (int i = 0; i < 8; ++i) { const h4_t hv = *(const LAS h4_t*)(unsigned)((p[i] & 0xffffu) << 3);
                    const _Float16 cf = __builtin_bit_cast(_Float16, (unsigned short)(p[i] >> 16)); const h2_t c2 = {cf, cf};
                    a01 = __builtin_shufflevector(hv, hv, 0, 1) * c2 + a01; a23 = __builtin_shufflevector(hv, hv, 2, 3) * c2 + a23; }
                acc.x += (float)a01.x; acc.y += (float)a01.y; acc.z += (float)a23.x; acc.w += (float)a23.y;
            }
            *(f32x4*)(po + (size_t)(mg * 64 + lane) * D + c0) = acc;
        }
    }
}
__device__ __forceinline__ void p12_final(Frame& F) {
    const float* mod = (const float*)(F.ws + WS_MOD); const float* ng3 = F.in[I_NG] + 3 * D; const float* po = (const float*)(F.ws + WS_PO);
    for (int m = F.bid * NWAVES + F.wave; m < MX; m += F.G * NWAVES) {
        const float* gt2 = mod + (m >> 12) * NMOD + 5 * D;
        f32x4 v[4]; float ss = 0.f;
#pragma unroll
        for (int j = 0; j < 4; ++j) { v[j] = *(const f32x4*)(po + (size_t)m * D + j * 256 + F.lane * 4); ss += v[j].x * v[j].x + v[j].y * v[j].y + v[j].z * v[j].z + v[j].w * v[j].w; }
        const float rstd = __builtin_amdgcn_rsqf(wave_sum(ss) * (1.f / D) + NORM_EPS);
#pragma unroll
        for (int j = 0; j < 4; ++j) { const int c = j * 256 + F.lane * 4; float* op = F.out + (size_t)m * D + c;
            const f32x4 x1 = *(const f32x4*)op, g = *(const f32x4*)(ng3 + c), gt = *(const f32x4*)(gt2 + c);
            *(f32x4*)op = x1 + gt * (v[j] * rstd * g); }
    }
}
struct Args { const float* in[25]; float* out; unsigned char* ws; int ph_lo, ph_hi; };
__global__ void __launch_bounds__(NWAVES * 64, 2) mk_fwd(Args args) {
    extern __shared__ __attribute__((aligned(16))) unsigned char lds_raw[];
    Frame F;
    F.lds = (LAS unsigned char*)lds_raw;
    F.MISC = (volatile LAS unsigned*)(F.lds + MISC_OFF);
    F.tid = threadIdx.x; F.lane = F.tid & 63; F.wave = __builtin_amdgcn_readfirstlane(F.tid >> 6);
    F.G = gridDim.x; F.bid = blockIdx.x;
#pragma unroll
    for (int i = 0; i < 25; ++i) F.in[i] = args.in[i];
    F.out = args.out; F.ws = args.ws; F.ctl = (gu32*)(args.ws + WS_CTL);
    for (int u = F.tid; u < (LDS_BYTES - LDSCTL_OFF) / 4; u += NWAVES * 64) ((LAS unsigned*)(F.lds + LDSCTL_OFF))[u] = 0u;
    __syncthreads();
    const int lo = args.ph_lo, hi = args.ph_hi;
    XcdBarrier bar; bar.bar = (unsigned*)(F.ctl + CW_BAR); bar.x = 0; bar.st = nullptr;
    if (hi - lo > 1) bar = xcd_barrier_post((unsigned*)(F.ctl + CW_BAR), F.MISC + 8);
#ifndef PROBE_LO
#define PROBE_LO -1
#define PROBE_HI -1
#endif
#define IN(k) (lo <= (k) && (k) < hi)
#define SEAM(k) do { if (IN(k) && IN((k) + 1)) xcd_barrier(bar); } while (0)
#define PH0 { p0_prep(F); }
#define PH1 { p1_hx(F); }
#define PH2 { pg8::Gemm g{(const pg8::bf16_t*)(F.ws + WS_HX), (const pg8::bf16_t*)(F.ws + WS_WINT), MA, NPROJ_PAD, D}; pg8::StaticOrder S; S.init(MA, NPROJ_PAD, F.G, F.bid); \
        pg8::EpiProj E{(pg8::bf16_t*)(F.ws + WS_PROJ), NPROJ, NPROJ}; \
        pg8::gemm_phase<pg8::EpiProj, pg8::StaticOrder, PG8_ALIGN, PG8_SP2>(F.lds, g, S, E); }
#define PH3 { p3_scan<0>(F, bar); }
#define PH4 { p4_mix(F); }
#define PH5 { pg8::Gemm g{(const pg8::bf16_t*)(F.ws + WS_HX), (const pg8::bf16_t*)(F.ws + WS_WOUTT), MX, D, D}; pg8::StaticOrder S; S.init(MX, D, F.G, F.bid); \
        pg8::EpiF32 E{(float*)(F.ws + WS_PROJ), D}; \
        pg8::gemm_phase<pg8::EpiF32, pg8::StaticOrder, PG8_ALIGN, PG8_SP2>(F.lds, g, S, E); }
#define PH6 { p6_mid(F); }
#define PH7 { pg8::Gemm g{(const pg8::bf16_t*)(F.ws + WS_HX), (const pg8::bf16_t*)(F.ws + WS_WEFFT), MX, NSC, D}; pg8::StaticOrder S; S.init(MX, NSC, F.G, F.bid); \
        pg8::EpiF32 E{(float*)(F.ws + WS_PROJ), NSC}; \
        pg8::gemm_phase<pg8::EpiF32, pg8::StaticOrder, PG8_ALIGN, PG8_SP2>(F.lds, g, S, E); }
#define PH8 { p8a_route(F); }
#define PH9 { p9_upass(F); }
#define PH10 { p10_combine(F); }
#define PH11 { p11_vpass<0>(F); }
#define PH12 { p12_final(F); }
#define PRB(k, body) if constexpr (PROBE_LO <= (k) && (k) <= PROBE_HI) { xcd_barrier(bar); body }
    if (IN(0)) PH0 PRB(0, PH0) SEAM(0);
    if (IN(1)) PH1 PRB(1, PH1) SEAM(1);
    if (IN(2)) PH2 PRB(2, PH2) SEAM(2);
    if (IN(3)) PH3 PRB(3, PH3) SEAM(3);
    if (IN(4)) PH4 PRB(4, PH4) SEAM(4);
    if (IN(5)) PH5 PRB(5, PH5) SEAM(5);
    if (IN(6)) PH6 PRB(6, PH6) SEAM(6);
    if (IN(7)) PH7 PRB(7, PH7) SEAM(7);
    if (IN(8)) PH8 PRB(8, PH8) SEAM(8);
    if (IN(9)) PH9 PRB(9, PH9) SEAM(9);
    if (IN(10)) PH10 PRB(10, PH10) SEAM(10);
    if constexpr (PROBE_LO == 111) { p11_vpass<1>(F); xcd_barrier(bar); }
    if constexpr (PROBE_LO == 112) { p11_vpass<2>(F); xcd_barrier(bar); }
    if (IN(11)) PH11 PRB(11, PH11) SEAM(11);
    if (IN(12)) PH12
#undef IN
#undef SEAM
}

extern "C" void kernel_launch(void* const* d_in, const int* in_sizes, int n_in, void* d_out, int out_size, void* d_ws, size_t ws_size, hipStream_t stream) {
    static int grid = 0;
    if (grid == 0) {
        if (n_in != 25 || in_sizes[0] != MX * D || out_size != MX * D || ws_size < WS_END) { fprintf(stderr, "kernel_launch: unexpected problem (n_in %d, in0 %d, out %d, ws %zu); nothing launched\n", n_in, n_in > 0 ? in_sizes[0] : -1, out_size, ws_size); grid = -1; return; }
        int dev = 0, cus = 0, per_cu = 0;
        if (hipGetDevice(&dev) != hipSuccess || hipDeviceGetAttribute(&cus, hipDeviceAttributeMultiprocessorCount, dev) != hipSuccess) { fprintf(stderr, "kernel_launch: device query failed\n"); grid = -1; return; }
        if (hipFuncSetAttribute((const void*)mk_fwd, hipFuncAttributeMaxDynamicSharedMemorySize, LDS_BYTES) != hipSuccess) { fprintf(stderr, "kernel_launch: hipFuncSetAttribute failed\n"); grid = -1; return; }
        if (hipOccupancyMaxActiveBlocksPerMultiprocessor(&per_cu, (const void*)mk_fwd, NWAVES * 64, LDS_BYTES) != hipSuccess || per_cu < 1) fprintf(stderr, "kernel_launch: occupancy query reports %d workgroups per CU\n", per_cu);
        (void)hipGetLastError();
        grid = cus;
    }
    if (grid < 0) return;
    if (hipMemsetAsync((char*)d_ws + WS_CTL, 0, CTL_ZERO_BYTES, stream) != hipSuccess) { fprintf(stderr, "kernel_launch: memset failed\n"); return; }
    Args a{};
    for (int i = 0; i < 25; ++i) a.in[i] = (const float*)d_in[i];
    a.out = (float*)d_out; a.ws = (unsigned char*)d_ws;
    if (MK_N_LAUNCHES == 1) { a.ph_lo = 0; a.ph_hi = NPH; hipLaunchKernelGGL(mk_fwd, dim3(grid), dim3(NWAVES * 64), LDS_BYTES, stream, a); }
    else for (int p = 0; p < NPH; ++p) { a.ph_lo = p; a.ph_hi = p + 1; hipLaunchKernelGGL(mk_fwd, dim3(grid), dim3(NWAVES * 64), LDS_BYTES, stream, a); }
    const hipError_t le = hipPeekAtLastError();
    if (le != hipSuccess) fprintf(stderr, "kernel_launch: launch failed: %s\n", hipGetErrorName(le));
}
```

```cpp
#include <hip/hip_runtime.h>
#include <cstdio>
#include <cstdint>
namespace pg8 {
#define PG8_LAS __attribute__((address_space(3)))
typedef unsigned short bf16_t;
typedef short bf16x8 __attribute__((ext_vector_type(8)));
typedef float f32x4 __attribute__((ext_vector_type(4)));
typedef unsigned u32x4 __attribute__((ext_vector_type(4)));
constexpr int BM = 256, BK = 64, HALF = 128, HTB = HALF * BK * 2  , STAGE_BYTES = 8 * HTB, NXCD = 8, WGM = 8;

__host__ __device__ __forceinline__ int lds_byte(int r, int c) { const int st = (r >> 4) * 2 + (c >> 5), rr = r & 15, cc = c & 31, ob = rr * 64 + cc * 2; return st * 1024 + (ob ^ (((ob >> 9) & 1) << 5)); }
__host__ __device__ __forceinline__ void stage_rc(int b, int& R, int& C) { const int st = b / 1024, sb = b % 1024, swz = sb ^ (((sb >> 9) & 1) << 5); R = (st >> 1) * 16 + swz / 64; C = (st & 1) * 32 + (swz % 64) / 2; }
__host__ __device__ __forceinline__ int perm32(int rho) { const int n = rho >> 4, i = rho & 15; return 8 * (i >> 2) + 4 * n + (i & 3); }

struct Unit { int pm, pn; };
struct Gemm { const bf16_t* A; const bf16_t* Bt; int M, N, K; };

struct StaticOrder {
    int nM, nN, nwg, G, c;
    __host__ __device__ void init(int M, int N, int G_, int c_) { nM = M / BM; nN = N / BM; nwg = nM * nN; G = G_; c = c_; }
    __host__ __device__ bool next(int i, Unit& u) const {
        const long L = (long)i * G + c; if (L >= nwg) return false;
        int wgid = (int)L; { const int q = nwg / NXCD, r = nwg % NXCD, xcd = wgid % NXCD, off = wgid / NXCD; wgid = (xcd < r ? xcd * (q + 1) : r * (q + 1) + (xcd - r) * q) + off; }
        const int nig = WGM * nN, gid = wgid / nig, fm = gid * WGM, gsz = (nM - fm) < WGM ? (nM - fm) : WGM;
        u.pm = fm + ((wgid % nig) % gsz); u.pn = (wgid % nig) / gsz; return true;
    }
    __device__ __forceinline__ void a_ready(const Unit&) const {}
    __device__ __forceinline__ void done(const Unit&) const {}
};

__device__ __forceinline__ unsigned cvt_pk_bf16(float lo, float hi) { unsigned r; asm volatile("v_cvt_pk_bf16_f32 %0, %1, %2" : "=v"(r) : "v"(lo), "v"(hi)); return r; }
typedef float f32x2 __attribute__((ext_vector_type(2)));
__device__ __forceinline__ f32x2 gelu_pk(f32x2 v) {
    const f32x2 av = __builtin_elementwise_abs(v), d = av * 0.2316418882f + 1.0f;
    f32x2 t; t.x = __builtin_amdgcn_rcpf(d.x); t.y = __builtin_amdgcn_rcpf(d.y);
    f32x2 q = t * 0.5307027145f + (-0.7265760135f); q = q * t + 0.7107068705f; q = q * t + (-0.142248368f); q = q * t + 0.127414796f; q = q * t;
    const f32x2 s = (v * v) * (-0.72134752044f);
    f32x2 e; e.x = __builtin_amdgcn_exp2f(s.x); e.y = __builtin_amdgcn_exp2f(s.y);
    const f32x2 m = v * (q * e), r = v - m;
    f32x2 o; o.x = v.x < 0.f ? m.x : r.x; o.y = v.y < 0.f ? m.y : r.y; return o;
}

template <int ACT  > struct EpiBf16 {
    static constexpr bool PERM = true, AFTER_DRAIN = false; static_assert(ACT == 0 || ACT == 1, "EpiBf16: ACT is 0 (none) or 1 (gelu_pk)");
    bf16_t* O; int ldc; const float* bias; int split_cols; size_t split_stride; float scale0;
    __device__ __forceinline__ void operator()(const f32x4 (&acc)[2][2][4][2], const Unit& u, int wr, int wc, int fr, int fq) const {
        const int row0 = u.pm * BM + wr * 64 + fr; int colt = u.pn * BM; bf16_t* base = O;
        float sc = 1.f; if (split_cols) { const int t = colt / split_cols; base += (size_t)t * split_stride; colt -= t * split_cols; if (t == 0) sc = scale0; }
        const int col0 = colt + wc * 32 + 8 * fq, bcol0 = u.pn * BM + wc * 32 + 8 * fq;
        f32x4 bv[2][2];
#pragma unroll
        for (int bj = 0; bj < 2; ++bj)
#pragma unroll
            for (int n = 0; n < 2; ++n) bv[bj][n] = bias ? *(const f32x4*)(bias + bcol0 + bj * HALF + 4 * n) : (f32x4){0.f, 0.f, 0.f, 0.f};
#pragma unroll
        for (int ai = 0; ai < 2; ++ai)
#pragma unroll
            for (int m = 0; m < 4; ++m) { bf16_t* rowp = base + (size_t)(row0 + ai * HALF + m * 16) * ldc + col0;
#pragma unroll
                for (int bj = 0; bj < 2; ++bj) { f32x4 v0 = acc[ai][bj][m][0] + bv[bj][0], v1 = acc[ai][bj][m][1] + bv[bj][1];
                    if (ACT == 1) { f32x2 a = gelu_pk((f32x2){v0[0], v0[1]}), b = gelu_pk((f32x2){v0[2], v0[3]}), c = gelu_pk((f32x2){v1[0], v1[1]}), d = gelu_pk((f32x2){v1[2], v1[3]});
                        v0 = (f32x4){a.x, a.y, b.x, b.y}; v1 = (f32x4){c.x, c.y, d.x, d.y}; }
                    v0 = v0 * sc; v1 = v1 * sc; u32x4 w; w.x = cvt_pk_bf16(v0[0], v0[1]); w.y = cvt_pk_bf16(v0[2], v0[3]); w.z = cvt_pk_bf16(v1[0], v1[1]); w.w = cvt_pk_bf16(v1[2], v1[3]);
                    *(u32x4*)(rowp + bj * HALF) = w; } }
    }
};

struct EpiF32 {
    static constexpr bool PERM = false, AFTER_DRAIN = false;
    float* C; int ldc;
    __device__ __forceinline__ void operator()(const f32x4 (&acc)[2][2][4][2], const Unit& u, int wr, int wc, int fr, int fq) const {
        const int row0 = u.pm * BM + wr * 64 + fr, col0 = u.pn * BM + wc * 32 + 4 * fq;
#pragma unroll
        for (int ai = 0; ai < 2; ++ai)
#pragma unroll
            for (int m = 0; m < 4; ++m) { float* rowp = C + (size_t)(row0 + ai * HALF + m * 16) * ldc + col0;
#pragma unroll
                for (int bj = 0; bj < 2; ++bj)
#pragma unroll
                    for (int n = 0; n < 2; ++n) *(f32x4*)(rowp + bj * HALF + n * 16) = acc[ai][bj][m][n]; }
    }
};
struct EpiProj {
    static constexpr bool PERM = true, AFTER_DRAIN = false;
    bf16_t* O; int ldc; int ncols;
    __device__ __forceinline__ void operator()(const f32x4 (&acc)[2][2][4][2], const Unit& u, int wr, int wc, int fr, int fq) const {
        const int row0 = u.pm * BM + wr * 64 + fr; const int col0 = u.pn * BM + wc * 32 + 8 * fq;
#pragma unroll
        for (int ai = 0; ai < 2; ++ai)
#pragma unroll
            for (int m = 0; m < 4; ++m) { bf16_t* rowp = O + (size_t)(row0 + ai * HALF + m * 16) * ldc + col0;
#pragma unroll
                for (int bj = 0; bj < 2; ++bj) { const f32x4 v0 = acc[ai][bj][m][0], v1 = acc[ai][bj][m][1];
                    u32x4 w; w.x = cvt_pk_bf16(v0[0], v0[1]); w.y = cvt_pk_bf16(v0[2], v0[3]); w.z = cvt_pk_bf16(v1[0], v1[1]); w.w = cvt_pk_bf16(v1[2], v1[3]);
                    if (col0 + bj * HALF < ncols) *(u32x4*)(rowp + bj * HALF) = w; } }
    }
};
template <class Epi, class Sched, bool ALIGN_EPI = false, bool SP2 = false>
__device__ __forceinline__ void gemm_phase(PG8_LAS unsigned char* lds, const Gemm g, const Sched& S, const Epi& E) {
    const int tid = threadIdx.x, wid = __builtin_amdgcn_readfirstlane(tid >> 6), lane = tid & 63, wr = wid >> 2, wc = wid & 3, fr = lane & 15, fq = lane >> 4;
    const int K = g.K, nt = K / BK;
    unsigned voffA[2], voffB[2];
#pragma unroll
    for (int i = 0; i < 2; ++i) { int R, C; stage_rc(tid * 16 + i * 8192, R, C); const int Rb = Epi::PERM ? ((R & ~31) + perm32(R & 31)) : R;
        voffA[i] = (unsigned)(R * K + C) * 2u; voffB[i] = (unsigned)(Rb * K + C) * 2u; }
    const size_t kstep = (size_t)(BK * 2);
    const size_t hstep = (size_t)HALF * K * 2;
    const size_t tstep = 2 * hstep;
    const unsigned ldsw = (unsigned)wid * 1024u;
    const int aoff = lds_byte(wr * 64 + fr, fq * 8), boff = lds_byte(wc * 32 + fr, fq * 8);
#define PG8_SA(b, h) (((b) * 2 + (h)) * HTB)
#define PG8_SB(b, h) ((4 + (b) * 2 + (h)) * HTB)
#define PG8_STAGE(bufoff, gbase, voff) do { _Pragma("unroll") for (int _i = 0; _i < 2; ++_i) \
        __builtin_amdgcn_global_load_lds((const unsigned*)((const char*)(gbase) + (voff)[_i]), (PG8_LAS unsigned*)(lds + (bufoff) + ldsw + _i * 8192), 16, 0, 0); } while (0)
#define PG8_LDA(dst, b, h) do { _Pragma("unroll") for (int m = 0; m < 4; ++m) _Pragma("unroll") for (int k = 0; k < 2; ++k) dst[m][k] = *(const PG8_LAS bf16x8*)(lds + PG8_SA(b, h) + aoff + m * 2048 + k * 1024); } while (0)
#define PG8_LDB(dst, b, h) do { _Pragma("unroll") for (int n = 0; n < 2; ++n) _Pragma("unroll") for (int k = 0; k < 2; ++k) dst[n][k] = *(const PG8_LAS bf16x8*)(lds + PG8_SB(b, h) + boff + n * 2048 + k * 1024); } while (0)
#define PG8_MMA(ai, bj, At, Bt) do { __builtin_amdgcn_s_setprio(1); _Pragma("unroll") for (int m = 0; m < 4; ++m) _Pragma("unroll") for (int n = 0; n < 2; ++n) _Pragma("unroll") for (int k = 0; k < 2; ++k) \
        acc[ai][bj][m][n] = __builtin_amdgcn_mfma_f32_16x16x32_bf16(Bt[n][k], At[m][k], acc[ai][bj][m][n], 0, 0, 0); __builtin_amdgcn_s_setprio(0); } while (0)
#define PG8_WAIT_V(n) asm volatile("s_waitcnt vmcnt(" #n ")" ::: "memory")
#define PG8_WAIT_L(n) asm volatile("s_waitcnt lgkmcnt(" #n ")" ::: "memory")
#define PG8_BAR __builtin_amdgcn_s_barrier()
#define PG8_SCHED __builtin_amdgcn_sched_barrier(0)
    Unit cur, nxt; int ui = 0;
    if (!S.next(0, cur)) return;
    f32x4 acc[2][2][4][2];
#pragma unroll
    for (int a = 0; a < 2; ++a)
#pragma unroll
        for (int b = 0; b < 2; ++b)
#pragma unroll
            for (int m = 0; m < 4; ++m)
#pragma unroll
                for (int n = 0; n < 2; ++n) acc[a][b][m][n] = (f32x4){0.f, 0.f, 0.f, 0.f};
    bf16x8 At[4][2], B0[2][2], B1[2][2];
    const char* cA = (const char*)g.A + (size_t)cur.pm * tstep; const char* cB = (const char*)g.Bt + (size_t)cur.pn * tstep;
    S.a_ready(cur);
    if constexpr (SP2) {
        PG8_STAGE(PG8_SB(0, 0), cB, voffB); PG8_STAGE(PG8_SB(0, 1), cB + hstep, voffB); PG8_STAGE(PG8_SA(0, 0), cA, voffA); PG8_STAGE(PG8_SA(0, 1), cA + hstep, voffA);
        if (wr == 1) PG8_BAR;
        PG8_WAIT_V(2); PG8_BAR;
        PG8_STAGE(PG8_SB(1, 0), cB + kstep, voffB); PG8_STAGE(PG8_SA(1, 0), cA + kstep, voffA); PG8_STAGE(PG8_SB(1, 1), cB + hstep + kstep, voffB);
        PG8_WAIT_V(6); PG8_BAR;
    } else {
        PG8_STAGE(PG8_SB(0, 0), cB, voffB); PG8_STAGE(PG8_SA(0, 0), cA, voffA); PG8_STAGE(PG8_SB(0, 1), cB + hstep, voffB); PG8_STAGE(PG8_SA(0, 1), cA + hstep, voffA);
        if (wr == 1) PG8_BAR;
        PG8_WAIT_V(4); PG8_BAR;
        PG8_STAGE(PG8_SB(1, 0), cB + kstep, voffB); PG8_STAGE(PG8_SA(1, 0), cA + kstep, voffA); PG8_STAGE(PG8_SB(1, 1), cB + hstep + kstep, voffB);
        PG8_WAIT_V(6); PG8_BAR;
    }
    for (;;) {
        const bool has_next = S.next(ui + 1, nxt);
        const char* nA = has_next ? (const char*)g.A + (size_t)nxt.pm * tstep : cA; const char* nB = has_next ? (const char*)g.Bt + (size_t)nxt.pn * tstep : cB;
        for (int t = 0; t < nt; t += 2) {
            const bool last = (t == nt - 2);
            const char* a1 = cA + (size_t)(t + 1) * kstep;
            const char* a2 = last ? nA : cA + (size_t)(t + 2) * kstep; const char* b2 = last ? nB : cB + (size_t)(t + 2) * kstep;
            const char* a3 = a2 + kstep; const char* b3 = b2 + kstep;
            if (last && has_next) S.a_ready(nxt);
            if constexpr (SP2) {
            PG8_LDB(B0, 0, 0); PG8_LDB(B1, 0, 1); PG8_SCHED; PG8_LDA(At, 0, 0); PG8_STAGE(PG8_SA(1, 1), a1 + hstep, voffA);
            PG8_WAIT_V(8); PG8_WAIT_L(0); PG8_BAR; PG8_MMA(0, 0, At, B0); PG8_MMA(0, 1, At, B1); PG8_BAR; PG8_SCHED;
            PG8_LDA(At, 0, 1); PG8_STAGE(PG8_SB(0, 0), b2, voffB); PG8_STAGE(PG8_SB(0, 1), b2 + hstep, voffB); PG8_STAGE(PG8_SA(0, 0), a2, voffA);
            PG8_WAIT_V(8); PG8_WAIT_L(0); PG8_BAR; PG8_MMA(1, 0, At, B0); PG8_MMA(1, 1, At, B1); PG8_BAR; PG8_SCHED;
            PG8_LDB(B0, 1, 0); PG8_LDB(B1, 1, 1); PG8_SCHED; PG8_LDA(At, 1, 0); PG8_STAGE(PG8_SA(0, 1), a2 + hstep, voffA);
            PG8_WAIT_V(8); PG8_WAIT_L(0); PG8_BAR; PG8_MMA(0, 0, At, B0); PG8_MMA(0, 1, At, B1); PG8_BAR; PG8_SCHED;
            PG8_LDA(At, 1, 1); PG8_STAGE(PG8_SB(1, 0), b3, voffB); PG8_STAGE(PG8_SB(1, 1), b3 + hstep, voffB); PG8_STAGE(PG8_SA(1, 0), a3, voffA);
            PG8_WAIT_V(8); PG8_WAIT_L(0); PG8_BAR; PG8_MMA(1, 0, At, B0); PG8_MMA(1, 1, At, B1); PG8_BAR; PG8_SCHED;
            } else {
            PG8_LDB(B0, 0, 0); PG8_SCHED; PG8_LDA(At, 0, 0); PG8_STAGE(PG8_SA(1, 1), a1 + hstep, voffA);
            PG8_WAIT_L(8); PG8_BAR; PG8_WAIT_L(0); PG8_MMA(0, 0, At, B0); PG8_BAR; PG8_SCHED;
            PG8_LDB(B1, 0, 1); PG8_STAGE(PG8_SB(0, 0), b2, voffB);
            PG8_BAR; PG8_WAIT_L(0); PG8_MMA(0, 1, At, B1); PG8_BAR;
            PG8_LDA(At, 0, 1); PG8_STAGE(PG8_SA(0, 0), a2, voffA);
            PG8_BAR; PG8_WAIT_L(0); PG8_MMA(1, 0, At, B0); PG8_BAR; PG8_SCHED;
            PG8_STAGE(PG8_SB(0, 1), b2 + hstep, voffB);
            PG8_WAIT_V(6); PG8_BAR; PG8_MMA(1, 1, At, B1); PG8_BAR;
            PG8_LDB(B0, 1, 0); PG8_SCHED; PG8_LDA(At, 1, 0); PG8_STAGE(PG8_SA(0, 1), a2 + hstep, voffA);
            PG8_WAIT_L(8); PG8_BAR; PG8_WAIT_L(0); PG8_MMA(0, 0, At, B0); PG8_BAR; PG8_SCHED;
            PG8_LDB(B1, 1, 1); PG8_STAGE(PG8_SB(1, 0), b3, voffB);
            PG8_BAR; PG8_WAIT_L(0); PG8_MMA(0, 1, At, B1); PG8_BAR;
            PG8_LDA(At, 1, 1); PG8_STAGE(PG8_SA(1, 0), a3, voffA);
            PG8_BAR; PG8_WAIT_L(0); PG8_MMA(1, 0, At, B0); PG8_BAR; PG8_SCHED;
            PG8_STAGE(PG8_SB(1, 1), b3 + hstep, voffB);
            PG8_WAIT_V(6); PG8_BAR; PG8_MMA(1, 1, At, B1); PG8_BAR;
            }
        }
        if constexpr (ALIGN_EPI) { if (wr == 0) PG8_BAR; }
        if constexpr (!Epi::AFTER_DRAIN) { E(acc, cur, wr, wc, fr, fq); S.done(cur); }
        if (!has_next) break;
#pragma unroll
        for (int a = 0; a < 2; ++a)
#pragma unroll
            for (int b = 0; b < 2; ++b)
#pragma unroll
                for (int m = 0; m < 4; ++m)
#pragma unroll
                    for (int n = 0; n < 2; ++n) acc[a][b][m][n] = (f32x4){0.f, 0.f, 0.f, 0.f};
        cur = nxt; cA = nA; cB = nB; ++ui;
        if constexpr (ALIGN_EPI) { if (wr == 1) PG8_BAR; }
    }
    PG8_WAIT_V(0);
    if constexpr (!ALIGN_EPI) { if (wr == 0) PG8_BAR; }
    PG8_BAR;
    if constexpr (Epi::AFTER_DRAIN) { E.fused(acc, cur, wr, wc, fr, fq, lds, wid, lane); S.done(cur); }
#undef PG8_SA
#undef PG8_SB
#undef PG8_STAGE
#undef PG8_LDA
#undef PG8_LDB
#undef PG8_MMA
#undef PG8_WAIT_V
#undef PG8_WAIT_L
#undef PG8_BAR
#undef PG8_SCHED
}
}
#ifndef PG8_SP2
#define PG8_SP2 true
#endif
#ifndef PG8_ALIGN
#define PG8_ALIGN true
#endif
constexpr int NWAVES = 8;
constexpr int D = 1024, NB = 4, T = 4096, TC = 256;
constexpr int MX = NB * T, MC = NB * TC, MA = MX + MC;
constexpr int NPROJ = 3456, NPROJ_PAD = 3584;
constexpr int COL_XB = 0, COL_XG = 512, COL_XC = 1024, COL_R = 1536, COL_K = 2048, COL_V = 2560, COL_G = 3072, COL_LW = 3200, COL_LA = 3328;
constexpr int NMOD = 6 * D;
constexpr int NEXP = 16384, NSC = 2048;
constexpr float NORM_EPS = 1e-6f, LNX_EPS = 64e-5f;
#ifndef MK_N_LAUNCHES
#define MK_N_LAUNCHES 1
#endif
constexpr int NPH = 13;
constexpr size_t MiB = 1u << 20;
constexpr size_t WS_CTL = 0, CTL_ZERO_BYTES = 64 * 1024;
constexpr size_t WS_MOD = 3 * MiB;
constexpr size_t WS_WINT = 6 * MiB;
constexpr size_t WS_WOUTT = 13 * MiB;
constexpr size_t WS_WEFFT = 15 * MiB;
constexpr size_t WS_GWT = 19 * MiB;
constexpr size_t WS_U = 20 * MiB, WS_V = 52 * MiB;
constexpr size_t WS_HX = 84 * MiB;
constexpr size_t WS_PROJ = 118 * MiB;
constexpr size_t WS_END = 246 * MiB;
constexpr size_t WS_EXL = WS_V, WS_GL = WS_V + 4 * MiB, WS_PL = WS_V + 12 * MiB;
constexpr size_t WS_BLOB0 = WS_V, WS_BLOB1 = WS_HX;
constexpr size_t WS_PART = WS_PROJ, WS_PO = WS_PROJ + 64 * MiB;
static_assert(WS_PROJ + (size_t)MA * NPROJ * 2 <= WS_END && WS_PROJ + (size_t)MX * NSC * 4 <= WS_END && WS_HX + (size_t)MA * D * 2 <= WS_PROJ, "d_ws map");
constexpr int CW_BAR = 1024;
constexpr int RING_BYTES = 131072;
constexpr int LDSCTL_OFF = RING_BYTES, MISC_OFF = LDSCTL_OFF + 320;
constexpr int LDS_BYTES = 147456;

#define GAS __attribute__((address_space(1)))
#define LAS __attribute__((address_space(3)))
typedef unsigned short bf16;
typedef unsigned v4u __attribute__((ext_vector_type(4)));
typedef unsigned v2u __attribute__((ext_vector_type(2)));
typedef float f32x4 __attribute__((ext_vector_type(4)));
typedef float f32x2 __attribute__((ext_vector_type(2)));
typedef float f32x16 __attribute__((ext_vector_type(16)));
typedef short bf16x8 __attribute__((ext_vector_type(8)));
typedef GAS unsigned gu32;
#define RLX_AGENT __ATOMIC_RELAXED, __HIP_MEMORY_SCOPE_AGENT
#define LDS_WAIT() asm volatile("s_waitcnt lgkmcnt(0)" ::: "memory")
#define VM_WAIT() asm volatile("s_waitcnt vmcnt(0)" ::: "memory")
typedef __bf16 bf16v2 __attribute__((ext_vector_type(2)));
__device__ __forceinline__ unsigned pk2(float lo, float hi) { const f32x2 v = {lo, hi}; return __builtin_bit_cast(unsigned, __builtin_convertvector(v, bf16v2)); }
__device__ __forceinline__ float bf_lo(unsigned w) { return __builtin_bit_cast(float, w << 16); }
__device__ __forceinline__ float bf_hi(unsigned w) { return __builtin_bit_cast(float, w & 0xffff0000u); }
__device__ __forceinline__ float bf1(bf16 b) { return __builtin_bit_cast(float, (unsigned)b << 16); }
__device__ __forceinline__ float fast_exp(float x) { return __builtin_amdgcn_exp2f(x * 1.44269504089f); }
__device__ __forceinline__ float fast_rcp(float x) { return __builtin_amdgcn_rcpf(x); }
__device__ __forceinline__ float sigmoidf(float x) { return fast_rcp(1.f + fast_exp(-x)); }
__device__ __forceinline__ float tanh_fast(float x) { return 1.f - 2.f * fast_rcp(fast_exp(2.f * x) + 1.f); }
__device__ __forceinline__ float siluf(float x) { return x * sigmoidf(x); }
template <int CTRL> __device__ __forceinline__ float dppf(float x) { return __builtin_bit_cast(float, __builtin_amdgcn_update_dpp(0, __builtin_bit_cast(int, x), CTRL, 0xF, 0xF, false)); }
template <int CTRL> __device__ __forceinline__ unsigned dppu(unsigned x) { return (unsigned)__builtin_amdgcn_update_dpp(0, (int)x, CTRL, 0xF, 0xF, false); }
__device__ __forceinline__ float rowsum16(float x) { x += dppf<0xB1>(x); x += dppf<0x4E>(x); x += dppf<0x141>(x); x += dppf<0x140>(x); return x; }
__device__ __forceinline__ float wave_sum(float v) {
    v = rowsum16(v); v += __shfl_xor(v, 16); v += __shfl_xor(v, 32); return v;
}
__device__ __forceinline__ float half_sum32(float v) { v = rowsum16(v); v += __shfl_xor(v, 16); return v; }
__device__ __forceinline__ unsigned umaxu(unsigned a, unsigned b) { return a > b ? a : b; }
__device__ __forceinline__ unsigned wave_max_u32(unsigned x) {
    x = umaxu(x, dppu<0xB1>(x)); x = umaxu(x, dppu<0x4E>(x)); x = umaxu(x, dppu<0x141>(x)); x = umaxu(x, dppu<0x140>(x));
    const unsigned a = __builtin_amdgcn_readlane((int)x, 0), b = __builtin_amdgcn_readlane((int)x, 16), c = __builtin_amdgcn_readlane((int)x, 32), d = __builtin_amdgcn_readlane((int)x, 48);
    return umaxu(umaxu(a, b), umaxu(c, d));
}
__device__ __forceinline__ unsigned f2key(float f) { const unsigned u = __builtin_bit_cast(unsigned, f); return (u & 0x80000000u) ? ~u : (u | 0x80000000u); }
__device__ __forceinline__ float key2f(unsigned k) { const unsigned u = (k & 0x80000000u) ? (k ^ 0x80000000u) : ~k; return __builtin_bit_cast(float, u); }
#define XB_TMO      128
#define XB_XCNT(j)  (256  + 64 * (j))
#define XB_XSUB(j)  (1280 + 64 * (j))
#define XB_XGEN(j)  (2304 + 64 * (j))
#define XB_TOP      3328
#define XB_TOPGEN   3392
#define XCD_BAR_WORDS 3456
#define XB_SPIN_CAP (1u << 18)

__device__ __forceinline__ unsigned xb_ld(unsigned* p)              { return __hip_atomic_load(p, __ATOMIC_RELAXED, __HIP_MEMORY_SCOPE_AGENT); }
__device__ __forceinline__ unsigned xb_add(unsigned* p, unsigned v) { return __hip_atomic_fetch_add(p, v, __ATOMIC_RELAXED, __HIP_MEMORY_SCOPE_AGENT); }
__device__ __forceinline__ unsigned xb_xcc_id() { return (unsigned)__builtin_amdgcn_s_getreg((3 << 11) | 20) & 0xFu; }
#define XB_SPIN(cond, bar) do { unsigned _sp = 0; while (cond) { __builtin_amdgcn_s_sleep(1); \
    if ((++_sp & 255u) == 0u) { if (xb_ld(&(bar)[XB_TMO])) break; if (_sp > XB_SPIN_CAP) { atomicAdd(&(bar)[XB_TMO], 1u); break; } } } } while (0)

struct XcdBarrier {
    unsigned* bar; unsigned x;
    volatile LAS unsigned* st;
};

__device__ __forceinline__ XcdBarrier xcd_barrier_post(unsigned* bar, volatile LAS unsigned* st) {
    XcdBarrier b; b.bar = bar; b.x = xb_xcc_id(); b.st = st;
    if (threadIdx.x == 0) (void)xb_add(&bar[XB_XCNT(b.x)], 1u);
    return b;
}
__device__ __forceinline__ void xcd_barrier_complete(unsigned* bar, unsigned x, unsigned& nloc, unsigned& nx) {
    const unsigned G = gridDim.x * gridDim.y * gridDim.z;
    unsigned sum, cnt, mine, sp = 0u;
    for (;;) {
        sum = 0u; cnt = 0u; mine = 0u;
#pragma unroll
        for (unsigned j = 0; j < 16; ++j) { const unsigned c = xb_ld(&bar[XB_XCNT(j)]); sum += c; cnt += (c > 0u) ? 1u : 0u; mine = (j == x) ? c : mine; }
        if (sum == G) break;
        __builtin_amdgcn_s_sleep(1);
        if ((++sp & 255u) == 0u) { if (xb_ld(&bar[XB_TMO])) break; if (sp > XB_SPIN_CAP) { atomicAdd(&bar[XB_TMO], 1u); break; } }
    }
    nloc = mine > 0u ? mine : 1u; nx = cnt > 0u ? cnt : 1u;
}

__device__ __forceinline__ void xcd_barrier(const XcdBarrier& b) {
    asm volatile("s_waitcnt vmcnt(0)" ::: "memory");
    __syncthreads();
    if (threadIdx.x == 0) {
        unsigned* bar = b.bar;
        __builtin_amdgcn_s_waitcnt(0);
        unsigned nloc = b.st[0], nx = b.st[1];
        if (nloc == 0u) { xcd_barrier_complete(bar, b.x, nloc, nx); b.st[0] = nloc; b.st[1] = nx; }
        const unsigned old = xb_add(&bar[XB_XSUB(b.x)], 1u);
        const unsigned gen = old / nloc;
        if (old + 1u == (gen + 1u) * nloc) {
            __builtin_amdgcn_fence(__ATOMIC_RELEASE, "agent");
            asm volatile("s_waitcnt vmcnt(0)" ::: "memory");
            const unsigned og = xb_add(&bar[XB_TOP], 1u);
            const unsigned tg = og / nx;
            if (og + 1u == (tg + 1u) * nx) xb_add(&bar[XB_TOPGEN], 1u);
            else XB_SPIN(xb_ld(&bar[XB_TOPGEN]) == tg, bar);
            __builtin_amdgcn_fence(__ATOMIC_ACQUIRE, "agent");
            xb_add(&bar[XB_XGEN(b.x)], 1u);
            asm volatile("s_waitcnt vmcnt(0)" ::: "memory");
        } else {
            XB_SPIN(xb_ld(&bar[XB_XGEN(b.x)]) == gen, bar);
            __builtin_amdgcn_fence(__ATOMIC_ACQUIRE, "agent");
            asm volatile("s_waitcnt vmcnt(0)" ::: "memory");
        }
    }
    __syncthreads();
}
struct Frame {
    LAS unsigned char* lds;
    volatile LAS unsigned* MISC;
    gu32* ctl;
    int tid, lane, wave, G, bid;
    const float* in[25];
    float* out;
    unsigned char* ws;
};
enum { I_X = 0, I_C, I_CTX, I_CCTX, I_WMOD, I_BMOD, I_NG, I_WIN, I_WOUT, I_CONVW, I_TMU, I_DW0, I_DW2, I_A0, I_A2, I_GW2, I_KK, I_KA, I_RK, I_LNG, I_LNB, I_WQ, I_SUBK, I_PU, I_PV };

__device__ __forceinline__ void p0_transpose_item(const float* W, int K, int N, bf16* WT, LAS float* scr, int item, int lane) {
    const int nblk = N / 32, kb = item / nblk, nb = item % nblk, k0 = 64 * kb, n0 = 32 * nb;
#pragma unroll 8
    for (int i = 0; i < 32; ++i) { const int kk = 2 * i + (lane >> 5); scr[kk * 33 + (lane & 31)] = W[(size_t)(k0 + kk) * N + n0 + (lane & 31)]; }
    LDS_WAIT(); asm volatile("" ::: "memory");
    const int c = lane & 7;
#pragma unroll
    for (int j = 0; j < 4; ++j) { const int n = (lane >> 3) + 8 * j; const LAS float* s = scr + (8 * c) * 33 + n;
        v4u o; o.x = pk2(s[0 * 33], s[1 * 33]); o.y = pk2(s[2 * 33], s[3 * 33]); o.z = pk2(s[4 * 33], s[5 * 33]); o.w = pk2(s[6 * 33], s[7 * 33]);
        *(v4u*)(WT + (size_t)(n0 + n) * K + k0 + 8 * c) = o; }
    LDS_WAIT(); asm volatile("" ::: "memory");
}
__device__ __forceinline__ void p0_mod_item(Frame& F, int cb) {
    LAS float* S = (LAS float*)F.lds;
    LAS float* RED = (LAS float*)(F.lds + 32768);
    const float* c = F.in[I_C]; const float* cc = F.in[I_CCTX];
    for (int i = F.tid; i < 5 * D; i += 512) { const int r = i >> 10, k = i & 1023; const float v = (r < 4) ? c[r * D + k] : cc[k]; S[i] = siluf(v); }
    __syncthreads();
    const int col = F.tid & 63, kg = F.tid >> 6;
    const float* wp = F.in[I_WMOD] + (size_t)(kg * 128) * NMOD + cb * 64 + col;
    float a0 = 0.f, a1 = 0.f, a2 = 0.f, a3 = 0.f, a4 = 0.f;
#pragma unroll 8
    for (int k = 0; k < 128; ++k) { const float w = wp[(size_t)k * NMOD]; const int kk = kg * 128 + k;
        a0 += S[kk] * w; a1 += S[D + kk] * w; a2 += S[2 * D + kk] * w; a3 += S[3 * D + kk] * w; a4 += S[4 * D + kk] * w; }
    RED[(kg * 5 + 0) * 64 + col] = a0; RED[(kg * 5 + 1) * 64 + col] = a1; RED[(kg * 5 + 2) * 64 + col] = a2; RED[(kg * 5 + 3) * 64 + col] = a3; RED[(kg * 5 + 4) * 64 + col] = a4;
    __syncthreads();
    if (F.tid < 320) { const int r = F.tid >> 6, cl = F.tid & 63; float s = F.in[I_BMOD][cb * 64 + cl];
#pragma unroll
        for (int g = 0; g < 8; ++g) s += RED[(g * 5 + r) * 64 + cl];
        ((float*)(F.ws + WS_MOD))[r * NMOD + cb * 64 + cl] = s; }
    __syncthreads();
}
__device__ __forceinline__ void p0_weff_item(Frame& F, int item) {
    const int hs = item >> 4, kb = item & 15;
    LAS float* SK = (LAS float*)F.lds;
    LAS float* WQ = (LAS float*)(F.lds + 128 * 132 * 4);
    const float* sk = F.in[I_SUBK] + (size_t)hs * 128 * 128;
    const float* wq = F.in[I_WQ] + (size_t)(kb * 64) * 2048 + hs * 128;
#pragma unroll
    for (int i = 0; i < 8; ++i) { const int idx = F.tid + 512 * i, row = idx >> 5, c4 = idx & 31; const f32x4 v = *(const f32x4*)(sk + row * 128 + c4 * 4); *(LAS f32x4*)(SK + row * 132 + c4 * 4) = v; }
#pragma unroll
    for (int i = 0; i < 4; ++i) { const int idx = F.tid + 512 * i, row = idx >> 5, c4 = idx & 31; const f32x4 v = *(const f32x4*)(wq + (size_t)row * 2048 + c4 * 4); *(LAS f32x4*)(WQ + row * 132 + c4 * 4) = v; }
    __syncthreads();
    const int key = F.tid >> 2, kq = F.tid & 3;
    float acc[16];
#pragma unroll
    for (int i = 0; i < 16; ++i) acc[i] = 0.f;
    for (int d = 0; d < 128; d += 4) {
        const f32x4 a = *(const LAS f32x4*)(SK + key * 132 + d);
#pragma unroll
        for (int i = 0; i < 16; ++i) { const f32x4 b = *(const LAS f32x4*)(WQ + (4 * i + kq) * 132 + d); acc[i] += a.x * b.x + a.y * b.y + a.z * b.z + a.w * b.w; }
    }
    bf16* dst = (bf16*)(F.ws + WS_WEFFT) + (size_t)(hs * 128 + key) * D + kb * 64;
#pragma unroll
    for (int i = 0; i < 16; ++i) dst[4 * i + kq] = (bf16)(pk2(acc[i], 0.f) & 0xffffu);
    __syncthreads();
}
__device__ __forceinline__ void p0_prep(Frame& F) {
    for (int it = F.bid; it < 96 + 256; it += F.G) { if (it < 96) p0_mod_item(F, it); else p0_weff_item(F, it - 96); }
    LAS float* scr = (LAS float*)(F.lds + F.wave * 16384);
    const int gw = F.bid * NWAVES + F.wave, NGW = F.G * NWAVES;
    constexpr int I_IN = (D / 64) * (NPROJ / 32), I_OUT = (D / 64) * (D / 32), I_GW = (128 / 64) * (512 / 32);
    for (int it = gw; it < I_IN + I_OUT + I_GW; it += NGW) {
        if (it < I_IN) p0_transpose_item(F.in[I_WIN], D, NPROJ, (bf16*)(F.ws + WS_WINT), scr, it, F.lane);
        else if (it < I_IN + I_OUT) p0_transpose_item(F.in[I_WOUT], D, D, (bf16*)(F.ws + WS_WOUTT), scr, it - I_IN, F.lane);
        else p0_transpose_item(F.in[I_GW2], 128, 512, (bf16*)(F.ws + WS_GWT), scr, it - I_IN - I_OUT, F.lane);
    }
    { v4u* z = (v4u*)((bf16*)(F.ws + WS_WINT) + (size_t)NPROJ * D); const int n16 = (NPROJ_PAD - NPROJ) * D * 2 / 16;
      for (int i = F.bid * 512 + F.tid; i < n16; i += F.G * 512) z[i] = (v4u){0u, 0u, 0u, 0u}; }
    { const f32x4* pu = (const f32x4*)F.in[I_PU]; v2u* du = (v2u*)(F.ws + WS_U);
      const int n8 = NEXP * D / 8;
      for (int i = F.bid * 512 + F.tid; i < n8; i += F.G * 512) {
          const f32x4 a0 = pu[2 * i] * 32.f, a1 = pu[2 * i + 1] * 32.f;
          int w0 = __builtin_amdgcn_cvt_pk_fp8_f32(a0.x, a0.y, 0, false); w0 = __builtin_amdgcn_cvt_pk_fp8_f32(a0.z, a0.w, w0, true);
          int w1 = __builtin_amdgcn_cvt_pk_fp8_f32(a1.x, a1.y, 0, false); w1 = __builtin_amdgcn_cvt_pk_fp8_f32(a1.z, a1.w, w1, true);
          du[i] = (v2u){(unsigned)w0, (unsigned)w1}; } }
}

__device__ __forceinline__ void p1_hx(Frame& F) {
    const float* mod = (const float*)(F.ws + WS_MOD); const float* ng = F.in[I_NG];
    bf16* hx = (bf16*)(F.ws + WS_HX);
    for (int m = F.bid * NWAVES + F.wave; m < MA; m += F.G * NWAVES) {
        const float* src = (m < MX) ? F.in[I_X] + (size_t)m * D : F.in[I_CTX] + (size_t)(m - MX) * D;
        const float* mr = mod + ((m < MX) ? (m >> 12) : 4) * NMOD;
        f32x4 v[4]; float ss = 0.f;
#pragma unroll
        for (int j = 0; j < 4; ++j) { v[j] = *(const f32x4*)(src + j * 256 + F.lane * 4); ss += v[j].x * v[j].x + v[j].y * v[j].y + v[j].z * v[j].z + v[j].w * v[j].w; }
        const float rstd = __builtin_amdgcn_rsqf(wave_sum(ss) * (1.f / D) + NORM_EPS);
#pragma unroll
        for (int j = 0; j < 4; ++j) { const int c = j * 256 + F.lane * 4;
            const f32x4 g = *(const f32x4*)(ng + c), sh = *(const f32x4*)(mr + c), sc = *(const f32x4*)(mr + D + c);
            const float o0 = v[j].x * rstd * g.x * (1.f + sc.x) + sh.x, o1 = v[j].y * rstd * g.y * (1.f + sc.y) + sh.y, o2 = v[j].z * rstd * g.z * (1.f + sc.z) + sh.z, o3 = v[j].w * rstd * g.w * (1.f + sc.w) + sh.w;
            *(v2u*)(hx + (size_t)m * D + c) = (v2u){pk2(o0, o1), pk2(o2, o3)}; }
    }
}
constexpr int BL_APT = 0, BL_NPT = 4608, BL_RH = 7168, BL_MKR = 11776, BL_MBR = 14336, BL_KGC = 16896, BL_BGC = 22016, BL_GC = 27136, BL_VT = 27648, BL_BYTES = 32768;
constexpr int CS_AH = 32768, CS_BH = 37376, CS_KH = 41984, CS_AHC = 46592, CS_E = 51712, CS_RAW = 59904, CS_TLW = 72960, CS_LOA = 77568, CS_W2T = 82176, CS_A2T = 91392,
              CS_LG = 100608, CS_NBA = 100608, CS_NKA = 105216, CS_TT = 107776, CS_CONST = 116992, CS_END = 119552;
constexpr int CS_RH = BL_RH, CS_KGC = BL_KGC, CS_BGC = BL_BGC, CS_VT = BL_VT, CS_GC = BL_GC, CS_APT = BL_APT, CS_NPT = BL_NPT, CS_MKR = BL_MKR, CS_MBR = BL_MBR;
constexpr int SC_NTILE = (TC + T) / 32, SC_RT = 16, SC_NROUND = (SC_NTILE + SC_RT - 1) / SC_RT;
constexpr int SC_ST = 2;
constexpr int GS_YS = 65536;
__device__ __forceinline__ void scan_issue_loads(const bf16* proj, int b, int h, int d, int tile, int tid, v4u (&rg)[3]) {
    const bool isctx = tile < TC / 32; const int L = isctx ? TC : T; const int jt = isctx ? tile : tile - TC / 32;
    const size_t rowbase = isctx ? (size_t)(MX + b * TC) : (size_t)b * T;
    const int tlo = d == 0 ? 32 * jt : L - 32 * (jt + 1);
#pragma unroll
    for (int i = 0; i < 3; ++i) {
        const int q = tid + 512 * i; v4u val = (v4u){0u, 0u, 0u, 0u};
        if (q < 816) { const int row = q / 24, rem = q - row * 24, which = rem >> 3, ch8 = rem & 7; const int tok = tlo - 1 + row;
            if (tok >= 0 && tok < L) val = *(const v4u*)(proj + (rowbase + tok) * NPROJ + COL_R + which * 512 + h * 64 + ch8 * 8); }
        else if (q < 1328) { const int q2 = q - 816, row = q2 >> 4, rem = q2 & 15, which = rem >> 3, ch8 = rem & 7; const int tok = tlo + row;
            val = *(const v4u*)(proj + (rowbase + tok) * NPROJ + (which ? COL_LA : COL_LW) + d * 64 + ch8 * 8); }
        rg[i] = val;
    }
}
__device__ __forceinline__ unsigned tanh_pk(unsigned w) { return pk2(tanh_fast(bf_lo(w)), tanh_fast(bf_hi(w))); }
__device__ __forceinline__ void scan_store_raw(LAS unsigned char* lds, int tid, const v4u (&rg)[3]) {
#pragma unroll
    for (int i = 0; i < 3; ++i) {
        const int q = tid + 512 * i;
        if (q < 816) { const int row = q / 24, rem = q - row * 24, which = rem >> 3, ch8 = rem & 7; *(LAS v4u*)(lds + CS_RAW + (which * 34 + row) * 128 + ch8 * 16) = rg[i]; }
        else if (q < 1328) { const int q2 = q - 816, row = q2 >> 4, rem = q2 & 15, which = rem >> 3, ch8 = rem & 7;
            if (which) *(LAS v4u*)(lds + CS_LOA + row * 144 + ch8 * 16) = rg[i];
            else { v4u t; t.x = tanh_pk(rg[i].x); t.y = tanh_pk(rg[i].y); t.z = tanh_pk(rg[i].z); t.w = tanh_pk(rg[i].w); *(LAS v4u*)(lds + CS_TLW + row * 144 + ch8 * 16) = t; } }
    }
}
__device__ __forceinline__ v2u pack4(f32x4 v) { return (v2u){pk2(v.x, v.y), pk2(v.z, v.w)}; }
__device__ __forceinline__ bf16 bfs(float v) { return (bf16)(pk2(v, 0.f) & 0xffffu); }
typedef v2u v2u_t;
__device__ __forceinline__ bf16x8 frag2(const LAS unsigned char* p0, const LAS unsigned char* p1) {
    const v2u a = *(const LAS v2u*)p0, b = *(const LAS v2u*)p1; const v4u w = (v4u){a.x, a.y, b.x, b.y}; return __builtin_bit_cast(bf16x8, w);
}
__device__ __forceinline__ bf16x8 frag_acc(f32x4 lo, f32x4 hi) { const v4u w = (v4u){pk2(lo.x, lo.y), pk2(lo.z, lo.w), pk2(hi.x, hi.y), pk2(hi.z, hi.w)}; return __builtin_bit_cast(bf16x8, w); }
__device__ __forceinline__ bf16x8 frag_zero() { const v4u w = (v4u){0u, 0u, 0u, 0u}; return __builtin_bit_cast(bf16x8, w); }
__device__ __forceinline__ void scan_prep_task(Frame& F, const bf16* proj, int chain, int tile, bool load_consts, bool have_next, int nchain, int ntile, v4u (&rg)[3], unsigned char* blob) {
    LAS unsigned char* lds = F.lds; const int tid = F.tid, lane = F.lane, wave = F.wave;
    const int b = chain >> 4, h = (chain >> 1) & 7, d = chain & 1, nb = nchain >> 4, nh = (nchain >> 1) & 7, nd = nchain & 1;
    if (load_consts) {
        __syncthreads();
        LAS float* C = (LAS float*)(lds + CS_CONST);
        if (tid < 384) { const int pn = tid / 192, r = tid - pn * 192, which = r >> 6, c = r & 63; C[pn * 192 + which * 64 + c] = F.in[I_TMU][(pn * 3 + which) * 512 + h * 64 + c]; }
        else if (tid < 448) { const int c = tid - 384; C[384 + c] = F.in[I_KK][h * 64 + c]; C[448 + c] = F.in[I_KA][h * 64 + c]; }
        else { const int c = tid - 448; C[512 + c] = F.in[I_DW0][d * 512 + h * 64 + c]; C[576 + c] = F.in[I_A0][d * 512 + h * 64 + c]; }
        const float* w2 = F.in[I_DW2] + (size_t)d * 64 * 512 + h * 64; const float* a2 = F.in[I_A2] + (size_t)d * 64 * 512 + h * 64;
#pragma unroll
        for (int i = 0; i < 8; ++i) { const int idx = tid + 512 * i, j = idx >> 6, c = idx & 63;
            *(LAS bf16*)(lds + CS_W2T + c * 144 + j * 2) = bfs(w2[j * 512 + c]);
            *(LAS bf16*)(lds + CS_A2T + c * 144 + j * 2) = bfs(a2[j * 512 + c]); }
    }
    {
            scan_store_raw(lds, tid, rg);
            __syncthreads();
            if (have_next) scan_issue_loads(proj, nb, nh, nd, ntile, tid, rg);
            if (wave < 4) {
                const int mat = wave >> 1, nt = wave & 1, r = lane & 31, hh = lane >> 5;
                const LAS unsigned char* Ab = lds + (mat ? CS_LOA : CS_TLW) + r * 144 + hh * 16;
                const LAS unsigned char* Bb = lds + (mat ? CS_A2T : CS_W2T) + (nt * 32 + r) * 144 + hh * 16;
                f32x16 acc;
#pragma unroll
                for (int i = 0; i < 16; ++i) acc[i] = 0.f;
#pragma unroll
                for (int ks = 0; ks < 4; ++ks) { const bf16x8 a = *(const LAS bf16x8*)(Ab + ks * 32), bb = *(const LAS bf16x8*)(Bb + ks * 32); acc = __builtin_amdgcn_mfma_f32_32x32x16_bf16(a, bb, acc, 0, 0, 0); }
                LAS float* LG = (LAS float*)(lds + CS_LG) + mat * 2048 + nt * 32 + r;
#pragma unroll
                for (int i = 0; i < 16; ++i) LG[((i & 3) + 8 * (i >> 2) + 4 * hh) * 64] = acc[i];
            }
            __syncthreads();
            const int tok = tid >> 4, cq = tid & 15, c0 = cq * 4, s = d == 0 ? tok : 31 - tok;
            f32x4 rs, vs, kd, kk, kka, ev;
            { const LAS float* C = (const LAS float*)(lds + CS_CONST);
              f32x4 xs[3];
#pragma unroll
              for (int which = 0; which < 3; ++which) {
                  const LAS unsigned char* rp = lds + CS_RAW + (which * 34 + tok) * 128 + c0 * 2;
                  const v2u p = *(const LAS v2u*)rp, x = *(const LAS v2u*)(rp + 128), n = *(const LAS v2u*)(rp + 256);
                  const f32x4 mp = *(const LAS f32x4*)(C + which * 64 + c0), mn = *(const LAS f32x4*)(C + 192 + which * 64 + c0);
                  const f32x4 xp = (f32x4){bf_lo(p.x), bf_hi(p.x), bf_lo(p.y), bf_hi(p.y)}, xc = (f32x4){bf_lo(x.x), bf_hi(x.x), bf_lo(x.y), bf_hi(x.y)}, xn = (f32x4){bf_lo(n.x), bf_hi(n.x), bf_lo(n.y), bf_hi(n.y)};
                  xs[which] = xc + mp * (xp - xc) + mn * (xn - xc); }
              const f32x4 kkc = *(const LAS f32x4*)(C + 384 + c0), kac = *(const LAS f32x4*)(C + 448 + c0), w0 = *(const LAS f32x4*)(C + 512 + c0), a0 = *(const LAS f32x4*)(C + 576 + c0);
              kk = xs[1] * kkc;
              const float ss = rowsum16(kk.x * kk.x + kk.y * kk.y + kk.z * kk.z + kk.w * kk.w);
              kk = kk * __builtin_amdgcn_rsqf(ss + 1e-12f);
              const f32x4 uw = *(const LAS f32x4*)(lds + CS_LG + (tok * 64 + c0) * 4) + w0, ua = *(const LAS f32x4*)(lds + CS_LG + 8192 + (tok * 64 + c0) * 4) + a0;
              f32x4 av;
#pragma unroll
              for (int e = 0; e < 4; ++e) { ev[e] = 0.60653066f * sigmoidf(uw[e]); av[e] = sigmoidf(ua[e]); }
              kd = xs[1] * (1.f + (av - 1.f) * kac); kka = kk * av; rs = xs[0]; vs = xs[2];
              *(LAS f32x4*)(lds + CS_E + (s * 64 + c0) * 4) = ev; }
            __syncthreads();
            { const int cb = s & 16, sl = s & 15;
              f32x4 cum = (f32x4){0.f, 0.f, 0.f, 0.f}, tot = cum;
#pragma unroll
              for (int ii = 0; ii < 16; ++ii) { const f32x4 e4 = *(const LAS f32x4*)(lds + CS_E + ((cb + ii) * 64 + c0) * 4); tot = tot + e4; if (ii <= sl) cum = cum + e4; }
              f32x4 g, gm1, gi, ge, gt;
#pragma unroll
              for (int e = 0; e < 4; ++e) { g[e] = fast_exp(-cum[e]); gm1[e] = fast_exp(ev[e] - cum[e]); gi[e] = fast_exp(cum[e]); ge[e] = fast_exp(cum[e] - tot[e]); gt[e] = fast_exp(-tot[e]); }
              const f32x4 ah = gm1 * kk, bh = kka * gi, kh = kd * gi, rh = g * rs, kg = kd * ge, bg = kka * ge;
              *(LAS v2u*)(lds + CS_AH + s * 144 + c0 * 2) = pack4(ah); *(LAS v2u*)(lds + CS_BH + s * 144 + c0 * 2) = pack4(bh);
              *(LAS v2u*)(lds + CS_KH + s * 144 + c0 * 2) = pack4(kh); *(LAS v2u*)(lds + CS_RH + s * 144 + c0 * 2) = pack4(rh);
#pragma unroll
              for (int e = 0; e < 4; ++e) { *(LAS bf16*)(lds + CS_AHC + (c0 + e) * 80 + s * 2) = bfs(ah[e]); *(LAS bf16*)(lds + CS_KGC + (c0 + e) * 80 + s * 2) = bfs(kg[e]); *(LAS bf16*)(lds + CS_BGC + (c0 + e) * 80 + s * 2) = bfs(-bg[e]); }
#pragma unroll
              for (int e = 0; e < 4; ++e) *(LAS bf16*)(lds + CS_VT + (c0 + e) * 80 + s * 2) = bfs(vs[e]);
              if (sl == 15) *(LAS f32x4*)(lds + CS_GC + ((s >> 4) * 64 + c0) * 4) = gt; }
            __syncthreads();
            if (wave < 4) {
                const int r = lane & 31, hh = lane >> 5;
                const LAS unsigned char* Ab = lds + ((wave == 0 || wave == 3) ? CS_BH : CS_KH) + r * 144 + hh * 16;
                const LAS unsigned char* Bb = lds + (wave < 2 ? CS_AH : CS_RH) + r * 144 + hh * 16;
                f32x16 acc;
#pragma unroll
                for (int i = 0; i < 16; ++i) acc[i] = 0.f;
#pragma unroll
                for (int ks = 0; ks < 4; ++ks) { const bf16x8 a = *(const LAS bf16x8*)(Ab + ks * 32), bb = *(const LAS bf16x8*)(Bb + ks * 32); acc = __builtin_amdgcn_mfma_f32_32x32x16_bf16(a, bb, acc, 0, 0, 0); }
                const int t = r;
#pragma unroll
                for (int i = 0; i < 16; ++i) { const int j = (i & 3) + 8 * (i >> 2) + 4 * hh; const bool same = (j >> 4) == (t >> 4);
                    const bool keep = same && (wave < 2 ? (j < t) : (j <= t)); acc[i] = keep ? acc[i] : 0.f; }
                if (wave == 0) {
#pragma unroll
                    for (int i = 0; i < 16; ++i) { const int j = (i & 3) + 8 * (i >> 2) + 4 * hh; *(LAS float*)(lds + CS_NBA + (t * 36 + j) * 4) = acc[i]; } }
                else if (wave == 1) {
#pragma unroll
                    for (int i = 0; i < 16; ++i) { const int j = (i & 3) + 8 * (i >> 2) + 4 * hh; *(LAS bf16*)(lds + CS_NKA + j * 80 + t * 2) = bfs(acc[i]); } }
                else { const float sg = wave == 2 ? 1.f : -1.f; const int base = wave == 2 ? CS_MKR : CS_MBR;
#pragma unroll
                    for (int q4 = 0; q4 < 4; ++q4) *(LAS v2u*)(lds + base + t * 80 + (8 * q4 + 4 * hh) * 2) = pack4((f32x4){sg * acc[4 * q4], sg * acc[4 * q4 + 1], sg * acc[4 * q4 + 2], sg * acc[4 * q4 + 3]}); }
            }
            __syncthreads();
            if (wave == 0 && lane < 32) {
                const int blk = lane >> 4, i = lane & 15;
                float Tr[16];
#pragma unroll
                for (int t = 0; t < 16; ++t) {
                    float acc = (t == i) ? 1.f : 0.f;
                    const LAS float* np = (const LAS float*)(lds + CS_NBA) + (16 * blk + t) * 36 + 16 * blk;
#pragma unroll
                    for (int j = 0; j < t; ++j) acc -= Tr[j] * np[j];
                    Tr[t] = acc;
                }
#pragma unroll
                for (int t = 0; t < 16; ++t) { *(LAS bf16*)(lds + CS_TT + (16 * blk + t) * 80 + (16 * blk + i) * 2) = bfs(Tr[t]); *(LAS bf16*)(lds + CS_TT + (16 * blk + t) * 80 + (16 * (1 - blk) + i) * 2) = (bf16)0; }
            }
            __syncthreads();
            if (wave < 3) {
                const int r = lane & 31, hh = lane >> 5;
                const LAS unsigned char* Ab = lds + (wave < 2 ? CS_AHC + (32 * wave + r) * 80 : CS_NKA + r * 80) + hh * 16;
                const LAS unsigned char* Bb = lds + CS_TT + r * 80 + hh * 16;
                f32x16 acc;
#pragma unroll
                for (int i = 0; i < 16; ++i) acc[i] = 0.f;
#pragma unroll
                for (int ks = 0; ks < 2; ++ks) { const bf16x8 a = *(const LAS bf16x8*)(Ab + ks * 32), bb = *(const LAS bf16x8*)(Bb + ks * 32); acc = __builtin_amdgcn_mfma_f32_32x32x16_bf16(a, bb, acc, 0, 0, 0); }
                const int t = r;
#pragma unroll
                for (int q4 = 0; q4 < 4; ++q4) { const v2u pk = pack4((f32x4){acc[4 * q4], acc[4 * q4 + 1], acc[4 * q4 + 2], acc[4 * q4 + 3]});
                    if (wave < 2) *(LAS v2u*)(lds + CS_APT + t * 144 + (32 * wave + 8 * q4 + 4 * hh) * 2) = pk;
                    else *(LAS v2u*)(lds + CS_NPT + t * 80 + (8 * q4 + 4 * hh) * 2) = pk; }
            }
            __syncthreads();
#pragma unroll
            for (int i = 0; i < 4; ++i) { const int idx = tid + 512 * i; *(v4u*)(blob + idx * 16) = *(const LAS v4u*)(lds + idx * 16); }
    }
}
__device__ __forceinline__ void scan_y_store(Frame& F, int chain, int tile, int t0, int tid2) {
    const int b = chain >> 4, h = (chain >> 1) & 7, d = chain & 1;
    const int jt = tile - TC / 32, tlo = d == 0 ? 32 * jt : T - 32 * (jt + 1);
    const int s2 = tid2 >> 3, part = tid2 & 7; const int tk = d == 0 ? tlo + s2 : tlo + 31 - s2;
    const LAS float* ys = (const LAS float*)(F.lds + GS_YS + ((tile - t0) & 1) * 8192) + s2 * 64 + part * 8;
    float* dst = F.out + ((size_t)(b * T + tk)) * D + d * 512 + h * 64 + part * 8;
    *(f32x4*)dst = *(const LAS f32x4*)ys; *(f32x4*)(dst + 4) = *(const LAS f32x4*)(ys + 4);
}
__device__ __forceinline__ void scan_state_round(Frame& F, int chain, int t0, int t1, const unsigned char* blobs, f32x4 (&Z)[4]) {
    LAS unsigned char* lds = F.lds; const int tid = F.tid, lane = F.lane, wave = F.wave;
    __syncthreads();
    { v4u bg[4];
#pragma unroll
      for (int i = 0; i < 4; ++i) bg[i] = *(const v4u*)(blobs + (tid + 512 * i) * 16);
#pragma unroll
      for (int i = 0; i < 4; ++i) *(LAS v4u*)(lds + (tid + 512 * i) * 16) = bg[i]; }
    __syncthreads();
    for (int tile = t0; tile < t1; ++tile) {
        const bool isctx = tile < TC / 32;
        const LAS unsigned char* bl = lds + ((tile - t0) & 1) * BL_BYTES;
        if (wave >= 4) {
            const int tid2 = tid - 256;
            if (tile + 1 < t1) { v4u bg[8];
#pragma unroll
                for (int i = 0; i < 8; ++i) bg[i] = *(const v4u*)(blobs + (size_t)(tile + 1 - t0) * BL_BYTES + (tid2 + 256 * i) * 16);
                if (tile > t0 && tile - 1 >= TC / 32) scan_y_store(F, chain, tile - 1, t0, tid2);
#pragma unroll
                for (int i = 0; i < 8; ++i) *(LAS v4u*)(lds + ((tile + 1 - t0) & 1) * BL_BYTES + (tid2 + 256 * i) * 16) = bg[i]; }
            else if (tile > t0 && tile - 1 >= TC / 32) scan_y_store(F, chain, tile - 1, t0, tid2);
        }
        if (wave < 4) {
                const int n = lane & 15, g = lane >> 4;
                const bf16x8 bvt = *(const LAS bf16x8*)(bl + BL_VT + (16 * wave + n) * 80 + g * 16);
                f32x4 U[2]; U[0] = (f32x4){0.f, 0.f, 0.f, 0.f}; U[1] = U[0];
#pragma unroll
                for (int cc = 0; cc < 2; ++cc) {
                    const int trow = 16 * cc + n;
                    const bf16x8 bz01 = frag_acc(Z[0], Z[1]), bz23 = frag_acc(Z[2], Z[3]);
                    { const LAS unsigned char* ap = bl + BL_APT + trow * 144;
                      f32x4 u = __builtin_amdgcn_mfma_f32_16x16x32_bf16(frag2(ap + (4 * g) * 2, ap + (16 + 4 * g) * 2), bz01, (f32x4){0.f, 0.f, 0.f, 0.f}, 0, 0, 0);
                      u = __builtin_amdgcn_mfma_f32_16x16x32_bf16(frag2(ap + (32 + 4 * g) * 2, ap + (48 + 4 * g) * 2), bz23, u, 0, 0, 0);
                      u = __builtin_amdgcn_mfma_f32_16x16x32_bf16(*(const LAS bf16x8*)(bl + BL_NPT + trow * 80 + g * 16), bvt, u, 0, 0, 0);
                      U[cc] = u; }
                    const bf16x8 bu = frag_acc(U[0], U[1]);
                    if (!isctx) { const LAS unsigned char* rp = bl + BL_RH + trow * 144;
                      f32x4 y = __builtin_amdgcn_mfma_f32_16x16x32_bf16(frag2(rp + (4 * g) * 2, rp + (16 + 4 * g) * 2), bz01, (f32x4){0.f, 0.f, 0.f, 0.f}, 0, 0, 0);
                      y = __builtin_amdgcn_mfma_f32_16x16x32_bf16(frag2(rp + (32 + 4 * g) * 2, rp + (48 + 4 * g) * 2), bz23, y, 0, 0, 0);
                      y = __builtin_amdgcn_mfma_f32_16x16x32_bf16(*(const LAS bf16x8*)(bl + BL_MKR + trow * 80 + g * 16), bvt, y, 0, 0, 0);
                      const LAS unsigned char* mp = bl + BL_MBR + trow * 80;
                      y = __builtin_amdgcn_mfma_f32_16x16x32_bf16(frag2(mp + (4 * g) * 2, mp + (16 + 4 * g) * 2), bu, y, 0, 0, 0);
#pragma unroll
                      for (int i = 0; i < 4; ++i) *(LAS float*)(lds + GS_YS + ((tile - t0) & 1) * 8192 + ((16 * cc + 4 * g + i) * 64 + 16 * wave + n) * 4) = y[i]; }
#pragma unroll
                    for (int kt = 0; kt < 4; ++kt) {
                        const f32x4 gc = *(const LAS f32x4*)(bl + BL_GC + (cc * 64 + 16 * kt + 4 * g) * 4);
                        bf16x8 ka = *(const LAS bf16x8*)(bl + BL_KGC + (16 * kt + n) * 80 + g * 16);
                        if ((g >> 1) != cc) ka = frag_zero();
                        const LAS unsigned char* bp = bl + BL_BGC + (16 * kt + n) * 80;
                        const v2u b0 = *(const LAS v2u*)(bp + (4 * g) * 2), b1 = *(const LAS v2u*)(bp + (16 + 4 * g) * 2);
                        const v4u bw = cc == 0 ? (v4u){b0.x, b0.y, 0u, 0u} : (v4u){0u, 0u, b1.x, b1.y};
                        f32x4 z = Z[kt] * gc;
                        z = __builtin_amdgcn_mfma_f32_16x16x32_bf16(ka, bvt, z, 0, 0, 0);
                        z = __builtin_amdgcn_mfma_f32_16x16x32_bf16(__builtin_bit_cast(bf16x8, bw), bu, z, 0, 0, 0);
                        Z[kt] = z;
                    }
                }
            }
        __syncthreads();
    }
    if (t1 - 1 >= TC / 32 && wave >= 4) scan_y_store(F, chain, t1 - 1, t0, tid - 256);
    __syncthreads();
}
template <int LEVEL> __device__ __forceinline__ void p3_scan(Frame& F, const XcdBarrier& bar) {
    const bf16* proj = (const bf16*)(F.ws + WS_PROJ);
    const bool state_role = F.bid < 64;
    f32x4 Z[4];
#pragma unroll
    for (int kt = 0; kt < 4; ++kt) Z[kt] = (f32x4){0.f, 0.f, 0.f, 0.f};
    for (int step = 0; step <= SC_NROUND; ++step) {
        if (step >= 1 && state_role) {
            const int r = step - 1, t0 = r * SC_RT, t1 = (t0 + SC_RT < SC_NTILE) ? t0 + SC_RT : SC_NTILE;
            scan_state_round(F, F.bid, t0, t1, F.ws + ((r & 1) ? WS_BLOB1 : WS_BLOB0) + (size_t)F.bid * SC_RT * BL_BYTES, Z);
        }
        if (step < SC_NROUND) {
            const int t0 = step * SC_RT, nt = (t0 + SC_RT < SC_NTILE) ? SC_RT : SC_NTILE - t0, ntask = 64 * nt;
            int k0, k1;
            if (step == 0) { k0 = (int)((long)ntask * F.bid / F.G); k1 = (int)((long)ntask * (F.bid + 1) / F.G); }
            else if (state_role) { k0 = F.bid * SC_ST; k1 = k0 + SC_ST; }
            else { const int rest = ntask - 64 * SC_ST, P = F.G - 64, p = F.bid - 64; k0 = 64 * SC_ST + (int)((long)rest * p / P); k1 = 64 * SC_ST + (int)((long)rest * (p + 1) / P); }
            unsigned char* base = F.ws + ((step & 1) ? WS_BLOB1 : WS_BLOB0);
            v4u rg[3];
            if (k0 < k1) scan_issue_loads(proj, (k0 / nt) >> 4, ((k0 / nt) >> 1) & 7, (k0 / nt) & 1, t0 + k0 % nt, F.tid, rg);
            int prev_chain = -1;
            for (int k = k0; k < k1; ++k) {
                const int chain = k / nt, tl = k % nt, kn = k + 1, nchain = kn / nt, ntl = kn % nt;
                scan_prep_task(F, proj, chain, t0 + tl, chain != prev_chain, kn < k1, nchain, t0 + ntl, rg, base + ((size_t)chain * SC_RT + tl) * BL_BYTES);
                prev_chain = chain;
            }
        }
        if (step < SC_NROUND) xcd_barrier(bar);
    }
}
constexpr int P4_SG = 0, P4_GT = 17408, P4_CST = 17408 + 64 * 1040, P4_END = P4_CST + 12 * 2048;
__device__ __forceinline__ f32x4 ldq(const LAS float* p) { return *(const LAS f32x4*)p; }
__device__ __forceinline__ void unpack8(v4u w, float (&o)[8]) { o[0] = bf_lo(w.x); o[1] = bf_hi(w.x); o[2] = bf_lo(w.y); o[3] = bf_hi(w.y); o[4] = bf_lo(w.z); o[5] = bf_hi(w.z); o[6] = bf_lo(w.w); o[7] = bf_hi(w.w); }
__device__ __forceinline__ float sum8lanes(float p) { p += dppf<0xB1>(p); p += dppf<0x4E>(p); p += dppf<0x141>(p); return p; }
__device__ __forceinline__ void p4_mix(Frame& F) {
    LAS unsigned char* lds = F.lds; const int tid = F.tid, lane = F.lane, wave = F.wave;
    const bf16* proj = (const bf16*)(F.ws + WS_PROJ); bf16* cat = (bf16*)(F.ws + WS_HX); const float* yscr = F.out; const bf16* gwt = (const bf16*)(F.ws + WS_GWT);
    LAS float* CST = (LAS float*)(lds + P4_CST);
    __syncthreads();
    for (int i = tid; i < 12 * 512; i += 512) { const int row = i >> 9, c = i & 511;
        CST[i] = row < 6 ? F.in[I_TMU][row * 512 + c] : row == 6 ? F.in[I_RK][c] : row == 7 ? F.in[I_LNG][c] : row == 8 ? F.in[I_LNB][c] : F.in[I_CONVW][(row - 9) * 512 + c]; }
    for (int unit = F.bid; unit < MX / 64; unit += F.G) {
        const size_t row0 = (size_t)unit * 64; const int tb0 = (unit * 64) & (T - 1);
        __syncthreads();
#pragma unroll
        for (int i = 0; i < 2; ++i) { const int ck = tid + 512 * i, tok = ck >> 4, j0 = (ck & 15) * 8;
            const v4u w = *(const v4u*)(proj + (row0 + tok) * NPROJ + COL_G + j0);
            v4u o; o.x = pk2(sigmoidf(bf_lo(w.x)), sigmoidf(bf_hi(w.x))); o.y = pk2(sigmoidf(bf_lo(w.y)), sigmoidf(bf_hi(w.y))); o.z = pk2(sigmoidf(bf_lo(w.z)), sigmoidf(bf_hi(w.z))); o.w = pk2(sigmoidf(bf_lo(w.w)), sigmoidf(bf_hi(w.w)));
            *(LAS v4u*)(lds + P4_SG + tok * 272 + j0 * 2) = o; }
        __syncthreads();
        { const int r = lane & 31, hh = lane >> 5;
#pragma unroll
          for (int nt = 0; nt < 2; ++nt) {
              const bf16* bp = gwt + (size_t)(64 * wave + 32 * nt + r) * 128 + hh * 8;
              bf16x8 bfr[8];
#pragma unroll
              for (int ks = 0; ks < 8; ++ks) bfr[ks] = *(const bf16x8*)(bp + ks * 16);
#pragma unroll
              for (int mt = 0; mt < 2; ++mt) {
                  f32x16 acc;
#pragma unroll
                  for (int i = 0; i < 16; ++i) acc[i] = 0.f;
#pragma unroll
                  for (int ks = 0; ks < 8; ++ks) { const bf16x8 a = *(const LAS bf16x8*)(lds + P4_SG + (32 * mt + r) * 272 + ks * 32 + hh * 16); acc = __builtin_amdgcn_mfma_f32_32x32x16_bf16(a, bfr[ks], acc, 0, 0, 0); }
#pragma unroll
                  for (int i = 0; i < 16; ++i) *(LAS bf16*)(lds + P4_GT + (32 * mt + (i & 3) + 8 * (i >> 2) + 4 * hh) * 1040 + (64 * wave + 32 * nt + r) * 2) = (bf16)(pk2(acc[i], 0.f) & 0xffffu);
              } } }
        __syncthreads();
        const int gq = tid & 63, c0 = gq * 8;
#pragma unroll 2
        for (int n = 0; n < 8; ++n) { const int t = 8 * n + (tid >> 6); const int tb = tb0 + t;
            const bf16* pr = proj + (row0 + t) * NPROJ + c0;
            float xs[3][8];
#pragma unroll
            for (int which = 0; which < 3; ++which) { const int col = COL_R + which * 512;
                float xc[8], xp[8], xn[8];
                unpack8(*(const v4u*)(pr + col), xc);
                if (tb > 0) unpack8(*(const v4u*)(pr - NPROJ + col), xp); else {
#pragma unroll
                    for (int e = 0; e < 8; ++e) xp[e] = 0.f; }
                if (tb + 1 < T) unpack8(*(const v4u*)(pr + NPROJ + col), xn); else {
#pragma unroll
                    for (int e = 0; e < 8; ++e) xn[e] = 0.f; }
                const f32x4 mp0 = ldq(CST + which * 512 + c0), mp1 = ldq(CST + which * 512 + c0 + 4), mn0 = ldq(CST + (3 + which) * 512 + c0), mn1 = ldq(CST + (3 + which) * 512 + c0 + 4);
#pragma unroll
                for (int e = 0; e < 8; ++e) { const float mp = e < 4 ? mp0[e & 3] : mp1[e & 3], mn = e < 4 ? mn0[e & 3] : mn1[e & 3]; xs[which][e] = xc[e] + mp * (xp[e] - xc[e]) + mn * (xn[e] - xc[e]); } }
            const float* yr = yscr + (row0 + t) * D + c0;
            const f32x4 ya = *(const f32x4*)yr + *(const f32x4*)(yr + 512), yb = *(const f32x4*)(yr + 4) + *(const f32x4*)(yr + 516);
            float y[8] = {ya.x, ya.y, ya.z, ya.w, yb.x, yb.y, yb.z, yb.w};
            float sm = 0.f, sb = 0.f;
            const f32x4 rk0 = ldq(CST + 6 * 512 + c0), rk1 = ldq(CST + 6 * 512 + c0 + 4);
#pragma unroll
            for (int e = 0; e < 8; ++e) { sm += y[e]; sb += xs[0][e] * xs[1][e] * (e < 4 ? rk0[e & 3] : rk1[e & 3]); }
            const float mu = sum8lanes(sm) * (1.f / 64.f); const float bon = sum8lanes(sb);
            float sv = 0.f;
#pragma unroll
            for (int e = 0; e < 8; ++e) { y[e] -= mu; sv += y[e] * y[e]; }
            const float rstd = __builtin_amdgcn_rsqf(sum8lanes(sv) * (1.f / 64.f) + LNX_EPS);
            const f32x4 lg0 = ldq(CST + 7 * 512 + c0), lg1 = ldq(CST + 7 * 512 + c0 + 4), lb0 = ldq(CST + 8 * 512 + c0), lb1 = ldq(CST + 8 * 512 + c0 + 4);
            float gt[8]; unpack8(*(const LAS v4u*)(lds + P4_GT + t * 1040 + c0 * 2), gt);
            float o[8];
#pragma unroll
            for (int e = 0; e < 8; ++e) o[e] = (y[e] * rstd * (e < 4 ? lg0[e & 3] : lg1[e & 3]) + (e < 4 ? lb0[e & 3] : lb1[e & 3]) + bon * xs[2][e]) * gt[e];
            *(v4u*)(cat + (row0 + t) * D + 512 + c0) = (v4u){pk2(o[0], o[1]), pk2(o[2], o[3]), pk2(o[4], o[5]), pk2(o[6], o[7])};
        }
#pragma unroll 2
        for (int n = 0; n < 8; ++n) { const int t = 8 * n + (tid >> 6);
            const bf16* pr = proj + (row0 + t) * NPROJ + c0;
            float zc[8], zp[8], zn[8], g8[8], x8[8], xb[8];
            unpack8(*(const v4u*)(pr + COL_XG), g8); unpack8(*(const v4u*)(pr + COL_XC), x8);
#pragma unroll
            for (int e = 0; e < 8; ++e) zc[e] = g8[e] * x8[e];
            if (t > 0) { unpack8(*(const v4u*)(pr - NPROJ + COL_XG), g8); unpack8(*(const v4u*)(pr - NPROJ + COL_XC), x8);
#pragma unroll
                for (int e = 0; e < 8; ++e) zp[e] = g8[e] * x8[e]; } else {
#pragma unroll
                for (int e = 0; e < 8; ++e) zp[e] = 0.f; }
            if (t < 63) { unpack8(*(const v4u*)(pr + NPROJ + COL_XG), g8); unpack8(*(const v4u*)(pr + NPROJ + COL_XC), x8);
#pragma unroll
                for (int e = 0; e < 8; ++e) zn[e] = g8[e] * x8[e]; } else {
#pragma unroll
                for (int e = 0; e < 8; ++e) zn[e] = 0.f; }
            unpack8(*(const v4u*)(pr + COL_XB), xb);
            const f32x4 w00 = ldq(CST + 9 * 512 + c0), w01 = ldq(CST + 9 * 512 + c0 + 4), w10 = ldq(CST + 10 * 512 + c0), w11 = ldq(CST + 10 * 512 + c0 + 4), w20 = ldq(CST + 11 * 512 + c0), w21 = ldq(CST + 11 * 512 + c0 + 4);
            float o[8];
#pragma unroll
            for (int e = 0; e < 8; ++e) o[e] = xb[e] * ((e < 4 ? w00[e & 3] : w01[e & 3]) * zp[e] + (e < 4 ? w10[e & 3] : w11[e & 3]) * zc[e] + (e < 4 ? w20[e & 3] : w21[e & 3]) * zn[e]);
            *(v4u*)(cat + (row0 + t) * D + c0) = (v4u){pk2(o[0], o[1]), pk2(o[2], o[3]), pk2(o[4], o[5]), pk2(o[6], o[7])};
        }
    }
}

__device__ __forceinline__ void p6_mid(Frame& F) {
    const float* mod = (const float*)(F.ws + WS_MOD); const float* ng = F.in[I_NG];
    const float* yx = (const float*)(F.ws + WS_PROJ); bf16* hx2 = (bf16*)(F.ws + WS_HX);
    for (int m = F.bid * NWAVES + F.wave; m < MX; m += F.G * NWAVES) {
        const float* mr = mod + (m >> 12) * NMOD;
        f32x4 v[4], xv[4]; float ss = 0.f;
#pragma unroll
        for (int j = 0; j < 4; ++j) { v[j] = *(const f32x4*)(yx + (size_t)m * D + j * 256 + F.lane * 4); xv[j] = *(const f32x4*)(F.in[I_X] + (size_t)m * D + j * 256 + F.lane * 4);
            ss += v[j].x * v[j].x + v[j].y * v[j].y + v[j].z * v[j].z + v[j].w * v[j].w; }
        const float rstd = __builtin_amdgcn_rsqf(wave_sum(ss) * (1.f / D) + NORM_EPS);
        float ss2 = 0.f;
#pragma unroll
        for (int j = 0; j < 4; ++j) { const int c = j * 256 + F.lane * 4;
            const f32x4 g1 = *(const f32x4*)(ng + D + c), gt = *(const f32x4*)(mr + 2 * D + c);
            xv[j] = xv[j] + gt * (v[j] * rstd * g1);
            *(f32x4*)(F.out + (size_t)m * D + c) = xv[j];
            ss2 += xv[j].x * xv[j].x + xv[j].y * xv[j].y + xv[j].z * xv[j].z + xv[j].w * xv[j].w; }
        const float rstd2 = __builtin_amdgcn_rsqf(wave_sum(ss2) * (1.f / D) + NORM_EPS);
#pragma unroll
        for (int j = 0; j < 4; ++j) { const int c = j * 256 + F.lane * 4;
            const f32x4 g2 = *(const f32x4*)(ng + 2 * D + c), sh = *(const f32x4*)(mr + 3 * D + c), sc = *(const f32x4*)(mr + 4 * D + c);
            const f32x4 o = xv[j] * rstd2 * g2 * (1.f + sc) + sh;
            *(v2u*)(hx2 + (size_t)m * D + c) = (v2u){pk2(o.x, o.y), pk2(o.z, o.w)}; }
    }
}
__device__ __forceinline__ float gelu_erf(float x) { return 0.5f * x * (1.f + erff(x * 0.70710678118f)); }
__device__ __forceinline__ float dot2bf(unsigned a, unsigned b, float c) {
    typedef __bf16 bf2 __attribute__((ext_vector_type(2)));
    return __builtin_amdgcn_fdot2_f32_bf16(__builtin_bit_cast(bf2, a), __builtin_bit_cast(bf2, b), c, false);
}
__device__ __forceinline__ unsigned uminu(unsigned a, unsigned b) { return a < b ? a : b; }
__device__ __forceinline__ void ce_desc(unsigned& x, unsigned& y) { const unsigned hi = umaxu(x, y), lo = uminu(x, y); x = hi; y = lo; }
template <int N> __device__ __forceinline__ void bitonic_sort_desc(unsigned (&a)[N]) {
#pragma unroll
    for (int k = 2; k <= N; k <<= 1)
#pragma unroll
        for (int j = k >> 1; j > 0; j >>= 1)
#pragma unroll
            for (int i = 0; i < N; ++i) { const int l = i ^ j; if (l > i) { if ((i & k) == 0) ce_desc(a[i], a[l]); else ce_desc(a[l], a[i]); } }
}
template <int N> __device__ __forceinline__ void bitonic_merge_desc(unsigned (&a)[N]) {
#pragma unroll
    for (int j = N >> 1; j > 0; j >>= 1)
#pragma unroll
        for (int i = 0; i < N; ++i) { const int l = i ^ j; if (l > i) ce_desc(a[i], a[l]); }
}
__device__ __forceinline__ void p8a_route(Frame& F) {
    const int lane = F.lane, wave = F.wave, part = lane & 3, L = lane >> 2, side = L & 1;
    LAS unsigned char* WL = F.lds + 1024 + wave * 1024;
    LAS unsigned char* TAB = F.lds;
    const float* scores = (const float*)(F.ws + WS_PROJ);
    unsigned short* exl = (unsigned short*)(F.ws + WS_EXL); float* gl = (float*)(F.ws + WS_GL);
    __syncthreads();
    if (F.tid < 64) { int l = F.tid, i = 0; for (; i < 16; ++i) { const int n = 16 / (i + 1); if (l < n) break; l -= n; } TAB[F.tid] = (unsigned char)(i < 16 ? i * 16 + l : 0); }
    __syncthreads();
    for (int m = F.bid * NWAVES + wave; m < MX; m += F.G * NWAVES) {
        const float* lp = scores + (size_t)m * NSC + L * 128 + part * 32;
        unsigned lo16[16], hi16[16];
#pragma unroll
        for (int q = 0; q < 4; ++q) { const f32x4 v = *(const f32x4*)(lp + 4 * q), w = *(const f32x4*)(lp + 16 + 4 * q);
#pragma unroll
            for (int e = 0; e < 4; ++e) { lo16[4 * q + e] = (f2key(v[e]) & ~127u) | (unsigned)(127 - part * 32 - (4 * q + e)); hi16[4 * q + e] = (f2key(w[e]) & ~127u) | (unsigned)(127 - part * 32 - 16 - (4 * q + e)); } }
        bitonic_sort_desc<16>(lo16); bitonic_sort_desc<16>(hi16);
        unsigned r[16];
#pragma unroll
        for (int i = 0; i < 16; ++i) r[i] = umaxu(lo16[i], hi16[15 - i]);
        bitonic_merge_desc<16>(r);
        { unsigned c[16];
#pragma unroll
          for (int i = 0; i < 16; ++i) c[i] = umaxu(r[i], dppu<0xB1>(r[15 - i]));
          bitonic_merge_desc<16>(c);
#pragma unroll
          for (int i = 0; i < 16; ++i) r[i] = umaxu(c[i], dppu<0x4E>(c[15 - i]));
          bitonic_merge_desc<16>(r); }
        if (part == 0) {
#pragma unroll
            for (int i = 0; i < 16; ++i) WL[L * 16 + i] = (unsigned char)(127u - (r[i] & 127u)); }
        float fa[16], fb[16];
#pragma unroll
        for (int i = 0; i < 16; ++i) { const unsigned up = dppu<0x104>(r[i]), dn = dppu<0x114>(r[i]);
            const unsigned av = side ? dn : r[i], bv = side ? r[i] : up; fa[i] = key2f(av & ~127u); fb[i] = key2f(bv & ~127u); }
        unsigned R[16];
#pragma unroll
        for (int j = 0; j < 16; ++j) R[j] = (f2key(fa[0] + fb[j]) & ~63u) | (unsigned)(63 - j);
        { int code = 16;
#pragma unroll
          for (int i = 1; i < 16; ++i) {
#pragma unroll
              for (int j = 0; j < 16; ++j) { if ((i + 1) * (j + 1) <= 16) {
                  const unsigned x = (f2key(fa[i] + fb[j]) & ~63u) | (unsigned)(63 - code); const int p0 = (i + 1) * (j + 1) - 1;
#pragma unroll
                  for (int p = 15; p > p0; --p) R[p] = umaxu(R[p], uminu(R[p - 1], x));
                  R[p0] = umaxu(R[p0], x); ++code; } } } }
        if ((lane & 7) == 0) {
#pragma unroll
            for (int k = 0; k < 16; ++k) *(LAS unsigned*)(WL + 256 + ((lane >> 3) * 16 + k) * 4) = R[k]; }
        LDS_WAIT();
#pragma unroll
        for (int half = 0; half < 2; ++half) { const int e = lane + 64 * half, hd = e >> 4;
            const unsigned rk = *(const LAS unsigned*)(WL + 256 + e * 4); const int ij = TAB[63 - (int)(rk & 63u)];
            const int idx0 = WL[(2 * hd) * 16 + (ij >> 4)], idx1 = WL[(2 * hd + 1) * 16 + (ij & 15)];
            const float scv = key2f(rk & ~63u);
            float mx = scv; mx = fmaxf(mx, dppf<0xB1>(mx)); mx = fmaxf(mx, dppf<0x4E>(mx)); mx = fmaxf(mx, dppf<0x141>(mx)); mx = fmaxf(mx, dppf<0x140>(mx));
            const float ev = fast_exp(scv - mx); const float den = rowsum16(ev);
            exl[(size_t)m * 128 + e] = (unsigned short)(idx0 * 128 + idx1); gl[(size_t)m * 128 + e] = ev * fast_rcp(den); }
        LDS_WAIT();
    }
}
__device__ __forceinline__ void p9_upass(Frame& F) {
    const int lane = F.lane, wave = F.wave, x = F.bid & 7, r = F.bid >> 3, nr = F.G >> 3, g = lane >> 3, q = lane & 7;
    LAS unsigned short* EXW = (LAS unsigned short*)(F.lds + wave * 256);
    const unsigned* exl32 = (const unsigned*)(F.ws + WS_EXL); const bf16* hx2 = (const bf16*)(F.ws + WS_HX);
    const unsigned char* U = F.ws + WS_U + 128 * x + 16 * q; float* part = (float*)(F.ws + WS_PART) + (size_t)x * MX * 128;
    for (int m = r + nr * wave; m < MX; m += nr * NWAVES) {
        *(LAS unsigned*)(EXW + 2 * lane) = exl32[(size_t)m * 64 + lane];
        const v4u h0 = *(const v4u*)(hx2 + (size_t)m * D + 128 * x + 16 * q), h1 = *(const v4u*)(hx2 + (size_t)m * D + 128 * x + 16 * q + 8);
        float hf[16];
        hf[0] = bf_lo(h0.x); hf[1] = bf_hi(h0.x); hf[2] = bf_lo(h0.y); hf[3] = bf_hi(h0.y); hf[4] = bf_lo(h0.z); hf[5] = bf_hi(h0.z); hf[6] = bf_lo(h0.w); hf[7] = bf_hi(h0.w);
        hf[8] = bf_lo(h1.x); hf[9] = bf_hi(h1.x); hf[10] = bf_lo(h1.y); hf[11] = bf_hi(h1.y); hf[12] = bf_lo(h1.z); hf[13] = bf_hi(h1.z); hf[14] = bf_lo(h1.w); hf[15] = bf_hi(h1.w);
        LDS_WAIT();
        float keep[2];
#pragma unroll
        for (int j = 0; j < 2; ++j) {
            float kp = 0.f;
            v4u uu[8];
#pragma unroll
            for (int i = 0; i < 8; ++i) { const unsigned ex = EXW[64 * j + 8 * i + g]; uu[i] = *(const v4u*)(U + (size_t)ex * 1024); }
#pragma unroll
            for (int i = 0; i < 8; ++i) { float p = 0.f;
#pragma unroll
                for (int w = 0; w < 4; ++w) { const f32x2 lo = __builtin_amdgcn_cvt_pk_f32_fp8((int)uu[i][w], false), hi = __builtin_amdgcn_cvt_pk_f32_fp8((int)uu[i][w], true);
                    p += lo.x * hf[4 * w] + lo.y * hf[4 * w + 1] + hi.x * hf[4 * w + 2] + hi.y * hf[4 * w + 3]; }
                p += dppf<0xB1>(p); p += dppf<0x4E>(p); p += dppf<0x141>(p);
                kp = (q == i) ? p : kp; }
            keep[j] = kp * (1.f / 32.f);
        }
        part[(size_t)m * 128 + 8 * q + g] = keep[0]; part[(size_t)m * 128 + 64 + 8 * q + g] = keep[1];
        LDS_WAIT();
    }
}
__device__ __forceinline__ void p10_combine(Frame& F) {
    const float* __restrict__ part = (const float*)(F.ws + WS_PART); const float* __restrict__ gl = (const float*)(F.ws + WS_GL);
    const unsigned short* __restrict__ exl = (const unsigned short*)(F.ws + WS_EXL); unsigned* __restrict__ plt = (unsigned*)(F.ws + WS_PL);
    LAS unsigned* TL = (LAS unsigned*)F.lds;
    for (int unit = F.bid; unit < MX / 64; unit += F.G) {
        const int m0 = unit * 64;
        __syncthreads();
#pragma unroll 4
        for (int i = 0; i < 16; ++i) { const int idx = F.tid + 512 * i, ml = idx >> 7, k = idx & 127; const size_t gi = (size_t)(m0 + ml) * 128 + k;
            float s = part[gi];
#pragma unroll
            for (int x = 1; x < 8; ++x) s += part[(size_t)x * MX * 128 + gi];
            TL[k * 65 + ml] = (unsigned)exl[gi] | ((unsigned)__builtin_bit_cast(unsigned short, (_Float16)(gl[gi] * gelu_erf(s))) << 16); }
        __syncthreads();
#pragma unroll 4
        for (int i = 0; i < 16; ++i) { const int idx = F.tid + 512 * i, k = idx >> 6, ml = idx & 63; plt[(size_t)k * MX + m0 + ml] = TL[k * 65 + ml]; }
    }
}
typedef _Float16 h2_t __attribute__((ext_vector_type(2)));
typedef _Float16 h4_t __attribute__((ext_vector_type(4)));
template <int MODE> __device__ __forceinline__ void p11_vpass(Frame& F) {
    const int lane = F.lane, wave = F.wave;
    const unsigned* __restrict__ plt = (const unsigned*)(F.ws + WS_PL); float* __restrict__ po = (float*)(F.ws + WS_PO);
    for (int cg = F.bid; cg < 256; cg += F.G) {
        const int c0 = 128 * (cg & 7) + 4 * (cg >> 3);
        __syncthreads();
        for (int e = F.tid; e < NEXP; e += 512) { const f32x4 vv = *(const f32x4*)(F.in[I_PV] + (size_t)e * D + c0);
            const h2_t a = {(_Float16)vv.x, (_Float16)vv.y}, b = {(_Float16)vv.z, (_Float16)vv.w};
            *(LAS v2u*)(F.lds + e * 8) = (v2u){__builtin_bit_cast(unsigned, a), __builtin_bit_cast(unsigned, b)}; }
        __syncthreads();
        for (int mg = wave; mg < MX / 64; mg += NWAVES) {
            const unsigned* __restrict__ pg = plt + mg * 64;
            f32x4 acc = (f32x4){0.f, 0.f, 0.f, 0.f};
#pragma unroll 2
            for (int k0 = 0; k0 < 128; k0 += 8) {
                unsigned p[8];
#pragma unroll
                for (int i = 0; i < 8; ++i) p[i] = pg[(size_t)(k0 + i) * MX + lane];
                h2_t a01 = {(_Float16)0.f, (_Float16)0.f}, a23 = a01;
#pragma unroll
                for (int i = 0; i < 8; ++i) { const h4_t hv = *(const LAS h4_t*)(unsigned)((p[i] & 0xffffu) << 3);
                    const _Float16 cf = __builtin_bit_cast(_Float16, (unsigned short)(p[i] >> 16)); const h2_t c2 = {cf, cf};
                    a01 = __builtin_shufflevector(hv, hv, 0, 1) * c2 + a01; a23 = __builtin_shufflevector(hv, hv, 2, 3) * c2 + a23; }
                acc.x += (float)a01.x; acc.y += (float)a01.y; acc.z += (float)a23.x; acc.w += (float)a23.y;
            }
            *(f32x4*)(po + (size_t)(mg * 64 + lane) * D + c0) = acc;
        }
    }
}
__device__ __forceinline__ void p12_final(Frame& F) {
    const float* mod = (const float*)(F.ws + WS_MOD); const float* ng3 = F.in[I_NG] + 3 * D; const float* po = (const float*)(F.ws + WS_PO);
    for (int m = F.bid * NWAVES + F.wave; m < MX; m += F.G * NWAVES) {
        const float* gt2 = mod + (m >> 12) * NMOD + 5 * D;
        f32x4 v[4]; float ss = 0.f;
#pragma unroll
        for (int j = 0; j < 4; ++j) { v[j] = *(const f32x4*)(po + (size_t)m * D + j * 256 + F.lane * 4); ss += v[j].x * v[j].x + v[j].y * v[j].y + v[j].z * v[j].z + v[j].w * v[j].w; }
        const float rstd = __builtin_amdgcn_rsqf(wave_sum(ss) * (1.f / D) + NORM_EPS);
#pragma unroll
        for (int j = 0; j < 4; ++j) { const int c = j * 256 + F.lane * 4; float* op = F.out + (size_t)m * D + c;
            const f32x4 x1 = *(const f32x4*)op, g = *(const f32x4*)(ng3 + c), gt = *(const f32x4*)(gt2 + c);
            *(f32x4*)op = x1 + gt * (v[j] * rstd * g); }
    }
}
struct Args { const float* in[25]; float* out; unsigned char* ws; int ph_lo, ph_hi; };
__global__ void __launch_bounds__(NWAVES * 64, 2) mk_fwd(Args args) {
    extern __shared__ __attribute__((aligned(16))) unsigned char lds_raw[];
    Frame F;
    F.lds = (LAS unsigned char*)lds_raw;
    F.MISC = (volatile LAS unsigned*)(F.lds + MISC_OFF);
    F.tid = threadIdx.x; F.lane = F.tid & 63; F.wave = __builtin_amdgcn_readfirstlane(F.tid >> 6);
    F.G = gridDim.x; F.bid = blockIdx.x;
#pragma unroll
    for (int i = 0; i < 25; ++i) F.in[i] = args.in[i];
    F.out = args.out; F.ws = args.ws; F.ctl = (gu32*)(args.ws + WS_CTL);
    for (int u = F.tid; u < (LDS_BYTES - LDSCTL_OFF) / 4; u += NWAVES * 64) ((LAS unsigned*)(F.lds + LDSCTL_OFF))[u] = 0u;
    __syncthreads();
    const int lo = args.ph_lo, hi = args.ph_hi;
    XcdBarrier bar; bar.bar = (unsigned*)(F.ctl + CW_BAR); bar.x = 0; bar.st = nullptr;
    if (hi - lo > 1) bar = xcd_barrier_post((unsigned*)(F.ctl + CW_BAR), F.MISC + 8);
#ifndef PROBE_LO
#define PROBE_LO -1
#define PROBE_HI -1
#endif
#define IN(k) (lo <= (k) && (k) < hi)
#define SEAM(k) do { if (IN(k) && IN((k) + 1)) xcd_barrier(bar); } while (0)
#define PH0 { p0_prep(F); }
#define PH1 { p1_hx(F); }
#define PH2 { pg8::Gemm g{(const pg8::bf16_t*)(F.ws + WS_HX), (const pg8::bf16_t*)(F.ws + WS_WINT), MA, NPROJ_PAD, D}; pg8::StaticOrder S; S.init(MA, NPROJ_PAD, F.G, F.bid); \
        pg8::EpiProj E{(pg8::bf16_t*)(F.ws + WS_PROJ), NPROJ, NPROJ}; \
        pg8::gemm_phase<pg8::EpiProj, pg8::StaticOrder, PG8_ALIGN, PG8_SP2>(F.lds, g, S, E); }
#define PH3 { p3_scan<0>(F, bar); }
#define PH4 { p4_mix(F); }
#define PH5 { pg8::Gemm g{(const pg8::bf16_t*)(F.ws + WS_HX), (const pg8::bf16_t*)(F.ws + WS_WOUTT), MX, D, D}; pg8::StaticOrder S; S.init(MX, D, F.G, F.bid); \
        pg8::EpiF32 E{(float*)(F.ws + WS_PROJ), D}; \
        pg8::gemm_phase<pg8::EpiF32, pg8::StaticOrder, PG8_ALIGN, PG8_SP2>(F.lds, g, S, E); }
#define PH6 { p6_mid(F); }
#define PH7 { pg8::Gemm g{(const pg8::bf16_t*)(F.ws + WS_HX), (const pg8::bf16_t*)(F.ws + WS_WEFFT), MX, NSC, D}; pg8::StaticOrder S; S.init(MX, NSC, F.G, F.bid); \
        pg8::EpiF32 E{(float*)(F.ws + WS_PROJ), NSC}; \
        pg8::gemm_phase<pg8::EpiF32, pg8::StaticOrder, PG8_ALIGN, PG8_SP2>(F.lds, g, S, E); }
#define PH8 { p8a_route(F); }
#define PH9 { p9_upass(F); }
#define PH10 { p10_combine(F); }
#define PH11 { p11_vpass<0>(F); }
#define PH12 { p12_final(F); }
#define PRB(k, body) if constexpr (PROBE_LO <= (k) && (k) <= PROBE_HI) { xcd_barrier(bar); body }
    if (IN(0)) PH0 PRB(0, PH0) SEAM(0);
    if (IN(1)) PH1 PRB(1, PH1) SEAM(1);
    if (IN(2)) PH2 PRB(2, PH2) SEAM(2);
    if (IN(3)) PH3 PRB(3, PH3) SEAM(3);
    if (IN(4)) PH4 PRB(4, PH4) SEAM(4);
    if (IN(5)) PH5 PRB(5, PH5) SEAM(5);
    if (IN(6)) PH6 PRB(6, PH6) SEAM(6);
    if (IN(7)) PH7 PRB(7, PH7) SEAM(7);
    if (IN(8)) PH8 PRB(8, PH8) SEAM(8);
    if (IN(9)) PH9 PRB(9, PH9) SEAM(9);
    if (IN(10)) PH10 PRB(10, PH10) SEAM(10);
    if constexpr (PROBE_LO == 111) { p11_vpass<1>(F); xcd_barrier(bar); }
    if constexpr (PROBE_LO == 112) { p11_vpass<2>(F); xcd_barrier(bar); }
    if (IN(11)) PH11 PRB(11, PH11) SEAM(11);
    if (IN(12)) PH12
#undef IN
#undef SEAM
}

extern "C" void kernel_launch(void* const* d_in, const int* in_sizes, int n_in, void* d_out, int out_size, void* d_ws, size_t ws_size, hipStream_t stream) {
    static int grid = 0;
    if (grid == 0) {
        if (n_in != 25 || in_sizes[0] != MX * D || out_size != MX * D || ws_size < WS_END) { fprintf(stderr, "kernel_launch: unexpected problem (n_in %d, in0 %d, out %d, ws %zu); nothing launched\n", n_in, n_in > 0 ? in_sizes[0] : -1, out_size, ws_size); grid = -1; return; }
        int dev = 0, cus = 0, per_cu = 0;
        if (hipGetDevice(&dev) != hipSuccess || hipDeviceGetAttribute(&cus, hipDeviceAttributeMultiprocessorCount, dev) != hipSuccess) { fprintf(stderr, "kernel_launch: device query failed\n"); grid = -1; return; }
        if (hipFuncSetAttribute((const void*)mk_fwd, hipFuncAttributeMaxDynamicSharedMemorySize, LDS_BYTES) != hipSuccess) { fprintf(stderr, "kernel_launch: hipFuncSetAttribute failed\n"); grid = -1; return; }
        if (hipOccupancyMaxActiveBlocksPerMultiprocessor(&per_cu, (const void*)mk_fwd, NWAVES * 64, LDS_BYTES) != hipSuccess || per_cu < 1) fprintf(stderr, "kernel_launch: occupancy query reports %d workgroups per CU\n", per_cu);
        (void)hipGetLastError();
        grid = cus;
    }
    if (grid < 0) return;
    if (hipMemsetAsync((char*)d_ws + WS_CTL, 0, CTL_ZERO_BYTES, stream) != hipSuccess) { fprintf(stderr, "kernel_launch: memset failed\n"); return; }
    Args a{};
    for (int i = 0; i < 25; ++i) a.in[i] = (const float*)d_in[i];
    a.out = (float*)d_out; a.ws = (unsigned char*)d_ws;
    if (MK_N_LAUNCHES == 1) { a.ph_lo = 0; a.ph_hi = NPH; hipLaunchKernelGGL(mk_fwd, dim3(grid), dim3(NWAVES * 64), LDS_BYTES, stream, a); }
    else for (int p = 0; p < NPH; ++p) { a.ph_lo = p; a.ph_hi = p + 1; hipLaunchKernelGGL(mk_fwd, dim3(grid), dim3(NWAVES * 64), LDS_BYTES, stream, a); }
    const hipError_t le = hipPeekAtLastError();
    if (le != hipSuccess) fprintf(stderr, "kernel_launch: launch failed: %s\n", hipGetErrorName(le));
}
```

```cpp
#include <hip/hip_runtime.h>
#include <cstdio>
#include <cstdint>
namespace pg8 {
#define PG8_LAS __attribute__((address_space(3)))
typedef unsigned short bf16_t;
typedef short bf16x8 __attribute__((ext_vector_type(8)));
typedef float f32x4 __attribute__((ext_vector_type(4)));
typedef unsigned u32x4 __attribute__((ext_vector_type(4)));
constexpr int BM = 256, BK = 64, HALF = 128, HTB = HALF * BK * 2  , STAGE_BYTES = 8 * HTB, NXCD = 8, WGM = 8;

__host__ __device__ __forceinline__ int lds_byte(int r, int c) { const int st = (r >> 4) * 2 + (c >> 5), rr = r & 15, cc = c & 31, ob = rr * 64 + cc * 2; return st * 1024 + (ob ^ (((ob >> 9) & 1) << 5)); }
__host__ __device__ __forceinline__ void stage_rc(int b, int& R, int& C) { const int st = b / 1024, sb = b % 1024, swz = sb ^ (((sb >> 9) & 1) << 5); R = (st >> 1) * 16 + swz / 64; C = (st & 1) * 32 + (swz % 64) / 2; }
__host__ __device__ __forceinline__ int perm32(int rho) { const int n = rho >> 4, i = rho & 15; return 8 * (i >> 2) + 4 * n + (i & 3); }

struct Unit { int pm, pn; };
struct Gemm { const bf16_t* A; const bf16_t* Bt; int M, N, K; };

struct StaticOrder {
    int nM, nN, nwg, G, c;
    __host__ __device__ void init(int M, int N, int G_, int c_) { nM = M / BM; nN = N / BM; nwg = nM * nN; G = G_; c = c_; }
    __host__ __device__ bool next(int i, Unit& u) const {
        const long L = (long)i * G + c; if (L >= nwg) return false;
        int wgid = (int)L; { const int q = nwg / NXCD, r = nwg % NXCD, xcd = wgid % NXCD, off = wgid / NXCD; wgid = (xcd < r ? xcd * (q + 1) : r * (q + 1) + (xcd - r) * q) + off; }
        const int nig = WGM * nN, gid = wgid / nig, fm = gid * WGM, gsz = (nM - fm) < WGM ? (nM - fm) : WGM;
        u.pm = fm + ((wgid % nig) % gsz); u.pn = (wgid % nig) / gsz; return true;
    }
    __device__ __forceinline__ void a_ready(const Unit&) const {}
    __device__ __forceinline__ void done(const Unit&) const {}
};

__device__ __forceinline__ unsigned cvt_pk_bf16(float lo, float hi) { unsigned r; asm volatile("v_cvt_pk_bf16_f32 %0, %1, %2" : "=v"(r) : "v"(lo), "v"(hi)); return r; }
typedef float f32x2 __attribute__((ext_vector_type(2)));
__device__ __forceinline__ f32x2 gelu_pk(f32x2 v) {
    const f32x2 av = __builtin_elementwise_abs(v), d = av * 0.2316418882f + 1.0f;
    f32x2 t; t.x = __builtin_amdgcn_rcpf(d.x); t.y = __builtin_amdgcn_rcpf(d.y);
    f32x2 q = t * 0.5307027145f + (-0.7265760135f); q = q * t + 0.7107068705f; q = q * t + (-0.142248368f); q = q * t + 0.127414796f; q = q * t;
    const f32x2 s = (v * v) * (-0.72134752044f);
    f32x2 e; e.x = __builtin_amdgcn_exp2f(s.x); e.y = __builtin_amdgcn_exp2f(s.y);
    const f32x2 m = v * (q * e), r = v - m;
    f32x2 o; o.x = v.x < 0.f ? m.x : r.x; o.y = v.y < 0.f ? m.y : r.y; return o;
}

template <int ACT  > struct EpiBf16 {
    static constexpr bool PERM = true, AFTER_DRAIN = false; static_assert(ACT == 0 || ACT == 1, "EpiBf16: ACT is 0 (none) or 1 (gelu_pk)");
    bf16_t* O; int ldc; const float* bias; int split_cols; size_t split_stride; float scale0;
    __device__ __forceinline__ void operator()(const f32x4 (&acc)[2][2][4][2], const Unit& u, int wr, int wc, int fr, int fq) const {
        const int row0 = u.pm * BM + wr * 64 + fr; int colt = u.pn * BM; bf16_t* base = O;
        float sc = 1.f; if (split_cols) { const int t = colt / split_cols; base += (size_t)t * split_stride; colt -= t * split_cols; if (t == 0) sc = scale0; }
        const int col0 = colt + wc * 32 + 8 * fq, bcol0 = u.pn * BM + wc * 32 + 8 * fq;
        f32x4 bv[2][2];
#pragma unroll
        for (int bj = 0; bj < 2; ++bj)
#pragma unroll
            for (int n = 0; n < 2; ++n) bv[bj][n] = bias ? *(const f32x4*)(bias + bcol0 + bj * HALF + 4 * n) : (f32x4){0.f, 0.f, 0.f, 0.f};
#pragma unroll
        for (int ai = 0; ai < 2; ++ai)
#pragma unroll
            for (int m = 0; m < 4; ++m) { bf16_t* rowp = base + (size_t)(row0 + ai * HALF + m * 16) * ldc + col0;
#pragma unroll
                for (int bj = 0; bj < 2; ++bj) { f32x4 v0 = acc[ai][bj][m][0] + bv[bj][0], v1 = acc[ai][bj][m][1] + bv[bj][1];
                    if (ACT == 1) { f32x2 a = gelu_pk((f32x2){v0[0], v0[1]}), b = gelu_pk((f32x2){v0[2], v0[3]}), c = gelu_pk((f32x2){v1[0], v1[1]}), d = gelu_pk((f32x2){v1[2], v1[3]});
                        v0 = (f32x4){a.x, a.y, b.x, b.y}; v1 = (f32x4){c.x, c.y, d.x, d.y}; }
                    v0 = v0 * sc; v1 = v1 * sc; u32x4 w; w.x = cvt_pk_bf16(v0[0], v0[1]); w.y = cvt_pk_bf16(v0[2], v0[3]); w.z = cvt_pk_bf16(v1[0], v1[1]); w.w = cvt_pk_bf16(v1[2], v1[3]);
                    *(u32x4*)(rowp + bj * HALF) = w; } }
    }
};

struct EpiF32 {
    static constexpr bool PERM = false, AFTER_DRAIN = false;
    float* C; int ldc;
    __device__ __forceinline__ void operator()(const f32x4 (&acc)[2][2][4][2], const Unit& u, int wr, int wc, int fr, int fq) const {
        const int row0 = u.pm * BM + wr * 64 + fr, col0 = u.pn * BM + wc * 32 + 4 * fq;
#pragma unroll
        for (int ai = 0; ai < 2; ++ai)
#pragma unroll
            for (int m = 0; m < 4; ++m) { float* rowp = C + (size_t)(row0 + ai * HALF + m * 16) * ldc + col0;
#pragma unroll
                for (int bj = 0; bj < 2; ++bj)
#pragma unroll
                    for (int n = 0; n < 2; ++n) *(f32x4*)(rowp + bj * HALF + n * 16) = acc[ai][bj][m][n]; }
    }
};
struct EpiProj {
    static constexpr bool PERM = true, AFTER_DRAIN = false;
    bf16_t* O; int ldc; int ncols;
    __device__ __forceinline__ void operator()(const f32x4 (&acc)[2][2][4][2], const Unit& u, int wr, int wc, int fr, int fq) const {
        const int row0 = u.pm * BM + wr * 64 + fr; const int col0 = u.pn * BM + wc * 32 + 8 * fq;
#pragma unroll
        for (int ai = 0; ai < 2; ++ai)
#pragma unroll
            for (int m = 0; m < 4; ++m) { bf16_t* rowp = O + (size_t)(row0 + ai * HALF + m * 16) * ldc + col0;
#pragma unroll
                for (int bj = 0; bj < 2; ++bj) { const f32x4 v0 = acc[ai][bj][m][0], v1 = acc[ai][bj][m][1];
                    u32x4 w; w.x = cvt_pk_bf16(v0[0], v0[1]); w.y = cvt_pk_bf16(v0[2], v0[3]); w.z = cvt_pk_bf16(v1[0], v1[1]); w.w = cvt_pk_bf16(v1[2], v1[3]);
                    if (col0 + bj * HALF < ncols) *(u32x4*)(rowp + bj * HALF) = w; } }
    }
};
template <class Epi, class Sched, bool ALIGN_EPI = false, bool SP2 = false>
__device__ __forceinline__ void gemm_phase(PG8_LAS unsigned char* lds, const Gemm g, const Sched& S, const Epi& E) {
    const int tid = threadIdx.x, wid = __builtin_amdgcn_readfirstlane(tid >> 6), lane = tid & 63, wr = wid >> 2, wc = wid & 3, fr = lane & 15, fq = lane >> 4;
    const int K = g.K, nt = K / BK;
    unsigned voffA[2], voffB[2];
#pragma unroll
    for (int i = 0; i < 2; ++i) { int R, C; stage_rc(tid * 16 + i * 8192, R, C); const int Rb = Epi::PERM ? ((R & ~31) + perm32(R & 31)) : R;
        voffA[i] = (unsigned)(R * K + C) * 2u; voffB[i] = (unsigned)(Rb * K + C) * 2u; }
    const size_t kstep = (size_t)(BK * 2);
    const size_t hstep = (size_t)HALF * K * 2;
    const size_t tstep = 2 * hstep;
    const unsigned ldsw = (unsigned)wid * 1024u;
    const int aoff = lds_byte(wr * 64 + fr, fq * 8), boff = lds_byte(wc * 32 + fr, fq * 8);
#define PG8_SA(b, h) (((b) * 2 + (h)) * HTB)
#define PG8_SB(b, h) ((4 + (b) * 2 + (h)) * HTB)
#define PG8_STAGE(bufoff, gbase, voff) do { _Pragma("unroll") for (int _i = 0; _i < 2; ++_i) \
        __builtin_amdgcn_global_load_lds((const unsigned*)((const char*)(gbase) + (voff)[_i]), (PG8_LAS unsigned*)(lds + (bufoff) + ldsw + _i * 8192), 16, 0, 0); } while (0)
#define PG8_LDA(dst, b, h) do { _Pragma("unroll") for (int m = 0; m < 4; ++m) _Pragma("unroll") for (int k = 0; k < 2; ++k) dst[m][k] = *(const PG8_LAS bf16x8*)(lds + PG8_SA(b, h) + aoff + m * 2048 + k * 1024); } while (0)
#define PG8_LDB(dst, b, h) do { _Pragma("unroll") for (int n = 0; n < 2; ++n) _Pragma("unroll") for (int k = 0; k < 2; ++k) dst[n][k] = *(const PG8_LAS bf16x8*)(lds + PG8_SB(b, h) + boff + n * 2048 + k * 1024); } while (0)
#define PG8_MMA(ai, bj, At, Bt) do { __builtin_amdgcn_s_setprio(1); _Pragma("unroll") for (int m = 0; m < 4; ++m) _Pragma("unroll") for (int n = 0; n < 2; ++n) _Pragma("unroll") for (int k = 0; k < 2; ++k) \
        acc[ai][bj][m][n] = __builtin_amdgcn_mfma_f32_16x16x32_bf16(Bt[n][k], At[m][k], acc[ai][bj][m][n], 0, 0, 0); __builtin_amdgcn_s_setprio(0); } while (0)
#define PG8_WAIT_V(n) asm volatile("s_waitcnt vmcnt(" #n ")" ::: "memory")
#define PG8_WAIT_L(n) asm volatile("s_waitcnt lgkmcnt(" #n ")" ::: "memory")
#define PG8_BAR __builtin_amdgcn_s_barrier()
#define PG8_SCHED __builtin_amdgcn_sched_barrier(0)
    Unit cur, nxt; int ui = 0;
    if (!S.next(0, cur)) return;
    f32x4 acc[2][2][4][2];
#pragma unroll
    for (int a = 0; a < 2; ++a)
#pragma unroll
        for (int b = 0; b < 2; ++b)
#pragma unroll
            for (int m = 0; m < 4; ++m)
#pragma unroll
                for (int n = 0; n < 2; ++n) acc[a][b][m][n] = (f32x4){0.f, 0.f, 0.f, 0.f};
    bf16x8 At[4][2], B0[2][2], B1[2][2];
    const char* cA = (const char*)g.A + (size_t)cur.pm * tstep; const char* cB = (const char*)g.Bt + (size_t)cur.pn * tstep;
    S.a_ready(cur);
    if constexpr (SP2) {
        PG8_STAGE(PG8_SB(0, 0), cB, voffB); PG8_STAGE(PG8_SB(0, 1), cB + hstep, voffB); PG8_STAGE(PG8_SA(0, 0), cA, voffA); PG8_STAGE(PG8_SA(0, 1), cA + hstep, voffA);
        if (wr == 1) PG8_BAR;
        PG8_WAIT_V(2); PG8_BAR;
        PG8_STAGE(PG8_SB(1, 0), cB + kstep, voffB); PG8_STAGE(PG8_SA(1, 0), cA + kstep, voffA); PG8_STAGE(PG8_SB(1, 1), cB + hstep + kstep, voffB);
        PG8_WAIT_V(6); PG8_BAR;
    } else {
        PG8_STAGE(PG8_SB(0, 0), cB, voffB); PG8_STAGE(PG8_SA(0, 0), cA, voffA); PG8_STAGE(PG8_SB(0, 1), cB + hstep, voffB); PG8_STAGE(PG8_SA(0, 1), cA + hstep, voffA);
        if (wr == 1) PG8_BAR;
        PG8_WAIT_V(4); PG8_BAR;
        PG8_STAGE(PG8_SB(1, 0), cB + kstep, voffB); PG8_STAGE(PG8_SA(1, 0), cA + kstep, voffA); PG8_STAGE(PG8_SB(1, 1), cB + hstep + kstep, voffB);
        PG8_WAIT_V(6); PG8_BAR;
    }
    for (;;) {
        const bool has_next = S.next(ui + 1, nxt);
        const char* nA = has_next ? (const char*)g.A + (size_t)nxt.pm * tstep : cA; const char* nB = has_next ? (const char*)g.Bt + (size_t)nxt.pn * tstep : cB;
        for (int t = 0; t < nt; t += 2) {
            const bool last = (t == nt - 2);
            const char* a1 = cA + (size_t)(t + 1) * kstep;
            const char* a2 = last ? nA : cA + (size_t)(t + 2) * kstep; const char* b2 = last ? nB : cB + (size_t)(t + 2) * kstep;
            const char* a3 = a2 + kstep; const char* b3 = b2 + kstep;
            if (last && has_next) S.a_ready(nxt);
            if constexpr (SP2) {
            PG8_LDB(B0, 0, 0); PG8_LDB(B1, 0, 1); PG8_SCHED; PG8_LDA(At, 0, 0); PG8_STAGE(PG8_SA(1, 1), a1 + hstep, voffA);
            PG8_WAIT_V(8); PG8_WAIT_L(0); PG8_BAR; PG8_MMA(0, 0, At, B0); PG8_MMA(0, 1, At, B1); PG8_BAR; PG8_SCHED;
            PG8_LDA(At, 0, 1); PG8_STAGE(PG8_SB(0, 0), b2, voffB); PG8_STAGE(PG8_SB(0, 1), b2 + hstep, voffB); PG8_STAGE(PG8_SA(0, 0), a2, voffA);
            PG8_WAIT_V(8); PG8_WAIT_L(0); PG8_BAR; PG8_MMA(1, 0, At, B0); PG8_MMA(1, 1, At, B1); PG8_BAR; PG8_SCHED;
            PG8_LDB(B0, 1, 0); PG8_LDB(B1, 1, 1); PG8_SCHED; PG8_LDA(At, 1, 0); PG8_STAGE(PG8_SA(0, 1), a2 + hstep, voffA);
            PG8_WAIT_V(8); PG8_WAIT_L(0); PG8_BAR; PG8_MMA(0, 0, At, B0); PG8_MMA(0, 1, At, B1); PG8_BAR; PG8_SCHED;
            PG8_LDA(At, 1, 1); PG8_STAGE(PG8_SB(1, 0), b3, voffB); PG8_STAGE(PG8_SB(1, 1), b3 + hstep, voffB); PG8_STAGE(PG8_SA(1, 0), a3, voffA);
            PG8_WAIT_V(8); PG8_WAIT_L(0); PG8_BAR; PG8_MMA(1, 0, At, B0); PG8_MMA(1, 1, At, B1); PG8_BAR; PG8_SCHED;
            } else {
            PG8_LDB(B0, 0, 0); PG8_SCHED; PG8_LDA(At, 0, 0); PG8_STAGE(PG8_SA(1, 1), a1 + hstep, voffA);
            PG8_WAIT_L(8); PG8_BAR; PG8_WAIT_L(0); PG8_MMA(0, 0, At, B0); PG8_BAR; PG8_SCHED;
            PG8_LDB(B1, 0, 1); PG8_STAGE(PG8_SB(0, 0), b2, voffB);
            PG8_BAR; PG8_WAIT_L(0); PG8_MMA(0, 1, At, B1); PG8_BAR;
            PG8_LDA(At, 0, 1); PG8_STAGE(PG8_SA(0, 0), a2, voffA);
            PG8_BAR; PG8_WAIT_L(0); PG8_MMA(1, 0, At, B0); PG8_BAR; PG8_SCHED;
            PG8_STAGE(PG8_SB(0, 1), b2 + hstep, voffB);
            PG8_WAIT_V(6); PG8_BAR; PG8_MMA(1, 1, At, B1); PG8_BAR;
            PG8_LDB(B0, 1, 0); PG8_SCHED; PG8_LDA(At, 1, 0); PG8_STAGE(PG8_SA(0, 1), a2 + hstep, voffA);
            PG8_WAIT_L(8); PG8_BAR; PG8_WAIT_L(0); PG8_MMA(0, 0, At, B0); PG8_BAR; PG8_SCHED;
            PG8_LDB(B1, 1, 1); PG8_STAGE(PG8_SB(1, 0), b3, voffB);
            PG8_BAR; PG8_WAIT_L(0); PG8_MMA(0, 1, At, B1); PG8_BAR;
            PG8_LDA(At, 1, 1); PG8_STAGE(PG8_SA(1, 0), a3, voffA);
            PG8_BAR; PG8_WAIT_L(0); PG8_MMA(1, 0, At, B0); PG8_BAR; PG8_SCHED;
            PG8_STAGE(PG8_SB(1, 1), b3 + hstep, voffB);
            PG8_WAIT_V(6); PG8_BAR; PG8_MMA(1, 1, At, B1); PG8_BAR;
            }
        }
        if constexpr (ALIGN_EPI) { if (wr == 0) PG8_BAR; }
        if constexpr (!Epi::AFTER_DRAIN) { E(acc, cur, wr, wc, fr, fq); S.done(cur); }
        if (!has_next) break;
#pragma unroll
        for (int a = 0; a < 2; ++a)
#pragma unroll
            for (int b = 0; b < 2; ++b)
#pragma unroll
                for (int m = 0; m < 4; ++m)
#pragma unroll
                    for (int n = 0; n < 2; ++n) acc[a][b][m][n] = (f32x4){0.f, 0.f, 0.f, 0.f};
        cur = nxt; cA = nA; cB = nB; ++ui;
        if constexpr (ALIGN_EPI) { if (wr == 1) PG8_BAR; }
    }
    PG8_WAIT_V(0);
    if constexpr (!ALIGN_EPI) { if (wr == 0) PG8_BAR; }
    PG8_BAR;
    if constexpr (Epi::AFTER_DRAIN) { E.fused(acc, cur, wr, wc, fr, fq, lds, wid, lane); S.done(cur); }
#undef PG8_SA
#undef PG8_SB
#undef PG8_STAGE
#undef PG8_LDA
#undef PG8_LDB
#undef PG8_MMA
#undef PG8_WAIT_V
#undef PG8_WAIT_L
#undef PG8_BAR
#undef PG8_SCHED
}
}
#ifndef PG8_SP2
#define PG8_SP2 true
#endif
#ifndef PG8_ALIGN
#define PG8_ALIGN true
#endif
constexpr int NWAVES = 8;
constexpr int D = 1024, NB = 4, T = 4096, TC = 256;
constexpr int MX = NB * T, MC = NB * TC, MA = MX + MC;
constexpr int NPROJ = 3456, NPROJ_PAD = 3584;
constexpr int COL_XB = 0, COL_XG = 512, COL_XC = 1024, COL_R = 1536, COL_K = 2048, COL_V = 2560, COL_G = 3072, COL_LW = 3200, COL_LA = 3328;
constexpr int NMOD = 6 * D;
constexpr int NEXP = 16384, NSC = 2048;
constexpr float NORM_EPS = 1e-6f, LNX_EPS = 64e-5f;
#ifndef MK_N_LAUNCHES
#define MK_N_LAUNCHES 1
#endif
constexpr int NPH = 13;
constexpr size_t MiB = 1u << 20;
constexpr size_t WS_CTL = 0, CTL_ZERO_BYTES = 64 * 1024;
constexpr size_t WS_MOD = 3 * MiB;
constexpr size_t WS_ZS = 4 * MiB;
constexpr size_t WS_WINT = 6 * MiB;
constexpr size_t WS_WOUTT = 13 * MiB;
constexpr size_t WS_WEFFT = 15 * MiB;
constexpr size_t WS_GWT = 19 * MiB;
constexpr size_t WS_U = 20 * MiB, WS_V = 52 * MiB;
constexpr size_t WS_HX = 84 * MiB;
constexpr size_t WS_PROJ = 118 * MiB;
constexpr size_t WS_END = 246 * MiB;
constexpr size_t WS_EXL = WS_V, WS_GL = WS_V + 4 * MiB, WS_PL = WS_V + 12 * MiB;
constexpr size_t WS_BLOB0 = WS_V, WS_BLOB1 = WS_HX;
constexpr size_t WS_PART = WS_PROJ, WS_PO = WS_PROJ + 64 * MiB;
static_assert(WS_PROJ + (size_t)MA * NPROJ * 2 <= WS_END && WS_PROJ + (size_t)MX * NSC * 4 <= WS_END && WS_HX + (size_t)MA * D * 2 <= WS_PROJ, "d_ws map");
constexpr int CW_BAR = 1024;
constexpr int RING_BYTES = 131072;
constexpr int LDSCTL_OFF = RING_BYTES, MISC_OFF = LDSCTL_OFF + 320;
constexpr int LDS_BYTES = 147456;

#define GAS __attribute__((address_space(1)))
#define LAS __attribute__((address_space(3)))
typedef unsigned short bf16;
typedef unsigned v4u __attribute__((ext_vector_type(4)));
typedef unsigned v2u __attribute__((ext_vector_type(2)));
typedef float f32x4 __attribute__((ext_vector_type(4)));
typedef float f32x2 __attribute__((ext_vector_type(2)));
typedef float f32x16 __attribute__((ext_vector_type(16)));
typedef short bf16x8 __attribute__((ext_vector_type(8)));
typedef GAS unsigned gu32;
#define RLX_AGENT __ATOMIC_RELAXED, __HIP_MEMORY_SCOPE_AGENT
#define LDS_WAIT() asm volatile("s_waitcnt lgkmcnt(0)" ::: "memory")
#define VM_WAIT() asm volatile("s_waitcnt vmcnt(0)" ::: "memory")
typedef __bf16 bf16v2 __attribute__((ext_vector_type(2)));
__device__ __forceinline__ unsigned pk2(float lo, float hi) { const f32x2 v = {lo, hi}; return __builtin_bit_cast(unsigned, __builtin_convertvector(v, bf16v2)); }
__device__ __forceinline__ float bf_lo(unsigned w) { return __builtin_bit_cast(float, w << 16); }
__device__ __forceinline__ float bf_hi(unsigned w) { return __builtin_bit_cast(float, w & 0xffff0000u); }
__device__ __forceinline__ float bf1(bf16 b) { return __builtin_bit_cast(float, (unsigned)b << 16); }
__device__ __forceinline__ float fast_exp(float x) { return __builtin_amdgcn_exp2f(x * 1.44269504089f); }
__device__ __forceinline__ float fast_rcp(float x) { return __builtin_amdgcn_rcpf(x); }
__device__ __forceinline__ float sigmoidf(float x) { return fast_rcp(1.f + fast_exp(-x)); }
__device__ __forceinline__ float tanh_fast(float x) { return 1.f - 2.f * fast_rcp(fast_exp(2.f * x) + 1.f); }
__device__ __forceinline__ float siluf(float x) { return x * sigmoidf(x); }
template <int CTRL> __device__ __forceinline__ float dppf(float x) { return __builtin_bit_cast(float, __builtin_amdgcn_update_dpp(0, __builtin_bit_cast(int, x), CTRL, 0xF, 0xF, false)); }
template <int CTRL> __device__ __forceinline__ unsigned dppu(unsigned x) { return (unsigned)__builtin_amdgcn_update_dpp(0, (int)x, CTRL, 0xF, 0xF, false); }
__device__ __forceinline__ float rowsum16(float x) { x += dppf<0xB1>(x); x += dppf<0x4E>(x); x += dppf<0x141>(x); x += dppf<0x140>(x); return x; }
__device__ __forceinline__ float wave_sum(float v) {
    v = rowsum16(v); v += __shfl_xor(v, 16); v += __shfl_xor(v, 32); return v;
}
__device__ __forceinline__ float half_sum32(float v) { v = rowsum16(v); v += __shfl_xor(v, 16); return v; }
__device__ __forceinline__ unsigned umaxu(unsigned a, unsigned b) { return a > b ? a : b; }
__device__ __forceinline__ unsigned wave_max_u32(unsigned x) {
    x = umaxu(x, dppu<0xB1>(x)); x = umaxu(x, dppu<0x4E>(x)); x = umaxu(x, dppu<0x141>(x)); x = umaxu(x, dppu<0x140>(x));
    const unsigned a = __builtin_amdgcn_readlane((int)x, 0), b = __builtin_amdgcn_readlane((int)x, 16), c = __builtin_amdgcn_readlane((int)x, 32), d = __builtin_amdgcn_readlane((int)x, 48);
    return umaxu(umaxu(a, b), umaxu(c, d));
}
__device__ __forceinline__ unsigned f2key(float f) { const unsigned u = __builtin_bit_cast(unsigned, f); return (u & 0x80000000u) ? ~u : (u | 0x80000000u); }
__device__ __forceinline__ float key2f(unsigned k) { const unsigned u = (k & 0x80000000u) ? (k ^ 0x80000000u) : ~k; return __builtin_bit_cast(float, u); }
#define XB_TMO      128
#define XB_XCNT(j)  (256  + 64 * (j))
#define XB_XSUB(j)  (1280 + 64 * (j))
#define XB_XGEN(j)  (2304 + 64 * (j))
#define XB_TOP      3328
#define XB_TOPGEN   3392
#define XCD_BAR_WORDS 3456
#define XB_SPIN_CAP (1u << 18)

__device__ __forceinline__ unsigned xb_ld(unsigned* p)              { return __hip_atomic_load(p, __ATOMIC_RELAXED, __HIP_MEMORY_SCOPE_AGENT); }
__device__ __forceinline__ unsigned xb_add(unsigned* p, unsigned v) { return __hip_atomic_fetch_add(p, v, __ATOMIC_RELAXED, __HIP_MEMORY_SCOPE_AGENT); }
__device__ __forceinline__ unsigned xb_xcc_id() { return (unsigned)__builtin_amdgcn_s_getreg((3 << 11) | 20) & 0xFu; }
#define XB_SPIN(cond, bar) do { unsigned _sp = 0; while (cond) { __builtin_amdgcn_s_sleep(1); \
    if ((++_sp & 255u) == 0u) { if (xb_ld(&(bar)[XB_TMO])) break; if (_sp > XB_SPIN_CAP) { atomicAdd(&(bar)[XB_TMO], 1u); break; } } } } while (0)

struct XcdBarrier {
    unsigned* bar; unsigned x;
    volatile LAS unsigned* st;
};

__device__ __forceinline__ XcdBarrier xcd_barrier_post(unsigned* bar, volatile LAS unsigned* st) {
    XcdBarrier b; b.bar = bar; b.x = xb_xcc_id(); b.st = st;
    if (threadIdx.x == 0) (void)xb_add(&bar[XB_XCNT(b.x)], 1u);
    return b;
}
__device__ __forceinline__ void xcd_barrier_complete(unsigned* bar, unsigned x, unsigned& nloc, unsigned& nx) {
    const unsigned G = gridDim.x * gridDim.y * gridDim.z;
    unsigned sum, cnt, mine, sp = 0u;
    for (;;) {
        sum = 0u; cnt = 0u; mine = 0u;
#pragma unroll
        for (unsigned j = 0; j < 16; ++j) { const unsigned c = xb_ld(&bar[XB_XCNT(j)]); sum += c; cnt += (c > 0u) ? 1u : 0u; mine = (j == x) ? c : mine; }
        if (sum == G) break;
        __builtin_amdgcn_s_sleep(1);
        if ((++sp & 255u) == 0u) { if (xb_ld(&bar[XB_TMO])) break; if (sp > XB_SPIN_CAP) { atomicAdd(&bar[XB_TMO], 1u); break; } }
    }
    nloc = mine > 0u ? mine : 1u; nx = cnt > 0u ? cnt : 1u;
}

__device__ __forceinline__ void xcd_barrier(const XcdBarrier& b) {
    asm volatile("s_waitcnt vmcnt(0)" ::: "memory");
    __syncthreads();
    if (threadIdx.x == 0) {
        unsigned* bar = b.bar;
        __builtin_amdgcn_s_waitcnt(0);
        unsigned nloc = b.st[0], nx = b.st[1];
        if (nloc == 0u) { xcd_barrier_complete(bar, b.x, nloc, nx); b.st[0] = nloc; b.st[1] = nx; }
        const unsigned old = xb_add(&bar[XB_XSUB(b.x)], 1u);
        const unsigned gen = old / nloc;
        if (old + 1u == (gen + 1u) * nloc) {
            __builtin_amdgcn_fence(__ATOMIC_RELEASE, "agent");
            asm volatile("s_waitcnt vmcnt(0)" ::: "memory");
            const unsigned og = xb_add(&bar[XB_TOP], 1u);
            const unsigned tg = og / nx;
            if (og + 1u == (tg + 1u) * nx) xb_add(&bar[XB_TOPGEN], 1u);
            else XB_SPIN(xb_ld(&bar[XB_TOPGEN]) == tg, bar);
            __builtin_amdgcn_fence(__ATOMIC_ACQUIRE, "agent");
            xb_add(&bar[XB_XGEN(b.x)], 1u);
            asm volatile("s_waitcnt vmcnt(0)" ::: "memory");
        } else {
            XB_SPIN(xb_ld(&bar[XB_XGEN(b.x)]) == gen, bar);
            __builtin_amdgcn_fence(__ATOMIC_ACQUIRE, "agent");
            asm volatile("s_waitcnt vmcnt(0)" ::: "memory");
        }
    }
    __syncthreads();
}
struct Frame {
    LAS unsigned char* lds;
    volatile LAS unsigned* MISC;
    gu32* ctl;
    int tid, lane, wave, G, bid;
    const float* in[25];
    float* out;
    unsigned char* ws;
};
enum { I_X = 0, I_C, I_CTX, I_CCTX, I_WMOD, I_BMOD, I_NG, I_WIN, I_WOUT, I_CONVW, I_TMU, I_DW0, I_DW2, I_A0, I_A2, I_GW2, I_KK, I_KA, I_RK, I_LNG, I_LNB, I_WQ, I_SUBK, I_PU, I_PV };

__device__ __forceinline__ void p0_transpose_item(const float* W, int K, int N, bf16* WT, LAS float* scr, int item, int lane) {
    const int nblk = N / 32, kb = item / nblk, nb = item % nblk, k0 = 64 * kb, n0 = 32 * nb;
#pragma unroll 8
    for (int i = 0; i < 32; ++i) { const int kk = 2 * i + (lane >> 5); scr[kk * 33 + (lane & 31)] = W[(size_t)(k0 + kk) * N + n0 + (lane & 31)]; }
    LDS_WAIT(); asm volatile("" ::: "memory");
    const int c = lane & 7;
#pragma unroll
    for (int j = 0; j < 4; ++j) { const int n = (lane >> 3) + 8 * j; const LAS float* s = scr + (8 * c) * 33 + n;
        v4u o; o.x = pk2(s[0 * 33], s[1 * 33]); o.y = pk2(s[2 * 33], s[3 * 33]); o.z = pk2(s[4 * 33], s[5 * 33]); o.w = pk2(s[6 * 33], s[7 * 33]);
        *(v4u*)(WT + (size_t)(n0 + n) * K + k0 + 8 * c) = o; }
    LDS_WAIT(); asm volatile("" ::: "memory");
}
__device__ __forceinline__ void p0_mod_item(Frame& F, int cb) {
    LAS float* S = (LAS float*)F.lds;
    LAS float* RED = (LAS float*)(F.lds + 32768);
    const float* c = F.in[I_C]; const float* cc = F.in[I_CCTX];
    for (int i = F.tid; i < 5 * D; i += 512) { const int r = i >> 10, k = i & 1023; const float v = (r < 4) ? c[r * D + k] : cc[k]; S[i] = siluf(v); }
    __syncthreads();
    const int col = F.tid & 63, kg = F.tid >> 6;
    const float* wp = F.in[I_WMOD] + (size_t)(kg * 128) * NMOD + cb * 64 + col;
    float a0 = 0.f, a1 = 0.f, a2 = 0.f, a3 = 0.f, a4 = 0.f;
#pragma unroll 8
    for (int k = 0; k < 128; ++k) { const float w = wp[(size_t)k * NMOD]; const int kk = kg * 128 + k;
        a0 += S[kk] * w; a1 += S[D + kk] * w; a2 += S[2 * D + kk] * w; a3 += S[3 * D + kk] * w; a4 += S[4 * D + kk] * w; }
    RED[(kg * 5 + 0) * 64 + col] = a0; RED[(kg * 5 + 1) * 64 + col] = a1; RED[(kg * 5 + 2) * 64 + col] = a2; RED[(kg * 5 + 3) * 64 + col] = a3; RED[(kg * 5 + 4) * 64 + col] = a4;
    __syncthreads();
    if (F.tid < 320) { const int r = F.tid >> 6, cl = F.tid & 63; float s = F.in[I_BMOD][cb * 64 + cl];
#pragma unroll
        for (int g = 0; g < 8; ++g) s += RED[(g * 5 + r) * 64 + cl];
        ((float*)(F.ws + WS_MOD))[r * NMOD + cb * 64 + cl] = s; }
    __syncthreads();
}
__device__ __forceinline__ void p0_weff_item(Frame& F, int item) {
    const int hs = item >> 4, kb = item & 15;
    LAS float* SK = (LAS float*)F.lds;
    LAS float* WQ = (LAS float*)(F.lds + 128 * 132 * 4);
    const float* sk = F.in[I_SUBK] + (size_t)hs * 128 * 128;
    const float* wq = F.in[I_WQ] + (size_t)(kb * 64) * 2048 + hs * 128;
#pragma unroll
    for (int i = 0; i < 8; ++i) { const int idx = F.tid + 512 * i, row = idx >> 5, c4 = idx & 31; const f32x4 v = *(const f32x4*)(sk + row * 128 + c4 * 4); *(LAS f32x4*)(SK + row * 132 + c4 * 4) = v; }
#pragma unroll
    for (int i = 0; i < 4; ++i) { const int idx = F.tid + 512 * i, row = idx >> 5, c4 = idx & 31; const f32x4 v = *(const f32x4*)(wq + (size_t)row * 2048 + c4 * 4); *(LAS f32x4*)(WQ + row * 132 + c4 * 4) = v; }
    __syncthreads();
    const int key = F.tid >> 2, kq = F.tid & 3;
    float acc[16];
#pragma unroll
    for (int i = 0; i < 16; ++i) acc[i] = 0.f;
    for (int d = 0; d < 128; d += 4) {
        const f32x4 a = *(const LAS f32x4*)(SK + key * 132 + d);
#pragma unroll
        for (int i = 0; i < 16; ++i) { const f32x4 b = *(const LAS f32x4*)(WQ + (4 * i + kq) * 132 + d); acc[i] += a.x * b.x + a.y * b.y + a.z * b.z + a.w * b.w; }
    }
    bf16* dst = (bf16*)(F.ws + WS_WEFFT) + (size_t)(hs * 128 + key) * D + kb * 64;
#pragma unroll
    for (int i = 0; i < 16; ++i) dst[4 * i + kq] = (bf16)(pk2(acc[i], 0.f) & 0xffffu);
    __syncthreads();
}
__device__ __forceinline__ void p0_prep(Frame& F) {
    for (int it = F.bid; it < 96 + 256; it += F.G) { if (it < 96) p0_mod_item(F, it); else p0_weff_item(F, it - 96); }
    LAS float* scr = (LAS float*)(F.lds + F.wave * 16384);
    const int gw = F.bid * NWAVES + F.wave, NGW = F.G * NWAVES;
    constexpr int I_IN = (D / 64) * (NPROJ / 32), I_OUT = (D / 64) * (D / 32), I_GW = (128 / 64) * (512 / 32);
    for (int it = gw; it < I_IN + I_OUT + I_GW; it += NGW) {
        if (it < I_IN) p0_transpose_item(F.in[I_WIN], D, NPROJ, (bf16*)(F.ws + WS_WINT), scr, it, F.lane);
        else if (it < I_IN + I_OUT) p0_transpose_item(F.in[I_WOUT], D, D, (bf16*)(F.ws + WS_WOUTT), scr, it - I_IN, F.lane);
        else p0_transpose_item(F.in[I_GW2], 128, 512, (bf16*)(F.ws + WS_GWT), scr, it - I_IN - I_OUT, F.lane);
    }
    { v4u* z = (v4u*)((bf16*)(F.ws + WS_WINT) + (size_t)NPROJ * D); const int n16 = (NPROJ_PAD - NPROJ) * D * 2 / 16;
      for (int i = F.bid * 512 + F.tid; i < n16; i += F.G * 512) z[i] = (v4u){0u, 0u, 0u, 0u}; }
    { const f32x4* pu = (const f32x4*)F.in[I_PU]; v2u* du = (v2u*)(F.ws + WS_U);
      const int n8 = NEXP * D / 8;
      for (int i = F.bid * 512 + F.tid; i < n8; i += F.G * 512) {
          const f32x4 a0 = pu[2 * i] * 32.f, a1 = pu[2 * i + 1] * 32.f;
          int w0 = __builtin_amdgcn_cvt_pk_fp8_f32(a0.x, a0.y, 0, false); w0 = __builtin_amdgcn_cvt_pk_fp8_f32(a0.z, a0.w, w0, true);
          int w1 = __builtin_amdgcn_cvt_pk_fp8_f32(a1.x, a1.y, 0, false); w1 = __builtin_amdgcn_cvt_pk_fp8_f32(a1.z, a1.w, w1, true);
          du[i] = (v2u){(unsigned)w0, (unsigned)w1}; } }
}

__device__ __forceinline__ void p1_hx(Frame& F) {
    const float* mod = (const float*)(F.ws + WS_MOD); const float* ng = F.in[I_NG];
    bf16* hx = (bf16*)(F.ws + WS_HX);
    for (int m = F.bid * NWAVES + F.wave; m < MA; m += F.G * NWAVES) {
        const float* src = (m < MX) ? F.in[I_X] + (size_t)m * D : F.in[I_CTX] + (size_t)(m - MX) * D;
        const float* mr = mod + ((m < MX) ? (m >> 12) : 4) * NMOD;
        f32x4 v[4]; float ss = 0.f;
#pragma unroll
        for (int j = 0; j < 4; ++j) { v[j] = *(const f32x4*)(src + j * 256 + F.lane * 4); ss += v[j].x * v[j].x + v[j].y * v[j].y + v[j].z * v[j].z + v[j].w * v[j].w; }
        const float rstd = __builtin_amdgcn_rsqf(wave_sum(ss) * (1.f / D) + NORM_EPS);
#pragma unroll
        for (int j = 0; j < 4; ++j) { const int c = j * 256 + F.lane * 4;
            const f32x4 g = *(const f32x4*)(ng + c), sh = *(const f32x4*)(mr + c), sc = *(const f32x4*)(mr + D + c);
            const float o0 = v[j].x * rstd * g.x * (1.f + sc.x) + sh.x, o1 = v[j].y * rstd * g.y * (1.f + sc.y) + sh.y, o2 = v[j].z * rstd * g.z * (1.f + sc.z) + sh.z, o3 = v[j].w * rstd * g.w * (1.f + sc.w) + sh.w;
            *(v2u*)(hx + (size_t)m * D + c) = (v2u){pk2(o0, o1), pk2(o2, o3)}; }
    }
}
constexpr int BL_APT = 0, BL_NPT = 4608, BL_RH = 7168, BL_MKR = 11776, BL_MBR = 14336, BL_KGC = 16896, BL_BGC = 22016, BL_GC = 27136, BL_VT = 27648, BL_BYTES = 32768;
constexpr int CS_AH = 32768, CS_BH = 37376, CS_KH = 41984, CS_AHC = 46592, CS_E = 51712, CS_RAW = 59904, CS_TLW = 72960, CS_LOA = 77568, CS_W2T = 82176, CS_A2T = 91392,
              CS_LG = 100608, CS_NBA = 100608, CS_NKA = 105216, CS_TT = 107776, CS_CONST = 116992, CS_END = 119552;
constexpr int CS_RH = BL_RH, CS_KGC = BL_KGC, CS_BGC = BL_BGC, CS_VT = BL_VT, CS_GC = BL_GC, CS_APT = BL_APT, CS_NPT = BL_NPT, CS_MKR = BL_MKR, CS_MBR = BL_MBR;
constexpr int SC_NTILE = (TC + T) / 32, SC_RT = 16, SC_NROUND = (SC_NTILE + SC_RT - 1) / SC_RT;
constexpr int SC_ST = 1;
constexpr int GS_YS = 65536;
__device__ __forceinline__ void scan_issue_loads(const bf16* proj, int b, int h, int d, int tile, int tid, v4u (&rg)[3]) {
    const bool isctx = tile < TC / 32; const int L = isctx ? TC : T; const int jt = isctx ? tile : tile - TC / 32;
    const size_t rowbase = isctx ? (size_t)(MX + b * TC) : (size_t)b * T;
    const int tlo = d == 0 ? 32 * jt : L - 32 * (jt + 1);
#pragma unroll
    for (int i = 0; i < 3; ++i) {
        const int q = tid + 512 * i; v4u val = (v4u){0u, 0u, 0u, 0u};
        if (q < 816) { const int row = q / 24, rem = q - row * 24, which = rem >> 3, ch8 = rem & 7; const int tok = tlo - 1 + row;
            if (tok >= 0 && tok < L) val = *(const v4u*)(proj + (rowbase + tok) * NPROJ + COL_R + which * 512 + h * 64 + ch8 * 8); }
        else if (q < 1328) { const int q2 = q - 816, row = q2 >> 4, rem = q2 & 15, which = rem >> 3, ch8 = rem & 7; const int tok = tlo + row;
            val = *(const v4u*)(proj + (rowbase + tok) * NPROJ + (which ? COL_LA : COL_LW) + d * 64 + ch8 * 8); }
        rg[i] = val;
    }
}
__device__ __forceinline__ unsigned tanh_pk(unsigned w) { return pk2(tanh_fast(bf_lo(w)), tanh_fast(bf_hi(w))); }
__device__ __forceinline__ void scan_store_raw(LAS unsigned char* lds, int tid, const v4u (&rg)[3]) {
#pragma unroll
    for (int i = 0; i < 3; ++i) {
        const int q = tid + 512 * i;
        if (q < 816) { const int row = q / 24, rem = q - row * 24, which = rem >> 3, ch8 = rem & 7; *(LAS v4u*)(lds + CS_RAW + (which * 34 + row) * 128 + ch8 * 16) = rg[i]; }
        else if (q < 1328) { const int q2 = q - 816, row = q2 >> 4, rem = q2 & 15, which = rem >> 3, ch8 = rem & 7;
            if (which) *(LAS v4u*)(lds + CS_LOA + row * 144 + ch8 * 16) = rg[i];
            else { v4u t; t.x = tanh_pk(rg[i].x); t.y = tanh_pk(rg[i].y); t.z = tanh_pk(rg[i].z); t.w = tanh_pk(rg[i].w); *(LAS v4u*)(lds + CS_TLW + row * 144 + ch8 * 16) = t; } }
    }
}
__device__ __forceinline__ v2u pack4(f32x4 v) { return (v2u){pk2(v.x, v.y), pk2(v.z, v.w)}; }
__device__ __forceinline__ bf16 bfs(float v) { return (bf16)(pk2(v, 0.f) & 0xffffu); }
typedef v2u v2u_t;
__device__ __forceinline__ bf16x8 frag2(const LAS unsigned char* p0, const LAS unsigned char* p1) {
    const v2u a = *(const LAS v2u*)p0, b = *(const LAS v2u*)p1; const v4u w = (v4u){a.x, a.y, b.x, b.y}; return __builtin_bit_cast(bf16x8, w);
}
__device__ __forceinline__ bf16x8 frag_acc(f32x4 lo, f32x4 hi) { const v4u w = (v4u){pk2(lo.x, lo.y), pk2(lo.z, lo.w), pk2(hi.x, hi.y), pk2(hi.z, hi.w)}; return __builtin_bit_cast(bf16x8, w); }
__device__ __forceinline__ bf16x8 frag_zero() { const v4u w = (v4u){0u, 0u, 0u, 0u}; return __builtin_bit_cast(bf16x8, w); }
__device__ __forceinline__ void scan_prep_task(Frame& F, const bf16* proj, int chain, int tile, bool load_consts, bool have_next, int nchain, int ntile, v4u (&rg)[3], unsigned char* blob) {
    LAS unsigned char* lds = F.lds; const int tid = F.tid, lane = F.lane, wave = F.wave;
    const int b = chain >> 4, h = (chain >> 1) & 7, d = chain & 1, nb = nchain >> 4, nh = (nchain >> 1) & 7, nd = nchain & 1;
    if (load_consts) {
        __syncthreads();
        LAS float* C = (LAS float*)(lds + CS_CONST);
        if (tid < 384) { const int pn = tid / 192, r = tid - pn * 192, which = r >> 6, c = r & 63; C[pn * 192 + which * 64 + c] = F.in[I_TMU][(pn * 3 + which) * 512 + h * 64 + c]; }
        else if (tid < 448) { const int c = tid - 384; C[384 + c] = F.in[I_KK][h * 64 + c]; C[448 + c] = F.in[I_KA][h * 64 + c]; }
        else { const int c = tid - 448; C[512 + c] = F.in[I_DW0][d * 512 + h * 64 + c]; C[576 + c] = F.in[I_A0][d * 512 + h * 64 + c]; }
        const float* w2 = F.in[I_DW2] + (size_t)d * 64 * 512 + h * 64; const float* a2 = F.in[I_A2] + (size_t)d * 64 * 512 + h * 64;
#pragma unroll
        for (int i = 0; i < 8; ++i) { const int idx = tid + 512 * i, j = idx >> 6, c = idx & 63;
            *(LAS bf16*)(lds + CS_W2T + c * 144 + j * 2) = bfs(w2[j * 512 + c]);
            *(LAS bf16*)(lds + CS_A2T + c * 144 + j * 2) = bfs(a2[j * 512 + c]); }
    }
    {
            scan_store_raw(lds, tid, rg);
            __syncthreads();
            if (have_next) scan_issue_loads(proj, nb, nh, nd, ntile, tid, rg);
            if (wave < 4) {
                const int mat = wave >> 1, nt = wave & 1, r = lane & 31, hh = lane >> 5;
                const LAS unsigned char* Ab = lds + (mat ? CS_LOA : CS_TLW) + r * 144 + hh * 16;
                const LAS unsigned char* Bb = lds + (mat ? CS_A2T : CS_W2T) + (nt * 32 + r) * 144 + hh * 16;
                f32x16 acc;
#pragma unroll
                for (int i = 0; i < 16; ++i) acc[i] = 0.f;
#pragma unroll
                for (int ks = 0; ks < 4; ++ks) { const bf16x8 a = *(const LAS bf16x8*)(Ab + ks * 32), bb = *(const LAS bf16x8*)(Bb + ks * 32); acc = __builtin_amdgcn_mfma_f32_32x32x16_bf16(a, bb, acc, 0, 0, 0); }
                LAS float* LG = (LAS float*)(lds + CS_LG) + mat * 2048 + nt * 32 + r;
#pragma unroll
                for (int i = 0; i < 16; ++i) LG[((i & 3) + 8 * (i >> 2) + 4 * hh) * 64] = acc[i];
            }
            __syncthreads();
            const int tok = tid >> 4, cq = tid & 15, c0 = cq * 4, s = d == 0 ? tok : 31 - tok;
            f32x4 rs, vs, kd, kk, kka, ev;
            { const LAS float* C = (const LAS float*)(lds + CS_CONST);
              f32x4 xs[3];
#pragma unroll
              for (int which = 0; which < 3; ++which) {
                  const LAS unsigned char* rp = lds + CS_RAW + (which * 34 + tok) * 128 + c0 * 2;
                  const v2u p = *(const LAS v2u*)rp, x = *(const LAS v2u*)(rp + 128), n = *(const LAS v2u*)(rp + 256);
                  const f32x4 mp = *(const LAS f32x4*)(C + which * 64 + c0), mn = *(const LAS f32x4*)(C + 192 + which * 64 + c0);
                  const f32x4 xp = (f32x4){bf_lo(p.x), bf_hi(p.x), bf_lo(p.y), bf_hi(p.y)}, xc = (f32x4){bf_lo(x.x), bf_hi(x.x), bf_lo(x.y), bf_hi(x.y)}, xn = (f32x4){bf_lo(n.x), bf_hi(n.x), bf_lo(n.y), bf_hi(n.y)};
                  xs[which] = xc + mp * (xp - xc) + mn * (xn - xc); }
              const f32x4 kkc = *(const LAS f32x4*)(C + 384 + c0), kac = *(const LAS f32x4*)(C + 448 + c0), w0 = *(const LAS f32x4*)(C + 512 + c0), a0 = *(const LAS f32x4*)(C + 576 + c0);
              kk = xs[1] * kkc;
              const float ss = rowsum16(kk.x * kk.x + kk.y * kk.y + kk.z * kk.z + kk.w * kk.w);
              kk = kk * __builtin_amdgcn_rsqf(ss + 1e-12f);
              const f32x4 uw = *(const LAS f32x4*)(lds + CS_LG + (tok * 64 + c0) * 4) + w0, ua = *(const LAS f32x4*)(lds + CS_LG + 8192 + (tok * 64 + c0) * 4) + a0;
              f32x4 av;
#pragma unroll
              for (int e = 0; e < 4; ++e) { ev[e] = 0.60653066f * sigmoidf(uw[e]); av[e] = sigmoidf(ua[e]); }
              kd = xs[1] * (1.f + (av - 1.f) * kac); kka = kk * av; rs = xs[0]; vs = xs[2];
              *(LAS f32x4*)(lds + CS_E + (s * 64 + c0) * 4) = ev; }
            __syncthreads();
            { const int cb = s & 16, sl = s & 15;
              f32x4 cum = (f32x4){0.f, 0.f, 0.f, 0.f}, tot = cum;
#pragma unroll
              for (int ii = 0; ii < 16; ++ii) { const f32x4 e4 = *(const LAS f32x4*)(lds + CS_E + ((cb + ii) * 64 + c0) * 4); tot = tot + e4; if (ii <= sl) cum = cum + e4; }
              f32x4 g, gm1, gi, ge, gt;
#pragma unroll
              for (int e = 0; e < 4; ++e) { g[e] = fast_exp(-cum[e]); gm1[e] = fast_exp(ev[e] - cum[e]); gi[e] = fast_exp(cum[e]); ge[e] = fast_exp(cum[e] - tot[e]); gt[e] = fast_exp(-tot[e]); }
              const f32x4 ah = gm1 * kk, bh = kka * gi, kh = kd * gi, rh = g * rs, kg = kd * ge, bg = kka * ge;
              *(LAS v2u*)(lds + CS_AH + s * 144 + c0 * 2) = pack4(ah); *(LAS v2u*)(lds + CS_BH + s * 144 + c0 * 2) = pack4(bh);
              *(LAS v2u*)(lds + CS_KH + s * 144 + c0 * 2) = pack4(kh); *(LAS v2u*)(lds + CS_RH + s * 144 + c0 * 2) = pack4(rh);
#pragma unroll
              for (int e = 0; e < 4; ++e) { *(LAS bf16*)(lds + CS_AHC + (c0 + e) * 80 + s * 2) = bfs(ah[e]); *(LAS bf16*)(lds + CS_KGC + (c0 + e) * 80 + s * 2) = bfs(kg[e]); *(LAS bf16*)(lds + CS_BGC + (c0 + e) * 80 + s * 2) = bfs(-bg[e]); }
#pragma unroll
              for (int e = 0; e < 4; ++e) *(LAS bf16*)(lds + CS_VT + (c0 + e) * 80 + s * 2) = bfs(vs[e]);
              if (sl == 15) *(LAS f32x4*)(lds + CS_GC + ((s >> 4) * 64 + c0) * 4) = gt; }
            __syncthreads();
            if (wave < 4) {
                const int r = lane & 31, hh = lane >> 5;
                const LAS unsigned char* Ab = lds + ((wave == 0 || wave == 3) ? CS_BH : CS_KH) + r * 144 + hh * 16;
                const LAS unsigned char* Bb = lds + (wave < 2 ? CS_AH : CS_RH) + r * 144 + hh * 16;
                f32x16 acc;
#pragma unroll
                for (int i = 0; i < 16; ++i) acc[i] = 0.f;
#pragma unroll
                for (int ks = 0; ks < 4; ++ks) { const bf16x8 a = *(const LAS bf16x8*)(Ab + ks * 32), bb = *(const LAS bf16x8*)(Bb + ks * 32); acc = __builtin_amdgcn_mfma_f32_32x32x16_bf16(a, bb, acc, 0, 0, 0); }
                const int t = r;
#pragma unroll
                for (int i = 0; i < 16; ++i) { const int j = (i & 3) + 8 * (i >> 2) + 4 * hh; const bool same = (j >> 4) == (t >> 4);
                    const bool keep = same && (wave < 2 ? (j < t) : (j <= t)); acc[i] = keep ? acc[i] : 0.f; }
                if (wave == 0) {
#pragma unroll
                    for (int i = 0; i < 16; ++i) { const int j = (i & 3) + 8 * (i >> 2) + 4 * hh; *(LAS float*)(lds + CS_NBA + (t * 36 + j) * 4) = acc[i]; } }
                else if (wave == 1) {
#pragma unroll
                    for (int i = 0; i < 16; ++i) { const int j = (i & 3) + 8 * (i >> 2) + 4 * hh; *(LAS bf16*)(lds + CS_NKA + j * 80 + t * 2) = bfs(acc[i]); } }
                else { const float sg = wave == 2 ? 1.f : -1.f; const int base = wave == 2 ? CS_MKR : CS_MBR;
#pragma unroll
                    for (int q4 = 0; q4 < 4; ++q4) *(LAS v2u*)(lds + base + t * 80 + (8 * q4 + 4 * hh) * 2) = pack4((f32x4){sg * acc[4 * q4], sg * acc[4 * q4 + 1], sg * acc[4 * q4 + 2], sg * acc[4 * q4 + 3]}); }
            }
            __syncthreads();
            if (wave == 0 && lane < 32) {
                const int blk = lane >> 4, i = lane & 15;
                float Tr[16];
#pragma unroll
                for (int t = 0; t < 16; ++t) {
                    float acc = (t == i) ? 1.f : 0.f;
                    const LAS float* np = (const LAS float*)(lds + CS_NBA) + (16 * blk + t) * 36 + 16 * blk;
#pragma unroll
                    for (int j = 0; j < t; ++j) acc -= Tr[j] * np[j];
                    Tr[t] = acc;
                }
#pragma unroll
                for (int t = 0; t < 16; ++t) { *(LAS bf16*)(lds + CS_TT + (16 * blk + t) * 80 + (16 * blk + i) * 2) = bfs(Tr[t]); *(LAS bf16*)(lds + CS_TT + (16 * blk + t) * 80 + (16 * (1 - blk) + i) * 2) = (bf16)0; }
            }
            __syncthreads();
            if (wave < 3) {
                const int r = lane & 31, hh = lane >> 5;
                const LAS unsigned char* Ab = lds + (wave < 2 ? CS_AHC + (32 * wave + r) * 80 : CS_NKA + r * 80) + hh * 16;
                const LAS unsigned char* Bb = lds + CS_TT + r * 80 + hh * 16;
                f32x16 acc;
#pragma unroll
                for (int i = 0; i < 16; ++i) acc[i] = 0.f;
#pragma unroll
                for (int ks = 0; ks < 2; ++ks) { const bf16x8 a = *(const LAS bf16x8*)(Ab + ks * 32), bb = *(const LAS bf16x8*)(Bb + ks * 32); acc = __builtin_amdgcn_mfma_f32_32x32x16_bf16(a, bb, acc, 0, 0, 0); }
                const int t = r;
#pragma unroll
                for (int q4 = 0; q4 < 4; ++q4) { const v2u pk = pack4((f32x4){acc[4 * q4], acc[4 * q4 + 1], acc[4 * q4 + 2], acc[4 * q4 + 3]});
                    if (wave < 2) *(LAS v2u*)(lds + CS_APT + t * 144 + (32 * wave + 8 * q4 + 4 * hh) * 2) = pk;
                    else *(LAS v2u*)(lds + CS_NPT + t * 80 + (8 * q4 + 4 * hh) * 2) = pk; }
            }
            __syncthreads();
#pragma unroll
            for (int i = 0; i < 4; ++i) { const int idx = tid + 512 * i; *(v4u*)(blob + idx * 16) = *(const LAS v4u*)(lds + idx * 16); }
    }
}
__device__ __forceinline__ void scan_y_store(Frame& F, int chain, int tile, int t0, int tid2) {
    const int b = chain >> 4, h = (chain >> 1) & 7, d = chain & 1;
    const int jt = tile - TC / 32, tlo = d == 0 ? 32 * jt : T - 32 * (jt + 1);
    const int s2 = tid2 >> 3, part = tid2 & 7; const int tk = d == 0 ? tlo + s2 : tlo + 31 - s2;
    const LAS float* ys = (const LAS float*)(F.lds + GS_YS + ((tile - t0) & 1) * 8192) + s2 * 64 + part * 8;
    float* dst = F.out + ((size_t)(b * T + tk)) * D + d * 512 + h * 64 + part * 8;
    *(f32x4*)dst = *(const LAS f32x4*)ys; *(f32x4*)(dst + 4) = *(const LAS f32x4*)(ys + 4);
}
__device__ __forceinline__ void scan_state_round(Frame& F, int chain, int t0, int t1, const unsigned char* blobs) {
    LAS unsigned char* lds = F.lds; const int tid = F.tid, lane = F.lane, wave = F.wave;
    f32x4* zs = (f32x4*)(F.ws + WS_ZS) + ((size_t)chain * 256 + (tid & 255)) * 4;
    f32x4 Z[4];
#pragma unroll
    for (int kt = 0; kt < 4; ++kt) Z[kt] = (t0 > 0 && wave < 4) ? zs[kt] : (f32x4){0.f, 0.f, 0.f, 0.f};
    __syncthreads();
    { v4u b0[4];
#pragma unroll
      for (int i = 0; i < 4; ++i) b0[i] = *(const v4u*)(blobs + (tid + 512 * i) * 16);
#pragma unroll
      for (int i = 0; i < 4; ++i) *(LAS v4u*)(lds + (tid + 512 * i) * 16) = b0[i]; }
    const int tid2 = tid - 256;
    v4u bg[4];
    if (t0 + 1 < t1) {
#pragma unroll
        for (int i = 0; i < 4; ++i) bg[i] = *(const v4u*)(blobs + (size_t)BL_BYTES + (tid + 512 * i) * 16); }
    __syncthreads();
    for (int tile = t0; tile < t1; ++tile) {
        const bool isctx = tile < TC / 32;
        const LAS unsigned char* bl = lds + ((tile - t0) & 1) * BL_BYTES;
        if (tile + 1 < t1) {
#pragma unroll
            for (int i = 0; i < 4; ++i) *(LAS v4u*)(lds + ((tile + 1 - t0) & 1) * BL_BYTES + (tid + 512 * i) * 16) = bg[i]; }
        if (tile + 2 < t1) {
#pragma unroll
            for (int i = 0; i < 4; ++i) bg[i] = *(const v4u*)(blobs + (size_t)(tile + 2 - t0) * BL_BYTES + (tid + 512 * i) * 16); }
        if (wave >= 4 && tile > t0 && tile - 1 >= TC / 32) scan_y_store(F, chain, tile - 1, t0, tid2);
        if (wave < 4) {
            const int n = lane & 15, g = lane >> 4;
            const bf16x8 bvt = *(const LAS bf16x8*)(bl + BL_VT + (16 * wave + n) * 80 + g * 16);
            f32x4 U[2]; U[0] = (f32x4){0.f, 0.f, 0.f, 0.f}; U[1] = U[0];
#pragma unroll
            for (int cc = 0; cc < 2; ++cc) {
                if (cc == 1) __builtin_amdgcn_sched_barrier(0);
                const int trow = 16 * cc + n;
                const LAS unsigned char* ap = bl + BL_APT + trow * 144; const LAS unsigned char* rp = bl + BL_RH + trow * 144; const LAS unsigned char* mp = bl + BL_MBR + trow * 80;
                const bf16x8 fAP0 = frag2(ap + (4 * g) * 2, ap + (16 + 4 * g) * 2), fAP1 = frag2(ap + (32 + 4 * g) * 2, ap + (48 + 4 * g) * 2);
                const bf16x8 fNP = *(const LAS bf16x8*)(bl + BL_NPT + trow * 80 + g * 16);
                f32x4 gcv = *(const LAS f32x4*)(bl + BL_GC + (cc * 64 + 4 * g) * 4);
                bf16x8 fKG = *(const LAS bf16x8*)(bl + BL_KGC + n * 80 + g * 16);
                v2u fBG = *(const LAS v2u*)(bl + BL_BGC + n * 80 + (16 * cc + 4 * g) * 2);
                asm volatile("" :: "v"(fAP0), "v"(fAP1), "v"(fNP), "v"(gcv), "v"(fKG), "v"(fBG));
                const bf16x8 bz01 = frag_acc(Z[0], Z[1]), bz23 = frag_acc(Z[2], Z[3]);
                f32x4 u = __builtin_amdgcn_mfma_f32_16x16x32_bf16(fAP0, bz01, (f32x4){0.f, 0.f, 0.f, 0.f}, 0, 0, 0);
                u = __builtin_amdgcn_mfma_f32_16x16x32_bf16(fAP1, bz23, u, 0, 0, 0);
                u = __builtin_amdgcn_mfma_f32_16x16x32_bf16(fNP, bvt, u, 0, 0, 0);
                U[cc] = u;
                const bf16x8 bu = frag_acc(U[0], U[1]);
                if (!isctx) {
                    const bf16x8 fRH0 = frag2(rp + (4 * g) * 2, rp + (16 + 4 * g) * 2), fRH1 = frag2(rp + (32 + 4 * g) * 2, rp + (48 + 4 * g) * 2);
                    const bf16x8 fMK = *(const LAS bf16x8*)(bl + BL_MKR + trow * 80 + g * 16);
                    const bf16x8 fMB = frag2(mp + (4 * g) * 2, mp + (16 + 4 * g) * 2);
                    asm volatile("" :: "v"(fRH0), "v"(fRH1), "v"(fMK), "v"(fMB));
                    f32x4 y = __builtin_amdgcn_mfma_f32_16x16x32_bf16(fRH0, bz01, (f32x4){0.f, 0.f, 0.f, 0.f}, 0, 0, 0);
                    y = __builtin_amdgcn_mfma_f32_16x16x32_bf16(fRH1, bz23, y, 0, 0, 0);
                    y = __builtin_amdgcn_mfma_f32_16x16x32_bf16(fMK, bvt, y, 0, 0, 0);
                    y = __builtin_amdgcn_mfma_f32_16x16x32_bf16(fMB, bu, y, 0, 0, 0);
#pragma unroll
                    for (int i = 0; i < 4; ++i) *(LAS float*)(lds + GS_YS + ((tile - t0) & 1) * 8192 + ((16 * cc + 4 * g + i) * 64 + 16 * wave + n) * 4) = y[i]; }
#pragma unroll
                for (int kt = 0; kt < 4; ++kt) {
                    f32x4 gcn = gcv; bf16x8 fKGn = fKG; v2u fBGn = fBG;
                    if (kt < 3) { gcn = *(const LAS f32x4*)(bl + BL_GC + (cc * 64 + 16 * (kt + 1) + 4 * g) * 4);
                        fKGn = *(const LAS bf16x8*)(bl + BL_KGC + (16 * (kt + 1) + n) * 80 + g * 16);
                        fBGn = *(const LAS v2u*)(bl + BL_BGC + (16 * (kt + 1) + n) * 80 + (16 * cc + 4 * g) * 2); }
                    const bf16x8 ka = ((g >> 1) == cc) ? fKG : frag_zero();
                    const v4u bw = cc == 0 ? (v4u){fBG.x, fBG.y, 0u, 0u} : (v4u){0u, 0u, fBG.x, fBG.y};
                    f32x4 z = Z[kt] * gcv;
                    z = __builtin_amdgcn_mfma_f32_16x16x32_bf16(ka, bvt, z, 0, 0, 0);
                    z = __builtin_amdgcn_mfma_f32_16x16x32_bf16(__builtin_bit_cast(bf16x8, bw), bu, z, 0, 0, 0);
                    Z[kt] = z;
                    if (kt < 3) asm volatile("" :: "v"(gcn), "v"(fKGn), "v"(fBGn));
                    gcv = gcn; fKG = fKGn; fBG = fBGn;
                }
            }
        }
        __syncthreads();
    }
    if (t1 - 1 >= TC / 32 && wave >= 4) scan_y_store(F, chain, t1 - 1, t0, tid - 256);
    if (wave < 4 && t1 < SC_NTILE) {
#pragma unroll
        for (int kt = 0; kt < 4; ++kt) zs[kt] = Z[kt]; }
    __syncthreads();
}
template <int LEVEL> __device__ __forceinline__ void p3_scan(Frame& F, const XcdBarrier& bar) {
    const bf16* proj = (const bf16*)(F.ws + WS_PROJ);
    const bool state_role = F.bid < 64;
    int prev_chain = -1;
    for (int step = 0; step <= SC_NROUND; ++step) {
        if (LEVEL != 1 && step >= 1 && state_role) {
            const int r = step - 1, t0 = r * SC_RT, t1 = (t0 + SC_RT < SC_NTILE) ? t0 + SC_RT : SC_NTILE;
            scan_state_round(F, F.bid, t0, t1, F.ws + ((r & 1) ? WS_BLOB1 : WS_BLOB0) + (size_t)F.bid * SC_RT * BL_BYTES);
        }
        if (LEVEL != 2 && step < SC_NROUND) {
            const int t0 = step * SC_RT, nt = (t0 + SC_RT < SC_NTILE) ? SC_RT : SC_NTILE - t0, ntask = 64 * nt;
            int k0, k1;
            if (step == 0) { k0 = (int)((long)ntask * F.bid / F.G); k1 = (int)((long)ntask * (F.bid + 1) / F.G); }
            else if (state_role) { k0 = F.bid * SC_ST; k1 = k0 + SC_ST; }
            else { const int rest = ntask - 64 * SC_ST, P = F.G - 64, p = F.bid - 64; k0 = 64 * SC_ST + (int)((long)rest * p / P); k1 = 64 * SC_ST + (int)((long)rest * (p + 1) / P); }
            unsigned char* base = F.ws + ((step & 1) ? WS_BLOB1 : WS_BLOB0);
            v4u rg[3];
            if (k0 < k1) scan_issue_loads(proj, (k0 / nt) >> 4, ((k0 / nt) >> 1) & 7, (k0 / nt) & 1, t0 + k0 % nt, F.tid, rg);
            if (state_role || step == 0) prev_chain = -1;
            for (int k = k0; k < k1; ++k) {
                const int chain = k / nt, tl = k % nt, kn = k + 1, nchain = kn / nt, ntl = kn % nt;
                scan_prep_task(F, proj, chain, t0 + tl, chain != prev_chain, kn < k1, nchain, t0 + ntl, rg, base + ((size_t)chain * SC_RT + tl) * BL_BYTES);
                prev_chain = chain;
            }
        }
        if (step < SC_NROUND) xcd_barrier(bar);
    }
}
constexpr int P4_SG = 0, P4_GT = 17408, P4_CST = 17408 + 64 * 1040, P4_END = P4_CST + 12 * 2048;
__device__ __forceinline__ f32x4 ldq(const LAS float* p) { return *(const LAS f32x4*)p; }
__device__ __forceinline__ void unpack8(v4u w, float (&o)[8]) { o[0] = bf_lo(w.x); o[1] = bf_hi(w.x); o[2] = bf_lo(w.y); o[3] = bf_hi(w.y); o[4] = bf_lo(w.z); o[5] = bf_hi(w.z); o[6] = bf_lo(w.w); o[7] = bf_hi(w.w); }
__device__ __forceinline__ float sum8lanes(float p) { p += dppf<0xB1>(p); p += dppf<0x4E>(p); p += dppf<0x141>(p); return p; }
__device__ __forceinline__ void p4_mix(Frame& F) {
    LAS unsigned char* lds = F.lds; const int tid = F.tid, lane = F.lane, wave = F.wave;
    const bf16* proj = (const bf16*)(F.ws + WS_PROJ); bf16* cat = (bf16*)(F.ws + WS_HX); const float* yscr = F.out; const bf16* gwt = (const bf16*)(F.ws + WS_GWT);
    LAS float* CST = (LAS float*)(lds + P4_CST);
    __syncthreads();
    for (int i = tid; i < 12 * 512; i += 512) { const int row = i >> 9, c = i & 511;
        CST[i] = row < 6 ? F.in[I_TMU][row * 512 + c] : row == 6 ? F.in[I_RK][c] : row == 7 ? F.in[I_LNG][c] : row == 8 ? F.in[I_LNB][c] : F.in[I_CONVW][(row - 9) * 512 + c]; }
    for (int unit = F.bid; unit < MX / 64; unit += F.G) {
        const size_t row0 = (size_t)unit * 64; const int tb0 = (unit * 64) & (T - 1);
        __syncthreads();
#pragma unroll
        for (int i = 0; i < 2; ++i) { const int ck = tid + 512 * i, tok = ck >> 4, j0 = (ck & 15) * 8;
            const v4u w = *(const v4u*)(proj + (row0 + tok) * NPROJ + COL_G + j0);
            v4u o; o.x = pk2(sigmoidf(bf_lo(w.x)), sigmoidf(bf_hi(w.x))); o.y = pk2(sigmoidf(bf_lo(w.y)), sigmoidf(bf_hi(w.y))); o.z = pk2(sigmoidf(bf_lo(w.z)), sigmoidf(bf_hi(w.z))); o.w = pk2(sigmoidf(bf_lo(w.w)), sigmoidf(bf_hi(w.w)));
            *(LAS v4u*)(lds + P4_SG + tok * 272 + j0 * 2) = o; }
        __syncthreads();
        { const int r = lane & 31, hh = lane >> 5;
#pragma unroll
          for (int nt = 0; nt < 2; ++nt) {
              const bf16* bp = gwt + (size_t)(64 * wave + 32 * nt + r) * 128 + hh * 8;
              bf16x8 bfr[8];
#pragma unroll
              for (int ks = 0; ks < 8; ++ks) bfr[ks] = *(const bf16x8*)(bp + ks * 16);
#pragma unroll
              for (int mt = 0; mt < 2; ++mt) {
                  f32x16 acc;
#pragma unroll
                  for (int i = 0; i < 16; ++i) acc[i] = 0.f;
#pragma unroll
                  for (int ks = 0; ks < 8; ++ks) { const bf16x8 a = *(const LAS bf16x8*)(lds + P4_SG + (32 * mt + r) * 272 + ks * 32 + hh * 16); acc = __builtin_amdgcn_mfma_f32_32x32x16_bf16(a, bfr[ks], acc, 0, 0, 0); }
#pragma unroll
                  for (int i = 0; i < 16; ++i) *(LAS bf16*)(lds + P4_GT + (32 * mt + (i & 3) + 8 * (i >> 2) + 4 * hh) * 1040 + (64 * wave + 32 * nt + r) * 2) = (bf16)(pk2(acc[i], 0.f) & 0xffffu);
              } } }
        __syncthreads();
        const int gq = tid & 63, c0 = gq * 8;
#pragma unroll 2
        for (int n = 0; n < 8; ++n) { const int t = 8 * n + (tid >> 6); const int tb = tb0 + t;
            const bf16* pr = proj + (row0 + t) * NPROJ + c0;
            float xs[3][8];
#pragma unroll
            for (int which = 0; which < 3; ++which) { const int col = COL_R + which * 512;
                float xc[8], xp[8], xn[8];
                unpack8(*(const v4u*)(pr + col), xc);
                if (tb > 0) unpack8(*(const v4u*)(pr - NPROJ + col), xp); else {
#pragma unroll
                    for (int e = 0; e < 8; ++e) xp[e] = 0.f; }
                if (tb + 1 < T) unpack8(*(const v4u*)(pr + NPROJ + col), xn); else {
#pragma unroll
                    for (int e = 0; e < 8; ++e) xn[e] = 0.f; }
                const f32x4 mp0 = ldq(CST + which * 512 + c0), mp1 = ldq(CST + which * 512 + c0 + 4), mn0 = ldq(CST + (3 + which) * 512 + c0), mn1 = ldq(CST + (3 + which) * 512 + c0 + 4);
#pragma unroll
                for (int e = 0; e < 8; ++e) { const float mp = e < 4 ? mp0[e & 3] : mp1[e & 3], mn = e < 4 ? mn0[e & 3] : mn1[e & 3]; xs[which][e] = xc[e] + mp * (xp[e] - xc[e]) + mn * (xn[e] - xc[e]); } }
            const float* yr = yscr + (row0 + t) * D + c0;
            const f32x4 ya = *(const f32x4*)yr + *(const f32x4*)(yr + 512), yb = *(const f32x4*)(yr + 4) + *(const f32x4*)(yr + 516);
            float y[8] = {ya.x, ya.y, ya.z, ya.w, yb.x, yb.y, yb.z, yb.w};
            float sm = 0.f, sb = 0.f;
            const f32x4 rk0 = ldq(CST + 6 * 512 + c0), rk1 = ldq(CST + 6 * 512 + c0 + 4);
#pragma unroll
            for (int e = 0; e < 8; ++e) { sm += y[e]; sb += xs[0][e] * xs[1][e] * (e < 4 ? rk0[e & 3] : rk1[e & 3]); }
            const float mu = sum8lanes(sm) * (1.f / 64.f); const float bon = sum8lanes(sb);
            float sv = 0.f;
#pragma unroll
            for (int e = 0; e < 8; ++e) { y[e] -= mu; sv += y[e] * y[e]; }
            const float rstd = __builtin_amdgcn_rsqf(sum8lanes(sv) * (1.f / 64.f) + LNX_EPS);
            const f32x4 lg0 = ldq(CST + 7 * 512 + c0), lg1 = ldq(CST + 7 * 512 + c0 + 4), lb0 = ldq(CST + 8 * 512 + c0), lb1 = ldq(CST + 8 * 512 + c0 + 4);
            float gt[8]; unpack8(*(const LAS v4u*)(lds + P4_GT + t * 1040 + c0 * 2), gt);
            float o[8];
#pragma unroll
            for (int e = 0; e < 8; ++e) o[e] = (y[e] * rstd * (e < 4 ? lg0[e & 3] : lg1[e & 3]) + (e < 4 ? lb0[e & 3] : lb1[e & 3]) + bon * xs[2][e]) * gt[e];
            *(v4u*)(cat + (row0 + t) * D + 512 + c0) = (v4u){pk2(o[0], o[1]), pk2(o[2], o[3]), pk2(o[4], o[5]), pk2(o[6], o[7])};
        }
#pragma unroll 2
        for (int n = 0; n < 8; ++n) { const int t = 8 * n + (tid >> 6);
            const bf16* pr = proj + (row0 + t) * NPROJ + c0;
            float zc[8], zp[8], zn[8], g8[8], x8[8], xb[8];
            unpack8(*(const v4u*)(pr + COL_XG), g8); unpack8(*(const v4u*)(pr + COL_XC), x8);
#pragma unroll
            for (int e = 0; e < 8; ++e) zc[e] = g8[e] * x8[e];
            if (t > 0) { unpack8(*(const v4u*)(pr - NPROJ + COL_XG), g8); unpack8(*(const v4u*)(pr - NPROJ + COL_XC), x8);
#pragma unroll
                for (int e = 0; e < 8; ++e) zp[e] = g8[e] * x8[e]; } else {
#pragma unroll
                for (int e = 0; e < 8; ++e) zp[e] = 0.f; }
            if (t < 63) { unpack8(*(const v4u*)(pr + NPROJ + COL_XG), g8); unpack8(*(const v4u*)(pr + NPROJ + COL_XC), x8);
#pragma unroll
                for (int e = 0; e < 8; ++e) zn[e] = g8[e] * x8[e]; } else {
#pragma unroll
                for (int e = 0; e < 8; ++e) zn[e] = 0.f; }
            unpack8(*(const v4u*)(pr + COL_XB), xb);
            const f32x4 w00 = ldq(CST + 9 * 512 + c0), w01 = ldq(CST + 9 * 512 + c0 + 4), w10 = ldq(CST + 10 * 512 + c0), w11 = ldq(CST + 10 * 512 + c0 + 4), w20 = ldq(CST + 11 * 512 + c0), w21 = ldq(CST + 11 * 512 + c0 + 4);
            float o[8];
#pragma unroll
            for (int e = 0; e < 8; ++e) o[e] = xb[e] * ((e < 4 ? w00[e & 3] : w01[e & 3]) * zp[e] + (e < 4 ? w10[e & 3] : w11[e & 3]) * zc[e] + (e < 4 ? w20[e & 3] : w21[e & 3]) * zn[e]);
            *(v4u*)(cat + (row0 + t) * D + c0) = (v4u){pk2(o[0], o[1]), pk2(o[2], o[3]), pk2(o[4], o[5]), pk2(o[6], o[7])};
        }
    }
}

__device__ __forceinline__ void p6_mid(Frame& F) {
    const float* mod = (const float*)(F.ws + WS_MOD); const float* ng = F.in[I_NG];
    const float* yx = (const float*)(F.ws + WS_PROJ); bf16* hx2 = (bf16*)(F.ws + WS_HX);
    for (int m = F.bid * NWAVES + F.wave; m < MX; m += F.G * NWAVES) {
        const float* mr = mod + (m >> 12) * NMOD;
        f32x4 v[4], xv[4]; float ss = 0.f;
#pragma unroll
        for (int j = 0; j < 4; ++j) { v[j] = *(const f32x4*)(yx + (size_t)m * D + j * 256 + F.lane * 4); xv[j] = *(const f32x4*)(F.in[I_X] + (size_t)m * D + j * 256 + F.lane * 4);
            ss += v[j].x * v[j].x + v[j].y * v[j].y + v[j].z * v[j].z + v[j].w * v[j].w; }
        const float rstd = __builtin_amdgcn_rsqf(wave_sum(ss) * (1.f / D) + NORM_EPS);
        float ss2 = 0.f;
#pragma unroll
        for (int j = 0; j < 4; ++j) { const int c = j * 256 + F.lane * 4;
            const f32x4 g1 = *(const f32x4*)(ng + D + c), gt = *(const f32x4*)(mr + 2 * D + c);
            xv[j] = xv[j] + gt * (v[j] * rstd * g1);
            *(f32x4*)(F.out + (size_t)m * D + c) = xv[j];
            ss2 += xv[j].x * xv[j].x + xv[j].y * xv[j].y + xv[j].z * xv[j].z + xv[j].w * xv[j].w; }
        const float rstd2 = __builtin_amdgcn_rsqf(wave_sum(ss2) * (1.f / D) + NORM_EPS);
#pragma unroll
        for (int j = 0; j < 4; ++j) { const int c = j * 256 + F.lane * 4;
            const f32x4 g2 = *(const f32x4*)(ng + 2 * D + c), sh = *(const f32x4*)(mr + 3 * D + c), sc = *(const f32x4*)(mr + 4 * D + c);
            const f32x4 o = xv[j] * rstd2 * g2 * (1.f + sc) + sh;
            *(v2u*)(hx2 + (size_t)m * D + c) = (v2u){pk2(o.x, o.y), pk2(o.z, o.w)}; }
    }
}
__device__ __forceinline__ float gelu_erf(float x) { return 0.5f * x * (1.f + erff(x * 0.70710678118f)); }
__device__ __forceinline__ float dot2bf(unsigned a, unsigned b, float c) {
    typedef __bf16 bf2 __attribute__((ext_vector_type(2)));
    return __builtin_amdgcn_fdot2_f32_bf16(__builtin_bit_cast(bf2, a), __builtin_bit_cast(bf2, b), c, false);
}
__device__ __forceinline__ unsigned uminu(unsigned a, unsigned b) { return a < b ? a : b; }
__device__ __forceinline__ void ce_desc(unsigned& x, unsigned& y) { const unsigned hi = umaxu(x, y), lo = uminu(x, y); x = hi; y = lo; }
template <int N> __device__ __forceinline__ void bitonic_sort_desc(unsigned (&a)[N]) {
#pragma unroll
    for (int k = 2; k <= N; k <<= 1)
#pragma unroll
        for (int j = k >> 1; j > 0; j >>= 1)
#pragma unroll
            for (int i = 0; i < N; ++i) { const int l = i ^ j; if (l > i) { if ((i & k) == 0) ce_desc(a[i], a[l]); else ce_desc(a[l], a[i]); } }
}
template <int N> __device__ __forceinline__ void bitonic_merge_desc(unsigned (&a)[N]) {
#pragma unroll
    for (int j = N >> 1; j > 0; j >>= 1)
#pragma unroll
        for (int i = 0; i < N; ++i) { const int l = i ^ j; if (l > i) ce_desc(a[i], a[l]); }
}
__device__ __forceinline__ void p8a_route(Frame& F) {
    const int lane = F.lane, wave = F.wave, part = lane & 3, L = lane >> 2, side = L & 1;
    LAS unsigned char* WL = F.lds + 1024 + wave * 1024;
    LAS unsigned char* TAB = F.lds;
    const float* scores = (const float*)(F.ws + WS_PROJ);
    unsigned short* exl = (unsigned short*)(F.ws + WS_EXL); float* gl = (float*)(F.ws + WS_GL);
    __syncthreads();
    if (F.tid < 64) { int l = F.tid, i = 0; for (; i < 16; ++i) { const int n = 16 / (i + 1); if (l < n) break; l -= n; } TAB[F.tid] = (unsigned char)(i < 16 ? i * 16 + l : 0); }
    __syncthreads();
    for (int m = F.bid * NWAVES + wave; m < MX; m += F.G * NWAVES) {
        const float* lp = scores + (size_t)m * NSC + L * 128 + part * 32;
        unsigned lo16[16], hi16[16];
#pragma unroll
        for (int q = 0; q < 4; ++q) { const f32x4 v = *(const f32x4*)(lp + 4 * q), w = *(const f32x4*)(lp + 16 + 4 * q);
#pragma unroll
            for (int e = 0; e < 4; ++e) { lo16[4 * q + e] = (f2key(v[e]) & ~127u) | (unsigned)(127 - part * 32 - (4 * q + e)); hi16[4 * q + e] = (f2key(w[e]) & ~127u) | (unsigned)(127 - part * 32 - 16 - (4 * q + e)); } }
        bitonic_sort_desc<16>(lo16); bitonic_sort_desc<16>(hi16);
        unsigned r[16];
#pragma unroll
        for (int i = 0; i < 16; ++i) r[i] = umaxu(lo16[i], hi16[15 - i]);
        bitonic_merge_desc<16>(r);
        { unsigned c[16];
#pragma unroll
          for (int i = 0; i < 16; ++i) c[i] = umaxu(r[i], dppu<0xB1>(r[15 - i]));
          bitonic_merge_desc<16>(c);
#pragma unroll
          for (int i = 0; i < 16; ++i) r[i] = umaxu(c[i], dppu<0x4E>(c[15 - i]));
          bitonic_merge_desc<16>(r); }
        if (part == 0) {
#pragma unroll
            for (int i = 0; i < 16; ++i) WL[L * 16 + i] = (unsigned char)(127u - (r[i] & 127u)); }
        float fa[16], fb[16];
#pragma unroll
        for (int i = 0; i < 16; ++i) { const unsigned up = dppu<0x104>(r[i]), dn = dppu<0x114>(r[i]);
            const unsigned av = side ? dn : r[i], bv = side ? r[i] : up; fa[i] = key2f(av & ~127u); fb[i] = key2f(bv & ~127u); }
        unsigned R[16];
#pragma unroll
        for (int j = 0; j < 16; ++j) R[j] = (f2key(fa[0] + fb[j]) & ~63u) | (unsigned)(63 - j);
        { int code = 16;
#pragma unroll
          for (int i = 1; i < 16; ++i) {
#pragma unroll
              for (int j = 0; j < 16; ++j) { if ((i + 1) * (j + 1) <= 16) {
                  const unsigned x = (f2key(fa[i] + fb[j]) & ~63u) | (unsigned)(63 - code); const int p0 = (i + 1) * (j + 1) - 1;
#pragma unroll
                  for (int p = 15; p > p0; --p) R[p] = umaxu(R[p], uminu(R[p - 1], x));
                  R[p0] = umaxu(R[p0], x); ++code; } } } }
        if ((lane & 7) == 0) {
#pragma unroll
            for (int k = 0; k < 16; ++k) *(LAS unsigned*)(WL + 256 + ((lane >> 3) * 16 + k) * 4) = R[k]; }
        LDS_WAIT();
#pragma unroll
        for (int half = 0; half < 2; ++half) { const int e = lane + 64 * half, hd = e >> 4;
            const unsigned rk = *(const LAS unsigned*)(WL + 256 + e * 4); const int ij = TAB[63 - (int)(rk & 63u)];
            const int idx0 = WL[(2 * hd) * 16 + (ij >> 4)], idx1 = WL[(2 * hd + 1) * 16 + (ij & 15)];
            const float scv = key2f(rk & ~63u);
            float mx = scv; mx = fmaxf(mx, dppf<0xB1>(mx)); mx = fmaxf(mx, dppf<0x4E>(mx)); mx = fmaxf(mx, dppf<0x141>(mx)); mx = fmaxf(mx, dppf<0x140>(mx));
            const float ev = fast_exp(scv - mx); const float den = rowsum16(ev);
            exl[(size_t)m * 128 + e] = (unsigned short)(idx0 * 128 + idx1); gl[(size_t)m * 128 + e] = ev * fast_rcp(den); }
        LDS_WAIT();
    }
}
__device__ __forceinline__ void p9_upass(Frame& F) {
    const int lane = F.lane, wave = F.wave, x = F.bid & 7, r = F.bid >> 3, nr = F.G >> 3, g = lane >> 3, q = lane & 7;
    LAS unsigned short* EXW = (LAS unsigned short*)(F.lds + wave * 256);
    const unsigned* exl32 = (const unsigned*)(F.ws + WS_EXL); const bf16* hx2 = (const bf16*)(F.ws + WS_HX);
    const unsigned char* U = F.ws + WS_U + 128 * x + 16 * q; float* part = (float*)(F.ws + WS_PART) + (size_t)x * MX * 128;
    for (int m = r + nr * wave; m < MX; m += nr * NWAVES) {
        *(LAS unsigned*)(EXW + 2 * lane) = exl32[(size_t)m * 64 + lane];
        const v4u h0 = *(const v4u*)(hx2 + (size_t)m * D + 128 * x + 16 * q), h1 = *(const v4u*)(hx2 + (size_t)m * D + 128 * x + 16 * q + 8);
        float hf[16];
        hf[0] = bf_lo(h0.x); hf[1] = bf_hi(h0.x); hf[2] = bf_lo(h0.y); hf[3] = bf_hi(h0.y); hf[4] = bf_lo(h0.z); hf[5] = bf_hi(h0.z); hf[6] = bf_lo(h0.w); hf[7] = bf_hi(h0.w);
        hf[8] = bf_lo(h1.x); hf[9] = bf_hi(h1.x); hf[10] = bf_lo(h1.y); hf[11] = bf_hi(h1.y); hf[12] = bf_lo(h1.z); hf[13] = bf_hi(h1.z); hf[14] = bf_lo(h1.w); hf[15] = bf_hi(h1.w);
        LDS_WAIT();
        float keep[2];
#pragma unroll
        for (int j = 0; j < 2; ++j) {
            float kp = 0.f;
            v4u uu[8];
#pragma unroll
            for (int i = 0; i < 8; ++i) { const unsigned ex = EXW[64 * j + 8 * i + g]; uu[i] = *(const v4u*)(U + (size_t)ex * 1024); }
#pragma unroll
            for (int i = 0; i < 8; ++i) { float p = 0.f;
#pragma unroll
                for (int w = 0; w < 4; ++w) { const f32x2 lo = __builtin_amdgcn_cvt_pk_f32_fp8((int)uu[i][w], false), hi = __builtin_amdgcn_cvt_pk_f32_fp8((int)uu[i][w], true);
                    p += lo.x * hf[4 * w] + lo.y * hf[4 * w + 1] + hi.x * hf[4 * w + 2] + hi.y * hf[4 * w + 3]; }
                p += dppf<0xB1>(p); p += dppf<0x4E>(p); p += dppf<0x141>(p);
                kp = (q == i) ? p : kp; }
            keep[j] = kp * (1.f / 32.f);
        }
        part[(size_t)m * 128 + 8 * q + g] = keep[0]; part[(size_t)m * 128 + 64 + 8 * q + g] = keep[1];
        LDS_WAIT();
    }
}
__device__ __forceinline__ void p10_combine(Frame& F) {
    const float* __restrict__ part = (const float*)(F.ws + WS_PART); const float* __restrict__ gl = (const float*)(F.ws + WS_GL);
    const unsigned short* __restrict__ exl = (const unsigned short*)(F.ws + WS_EXL); unsigned* __restrict__ plt = (unsigned*)(F.ws + WS_PL);
    LAS unsigned* TL = (LAS unsigned*)F.lds;
    for (int unit = F.bid; unit < MX / 64; unit += F.G) {
        const int m0 = unit * 64;
        __syncthreads();
#pragma unroll 4
        for (int i = 0; i < 16; ++i) { const int idx = F.tid + 512 * i, ml = idx >> 7, k = idx & 127; const size_t gi = (size_t)(m0 + ml) * 128 + k;
            float s = part[gi];
#pragma unroll
            for (int x = 1; x < 8; ++x) s += part[(size_t)x * MX * 128 + gi];
            TL[k * 65 + ml] = (unsigned)exl[gi] | ((unsigned)__builtin_bit_cast(unsigned short, (_Float16)(gl[gi] * gelu_erf(s))) << 16); }
        __syncthreads();
#pragma unroll 4
        for (int i = 0; i < 16; ++i) { const int idx = F.tid + 512 * i, k = idx >> 6, ml = idx & 63; plt[(size_t)k * MX + m0 + ml] = TL[k * 65 + ml]; }
    }
}
typedef _Float16 h2_t __attribute__((ext_vector_type(2)));
typedef _Float16 h4_t __attribute__((ext_vector_type(4)));
template <int MODE> __device__ __forceinline__ void p11_vpass(Frame& F) {
    const int lane = F.lane, wave = F.wave;
    const unsigned* __restrict__ plt = (const unsigned*)(F.ws + WS_PL); float* __restrict__ po = (float*)(F.ws + WS_PO);
    for (int cg = F.bid; cg < 256; cg += F.G) {
        const int c0 = 128 * (cg & 7) + 4 * (cg >> 3);
        __syncthreads();
        for (int e = F.tid; e < NEXP; e += 512) { const f32x4 vv = *(const f32x4*)(F.in[I_PV] + (size_t)e * D + c0);
            const h2_t a = {(_Float16)vv.x, (_Float16)vv.y}, b = {(_Float16)vv.z, (_Float16)vv.w};
            *(LAS v2u*)(F.lds + e * 8) = (v2u){__builtin_bit_cast(unsigned, a), __builtin_bit_cast(unsigned, b)}; }
        __syncthreads();
        for (int mg = wave; mg < MX / 64; mg += NWAVES) {
            const unsigned* __restrict__ pg = plt + mg * 64;
            f32x4 acc = (f32x4){0.f, 0.f, 0.f, 0.f};
#pragma unroll 2
            for (int k0 = 0; k0 < 128; k0 += 8) {
                unsigned p[8];
#pragma unroll
                for (int i = 0; i < 8; ++i) p[i] = pg[(size_t)(k0 + i) * MX + lane];
                h2_t a01 = {(_Float16)0.f, (_Float16)0.f}, a23 = a01;
#pragma unroll
                for (int i = 0; i < 8; ++i) { const h4_t hv = *(const LAS h4_t*)(unsigned)((p[i] & 0xffffu) << 3);
                    const _Float16 cf = __builtin_bit_cast(_Float16, (unsigned short)(p[i] >> 16)); const h2_t c2 = {cf, cf};
                    a01 = __builtin_shufflevector(hv, hv, 0, 1) * c2 + a01; a23 = __builtin_shufflevector(hv, hv, 2, 3) * c2 + a23; }
                acc.x += (float)a01.x; acc.y += (float)a01.y; acc.z += (float)a23.x; acc.w += (float)a23.y;
            }
            *(f32x4*)(po + (size_t)(mg * 64 + lane) * D + c0) = acc;
        }
    }
}
__device__ __forceinline__ void p12_final(Frame& F) {
    const float* mod = (const float*)(F.ws + WS_MOD); const float* ng3 = F.in[I_NG] + 3 * D; const float* po = (const float*)(F.ws + WS_PO);
    for (int m = F.bid * NWAVES + F.wave; m < MX; m += F.G * NWAVES) {
        const float* gt2 = mod + (m >> 12) * NMOD + 5 * D;
        f32x4 v[4]; float ss = 0.f;
#pragma unroll
        for (int j = 0; j < 4; ++j) { v[j] = *(const f32x4*)(po + (size_t)m * D + j * 256 + F.lane * 4); ss += v[j].x * v[j].x + v[j].y * v[j].y + v[j].z * v[j].z + v[j].w * v[j].w; }
        const float rstd = __builtin_amdgcn_rsqf(wave_sum(ss) * (1.f / D) + NORM_EPS);
#pragma unroll
        for (int j = 0; j < 4; ++j) { const int c = j * 256 + F.lane * 4; float* op = F.out + (size_t)m * D + c;
            const f32x4 x1 = *(const f32x4*)op, g = *(const f32x4*)(ng3 + c), gt = *(const f32x4*)(gt2 + c);
            *(f32x4*)op = x1 + gt * (v[j] * rstd * g); }
    }
}
struct Args { const float* in[25]; float* out; unsigned char* ws; int ph_lo, ph_hi; };
__global__ void __launch_bounds__(NWAVES * 64, 2) mk_fwd(Args args) {
    extern __shared__ __attribute__((aligned(16))) unsigned char lds_raw[];
    Frame F;
    F.lds = (LAS unsigned char*)lds_raw;
    F.MISC = (volatile LAS unsigned*)(F.lds + MISC_OFF);
    F.tid = threadIdx.x; F.lane = F.tid & 63; F.wave = __builtin_amdgcn_readfirstlane(F.tid >> 6);
    F.G = gridDim.x; F.bid = blockIdx.x;
#pragma unroll
    for (int i = 0; i < 25; ++i) F.in[i] = args.in[i];
    F.out = args.out; F.ws = args.ws; F.ctl = (gu32*)(args.ws + WS_CTL);
    for (int u = F.tid; u < (LDS_BYTES - LDSCTL_OFF) / 4; u += NWAVES * 64) ((LAS unsigned*)(F.lds + LDSCTL_OFF))[u] = 0u;
    __syncthreads();
    const int lo = args.ph_lo, hi = args.ph_hi;
    XcdBarrier bar; bar.bar = (unsigned*)(F.ctl + CW_BAR); bar.x = 0; bar.st = nullptr;
    if (hi - lo > 1) bar = xcd_barrier_post((unsigned*)(F.ctl + CW_BAR), F.MISC + 8);
#ifndef PROBE_LO
#define PROBE_LO -1
#define PROBE_HI -1
#endif
#define IN(k) (lo <= (k) && (k) < hi)
#define SEAM(k) do { if (IN(k) && IN((k) + 1)) xcd_barrier(bar); } while (0)
#define PH0 { p0_prep(F); }
#define PH1 { p1_hx(F); }
#define PH2 { pg8::Gemm g{(const pg8::bf16_t*)(F.ws + WS_HX), (const pg8::bf16_t*)(F.ws + WS_WINT), MA, NPROJ_PAD, D}; pg8::StaticOrder S; S.init(MA, NPROJ_PAD, F.G, F.bid); \
        pg8::EpiProj E{(pg8::bf16_t*)(F.ws + WS_PROJ), NPROJ, NPROJ}; \
        pg8::gemm_phase<pg8::EpiProj, pg8::StaticOrder, PG8_ALIGN, PG8_SP2>(F.lds, g, S, E); }
#define PH3 { p3_scan<0>(F, bar); }
#define PH4 { p4_mix(F); }
#define PH5 { pg8::Gemm g{(const pg8::bf16_t*)(F.ws + WS_HX), (const pg8::bf16_t*)(F.ws + WS_WOUTT), MX, D, D}; pg8::StaticOrder S; S.init(MX, D, F.G, F.bid); \
        pg8::EpiF32 E{(float*)(F.ws + WS_PROJ), D}; \
        pg8::gemm_phase<pg8::EpiF32, pg8::StaticOrder, PG8_ALIGN, PG8_SP2>(F.lds, g, S, E); }
#define PH6 { p6_mid(F); }
#define PH7 { pg8::Gemm g{(const pg8::bf16_t*)(F.ws + WS_HX), (const pg8::bf16_t*)(F.ws + WS_WEFFT), MX, NSC, D}; pg8::StaticOrder S; S.init(MX, NSC, F.G, F.bid); \
        pg8::EpiF32 E{(float*)(F.ws + WS_PROJ), NSC}; \
        pg8::gemm_phase<pg8::EpiF32, pg8::StaticOrder, PG8_ALIGN, PG8_SP2>(F.lds, g, S, E); }
#define PH8 { p8a_route(F); }
#define PH9 { p9_upass(F); }
#define PH10 { p10_combine(F); }
#define PH11 { p11_vpass<0>(F); }
#define PH12 { p12_final(F); }
#define PRB(k, body) if constexpr (PROBE_LO <= (k) && (k) <= PROBE_HI) { xcd_barrier(bar); body }
    if (IN(0)) PH0 PRB(0, PH0) SEAM(0);
    if (IN(1)) PH1 PRB(1, PH1) SEAM(1);
    if (IN(2)) PH2 PRB(2, PH2) SEAM(2);
    if constexpr (PROBE_LO == 33) { p3_scan<1>(F, bar); xcd_barrier(bar); }
    if constexpr (PROBE_LO == 34) { p3_scan<2>(F, bar); xcd_barrier(bar); }
    if (IN(3)) PH3 PRB(3, PH3) SEAM(3);
    if (IN(4)) PH4 PRB(4, PH4) SEAM(4);
    if (IN(5)) PH5 PRB(5, PH5) SEAM(5);
    if (IN(6)) PH6 PRB(6, PH6) SEAM(6);
    if (IN(7)) PH7 PRB(7, PH7) SEAM(7);
    if (IN(8)) PH8 PRB(8, PH8) SEAM(8);
    if (IN(9)) PH9 PRB(9, PH9) SEAM(9);
    if (IN(10)) PH10 PRB(10, PH10) SEAM(10);
    if constexpr (PROBE_LO == 111) { p11_vpass<1>(F); xcd_barrier(bar); }
    if constexpr (PROBE_LO == 112) { p11_vpass<2>(F); xcd_barrier(bar); }
    if (IN(11)) PH11 PRB(11, PH11) SEAM(11);
    if (IN(12)) PH12
#undef IN
#undef SEAM
}

extern "C" void kernel_launch(void* const* d_in, const int* in_sizes, int n_in, void* d_out, int out_size, void* d_ws, size_t ws_size, hipStream_t stream) {
    static int grid = 0;
    if (grid == 0) {
        if (n_in != 25 || in_sizes[0] != MX * D || out_size != MX * D || ws_size < WS_END) { fprintf(stderr, "kernel_launch: unexpected problem (n_in %d, in0 %d, out %d, ws %zu); nothing launched\n", n_in, n_in > 0 ? in_sizes[0] : -1, out_size, ws_size); grid = -1; return; }
        int dev = 0, cus = 0, per_cu = 0;
        if (hipGetDevice(&dev) != hipSuccess || hipDeviceGetAttribute(&cus, hipDeviceAttributeMultiprocessorCount, dev) != hipSuccess) { fprintf(stderr, "kernel_launch: device query failed\n"); grid = -1; return; }
        if (hipFuncSetAttribute((const void*)mk_fwd, hipFuncAttributeMaxDynamicSharedMemorySize, LDS_BYTES) != hipSuccess) { fprintf(stderr, "kernel_launch: hipFuncSetAttribute failed\n"); grid = -1; return; }
        if (hipOccupancyMaxActiveBlocksPerMultiprocessor(&per_cu, (const void*)mk_fwd, NWAVES * 64, LDS_BYTES) != hipSuccess || per_cu < 1) fprintf(stderr, "kernel_launch: occupancy query reports %d workgroups per CU\n", per_cu);
        (void)hipGetLastError();
        grid = cus;
        if (grid != 256) { fprintf(stderr, "kernel_launch: this build needs a 256-CU device (got %d); nothing launched\n", grid); grid = -1; return; }
    }
    if (grid < 0) return;
    if (hipMemsetAsync((char*)d_ws + WS_CTL, 0, CTL_ZERO_BYTES, stream) != hipSuccess) { fprintf(stderr, "kernel_launch: memset failed\n"); return; }
    Args a{};
    for (int i = 0; i < 25; ++i) a.in[i] = (const float*)d_in[i];
    a.out = (float*)d_out; a.ws = (unsigned char*)d_ws;
    if (MK_N_LAUNCHES == 1) { a.ph_lo = 0; a.ph_hi = NPH; hipLaunchKernelGGL(mk_fwd, dim3(grid), dim3(NWAVES * 64), LDS_BYTES, stream, a); }
    else for (int p = 0; p < NPH; ++p) { a.ph_lo = p; a.ph_hi = p + 1; hipLaunchKernelGGL(mk_fwd, dim3(grid), dim3(NWAVES * 64), LDS_BYTES, stream, a); }
    const hipError_t le = hipPeekAtLastError();
    if (le != hipSuccess) fprintf(stderr, "kernel_launch: launch failed: %s\n", hipGetErrorName(le));
}
```

```cpp
#include <hip/hip_runtime.h>
#include <cstdio>
#include <cstdint>
namespace pg8 {
#define PG8_LAS __attribute__((address_space(3)))
typedef unsigned short bf16_t;
typedef short bf16x8 __attribute__((ext_vector_type(8)));
typedef float f32x4 __attribute__((ext_vector_type(4)));
typedef unsigned u32x4 __attribute__((ext_vector_type(4)));
constexpr int BM = 256, BK = 64, HALF = 128, HTB = HALF * BK * 2  , STAGE_BYTES = 8 * HTB, NXCD = 8, WGM = 8;

__host__ __device__ __forceinline__ int lds_byte(int r, int c) { const int st = (r >> 4) * 2 + (c >> 5), rr = r & 15, cc = c & 31, ob = rr * 64 + cc * 2; return st * 1024 + (ob ^ (((ob >> 9) & 1) << 5)); }
__host__ __device__ __forceinline__ void stage_rc(int b, int& R, int& C) { const int st = b / 1024, sb = b % 1024, swz = sb ^ (((sb >> 9) & 1) << 5); R = (st >> 1) * 16 + swz / 64; C = (st & 1) * 32 + (swz % 64) / 2; }
__host__ __device__ __forceinline__ int perm32(int rho) { const int n = rho >> 4, i = rho & 15; return 8 * (i >> 2) + 4 * n + (i & 3); }

struct Unit { int pm, pn; };
struct Gemm { const bf16_t* A; const bf16_t* Bt; int M, N, K; };

struct StaticOrder {
    int nM, nN, nwg, G, c;
    __host__ __device__ void init(int M, int N, int G_, int c_) { nM = M / BM; nN = N / BM; nwg = nM * nN; G = G_; c = c_; }
    __host__ __device__ bool next(int i, Unit& u) const {
        const long L = (long)i * G + c; if (L >= nwg) return false;
        int wgid = (int)L; { const int q = nwg / NXCD, r = nwg % NXCD, xcd = wgid % NXCD, off = wgid / NXCD; wgid = (xcd < r ? xcd * (q + 1) : r * (q + 1) + (xcd - r) * q) + off; }
        const int nig = WGM * nN, gid = wgid / nig, fm = gid * WGM, gsz = (nM - fm) < WGM ? (nM - fm) : WGM;
        u.pm = fm + ((wgid % nig) % gsz); u.pn = (wgid % nig) / gsz; return true;
    }
    __device__ __forceinline__ void a_ready(const Unit&) const {}
    __device__ __forceinline__ void done(const Unit&) const {}
};

__device__ __forceinline__ unsigned cvt_pk_bf16(float lo, float hi) { unsigned r; asm volatile("v_cvt_pk_bf16_f32 %0, %1, %2" : "=v"(r) : "v"(lo), "v"(hi)); return r; }
typedef float f32x2 __attribute__((ext_vector_type(2)));
__device__ __forceinline__ f32x2 gelu_pk(f32x2 v) {
    const f32x2 av = __builtin_elementwise_abs(v), d = av * 0.2316418882f + 1.0f;
    f32x2 t; t.x = __builtin_amdgcn_rcpf(d.x); t.y = __builtin_amdgcn_rcpf(d.y);
    f32x2 q = t * 0.5307027145f + (-0.7265760135f); q = q * t + 0.7107068705f; q = q * t + (-0.142248368f); q = q * t + 0.127414796f; q = q * t;
    const f32x2 s = (v * v) * (-0.72134752044f);
    f32x2 e; e.x = __builtin_amdgcn_exp2f(s.x); e.y = __builtin_amdgcn_exp2f(s.y);
    const f32x2 m = v * (q * e), r = v - m;
    f32x2 o; o.x = v.x < 0.f ? m.x : r.x; o.y = v.y < 0.f ? m.y : r.y; return o;
}

template <int ACT  > struct EpiBf16 {
    static constexpr bool PERM = true, AFTER_DRAIN = false; static_assert(ACT == 0 || ACT == 1, "EpiBf16: ACT is 0 (none) or 1 (gelu_pk)");
    bf16_t* O; int ldc; const float* bias; int split_cols; size_t split_stride; float scale0;
    __device__ __forceinline__ void operator()(const f32x4 (&acc)[2][2][4][2], const Unit& u, int wr, int wc, int fr, int fq) const {
        const int row0 = u.pm * BM + wr * 64 + fr; int colt = u.pn * BM; bf16_t* base = O;
        float sc = 1.f; if (split_cols) { const int t = colt / split_cols; base += (size_t)t * split_stride; colt -= t * split_cols; if (t == 0) sc = scale0; }
        const int col0 = colt + wc * 32 + 8 * fq, bcol0 = u.pn * BM + wc * 32 + 8 * fq;
        f32x4 bv[2][2];
#pragma unroll
        for (int bj = 0; bj < 2; ++bj)
#pragma unroll
            for (int n = 0; n < 2; ++n) bv[bj][n] = bias ? *(const f32x4*)(bias + bcol0 + bj * HALF + 4 * n) : (f32x4){0.f, 0.f, 0.f, 0.f};
#pragma unroll
        for (int ai = 0; ai < 2; ++ai)
#pragma unroll
            for (int m = 0; m < 4; ++m) { bf16_t* rowp = base + (size_t)(row0 + ai * HALF + m * 16) * ldc + col0;
#pragma unroll
                for (int bj = 0; bj < 2; ++bj) { f32x4 v0 = acc[ai][bj][m][0] + bv[bj][0], v1 = acc[ai][bj][m][1] + bv[bj][1];
                    if (ACT == 1) { f32x2 a = gelu_pk((f32x2){v0[0], v0[1]}), b = gelu_pk((f32x2){v0[2], v0[3]}), c = gelu_pk((f32x2){v1[0], v1[1]}), d = gelu_pk((f32x2){v1[2], v1[3]});
                        v0 = (f32x4){a.x, a.y, b.x, b.y}; v1 = (f32x4){c.x, c.y, d.x, d.y}; }
                    v0 = v0 * sc; v1 = v1 * sc; u32x4 w; w.x = cvt_pk_bf16(v0[0], v0[1]); w.y = cvt_pk_bf16(v0[2], v0[3]); w.z = cvt_pk_bf16(v1[0], v1[1]); w.w = cvt_pk_bf16(v1[2], v1[3]);
                    *(u32x4*)(rowp + bj * HALF) = w; } }
    }
};

struct EpiF32 {
    static constexpr bool PERM = false, AFTER_DRAIN = false;
    float* C; int ldc;
    __device__ __forceinline__ void operator()(const f32x4 (&acc)[2][2][4][2], const Unit& u, int wr, int wc, int fr, int fq) const {
        const int row0 = u.pm * BM + wr * 64 + fr, col0 = u.pn * BM + wc * 32 + 4 * fq;
#pragma unroll
        for (int ai = 0; ai < 2; ++ai)
#pragma unroll
            for (int m = 0; m < 4; ++m) { float* rowp = C + (size_t)(row0 + ai * HALF + m * 16) * ldc + col0;
#pragma unroll
                for (int bj = 0; bj < 2; ++bj)
#pragma unroll
                    for (int n = 0; n < 2; ++n) *(f32x4*)(rowp + bj * HALF + n * 16) = acc[ai][bj][m][n]; }
    }
};
struct EpiProj {
    static constexpr bool PERM = true, AFTER_DRAIN = false;
    bf16_t* O; int ldc; int ncols;
    __device__ __forceinline__ void operator()(const f32x4 (&acc)[2][2][4][2], const Unit& u, int wr, int wc, int fr, int fq) const {
        const int row0 = u.pm * BM + wr * 64 + fr; const int col0 = u.pn * BM + wc * 32 + 8 * fq;
#pragma unroll
        for (int ai = 0; ai < 2; ++ai)
#pragma unroll
            for (int m = 0; m < 4; ++m) { bf16_t* rowp = O + (size_t)(row0 + ai * HALF + m * 16) * ldc + col0;
#pragma unroll
                for (int bj = 0; bj < 2; ++bj) { const f32x4 v0 = acc[ai][bj][m][0], v1 = acc[ai][bj][m][1];
                    u32x4 w; w.x = cvt_pk_bf16(v0[0], v0[1]); w.y = cvt_pk_bf16(v0[2], v0[3]); w.z = cvt_pk_bf16(v1[0], v1[1]); w.w = cvt_pk_bf16(v1[2], v1[3]);
                    if (col0 + bj * HALF < ncols) *(u32x4*)(rowp + bj * HALF) = w; } }
    }
};
template <class Epi, class Sched, bool ALIGN_EPI = false, bool SP2 = false>
__device__ __forceinline__ void gemm_phase(PG8_LAS unsigned char* lds, const Gemm g, const Sched& S, const Epi& E) {
    const int tid = threadIdx.x, wid = __builtin_amdgcn_readfirstlane(tid >> 6), lane = tid & 63, wr = wid >> 2, wc = wid & 3, fr = lane & 15, fq = lane >> 4;
    const int K = g.K, nt = K / BK;
    unsigned voffA[2], voffB[2];
#pragma unroll
    for (int i = 0; i < 2; ++i) { int R, C; stage_rc(tid * 16 + i * 8192, R, C); const int Rb = Epi::PERM ? ((R & ~31) + perm32(R & 31)) : R;
        voffA[i] = (unsigned)(R * K + C) * 2u; voffB[i] = (unsigned)(Rb * K + C) * 2u; }
    const size_t kstep = (size_t)(BK * 2);
    const size_t hstep = (size_t)HALF * K * 2;
    const size_t tstep = 2 * hstep;
    const unsigned ldsw = (unsigned)wid * 1024u;
    const int aoff = lds_byte(wr * 64 + fr, fq * 8), boff = lds_byte(wc * 32 + fr, fq * 8);
#define PG8_SA(b, h) (((b) * 2 + (h)) * HTB)
#define PG8_SB(b, h) ((4 + (b) * 2 + (h)) * HTB)
#define PG8_STAGE(bufoff, gbase, voff) do { _Pragma("unroll") for (int _i = 0; _i < 2; ++_i) \
        __builtin_amdgcn_global_load_lds((const unsigned*)((const char*)(gbase) + (voff)[_i]), (PG8_LAS unsigned*)(lds + (bufoff) + ldsw + _i * 8192), 16, 0, 0); } while (0)
#define PG8_LDA(dst, b, h) do { _Pragma("unroll") for (int m = 0; m < 4; ++m) _Pragma("unroll") for (int k = 0; k < 2; ++k) dst[m][k] = *(const PG8_LAS bf16x8*)(lds + PG8_SA(b, h) + aoff + m * 2048 + k * 1024); } while (0)
#define PG8_LDB(dst, b, h) do { _Pragma("unroll") for (int n = 0; n < 2; ++n) _Pragma("unroll") for (int k = 0; k < 2; ++k) dst[n][k] = *(const PG8_LAS bf16x8*)(lds + PG8_SB(b, h) + boff + n * 2048 + k * 1024); } while (0)
#define PG8_MMA(ai, bj, At, Bt) do { __builtin_amdgcn_s_setprio(1); _Pragma("unroll") for (int m = 0; m < 4; ++m) _Pragma("unroll") for (int n = 0; n < 2; ++n) _Pragma("unroll") for (int k = 0; k < 2; ++k) \
        acc[ai][bj][m][n] = __builtin_amdgcn_mfma_f32_16x16x32_bf16(Bt[n][k], At[m][k], acc[ai][bj][m][n], 0, 0, 0); __builtin_amdgcn_s_setprio(0); } while (0)
#define PG8_WAIT_V(n) asm volatile("s_waitcnt vmcnt(" #n ")" ::: "memory")
#define PG8_WAIT_L(n) asm volatile("s_waitcnt lgkmcnt(" #n ")" ::: "memory")
#define PG8_BAR __builtin_amdgcn_s_barrier()
#define PG8_SCHED __builtin_amdgcn_sched_barrier(0)
    Unit cur, nxt; int ui = 0;
    if (!S.next(0, cur)) return;
    f32x4 acc[2][2][4][2];
#pragma unroll
    for (int a = 0; a < 2; ++a)
#pragma unroll
        for (int b = 0; b < 2; ++b)
#pragma unroll
            for (int m = 0; m < 4; ++m)
#pragma unroll
                for (int n = 0; n < 2; ++n) acc[a][b][m][n] = (f32x4){0.f, 0.f, 0.f, 0.f};
    bf16x8 At[4][2], B0[2][2], B1[2][2];
    const char* cA = (const char*)g.A + (size_t)cur.pm * tstep; const char* cB = (const char*)g.Bt + (size_t)cur.pn * tstep;
    S.a_ready(cur);
    if constexpr (SP2) {
        PG8_STAGE(PG8_SB(0, 0), cB, voffB); PG8_STAGE(PG8_SB(0, 1), cB + hstep, voffB); PG8_STAGE(PG8_SA(0, 0), cA, voffA); PG8_STAGE(PG8_SA(0, 1), cA + hstep, voffA);
        if (wr == 1) PG8_BAR;
        PG8_WAIT_V(2); PG8_BAR;
        PG8_STAGE(PG8_SB(1, 0), cB + kstep, voffB); PG8_STAGE(PG8_SA(1, 0), cA + kstep, voffA); PG8_STAGE(PG8_SB(1, 1), cB + hstep + kstep, voffB);
        PG8_WAIT_V(6); PG8_BAR;
    } else {
        PG8_STAGE(PG8_SB(0, 0), cB, voffB); PG8_STAGE(PG8_SA(0, 0), cA, voffA); PG8_STAGE(PG8_SB(0, 1), cB + hstep, voffB); PG8_STAGE(PG8_SA(0, 1), cA + hstep, voffA);
        if (wr == 1) PG8_BAR;
        PG8_WAIT_V(4); PG8_BAR;
        PG8_STAGE(PG8_SB(1, 0), cB + kstep, voffB); PG8_STAGE(PG8_SA(1, 0), cA + kstep, voffA); PG8_STAGE(PG8_SB(1, 1), cB + hstep + kstep, voffB);
        PG8_WAIT_V(6); PG8_BAR;
    }
    for (;;) {
        const bool has_next = S.next(ui + 1, nxt);
        const char* nA = has_next ? (const char*)g.A + (size_t)nxt.pm * tstep : cA; const char* nB = has_next ? (const char*)g.Bt + (size_t)nxt.pn * tstep : cB;
        for (int t = 0; t < nt; t += 2) {
            const bool last = (t == nt - 2);
            const char* a1 = cA + (size_t)(t + 1) * kstep;
            const char* a2 = last ? nA : cA + (size_t)(t + 2) * kstep; const char* b2 = last ? nB : cB + (size_t)(t + 2) * kstep;
            const char* a3 = a2 + kstep; const char* b3 = b2 + kstep;
            if (last && has_next) S.a_ready(nxt);
            if constexpr (SP2) {
            PG8_LDB(B0, 0, 0); PG8_LDB(B1, 0, 1); PG8_SCHED; PG8_LDA(At, 0, 0); PG8_STAGE(PG8_SA(1, 1), a1 + hstep, voffA);
            PG8_WAIT_V(8); PG8_WAIT_L(0); PG8_BAR; PG8_MMA(0, 0, At, B0); PG8_MMA(0, 1, At, B1); PG8_BAR; PG8_SCHED;
            PG8_LDA(At, 0, 1); PG8_STAGE(PG8_SB(0, 0), b2, voffB); PG8_STAGE(PG8_SB(0, 1), b2 + hstep, voffB); PG8_STAGE(PG8_SA(0, 0), a2, voffA);
            PG8_WAIT_V(8); PG8_WAIT_L(0); PG8_BAR; PG8_MMA(1, 0, At, B0); PG8_MMA(1, 1, At, B1); PG8_BAR; PG8_SCHED;
            PG8_LDB(B0, 1, 0); PG8_LDB(B1, 1, 1); PG8_SCHED; PG8_LDA(At, 1, 0); PG8_STAGE(PG8_SA(0, 1), a2 + hstep, voffA);
            PG8_WAIT_V(8); PG8_WAIT_L(0); PG8_BAR; PG8_MMA(0, 0, At, B0); PG8_MMA(0, 1, At, B1); PG8_BAR; PG8_SCHED;
            PG8_LDA(At, 1, 1); PG8_STAGE(PG8_SB(1, 0), b3, voffB); PG8_STAGE(PG8_SB(1, 1), b3 + hstep, voffB); PG8_STAGE(PG8_SA(1, 0), a3, voffA);
            PG8_WAIT_V(8); PG8_WAIT_L(0); PG8_BAR; PG8_MMA(1, 0, At, B0); PG8_MMA(1, 1, At, B1); PG8_BAR; PG8_SCHED;
            } else {
            PG8_LDB(B0, 0, 0); PG8_SCHED; PG8_LDA(At, 0, 0); PG8_STAGE(PG8_SA(1, 1), a1 + hstep, voffA);
            PG8_WAIT_L(8); PG8_BAR; PG8_WAIT_L(0); PG8_MMA(0, 0, At, B0); PG8_BAR; PG8_SCHED;
            PG8_LDB(B1, 0, 1); PG8_STAGE(PG8_SB(0, 0), b2, voffB);
            PG8_BAR; PG8_WAIT_L(0); PG8_MMA(0, 1, At, B1); PG8_BAR;
            PG8_LDA(At, 0, 1); PG8_STAGE(PG8_SA(0, 0), a2, voffA);
            PG8_BAR; PG8_WAIT_L(0); PG8_MMA(1, 0, At, B0); PG8_BAR; PG8_SCHED;
            PG8_STAGE(PG8_SB(0, 1), b2 + hstep, voffB);
            PG8_WAIT_V(6); PG8_BAR; PG8_MMA(1, 1, At, B1); PG8_BAR;
            PG8_LDB(B0, 1, 0); PG8_SCHED; PG8_LDA(At, 1, 0); PG8_STAGE(PG8_SA(0, 1), a2 + hstep, voffA);
            PG8_WAIT_L(8); PG8_BAR; PG8_WAIT_L(0); PG8_MMA(0, 0, At, B0); PG8_BAR; PG8_SCHED;
            PG8_LDB(B1, 1, 1); PG8_STAGE(PG8_SB(1, 0), b3, voffB);
            PG8_BAR; PG8_WAIT_L(0); PG8_MMA(0, 1, At, B1); PG8_BAR;
            PG8_LDA(At, 1, 1); PG8_STAGE(PG8_SA(1, 0), a3, voffA);
            PG8_BAR; PG8_WAIT_L(0); PG8_MMA(1, 0, At, B0); PG8_BAR; PG8_SCHED;
            PG8_STAGE(PG8_SB(1, 1), b3 + hstep, voffB);
            PG8_WAIT_V(6); PG8_BAR; PG8_MMA(1, 1, At, B1); PG8_BAR;
            }
        }
        if constexpr (ALIGN_EPI) { if (wr == 0) PG8_BAR; }
        if constexpr (!Epi::AFTER_DRAIN) { E(acc, cur, wr, wc, fr, fq); S.done(cur); }
        if (!has_next) break;
#pragma unroll
        for (int a = 0; a < 2; ++a)
#pragma unroll
            for (int b = 0; b < 2; ++b)
#pragma unroll
                for (int m = 0; m < 4; ++m)
#pragma unroll
                    for (int n = 0; n < 2; ++n) acc[a][b][m][n] = (f32x4){0.f, 0.f, 0.f, 0.f};
        cur = nxt; cA = nA; cB = nB; ++ui;
        if constexpr (ALIGN_EPI) { if (wr == 1) PG8_BAR; }
    }
    PG8_WAIT_V(0);
    if constexpr (!ALIGN_EPI) { if (wr == 0) PG8_BAR; }
    PG8_BAR;
    if constexpr (Epi::AFTER_DRAIN) { E.fused(acc, cur, wr, wc, fr, fq, lds, wid, lane); S.done(cur); }
#undef PG8_SA
#undef PG8_SB
#undef PG8_STAGE
#undef PG8_LDA
#undef PG8_LDB
#undef PG8_MMA
#undef PG8_WAIT_V
#undef PG8_WAIT_L
#undef PG8_BAR
#undef PG8_SCHED
}
}
#ifndef PG8_SP2
#define PG8_SP2 true
#endif
#ifndef PG8_ALIGN
#define PG8_ALIGN true
#endif
constexpr int NWAVES = 8;
constexpr int D = 1024, NB = 4, T = 4096, TC = 256;
constexpr int MX = NB * T, MC = NB * TC, MA = MX + MC;
constexpr int NPROJ = 3456, NPROJ_PAD = 3584;
constexpr int COL_XB = 0, COL_XG = 512, COL_XC = 1024, COL_R = 1536, COL_K = 2048, COL_V = 2560, COL_G = 3072, COL_LW = 3200, COL_LA = 3328;
constexpr int NMOD = 6 * D;
constexpr int NEXP = 16384, NSC = 2048;
constexpr float NORM_EPS = 1e-6f, LNX_EPS = 64e-5f;
#ifndef MK_N_LAUNCHES
#define MK_N_LAUNCHES 1
#endif
constexpr int NPH = 13;
constexpr size_t MiB = 1u << 20;
constexpr size_t WS_CTL = 0, CTL_ZERO_BYTES = 64 * 1024;
constexpr size_t WS_MOD = 3 * MiB;
constexpr size_t WS_ZS = 4 * MiB;
constexpr size_t WS_WINT = 6 * MiB;
constexpr size_t WS_WOUTT = 13 * MiB;
constexpr size_t WS_WEFFT = 15 * MiB;
constexpr size_t WS_GWT = 19 * MiB;
constexpr size_t WS_U = 20 * MiB, WS_V = 52 * MiB;
constexpr size_t WS_HX = 84 * MiB;
constexpr size_t WS_PROJ = 118 * MiB;
constexpr size_t WS_END = 246 * MiB;
constexpr size_t WS_EXL = WS_V, WS_GL = WS_V + 4 * MiB, WS_PL = WS_V + 12 * MiB;
constexpr size_t WS_BLOB0 = WS_V, WS_BLOB1 = WS_HX;
constexpr size_t WS_PART = WS_PROJ, WS_PO = WS_PROJ + 64 * MiB;
static_assert(WS_PROJ + (size_t)MA * NPROJ * 2 <= WS_END && WS_PROJ + (size_t)MX * NSC * 4 <= WS_END && WS_HX + (size_t)MA * D * 2 <= WS_PROJ, "d_ws map");
constexpr int CW_BAR = 1024;
constexpr int RING_BYTES = 131072;
constexpr int LDSCTL_OFF = 155648, MISC_OFF = LDSCTL_OFF + 320;
constexpr int LDS_BYTES = 163840;

#define GAS __attribute__((address_space(1)))
#define LAS __attribute__((address_space(3)))
typedef unsigned short bf16;
typedef unsigned v4u __attribute__((ext_vector_type(4)));
typedef unsigned v2u __attribute__((ext_vector_type(2)));
typedef float f32x4 __attribute__((ext_vector_type(4)));
typedef float f32x2 __attribute__((ext_vector_type(2)));
typedef float f32x16 __attribute__((ext_vector_type(16)));
typedef short bf16x8 __attribute__((ext_vector_type(8)));
typedef GAS unsigned gu32;
#define RLX_AGENT __ATOMIC_RELAXED, __HIP_MEMORY_SCOPE_AGENT
#define LDS_WAIT() asm volatile("s_waitcnt lgkmcnt(0)" ::: "memory")
#define VM_WAIT() asm volatile("s_waitcnt vmcnt(0)" ::: "memory")
typedef __bf16 bf16v2 __attribute__((ext_vector_type(2)));
__device__ __forceinline__ unsigned pk2(float lo, float hi) { const f32x2 v = {lo, hi}; return __builtin_bit_cast(unsigned, __builtin_convertvector(v, bf16v2)); }
__device__ __forceinline__ float bf_lo(unsigned w) { return __builtin_bit_cast(float, w << 16); }
__device__ __forceinline__ float bf_hi(unsigned w) { return __builtin_bit_cast(float, w & 0xffff0000u); }
__device__ __forceinline__ float bf1(bf16 b) { return __builtin_bit_cast(float, (unsigned)b << 16); }
__device__ __forceinline__ float fast_exp(float x) { return __builtin_amdgcn_exp2f(x * 1.44269504089f); }
__device__ __forceinline__ float fast_rcp(float x) { return __builtin_amdgcn_rcpf(x); }
__device__ __forceinline__ float sigmoidf(float x) { return fast_rcp(1.f + fast_exp(-x)); }
__device__ __forceinline__ float tanh_fast(float x) { return 1.f - 2.f * fast_rcp(fast_exp(2.f * x) + 1.f); }
__device__ __forceinline__ float siluf(float x) { return x * sigmoidf(x); }
template <int CTRL> __device__ __forceinline__ float dppf(float x) { return __builtin_bit_cast(float, __builtin_amdgcn_update_dpp(0, __builtin_bit_cast(int, x), CTRL, 0xF, 0xF, false)); }
template <int CTRL> __device__ __forceinline__ unsigned dppu(unsigned x) { return (unsigned)__builtin_amdgcn_update_dpp(0, (int)x, CTRL, 0xF, 0xF, false); }
__device__ __forceinline__ float rowsum16(float x) { x += dppf<0xB1>(x); x += dppf<0x4E>(x); x += dppf<0x141>(x); x += dppf<0x140>(x); return x; }
__device__ __forceinline__ float wave_sum(float v) {
    v = rowsum16(v); v += __shfl_xor(v, 16); v += __shfl_xor(v, 32); return v;
}
__device__ __forceinline__ float half_sum32(float v) { v = rowsum16(v); v += __shfl_xor(v, 16); return v; }
__device__ __forceinline__ unsigned umaxu(unsigned a, unsigned b) { return a > b ? a : b; }
__device__ __forceinline__ unsigned wave_max_u32(unsigned x) {
    x = umaxu(x, dppu<0xB1>(x)); x = umaxu(x, dppu<0x4E>(x)); x = umaxu(x, dppu<0x141>(x)); x = umaxu(x, dppu<0x140>(x));
    const unsigned a = __builtin_amdgcn_readlane((int)x, 0), b = __builtin_amdgcn_readlane((int)x, 16), c = __builtin_amdgcn_readlane((int)x, 32), d = __builtin_amdgcn_readlane((int)x, 48);
    return umaxu(umaxu(a, b), umaxu(c, d));
}
__device__ __forceinline__ unsigned f2key(float f) { const unsigned u = __builtin_bit_cast(unsigned, f); return (u & 0x80000000u) ? ~u : (u | 0x80000000u); }
__device__ __forceinline__ float key2f(unsigned k) { const unsigned u = (k & 0x80000000u) ? (k ^ 0x80000000u) : ~k; return __builtin_bit_cast(float, u); }
#define XB_TMO      128
#define XB_XCNT(j)  (256  + 64 * (j))
#define XB_XSUB(j)  (1280 + 64 * (j))
#define XB_XGEN(j)  (2304 + 64 * (j))
#define XB_TOP      3328
#define XB_TOPGEN   3392
#define XCD_BAR_WORDS 3456
#define XB_SPIN_CAP (1u << 18)

__device__ __forceinline__ unsigned xb_ld(unsigned* p)              { return __hip_atomic_load(p, __ATOMIC_RELAXED, __HIP_MEMORY_SCOPE_AGENT); }
__device__ __forceinline__ unsigned xb_add(unsigned* p, unsigned v) { return __hip_atomic_fetch_add(p, v, __ATOMIC_RELAXED, __HIP_MEMORY_SCOPE_AGENT); }
__device__ __forceinline__ unsigned xb_xcc_id() { return (unsigned)__builtin_amdgcn_s_getreg((3 << 11) | 20) & 0xFu; }
#define XB_SPIN(cond, bar) do { unsigned _sp = 0; while (cond) { __builtin_amdgcn_s_sleep(1); \
    if ((++_sp & 255u) == 0u) { if (xb_ld(&(bar)[XB_TMO])) break; if (_sp > XB_SPIN_CAP) { atomicAdd(&(bar)[XB_TMO], 1u); break; } } } } while (0)

struct XcdBarrier {
    unsigned* bar; unsigned x;
    volatile LAS unsigned* st;
};

__device__ __forceinline__ XcdBarrier xcd_barrier_post(unsigned* bar, volatile LAS unsigned* st) {
    XcdBarrier b; b.bar = bar; b.x = xb_xcc_id(); b.st = st;
    if (threadIdx.x == 0) (void)xb_add(&bar[XB_XCNT(b.x)], 1u);
    return b;
}
__device__ __forceinline__ void xcd_barrier_complete(unsigned* bar, unsigned x, unsigned& nloc, unsigned& nx) {
    const unsigned G = gridDim.x * gridDim.y * gridDim.z;
    unsigned sum, cnt, mine, sp = 0u;
    for (;;) {
        sum = 0u; cnt = 0u; mine = 0u;
#pragma unroll
        for (unsigned j = 0; j < 16; ++j) { const unsigned c = xb_ld(&bar[XB_XCNT(j)]); sum += c; cnt += (c > 0u) ? 1u : 0u; mine = (j == x) ? c : mine; }
        if (sum == G) break;
        __builtin_amdgcn_s_sleep(1);
        if ((++sp & 255u) == 0u) { if (xb_ld(&bar[XB_TMO])) break; if (sp > XB_SPIN_CAP) { atomicAdd(&bar[XB_TMO], 1u); break; } }
    }
    nloc = mine > 0u ? mine : 1u; nx = cnt > 0u ? cnt : 1u;
}

__device__ __forceinline__ void xcd_barrier(const XcdBarrier& b) {
    asm volatile("s_waitcnt vmcnt(0)" ::: "memory");
    __syncthreads();
    if (threadIdx.x == 0) {
        unsigned* bar = b.bar;
        __builtin_amdgcn_s_waitcnt(0);
        unsigned nloc = b.st[0], nx = b.st[1];
        if (nloc == 0u) { xcd_barrier_complete(bar, b.x, nloc, nx); b.st[0] = nloc; b.st[1] = nx; }
        const unsigned old = xb_add(&bar[XB_XSUB(b.x)], 1u);
        const unsigned gen = old / nloc;
        if (old + 1u == (gen + 1u) * nloc) {
            __builtin_amdgcn_fence(__ATOMIC_RELEASE, "agent");
            asm volatile("s_waitcnt vmcnt(0)" ::: "memory");
            const unsigned og = xb_add(&bar[XB_TOP], 1u);
            const unsigned tg = og / nx;
            if (og + 1u == (tg + 1u) * nx) xb_add(&bar[XB_TOPGEN], 1u);
            else XB_SPIN(xb_ld(&bar[XB_TOPGEN]) == tg, bar);
            __builtin_amdgcn_fence(__ATOMIC_ACQUIRE, "agent");
            xb_add(&bar[XB_XGEN(b.x)], 1u);
            asm volatile("s_waitcnt vmcnt(0)" ::: "memory");
        } else {
            XB_SPIN(xb_ld(&bar[XB_XGEN(b.x)]) == gen, bar);
            __builtin_amdgcn_fence(__ATOMIC_ACQUIRE, "agent");
            asm volatile("s_waitcnt vmcnt(0)" ::: "memory");
        }
    }
    __syncthreads();
}
struct Frame {
    LAS unsigned char* lds;
    volatile LAS unsigned* MISC;
    gu32* ctl;
    int tid, lane, wave, G, bid;
    const float* in[25];
    float* out;
    unsigned char* ws;
};
enum { I_X = 0, I_C, I_CTX, I_CCTX, I_WMOD, I_BMOD, I_NG, I_WIN, I_WOUT, I_CONVW, I_TMU, I_DW0, I_DW2, I_A0, I_A2, I_GW2, I_KK, I_KA, I_RK, I_LNG, I_LNB, I_WQ, I_SUBK, I_PU, I_PV };

__device__ __forceinline__ void p0_transpose_item(const float* W, int K, int N, bf16* WT, LAS float* scr, int item, int lane) {
    const int nblk = N / 32, kb = item / nblk, nb = item % nblk, k0 = 64 * kb, n0 = 32 * nb;
#pragma unroll 8
    for (int i = 0; i < 32; ++i) { const int kk = 2 * i + (lane >> 5); scr[kk * 33 + (lane & 31)] = W[(size_t)(k0 + kk) * N + n0 + (lane & 31)]; }
    LDS_WAIT(); asm volatile("" ::: "memory");
    const int c = lane & 7;
#pragma unroll
    for (int j = 0; j < 4; ++j) { const int n = (lane >> 3) + 8 * j; const LAS float* s = scr + (8 * c) * 33 + n;
        v4u o; o.x = pk2(s[0 * 33], s[1 * 33]); o.y = pk2(s[2 * 33], s[3 * 33]); o.z = pk2(s[4 * 33], s[5 * 33]); o.w = pk2(s[6 * 33], s[7 * 33]);
        *(v4u*)(WT + (size_t)(n0 + n) * K + k0 + 8 * c) = o; }
    LDS_WAIT(); asm volatile("" ::: "memory");
}
__device__ __forceinline__ void p0_mod_item(Frame& F, int cb) {
    LAS float* S = (LAS float*)F.lds;
    LAS float* RED = (LAS float*)(F.lds + 32768);
    const float* c = F.in[I_C]; const float* cc = F.in[I_CCTX];
    for (int i = F.tid; i < 5 * D; i += 512) { const int r = i >> 10, k = i & 1023; const float v = (r < 4) ? c[r * D + k] : cc[k]; S[i] = siluf(v); }
    __syncthreads();
    const int col = F.tid & 63, kg = F.tid >> 6;
    const float* wp = F.in[I_WMOD] + (size_t)(kg * 128) * NMOD + cb * 64 + col;
    float a0 = 0.f, a1 = 0.f, a2 = 0.f, a3 = 0.f, a4 = 0.f;
#pragma unroll 8
    for (int k = 0; k < 128; ++k) { const float w = wp[(size_t)k * NMOD]; const int kk = kg * 128 + k;
        a0 += S[kk] * w; a1 += S[D + kk] * w; a2 += S[2 * D + kk] * w; a3 += S[3 * D + kk] * w; a4 += S[4 * D + kk] * w; }
    RED[(kg * 5 + 0) * 64 + col] = a0; RED[(kg * 5 + 1) * 64 + col] = a1; RED[(kg * 5 + 2) * 64 + col] = a2; RED[(kg * 5 + 3) * 64 + col] = a3; RED[(kg * 5 + 4) * 64 + col] = a4;
    __syncthreads();
    if (F.tid < 320) { const int r = F.tid >> 6, cl = F.tid & 63; float s = F.in[I_BMOD][cb * 64 + cl];
#pragma unroll
        for (int g = 0; g < 8; ++g) s += RED[(g * 5 + r) * 64 + cl];
        ((float*)(F.ws + WS_MOD))[r * NMOD + cb * 64 + cl] = s; }
    __syncthreads();
}
__device__ __forceinline__ void p0_weff_item(Frame& F, int item) {
    const int hs = item >> 4, kb = item & 15;
    LAS float* SK = (LAS float*)F.lds;
    LAS float* WQ = (LAS float*)(F.lds + 128 * 132 * 4);
    const float* sk = F.in[I_SUBK] + (size_t)hs * 128 * 128;
    const float* wq = F.in[I_WQ] + (size_t)(kb * 64) * 2048 + hs * 128;
#pragma unroll
    for (int i = 0; i < 8; ++i) { const int idx = F.tid + 512 * i, row = idx >> 5, c4 = idx & 31; const f32x4 v = *(const f32x4*)(sk + row * 128 + c4 * 4); *(LAS f32x4*)(SK + row * 132 + c4 * 4) = v; }
#pragma unroll
    for (int i = 0; i < 4; ++i) { const int idx = F.tid + 512 * i, row = idx >> 5, c4 = idx & 31; const f32x4 v = *(const f32x4*)(wq + (size_t)row * 2048 + c4 * 4); *(LAS f32x4*)(WQ + row * 132 + c4 * 4) = v; }
    __syncthreads();
    const int key = F.tid >> 2, kq = F.tid & 3;
    float acc[16];
#pragma unroll
    for (int i = 0; i < 16; ++i) acc[i] = 0.f;
    for (int d = 0; d < 128; d += 4) {
        const f32x4 a = *(const LAS f32x4*)(SK + key * 132 + d);
#pragma unroll
        for (int i = 0; i < 16; ++i) { const f32x4 b = *(const LAS f32x4*)(WQ + (4 * i + kq) * 132 + d); acc[i] += a.x * b.x + a.y * b.y + a.z * b.z + a.w * b.w; }
    }
    bf16* dst = (bf16*)(F.ws + WS_WEFFT) + (size_t)(hs * 128 + key) * D + kb * 64;
#pragma unroll
    for (int i = 0; i < 16; ++i) dst[4 * i + kq] = (bf16)(pk2(acc[i], 0.f) & 0xffffu);
    __syncthreads();
}
__device__ __forceinline__ void p0_prep(Frame& F) {
    for (int it = F.bid; it < 96 + 256; it += F.G) { if (it < 96) p0_mod_item(F, it); else p0_weff_item(F, it - 96); }
    LAS float* scr = (LAS float*)(F.lds + F.wave * 16384);
    const int gw = F.bid * NWAVES + F.wave, NGW = F.G * NWAVES;
    constexpr int I_IN = (D / 64) * (NPROJ / 32), I_OUT = (D / 64) * (D / 32), I_GW = (128 / 64) * (512 / 32);
    for (int it = gw; it < I_IN + I_OUT + I_GW; it += NGW) {
        if (it < I_IN) p0_transpose_item(F.in[I_WIN], D, NPROJ, (bf16*)(F.ws + WS_WINT), scr, it, F.lane);
        else if (it < I_IN + I_OUT) p0_transpose_item(F.in[I_WOUT], D, D, (bf16*)(F.ws + WS_WOUTT), scr, it - I_IN, F.lane);
        else p0_transpose_item(F.in[I_GW2], 128, 512, (bf16*)(F.ws + WS_GWT), scr, it - I_IN - I_OUT, F.lane);
    }
    { v4u* z = (v4u*)((bf16*)(F.ws + WS_WINT) + (size_t)NPROJ * D); const int n16 = (NPROJ_PAD - NPROJ) * D * 2 / 16;
      for (int i = F.bid * 512 + F.tid; i < n16; i += F.G * 512) z[i] = (v4u){0u, 0u, 0u, 0u}; }
    { const f32x4* pu = (const f32x4*)F.in[I_PU]; v2u* du = (v2u*)(F.ws + WS_U);
      const int n8 = NEXP * D / 8;
      for (int i = F.bid * 512 + F.tid; i < n8; i += F.G * 512) {
          const f32x4 a0 = pu[2 * i] * 32.f, a1 = pu[2 * i + 1] * 32.f;
          int w0 = __builtin_amdgcn_cvt_pk_fp8_f32(a0.x, a0.y, 0, false); w0 = __builtin_amdgcn_cvt_pk_fp8_f32(a0.z, a0.w, w0, true);
          int w1 = __builtin_amdgcn_cvt_pk_fp8_f32(a1.x, a1.y, 0, false); w1 = __builtin_amdgcn_cvt_pk_fp8_f32(a1.z, a1.w, w1, true);
          du[i] = (v2u){(unsigned)w0, (unsigned)w1}; } }
}

__device__ __forceinline__ void p1_hx(Frame& F) {
    const float* mod = (const float*)(F.ws + WS_MOD); const float* ng = F.in[I_NG];
    bf16* hx = (bf16*)(F.ws + WS_HX);
    for (int m = F.bid * NWAVES + F.wave; m < MA; m += F.G * NWAVES) {
        const float* src = (m < MX) ? F.in[I_X] + (size_t)m * D : F.in[I_CTX] + (size_t)(m - MX) * D;
        const float* mr = mod + ((m < MX) ? (m >> 12) : 4) * NMOD;
        f32x4 v[4]; float ss = 0.f;
#pragma unroll
        for (int j = 0; j < 4; ++j) { v[j] = *(const f32x4*)(src + j * 256 + F.lane * 4); ss += v[j].x * v[j].x + v[j].y * v[j].y + v[j].z * v[j].z + v[j].w * v[j].w; }
        const float rstd = __builtin_amdgcn_rsqf(wave_sum(ss) * (1.f / D) + NORM_EPS);
#pragma unroll
        for (int j = 0; j < 4; ++j) { const int c = j * 256 + F.lane * 4;
            const f32x4 g = *(const f32x4*)(ng + c), sh = *(const f32x4*)(mr + c), sc = *(const f32x4*)(mr + D + c);
            const float o0 = v[j].x * rstd * g.x * (1.f + sc.x) + sh.x, o1 = v[j].y * rstd * g.y * (1.f + sc.y) + sh.y, o2 = v[j].z * rstd * g.z * (1.f + sc.z) + sh.z, o3 = v[j].w * rstd * g.w * (1.f + sc.w) + sh.w;
            *(v2u*)(hx + (size_t)m * D + c) = (v2u){pk2(o0, o1), pk2(o2, o3)}; }
    }
}
constexpr int BL_APT = 0, BL_NPT = 4608, BL_RH = 7168, BL_MKR = 11776, BL_MBR = 14336, BL_KGC = 16896, BL_BGC = 22016, BL_GC = 27136, BL_VT = 27648, BL_BYTES = 32768;
constexpr int HSZ = 66048;
constexpr int CS_RAW = 0, CS_TLW = 13056, CS_LOA = 17664, CS_LG = 22272, CS_NBA = 32768, CS_AH = 38912, CS_BH = 43520, CS_KH = 48128, CS_AHC = 52736, CS_E = 57856, CS_NKA = 57856, CS_TT = 60416;
constexpr int CS_CONST = 2 * HSZ, CS_W2T = CS_CONST + 2560, CS_A2T = CS_W2T + 9216, CS_END = CS_A2T + 9216;
static_assert(CS_END <= LDSCTL_OFF, "scan prep LDS map");
constexpr int CS_RH = BL_RH, CS_KGC = BL_KGC, CS_BGC = BL_BGC, CS_VT = BL_VT, CS_GC = BL_GC, CS_APT = BL_APT, CS_NPT = BL_NPT, CS_MKR = BL_MKR, CS_MBR = BL_MBR;
constexpr int SC_NTILE = (TC + T) / 32, SC_RT = 16, SC_NROUND = (SC_NTILE + SC_RT - 1) / SC_RT;
constexpr int SC_ST = 1;
constexpr int GS_YS = 65536;
__device__ __forceinline__ void scan_issue_loads(const bf16* proj, int b, int h, int d, int tile, int tid, v4u (&rg)[3]) {
    const bool isctx = tile < TC / 32; const int L = isctx ? TC : T; const int jt = isctx ? tile : tile - TC / 32;
    const size_t rowbase = isctx ? (size_t)(MX + b * TC) : (size_t)b * T;
    const int tlo = d == 0 ? 32 * jt : L - 32 * (jt + 1);
#pragma unroll
    for (int i = 0; i < 3; ++i) {
        const int q = tid + 512 * i;
        const int row = q / 24, rem = q - row * 24; int tok = tlo - 1 + row; tok = tok < 0 ? 0 : (tok >= L ? L - 1 : tok);
        const int q2 = (q - 816) & 511, row2 = q2 >> 4, rem2 = q2 & 15;
        const size_t offA = (rowbase + tok) * NPROJ + COL_R + (rem >> 3) * 512 + h * 64 + (rem & 7) * 8;
        const size_t offB = (rowbase + tlo + row2) * NPROJ + ((rem2 >> 3) ? COL_LA : COL_LW) + d * 64 + (rem2 & 7) * 8;
        rg[i] = *(const v4u*)(proj + (q < 816 ? offA : offB));
    }
}
__device__ __forceinline__ unsigned tanh_pk(unsigned w) { return pk2(tanh_fast(bf_lo(w)), tanh_fast(bf_hi(w))); }
__device__ __forceinline__ void scan_store_raw(LAS unsigned char* lds, int tid, int d, int tile, const v4u (&rg)[3]) {
    const bool isctx = tile < TC / 32; const int L = isctx ? TC : T; const int jt = isctx ? tile : tile - TC / 32;
    const int tlo = d == 0 ? 32 * jt : L - 32 * (jt + 1);
#pragma unroll
    for (int i = 0; i < 3; ++i) {
        const int q = tid + 512 * i;
        if (q < 816) { const int row = q / 24, rem = q - row * 24, which = rem >> 3, ch8 = rem & 7; const int tok = tlo - 1 + row;
            *(LAS v4u*)(lds + CS_RAW + (which * 34 + row) * 128 + ch8 * 16) = (tok >= 0 && tok < L) ? rg[i] : (v4u){0u, 0u, 0u, 0u}; }
        else if (q < 1328) { const int q2 = q - 816, row = q2 >> 4, rem = q2 & 15, which = rem >> 3, ch8 = rem & 7;
            if (which) *(LAS v4u*)(lds + CS_LOA + row * 144 + ch8 * 16) = rg[i];
            else { v4u t; t.x = tanh_pk(rg[i].x); t.y = tanh_pk(rg[i].y); t.z = tanh_pk(rg[i].z); t.w = tanh_pk(rg[i].w); *(LAS v4u*)(lds + CS_TLW + row * 144 + ch8 * 16) = t; } }
    }
}
__device__ __forceinline__ v2u pack4(f32x4 v) { return (v2u){pk2(v.x, v.y), pk2(v.z, v.w)}; }
__device__ __forceinline__ bf16 bfs(float v) { return (bf16)(pk2(v, 0.f) & 0xffffu); }
typedef v2u v2u_t;
__device__ __forceinline__ bf16x8 frag2(const LAS unsigned char* p0, const LAS unsigned char* p1) {
    const v2u a = *(const LAS v2u*)p0, b = *(const LAS v2u*)p1; const v4u w = (v4u){a.x, a.y, b.x, b.y}; return __builtin_bit_cast(bf16x8, w);
}
__device__ __forceinline__ bf16x8 frag_acc(f32x4 lo, f32x4 hi) { const v4u w = (v4u){pk2(lo.x, lo.y), pk2(lo.z, lo.w), pk2(hi.x, hi.y), pk2(hi.z, hi.w)}; return __builtin_bit_cast(bf16x8, w); }
__device__ __forceinline__ bf16x8 frag_zero() { const v4u w = (v4u){0u, 0u, 0u, 0u}; return __builtin_bit_cast(bf16x8, w); }
__device__ __forceinline__ void scan_prep_pair(Frame& F, const bf16* proj, int chain, int tile0, bool two, bool load_consts, bool have_next, int ntile0, bool ntwo, v4u (&rg)[6], unsigned char* blob0) {
    LAS unsigned char* lds = F.lds; int tid = F.tid; asm volatile("" : "+v"(tid));
    const int lane = tid & 63, wave = F.wave, wl = wave & 3, ts = wave >> 2;
    const int b = chain >> 4, h = (chain >> 1) & 7, d = chain & 1;
    const bool act = ts == 0 || two;
    if (load_consts) {
        __syncthreads();
        LAS float* C = (LAS float*)(lds + CS_CONST);
        if (tid < 384) { const int pn = tid / 192, r = tid - pn * 192, which = r >> 6, c = r & 63; C[pn * 192 + which * 64 + c] = F.in[I_TMU][(pn * 3 + which) * 512 + h * 64 + c]; }
        else if (tid < 448) { const int c = tid - 384; C[384 + c] = F.in[I_KK][h * 64 + c]; C[448 + c] = F.in[I_KA][h * 64 + c]; }
        else { const int c = tid - 448; C[512 + c] = F.in[I_DW0][d * 512 + h * 64 + c]; C[576 + c] = F.in[I_A0][d * 512 + h * 64 + c]; }
        const float* w2 = F.in[I_DW2] + (size_t)d * 64 * 512 + h * 64; const float* a2 = F.in[I_A2] + (size_t)d * 64 * 512 + h * 64;
#pragma unroll
        for (int i = 0; i < 8; ++i) { const int idx = tid + 512 * i, j = idx >> 6, c = idx & 63;
            *(LAS bf16*)(lds + CS_W2T + c * 144 + j * 2) = bfs(w2[j * 512 + c]);
            *(LAS bf16*)(lds + CS_A2T + c * 144 + j * 2) = bfs(a2[j * 512 + c]); }
    }
    { const v4u r0[3] = {rg[0], rg[1], rg[2]}; scan_store_raw(lds, tid, d, tile0, r0); }
    if (two) { const v4u r1[3] = {rg[3], rg[4], rg[5]}; scan_store_raw(lds + HSZ, tid, d, tile0 + 1, r1); }
    __syncthreads();
    { LAS unsigned char* hl = lds + ts * HSZ;
            if (act) {
                const int mat = wl >> 1, nt = wl & 1, r = lane & 31, hh = lane >> 5;
                const LAS unsigned char* Ab = hl + (mat ? CS_LOA : CS_TLW) + r * 144 + hh * 16;
                const LAS unsigned char* Bb = lds + (mat ? CS_A2T : CS_W2T) + (nt * 32 + r) * 144 + hh * 16;
                f32x16 acc;
#pragma unroll
                for (int i = 0; i < 16; ++i) acc[i] = 0.f;
#pragma unroll
                for (int ks = 0; ks < 4; ++ks) { const bf16x8 a = *(const LAS bf16x8*)(Ab + ks * 32), bb = *(const LAS bf16x8*)(Bb + ks * 32); acc = __builtin_amdgcn_mfma_f32_32x32x16_bf16(a, bb, acc, 0, 0, 0); }
                LAS float* LG = (LAS float*)(hl + CS_LG) + mat * 2048 + nt * 32 + r;
#pragma unroll
                for (int i = 0; i < 16; ++i) LG[((i & 3) + 8 * (i >> 2) + 4 * hh) * 64] = acc[i];
            }
    }
    __syncthreads();
    const int tok = tid >> 4, cq = tid & 15, c0 = cq * 4, s = d == 0 ? tok : 31 - tok;
    f32x4 rs, vs, kd, kk, kka, ev;
    { LAS unsigned char* hl = lds;
            { const LAS float* C = (const LAS float*)(lds + CS_CONST);
              f32x4 xs[3];
#pragma unroll
              for (int which = 0; which < 3; ++which) {
                  const LAS unsigned char* rp = hl + CS_RAW + (which * 34 + tok) * 128 + c0 * 2;
                  const v2u p = *(const LAS v2u*)rp, x = *(const LAS v2u*)(rp + 128), n = *(const LAS v2u*)(rp + 256);
                  const f32x4 mp = *(const LAS f32x4*)(C + which * 64 + c0), mn = *(const LAS f32x4*)(C + 192 + which * 64 + c0);
                  const f32x4 xp = (f32x4){bf_lo(p.x), bf_hi(p.x), bf_lo(p.y), bf_hi(p.y)}, xc = (f32x4){bf_lo(x.x), bf_hi(x.x), bf_lo(x.y), bf_hi(x.y)}, xn = (f32x4){bf_lo(n.x), bf_hi(n.x), bf_lo(n.y), bf_hi(n.y)};
                  xs[which] = xc + mp * (xp - xc) + mn * (xn - xc); }
              const f32x4 kkc = *(const LAS f32x4*)(C + 384 + c0), kac = *(const LAS f32x4*)(C + 448 + c0), w0 = *(const LAS f32x4*)(C + 512 + c0), a0 = *(const LAS f32x4*)(C + 576 + c0);
              kk = xs[1] * kkc;
              const float ss = rowsum16(kk.x * kk.x + kk.y * kk.y + kk.z * kk.z + kk.w * kk.w);
              kk = kk * __builtin_amdgcn_rsqf(ss + 1e-12f);
              const f32x4 uw = *(const LAS f32x4*)(hl + CS_LG + (tok * 64 + c0) * 4) + w0, ua = *(const LAS f32x4*)(hl + CS_LG + 8192 + (tok * 64 + c0) * 4) + a0;
              f32x4 av;
#pragma unroll
              for (int e = 0; e < 4; ++e) { ev[e] = 0.60653066f * sigmoidf(uw[e]); av[e] = sigmoidf(ua[e]); }
              kd = xs[1] * (1.f + (av - 1.f) * kac); kka = kk * av; rs = xs[0]; vs = xs[2];
              *(LAS f32x4*)(hl + CS_E + (s * 64 + c0) * 4) = ev; }
    }
    __syncthreads();
    { LAS unsigned char* hl = lds;
            { const int cb = s & 16, sl = s & 15;
              f32x4 cum = (f32x4){0.f, 0.f, 0.f, 0.f}, tot = cum;
#pragma unroll
              for (int ii = 0; ii < 16; ++ii) { const f32x4 e4 = *(const LAS f32x4*)(hl + CS_E + ((cb + ii) * 64 + c0) * 4); tot = tot + e4; if (ii <= sl) cum = cum + e4; }
              f32x4 g, gm1, gi, ge, gt;
#pragma unroll
              for (int e = 0; e < 4; ++e) { g[e] = fast_exp(-cum[e]); gm1[e] = fast_exp(ev[e] - cum[e]); gi[e] = fast_exp(cum[e]); ge[e] = fast_exp(cum[e] - tot[e]); gt[e] = fast_exp(-tot[e]); }
              const f32x4 ah = gm1 * kk, bh = kka * gi, kh = kd * gi, rh = g * rs, kg = kd * ge, bg = kka * ge;
              *(LAS v2u*)(hl + CS_AH + s * 144 + c0 * 2) = pack4(ah); *(LAS v2u*)(hl + CS_BH + s * 144 + c0 * 2) = pack4(bh);
              *(LAS v2u*)(hl + CS_KH + s * 144 + c0 * 2) = pack4(kh); *(LAS v2u*)(hl + CS_RH + s * 144 + c0 * 2) = pack4(rh);
#pragma unroll
              for (int e = 0; e < 4; ++e) { *(LAS bf16*)(hl + CS_AHC + (c0 + e) * 80 + s * 2) = bfs(ah[e]); *(LAS bf16*)(hl + CS_KGC + (c0 + e) * 80 + s * 2) = bfs(kg[e]); *(LAS bf16*)(hl + CS_BGC + (c0 + e) * 80 + s * 2) = bfs(-bg[e]); }
#pragma unroll
              for (int e = 0; e < 4; ++e) *(LAS bf16*)(hl + CS_VT + (c0 + e) * 80 + s * 2) = bfs(vs[e]);
              if (sl == 15) *(LAS f32x4*)(hl + CS_GC + ((s >> 4) * 64 + c0) * 4) = gt; }
    }
    __builtin_amdgcn_sched_barrier(0);
    if (two) {
        LAS unsigned char* hl = lds + HSZ;
            { const LAS float* C = (const LAS float*)(lds + CS_CONST);
              f32x4 xs[3];
#pragma unroll
              for (int which = 0; which < 3; ++which) {
                  const LAS unsigned char* rp = hl + CS_RAW + (which * 34 + tok) * 128 + c0 * 2;
                  const v2u p = *(const LAS v2u*)rp, x = *(const LAS v2u*)(rp + 128), n = *(const LAS v2u*)(rp + 256);
                  const f32x4 mp = *(const LAS f32x4*)(C + which * 64 + c0), mn = *(const LAS f32x4*)(C + 192 + which * 64 + c0);
                  const f32x4 xp = (f32x4){bf_lo(p.x), bf_hi(p.x), bf_lo(p.y), bf_hi(p.y)}, xc = (f32x4){bf_lo(x.x), bf_hi(x.x), bf_lo(x.y), bf_hi(x.y)}, xn = (f32x4){bf_lo(n.x), bf_hi(n.x), bf_lo(n.y), bf_hi(n.y)};
                  xs[which] = xc + mp * (xp - xc) + mn * (xn - xc); }
              const f32x4 kkc = *(const LAS f32x4*)(C + 384 + c0), kac = *(const LAS f32x4*)(C + 448 + c0), w0 = *(const LAS f32x4*)(C + 512 + c0), a0 = *(const LAS f32x4*)(C + 576 + c0);
              kk = xs[1] * kkc;
              const float ss = rowsum16(kk.x * kk.x + kk.y * kk.y + kk.z * kk.z + kk.w * kk.w);
              kk = kk * __builtin_amdgcn_rsqf(ss + 1e-12f);
              const f32x4 uw = *(const LAS f32x4*)(hl + CS_LG + (tok * 64 + c0) * 4) + w0, ua = *(const LAS f32x4*)(hl + CS_LG + 8192 + (tok * 64 + c0) * 4) + a0;
              f32x4 av;
#pragma unroll
              for (int e = 0; e < 4; ++e) { ev[e] = 0.60653066f * sigmoidf(uw[e]); av[e] = sigmoidf(ua[e]); }
              kd = xs[1] * (1.f + (av - 1.f) * kac); kka = kk * av; rs = xs[0]; vs = xs[2];
              *(LAS f32x4*)(hl + CS_E + (s * 64 + c0) * 4) = ev; }
    }
    __syncthreads();
    if (two) {
        LAS unsigned char* hl = lds + HSZ;
            { const int cb = s & 16, sl = s & 15;
              f32x4 cum = (f32x4){0.f, 0.f, 0.f, 0.f}, tot = cum;
#pragma unroll
              for (int ii = 0; ii < 16; ++ii) { const f32x4 e4 = *(const LAS f32x4*)(hl + CS_E + ((cb + ii) * 64 + c0) * 4); tot = tot + e4; if (ii <= sl) cum = cum + e4; }
              f32x4 g, gm1, gi, ge, gt;
#pragma unroll
              for (int e = 0; e < 4; ++e) { g[e] = fast_exp(-cum[e]); gm1[e] = fast_exp(ev[e] - cum[e]); gi[e] = fast_exp(cum[e]); ge[e] = fast_exp(cum[e] - tot[e]); gt[e] = fast_exp(-tot[e]); }
              const f32x4 ah = gm1 * kk, bh = kka * gi, kh = kd * gi, rh = g * rs, kg = kd * ge, bg = kka * ge;
              *(LAS v2u*)(hl + CS_AH + s * 144 + c0 * 2) = pack4(ah); *(LAS v2u*)(hl + CS_BH + s * 144 + c0 * 2) = pack4(bh);
              *(LAS v2u*)(hl + CS_KH + s * 144 + c0 * 2) = pack4(kh); *(LAS v2u*)(hl + CS_RH + s * 144 + c0 * 2) = pack4(rh);
#pragma unroll
              for (int e = 0; e < 4; ++e) { *(LAS bf16*)(hl + CS_AHC + (c0 + e) * 80 + s * 2) = bfs(ah[e]); *(LAS bf16*)(hl + CS_KGC + (c0 + e) * 80 + s * 2) = bfs(kg[e]); *(LAS bf16*)(hl + CS_BGC + (c0 + e) * 80 + s * 2) = bfs(-bg[e]); }
#pragma unroll
              for (int e = 0; e < 4; ++e) *(LAS bf16*)(hl + CS_VT + (c0 + e) * 80 + s * 2) = bfs(vs[e]);
              if (sl == 15) *(LAS f32x4*)(hl + CS_GC + ((s >> 4) * 64 + c0) * 4) = gt; }
    }
    __syncthreads();
    if (have_next) { v4u n0[3]; scan_issue_loads(proj, b, h, d, ntile0, tid, n0); rg[0] = n0[0]; rg[1] = n0[1]; rg[2] = n0[2];
        if (ntwo) { v4u n1[3]; scan_issue_loads(proj, b, h, d, ntile0 + 1, tid, n1); rg[3] = n1[0]; rg[4] = n1[1]; rg[5] = n1[2]; } }
    { LAS unsigned char* hl = lds + ts * HSZ;
            if (act) {
                const int r = lane & 31, hh = lane >> 5;
                const LAS unsigned char* Ab = hl + ((wl == 0 || wl == 3) ? CS_BH : CS_KH) + r * 144 + hh * 16;
                const LAS unsigned char* Bb = hl + (wl < 2 ? CS_AH : CS_RH) + r * 144 + hh * 16;
                f32x16 acc;
#pragma unroll
                for (int i = 0; i < 16; ++i) acc[i] = 0.f;
#pragma unroll
                for (int ks = 0; ks < 4; ++ks) { const bf16x8 a = *(const LAS bf16x8*)(Ab + ks * 32), bb = *(const LAS bf16x8*)(Bb + ks * 32); acc = __builtin_amdgcn_mfma_f32_32x32x16_bf16(a, bb, acc, 0, 0, 0); }
                const int t = r;
#pragma unroll
                for (int i = 0; i < 16; ++i) { const int j = (i & 3) + 8 * (i >> 2) + 4 * hh; const bool same = (j >> 4) == (t >> 4);
                    const bool keep = same && (wl < 2 ? (j < t) : (j <= t)); acc[i] = keep ? acc[i] : 0.f; }
                if (wl == 0) {
#pragma unroll
                    for (int i = 0; i < 16; ++i) { const int j = (i & 3) + 8 * (i >> 2) + 4 * hh; *(LAS float*)(hl + CS_NBA + (t * 36 + j) * 4) = acc[i]; } }
                else if (wl == 1) {
#pragma unroll
                    for (int i = 0; i < 16; ++i) { const int j = (i & 3) + 8 * (i >> 2) + 4 * hh; *(LAS bf16*)(hl + CS_NKA + j * 80 + t * 2) = bfs(acc[i]); } }
                else { const float sg = wl == 2 ? 1.f : -1.f; const int base = wl == 2 ? CS_MKR : CS_MBR;
#pragma unroll
                    for (int q4 = 0; q4 < 4; ++q4) *(LAS v2u*)(hl + base + t * 80 + (8 * q4 + 4 * hh) * 2) = pack4((f32x4){sg * acc[4 * q4], sg * acc[4 * q4 + 1], sg * acc[4 * q4 + 2], sg * acc[4 * q4 + 3]}); }
            }
    __syncthreads();
            if (act && wl == 0 && lane < 32) {
                const int blk = lane >> 4, i = lane & 15;
                float Tr[16];
#pragma unroll
                for (int t = 0; t < 16; ++t) {
                    float acc = (t == i) ? 1.f : 0.f;
                    const LAS float* np = (const LAS float*)(hl + CS_NBA) + (16 * blk + t) * 36 + 16 * blk;
#pragma unroll
                    for (int j = 0; j < t; ++j) acc -= Tr[j] * np[j];
                    Tr[t] = acc;
                }
#pragma unroll
                for (int t = 0; t < 16; ++t) { *(LAS bf16*)(hl + CS_TT + (16 * blk + t) * 80 + (16 * blk + i) * 2) = bfs(Tr[t]); *(LAS bf16*)(hl + CS_TT + (16 * blk + t) * 80 + (16 * (1 - blk) + i) * 2) = (bf16)0; }
            }
    __syncthreads();
            if (act && wl < 3) {
                const int r = lane & 31, hh = lane >> 5;
                const LAS unsigned char* Ab = hl + (wl < 2 ? CS_AHC + (32 * wl + r) * 80 : CS_NKA + r * 80) + hh * 16;
                const LAS unsigned char* Bb = hl + CS_TT + r * 80 + hh * 16;
                f32x16 acc;
#pragma unroll
                for (int i = 0; i < 16; ++i) acc[i] = 0.f;
#pragma unroll
                for (int ks = 0; ks < 2; ++ks) { const bf16x8 a = *(const LAS bf16x8*)(Ab + ks * 32), bb = *(const LAS bf16x8*)(Bb + ks * 32); acc = __builtin_amdgcn_mfma_f32_32x32x16_bf16(a, bb, acc, 0, 0, 0); }
                const int t = r;
#pragma unroll
                for (int q4 = 0; q4 < 4; ++q4) { const v2u pk = pack4((f32x4){acc[4 * q4], acc[4 * q4 + 1], acc[4 * q4 + 2], acc[4 * q4 + 3]});
                    if (wl < 2) *(LAS v2u*)(hl + CS_APT + t * 144 + (32 * wl + 8 * q4 + 4 * hh) * 2) = pk;
                    else *(LAS v2u*)(hl + CS_NPT + t * 80 + (8 * q4 + 4 * hh) * 2) = pk; }
            }
    }
    __syncthreads();
#pragma unroll
    for (int i = 0; i < 4; ++i) { const int idx = tid + 512 * i; *(v4u*)(blob0 + idx * 16) = *(const LAS v4u*)(lds + idx * 16); }
    if (two) {
#pragma unroll
        for (int i = 0; i < 4; ++i) { const int idx = tid + 512 * i; *(v4u*)(blob0 + BL_BYTES + idx * 16) = *(const LAS v4u*)(lds + HSZ + idx * 16); } }
}
__device__ __forceinline__ void scan_y_store(Frame& F, int chain, int tile, int t0, int tid2) {
    const int b = chain >> 4, h = (chain >> 1) & 7, d = chain & 1;
    const int jt = tile - TC / 32, tlo = d == 0 ? 32 * jt : T - 32 * (jt + 1);
    const int s2 = tid2 >> 3, part = tid2 & 7; const int tk = d == 0 ? tlo + s2 : tlo + 31 - s2;
    const LAS float* ys = (const LAS float*)(F.lds + GS_YS + ((tile - t0) & 1) * 8192) + s2 * 64 + part * 8;
    float* dst = F.out + ((size_t)(b * T + tk)) * D + d * 512 + h * 64 + part * 8;
    *(f32x4*)dst = *(const LAS f32x4*)ys; *(f32x4*)(dst + 4) = *(const LAS f32x4*)(ys + 4);
}
__device__ __forceinline__ void scan_state_round(Frame& F, int chain, int t0, int t1, const unsigned char* blobs) {
    LAS unsigned char* lds = F.lds; const int tid = F.tid, lane = F.lane, wave = F.wave;
    f32x4* zs = (f32x4*)(F.ws + WS_ZS) + ((size_t)chain * 256 + (tid & 255)) * 4;
    f32x4 Z[4];
#pragma unroll
    for (int kt = 0; kt < 4; ++kt) Z[kt] = (t0 > 0 && wave < 4) ? zs[kt] : (f32x4){0.f, 0.f, 0.f, 0.f};
    __syncthreads();
    { v4u b0[4];
#pragma unroll
      for (int i = 0; i < 4; ++i) b0[i] = *(const v4u*)(blobs + (tid + 512 * i) * 16);
#pragma unroll
      for (int i = 0; i < 4; ++i) *(LAS v4u*)(lds + (tid + 512 * i) * 16) = b0[i]; }
    const int tid2 = tid - 256;
    v4u bg[4];
    if (t0 + 1 < t1) {
#pragma unroll
        for (int i = 0; i < 4; ++i) bg[i] = *(const v4u*)(blobs + (size_t)BL_BYTES + (tid + 512 * i) * 16); }
    __syncthreads();
    for (int tile = t0; tile < t1; ++tile) {
        const bool isctx = tile < TC / 32;
        const LAS unsigned char* bl = lds + ((tile - t0) & 1) * BL_BYTES;
        if (tile + 1 < t1) {
#pragma unroll
            for (int i = 0; i < 4; ++i) *(LAS v4u*)(lds + ((tile + 1 - t0) & 1) * BL_BYTES + (tid + 512 * i) * 16) = bg[i]; }
        if (tile + 2 < t1) {
#pragma unroll
            for (int i = 0; i < 4; ++i) bg[i] = *(const v4u*)(blobs + (size_t)(tile + 2 - t0) * BL_BYTES + (tid + 512 * i) * 16); }
        if (wave >= 4 && tile > t0 && tile - 1 >= TC / 32) scan_y_store(F, chain, tile - 1, t0, tid2);
        if (wave < 4) {
            const int n = lane & 15, g = lane >> 4;
            const bf16x8 bvt = *(const LAS bf16x8*)(bl + BL_VT + (16 * wave + n) * 80 + g * 16);
            f32x4 U[2]; U[0] = (f32x4){0.f, 0.f, 0.f, 0.f}; U[1] = U[0];
#pragma unroll
            for (int cc = 0; cc < 2; ++cc) {
                if (cc == 1) __builtin_amdgcn_sched_barrier(0);
                const int trow = 16 * cc + n;
                const LAS unsigned char* ap = bl + BL_APT + trow * 144; const LAS unsigned char* rp = bl + BL_RH + trow * 144; const LAS unsigned char* mp = bl + BL_MBR + trow * 80;
                const bf16x8 fAP0 = frag2(ap + (4 * g) * 2, ap + (16 + 4 * g) * 2), fAP1 = frag2(ap + (32 + 4 * g) * 2, ap + (48 + 4 * g) * 2);
                const bf16x8 fNP = *(const LAS bf16x8*)(bl + BL_NPT + trow * 80 + g * 16);
                f32x4 gcv = *(const LAS f32x4*)(bl + BL_GC + (cc * 64 + 4 * g) * 4);
                bf16x8 fKG = *(const LAS bf16x8*)(bl + BL_KGC + n * 80 + g * 16);
                v2u fBG = *(const LAS v2u*)(bl + BL_BGC + n * 80 + (16 * cc + 4 * g) * 2);
                asm volatile("" :: "v"(fAP0), "v"(fAP1), "v"(fNP), "v"(gcv), "v"(fKG), "v"(fBG));
                const bf16x8 bz01 = frag_acc(Z[0], Z[1]), bz23 = frag_acc(Z[2], Z[3]);
                f32x4 u = __builtin_amdgcn_mfma_f32_16x16x32_bf16(fAP0, bz01, (f32x4){0.f, 0.f, 0.f, 0.f}, 0, 0, 0);
                u = __builtin_amdgcn_mfma_f32_16x16x32_bf16(fAP1, bz23, u, 0, 0, 0);
                u = __builtin_amdgcn_mfma_f32_16x16x32_bf16(fNP, bvt, u, 0, 0, 0);
                U[cc] = u;
                const bf16x8 bu = frag_acc(U[0], U[1]);
                if (!isctx) {
                    const bf16x8 fRH0 = frag2(rp + (4 * g) * 2, rp + (16 + 4 * g) * 2), fRH1 = frag2(rp + (32 + 4 * g) * 2, rp + (48 + 4 * g) * 2);
                    const bf16x8 fMK = *(const LAS bf16x8*)(bl + BL_MKR + trow * 80 + g * 16);
                    const bf16x8 fMB = frag2(mp + (4 * g) * 2, mp + (16 + 4 * g) * 2);
                    asm volatile("" :: "v"(fRH0), "v"(fRH1), "v"(fMK), "v"(fMB));
                    f32x4 y = __builtin_amdgcn_mfma_f32_16x16x32_bf16(fRH0, bz01, (f32x4){0.f, 0.f, 0.f, 0.f}, 0, 0, 0);
                    y = __builtin_amdgcn_mfma_f32_16x16x32_bf16(fRH1, bz23, y, 0, 0, 0);
                    y = __builtin_amdgcn_mfma_f32_16x16x32_bf16(fMK, bvt, y, 0, 0, 0);
                    y = __builtin_amdgcn_mfma_f32_16x16x32_bf16(fMB, bu, y, 0, 0, 0);
#pragma unroll
                    for (int i = 0; i < 4; ++i) *(LAS float*)(lds + GS_YS + ((tile - t0) & 1) * 8192 + ((16 * cc + 4 * g + i) * 64 + 16 * wave + n) * 4) = y[i]; }
#pragma unroll
                for (int kt = 0; kt < 4; ++kt) {
                    f32x4 gcn = gcv; bf16x8 fKGn = fKG; v2u fBGn = fBG;
                    if (kt < 3) { gcn = *(const LAS f32x4*)(bl + BL_GC + (cc * 64 + 16 * (kt + 1) + 4 * g) * 4);
                        fKGn = *(const LAS bf16x8*)(bl + BL_KGC + (16 * (kt + 1) + n) * 80 + g * 16);
                        fBGn = *(const LAS v2u*)(bl + BL_BGC + (16 * (kt + 1) + n) * 80 + (16 * cc + 4 * g) * 2); }
                    const bf16x8 ka = ((g >> 1) == cc) ? fKG : frag_zero();
                    const v4u bw = cc == 0 ? (v4u){fBG.x, fBG.y, 0u, 0u} : (v4u){0u, 0u, fBG.x, fBG.y};
                    f32x4 z = Z[kt] * gcv;
                    z = __builtin_amdgcn_mfma_f32_16x16x32_bf16(ka, bvt, z, 0, 0, 0);
                    z = __builtin_amdgcn_mfma_f32_16x16x32_bf16(__builtin_bit_cast(bf16x8, bw), bu, z, 0, 0, 0);
                    Z[kt] = z;
                    if (kt < 3) asm volatile("" :: "v"(gcn), "v"(fKGn), "v"(fBGn));
                    gcv = gcn; fKG = fKGn; fBG = fBGn;
                }
            }
        }
        __syncthreads();
    }
    if (t1 - 1 >= TC / 32 && wave >= 4) scan_y_store(F, chain, t1 - 1, t0, tid - 256);
    if (wave < 4 && t1 < SC_NTILE) {
#pragma unroll
        for (int kt = 0; kt < 4; ++kt) zs[kt] = Z[kt]; }
    __syncthreads();
}
template <int LEVEL> __device__ __forceinline__ void p3_scan(Frame& F, const XcdBarrier& bar) {
    const bf16* proj = (const bf16*)(F.ws + WS_PROJ);
    const bool state_role = F.bid < 64;
    const int pchain = state_role ? F.bid : (F.bid - 64) / 3, psub = state_role ? 0 : (F.bid - 64) % 3;
    int prev_chain = -1;
    for (int step = 0; step <= SC_NROUND; ++step) {
        if (LEVEL != 1 && step >= 1 && state_role) {
            const int r = step - 1, t0 = r * SC_RT, t1 = (t0 + SC_RT < SC_NTILE) ? t0 + SC_RT : SC_NTILE;
            scan_state_round(F, F.bid, t0, t1, F.ws + ((r & 1) ? WS_BLOB1 : WS_BLOB0) + (size_t)F.bid * SC_RT * BL_BYTES);
            prev_chain = -1;
        }
        if (LEVEL != 2 && step < SC_NROUND) {
            const int t0 = step * SC_RT, nt = (t0 + SC_RT < SC_NTILE) ? SC_RT : SC_NTILE - t0;
            unsigned char* base = F.ws + ((step & 1) ? WS_BLOB1 : WS_BLOB0) + (size_t)pchain * SC_RT * BL_BYTES;
            int a0, a1;
            if (state_role) { a0 = 0; a1 = 1; } else { const int rest = nt - 1; a0 = 1 + rest * psub / 3; a1 = 1 + rest * (psub + 1) / 3; }
            v4u rg[6];
            if (a0 < a1) { v4u n0[3]; scan_issue_loads(proj, pchain >> 4, (pchain >> 1) & 7, pchain & 1, t0 + a0, F.tid, n0); rg[0] = n0[0]; rg[1] = n0[1]; rg[2] = n0[2];
                if (a0 + 1 < a1) { v4u n1[3]; scan_issue_loads(proj, pchain >> 4, (pchain >> 1) & 7, pchain & 1, t0 + a0 + 1, F.tid, n1); rg[3] = n1[0]; rg[4] = n1[1]; rg[5] = n1[2]; } }
            for (int tl = a0; tl < a1; tl += 2) {
                const bool two = tl + 1 < a1, have_next = tl + 2 < a1, ntwo = tl + 3 < a1;
                scan_prep_pair(F, proj, pchain, t0 + tl, two, pchain != prev_chain, have_next, t0 + tl + 2, ntwo, rg, base + (size_t)tl * BL_BYTES);
                prev_chain = pchain;
            }
        }
        if (step < SC_NROUND) xcd_barrier(bar);
    }
}
constexpr int P4_SG = 0, P4_GT = 17408, P4_CST = 17408 + 64 * 1040, P4_END = P4_CST + 12 * 2048;
__device__ __forceinline__ f32x4 ldq(const LAS float* p) { return *(const LAS f32x4*)p; }
__device__ __forceinline__ void unpack8(v4u w, float (&o)[8]) { o[0] = bf_lo(w.x); o[1] = bf_hi(w.x); o[2] = bf_lo(w.y); o[3] = bf_hi(w.y); o[4] = bf_lo(w.z); o[5] = bf_hi(w.z); o[6] = bf_lo(w.w); o[7] = bf_hi(w.w); }
__device__ __forceinline__ float sum8lanes(float p) { p += dppf<0xB1>(p); p += dppf<0x4E>(p); p += dppf<0x141>(p); return p; }
__device__ __forceinline__ void p4_mix(Frame& F) {
    LAS unsigned char* lds = F.lds; const int tid = F.tid, lane = F.lane, wave = F.wave;
    const bf16* proj = (const bf16*)(F.ws + WS_PROJ); bf16* cat = (bf16*)(F.ws + WS_HX); const float* yscr = F.out; const bf16* gwt = (const bf16*)(F.ws + WS_GWT);
    LAS float* CST = (LAS float*)(lds + P4_CST);
    __syncthreads();
    for (int i = tid; i < 12 * 512; i += 512) { const int row = i >> 9, c = i & 511;
        CST[i] = row < 6 ? F.in[I_TMU][row * 512 + c] : row == 6 ? F.in[I_RK][c] : row == 7 ? F.in[I_LNG][c] : row == 8 ? F.in[I_LNB][c] : F.in[I_CONVW][(row - 9) * 512 + c]; }
    for (int unit = F.bid; unit < MX / 64; unit += F.G) {
        const size_t row0 = (size_t)unit * 64; const int tb0 = (unit * 64) & (T - 1);
        __syncthreads();
#pragma unroll
        for (int i = 0; i < 2; ++i) { const int ck = tid + 512 * i, tok = ck >> 4, j0 = (ck & 15) * 8;
            const v4u w = *(const v4u*)(proj + (row0 + tok) * NPROJ + COL_G + j0);
            v4u o; o.x = pk2(sigmoidf(bf_lo(w.x)), sigmoidf(bf_hi(w.x))); o.y = pk2(sigmoidf(bf_lo(w.y)), sigmoidf(bf_hi(w.y))); o.z = pk2(sigmoidf(bf_lo(w.z)), sigmoidf(bf_hi(w.z))); o.w = pk2(sigmoidf(bf_lo(w.w)), sigmoidf(bf_hi(w.w)));
            *(LAS v4u*)(lds + P4_SG + tok * 272 + j0 * 2) = o; }
        __syncthreads();
        { const int r = lane & 31, hh = lane >> 5;
#pragma unroll
          for (int nt = 0; nt < 2; ++nt) {
              const bf16* bp = gwt + (size_t)(64 * wave + 32 * nt + r) * 128 + hh * 8;
              bf16x8 bfr[8];
#pragma unroll
              for (int ks = 0; ks < 8; ++ks) bfr[ks] = *(const bf16x8*)(bp + ks * 16);
#pragma unroll
              for (int mt = 0; mt < 2; ++mt) {
                  f32x16 acc;
#pragma unroll
                  for (int i = 0; i < 16; ++i) acc[i] = 0.f;
#pragma unroll
                  for (int ks = 0; ks < 8; ++ks) { const bf16x8 a = *(const LAS bf16x8*)(lds + P4_SG + (32 * mt + r) * 272 + ks * 32 + hh * 16); acc = __builtin_amdgcn_mfma_f32_32x32x16_bf16(a, bfr[ks], acc, 0, 0, 0); }
#pragma unroll
                  for (int i = 0; i < 16; ++i) *(LAS bf16*)(lds + P4_GT + (32 * mt + (i & 3) + 8 * (i >> 2) + 4 * hh) * 1040 + (64 * wave + 32 * nt + r) * 2) = (bf16)(pk2(acc[i], 0.f) & 0xffffu);
              } } }
        __syncthreads();
        const int gq = tid & 63, c0 = gq * 8;
#pragma unroll 2
        for (int n = 0; n < 8; ++n) { const int t = 8 * n + (tid >> 6); const int tb = tb0 + t;
            const bf16* pr = proj + (row0 + t) * NPROJ + c0;
            float xs[3][8];
#pragma unroll
            for (int which = 0; which < 3; ++which) { const int col = COL_R + which * 512;
                float xc[8], xp[8], xn[8];
                unpack8(*(const v4u*)(pr + col), xc);
                if (tb > 0) unpack8(*(const v4u*)(pr - NPROJ + col), xp); else {
#pragma unroll
                    for (int e = 0; e < 8; ++e) xp[e] = 0.f; }
                if (tb + 1 < T) unpack8(*(const v4u*)(pr + NPROJ + col), xn); else {
#pragma unroll
                    for (int e = 0; e < 8; ++e) xn[e] = 0.f; }
                const f32x4 mp0 = ldq(CST + which * 512 + c0), mp1 = ldq(CST + which * 512 + c0 + 4), mn0 = ldq(CST + (3 + which) * 512 + c0), mn1 = ldq(CST + (3 + which) * 512 + c0 + 4);
#pragma unroll
                for (int e = 0; e < 8; ++e) { const float mp = e < 4 ? mp0[e & 3] : mp1[e & 3], mn = e < 4 ? mn0[e & 3] : mn1[e & 3]; xs[which][e] = xc[e] + mp * (xp[e] - xc[e]) + mn * (xn[e] - xc[e]); } }
            const float* yr = yscr + (row0 + t) * D + c0;
            const f32x4 ya = *(const f32x4*)yr + *(const f32x4*)(yr + 512), yb = *(const f32x4*)(yr + 4) + *(const f32x4*)(yr + 516);
            float y[8] = {ya.x, ya.y, ya.z, ya.w, yb.x, yb.y, yb.z, yb.w};
            float sm = 0.f, sb = 0.f;
            const f32x4 rk0 = ldq(CST + 6 * 512 + c0), rk1 = ldq(CST + 6 * 512 + c0 + 4);
#pragma unroll
            for (int e = 0; e < 8; ++e) { sm += y[e]; sb += xs[0][e] * xs[1][e] * (e < 4 ? rk0[e & 3] : rk1[e & 3]); }
            const float mu = sum8lanes(sm) * (1.f / 64.f); const float bon = sum8lanes(sb);
            float sv = 0.f;
#pragma unroll
            for (int e = 0; e < 8; ++e) { y[e] -= mu; sv += y[e] * y[e]; }
            const float rstd = __builtin_amdgcn_rsqf(sum8lanes(sv) * (1.f / 64.f) + LNX_EPS);
            const f32x4 lg0 = ldq(CST + 7 * 512 + c0), lg1 = ldq(CST + 7 * 512 + c0 + 4), lb0 = ldq(CST + 8 * 512 + c0), lb1 = ldq(CST + 8 * 512 + c0 + 4);
            float gt[8]; unpack8(*(const LAS v4u*)(lds + P4_GT + t * 1040 + c0 * 2), gt);
            float o[8];
#pragma unroll
            for (int e = 0; e < 8; ++e) o[e] = (y[e] * rstd * (e < 4 ? lg0[e & 3] : lg1[e & 3]) + (e < 4 ? lb0[e & 3] : lb1[e & 3]) + bon * xs[2][e]) * gt[e];
            *(v4u*)(cat + (row0 + t) * D + 512 + c0) = (v4u){pk2(o[0], o[1]), pk2(o[2], o[3]), pk2(o[4], o[5]), pk2(o[6], o[7])};
        }
#pragma unroll 2
        for (int n = 0; n < 8; ++n) { const int t = 8 * n + (tid >> 6);
            const bf16* pr = proj + (row0 + t) * NPROJ + c0;
            float zc[8], zp[8], zn[8], g8[8], x8[8], xb[8];
            unpack8(*(const v4u*)(pr + COL_XG), g8); unpack8(*(const v4u*)(pr + COL_XC), x8);
#pragma unroll
            for (int e = 0; e < 8; ++e) zc[e] = g8[e] * x8[e];
            if (t > 0) { unpack8(*(const v4u*)(pr - NPROJ + COL_XG), g8); unpack8(*(const v4u*)(pr - NPROJ + COL_XC), x8);
#pragma unroll
                for (int e = 0; e < 8; ++e) zp[e] = g8[e] * x8[e]; } else {
#pragma unroll
                for (int e = 0; e < 8; ++e) zp[e] = 0.f; }
            if (t < 63) { unpack8(*(const v4u*)(pr + NPROJ + COL_XG), g8); unpack8(*(const v4u*)(pr + NPROJ + COL_XC), x8);
#pragma unroll
                for (int e = 0; e < 8; ++e) zn[e] = g8[e] * x8[e]; } else {
#pragma unroll
                for (int e = 0; e < 8; ++e) zn[e] = 0.f; }
            unpack8(*(const v4u*)(pr + COL_XB), xb);
            const f32x4 w00 = ldq(CST + 9 * 512 + c0), w01 = ldq(CST + 9 * 512 + c0 + 4), w10 = ldq(CST + 10 * 512 + c0), w11 = ldq(CST + 10 * 512 + c0 + 4), w20 = ldq(CST + 11 * 512 + c0), w21 = ldq(CST + 11 * 512 + c0 + 4);
            float o[8];
#pragma unroll
            for (int e = 0; e < 8; ++e) o[e] = xb[e] * ((e < 4 ? w00[e & 3] : w01[e & 3]) * zp[e] + (e < 4 ? w10[e & 3] : w11[e & 3]) * zc[e] + (e < 4 ? w20[e & 3] : w21[e & 3]) * zn[e]);
            *(v4u*)(cat + (row0 + t) * D + c0) = (v4u){pk2(o[0], o[1]), pk2(o[2], o[3]), pk2(o[4], o[5]), pk2(o[6], o[7])};
        }
    }
}

__device__ __forceinline__ void p6_mid(Frame& F) {
    const float* mod = (const float*)(F.ws + WS_MOD); const float* ng = F.in[I_NG];
    const float* yx = (const float*)(F.ws + WS_PROJ); bf16* hx2 = (bf16*)(F.ws + WS_HX);
    for (int m = F.bid * NWAVES + F.wave; m < MX; m += F.G * NWAVES) {
        const float* mr = mod + (m >> 12) * NMOD;
        f32x4 v[4], xv[4]; float ss = 0.f;
#pragma unroll
        for (int j = 0; j < 4; ++j) { v[j] = *(const f32x4*)(yx + (size_t)m * D + j * 256 + F.lane * 4); xv[j] = *(const f32x4*)(F.in[I_X] + (size_t)m * D + j * 256 + F.lane * 4);
            ss += v[j].x * v[j].x + v[j].y * v[j].y + v[j].z * v[j].z + v[j].w * v[j].w; }
        const float rstd = __builtin_amdgcn_rsqf(wave_sum(ss) * (1.f / D) + NORM_EPS);
        float ss2 = 0.f;
#pragma unroll
        for (int j = 0; j < 4; ++j) { const int c = j * 256 + F.lane * 4;
            const f32x4 g1 = *(const f32x4*)(ng + D + c), gt = *(const f32x4*)(mr + 2 * D + c);
            xv[j] = xv[j] + gt * (v[j] * rstd * g1);
            *(f32x4*)(F.out + (size_t)m * D + c) = xv[j];
            ss2 += xv[j].x * xv[j].x + xv[j].y * xv[j].y + xv[j].z * xv[j].z + xv[j].w * xv[j].w; }
        const float rstd2 = __builtin_amdgcn_rsqf(wave_sum(ss2) * (1.f / D) + NORM_EPS);
#pragma unroll
        for (int j = 0; j < 4; ++j) { const int c = j * 256 + F.lane * 4;
            const f32x4 g2 = *(const f32x4*)(ng + 2 * D + c), sh = *(const f32x4*)(mr + 3 * D + c), sc = *(const f32x4*)(mr + 4 * D + c);
            const f32x4 o = xv[j] * rstd2 * g2 * (1.f + sc) + sh;
            *(v2u*)(hx2 + (size_t)m * D + c) = (v2u){pk2(o.x, o.y), pk2(o.z, o.w)}; }
    }
}
__device__ __forceinline__ float gelu_erf(float x) { return 0.5f * x * (1.f + erff(x * 0.70710678118f)); }
__device__ __forceinline__ float dot2bf(unsigned a, unsigned b, float c) {
    typedef __bf16 bf2 __attribute__((ext_vector_type(2)));
    return __builtin_amdgcn_fdot2_f32_bf16(__builtin_bit_cast(bf2, a), __builtin_bit_cast(bf2, b), c, false);
}
__device__ __forceinline__ unsigned uminu(unsigned a, unsigned b) { return a < b ? a : b; }
__device__ __forceinline__ void ce_desc(unsigned& x, unsigned& y) { const unsigned hi = umaxu(x, y), lo = uminu(x, y); x = hi; y = lo; }
template <int N> __device__ __forceinline__ void bitonic_sort_desc(unsigned (&a)[N]) {
#pragma unroll
    for (int k = 2; k <= N; k <<= 1)
#pragma unroll
        for (int j = k >> 1; j > 0; j >>= 1)
#pragma unroll
            for (int i = 0; i < N; ++i) { const int l = i ^ j; if (l > i) { if ((i & k) == 0) ce_desc(a[i], a[l]); else ce_desc(a[l], a[i]); } }
}
template <int N> __device__ __forceinline__ void bitonic_merge_desc(unsigned (&a)[N]) {
#pragma unroll
    for (int j = N >> 1; j > 0; j >>= 1)
#pragma unroll
        for (int i = 0; i < N; ++i) { const int l = i ^ j; if (l > i) ce_desc(a[i], a[l]); }
}
__device__ __forceinline__ void p8a_route(Frame& F) {
    const int lane = F.lane, wave = F.wave, part = lane & 3, L = lane >> 2, side = L & 1;
    LAS unsigned char* WL = F.lds + 1024 + wave * 1024;
    LAS unsigned char* TAB = F.lds;
    const float* scores = (const float*)(F.ws + WS_PROJ);
    unsigned short* exl = (unsigned short*)(F.ws + WS_EXL); float* gl = (float*)(F.ws + WS_GL);
    __syncthreads();
    if (F.tid < 64) { int l = F.tid, i = 0; for (; i < 16; ++i) { const int n = 16 / (i + 1); if (l < n) break; l -= n; } TAB[F.tid] = (unsigned char)(i < 16 ? i * 16 + l : 0); }
    __syncthreads();
    for (int m = F.bid * NWAVES + wave; m < MX; m += F.G * NWAVES) {
        const float* lp = scores + (size_t)m * NSC + L * 128 + part * 32;
        unsigned lo16[16], hi16[16];
#pragma unroll
        for (int q = 0; q < 4; ++q) { const f32x4 v = *(const f32x4*)(lp + 4 * q), w = *(const f32x4*)(lp + 16 + 4 * q);
#pragma unroll
            for (int e = 0; e < 4; ++e) { lo16[4 * q + e] = (f2key(v[e]) & ~127u) | (unsigned)(127 - part * 32 - (4 * q + e)); hi16[4 * q + e] = (f2key(w[e]) & ~127u) | (unsigned)(127 - part * 32 - 16 - (4 * q + e)); } }
        bitonic_sort_desc<16>(lo16); bitonic_sort_desc<16>(hi16);
        unsigned r[16];
#pragma unroll
        for (int i = 0; i < 16; ++i) r[i] = umaxu(lo16[i], hi16[15 - i]);
        bitonic_merge_desc<16>(r);
        { unsigned c[16];
#pragma unroll
          for (int i = 0; i < 16; ++i) c[i] = umaxu(r[i], dppu<0xB1>(r[15 - i]));
          bitonic_merge_desc<16>(c);
#pragma unroll
          for (int i = 0; i < 16; ++i) r[i] = umaxu(c[i], dppu<0x4E>(c[15 - i]));
          bitonic_merge_desc<16>(r); }
        if (part == 0) {
#pragma unroll
            for (int i = 0; i < 16; ++i) WL[L * 16 + i] = (unsigned char)(127u - (r[i] & 127u)); }
        float fa[16], fb[16];
#pragma unroll
        for (int i = 0; i < 16; ++i) { const unsigned up = dppu<0x104>(r[i]), dn = dppu<0x114>(r[i]);
            const unsigned av = side ? dn : r[i], bv = side ? r[i] : up; fa[i] = key2f(av & ~127u); fb[i] = key2f(bv & ~127u); }
        unsigned R[16];
#pragma unroll
        for (int j = 0; j < 16; ++j) R[j] = (f2key(fa[0] + fb[j]) & ~63u) | (unsigned)(63 - j);
        { int code = 16;
#pragma unroll
          for (int i = 1; i < 16; ++i) {
#pragma unroll
              for (int j = 0; j < 16; ++j) { if ((i + 1) * (j + 1) <= 16) {
                  const unsigned x = (f2key(fa[i] + fb[j]) & ~63u) | (unsigned)(63 - code); const int p0 = (i + 1) * (j + 1) - 1;
#pragma unroll
                  for (int p = 15; p > p0; --p) R[p] = umaxu(R[p], uminu(R[p - 1], x));
                  R[p0] = umaxu(R[p0], x); ++code; } } } }
        if ((lane & 7) == 0) {
#pragma unroll
            for (int k = 0; k < 16; ++k) *(LAS unsigned*)(WL + 256 + ((lane >> 3) * 16 + k) * 4) = R[k]; }
        LDS_WAIT();
#pragma unroll
        for (int half = 0; half < 2; ++half) { const int e = lane + 64 * half, hd = e >> 4;
            const unsigned rk = *(const LAS unsigned*)(WL + 256 + e * 4); const int ij = TAB[63 - (int)(rk & 63u)];
            const int idx0 = WL[(2 * hd) * 16 + (ij >> 4)], idx1 = WL[(2 * hd + 1) * 16 + (ij & 15)];
            const float scv = key2f(rk & ~63u);
            float mx = scv; mx = fmaxf(mx, dppf<0xB1>(mx)); mx = fmaxf(mx, dppf<0x4E>(mx)); mx = fmaxf(mx, dppf<0x141>(mx)); mx = fmaxf(mx, dppf<0x140>(mx));
            const float ev = fast_exp(scv - mx); const float den = rowsum16(ev);
            exl[(size_t)m * 128 + e] = (unsigned short)(idx0 * 128 + idx1); gl[(size_t)m * 128 + e] = ev * fast_rcp(den); }
        LDS_WAIT();
    }
}
__device__ __forceinline__ void p9_upass(Frame& F) {
    const int lane = F.lane, wave = F.wave, x = F.bid & 7, r = F.bid >> 3, nr = F.G >> 3, g = lane >> 3, q = lane & 7;
    LAS unsigned short* EXW = (LAS unsigned short*)(F.lds + wave * 256);
    const unsigned* exl32 = (const unsigned*)(F.ws + WS_EXL); const bf16* hx2 = (const bf16*)(F.ws + WS_HX);
    const unsigned char* U = F.ws + WS_U + 128 * x + 16 * q; float* part = (float*)(F.ws + WS_PART) + (size_t)x * MX * 128;
    for (int m = r + nr * wave; m < MX; m += nr * NWAVES) {
        *(LAS unsigned*)(EXW + 2 * lane) = exl32[(size_t)m * 64 + lane];
        const v4u h0 = *(const v4u*)(hx2 + (size_t)m * D + 128 * x + 16 * q), h1 = *(const v4u*)(hx2 + (size_t)m * D + 128 * x + 16 * q + 8);
        float hf[16];
        hf[0] = bf_lo(h0.x); hf[1] = bf_hi(h0.x); hf[2] = bf_lo(h0.y); hf[3] = bf_hi(h0.y); hf[4] = bf_lo(h0.z); hf[5] = bf_hi(h0.z); hf[6] = bf_lo(h0.w); hf[7] = bf_hi(h0.w);
        hf[8] = bf_lo(h1.x); hf[9] = bf_hi(h1.x); hf[10] = bf_lo(h1.y); hf[11] = bf_hi(h1.y); hf[12] = bf_lo(h1.z); hf[13] = bf_hi(h1.z); hf[14] = bf_lo(h1.w); hf[15] = bf_hi(h1.w);
        LDS_WAIT();
        float keep[2];
#pragma unroll
        for (int j = 0; j < 2; ++j) {
            float kp = 0.f;
            v4u uu[8];
#pragma unroll
            for (int i = 0; i < 8; ++i) { const unsigned ex = EXW[64 * j + 8 * i + g]; uu[i] = *(const v4u*)(U + (size_t)ex * 1024); }
#pragma unroll
            for (int i = 0; i < 8; ++i) { float p = 0.f;
#pragma unroll
                for (int w = 0; w < 4; ++w) { const f32x2 lo = __builtin_amdgcn_cvt_pk_f32_fp8((int)uu[i][w], false), hi = __builtin_amdgcn_cvt_pk_f32_fp8((int)uu[i][w], true);
                    p += lo.x * hf[4 * w] + lo.y * hf[4 * w + 1] + hi.x * hf[4 * w + 2] + hi.y * hf[4 * w + 3]; }
                p += dppf<0xB1>(p); p += dppf<0x4E>(p); p += dppf<0x141>(p);
                kp = (q == i) ? p : kp; }
            keep[j] = kp * (1.f / 32.f);
        }
        part[(size_t)m * 128 + 8 * q + g] = keep[0]; part[(size_t)m * 128 + 64 + 8 * q + g] = keep[1];
        LDS_WAIT();
    }
}
__device__ __forceinline__ void p10_combine(Frame& F) {
    const float* __restrict__ part = (const float*)(F.ws + WS_PART); const float* __restrict__ gl = (const float*)(F.ws + WS_GL);
    const unsigned short* __restrict__ exl = (const unsigned short*)(F.ws + WS_EXL); unsigned* __restrict__ plt = (unsigned*)(F.ws + WS_PL);
    LAS unsigned* TL = (LAS unsigned*)F.lds;
    for (int unit = F.bid; unit < MX / 64; unit += F.G) {
        const int m0 = unit * 64;
        __syncthreads();
#pragma unroll 4
        for (int i = 0; i < 16; ++i) { const int idx = F.tid + 512 * i, ml = idx >> 7, k = idx & 127; const size_t gi = (size_t)(m0 + ml) * 128 + k;
            float s = part[gi];
#pragma unroll
            for (int x = 1; x < 8; ++x) s += part[(size_t)x * MX * 128 + gi];
            TL[k * 65 + ml] = (unsigned)exl[gi] | ((unsigned)__builtin_bit_cast(unsigned short, (_Float16)(gl[gi] * gelu_erf(s))) << 16); }
        __syncthreads();
#pragma unroll 4
        for (int i = 0; i < 16; ++i) { const int idx = F.tid + 512 * i, k = idx >> 6, ml = idx & 63; plt[(size_t)k * MX + m0 + ml] = TL[k * 65 + ml]; }
    }
}
typedef _Float16 h2_t __attribute__((ext_vector_type(2)));
typedef _Float16 h4_t __attribute__((ext_vector_type(4)));
template <int MODE> __device__ __forceinline__ void p11_vpass(Frame& F) {
    const int lane = F.lane, wave = F.wave;
    const unsigned* __restrict__ plt = (const unsigned*)(F.ws + WS_PL); float* __restrict__ po = (float*)(F.ws + WS_PO);
    for (int cg = F.bid; cg < 256; cg += F.G) {
        const int c0 = 128 * (cg & 7) + 4 * (cg >> 3);
        __syncthreads();
        for (int e = F.tid; e < NEXP; e += 512) { const f32x4 vv = *(const f32x4*)(F.in[I_PV] + (size_t)e * D + c0);
            const h2_t a = {(_Float16)vv.x, (_Float16)vv.y}, b = {(_Float16)vv.z, (_Float16)vv.w};
            *(LAS v2u*)(F.lds + e * 8) = (v2u){__builtin_bit_cast(unsigned, a), __builtin_bit_cast(unsigned, b)}; }
        __syncthreads();
        for (int mg = wave; mg < MX / 64; mg += NWAVES) {
            const unsigned* __restrict__ pg = plt + mg * 64;
            f32x4 acc = (f32x4){0.f, 0.f, 0.f, 0.f};
#pragma unroll 2
            for (int k0 = 0; k0 < 128; k0 += 8) {
                unsigned p[8];
#pragma unroll
                for (int i = 0; i < 8; ++i) p[i] = pg[(size_t)(k0 + i) * MX + lane];
                h2_t a01 = {(_Float16)0.f, (_Float16)0.f}, a23 = a01;
#pragma unroll
                for (int i = 0; i < 8; ++i) { const h4_t hv = *(const LAS h4_t*)(unsigned)((p[i] & 0xffffu) << 3);
                    const _Float16 cf = __builtin_bit_cast(_Float16, (unsigned short)(p[i] >> 16)); const h2_t c2 = {cf, cf};
                    a01 = __builtin_shufflevector(hv, hv, 0, 1) * c2 + a01; a23 = __builtin_shufflevector(hv, hv, 2, 3) * c2 + a23; }
                acc.x += (float)a01.x; acc.y += (float)a01.y; acc.z += (float)a23.x; acc.w += (float)a23.y;
            }
            *(f32x4*)(po + (size_t)(mg * 64 + lane) * D + c0) = acc;
        }
    }
}
__device__ __forceinline__ void p12_final(Frame& F) {
    const float* mod = (const float*)(F.ws + WS_MOD); const float* ng3 = F.in[I_NG] + 3 * D; const float* po = (const float*)(F.ws + WS_PO);
    for (int m = F.bid * NWAVES + F.wave; m < MX; m += F.G * NWAVES) {
        const float* gt2 = mod + (m >> 12) * NMOD + 5 * D;
        f32x4 v[4]; float ss = 0.f;
#pragma unroll
        for (int j = 0; j < 4; ++j) { v[j] = *(const f32x4*)(po + (size_t)m * D + j * 256 + F.lane * 4); ss += v[j].x * v[j].x + v[j].y * v[j].y + v[j].z * v[j].z + v[j].w * v[j].w; }
        const float rstd = __builtin_amdgcn_rsqf(wave_sum(ss) * (1.f / D) + NORM_EPS);
#pragma unroll
        for (int j = 0; j < 4; ++j) { const int c = j * 256 + F.lane * 4; float* op = F.out + (size_t)m * D + c;
            const f32x4 x1 = *(const f32x4*)op, g = *(const f32x4*)(ng3 + c), gt = *(const f32x4*)(gt2 + c);
            *(f32x4*)op = x1 + gt * (v[j] * rstd * g); }
    }
}
struct Args { const float* in[25]; float* out; unsigned char* ws; int ph_lo, ph_hi; };
__global__ void __launch_bounds__(NWAVES * 64, 2) mk_fwd(Args args) {
    extern __shared__ __attribute__((aligned(16))) unsigned char lds_raw[];
    Frame F;
    F.lds = (LAS unsigned char*)lds_raw;
    F.MISC = (volatile LAS unsigned*)(F.lds + MISC_OFF);
    F.tid = threadIdx.x; F.lane = F.tid & 63; F.wave = __builtin_amdgcn_readfirstlane(F.tid >> 6);
    F.G = gridDim.x; F.bid = blockIdx.x;
#pragma unroll
    for (int i = 0; i < 25; ++i) F.in[i] = args.in[i];
    F.out = args.out; F.ws = args.ws; F.ctl = (gu32*)(args.ws + WS_CTL);
    for (int u = F.tid; u < (LDS_BYTES - LDSCTL_OFF) / 4; u += NWAVES * 64) ((LAS unsigned*)(F.lds + LDSCTL_OFF))[u] = 0u;
    __syncthreads();
    const int lo = args.ph_lo, hi = args.ph_hi;
    XcdBarrier bar; bar.bar = (unsigned*)(F.ctl + CW_BAR); bar.x = 0; bar.st = nullptr;
    if (hi - lo > 1) bar = xcd_barrier_post((unsigned*)(F.ctl + CW_BAR), F.MISC + 8);
#ifndef PROBE_LO
#define PROBE_LO -1
#define PROBE_HI -1
#endif
#define IN(k) (lo <= (k) && (k) < hi)
#define SEAM(k) do { if (IN(k) && IN((k) + 1)) xcd_barrier(bar); } while (0)
#define PH0 { p0_prep(F); }
#define PH1 { p1_hx(F); }
#define PH2 { pg8::Gemm g{(const pg8::bf16_t*)(F.ws + WS_HX), (const pg8::bf16_t*)(F.ws + WS_WINT), MA, NPROJ_PAD, D}; pg8::StaticOrder S; S.init(MA, NPROJ_PAD, F.G, F.bid); \
        pg8::EpiProj E{(pg8::bf16_t*)(F.ws + WS_PROJ), NPROJ, NPROJ}; \
        pg8::gemm_phase<pg8::EpiProj, pg8::StaticOrder, PG8_ALIGN, PG8_SP2>(F.lds, g, S, E); }
#define PH3 { p3_scan<0>(F, bar); }
#define PH4 { p4_mix(F); }
#define PH5 { pg8::Gemm g{(const pg8::bf16_t*)(F.ws + WS_HX), (const pg8::bf16_t*)(F.ws + WS_WOUTT), MX, D, D}; pg8::StaticOrder S; S.init(MX, D, F.G, F.bid); \
        pg8::EpiF32 E{(float*)(F.ws + WS_PROJ), D}; \
        pg8::gemm_phase<pg8::EpiF32, pg8::StaticOrder, PG8_ALIGN, PG8_SP2>(F.lds, g, S, E); }
#define PH6 { p6_mid(F); }
#define PH7 { pg8::Gemm g{(const pg8::bf16_t*)(F.ws + WS_HX), (const pg8::bf16_t*)(F.ws + WS_WEFFT), MX, NSC, D}; pg8::StaticOrder S; S.init(MX, NSC, F.G, F.bid); \
        pg8::EpiF32 E{(float*)(F.ws + WS_PROJ), NSC}; \
        pg8::gemm_phase<pg8::EpiF32, pg8::StaticOrder, PG8_ALIGN, PG8_SP2>(F.lds, g, S, E); }
#define PH8 { p8a_route(F); }
#define PH9 { p9_upass(F); }
#define PH10 { p10_combine(F); }
#define PH11 { p11_vpass<0>(F); }
#define PH12 { p12_final(F); }
#define PRB(k, body) if constexpr (PROBE_LO <= (k) && (k) <= PROBE_HI) { xcd_barrier(bar); body }
    if (IN(0)) PH0 PRB(0, PH0) SEAM(0);
    if (IN(1)) PH1 PRB(1, PH1) SEAM(1);
    if (IN(2)) PH2 PRB(2, PH2) SEAM(2);
    if constexpr (PROBE_LO == 33) { p3_scan<1>(F, bar); xcd_barrier(bar); }
    if constexpr (PROBE_LO == 34) { p3_scan<2>(F, bar); xcd_barrier(bar); }
    if (IN(3)) PH3 PRB(3, PH3) SEAM(3);
    if (IN(4)) PH4 PRB(4, PH4) SEAM(4);
    if (IN(5)) PH5 PRB(5, PH5) SEAM(5);
    if (IN(6)) PH6 PRB(6, PH6) SEAM(6);
    if (IN(7)) PH7 PRB(7, PH7) SEAM(7);
    if (IN(8)) PH8 PRB(8, PH8) SEAM(8);
    if (IN(9)) PH9 PRB(9, PH9) SEAM(9);
    if (IN(10)) PH10 PRB(10, PH10) SEAM(10);
    if constexpr (PROBE_LO == 111) { p11_vpass<1>(F); xcd_barrier(bar); }
    if constexpr (PROBE_LO == 112) { p11_vpass<2>(F); xcd_barrier(bar); }
    if (IN(11)) PH11 PRB(11, PH11) SEAM(11);
    if (IN(12)) PH12
#undef IN
#undef SEAM
}

extern "C" void kernel_launch(void* const* d_in, const int* in_sizes, int n_in, void* d_out, int out_size, void* d_ws, size_t ws_size, hipStream_t stream) {
    static int grid = 0;
    if (grid == 0) {
        if (n_in != 25 || in_sizes[0] != MX * D || out_size != MX * D || ws_size < WS_END) { fprintf(stderr, "kernel_launch: unexpected problem (n_in %d, in0 %d, out %d, ws %zu); nothing launched\n", n_in, n_in > 0 ? in_sizes[0] : -1, out_size, ws_size); grid = -1; return; }
        int dev = 0, cus = 0, per_cu = 0;
        if (hipGetDevice(&dev) != hipSuccess || hipDeviceGetAttribute(&cus, hipDeviceAttributeMultiprocessorCount, dev) != hipSuccess) { fprintf(stderr, "kernel_launch: device query failed\n"); grid = -1; return; }
        if (hipFuncSetAttribute((const void*)mk_fwd, hipFuncAttributeMaxDynamicSharedMemorySize, LDS_BYTES) != hipSuccess) { fprintf(stderr, "kernel_launch: hipFuncSetAttribute failed\n"); grid = -1; return; }
        if (hipOccupancyMaxActiveBlocksPerMultiprocessor(&per_cu, (const void*)mk_fwd, NWAVES * 64, LDS_BYTES) != hipSuccess || per_cu < 1) fprintf(stderr, "kernel_launch: occupancy query reports %d workgroups per CU\n", per_cu);
        (void)hipGetLastError();
        grid = cus;
        if (grid != 256) { fprintf(stderr, "kernel_launch: this build needs a 256-CU device (got %d); nothing launched\n", grid); grid = -1; return; }
    }
    if (grid < 0) return;
    if (hipMemsetAsync((char*)d_ws + WS_CTL, 0, CTL_ZERO_BYTES, stream) != hipSuccess) { fprintf(stderr, "kernel_launch: memset failed\n"); return; }
    Args a{};
    for (int i = 0; i < 25; ++i) a.in[i] = (const float*)d_in[i];
    a.out = (float*)d_out; a.ws = (unsigned char*)d_ws;
    if (MK_N_LAUNCHES == 1) { a.ph_lo = 0; a.ph_hi = NPH; hipLaunchKernelGGL(mk_fwd, dim3(grid), dim3(NWAVES * 64), LDS_BYTES, stream, a); }
    else for (int p = 0; p < NPH; ++p) { a.ph_lo = p; a.ph_hi = p + 1; hipLaunchKernelGGL(mk_fwd, dim3(grid), dim3(NWAVES * 64), LDS_BYTES, stream, a); }
    const hipError_t le = hipPeekAtLastError();
    if (le != hipSuccess) fprintf(stderr, "kernel_launch: launch failed: %s\n", hipGetErrorName(le));
}
```

```cpp
#include <hip/hip_runtime.h>
#include <cstdio>
#include <cstdint>
namespace pg8 {
#define PG8_LAS __attribute__((address_space(3)))
typedef unsigned short bf16_t;
typedef short bf16x8 __attribute__((ext_vector_type(8)));
typedef float f32x4 __attribute__((ext_vector_type(4)));
typedef unsigned u32x4 __attribute__((ext_vector_type(4)));
constexpr int BM = 256, BK = 64, HALF = 128, HTB = HALF * BK * 2  , STAGE_BYTES = 8 * HTB, NXCD = 8, WGM = 8;

__host__ __device__ __forceinline__ int lds_byte(int r, int c) { const int st = (r >> 4) * 2 + (c >> 5), rr = r & 15, cc = c & 31, ob = rr * 64 + cc * 2; return st * 1024 + (ob ^ (((ob >> 9) & 1) << 5)); }
__host__ __device__ __forceinline__ void stage_rc(int b, int& R, int& C) { const int st = b / 1024, sb = b % 1024, swz = sb ^ (((sb >> 9) & 1) << 5); R = (st >> 1) * 16 + swz / 64; C = (st & 1) * 32 + (swz % 64) / 2; }
__host__ __device__ __forceinline__ int perm32(int rho) { const int n = rho >> 4, i = rho & 15; return 8 * (i >> 2) + 4 * n + (i & 3); }

struct Unit { int pm, pn; };
struct Gemm { const bf16_t* A; const bf16_t* Bt; int M, N, K; };

struct StaticOrder {
    int nM, nN, nwg, G, c;
    __host__ __device__ void init(int M, int N, int G_, int c_) { nM = M / BM; nN = N / BM; nwg = nM * nN; G = G_; c = c_; }
    __host__ __device__ bool next(int i, Unit& u) const {
        const long L = (long)i * G + c; if (L >= nwg) return false;
        int wgid = (int)L; { const int q = nwg / NXCD, r = nwg % NXCD, xcd = wgid % NXCD, off = wgid / NXCD; wgid = (xcd < r ? xcd * (q + 1) : r * (q + 1) + (xcd - r) * q) + off; }
        const int nig = WGM * nN, gid = wgid / nig, fm = gid * WGM, gsz = (nM - fm) < WGM ? (nM - fm) : WGM;
        u.pm = fm + ((wgid % nig) % gsz); u.pn = (wgid % nig) / gsz; return true;
    }
    __device__ __forceinline__ void a_ready(const Unit&) const {}
    __device__ __forceinline__ void done(const Unit&) const {}
};

__device__ __forceinline__ unsigned cvt_pk_bf16(float lo, float hi) { unsigned r; asm volatile("v_cvt_pk_bf16_f32 %0, %1, %2" : "=v"(r) : "v"(lo), "v"(hi)); return r; }
typedef float f32x2 __attribute__((ext_vector_type(2)));
__device__ __forceinline__ f32x2 gelu_pk(f32x2 v) {
    const f32x2 av = __builtin_elementwise_abs(v), d = av * 0.2316418882f + 1.0f;
    f32x2 t; t.x = __builtin_amdgcn_rcpf(d.x); t.y = __builtin_amdgcn_rcpf(d.y);
    f32x2 q = t * 0.5307027145f + (-0.7265760135f); q = q * t + 0.7107068705f; q = q * t + (-0.142248368f); q = q * t + 0.127414796f; q = q * t;
    const f32x2 s = (v * v) * (-0.72134752044f);
    f32x2 e; e.x = __builtin_amdgcn_exp2f(s.x); e.y = __builtin_amdgcn_exp2f(s.y);
    const f32x2 m = v * (q * e), r = v - m;
    f32x2 o; o.x = v.x < 0.f ? m.x : r.x; o.y = v.y < 0.f ? m.y : r.y; return o;
}

template <int ACT  > struct EpiBf16 {
    static constexpr bool PERM = true, AFTER_DRAIN = false; static_assert(ACT == 0 || ACT == 1, "EpiBf16: ACT is 0 (none) or 1 (gelu_pk)");
    bf16_t* O; int ldc; const float* bias; int split_cols; size_t split_stride; float scale0;
    __device__ __forceinline__ void operator()(const f32x4 (&acc)[2][2][4][2], const Unit& u, int wr, int wc, int fr, int fq) const {
        const int row0 = u.pm * BM + wr * 64 + fr; int colt = u.pn * BM; bf16_t* base = O;
        float sc = 1.f; if (split_cols) { const int t = colt / split_cols; base += (size_t)t * split_stride; colt -= t * split_cols; if (t == 0) sc = scale0; }
        const int col0 = colt + wc * 32 + 8 * fq, bcol0 = u.pn * BM + wc * 32 + 8 * fq;
        f32x4 bv[2][2];
#pragma unroll
        for (int bj = 0; bj < 2; ++bj)
#pragma unroll
            for (int n = 0; n < 2; ++n) bv[bj][n] = bias ? *(const f32x4*)(bias + bcol0 + bj * HALF + 4 * n) : (f32x4){0.f, 0.f, 0.f, 0.f};
#pragma unroll
        for (int ai = 0; ai < 2; ++ai)
#pragma unroll
            for (int m = 0; m < 4; ++m) { bf16_t* rowp = base + (size_t)(row0 + ai * HALF + m * 16) * ldc + col0;
#pragma unroll
                for (int bj = 0; bj < 2; ++bj) { f32x4 v0 = acc[ai][bj][m][0] + bv[bj][0], v1 = acc[ai][bj][m][1] + bv[bj][1];
                    if (ACT == 1) { f32x2 a = gelu_pk((f32x2){v0[0], v0[1]}), b = gelu_pk((f32x2){v0[2], v0[3]}), c = gelu_pk((f32x2){v1[0], v1[1]}), d = gelu_pk((f32x2){v1[2], v1[3]});
                        v0 = (f32x4){a.x, a.y, b.x, b.y}; v1 = (f32x4){c.x, c.y, d.x, d.y}; }
                    v0 = v0 * sc; v1 = v1 * sc; u32x4 w; w.x = cvt_pk_bf16(v0[0], v0[1]); w.y = cvt_pk_bf16(v0[2], v0[3]); w.z = cvt_pk_bf16(v1[0], v1[1]); w.w = cvt_pk_bf16(v1[2], v1[3]);
                    *(u32x4*)(rowp + bj * HALF) = w; } }
    }
};

struct EpiF32 {
    static constexpr bool PERM = false, AFTER_DRAIN = false;
    float* C; int ldc;
    __device__ __forceinline__ void operator()(const f32x4 (&acc)[2][2][4][2], const Unit& u, int wr, int wc, int fr, int fq) const {
        const int row0 = u.pm * BM + wr * 64 + fr, col0 = u.pn * BM + wc * 32 + 4 * fq;
#pragma unroll
        for (int ai = 0; ai < 2; ++ai)
#pragma unroll
            for (int m = 0; m < 4; ++m) { float* rowp = C + (size_t)(row0 + ai * HALF + m * 16) * ldc + col0;
#pragma unroll
                for (int bj = 0; bj < 2; ++bj)
#pragma unroll
                    for (int n = 0; n < 2; ++n) *(f32x4*)(rowp + bj * HALF + n * 16) = acc[ai][bj][m][n]; }
    }
};
struct EpiProj {
    static constexpr bool PERM = true, AFTER_DRAIN = false;
    bf16_t* O; int ldc; int ncols;
    __device__ __forceinline__ void operator()(const f32x4 (&acc)[2][2][4][2], const Unit& u, int wr, int wc, int fr, int fq) const {
        const int row0 = u.pm * BM + wr * 64 + fr; const int col0 = u.pn * BM + wc * 32 + 8 * fq;
#pragma unroll
        for (int ai = 0; ai < 2; ++ai)
#pragma unroll
            for (int m = 0; m < 4; ++m) { bf16_t* rowp = O + (size_t)(row0 + ai * HALF + m * 16) * ldc + col0;
#pragma unroll
                for (int bj = 0; bj < 2; ++bj) { const f32x4 v0 = acc[ai][bj][m][0], v1 = acc[ai][bj][m][1];
                    u32x4 w; w.x = cvt_pk_bf16(v0[0], v0[1]); w.y = cvt_pk_bf16(v0[2], v0[3]); w.z = cvt_pk_bf16(v1[0], v1[1]); w.w = cvt_pk_bf16(v1[2], v1[3]);
                    if (col0 + bj * HALF < ncols) *(u32x4*)(rowp + bj * HALF) = w; } }
    }
};
template <class Epi, class Sched, bool ALIGN_EPI = false, bool SP2 = false>
__device__ __forceinline__ void gemm_phase(PG8_LAS unsigned char* lds, const Gemm g, const Sched& S, const Epi& E) {
    const int tid = threadIdx.x, wid = __builtin_amdgcn_readfirstlane(tid >> 6), lane = tid & 63, wr = wid >> 2, wc = wid & 3, fr = lane & 15, fq = lane >> 4;
    const int K = g.K, nt = K / BK;
    unsigned voffA[2], voffB[2];
#pragma unroll
    for (int i = 0; i < 2; ++i) { int R, C; stage_rc(tid * 16 + i * 8192, R, C); const int Rb = Epi::PERM ? ((R & ~31) + perm32(R & 31)) : R;
        voffA[i] = (unsigned)(R * K + C) * 2u; voffB[i] = (unsigned)(Rb * K + C) * 2u; }
    const size_t kstep = (size_t)(BK * 2);
    const size_t hstep = (size_t)HALF * K * 2;
    const size_t tstep = 2 * hstep;
    const unsigned ldsw = (unsigned)wid * 1024u;
    const int aoff = lds_byte(wr * 64 + fr, fq * 8), boff = lds_byte(wc * 32 + fr, fq * 8);
#define PG8_SA(b, h) (((b) * 2 + (h)) * HTB)
#define PG8_SB(b, h) ((4 + (b) * 2 + (h)) * HTB)
#define PG8_STAGE(bufoff, gbase, voff) do { _Pragma("unroll") for (int _i = 0; _i < 2; ++_i) \
        __builtin_amdgcn_global_load_lds((const unsigned*)((const char*)(gbase) + (voff)[_i]), (PG8_LAS unsigned*)(lds + (bufoff) + ldsw + _i * 8192), 16, 0, 0); } while (0)
#define PG8_LDA(dst, b, h) do { _Pragma("unroll") for (int m = 0; m < 4; ++m) _Pragma("unroll") for (int k = 0; k < 2; ++k) dst[m][k] = *(const PG8_LAS bf16x8*)(lds + PG8_SA(b, h) + aoff + m * 2048 + k * 1024); } while (0)
#define PG8_LDB(dst, b, h) do { _Pragma("unroll") for (int n = 0; n < 2; ++n) _Pragma("unroll") for (int k = 0; k < 2; ++k) dst[n][k] = *(const PG8_LAS bf16x8*)(lds + PG8_SB(b, h) + boff + n * 2048 + k * 1024); } while (0)
#define PG8_MMA(ai, bj, At, Bt) do { __builtin_amdgcn_s_setprio(1); _Pragma("unroll") for (int m = 0; m < 4; ++m) _Pragma("unroll") for (int n = 0; n < 2; ++n) _Pragma("unroll") for (int k = 0; k < 2; ++k) \
        acc[ai][bj][m][n] = __builtin_amdgcn_mfma_f32_16x16x32_bf16(Bt[n][k], At[m][k], acc[ai][bj][m][n], 0, 0, 0); __builtin_amdgcn_s_setprio(0); } while (0)
#define PG8_WAIT_V(n) asm volatile("s_waitcnt vmcnt(" #n ")" ::: "memory")
#define PG8_WAIT_L(n) asm volatile("s_waitcnt lgkmcnt(" #n ")" ::: "memory")
#define PG8_BAR __builtin_amdgcn_s_barrier()
#define PG8_SCHED __builtin_amdgcn_sched_barrier(0)
    Unit cur, nxt; int ui = 0;
    if (!S.next(0, cur)) return;
    f32x4 acc[2][2][4][2];
#pragma unroll
    for (int a = 0; a < 2; ++a)
#pragma unroll
        for (int b = 0; b < 2; ++b)
#pragma unroll
            for (int m = 0; m < 4; ++m)
#pragma unroll
                for (int n = 0; n < 2; ++n) acc[a][b][m][n] = (f32x4){0.f, 0.f, 0.f, 0.f};
    bf16x8 At[4][2], B0[2][2], B1[2][2];
    const char* cA = (const char*)g.A + (size_t)cur.pm * tstep; const char* cB = (const char*)g.Bt + (size_t)cur.pn * tstep;
    S.a_ready(cur);
    if constexpr (SP2) {
        PG8_STAGE(PG8_SB(0, 0), cB, voffB); PG8_STAGE(PG8_SB(0, 1), cB + hstep, voffB); PG8_STAGE(PG8_SA(0, 0), cA, voffA); PG8_STAGE(PG8_SA(0, 1), cA + hstep, voffA);
        if (wr == 1) PG8_BAR;
        PG8_WAIT_V(2); PG8_BAR;
        PG8_STAGE(PG8_SB(1, 0), cB + kstep, voffB); PG8_STAGE(PG8_SA(1, 0), cA + kstep, voffA); PG8_STAGE(PG8_SB(1, 1), cB + hstep + kstep, voffB);
        PG8_WAIT_V(6); PG8_BAR;
    } else {
        PG8_STAGE(PG8_SB(0, 0), cB, voffB); PG8_STAGE(PG8_SA(0, 0), cA, voffA); PG8_STAGE(PG8_SB(0, 1), cB + hstep, voffB); PG8_STAGE(PG8_SA(0, 1), cA + hstep, voffA);
        if (wr == 1) PG8_BAR;
        PG8_WAIT_V(4); PG8_BAR;
        PG8_STAGE(PG8_SB(1, 0), cB + kstep, voffB); PG8_STAGE(PG8_SA(1, 0), cA + kstep, voffA); PG8_STAGE(PG8_SB(1, 1), cB + hstep + kstep, voffB);
        PG8_WAIT_V(6); PG8_BAR;
    }
    for (;;) {
        const bool has_next = S.next(ui + 1, nxt);
        const char* nA = has_next ? (const char*)g.A + (size_t)nxt.pm * tstep : cA; const char* nB = has_next ? (const char*)g.Bt + (size_t)nxt.pn * tstep : cB;
        for (int t = 0; t < nt; t += 2) {
            const bool last = (t == nt - 2);
            const char* a1 = cA + (size_t)(t + 1) * kstep;
            const char* a2 = last ? nA : cA + (size_t)(t + 2) * kstep; const char* b2 = last ? nB : cB + (size_t)(t + 2) * kstep;
            const char* a3 = a2 + kstep; const char* b3 = b2 + kstep;
            if (last && has_next) S.a_ready(nxt);
            if constexpr (SP2) {
            PG8_LDB(B0, 0, 0); PG8_LDB(B1, 0, 1); PG8_SCHED; PG8_LDA(At, 0, 0); PG8_STAGE(PG8_SA(1, 1), a1 + hstep, voffA);
            PG8_WAIT_V(8); PG8_WAIT_L(0); PG8_BAR; PG8_MMA(0, 0, At, B0); PG8_MMA(0, 1, At, B1); PG8_BAR; PG8_SCHED;
            PG8_LDA(At, 0, 1); PG8_STAGE(PG8_SB(0, 0), b2, voffB); PG8_STAGE(PG8_SB(0, 1), b2 + hstep, voffB); PG8_STAGE(PG8_SA(0, 0), a2, voffA);
            PG8_WAIT_V(8); PG8_WAIT_L(0); PG8_BAR; PG8_MMA(1, 0, At, B0); PG8_MMA(1, 1, At, B1); PG8_BAR; PG8_SCHED;
            PG8_LDB(B0, 1, 0); PG8_LDB(B1, 1, 1); PG8_SCHED; PG8_LDA(At, 1, 0); PG8_STAGE(PG8_SA(0, 1), a2 + hstep, voffA);
            PG8_WAIT_V(8); PG8_WAIT_L(0); PG8_BAR; PG8_MMA(0, 0, At, B0); PG8_MMA(0, 1, At, B1); PG8_BAR; PG8_SCHED;
            PG8_LDA(At, 1, 1); PG8_STAGE(PG8_SB(1, 0), b3, voffB); PG8_STAGE(PG8_SB(1, 1), b3 + hstep, voffB); PG8_STAGE(PG8_SA(1, 0), a3, voffA);
            PG8_WAIT_V(8); PG8_WAIT_L(0); PG8_BAR; PG8_MMA(1, 0, At, B0); PG8_MMA(1, 1, At, B1); PG8_BAR; PG8_SCHED;
            } else {
            PG8_LDB(B0, 0, 0); PG8_SCHED; PG8_LDA(At, 0, 0); PG8_STAGE(PG8_SA(1, 1), a1 + hstep, voffA);
            PG8_WAIT_L(8); PG8_BAR; PG8_WAIT_L(0); PG8_MMA(0, 0, At, B0); PG8_BAR; PG8_SCHED;
            PG8_LDB(B1, 0, 1); PG8_STAGE(PG8_SB(0, 0), b2, voffB);
            PG8_BAR; PG8_WAIT_L(0); PG8_MMA(0, 1, At, B1); PG8_BAR;
            PG8_LDA(At, 0, 1); PG8_STAGE(PG8_SA(0, 0), a2, voffA);
            PG8_BAR; PG8_WAIT_L(0); PG8_MMA(1, 0, At, B0); PG8_BAR; PG8_SCHED;
            PG8_STAGE(PG8_SB(0, 1), b2 + hstep, voffB);
            PG8_WAIT_V(6); PG8_BAR; PG8_MMA(1, 1, At, B1); PG8_BAR;
            PG8_LDB(B0, 1, 0); PG8_SCHED; PG8_LDA(At, 1, 0); PG8_STAGE(PG8_SA(0, 1), a2 + hstep, voffA);
            PG8_WAIT_L(8); PG8_BAR; PG8_WAIT_L(0); PG8_MMA(0, 0, At, B0); PG8_BAR; PG8_SCHED;
            PG8_LDB(B1, 1, 1); PG8_STAGE(PG8_SB(1, 0), b3, voffB);
            PG8_BAR; PG8_WAIT_L(0); PG8_MMA(0, 1, At, B1); PG8_BAR;
            PG8_LDA(At, 1, 1); PG8_STAGE(PG8_SA(1, 0), a3, voffA);
            PG8_BAR; PG8_WAIT_L(0); PG8_MMA(1, 0, At, B0); PG8_BAR; PG8_SCHED;
            PG8_STAGE(PG8_SB(1, 1), b3 + hstep, voffB);
            PG8_WAIT_V(6); PG8_BAR; PG8_MMA(1, 1, At, B1); PG8_BAR;
            }
        }
        if constexpr (ALIGN_EPI) { if (wr == 0) PG8_BAR; }
        if constexpr (!Epi::AFTER_DRAIN) { E(acc, cur, wr, wc, fr, fq); S.done(cur); }
        if (!has_next) break;
#pragma unroll
        for (int a = 0; a < 2; ++a)
#pragma unroll
            for (int b = 0; b < 2; ++b)
#pragma unroll
                for (int m = 0; m < 4; ++m)
#pragma unroll
                    for (int n = 0; n < 2; ++n) acc[a][b][m][n] = (f32x4){0.f, 0.f, 0.f, 0.f};
        cur = nxt; cA = nA; cB = nB; ++ui;
        if constexpr (ALIGN_EPI) { if (wr == 1) PG8_BAR; }
    }
    PG8_WAIT_V(0);
    if constexpr (!ALIGN_EPI) { if (wr == 0) PG8_BAR; }
    PG8_BAR;
    if constexpr (Epi::AFTER_DRAIN) { E.fused(acc, cur, wr, wc, fr, fq, lds, wid, lane); S.done(cur); }
#undef PG8_SA
#undef PG8_SB
#undef PG8_STAGE
#undef PG8_LDA
#undef PG8_LDB
#undef PG8_MMA
#undef PG8_WAIT_V
#undef PG8_WAIT_L
#undef PG8_BAR
#undef PG8_SCHED
}
}
#ifndef PG8_SP2
#define PG8_SP2 true
#endif
#ifndef PG8_ALIGN
#define PG8_ALIGN true
#endif
constexpr int NWAVES = 8;
constexpr int D = 1024, NB = 4, T = 4096, TC = 256;
constexpr int MX = NB * T, MC = NB * TC, MA = MX + MC;
constexpr int NPROJ = 3456, NPROJ_PAD = 3584;
constexpr int COL_XB = 0, COL_XG = 512, COL_XC = 1024, COL_R = 1536, COL_K = 2048, COL_V = 2560, COL_G = 3072, COL_LW = 3200, COL_LA = 3328;
constexpr int NMOD = 6 * D;
constexpr int NEXP = 16384, NSC = 2048;
constexpr float NORM_EPS = 1e-6f, LNX_EPS = 64e-5f;
#ifndef MK_N_LAUNCHES
#define MK_N_LAUNCHES 1
#endif
constexpr int NPH = 13;
constexpr size_t MiB = 1u << 20;
constexpr size_t WS_CTL = 0, CTL_ZERO_BYTES = 64 * 1024;
constexpr size_t WS_MOD = 3 * MiB;
constexpr size_t WS_ZS = 4 * MiB;
constexpr size_t WS_WINT = 6 * MiB;
constexpr size_t WS_WOUTT = 13 * MiB;
constexpr size_t WS_WEFFT = 15 * MiB;
constexpr size_t WS_GWT = 19 * MiB;
constexpr size_t WS_U = 20 * MiB, WS_V = 52 * MiB;
constexpr size_t WS_HX = 84 * MiB;
constexpr size_t WS_PROJ = 118 * MiB;
constexpr size_t WS_END = 246 * MiB;
constexpr size_t WS_EXL = WS_V, WS_GL = WS_V + 4 * MiB, WS_PL = WS_V + 12 * MiB;
constexpr size_t WS_BLOB0 = 36 * MiB, WS_BLOB1 = 77 * MiB;
constexpr size_t WS_PART = WS_PROJ, WS_PO = WS_PROJ + 64 * MiB;
static_assert(WS_PROJ + (size_t)MA * NPROJ * 2 <= WS_END && WS_PROJ + (size_t)MX * NSC * 4 <= WS_END && WS_HX + (size_t)MA * D * 2 <= WS_PROJ, "d_ws map");
constexpr int CW_BAR = 1024;
constexpr int RING_BYTES = 131072;
constexpr int LDSCTL_OFF = 155648, MISC_OFF = LDSCTL_OFF + 320;
constexpr int LDS_BYTES = 163840;

#define GAS __attribute__((address_space(1)))
#define LAS __attribute__((address_space(3)))
typedef unsigned short bf16;
typedef unsigned v4u __attribute__((ext_vector_type(4)));
typedef unsigned v2u __attribute__((ext_vector_type(2)));
typedef float f32x4 __attribute__((ext_vector_type(4)));
typedef float f32x2 __attribute__((ext_vector_type(2)));
typedef float f32x16 __attribute__((ext_vector_type(16)));
typedef short bf16x8 __attribute__((ext_vector_type(8)));
typedef GAS unsigned gu32;
#define RLX_AGENT __ATOMIC_RELAXED, __HIP_MEMORY_SCOPE_AGENT
#define LDS_WAIT() asm volatile("s_waitcnt lgkmcnt(0)" ::: "memory")
#define VM_WAIT() asm volatile("s_waitcnt vmcnt(0)" ::: "memory")
typedef __bf16 bf16v2 __attribute__((ext_vector_type(2)));
__device__ __forceinline__ unsigned pk2(float lo, float hi) { const f32x2 v = {lo, hi}; return __builtin_bit_cast(unsigned, __builtin_convertvector(v, bf16v2)); }
__device__ __forceinline__ float bf_lo(unsigned w) { return __builtin_bit_cast(float, w << 16); }
__device__ __forceinline__ float bf_hi(unsigned w) { return __builtin_bit_cast(float, w & 0xffff0000u); }
__device__ __forceinline__ float bf1(bf16 b) { return __builtin_bit_cast(float, (unsigned)b << 16); }
__device__ __forceinline__ float fast_exp(float x) { return __builtin_amdgcn_exp2f(x * 1.44269504089f); }
__device__ __forceinline__ float fast_rcp(float x) { return __builtin_amdgcn_rcpf(x); }
__device__ __forceinline__ float sigmoidf(float x) { return fast_rcp(1.f + fast_exp(-x)); }
__device__ __forceinline__ float tanh_fast(float x) { return 1.f - 2.f * fast_rcp(fast_exp(2.f * x) + 1.f); }
__device__ __forceinline__ float siluf(float x) { return x * sigmoidf(x); }
template <int CTRL> __device__ __forceinline__ float dppf(float x) { return __builtin_bit_cast(float, __builtin_amdgcn_update_dpp(0, __builtin_bit_cast(int, x), CTRL, 0xF, 0xF, false)); }
template <int CTRL> __device__ __forceinline__ unsigned dppu(unsigned x) { return (unsigned)__builtin_amdgcn_update_dpp(0, (int)x, CTRL, 0xF, 0xF, false); }
__device__ __forceinline__ float rowsum16(float x) { x += dppf<0xB1>(x); x += dppf<0x4E>(x); x += dppf<0x141>(x); x += dppf<0x140>(x); return x; }
__device__ __forceinline__ float wave_sum(float v) {
    v = rowsum16(v); v += __shfl_xor(v, 16); v += __shfl_xor(v, 32); return v;
}
__device__ __forceinline__ float half_sum32(float v) { v = rowsum16(v); v += __shfl_xor(v, 16); return v; }
__device__ __forceinline__ unsigned umaxu(unsigned a, unsigned b) { return a > b ? a : b; }
__device__ __forceinline__ unsigned wave_max_u32(unsigned x) {
    x = umaxu(x, dppu<0xB1>(x)); x = umaxu(x, dppu<0x4E>(x)); x = umaxu(x, dppu<0x141>(x)); x = umaxu(x, dppu<0x140>(x));
    const unsigned a = __builtin_amdgcn_readlane((int)x, 0), b = __builtin_amdgcn_readlane((int)x, 16), c = __builtin_amdgcn_readlane((int)x, 32), d = __builtin_amdgcn_readlane((int)x, 48);
    return umaxu(umaxu(a, b), umaxu(c, d));
}
__device__ __forceinline__ unsigned f2key(float f) { const unsigned u = __builtin_bit_cast(unsigned, f); return (u & 0x80000000u) ? ~u : (u | 0x80000000u); }
__device__ __forceinline__ float key2f(unsigned k) { const unsigned u = (k & 0x80000000u) ? (k ^ 0x80000000u) : ~k; return __builtin_bit_cast(float, u); }
#define XB_TMO      128
#define XB_XCNT(j)  (256  + 64 * (j))
#define XB_XSUB(j)  (1280 + 64 * (j))
#define XB_XGEN(j)  (2304 + 64 * (j))
#define XB_TOP      3328
#define XB_TOPGEN   3392
#define XCD_BAR_WORDS 3456
#define XB_SPIN_CAP (1u << 18)

__device__ __forceinline__ unsigned xb_ld(unsigned* p)              { return __hip_atomic_load(p, __ATOMIC_RELAXED, __HIP_MEMORY_SCOPE_AGENT); }
__device__ __forceinline__ unsigned xb_add(unsigned* p, unsigned v) { return __hip_atomic_fetch_add(p, v, __ATOMIC_RELAXED, __HIP_MEMORY_SCOPE_AGENT); }
__device__ __forceinline__ unsigned xb_xcc_id() { return (unsigned)__builtin_amdgcn_s_getreg((3 << 11) | 20) & 0xFu; }
#define XB_SPIN(cond, bar) do { unsigned _sp = 0; while (cond) { __builtin_amdgcn_s_sleep(1); \
    if ((++_sp & 255u) == 0u) { if (xb_ld(&(bar)[XB_TMO])) break; if (_sp > XB_SPIN_CAP) { atomicAdd(&(bar)[XB_TMO], 1u); break; } } } } while (0)

struct XcdBarrier {
    unsigned* bar; unsigned x;
    volatile LAS unsigned* st;
};

__device__ __forceinline__ XcdBarrier xcd_barrier_post(unsigned* bar, volatile LAS unsigned* st) {
    XcdBarrier b; b.bar = bar; b.x = xb_xcc_id(); b.st = st;
    if (threadIdx.x == 0) (void)xb_add(&bar[XB_XCNT(b.x)], 1u);
    return b;
}
__device__ __forceinline__ void xcd_barrier_complete(unsigned* bar, unsigned x, unsigned& nloc, unsigned& nx) {
    const unsigned G = gridDim.x * gridDim.y * gridDim.z;
    unsigned sum, cnt, mine, sp = 0u;
    for (;;) {
        sum = 0u; cnt = 0u; mine = 0u;
#pragma unroll
        for (unsigned j = 0; j < 16; ++j) { const unsigned c = xb_ld(&bar[XB_XCNT(j)]); sum += c; cnt += (c > 0u) ? 1u : 0u; mine = (j == x) ? c : mine; }
        if (sum == G) break;
        __builtin_amdgcn_s_sleep(1);
        if ((++sp & 255u) == 0u) { if (xb_ld(&bar[XB_TMO])) break; if (sp > XB_SPIN_CAP) { atomicAdd(&bar[XB_TMO], 1u); break; } }
    }
    nloc = mine > 0u ? mine : 1u; nx = cnt > 0u ? cnt : 1u;
}

__device__ __forceinline__ void xcd_barrier(const XcdBarrier& b) {
    asm volatile("s_waitcnt vmcnt(0)" ::: "memory");
    __syncthreads();
    if (threadIdx.x == 0) {
        unsigned* bar = b.bar;
        __builtin_amdgcn_s_waitcnt(0);
        unsigned nloc = b.st[0], nx = b.st[1];
        if (nloc == 0u) { xcd_barrier_complete(bar, b.x, nloc, nx); b.st[0] = nloc; b.st[1] = nx; }
        const unsigned old = xb_add(&bar[XB_XSUB(b.x)], 1u);
        const unsigned gen = old / nloc;
        if (old + 1u == (gen + 1u) * nloc) {
            __builtin_amdgcn_fence(__ATOMIC_RELEASE, "agent");
            asm volatile("s_waitcnt vmcnt(0)" ::: "memory");
            const unsigned og = xb_add(&bar[XB_TOP], 1u);
            const unsigned tg = og / nx;
            if (og + 1u == (tg + 1u) * nx) xb_add(&bar[XB_TOPGEN], 1u);
            else XB_SPIN(xb_ld(&bar[XB_TOPGEN]) == tg, bar);
            __builtin_amdgcn_fence(__ATOMIC_ACQUIRE, "agent");
            xb_add(&bar[XB_XGEN(b.x)], 1u);
            asm volatile("s_waitcnt vmcnt(0)" ::: "memory");
        } else {
            XB_SPIN(xb_ld(&bar[XB_XGEN(b.x)]) == gen, bar);
            __builtin_amdgcn_fence(__ATOMIC_ACQUIRE, "agent");
            asm volatile("s_waitcnt vmcnt(0)" ::: "memory");
        }
    }
    __syncthreads();
}
struct Frame {
    LAS unsigned char* lds;
    volatile LAS unsigned* MISC;
    gu32* ctl;
    int tid, lane, wave, G, bid;
    const float* in[25];
    float* out;
    unsigned char* ws;
};
enum { I_X = 0, I_C, I_CTX, I_CCTX, I_WMOD, I_BMOD, I_NG, I_WIN, I_WOUT, I_CONVW, I_TMU, I_DW0, I_DW2, I_A0, I_A2, I_GW2, I_KK, I_KA, I_RK, I_LNG, I_LNB, I_WQ, I_SUBK, I_PU, I_PV };

__device__ __forceinline__ void p0_transpose_item(const float* W, int K, int N, bf16* WT, LAS float* scr, int item, int lane) {
    const int nblk = N / 32, kb = item / nblk, nb = item % nblk, k0 = 64 * kb, n0 = 32 * nb;
#pragma unroll 8
    for (int i = 0; i < 32; ++i) { const int kk = 2 * i + (lane >> 5); scr[kk * 33 + (lane & 31)] = W[(size_t)(k0 + kk) * N + n0 + (lane & 31)]; }
    LDS_WAIT(); asm volatile("" ::: "memory");
    const int c = lane & 7;
#pragma unroll
    for (int j = 0; j < 4; ++j) { const int n = (lane >> 3) + 8 * j; const LAS float* s = scr + (8 * c) * 33 + n;
        v4u o; o.x = pk2(s[0 * 33], s[1 * 33]); o.y = pk2(s[2 * 33], s[3 * 33]); o.z = pk2(s[4 * 33], s[5 * 33]); o.w = pk2(s[6 * 33], s[7 * 33]);
        *(v4u*)(WT + (size_t)(n0 + n) * K + k0 + 8 * c) = o; }
    LDS_WAIT(); asm volatile("" ::: "memory");
}
__device__ __forceinline__ void p0_mod_item(Frame& F, int cb) {
    LAS float* S = (LAS float*)F.lds;
    LAS float* RED = (LAS float*)(F.lds + 32768);
    const float* c = F.in[I_C]; const float* cc = F.in[I_CCTX];
    for (int i = F.tid; i < 5 * D; i += 512) { const int r = i >> 10, k = i & 1023; const float v = (r < 4) ? c[r * D + k] : cc[k]; S[i] = siluf(v); }
    __syncthreads();
    const int col = F.tid & 63, kg = F.tid >> 6;
    const float* wp = F.in[I_WMOD] + (size_t)(kg * 128) * NMOD + cb * 64 + col;
    float a0 = 0.f, a1 = 0.f, a2 = 0.f, a3 = 0.f, a4 = 0.f;
#pragma unroll 8
    for (int k = 0; k < 128; ++k) { const float w = wp[(size_t)k * NMOD]; const int kk = kg * 128 + k;
        a0 += S[kk] * w; a1 += S[D + kk] * w; a2 += S[2 * D + kk] * w; a3 += S[3 * D + kk] * w; a4 += S[4 * D + kk] * w; }
    RED[(kg * 5 + 0) * 64 + col] = a0; RED[(kg * 5 + 1) * 64 + col] = a1; RED[(kg * 5 + 2) * 64 + col] = a2; RED[(kg * 5 + 3) * 64 + col] = a3; RED[(kg * 5 + 4) * 64 + col] = a4;
    __syncthreads();
    if (F.tid < 320) { const int r = F.tid >> 6, cl = F.tid & 63; float s = F.in[I_BMOD][cb * 64 + cl];
#pragma unroll
        for (int g = 0; g < 8; ++g) s += RED[(g * 5 + r) * 64 + cl];
        ((float*)(F.ws + WS_MOD))[r * NMOD + cb * 64 + cl] = s; }
    __syncthreads();
}
__device__ __forceinline__ void p0_weff_item(Frame& F, int item) {
    const int hs = item >> 4, kb = item & 15;
    LAS float* SK = (LAS float*)F.lds;
    LAS float* WQ = (LAS float*)(F.lds + 128 * 132 * 4);
    const float* sk = F.in[I_SUBK] + (size_t)hs * 128 * 128;
    const float* wq = F.in[I_WQ] + (size_t)(kb * 64) * 2048 + hs * 128;
#pragma unroll
    for (int i = 0; i < 8; ++i) { const int idx = F.tid + 512 * i, row = idx >> 5, c4 = idx & 31; const f32x4 v = *(const f32x4*)(sk + row * 128 + c4 * 4); *(LAS f32x4*)(SK + row * 132 + c4 * 4) = v; }
#pragma unroll
    for (int i = 0; i < 4; ++i) { const int idx = F.tid + 512 * i, row = idx >> 5, c4 = idx & 31; const f32x4 v = *(const f32x4*)(wq + (size_t)row * 2048 + c4 * 4); *(LAS f32x4*)(WQ + row * 132 + c4 * 4) = v; }
    __syncthreads();
    const int key = F.tid >> 2, kq = F.tid & 3;
    float acc[16];
#pragma unroll
    for (int i = 0; i < 16; ++i) acc[i] = 0.f;
    for (int d = 0; d < 128; d += 4) {
        const f32x4 a = *(const LAS f32x4*)(SK + key * 132 + d);
#pragma unroll
        for (int i = 0; i < 16; ++i) { const f32x4 b = *(const LAS f32x4*)(WQ + (4 * i + kq) * 132 + d); acc[i] += a.x * b.x + a.y * b.y + a.z * b.z + a.w * b.w; }
    }
    bf16* dst = (bf16*)(F.ws + WS_WEFFT) + (size_t)(hs * 128 + key) * D + kb * 64;
#pragma unroll
    for (int i = 0; i < 16; ++i) dst[4 * i + kq] = (bf16)(pk2(acc[i], 0.f) & 0xffffu);
    __syncthreads();
}
__device__ __forceinline__ void p0_prep(Frame& F) {
    for (int it = F.bid; it < 96 + 256; it += F.G) { if (it < 96) p0_mod_item(F, it); else p0_weff_item(F, it - 96); }
    LAS float* scr = (LAS float*)(F.lds + F.wave * 16384);
    const int gw = F.bid * NWAVES + F.wave, NGW = F.G * NWAVES;
    constexpr int I_IN = (D / 64) * (NPROJ / 32), I_OUT = (D / 64) * (D / 32), I_GW = (128 / 64) * (512 / 32);
    for (int it = gw; it < I_IN + I_OUT + I_GW; it += NGW) {
        if (it < I_IN) p0_transpose_item(F.in[I_WIN], D, NPROJ, (bf16*)(F.ws + WS_WINT), scr, it, F.lane);
        else if (it < I_IN + I_OUT) p0_transpose_item(F.in[I_WOUT], D, D, (bf16*)(F.ws + WS_WOUTT), scr, it - I_IN, F.lane);
        else p0_transpose_item(F.in[I_GW2], 128, 512, (bf16*)(F.ws + WS_GWT), scr, it - I_IN - I_OUT, F.lane);
    }
    { v4u* z = (v4u*)((bf16*)(F.ws + WS_WINT) + (size_t)NPROJ * D); const int n16 = (NPROJ_PAD - NPROJ) * D * 2 / 16;
      for (int i = F.bid * 512 + F.tid; i < n16; i += F.G * 512) z[i] = (v4u){0u, 0u, 0u, 0u}; }
    { const f32x4* pu = (const f32x4*)F.in[I_PU]; v2u* du = (v2u*)(F.ws + WS_U);
      const int n8 = NEXP * D / 8;
      for (int i = F.bid * 512 + F.tid; i < n8; i += F.G * 512) {
          const f32x4 a0 = pu[2 * i] * 32.f, a1 = pu[2 * i + 1] * 32.f;
          int w0 = __builtin_amdgcn_cvt_pk_fp8_f32(a0.x, a0.y, 0, false); w0 = __builtin_amdgcn_cvt_pk_fp8_f32(a0.z, a0.w, w0, true);
          int w1 = __builtin_amdgcn_cvt_pk_fp8_f32(a1.x, a1.y, 0, false); w1 = __builtin_amdgcn_cvt_pk_fp8_f32(a1.z, a1.w, w1, true);
          du[i] = (v2u){(unsigned)w0, (unsigned)w1}; } }
}

__device__ __forceinline__ void p1_hx(Frame& F) {
    const float* mod = (const float*)(F.ws + WS_MOD); const float* ng = F.in[I_NG];
    bf16* hx = (bf16*)(F.ws + WS_HX);
    for (int m = F.bid * NWAVES + F.wave; m < MA; m += F.G * NWAVES) {
        const float* src = (m < MX) ? F.in[I_X] + (size_t)m * D : F.in[I_CTX] + (size_t)(m - MX) * D;
        const float* mr = mod + ((m < MX) ? (m >> 12) : 4) * NMOD;
        f32x4 v[4]; float ss = 0.f;
#pragma unroll
        for (int j = 0; j < 4; ++j) { v[j] = *(const f32x4*)(src + j * 256 + F.lane * 4); ss += v[j].x * v[j].x + v[j].y * v[j].y + v[j].z * v[j].z + v[j].w * v[j].w; }
        const float rstd = __builtin_amdgcn_rsqf(wave_sum(ss) * (1.f / D) + NORM_EPS);
#pragma unroll
        for (int j = 0; j < 4; ++j) { const int c = j * 256 + F.lane * 4;
            const f32x4 g = *(const f32x4*)(ng + c), sh = *(const f32x4*)(mr + c), sc = *(const f32x4*)(mr + D + c);
            const float o0 = v[j].x * rstd * g.x * (1.f + sc.x) + sh.x, o1 = v[j].y * rstd * g.y * (1.f + sc.y) + sh.y, o2 = v[j].z * rstd * g.z * (1.f + sc.z) + sh.z, o3 = v[j].w * rstd * g.w * (1.f + sc.w) + sh.w;
            *(v2u*)(hx + (size_t)m * D + c) = (v2u){pk2(o0, o1), pk2(o2, o3)}; }
    }
}
constexpr int BL_APT = 0, BL_NPT = 4608, BL_RH = 7168, BL_MKR = 11776, BL_MBR = 14336, BL_KGC = 16896, BL_BGC = 22016, BL_GC = 27136, BL_VT = 27648, BL_BYTES = 32768;
constexpr int HSZ = 66048;
constexpr int CS_RAW = 0, CS_TLW = 13056, CS_LOA = 17664, CS_LG = 22272, CS_NBA = 32768, CS_AH = 38912, CS_BH = 43520, CS_KH = 48128, CS_AHC = 52736, CS_E = 57856, CS_NKA = 57856, CS_TT = 60416;
constexpr int CS_CONST = 2 * HSZ, CS_W2T = CS_CONST + 2560, CS_A2T = CS_W2T + 9216, CS_END = CS_A2T + 9216;
static_assert(CS_END <= LDSCTL_OFF, "scan prep LDS map");
constexpr int CS_RH = BL_RH, CS_KGC = BL_KGC, CS_BGC = BL_BGC, CS_VT = BL_VT, CS_GC = BL_GC, CS_APT = BL_APT, CS_NPT = BL_NPT, CS_MKR = BL_MKR, CS_MBR = BL_MBR;
constexpr int SC_NTILE = (TC + T) / 32, SC_RT = 19, SC_NROUND = (SC_NTILE + SC_RT - 1) / SC_RT;
constexpr int SC_ST = 1;
constexpr int GS_YS = 65536;
__device__ __forceinline__ void scan_issue_loads(const bf16* proj, int b, int h, int d, int tile, int tid, v4u (&rg)[3]) {
    const bool isctx = tile < TC / 32; const int L = isctx ? TC : T; const int jt = isctx ? tile : tile - TC / 32;
    const size_t rowbase = isctx ? (size_t)(MX + b * TC) : (size_t)b * T;
    const int tlo = d == 0 ? 32 * jt : L - 32 * (jt + 1);
#pragma unroll
    for (int i = 0; i < 3; ++i) {
        const int q = tid + 512 * i;
        const int row = q / 24, rem = q - row * 24; int tok = tlo - 1 + row; tok = tok < 0 ? 0 : (tok >= L ? L - 1 : tok);
        const int q2 = (q - 816) & 511, row2 = q2 >> 4, rem2 = q2 & 15;
        const size_t offA = (rowbase + tok) * NPROJ + COL_R + (rem >> 3) * 512 + h * 64 + (rem & 7) * 8;
        const size_t offB = (rowbase + tlo + row2) * NPROJ + ((rem2 >> 3) ? COL_LA : COL_LW) + d * 64 + (rem2 & 7) * 8;
        rg[i] = *(const v4u*)(proj + (q < 816 ? offA : offB));
    }
}
__device__ __forceinline__ unsigned tanh_pk(unsigned w) { return pk2(tanh_fast(bf_lo(w)), tanh_fast(bf_hi(w))); }
__device__ __forceinline__ void scan_store_raw(LAS unsigned char* lds, int tid, int d, int tile, const v4u (&rg)[3]) {
    const bool isctx = tile < TC / 32; const int L = isctx ? TC : T; const int jt = isctx ? tile : tile - TC / 32;
    const int tlo = d == 0 ? 32 * jt : L - 32 * (jt + 1);
#pragma unroll
    for (int i = 0; i < 3; ++i) {
        const int q = tid + 512 * i;
        if (q < 816) { const int row = q / 24, rem = q - row * 24, which = rem >> 3, ch8 = rem & 7; const int tok = tlo - 1 + row;
            *(LAS v4u*)(lds + CS_RAW + (which * 34 + row) * 128 + ch8 * 16) = (tok >= 0 && tok < L) ? rg[i] : (v4u){0u, 0u, 0u, 0u}; }
        else if (q < 1328) { const int q2 = q - 816, row = q2 >> 4, rem = q2 & 15, which = rem >> 3, ch8 = rem & 7;
            if (which) *(LAS v4u*)(lds + CS_LOA + row * 144 + ch8 * 16) = rg[i];
            else { v4u t; t.x = tanh_pk(rg[i].x); t.y = tanh_pk(rg[i].y); t.z = tanh_pk(rg[i].z); t.w = tanh_pk(rg[i].w); *(LAS v4u*)(lds + CS_TLW + row * 144 + ch8 * 16) = t; } }
    }
}
__device__ __forceinline__ v2u pack4(f32x4 v) { return (v2u){pk2(v.x, v.y), pk2(v.z, v.w)}; }
__device__ __forceinline__ bf16 bfs(float v) { return (bf16)(pk2(v, 0.f) & 0xffffu); }
typedef v2u v2u_t;
__device__ __forceinline__ bf16x8 frag2(const LAS unsigned char* p0, const LAS unsigned char* p1) {
    const v2u a = *(const LAS v2u*)p0, b = *(const LAS v2u*)p1; const v4u w = (v4u){a.x, a.y, b.x, b.y}; return __builtin_bit_cast(bf16x8, w);
}
__device__ __forceinline__ bf16x8 frag_acc(f32x4 lo, f32x4 hi) { const v4u w = (v4u){pk2(lo.x, lo.y), pk2(lo.z, lo.w), pk2(hi.x, hi.y), pk2(hi.z, hi.w)}; return __builtin_bit_cast(bf16x8, w); }
__device__ __forceinline__ bf16x8 frag_zero() { const v4u w = (v4u){0u, 0u, 0u, 0u}; return __builtin_bit_cast(bf16x8, w); }
__device__ __forceinline__ void scan_prep_pair(Frame& F, const bf16* proj, int chain, int tile0, bool two, bool load_consts, bool have_next, int ntile0, bool ntwo, v4u (&rg)[6], unsigned char* blob0) {
    LAS unsigned char* lds = F.lds; int tid = F.tid; asm volatile("" : "+v"(tid));
    const int lane = tid & 63, wave = F.wave, wl = wave & 3, ts = wave >> 2;
    const int b = chain >> 4, h = (chain >> 1) & 7, d = chain & 1;
    const bool act = ts == 0 || two;
    if (load_consts) {
        __syncthreads();
        LAS float* C = (LAS float*)(lds + CS_CONST);
        if (tid < 384) { const int pn = tid / 192, r = tid - pn * 192, which = r >> 6, c = r & 63; C[pn * 192 + which * 64 + c] = F.in[I_TMU][(pn * 3 + which) * 512 + h * 64 + c]; }
        else if (tid < 448) { const int c = tid - 384; C[384 + c] = F.in[I_KK][h * 64 + c]; C[448 + c] = F.in[I_KA][h * 64 + c]; }
        else { const int c = tid - 448; C[512 + c] = F.in[I_DW0][d * 512 + h * 64 + c]; C[576 + c] = F.in[I_A0][d * 512 + h * 64 + c]; }
        const float* w2 = F.in[I_DW2] + (size_t)d * 64 * 512 + h * 64; const float* a2 = F.in[I_A2] + (size_t)d * 64 * 512 + h * 64;
#pragma unroll
        for (int i = 0; i < 8; ++i) { const int idx = tid + 512 * i, j = idx >> 6, c = idx & 63;
            *(LAS bf16*)(lds + CS_W2T + c * 144 + j * 2) = bfs(w2[j * 512 + c]);
            *(LAS bf16*)(lds + CS_A2T + c * 144 + j * 2) = bfs(a2[j * 512 + c]); }
    }
    { const v4u r0[3] = {rg[0], rg[1], rg[2]}; scan_store_raw(lds, tid, d, tile0, r0); }
    if (two) { const v4u r1[3] = {rg[3], rg[4], rg[5]}; scan_store_raw(lds + HSZ, tid, d, tile0 + 1, r1); }
    __syncthreads();
    { LAS unsigned char* hl = lds + ts * HSZ;
            if (act) {
                const int mat = wl >> 1, nt = wl & 1, r = lane & 31, hh = lane >> 5;
                const LAS unsigned char* Ab = hl + (mat ? CS_LOA : CS_TLW) + r * 144 + hh * 16;
                const LAS unsigned char* Bb = lds + (mat ? CS_A2T : CS_W2T) + (nt * 32 + r) * 144 + hh * 16;
                f32x16 acc;
#pragma unroll
                for (int i = 0; i < 16; ++i) acc[i] = 0.f;
#pragma unroll
                for (int ks = 0; ks < 4; ++ks) { const bf16x8 a = *(const LAS bf16x8*)(Ab + ks * 32), bb = *(const LAS bf16x8*)(Bb + ks * 32); acc = __builtin_amdgcn_mfma_f32_32x32x16_bf16(a, bb, acc, 0, 0, 0); }
                LAS float* LG = (LAS float*)(hl + CS_LG) + mat * 2048 + nt * 32 + r;
#pragma unroll
                for (int i = 0; i < 16; ++i) LG[((i & 3) + 8 * (i >> 2) + 4 * hh) * 64] = acc[i];
            }
    }
    __syncthreads();
    const int tok = tid >> 4, cq = tid & 15, c0 = cq * 4, s = d == 0 ? tok : 31 - tok;
    f32x4 rs, vs, kd, kk, kka, ev;
    { LAS unsigned char* hl = lds;
            { const LAS float* C = (const LAS float*)(lds + CS_CONST);
              f32x4 xs[3];
#pragma unroll
              for (int which = 0; which < 3; ++which) {
                  const LAS unsigned char* rp = hl + CS_RAW + (which * 34 + tok) * 128 + c0 * 2;
                  const v2u p = *(const LAS v2u*)rp, x = *(const LAS v2u*)(rp + 128), n = *(const LAS v2u*)(rp + 256);
                  const f32x4 mp = *(const LAS f32x4*)(C + which * 64 + c0), mn = *(const LAS f32x4*)(C + 192 + which * 64 + c0);
                  const f32x4 xp = (f32x4){bf_lo(p.x), bf_hi(p.x), bf_lo(p.y), bf_hi(p.y)}, xc = (f32x4){bf_lo(x.x), bf_hi(x.x), bf_lo(x.y), bf_hi(x.y)}, xn = (f32x4){bf_lo(n.x), bf_hi(n.x), bf_lo(n.y), bf_hi(n.y)};
                  xs[which] = xc + mp * (xp - xc) + mn * (xn - xc); }
              const f32x4 kkc = *(const LAS f32x4*)(C + 384 + c0), kac = *(const LAS f32x4*)(C + 448 + c0), w0 = *(const LAS f32x4*)(C + 512 + c0), a0 = *(const LAS f32x4*)(C + 576 + c0);
              kk = xs[1] * kkc;
              const float ss = rowsum16(kk.x * kk.x + kk.y * kk.y + kk.z * kk.z + kk.w * kk.w);
              kk = kk * __builtin_amdgcn_rsqf(ss + 1e-12f);
              const f32x4 uw = *(const LAS f32x4*)(hl + CS_LG + (tok * 64 + c0) * 4) + w0, ua = *(const LAS f32x4*)(hl + CS_LG + 8192 + (tok * 64 + c0) * 4) + a0;
              f32x4 av;
#pragma unroll
              for (int e = 0; e < 4; ++e) { ev[e] = 0.60653066f * sigmoidf(uw[e]); av[e] = sigmoidf(ua[e]); }
              kd = xs[1] * (1.f + (av - 1.f) * kac); kka = kk * av; rs = xs[0]; vs = xs[2];
              *(LAS f32x4*)(hl + CS_E + (s * 64 + c0) * 4) = ev; }
    }
    __syncthreads();
    { LAS unsigned char* hl = lds;
            { const int cb = s & 16, sl = s & 15;
              f32x4 cum = (f32x4){0.f, 0.f, 0.f, 0.f}, tot = cum;
#pragma unroll
              for (int ii = 0; ii < 16; ++ii) { const f32x4 e4 = *(const LAS f32x4*)(hl + CS_E + ((cb + ii) * 64 + c0) * 4); tot = tot + e4; if (ii <= sl) cum = cum + e4; }
              f32x4 g, gm1, gi, ge, gt;
#pragma unroll
              for (int e = 0; e < 4; ++e) { g[e] = fast_exp(-cum[e]); gm1[e] = fast_exp(ev[e] - cum[e]); gi[e] = fast_exp(cum[e]); ge[e] = fast_exp(cum[e] - tot[e]); gt[e] = fast_exp(-tot[e]); }
              const f32x4 ah = gm1 * kk, bh = kka * gi, kh = kd * gi, rh = g * rs, kg = kd * ge, bg = kka * ge;
              *(LAS v2u*)(hl + CS_AH + s * 144 + c0 * 2) = pack4(ah); *(LAS v2u*)(hl + CS_BH + s * 144 + c0 * 2) = pack4(bh);
              *(LAS v2u*)(hl + CS_KH + s * 144 + c0 * 2) = pack4(kh); *(LAS v2u*)(hl + CS_RH + s * 144 + c0 * 2) = pack4(rh);
#pragma unroll
              for (int e = 0; e < 4; ++e) { *(LAS bf16*)(hl + CS_AHC + (c0 + e) * 80 + s * 2) = bfs(ah[e]); *(LAS bf16*)(hl + CS_KGC + (c0 + e) * 80 + s * 2) = bfs(kg[e]); *(LAS bf16*)(hl + CS_BGC + (c0 + e) * 80 + s * 2) = bfs(-bg[e]); }
#pragma unroll
              for (int e = 0; e < 4; ++e) *(LAS bf16*)(hl + CS_VT + (c0 + e) * 80 + s * 2) = bfs(vs[e]);
              if (sl == 15) *(LAS f32x4*)(hl + CS_GC + ((s >> 4) * 64 + c0) * 4) = gt; }
    }
    __builtin_amdgcn_sched_barrier(0);
    if (two) {
        LAS unsigned char* hl = lds + HSZ;
            { const LAS float* C = (const LAS float*)(lds + CS_CONST);
              f32x4 xs[3];
#pragma unroll
              for (int which = 0; which < 3; ++which) {
                  const LAS unsigned char* rp = hl + CS_RAW + (which * 34 + tok) * 128 + c0 * 2;
                  const v2u p = *(const LAS v2u*)rp, x = *(const LAS v2u*)(rp + 128), n = *(const LAS v2u*)(rp + 256);
                  const f32x4 mp = *(const LAS f32x4*)(C + which * 64 + c0), mn = *(const LAS f32x4*)(C + 192 + which * 64 + c0);
                  const f32x4 xp = (f32x4){bf_lo(p.x), bf_hi(p.x), bf_lo(p.y), bf_hi(p.y)}, xc = (f32x4){bf_lo(x.x), bf_hi(x.x), bf_lo(x.y), bf_hi(x.y)}, xn = (f32x4){bf_lo(n.x), bf_hi(n.x), bf_lo(n.y), bf_hi(n.y)};
                  xs[which] = xc + mp * (xp - xc) + mn * (xn - xc); }
              const f32x4 kkc = *(const LAS f32x4*)(C + 384 + c0), kac = *(const LAS f32x4*)(C + 448 + c0), w0 = *(const LAS f32x4*)(C + 512 + c0), a0 = *(const LAS f32x4*)(C + 576 + c0);
              kk = xs[1] * kkc;
              const float ss = rowsum16(kk.x * kk.x + kk.y * kk.y + kk.z * kk.z + kk.w * kk.w);
              kk = kk * __builtin_amdgcn_rsqf(ss + 1e-12f);
              const f32x4 uw = *(const LAS f32x4*)(hl + CS_LG + (tok * 64 + c0) * 4) + w0, ua = *(const LAS f32x4*)(hl + CS_LG + 8192 + (tok * 64 + c0) * 4) + a0;
              f32x4 av;
#pragma unroll
              for (int e = 0; e < 4; ++e) { ev[e] = 0.60653066f * sigmoidf(uw[e]); av[e] = sigmoidf(ua[e]); }
              kd = xs[1] * (1.f + (av - 1.f) * kac); kka = kk * av; rs = xs[0]; vs = xs[2];
              *(LAS f32x4*)(hl + CS_E + (s * 64 + c0) * 4) = ev; }
    }
    __syncthreads();
    if (two) {
        LAS unsigned char* hl = lds + HSZ;
            { const int cb = s & 16, sl = s & 15;
              f32x4 cum = (f32x4){0.f, 0.f, 0.f, 0.f}, tot = cum;
#pragma unroll
              for (int ii = 0; ii < 16; ++ii) { const f32x4 e4 = *(const LAS f32x4*)(hl + CS_E + ((cb + ii) * 64 + c0) * 4); tot = tot + e4; if (ii <= sl) cum = cum + e4; }
              f32x4 g, gm1, gi, ge, gt;
#pragma unroll
              for (int e = 0; e < 4; ++e) { g[e] = fast_exp(-cum[e]); gm1[e] = fast_exp(ev[e] - cum[e]); gi[e] = fast_exp(cum[e]); ge[e] = fast_exp(cum[e] - tot[e]); gt[e] = fast_exp(-tot[e]); }
              const f32x4 ah = gm1 * kk, bh = kka * gi, kh = kd * gi, rh = g * rs, kg = kd * ge, bg = kka * ge;
              *(LAS v2u*)(hl + CS_AH + s * 144 + c0 * 2) = pack4(ah); *(LAS v2u*)(hl + CS_BH + s * 144 + c0 * 2) = pack4(bh);
              *(LAS v2u*)(hl + CS_KH + s * 144 + c0 * 2) = pack4(kh); *(LAS v2u*)(hl + CS_RH + s * 144 + c0 * 2) = pack4(rh);
#pragma unroll
              for (int e = 0; e < 4; ++e) { *(LAS bf16*)(hl + CS_AHC + (c0 + e) * 80 + s * 2) = bfs(ah[e]); *(LAS bf16*)(hl + CS_KGC + (c0 + e) * 80 + s * 2) = bfs(kg[e]); *(LAS bf16*)(hl + CS_BGC + (c0 + e) * 80 + s * 2) = bfs(-bg[e]); }
#pragma unroll
              for (int e = 0; e < 4; ++e) *(LAS bf16*)(hl + CS_VT + (c0 + e) * 80 + s * 2) = bfs(vs[e]);
              if (sl == 15) *(LAS f32x4*)(hl + CS_GC + ((s >> 4) * 64 + c0) * 4) = gt; }
    }
    __syncthreads();
    if (have_next) { v4u n0[3]; scan_issue_loads(proj, b, h, d, ntile0, tid, n0); rg[0] = n0[0]; rg[1] = n0[1]; rg[2] = n0[2];
        if (ntwo) { v4u n1[3]; scan_issue_loads(proj, b, h, d, ntile0 + 1, tid, n1); rg[3] = n1[0]; rg[4] = n1[1]; rg[5] = n1[2]; } }
    { LAS unsigned char* hl = lds + ts * HSZ;
            if (act) {
                const int r = lane & 31, hh = lane >> 5;
                const LAS unsigned char* Ab = hl + ((wl == 0 || wl == 3) ? CS_BH : CS_KH) + r * 144 + hh * 16;
                const LAS unsigned char* Bb = hl + (wl < 2 ? CS_AH : CS_RH) + r * 144 + hh * 16;
                f32x16 acc;
#pragma unroll
                for (int i = 0; i < 16; ++i) acc[i] = 0.f;
#pragma unroll
                for (int ks = 0; ks < 4; ++ks) { const bf16x8 a = *(const LAS bf16x8*)(Ab + ks * 32), bb = *(const LAS bf16x8*)(Bb + ks * 32); acc = __builtin_amdgcn_mfma_f32_32x32x16_bf16(a, bb, acc, 0, 0, 0); }
                const int t = r;
#pragma unroll
                for (int i = 0; i < 16; ++i) { const int j = (i & 3) + 8 * (i >> 2) + 4 * hh; const bool same = (j >> 4) == (t >> 4);
                    const bool keep = same && (wl < 2 ? (j < t) : (j <= t)); acc[i] = keep ? acc[i] : 0.f; }
                if (wl == 0) {
#pragma unroll
                    for (int i = 0; i < 16; ++i) { const int j = (i & 3) + 8 * (i >> 2) + 4 * hh; *(LAS float*)(hl + CS_NBA + (t * 36 + j) * 4) = acc[i]; } }
                else if (wl == 1) {
#pragma unroll
                    for (int i = 0; i < 16; ++i) { const int j = (i & 3) + 8 * (i >> 2) + 4 * hh; *(LAS bf16*)(hl + CS_NKA + j * 80 + t * 2) = bfs(acc[i]); } }
                else { const float sg = wl == 2 ? 1.f : -1.f; const int base = wl == 2 ? CS_MKR : CS_MBR;
#pragma unroll
                    for (int q4 = 0; q4 < 4; ++q4) *(LAS v2u*)(hl + base + t * 80 + (8 * q4 + 4 * hh) * 2) = pack4((f32x4){sg * acc[4 * q4], sg * acc[4 * q4 + 1], sg * acc[4 * q4 + 2], sg * acc[4 * q4 + 3]}); }
            }
    __syncthreads();
            if (act && wl == 0 && lane < 32) {
                const int blk = lane >> 4, i = lane & 15;
                float Tr[16];
#pragma unroll
                for (int t = 0; t < 16; ++t) {
                    float acc = (t == i) ? 1.f : 0.f;
                    const LAS float* np = (const LAS float*)(hl + CS_NBA) + (16 * blk + t) * 36 + 16 * blk;
#pragma unroll
                    for (int j = 0; j < t; ++j) acc -= Tr[j] * np[j];
                    Tr[t] = acc;
                }
#pragma unroll
                for (int t = 0; t < 16; ++t) { *(LAS bf16*)(hl + CS_TT + (16 * blk + t) * 80 + (16 * blk + i) * 2) = bfs(Tr[t]); *(LAS bf16*)(hl + CS_TT + (16 * blk + t) * 80 + (16 * (1 - blk) + i) * 2) = (bf16)0; }
            }
    __syncthreads();
            if (act && wl < 3) {
                const int r = lane & 31, hh = lane >> 5;
                const LAS unsigned char* Ab = hl + (wl < 2 ? CS_AHC + (32 * wl + r) * 80 : CS_NKA + r * 80) + hh * 16;
                const LAS unsigned char* Bb = hl + CS_TT + r * 80 + hh * 16;
                f32x16 acc;
#pragma unroll
                for (int i = 0; i < 16; ++i) acc[i] = 0.f;
#pragma unroll
                for (int ks = 0; ks < 2; ++ks) { const bf16x8 a = *(const LAS bf16x8*)(Ab + ks * 32), bb = *(const LAS bf16x8*)(Bb + ks * 32); acc = __builtin_amdgcn_mfma_f32_32x32x16_bf16(a, bb, acc, 0, 0, 0); }
                const int t = r;
#pragma unroll
                for (int q4 = 0; q4 < 4; ++q4) { const v2u pk = pack4((f32x4){acc[4 * q4], acc[4 * q4 + 1], acc[4 * q4 + 2], acc[4 * q4 + 3]});
                    if (wl < 2) *(LAS v2u*)(hl + CS_APT + t * 144 + (32 * wl + 8 * q4 + 4 * hh) * 2) = pk;
                    else *(LAS v2u*)(hl + CS_NPT + t * 80 + (8 * q4 + 4 * hh) * 2) = pk; }
            }
    }
    __syncthreads();
#pragma unroll
    for (int i = 0; i < 4; ++i) { const int idx = tid + 512 * i; *(v4u*)(blob0 + idx * 16) = *(const LAS v4u*)(lds + idx * 16); }
    if (two) {
#pragma unroll
        for (int i = 0; i < 4; ++i) { const int idx = tid + 512 * i; *(v4u*)(blob0 + BL_BYTES + idx * 16) = *(const LAS v4u*)(lds + HSZ + idx * 16); } }
}
__device__ __forceinline__ void scan_y_store(Frame& F, int chain, int tile, int t0, int tid2) {
    const int b = chain >> 4, h = (chain >> 1) & 7, d = chain & 1;
    const int jt = tile - TC / 32, tlo = d == 0 ? 32 * jt : T - 32 * (jt + 1);
    const int s2 = tid2 >> 3, part = tid2 & 7; const int tk = d == 0 ? tlo + s2 : tlo + 31 - s2;
    const LAS float* ys = (const LAS float*)(F.lds + GS_YS + ((tile - t0) & 1) * 8192) + s2 * 64 + part * 8;
    float* dst = F.out + ((size_t)(b * T + tk)) * D + d * 512 + h * 64 + part * 8;
    *(f32x4*)dst = *(const LAS f32x4*)ys; *(f32x4*)(dst + 4) = *(const LAS f32x4*)(ys + 4);
}
__device__ __forceinline__ void scan_state_round(Frame& F, int chain, int t0, int t1, const unsigned char* blobs) {
    LAS unsigned char* lds = F.lds; const int tid = F.tid, lane = F.lane, wave = F.wave;
    f32x4* zs = (f32x4*)(F.ws + WS_ZS) + ((size_t)chain * 256 + (tid & 255)) * 4;
    f32x4 Z[4];
#pragma unroll
    for (int kt = 0; kt < 4; ++kt) Z[kt] = (t0 > 0 && wave < 4) ? zs[kt] : (f32x4){0.f, 0.f, 0.f, 0.f};
    __syncthreads();
    { v4u b0[4];
#pragma unroll
      for (int i = 0; i < 4; ++i) b0[i] = *(const v4u*)(blobs + (tid + 512 * i) * 16);
#pragma unroll
      for (int i = 0; i < 4; ++i) *(LAS v4u*)(lds + (tid + 512 * i) * 16) = b0[i]; }
    const int tid2 = tid - 256;
    v4u bg[4];
    if (t0 + 1 < t1) {
#pragma unroll
        for (int i = 0; i < 4; ++i) bg[i] = *(const v4u*)(blobs + (size_t)BL_BYTES + (tid + 512 * i) * 16); }
    __syncthreads();
    for (int tile = t0; tile < t1; ++tile) {
        const bool isctx = tile < TC / 32;
        const LAS unsigned char* bl = lds + ((tile - t0) & 1) * BL_BYTES;
        if (tile + 1 < t1) {
#pragma unroll
            for (int i = 0; i < 4; ++i) *(LAS v4u*)(lds + ((tile + 1 - t0) & 1) * BL_BYTES + (tid + 512 * i) * 16) = bg[i]; }
        if (tile + 2 < t1) {
#pragma unroll
            for (int i = 0; i < 4; ++i) bg[i] = *(const v4u*)(blobs + (size_t)(tile + 2 - t0) * BL_BYTES + (tid + 512 * i) * 16); }
        if (wave >= 4 && tile > t0 && tile - 1 >= TC / 32) scan_y_store(F, chain, tile - 1, t0, tid2);
        if (wave < 4) {
            const int n = lane & 15, g = lane >> 4;
            const bf16x8 bvt = *(const LAS bf16x8*)(bl + BL_VT + (16 * wave + n) * 80 + g * 16);
            f32x4 U[2]; U[0] = (f32x4){0.f, 0.f, 0.f, 0.f}; U[1] = U[0];
#pragma unroll
            for (int cc = 0; cc < 2; ++cc) {
                if (cc == 1) __builtin_amdgcn_sched_barrier(0);
                const int trow = 16 * cc + n;
                const LAS unsigned char* ap = bl + BL_APT + trow * 144; const LAS unsigned char* rp = bl + BL_RH + trow * 144; const LAS unsigned char* mp = bl + BL_MBR + trow * 80;
                const bf16x8 fAP0 = frag2(ap + (4 * g) * 2, ap + (16 + 4 * g) * 2), fAP1 = frag2(ap + (32 + 4 * g) * 2, ap + (48 + 4 * g) * 2);
                const bf16x8 fNP = *(const LAS bf16x8*)(bl + BL_NPT + trow * 80 + g * 16);
                f32x4 gcv = *(const LAS f32x4*)(bl + BL_GC + (cc * 64 + 4 * g) * 4);
                bf16x8 fKG = *(const LAS bf16x8*)(bl + BL_KGC + n * 80 + g * 16);
                v2u fBG = *(const LAS v2u*)(bl + BL_BGC + n * 80 + (16 * cc + 4 * g) * 2);
                asm volatile("" :: "v"(fAP0), "v"(fAP1), "v"(fNP), "v"(gcv), "v"(fKG), "v"(fBG));
                const bf16x8 bz01 = frag_acc(Z[0], Z[1]), bz23 = frag_acc(Z[2], Z[3]);
                f32x4 u = __builtin_amdgcn_mfma_f32_16x16x32_bf16(fAP0, bz01, (f32x4){0.f, 0.f, 0.f, 0.f}, 0, 0, 0);
                u = __builtin_amdgcn_mfma_f32_16x16x32_bf16(fAP1, bz23, u, 0, 0, 0);
                u = __builtin_amdgcn_mfma_f32_16x16x32_bf16(fNP, bvt, u, 0, 0, 0);
                U[cc] = u;
                const bf16x8 bu = frag_acc(U[0], U[1]);
                if (!isctx) {
                    const bf16x8 fRH0 = frag2(rp + (4 * g) * 2, rp + (16 + 4 * g) * 2), fRH1 = frag2(rp + (32 + 4 * g) * 2, rp + (48 + 4 * g) * 2);
                    const bf16x8 fMK = *(const LAS bf16x8*)(bl + BL_MKR + trow * 80 + g * 16);
                    const bf16x8 fMB = frag2(mp + (4 * g) * 2, mp + (16 + 4 * g) * 2);
                    asm volatile("" :: "v"(fRH0), "v"(fRH1), "v"(fMK), "v"(fMB));
                    f32x4 y = __builtin_amdgcn_mfma_f32_16x16x32_bf16(fRH0, bz01, (f32x4){0.f, 0.f, 0.f, 0.f}, 0, 0, 0);
                    y = __builtin_amdgcn_mfma_f32_16x16x32_bf16(fRH1, bz23, y, 0, 0, 0);
                    y = __builtin_amdgcn_mfma_f32_16x16x32_bf16(fMK, bvt, y, 0, 0, 0);
                    y = __builtin_amdgcn_mfma_f32_16x16x32_bf16(fMB, bu, y, 0, 0, 0);
#pragma unroll
                    for (int i = 0; i < 4; ++i) *(LAS float*)(lds + GS_YS + ((tile - t0) & 1) * 8192 + ((16 * cc + 4 * g + i) * 64 + 16 * wave + n) * 4) = y[i]; }
#pragma unroll
                for (int kt = 0; kt < 4; ++kt) {
                    f32x4 gcn = gcv; bf16x8 fKGn = fKG; v2u fBGn = fBG;
                    if (kt < 3) { gcn = *(const LAS f32x4*)(bl + BL_GC + (cc * 64 + 16 * (kt + 1) + 4 * g) * 4);
                        fKGn = *(const LAS bf16x8*)(bl + BL_KGC + (16 * (kt + 1) + n) * 80 + g * 16);
                        fBGn = *(const LAS v2u*)(bl + BL_BGC + (16 * (kt + 1) + n) * 80 + (16 * cc + 4 * g) * 2); }
                    const bf16x8 ka = ((g >> 1) == cc) ? fKG : frag_zero();
                    const v4u bw = cc == 0 ? (v4u){fBG.x, fBG.y, 0u, 0u} : (v4u){0u, 0u, fBG.x, fBG.y};
                    f32x4 z = Z[kt] * gcv;
                    z = __builtin_amdgcn_mfma_f32_16x16x32_bf16(ka, bvt, z, 0, 0, 0);
                    z = __builtin_amdgcn_mfma_f32_16x16x32_bf16(__builtin_bit_cast(bf16x8, bw), bu, z, 0, 0, 0);
                    Z[kt] = z;
                    if (kt < 3) asm volatile("" :: "v"(gcn), "v"(fKGn), "v"(fBGn));
                    gcv = gcn; fKG = fKGn; fBG = fBGn;
                }
            }
        }
        __syncthreads();
    }
    if (t1 - 1 >= TC / 32 && wave >= 4) scan_y_store(F, chain, t1 - 1, t0, tid - 256);
    if (wave < 4 && t1 < SC_NTILE) {
#pragma unroll
        for (int kt = 0; kt < 4; ++kt) zs[kt] = Z[kt]; }
    __syncthreads();
}
template <int LEVEL> __device__ __forceinline__ void p3_scan(Frame& F, const XcdBarrier& bar) {
    const bf16* proj = (const bf16*)(F.ws + WS_PROJ);
    const bool state_role = F.bid < 64;
    const int pj = (F.bid - 64) >> 3;
    const int pchain = state_role ? F.bid : (F.bid & 7) + 8 * (pj / 3), psub = state_role ? 0 : pj % 3;
    int prev_chain = -1;
    for (int step = 0; step <= SC_NROUND; ++step) {
        if (LEVEL != 1 && step >= 1 && state_role) {
            const int r = step - 1, t0 = r * SC_RT, t1 = (t0 + SC_RT < SC_NTILE) ? t0 + SC_RT : SC_NTILE;
            scan_state_round(F, F.bid, t0, t1, F.ws + ((r & 1) ? WS_BLOB1 : WS_BLOB0) + (size_t)F.bid * SC_RT * BL_BYTES);
            prev_chain = -1;
        }
        if (LEVEL != 2 && step < SC_NROUND) {
            const int t0 = step * SC_RT, nt = (t0 + SC_RT < SC_NTILE) ? SC_RT : SC_NTILE - t0;
            unsigned char* base = F.ws + ((step & 1) ? WS_BLOB1 : WS_BLOB0) + (size_t)pchain * SC_RT * BL_BYTES;
            int a0, a1;
            if (state_role) { a0 = 0; a1 = 1; } else { const int rest = nt - 1; a0 = 1 + rest * psub / 3; a1 = 1 + rest * (psub + 1) / 3; }
            v4u rg[6];
            if (a0 < a1) { v4u n0[3]; scan_issue_loads(proj, pchain >> 4, (pchain >> 1) & 7, pchain & 1, t0 + a0, F.tid, n0); rg[0] = n0[0]; rg[1] = n0[1]; rg[2] = n0[2];
                if (a0 + 1 < a1) { v4u n1[3]; scan_issue_loads(proj, pchain >> 4, (pchain >> 1) & 7, pchain & 1, t0 + a0 + 1, F.tid, n1); rg[3] = n1[0]; rg[4] = n1[1]; rg[5] = n1[2]; } }
            for (int tl = a0; tl < a1; tl += 2) {
                const bool two = tl + 1 < a1, have_next = tl + 2 < a1, ntwo = tl + 3 < a1;
                scan_prep_pair(F, proj, pchain, t0 + tl, two, pchain != prev_chain, have_next, t0 + tl + 2, ntwo, rg, base + (size_t)tl * BL_BYTES);
                prev_chain = pchain;
            }
        }
        if (step < SC_NROUND) xcd_barrier(bar);
    }
}
constexpr int P4_SG = 0, P4_GT = 17408, P4_CST = 17408 + 64 * 1040, P4_END = P4_CST + 12 * 2048;
__device__ __forceinline__ f32x4 ldq(const LAS float* p) { return *(const LAS f32x4*)p; }
__device__ __forceinline__ void unpack8(v4u w, float (&o)[8]) { o[0] = bf_lo(w.x); o[1] = bf_hi(w.x); o[2] = bf_lo(w.y); o[3] = bf_hi(w.y); o[4] = bf_lo(w.z); o[5] = bf_hi(w.z); o[6] = bf_lo(w.w); o[7] = bf_hi(w.w); }
__device__ __forceinline__ float sum8lanes(float p) { p += dppf<0xB1>(p); p += dppf<0x4E>(p); p += dppf<0x141>(p); return p; }
__device__ __forceinline__ void p4_mix(Frame& F) {
    LAS unsigned char* lds = F.lds; const int tid = F.tid, lane = F.lane, wave = F.wave;
    const bf16* proj = (const bf16*)(F.ws + WS_PROJ); bf16* cat = (bf16*)(F.ws + WS_HX); const float* yscr = F.out; const bf16* gwt = (const bf16*)(F.ws + WS_GWT);
    LAS float* CST = (LAS float*)(lds + P4_CST);
    __syncthreads();
    for (int i = tid; i < 12 * 512; i += 512) { const int row = i >> 9, c = i & 511;
        CST[i] = row < 6 ? F.in[I_TMU][row * 512 + c] : row == 6 ? F.in[I_RK][c] : row == 7 ? F.in[I_LNG][c] : row == 8 ? F.in[I_LNB][c] : F.in[I_CONVW][(row - 9) * 512 + c]; }
    for (int unit = F.bid; unit < MX / 64; unit += F.G) {
        const size_t row0 = (size_t)unit * 64; const int tb0 = (unit * 64) & (T - 1);
        __syncthreads();
#pragma unroll
        for (int i = 0; i < 2; ++i) { const int ck = tid + 512 * i, tok = ck >> 4, j0 = (ck & 15) * 8;
            const v4u w = *(const v4u*)(proj + (row0 + tok) * NPROJ + COL_G + j0);
            v4u o; o.x = pk2(sigmoidf(bf_lo(w.x)), sigmoidf(bf_hi(w.x))); o.y = pk2(sigmoidf(bf_lo(w.y)), sigmoidf(bf_hi(w.y))); o.z = pk2(sigmoidf(bf_lo(w.z)), sigmoidf(bf_hi(w.z))); o.w = pk2(sigmoidf(bf_lo(w.w)), sigmoidf(bf_hi(w.w)));
            *(LAS v4u*)(lds + P4_SG + tok * 272 + j0 * 2) = o; }
        __syncthreads();
        { const int r = lane & 31, hh = lane >> 5;
#pragma unroll
          for (int nt = 0; nt < 2; ++nt) {
              const bf16* bp = gwt + (size_t)(64 * wave + 32 * nt + r) * 128 + hh * 8;
              bf16x8 bfr[8];
#pragma unroll
              for (int ks = 0; ks < 8; ++ks) bfr[ks] = *(const bf16x8*)(bp + ks * 16);
#pragma unroll
              for (int mt = 0; mt < 2; ++mt) {
                  f32x16 acc;
#pragma unroll
                  for (int i = 0; i < 16; ++i) acc[i] = 0.f;
#pragma unroll
                  for (int ks = 0; ks < 8; ++ks) { const bf16x8 a = *(const LAS bf16x8*)(lds + P4_SG + (32 * mt + r) * 272 + ks * 32 + hh * 16); acc = __builtin_amdgcn_mfma_f32_32x32x16_bf16(a, bfr[ks], acc, 0, 0, 0); }
#pragma unroll
                  for (int i = 0; i < 16; ++i) *(LAS bf16*)(lds + P4_GT + (32 * mt + (i & 3) + 8 * (i >> 2) + 4 * hh) * 1040 + (64 * wave + 32 * nt + r) * 2) = (bf16)(pk2(acc[i], 0.f) & 0xffffu);
              } } }
        __syncthreads();
        const int gq = tid & 63, c0 = gq * 8;
#pragma unroll 2
        for (int n = 0; n < 8; ++n) { const int t = 8 * n + (tid >> 6); const int tb = tb0 + t;
            const bf16* pr = proj + (row0 + t) * NPROJ + c0;
            float xs[3][8];
#pragma unroll
            for (int which = 0; which < 3; ++which) { const int col = COL_R + which * 512;
                float xc[8], xp[8], xn[8];
                unpack8(*(const v4u*)(pr + col), xc);
                if (tb > 0) unpack8(*(const v4u*)(pr - NPROJ + col), xp); else {
#pragma unroll
                    for (int e = 0; e < 8; ++e) xp[e] = 0.f; }
                if (tb + 1 < T) unpack8(*(const v4u*)(pr + NPROJ + col), xn); else {
#pragma unroll
                    for (int e = 0; e < 8; ++e) xn[e] = 0.f; }
                const f32x4 mp0 = ldq(CST + which * 512 + c0), mp1 = ldq(CST + which * 512 + c0 + 4), mn0 = ldq(CST + (3 + which) * 512 + c0), mn1 = ldq(CST + (3 + which) * 512 + c0 + 4);
#pragma unroll
                for (int e = 0; e < 8; ++e) { const float mp = e < 4 ? mp0[e & 3] : mp1[e & 3], mn = e < 4 ? mn0[e & 3] : mn1[e & 3]; xs[which][e] = xc[e] + mp * (xp[e] - xc[e]) + mn * (xn[e] - xc[e]); } }
            const float* yr = yscr + (row0 + t) * D + c0;
            const f32x4 ya = *(const f32x4*)yr + *(const f32x4*)(yr + 512), yb = *(const f32x4*)(yr + 4) + *(const f32x4*)(yr + 516);
            float y[8] = {ya.x, ya.y, ya.z, ya.w, yb.x, yb.y, yb.z, yb.w};
            float sm = 0.f, sb = 0.f;
            const f32x4 rk0 = ldq(CST + 6 * 512 + c0), rk1 = ldq(CST + 6 * 512 + c0 + 4);
#pragma unroll
            for (int e = 0; e < 8; ++e) { sm += y[e]; sb += xs[0][e] * xs[1][e] * (e < 4 ? rk0[e & 3] : rk1[e & 3]); }
            const float mu = sum8lanes(sm) * (1.f / 64.f); const float bon = sum8lanes(sb);
            float sv = 0.f;
#pragma unroll
            for (int e = 0; e < 8; ++e) { y[e] -= mu; sv += y[e] * y[e]; }
            const float rstd = __builtin_amdgcn_rsqf(sum8lanes(sv) * (1.f / 64.f) + LNX_EPS);
            const f32x4 lg0 = ldq(CST + 7 * 512 + c0), lg1 = ldq(CST + 7 * 512 + c0 + 4), lb0 = ldq(CST + 8 * 512 + c0), lb1 = ldq(CST + 8 * 512 + c0 + 4);
            float gt[8]; unpack8(*(const LAS v4u*)(lds + P4_GT + t * 1040 + c0 * 2), gt);
            float o[8];
#pragma unroll
            for (int e = 0; e < 8; ++e) o[e] = (y[e] * rstd * (e < 4 ? lg0[e & 3] : lg1[e & 3]) + (e < 4 ? lb0[e & 3] : lb1[e & 3]) + bon * xs[2][e]) * gt[e];
            *(v4u*)(cat + (row0 + t) * D + 512 + c0) = (v4u){pk2(o[0], o[1]), pk2(o[2], o[3]), pk2(o[4], o[5]), pk2(o[6], o[7])};
        }
#pragma unroll 2
        for (int n = 0; n < 8; ++n) { const int t = 8 * n + (tid >> 6);
            const bf16* pr = proj + (row0 + t) * NPROJ + c0;
            float zc[8], zp[8], zn[8], g8[8], x8[8], xb[8];
            unpack8(*(const v4u*)(pr + COL_XG), g8); unpack8(*(const v4u*)(pr + COL_XC), x8);
#pragma unroll
            for (int e = 0; e < 8; ++e) zc[e] = g8[e] * x8[e];
            if (t > 0) { unpack8(*(const v4u*)(pr - NPROJ + COL_XG), g8); unpack8(*(const v4u*)(pr - NPROJ + COL_XC), x8);
#pragma unroll
                for (int e = 0; e < 8; ++e) zp[e] = g8[e] * x8[e]; } else {
#pragma unroll
                for (int e = 0; e < 8; ++e) zp[e] = 0.f; }
            if (t < 63) { unpack8(*(const v4u*)(pr + NPROJ + COL_XG), g8); unpack8(*(const v4u*)(pr + NPROJ + COL_XC), x8);
#pragma unroll
                for (int e = 0; e < 8; ++e) zn[e] = g8[e] * x8[e]; } else {
#pragma unroll
                for (int e = 0; e < 8; ++e) zn[e] = 0.f; }
            unpack8(*(const v4u*)(pr + COL_XB), xb);
            const f32x4 w00 = ldq(CST + 9 * 512 + c0), w01 = ldq(CST + 9 * 512 + c0 + 4), w10 = ldq(CST + 10 * 512 + c0), w11 = ldq(CST + 10 * 512 + c0 + 4), w20 = ldq(CST + 11 * 512 + c0), w21 = ldq(CST + 11 * 512 + c0 + 4);
            float o[8];
#pragma unroll
            for (int e = 0; e < 8; ++e) o[e] = xb[e] * ((e < 4 ? w00[e & 3] : w01[e & 3]) * zp[e] + (e < 4 ? w10[e & 3] : w11[e & 3]) * zc[e] + (e < 4 ? w20[e & 3] : w21[e & 3]) * zn[e]);
            *(v4u*)(cat + (row0 + t) * D + c0) = (v4u){pk2(o[0], o[1]), pk2(o[2], o[3]), pk2(o[4], o[5]), pk2(o[6], o[7])};
        }
    }
}

__device__ __forceinline__ void p6_mid(Frame& F) {
    const float* mod = (const float*)(F.ws + WS_MOD); const float* ng = F.in[I_NG];
    const float* yx = (const float*)(F.ws + WS_PROJ); bf16* hx2 = (bf16*)(F.ws + WS_HX);
    for (int m = F.bid * NWAVES + F.wave; m < MX; m += F.G * NWAVES) {
        const float* mr = mod + (m >> 12) * NMOD;
        f32x4 v[4], xv[4]; float ss = 0.f;
#pragma unroll
        for (int j = 0; j < 4; ++j) { v[j] = *(const f32x4*)(yx + (size_t)m * D + j * 256 + F.lane * 4); xv[j] = *(const f32x4*)(F.in[I_X] + (size_t)m * D + j * 256 + F.lane * 4);
            ss += v[j].x * v[j].x + v[j].y * v[j].y + v[j].z * v[j].z + v[j].w * v[j].w; }
        const float rstd = __builtin_amdgcn_rsqf(wave_sum(ss) * (1.f / D) + NORM_EPS);
        float ss2 = 0.f;
#pragma unroll
        for (int j = 0; j < 4; ++j) { const int c = j * 256 + F.lane * 4;
            const f32x4 g1 = *(const f32x4*)(ng + D + c), gt = *(const f32x4*)(mr + 2 * D + c);
            xv[j] = xv[j] + gt * (v[j] * rstd * g1);
            *(f32x4*)(F.out + (size_t)m * D + c) = xv[j];
            ss2 += xv[j].x * xv[j].x + xv[j].y * xv[j].y + xv[j].z * xv[j].z + xv[j].w * xv[j].w; }
        const float rstd2 = __builtin_amdgcn_rsqf(wave_sum(ss2) * (1.f / D) + NORM_EPS);
#pragma unroll
        for (int j = 0; j < 4; ++j) { const int c = j * 256 + F.lane * 4;
            const f32x4 g2 = *(const f32x4*)(ng + 2 * D + c), sh = *(const f32x4*)(mr + 3 * D + c), sc = *(const f32x4*)(mr + 4 * D + c);
            const f32x4 o = xv[j] * rstd2 * g2 * (1.f + sc) + sh;
            *(v2u*)(hx2 + (size_t)m * D + c) = (v2u){pk2(o.x, o.y), pk2(o.z, o.w)}; }
    }
}
__device__ __forceinline__ float gelu_erf(float x) { return 0.5f * x * (1.f + erff(x * 0.70710678118f)); }
__device__ __forceinline__ float dot2bf(unsigned a, unsigned b, float c) {
    typedef __bf16 bf2 __attribute__((ext_vector_type(2)));
    return __builtin_amdgcn_fdot2_f32_bf16(__builtin_bit_cast(bf2, a), __builtin_bit_cast(bf2, b), c, false);
}
__device__ __forceinline__ unsigned uminu(unsigned a, unsigned b) { return a < b ? a : b; }
__device__ __forceinline__ void ce_desc(unsigned& x, unsigned& y) { const unsigned hi = umaxu(x, y), lo = uminu(x, y); x = hi; y = lo; }
template <int N> __device__ __forceinline__ void bitonic_sort_desc(unsigned (&a)[N]) {
#pragma unroll
    for (int k = 2; k <= N; k <<= 1)
#pragma unroll
        for (int j = k >> 1; j > 0; j >>= 1)
#pragma unroll
            for (int i = 0; i < N; ++i) { const int l = i ^ j; if (l > i) { if ((i & k) == 0) ce_desc(a[i], a[l]); else ce_desc(a[l], a[i]); } }
}
template <int N> __device__ __forceinline__ void bitonic_merge_desc(unsigned (&a)[N]) {
#pragma unroll
    for (int j = N >> 1; j > 0; j >>= 1)
#pragma unroll
        for (int i = 0; i < N; ++i) { const int l = i ^ j; if (l > i) ce_desc(a[i], a[l]); }
}
__device__ __forceinline__ void p8a_route(Frame& F) {
    const int lane = F.lane, wave = F.wave, part = lane & 3, L = lane >> 2, side = L & 1;
    LAS unsigned char* WL = F.lds + 1024 + wave * 1024;
    LAS unsigned char* TAB = F.lds;
    const float* scores = (const float*)(F.ws + WS_PROJ);
    unsigned short* exl = (unsigned short*)(F.ws + WS_EXL); float* gl = (float*)(F.ws + WS_GL);
    __syncthreads();
    if (F.tid < 64) { int l = F.tid, i = 0; for (; i < 16; ++i) { const int n = 16 / (i + 1); if (l < n) break; l -= n; } TAB[F.tid] = (unsigned char)(i < 16 ? i * 16 + l : 0); }
    __syncthreads();
    for (int m = F.bid * NWAVES + wave; m < MX; m += F.G * NWAVES) {
        const float* lp = scores + (size_t)m * NSC + L * 128 + part * 32;
        unsigned lo16[16], hi16[16];
#pragma unroll
        for (int q = 0; q < 4; ++q) { const f32x4 v = *(const f32x4*)(lp + 4 * q), w = *(const f32x4*)(lp + 16 + 4 * q);
#pragma unroll
            for (int e = 0; e < 4; ++e) { lo16[4 * q + e] = (f2key(v[e]) & ~127u) | (unsigned)(127 - part * 32 - (4 * q + e)); hi16[4 * q + e] = (f2key(w[e]) & ~127u) | (unsigned)(127 - part * 32 - 16 - (4 * q + e)); } }
        bitonic_sort_desc<16>(lo16); bitonic_sort_desc<16>(hi16);
        unsigned r[16];
#pragma unroll
        for (int i = 0; i < 16; ++i) r[i] = umaxu(lo16[i], hi16[15 - i]);
        bitonic_merge_desc<16>(r);
        { unsigned c[16];
#pragma unroll
          for (int i = 0; i < 16; ++i) c[i] = umaxu(r[i], dppu<0xB1>(r[15 - i]));
          bitonic_merge_desc<16>(c);
#pragma unroll
          for (int i = 0; i < 16; ++i) r[i] = umaxu(c[i], dppu<0x4E>(c[15 - i]));
          bitonic_merge_desc<16>(r); }
        if (part == 0) {
#pragma unroll
            for (int i = 0; i < 16; ++i) WL[L * 16 + i] = (unsigned char)(127u - (r[i] & 127u)); }
        float fa[16], fb[16];
#pragma unroll
        for (int i = 0; i < 16; ++i) { const unsigned up = dppu<0x104>(r[i]), dn = dppu<0x114>(r[i]);
            const unsigned av = side ? dn : r[i], bv = side ? r[i] : up; fa[i] = key2f(av & ~127u); fb[i] = key2f(bv & ~127u); }
        unsigned R[16];
#pragma unroll
        for (int j = 0; j < 16; ++j) R[j] = (f2key(fa[0] + fb[j]) & ~63u) | (unsigned)(63 - j);
        { int code = 16;
#pragma unroll
          for (int i = 1; i < 16; ++i) {
#pragma unroll
              for (int j = 0; j < 16; ++j) { if ((i + 1) * (j + 1) <= 16) {
                  const unsigned x = (f2key(fa[i] + fb[j]) & ~63u) | (unsigned)(63 - code); const int p0 = (i + 1) * (j + 1) - 1;
#pragma unroll
                  for (int p = 15; p > p0; --p) R[p] = umaxu(R[p], uminu(R[p - 1], x));
                  R[p0] = umaxu(R[p0], x); ++code; } } } }
        if ((lane & 7) == 0) {
#pragma unroll
            for (int k = 0; k < 16; ++k) *(LAS unsigned*)(WL + 256 + ((lane >> 3) * 16 + k) * 4) = R[k]; }
        LDS_WAIT();
#pragma unroll
        for (int half = 0; half < 2; ++half) { const int e = lane + 64 * half, hd = e >> 4;
            const unsigned rk = *(const LAS unsigned*)(WL + 256 + e * 4); const int ij = TAB[63 - (int)(rk & 63u)];
            const int idx0 = WL[(2 * hd) * 16 + (ij >> 4)], idx1 = WL[(2 * hd + 1) * 16 + (ij & 15)];
            const float scv = key2f(rk & ~63u);
            float mx = scv; mx = fmaxf(mx, dppf<0xB1>(mx)); mx = fmaxf(mx, dppf<0x4E>(mx)); mx = fmaxf(mx, dppf<0x141>(mx)); mx = fmaxf(mx, dppf<0x140>(mx));
            const float ev = fast_exp(scv - mx); const float den = rowsum16(ev);
            exl[(size_t)m * 128 + e] = (unsigned short)(idx0 * 128 + idx1); gl[(size_t)m * 128 + e] = ev * fast_rcp(den); }
        LDS_WAIT();
    }
}
__device__ __forceinline__ void p9_upass(Frame& F) {
    const int lane = F.lane, wave = F.wave, x = F.bid & 7, r = F.bid >> 3, nr = F.G >> 3, g = lane >> 3, q = lane & 7;
    LAS unsigned short* EXW = (LAS unsigned short*)(F.lds + wave * 256);
    const unsigned* exl32 = (const unsigned*)(F.ws + WS_EXL); const bf16* hx2 = (const bf16*)(F.ws + WS_HX);
    const unsigned char* U = F.ws + WS_U + 128 * x + 16 * q; float* part = (float*)(F.ws + WS_PART) + (size_t)x * MX * 128;
    for (int m = r + nr * wave; m < MX; m += nr * NWAVES) {
        *(LAS unsigned*)(EXW + 2 * lane) = exl32[(size_t)m * 64 + lane];
        const v4u h0 = *(const v4u*)(hx2 + (size_t)m * D + 128 * x + 16 * q), h1 = *(const v4u*)(hx2 + (size_t)m * D + 128 * x + 16 * q + 8);
        float hf[16];
        hf[0] = bf_lo(h0.x); hf[1] = bf_hi(h0.x); hf[2] = bf_lo(h0.y); hf[3] = bf_hi(h0.y); hf[4] = bf_lo(h0.z); hf[5] = bf_hi(h0.z); hf[6] = bf_lo(h0.w); hf[7] = bf_hi(h0.w);
        hf[8] = bf_lo(h1.x); hf[9] = bf_hi(h1.x); hf[10] = bf_lo(h1.y); hf[11] = bf_hi(h1.y); hf[12] = bf_lo(h1.z); hf[13] = bf_hi(h1.z); hf[14] = bf_lo(h1.w); hf[15] = bf_hi(h1.w);
        LDS_WAIT();
        float keep[2];
#pragma unroll
        for (int j = 0; j < 2; ++j) {
            float kp = 0.f;
            v4u uu[8];
#pragma unroll
            for (int i = 0; i < 8; ++i) { const unsigned ex = EXW[64 * j + 8 * i + g]; uu[i] = *(const v4u*)(U + (size_t)ex * 1024); }
#pragma unroll
            for (int i = 0; i < 8; ++i) { float p = 0.f;
#pragma unroll
                for (int w = 0; w < 4; ++w) { const f32x2 lo = __builtin_amdgcn_cvt_pk_f32_fp8((int)uu[i][w], false), hi = __builtin_amdgcn_cvt_pk_f32_fp8((int)uu[i][w], true);
                    p += lo.x * hf[4 * w] + lo.y * hf[4 * w + 1] + hi.x * hf[4 * w + 2] + hi.y * hf[4 * w + 3]; }
                p += dppf<0xB1>(p); p += dppf<0x4E>(p); p += dppf<0x141>(p);
                kp = (q == i) ? p : kp; }
            keep[j] = kp * (1.f / 32.f);
        }
        part[(size_t)m * 128 + 8 * q + g] = keep[0]; part[(size_t)m * 128 + 64 + 8 * q + g] = keep[1];
        LDS_WAIT();
    }
}
__device__ __forceinline__ void p10_combine(Frame& F) {
    const float* __restrict__ part = (const float*)(F.ws + WS_PART); const float* __restrict__ gl = (const float*)(F.ws + WS_GL);
    const unsigned short* __restrict__ exl = (const unsigned short*)(F.ws + WS_EXL); unsigned* __restrict__ plt = (unsigned*)(F.ws + WS_PL);
    LAS unsigned* TL = (LAS unsigned*)F.lds;
    for (int unit = F.bid; unit < MX / 64; unit += F.G) {
        const int m0 = unit * 64;
        __syncthreads();
#pragma unroll 4
        for (int i = 0; i < 16; ++i) { const int idx = F.tid + 512 * i, ml = idx >> 7, k = idx & 127; const size_t gi = (size_t)(m0 + ml) * 128 + k;
            float s = part[gi];
#pragma unroll
            for (int x = 1; x < 8; ++x) s += part[(size_t)x * MX * 128 + gi];
            TL[k * 65 + ml] = (unsigned)exl[gi] | ((unsigned)__builtin_bit_cast(unsigned short, (_Float16)(gl[gi] * gelu_erf(s))) << 16); }
        __syncthreads();
#pragma unroll 4
        for (int i = 0; i < 16; ++i) { const int idx = F.tid + 512 * i, k = idx >> 6, ml = idx & 63; plt[(size_t)k * MX + m0 + ml] = TL[k * 65 + ml]; }
    }
}
typedef _Float16 h2_t __attribute__((ext_vector_type(2)));
typedef _Float16 h4_t __attribute__((ext_vector_type(4)));
template <int MODE> __device__ __forceinline__ void p11_vpass(Frame& F) {
    const int lane = F.lane, wave = F.wave;
    const unsigned* __restrict__ plt = (const unsigned*)(F.ws + WS_PL); float* __restrict__ po = (float*)(F.ws + WS_PO);
    for (int cg = F.bid; cg < 256; cg += F.G) {
        const int c0 = 128 * (cg & 7) + 4 * (cg >> 3);
        __syncthreads();
        for (int e = F.tid; e < NEXP; e += 512) { const f32x4 vv = *(const f32x4*)(F.in[I_PV] + (size_t)e * D + c0);
            const h2_t a = {(_Float16)vv.x, (_Float16)vv.y}, b = {(_Float16)vv.z, (_Float16)vv.w};
            *(LAS v2u*)(F.lds + e * 8) = (v2u){__builtin_bit_cast(unsigned, a), __builtin_bit_cast(unsigned, b)}; }
        __syncthreads();
        for (int mg = wave; mg < MX / 64; mg += NWAVES) {
            const unsigned* __restrict__ pg = plt + mg * 64;
            f32x4 acc = (f32x4){0.f, 0.f, 0.f, 0.f};
#pragma unroll 2
            for (int k0 = 0; k0 < 128; k0 += 8) {
                unsigned p[8];
#pragma unroll
                for (int i = 0; i < 8; ++i) p[i] = pg[(size_t)(k0 + i) * MX + lane];
                h2_t a01 = {(_Float16)0.f, (_Float16)0.f}, a23 = a01;
#pragma unroll
                for (int i = 0; i < 8; ++i) { const h4_t hv = *(const LAS h4_t*)(unsigned)((p[i] & 0xffffu) << 3);
                    const _Float16 cf = __builtin_bit_cast(_Float16, (unsigned short)(p[i] >> 16)); const h2_t c2 = {cf, cf};
                    a01 = __builtin_shufflevector(hv, hv, 0, 1) * c2 + a01; a23 = __builtin_shufflevector(hv, hv, 2, 3) * c2 + a23; }
                acc.x += (float)a01.x; acc.y += (float)a01.y; acc.z += (float)a23.x; acc.w += (float)a23.y;
            }
            *(f32x4*)(po + (size_t)(mg * 64 + lane) * D + c0) = acc;
        }
    }
}
__device__ __forceinline__ void p12_final(Frame& F) {
    const float* mod = (const float*)(F.ws + WS_MOD); const float* ng3 = F.in[I_NG] + 3 * D; const float* po = (const float*)(F.ws + WS_PO);
    for (int m = F.bid * NWAVES + F.wave; m < MX; m += F.G * NWAVES) {
        const float* gt2 = mod + (m >> 12) * NMOD + 5 * D;
        f32x4 v[4]; float ss = 0.f;
#pragma unroll
        for (int j = 0; j < 4; ++j) { v[j] = *(const f32x4*)(po + (size_t)m * D + j * 256 + F.lane * 4); ss += v[j].x * v[j].x + v[j].y * v[j].y + v[j].z * v[j].z + v[j].w * v[j].w; }
        const float rstd = __builtin_amdgcn_rsqf(wave_sum(ss) * (1.f / D) + NORM_EPS);
#pragma unroll
        for (int j = 0; j < 4; ++j) { const int c = j * 256 + F.lane * 4; float* op = F.out + (size_t)m * D + c;
            const f32x4 x1 = *(const f32x4*)op, g = *(const f32x4*)(ng3 + c), gt = *(const f32x4*)(gt2 + c);
            *(f32x4*)op = x1 + gt * (v[j] * rstd * g); }
    }
}
struct Args { const float* in[25]; float* out; unsigned char* ws; int ph_lo, ph_hi; };
__global__ void __launch_bounds__(NWAVES * 64, 2) mk_fwd(Args args) {
    extern __shared__ __attribute__((aligned(16))) unsigned char lds_raw[];
    Frame F;
    F.lds = (LAS unsigned char*)lds_raw;
    F.MISC = (volatile LAS unsigned*)(F.lds + MISC_OFF);
    F.tid = threadIdx.x; F.lane = F.tid & 63; F.wave = __builtin_amdgcn_readfirstlane(F.tid >> 6);
    F.G = gridDim.x; F.bid = blockIdx.x;
#pragma unroll
    for (int i = 0; i < 25; ++i) F.in[i] = args.in[i];
    F.out = args.out; F.ws = args.ws; F.ctl = (gu32*)(args.ws + WS_CTL);
    for (int u = F.tid; u < (LDS_BYTES - LDSCTL_OFF) / 4; u += NWAVES * 64) ((LAS unsigned*)(F.lds + LDSCTL_OFF))[u] = 0u;
    __syncthreads();
    const int lo = args.ph_lo, hi = args.ph_hi;
    XcdBarrier bar; bar.bar = (unsigned*)(F.ctl + CW_BAR); bar.x = 0; bar.st = nullptr;
    if (hi - lo > 1) bar = xcd_barrier_post((unsigned*)(F.ctl + CW_BAR), F.MISC + 8);
#ifndef PROBE_LO
#define PROBE_LO -1
#define PROBE_HI -1
#endif
#define IN(k) (lo <= (k) && (k) < hi)
#define SEAM(k) do { if (IN(k) && IN((k) + 1)) xcd_barrier(bar); } while (0)
#define PH0 { p0_prep(F); }
#define PH1 { p1_hx(F); }
#define PH2 { pg8::Gemm g{(const pg8::bf16_t*)(F.ws + WS_HX), (const pg8::bf16_t*)(F.ws + WS_WINT), MA, NPROJ_PAD, D}; pg8::StaticOrder S; S.init(MA, NPROJ_PAD, F.G, F.bid); \
        pg8::EpiProj E{(pg8::bf16_t*)(F.ws + WS_PROJ), NPROJ, NPROJ}; \
        pg8::gemm_phase<pg8::EpiProj, pg8::StaticOrder, PG8_ALIGN, PG8_SP2>(F.lds, g, S, E); }
#define PH3 { p3_scan<0>(F, bar); }
#define PH4 { p4_mix(F); }
#define PH5 { pg8::Gemm g{(const pg8::bf16_t*)(F.ws + WS_HX), (const pg8::bf16_t*)(F.ws + WS_WOUTT), MX, D, D}; pg8::StaticOrder S; S.init(MX, D, F.G, F.bid); \
        pg8::EpiF32 E{(float*)(F.ws + WS_PROJ), D}; \
        pg8::gemm_phase<pg8::EpiF32, pg8::StaticOrder, PG8_ALIGN, PG8_SP2>(F.lds, g, S, E); }
#define PH6 { p6_mid(F); }
#define PH7 { pg8::Gemm g{(const pg8::bf16_t*)(F.ws + WS_HX), (const pg8::bf16_t*)(F.ws + WS_WEFFT), MX, NSC, D}; pg8::StaticOrder S; S.init(MX, NSC, F.G, F.bid); \
        pg8::EpiF32 E{(float*)(F.ws + WS_PROJ), NSC}; \
        pg8::gemm_phase<pg8::EpiF32, pg8::StaticOrder, PG8_ALIGN, PG8_SP2>(F.lds, g, S, E); }
#define PH8 { p8a_route(F); }
#define PH9 { p9_upass(F); }
#define PH10 { p10_combine(F); }
#define PH11 { p11_vpass<0>(F); }
#define PH12 { p12_final(F); }
#define PRB(k, body) if constexpr (PROBE_LO <= (k) && (k) <= PROBE_HI) { xcd_barrier(bar); body }
    if (IN(0)) PH0 PRB(0, PH0) SEAM(0);
    if (IN(1)) PH1 PRB(1, PH1) SEAM(1);
    if (IN(2)) PH2 PRB(2, PH2) SEAM(2);
    if constexpr (PROBE_LO == 33) { p3_scan<1>(F, bar); xcd_barrier(bar); }
    if constexpr (PROBE_LO == 34) { p3_scan<2>(F, bar); xcd_barrier(bar); }
    if (IN(3)) PH3 PRB(3, PH3) SEAM(3);
    if (IN(4)) PH4 PRB(4, PH4) SEAM(4);
    if (IN(5)) PH5 PRB(5, PH5) SEAM(5);
    if (IN(6)) PH6 PRB(6, PH6) SEAM(6);
    if (IN(7)) PH7 PRB(7, PH7) SEAM(7);
    if (IN(8)) PH8 PRB(8, PH8) SEAM(8);
    if (IN(9)) PH9 PRB(9, PH9) SEAM(9);
    if (IN(10)) PH10 PRB(10, PH10) SEAM(10);
    if constexpr (PROBE_LO == 111) { p11_vpass<1>(F); xcd_barrier(bar); }
    if constexpr (PROBE_LO == 112) { p11_vpass<2>(F); xcd_barrier(bar); }
    if (IN(11)) PH11 PRB(11, PH11) SEAM(11);
    if (IN(12)) PH12
#undef IN
#undef SEAM
}

extern "C" void kernel_launch(void* const* d_in, const int* in_sizes, int n_in, void* d_out, int out_size, void* d_ws, size_t ws_size, hipStream_t stream) {
    static int grid = 0;
    if (grid == 0) {
        if (n_in != 25 || in_sizes[0] != MX * D || out_size != MX * D || ws_size < WS_END) { fprintf(stderr, "kernel_launch: unexpected problem (n_in %d, in0 %d, out %d, ws %zu); nothing launched\n", n_in, n_in > 0 ? in_sizes[0] : -1, out_size, ws_size); grid = -1; return; }
        int dev = 0, cus = 0, per_cu = 0;
        if (hipGetDevice(&dev) != hipSuccess || hipDeviceGetAttribute(&cus, hipDeviceAttributeMultiprocessorCount, dev) != hipSuccess) { fprintf(stderr, "kernel_launch: device query failed\n"); grid = -1; return; }
        if (hipFuncSetAttribute((const void*)mk_fwd, hipFuncAttributeMaxDynamicSharedMemorySize, LDS_BYTES) != hipSuccess) { fprintf(stderr, "kernel_launch: hipFuncSetAttribute failed\n"); grid = -1; return; }
        if (hipOccupancyMaxActiveBlocksPerMultiprocessor(&per_cu, (const void*)mk_fwd, NWAVES * 64, LDS_BYTES) != hipSuccess || per_cu < 1) fprintf(stderr, "kernel_launch: occupancy query reports %d workgroups per CU\n", per_cu);
        (void)hipGetLastError();
        grid = cus;
        if (grid != 256) { fprintf(stderr, "kernel_launch: this build needs a 256-CU device (got %d); nothing launched\n", grid); grid = -1; return; }
    }
    if (grid < 0) return;
    if (hipMemsetAsync((char*)d_ws + WS_CTL, 0, CTL_ZERO_BYTES, stream) != hipSuccess) { fprintf(stderr, "kernel_launch: memset failed\n"); return; }
    Args a{};
    for (int i = 0; i < 25; ++i) a.in[i] = (const float*)d_in[i];
    a.out = (float*)d_out; a.ws = (unsigned char*)d_ws;
    if (MK_N_LAUNCHES == 1) { a.ph_lo = 0; a.ph_hi = NPH; hipLaunchKernelGGL(mk_fwd, dim3(grid), dim3(NWAVES * 64), LDS_BYTES, stream, a); }
    else for (int p = 0; p < NPH; ++p) { a.ph_lo = p; a.ph_hi = p + 1; hipLaunchKernelGGL(mk_fwd, dim3(grid), dim3(NWAVES * 64), LDS_BYTES, stream, a); }
    const hipError_t le = hipPeekAtLastError();
    if (le != hipSuccess) fprintf(stderr, "kernel_launch: launch failed: %s\n", hipGetErrorName(le));
}
```

```cpp
#include <hip/hip_runtime.h>
#include <cstdio>
#include <cstdint>
namespace pg8 {
#define PG8_LAS __attribute__((address_space(3)))
typedef unsigned short bf16_t;
typedef short bf16x8 __attribute__((ext_vector_type(8)));
typedef float f32x4 __attribute__((ext_vector_type(4)));
typedef unsigned u32x4 __attribute__((ext_vector_type(4)));
constexpr int BM = 256, BK = 64, HALF = 128, HTB = HALF * BK * 2  , STAGE_BYTES = 8 * HTB, NXCD = 8, WGM = 8;

__host__ __device__ __forceinline__ int lds_byte(int r, int c) { const int st = (r >> 4) * 2 + (c >> 5), rr = r & 15, cc = c & 31, ob = rr * 64 + cc * 2; return st * 1024 + (ob ^ (((ob >> 9) & 1) << 5)); }
__host__ __device__ __forceinline__ void stage_rc(int b, int& R, int& C) { const int st = b / 1024, sb = b % 1024, swz = sb ^ (((sb >> 9) & 1) << 5); R = (st >> 1) * 16 + swz / 64; C = (st & 1) * 32 + (swz % 64) / 2; }
__host__ __device__ __forceinline__ int perm32(int rho) { const int n = rho >> 4, i = rho & 15; return 8 * (i >> 2) + 4 * n + (i & 3); }

struct Unit { int pm, pn; };
struct Gemm { const bf16_t* A; const bf16_t* Bt; int M, N, K; };

struct StaticOrder {
    int nM, nN, nwg, G, c;
    __host__ __device__ void init(int M, int N, int G_, int c_) { nM = M / BM; nN = N / BM; nwg = nM * nN; G = G_; c = c_; }
    __host__ __device__ bool next(int i, Unit& u) const {
        const long L = (long)i * G + c; if (L >= nwg) return false;
        int wgid = (int)L; { const int q = nwg / NXCD, r = nwg % NXCD, xcd = wgid % NXCD, off = wgid / NXCD; wgid = (xcd < r ? xcd * (q + 1) : r * (q + 1) + (xcd - r) * q) + off; }
        const int nig = WGM * nN, gid = wgid / nig, fm = gid * WGM, gsz = (nM - fm) < WGM ? (nM - fm) : WGM;
        u.pm = fm + ((wgid % nig) % gsz); u.pn = (wgid % nig) / gsz; return true;
    }
    __device__ __forceinline__ void a_ready(const Unit&) const {}
    __device__ __forceinline__ void done(const Unit&) const {}
};

__device__ __forceinline__ unsigned cvt_pk_bf16(float lo, float hi) { unsigned r; asm volatile("v_cvt_pk_bf16_f32 %0, %1, %2" : "=v"(r) : "v"(lo), "v"(hi)); return r; }
typedef float f32x2 __attribute__((ext_vector_type(2)));
__device__ __forceinline__ f32x2 gelu_pk(f32x2 v) {
    const f32x2 av = __builtin_elementwise_abs(v), d = av * 0.2316418882f + 1.0f;
    f32x2 t; t.x = __builtin_amdgcn_rcpf(d.x); t.y = __builtin_amdgcn_rcpf(d.y);
    f32x2 q = t * 0.5307027145f + (-0.7265760135f); q = q * t + 0.7107068705f; q = q * t + (-0.142248368f); q = q * t + 0.127414796f; q = q * t;
    const f32x2 s = (v * v) * (-0.72134752044f);
    f32x2 e; e.x = __builtin_amdgcn_exp2f(s.x); e.y = __builtin_amdgcn_exp2f(s.y);
    const f32x2 m = v * (q * e), r = v - m;
    f32x2 o; o.x = v.x < 0.f ? m.x : r.x; o.y = v.y < 0.f ? m.y : r.y; return o;
}

template <int ACT  > struct EpiBf16 {
    static constexpr bool PERM = true, AFTER_DRAIN = false; static_assert(ACT == 0 || ACT == 1, "EpiBf16: ACT is 0 (none) or 1 (gelu_pk)");
    bf16_t* O; int ldc; const float* bias; int split_cols; size_t split_stride; float scale0;
    __device__ __forceinline__ void operator()(const f32x4 (&acc)[2][2][4][2], const Unit& u, int wr, int wc, int fr, int fq) const {
        const int row0 = u.pm * BM + wr * 64 + fr; int colt = u.pn * BM; bf16_t* base = O;
        float sc = 1.f; if (split_cols) { const int t = colt / split_cols; base += (size_t)t * split_stride; colt -= t * split_cols; if (t == 0) sc = scale0; }
        const int col0 = colt + wc * 32 + 8 * fq, bcol0 = u.pn * BM + wc * 32 + 8 * fq;
        f32x4 bv[2][2];
#pragma unroll
        for (int bj = 0; bj < 2; ++bj)
#pragma unroll
            for (int n = 0; n < 2; ++n) bv[bj][n] = bias ? *(const f32x4*)(bias + bcol0 + bj * HALF + 4 * n) : (f32x4){0.f, 0.f, 0.f, 0.f};
#pragma unroll
        for (int ai = 0; ai < 2; ++ai)
#pragma unroll
            for (int m = 0; m < 4; ++m) { bf16_t* rowp = base + (size_t)(row0 + ai * HALF + m * 16) * ldc + col0;
#pragma unroll
                for (int bj = 0; bj < 2; ++bj) { f32x4 v0 = acc[ai][bj][m][0] + bv[bj][0], v1 = acc[ai][bj][m][1] + bv[bj][1];
                    if (ACT == 1) { f32x2 a = gelu_pk((f32x2){v0[0], v0[1]}), b = gelu_pk((f32x2){v0[2], v0[3]}), c = gelu_pk((f32x2){v1[0], v1[1]}), d = gelu_pk((f32x2){v1[2], v1[3]});
                        v0 = (f32x4){a.x, a.y, b.x, b.y}; v1 = (f32x4){c.x, c.y, d.x, d.y}; }
                    v0 = v0 * sc; v1 = v1 * sc; u32x4 w; w.x = cvt_pk_bf16(v0[0], v0[1]); w.y = cvt_pk_bf16(v0[2], v0[3]); w.z = cvt_pk_bf16(v1[0], v1[1]); w.w = cvt_pk_bf16(v1[2], v1[3]);
                    *(u32x4*)(rowp + bj * HALF) = w; } }
    }
};

struct EpiF32 {
    static constexpr bool PERM = false, AFTER_DRAIN = false;
    float* C; int ldc;
    __device__ __forceinline__ void operator()(const f32x4 (&acc)[2][2][4][2], const Unit& u, int wr, int wc, int fr, int fq) const {
        const int row0 = u.pm * BM + wr * 64 + fr, col0 = u.pn * BM + wc * 32 + 4 * fq;
#pragma unroll
        for (int ai = 0; ai < 2; ++ai)
#pragma unroll
            for (int m = 0; m < 4; ++m) { float* rowp = C + (size_t)(row0 + ai * HALF + m * 16) * ldc + col0;
#pragma unroll
                for (int bj = 0; bj < 2; ++bj)
#pragma unroll
                    for (int n = 0; n < 2; ++n) *(f32x4*)(rowp + bj * HALF + n * 16) = acc[ai][bj][m][n]; }
    }
};
struct EpiProj {
    static constexpr bool PERM = true, AFTER_DRAIN = false;
    bf16_t* O; int ldc; int ncols;
    __device__ __forceinline__ void operator()(const f32x4 (&acc)[2][2][4][2], const Unit& u, int wr, int wc, int fr, int fq) const {
        const int row0 = u.pm * BM + wr * 64 + fr; const int col0 = u.pn * BM + wc * 32 + 8 * fq;
#pragma unroll
        for (int ai = 0; ai < 2; ++ai)
#pragma unroll
            for (int m = 0; m < 4; ++m) { bf16_t* rowp = O + (size_t)(row0 + ai * HALF + m * 16) * ldc + col0;
#pragma unroll
                for (int bj = 0; bj < 2; ++bj) { const f32x4 v0 = acc[ai][bj][m][0], v1 = acc[ai][bj][m][1];
                    u32x4 w; w.x = cvt_pk_bf16(v0[0], v0[1]); w.y = cvt_pk_bf16(v0[2], v0[3]); w.z = cvt_pk_bf16(v1[0], v1[1]); w.w = cvt_pk_bf16(v1[2], v1[3]);
                    if (col0 + bj * HALF < ncols) *(u32x4*)(rowp + bj * HALF) = w; } }
    }
};
template <class Epi, class Sched, bool ALIGN_EPI = false, bool SP2 = false>
__device__ __forceinline__ void gemm_phase(PG8_LAS unsigned char* lds, const Gemm g, const Sched& S, const Epi& E) {
    const int tid = threadIdx.x, wid = __builtin_amdgcn_readfirstlane(tid >> 6), lane = tid & 63, wr = wid >> 2, wc = wid & 3, fr = lane & 15, fq = lane >> 4;
    const int K = g.K, nt = K / BK;
    unsigned voffA[2], voffB[2];
#pragma unroll
    for (int i = 0; i < 2; ++i) { int R, C; stage_rc(tid * 16 + i * 8192, R, C); const int Rb = Epi::PERM ? ((R & ~31) + perm32(R & 31)) : R;
        voffA[i] = (unsigned)(R * K + C) * 2u; voffB[i] = (unsigned)(Rb * K + C) * 2u; }
    const size_t kstep = (size_t)(BK * 2);
    const size_t hstep = (size_t)HALF * K * 2;
    const size_t tstep = 2 * hstep;
    const unsigned ldsw = (unsigned)wid * 1024u;
    const int aoff = lds_byte(wr * 64 + fr, fq * 8), boff = lds_byte(wc * 32 + fr, fq * 8);
#define PG8_SA(b, h) (((b) * 2 + (h)) * HTB)
#define PG8_SB(b, h) ((4 + (b) * 2 + (h)) * HTB)
#define PG8_STAGE(bufoff, gbase, voff) do { _Pragma("unroll") for (int _i = 0; _i < 2; ++_i) \
        __builtin_amdgcn_global_load_lds((const unsigned*)((const char*)(gbase) + (voff)[_i]), (PG8_LAS unsigned*)(lds + (bufoff) + ldsw + _i * 8192), 16, 0, 0); } while (0)
#define PG8_LDA(dst, b, h) do { _Pragma("unroll") for (int m = 0; m < 4; ++m) _Pragma("unroll") for (int k = 0; k < 2; ++k) dst[m][k] = *(const PG8_LAS bf16x8*)(lds + PG8_SA(b, h) + aoff + m * 2048 + k * 1024); } while (0)
#define PG8_LDB(dst, b, h) do { _Pragma("unroll") for (int n = 0; n < 2; ++n) _Pragma("unroll") for (int k = 0; k < 2; ++k) dst[n][k] = *(const PG8_LAS bf16x8*)(lds + PG8_SB(b, h) + boff + n * 2048 + k * 1024); } while (0)
#define PG8_MMA(ai, bj, At, Bt) do { __builtin_amdgcn_s_setprio(1); _Pragma("unroll") for (int m = 0; m < 4; ++m) _Pragma("unroll") for (int n = 0; n < 2; ++n) _Pragma("unroll") for (int k = 0; k < 2; ++k) \
        acc[ai][bj][m][n] = __builtin_amdgcn_mfma_f32_16x16x32_bf16(Bt[n][k], At[m][k], acc[ai][bj][m][n], 0, 0, 0); __builtin_amdgcn_s_setprio(0); } while (0)
#define PG8_WAIT_V(n) asm volatile("s_waitcnt vmcnt(" #n ")" ::: "memory")
#define PG8_WAIT_L(n) asm volatile("s_waitcnt lgkmcnt(" #n ")" ::: "memory")
#define PG8_BAR __builtin_amdgcn_s_barrier()
#define PG8_SCHED __builtin_amdgcn_sched_barrier(0)
    Unit cur, nxt; int ui = 0;
    if (!S.next(0, cur)) return;
    f32x4 acc[2][2][4][2];
#pragma unroll
    for (int a = 0; a < 2; ++a)
#pragma unroll
        for (int b = 0; b < 2; ++b)
#pragma unroll
            for (int m = 0; m < 4; ++m)
#pragma unroll
                for (int n = 0; n < 2; ++n) acc[a][b][m][n] = (f32x4){0.f, 0.f, 0.f, 0.f};
    bf16x8 At[4][2], B0[2][2], B1[2][2];
    const char* cA = (const char*)g.A + (size_t)cur.pm * tstep; const char* cB = (const char*)g.Bt + (size_t)cur.pn * tstep;
    S.a_ready(cur);
    if constexpr (SP2) {
        PG8_STAGE(PG8_SB(0, 0), cB, voffB); PG8_STAGE(PG8_SB(0, 1), cB + hstep, voffB); PG8_STAGE(PG8_SA(0, 0), cA, voffA); PG8_STAGE(PG8_SA(0, 1), cA + hstep, voffA);
        if (wr == 1) PG8_BAR;
        PG8_WAIT_V(2); PG8_BAR;
        PG8_STAGE(PG8_SB(1, 0), cB + kstep, voffB); PG8_STAGE(PG8_SA(1, 0), cA + kstep, voffA); PG8_STAGE(PG8_SB(1, 1), cB + hstep + kstep, voffB);
        PG8_WAIT_V(6); PG8_BAR;
    } else {
        PG8_STAGE(PG8_SB(0, 0), cB, voffB); PG8_STAGE(PG8_SA(0, 0), cA, voffA); PG8_STAGE(PG8_SB(0, 1), cB + hstep, voffB); PG8_STAGE(PG8_SA(0, 1), cA + hstep, voffA);
        if (wr == 1) PG8_BAR;
        PG8_WAIT_V(4); PG8_BAR;
        PG8_STAGE(PG8_SB(1, 0), cB + kstep, voffB); PG8_STAGE(PG8_SA(1, 0), cA + kstep, voffA); PG8_STAGE(PG8_SB(1, 1), cB + hstep + kstep, voffB);
        PG8_WAIT_V(6); PG8_BAR;
    }
    for (;;) {
        const bool has_next = S.next(ui + 1, nxt);
        const char* nA = has_next ? (const char*)g.A + (size_t)nxt.pm * tstep : cA; const char* nB = has_next ? (const char*)g.Bt + (size_t)nxt.pn * tstep : cB;
        for (int t = 0; t < nt; t += 2) {
            const bool last = (t == nt - 2);
            const char* a1 = cA + (size_t)(t + 1) * kstep;
            const char* a2 = last ? nA : cA + (size_t)(t + 2) * kstep; const char* b2 = last ? nB : cB + (size_t)(t + 2) * kstep;
            const char* a3 = a2 + kstep; const char* b3 = b2 + kstep;
            if (last && has_next) S.a_ready(nxt);
            if constexpr (SP2) {
            PG8_LDB(B0, 0, 0); PG8_LDB(B1, 0, 1); PG8_SCHED; PG8_LDA(At, 0, 0); PG8_STAGE(PG8_SA(1, 1), a1 + hstep, voffA);
            PG8_WAIT_V(8); PG8_WAIT_L(0); PG8_BAR; PG8_MMA(0, 0, At, B0); PG8_MMA(0, 1, At, B1); PG8_BAR; PG8_SCHED;
            PG8_LDA(At, 0, 1); PG8_STAGE(PG8_SB(0, 0), b2, voffB); PG8_STAGE(PG8_SB(0, 1), b2 + hstep, voffB); PG8_STAGE(PG8_SA(0, 0), a2, voffA);
            PG8_WAIT_V(8); PG8_WAIT_L(0); PG8_BAR; PG8_MMA(1, 0, At, B0); PG8_MMA(1, 1, At, B1); PG8_BAR; PG8_SCHED;
            PG8_LDB(B0, 1, 0); PG8_LDB(B1, 1, 1); PG8_SCHED; PG8_LDA(At, 1, 0); PG8_STAGE(PG8_SA(0, 1), a2 + hstep, voffA);
            PG8_WAIT_V(8); PG8_WAIT_L(0); PG8_BAR; PG8_MMA(0, 0, At, B0); PG8_MMA(0, 1, At, B1); PG8_BAR; PG8_SCHED;
            PG8_LDA(At, 1, 1); PG8_STAGE(PG8_SB(1, 0), b3, voffB); PG8_STAGE(PG8_SB(1, 1), b3 + hstep, voffB); PG8_STAGE(PG8_SA(1, 0), a3, voffA);
            PG8_WAIT_V(8); PG8_WAIT_L(0); PG8_BAR; PG8_MMA(1, 0, At, B0); PG8_MMA(1, 1, At, B1); PG8_BAR; PG8_SCHED;
            } else {
            PG8_LDB(B0, 0, 0); PG8_SCHED; PG8_LDA(At, 0, 0); PG8_STAGE(PG8_SA(1, 1), a1 + hstep, voffA);
            PG8_WAIT_L(8); PG8_BAR; PG8_WAIT_L(0); PG8_MMA(0, 0, At, B0); PG8_BAR; PG8_SCHED;
            PG8_LDB(B1, 0, 1); PG8_STAGE(PG8_SB(0, 0), b2, voffB);
            PG8_BAR; PG8_WAIT_L(0); PG8_MMA(0, 1, At, B1); PG8_BAR;
            PG8_LDA(At, 0, 1); PG8_STAGE(PG8_SA(0, 0), a2, voffA);
            PG8_BAR; PG8_WAIT_L(0); PG8_MMA(1, 0, At, B0); PG8_BAR; PG8_SCHED;
            PG8_STAGE(PG8_SB(0, 1), b2 + hstep, voffB);
            PG8_WAIT_V(6); PG8_BAR; PG8_MMA(1, 1, At, B1); PG8_BAR;
            PG8_LDB(B0, 1, 0); PG8_SCHED; PG8_LDA(At, 1, 0); PG8_STAGE(PG8_SA(0, 1), a2 + hstep, voffA);
            PG8_WAIT_L(8); PG8_BAR; PG8_WAIT_L(0); PG8_MMA(0, 0, At, B0); PG8_BAR; PG8_SCHED;
            PG8_LDB(B1, 1, 1); PG8_STAGE(PG8_SB(1, 0), b3, voffB);
            PG8_BAR; PG8_WAIT_L(0); PG8_MMA(0, 1, At, B1); PG8_BAR;
            PG8_LDA(At, 1, 1); PG8_STAGE(PG8_SA(1, 0), a3, voffA);
            PG8_BAR; PG8_WAIT_L(0); PG8_MMA(1, 0, At, B0); PG8_BAR; PG8_SCHED;
            PG8_STAGE(PG8_SB(1, 1), b3 + hstep, voffB);
            PG8_WAIT_V(6); PG8_BAR; PG8_MMA(1, 1, At, B1); PG8_BAR;
            }
        }
        if constexpr (ALIGN_EPI) { if (wr == 0) PG8_BAR; }
        if constexpr (!Epi::AFTER_DRAIN) { E(acc, cur, wr, wc, fr, fq); S.done(cur); }
        if (!has_next) break;
#pragma unroll
        for (int a = 0; a < 2; ++a)
#pragma unroll
            for (int b = 0; b < 2; ++b)
#pragma unroll
                for (int m = 0; m < 4; ++m)
#pragma unroll
                    for (int n = 0; n < 2; ++n) acc[a][b][m][n] = (f32x4){0.f, 0.f, 0.f, 0.f};
        cur = nxt; cA = nA; cB = nB; ++ui;
        if constexpr (ALIGN_EPI) { if (wr == 1) PG8_BAR; }
    }
    PG8_WAIT_V(0);
    if constexpr (!ALIGN_EPI) { if (wr == 0) PG8_BAR; }
    PG8_BAR;
    if constexpr (Epi::AFTER_DRAIN) { E.fused(acc, cur, wr, wc, fr, fq, lds, wid, lane); S.done(cur); }
#undef PG8_SA
#undef PG8_SB
#undef PG8_STAGE
#undef PG8_LDA
#undef PG8_LDB
#undef PG8_MMA
#undef PG8_WAIT_V
#undef PG8_WAIT_L
#undef PG8_BAR
#undef PG8_SCHED
}
}
#ifndef PG8_SP2
#define PG8_SP2 true
#endif
#ifndef PG8_ALIGN
#define PG8_ALIGN true
#endif
constexpr int NWAVES = 8;
constexpr int D = 1024, NB = 4, T = 4096, TC = 256;
constexpr int MX = NB * T, MC = NB * TC, MA = MX + MC;
constexpr int NPROJ = 3456, NPROJ_PAD = 3584;
constexpr int COL_XB = 0, COL_XG = 512, COL_XC = 1024, COL_R = 1536, COL_K = 2048, COL_V = 2560, COL_G = 3072, COL_LW = 3200, COL_LA = 3328;
constexpr int NMOD = 6 * D;
constexpr int NEXP = 16384, NSC = 2048;
constexpr float NORM_EPS = 1e-6f, LNX_EPS = 64e-5f;
#ifndef MK_N_LAUNCHES
#define MK_N_LAUNCHES 1
#endif
constexpr int NPH = 13;
constexpr size_t MiB = 1u << 20;
constexpr size_t WS_CTL = 0, CTL_ZERO_BYTES = 64 * 1024;
constexpr size_t WS_MOD = 3 * MiB;
constexpr size_t WS_ZS = 4 * MiB;
constexpr size_t WS_WINT = 6 * MiB;
constexpr size_t WS_WOUTT = 13 * MiB;
constexpr size_t WS_WEFFT = 15 * MiB;
constexpr size_t WS_GWT = 19 * MiB;
constexpr size_t WS_U = 20 * MiB, WS_V = 52 * MiB;
constexpr size_t WS_HX = 84 * MiB;
constexpr size_t WS_PROJ = 118 * MiB;
constexpr size_t WS_END = 246 * MiB;
constexpr size_t WS_EXL = WS_V, WS_GL = WS_V + 4 * MiB, WS_PL = WS_V + 12 * MiB;
constexpr size_t WS_BLOB0 = 36 * MiB, WS_BLOB1 = 77 * MiB;
constexpr size_t WS_PART = WS_PROJ, WS_PO = WS_PROJ + 64 * MiB;
static_assert(WS_PROJ + (size_t)MA * NPROJ * 2 <= WS_END && WS_PROJ + (size_t)MX * NSC * 4 <= WS_END && WS_HX + (size_t)MA * D * 2 <= WS_PROJ, "d_ws map");
constexpr int CW_BAR = 1024;
constexpr int RING_BYTES = 131072;
constexpr int LDSCTL_OFF = 155648, MISC_OFF = LDSCTL_OFF + 320;
constexpr int LDS_BYTES = 163840;

#define GAS __attribute__((address_space(1)))
#define LAS __attribute__((address_space(3)))
typedef unsigned short bf16;
typedef unsigned v4u __attribute__((ext_vector_type(4)));
typedef unsigned v2u __attribute__((ext_vector_type(2)));
typedef float f32x4 __attribute__((ext_vector_type(4)));
typedef float f32x2 __attribute__((ext_vector_type(2)));
typedef float f32x16 __attribute__((ext_vector_type(16)));
typedef short bf16x8 __attribute__((ext_vector_type(8)));
typedef GAS unsigned gu32;
#define RLX_AGENT __ATOMIC_RELAXED, __HIP_MEMORY_SCOPE_AGENT
#define LDS_WAIT() asm volatile("s_waitcnt lgkmcnt(0)" ::: "memory")
#define VM_WAIT() asm volatile("s_waitcnt vmcnt(0)" ::: "memory")
typedef __bf16 bf16v2 __attribute__((ext_vector_type(2)));
__device__ __forceinline__ unsigned pk2(float lo, float hi) { const f32x2 v = {lo, hi}; return __builtin_bit_cast(unsigned, __builtin_convertvector(v, bf16v2)); }
__device__ __forceinline__ float bf_lo(unsigned w) { return __builtin_bit_cast(float, w << 16); }
__device__ __forceinline__ float bf_hi(unsigned w) { return __builtin_bit_cast(float, w & 0xffff0000u); }
__device__ __forceinline__ float bf1(bf16 b) { return __builtin_bit_cast(float, (unsigned)b << 16); }
__device__ __forceinline__ float fast_exp(float x) { return __builtin_amdgcn_exp2f(x * 1.44269504089f); }
__device__ __forceinline__ float fast_rcp(float x) { return __builtin_amdgcn_rcpf(x); }
__device__ __forceinline__ float sigmoidf(float x) { return fast_rcp(1.f + fast_exp(-x)); }
__device__ __forceinline__ float tanh_fast(float x) { return 1.f - 2.f * fast_rcp(fast_exp(2.f * x) + 1.f); }
__device__ __forceinline__ float siluf(float x) { return x * sigmoidf(x); }
template <int CTRL> __device__ __forceinline__ float dppf(float x) { return __builtin_bit_cast(float, __builtin_amdgcn_update_dpp(0, __builtin_bit_cast(int, x), CTRL, 0xF, 0xF, false)); }
template <int CTRL> __device__ __forceinline__ unsigned dppu(unsigned x) { return (unsigned)__builtin_amdgcn_update_dpp(0, (int)x, CTRL, 0xF, 0xF, false); }
__device__ __forceinline__ float rowsum16(float x) { x += dppf<0xB1>(x); x += dppf<0x4E>(x); x += dppf<0x141>(x); x += dppf<0x140>(x); return x; }
__device__ __forceinline__ float wave_sum(float v) {
    v = rowsum16(v); v += __shfl_xor(v, 16); v += __shfl_xor(v, 32); return v;
}
__device__ __forceinline__ float half_sum32(float v) { v = rowsum16(v); v += __shfl_xor(v, 16); return v; }
__device__ __forceinline__ unsigned umaxu(unsigned a, unsigned b) { return a > b ? a : b; }
__device__ __forceinline__ unsigned wave_max_u32(unsigned x) {
    x = umaxu(x, dppu<0xB1>(x)); x = umaxu(x, dppu<0x4E>(x)); x = umaxu(x, dppu<0x141>(x)); x = umaxu(x, dppu<0x140>(x));
    const unsigned a = __builtin_amdgcn_readlane((int)x, 0), b = __builtin_amdgcn_readlane((int)x, 16), c = __builtin_amdgcn_readlane((int)x, 32), d = __builtin_amdgcn_readlane((int)x, 48);
    return umaxu(umaxu(a, b), umaxu(c, d));
}
__device__ __forceinline__ unsigned f2key(float f) { const unsigned u = __builtin_bit_cast(unsigned, f); return (u & 0x80000000u) ? ~u : (u | 0x80000000u); }
__device__ __forceinline__ float key2f(unsigned k) { const unsigned u = (k & 0x80000000u) ? (k ^ 0x80000000u) : ~k; return __builtin_bit_cast(float, u); }
#define XB_TMO      128
#define XB_XCNT(j)  (256  + 64 * (j))
#define XB_XSUB(j)  (1280 + 64 * (j))
#define XB_XGEN(j)  (2304 + 64 * (j))
#define XB_TOP      3328
#define XB_TOPGEN   3392
#define XCD_BAR_WORDS 3456
#define XB_SPIN_CAP (1u << 18)

__device__ __forceinline__ unsigned xb_ld(unsigned* p)              { return __hip_atomic_load(p, __ATOMIC_RELAXED, __HIP_MEMORY_SCOPE_AGENT); }
__device__ __forceinline__ unsigned xb_add(unsigned* p, unsigned v) { return __hip_atomic_fetch_add(p, v, __ATOMIC_RELAXED, __HIP_MEMORY_SCOPE_AGENT); }
__device__ __forceinline__ unsigned xb_xcc_id() { return (unsigned)__builtin_amdgcn_s_getreg((3 << 11) | 20) & 0xFu; }
#define XB_SPIN(cond, bar) do { unsigned _sp = 0; while (cond) { __builtin_amdgcn_s_sleep(1); \
    if ((++_sp & 255u) == 0u) { if (xb_ld(&(bar)[XB_TMO])) break; if (_sp > XB_SPIN_CAP) { atomicAdd(&(bar)[XB_TMO], 1u); break; } } } } while (0)

struct XcdBarrier {
    unsigned* bar; unsigned x;
    volatile LAS unsigned* st;
};

__device__ __forceinline__ XcdBarrier xcd_barrier_post(unsigned* bar, volatile LAS unsigned* st) {
    XcdBarrier b; b.bar = bar; b.x = xb_xcc_id(); b.st = st;
    if (threadIdx.x == 0) (void)xb_add(&bar[XB_XCNT(b.x)], 1u);
    return b;
}
__device__ __forceinline__ void xcd_barrier_complete(unsigned* bar, unsigned x, unsigned& nloc, unsigned& nx) {
    const unsigned G = gridDim.x * gridDim.y * gridDim.z;
    unsigned sum, cnt, mine, sp = 0u;
    for (;;) {
        sum = 0u; cnt = 0u; mine = 0u;
#pragma unroll
        for (unsigned j = 0; j < 16; ++j) { const unsigned c = xb_ld(&bar[XB_XCNT(j)]); sum += c; cnt += (c > 0u) ? 1u : 0u; mine = (j == x) ? c : mine; }
        if (sum == G) break;
        __builtin_amdgcn_s_sleep(1);
        if ((++sp & 255u) == 0u) { if (xb_ld(&bar[XB_TMO])) break; if (sp > XB_SPIN_CAP) { atomicAdd(&bar[XB_TMO], 1u); break; } }
    }
    nloc = mine > 0u ? mine : 1u; nx = cnt > 0u ? cnt : 1u;
}

__device__ __forceinline__ void xcd_barrier(const XcdBarrier& b) {
    asm volatile("s_waitcnt vmcnt(0)" ::: "memory");
    __syncthreads();
    if (threadIdx.x == 0) {
        unsigned* bar = b.bar;
        __builtin_amdgcn_s_waitcnt(0);
        unsigned nloc = b.st[0], nx = b.st[1];
        if (nloc == 0u) { xcd_barrier_complete(bar, b.x, nloc, nx); b.st[0] = nloc; b.st[1] = nx; }
        const unsigned old = xb_add(&bar[XB_XSUB(b.x)], 1u);
        const unsigned gen = old / nloc;
        if (old + 1u == (gen + 1u) * nloc) {
            __builtin_amdgcn_fence(__ATOMIC_RELEASE, "agent");
            asm volatile("s_waitcnt vmcnt(0)" ::: "memory");
            const unsigned og = xb_add(&bar[XB_TOP], 1u);
            const unsigned tg = og / nx;
            if (og + 1u == (tg + 1u) * nx) xb_add(&bar[XB_TOPGEN], 1u);
            else XB_SPIN(xb_ld(&bar[XB_TOPGEN]) == tg, bar);
            __builtin_amdgcn_fence(__ATOMIC_ACQUIRE, "agent");
            xb_add(&bar[XB_XGEN(b.x)], 1u);
            asm volatile("s_waitcnt vmcnt(0)" ::: "memory");
        } else {
            XB_SPIN(xb_ld(&bar[XB_XGEN(b.x)]) == gen, bar);
            __builtin_amdgcn_fence(__ATOMIC_ACQUIRE, "agent");
            asm volatile("s_waitcnt vmcnt(0)" ::: "memory");
        }
    }
    __syncthreads();
}
__device__ __forceinline__ void flat_barrier(unsigned* w, unsigned G) {
    asm volatile("s_waitcnt vmcnt(0)" ::: "memory");
    __syncthreads();
    if (threadIdx.x == 0) {
        __builtin_amdgcn_fence(__ATOMIC_RELEASE, "agent");
        asm volatile("s_waitcnt vmcnt(0)" ::: "memory");
        const unsigned old = __hip_atomic_fetch_add(w, 1u, __ATOMIC_RELAXED, __HIP_MEMORY_SCOPE_AGENT);
        const unsigned gen = old / G;
        if (old + 1u == (gen + 1u) * G) __hip_atomic_fetch_add(w + 64, 1u, __ATOMIC_RELAXED, __HIP_MEMORY_SCOPE_AGENT);
        else { unsigned sp = 0; while (__hip_atomic_load(w + 64, __ATOMIC_RELAXED, __HIP_MEMORY_SCOPE_AGENT) == gen) { __builtin_amdgcn_s_sleep(1); if (++sp > (1u << 22)) break; } }
        __builtin_amdgcn_fence(__ATOMIC_ACQUIRE, "agent");
        asm volatile("s_waitcnt vmcnt(0)" ::: "memory");
    }
    __syncthreads();
}
struct Frame {
    LAS unsigned char* lds;
    volatile LAS unsigned* MISC;
    gu32* ctl;
    int tid, lane, wave, G, bid;
    const float* in[25];
    float* out;
    unsigned char* ws;
};
enum { I_X = 0, I_C, I_CTX, I_CCTX, I_WMOD, I_BMOD, I_NG, I_WIN, I_WOUT, I_CONVW, I_TMU, I_DW0, I_DW2, I_A0, I_A2, I_GW2, I_KK, I_KA, I_RK, I_LNG, I_LNB, I_WQ, I_SUBK, I_PU, I_PV };

__device__ __forceinline__ void p0_transpose_item(const float* W, int K, int N, bf16* WT, LAS float* scr, int item, int lane) {
    const int nblk = N / 32, kb = item / nblk, nb = item % nblk, k0 = 64 * kb, n0 = 32 * nb;
#pragma unroll 8
    for (int i = 0; i < 32; ++i) { const int kk = 2 * i + (lane >> 5); scr[kk * 33 + (lane & 31)] = W[(size_t)(k0 + kk) * N + n0 + (lane & 31)]; }
    LDS_WAIT(); asm volatile("" ::: "memory");
    const int c = lane & 7;
#pragma unroll
    for (int j = 0; j < 4; ++j) { const int n = (lane >> 3) + 8 * j; const LAS float* s = scr + (8 * c) * 33 + n;
        v4u o; o.x = pk2(s[0 * 33], s[1 * 33]); o.y = pk2(s[2 * 33], s[3 * 33]); o.z = pk2(s[4 * 33], s[5 * 33]); o.w = pk2(s[6 * 33], s[7 * 33]);
        *(v4u*)(WT + (size_t)(n0 + n) * K + k0 + 8 * c) = o; }
    LDS_WAIT(); asm volatile("" ::: "memory");
}
__device__ __forceinline__ void p0_mod_item(Frame& F, int cb) {
    LAS float* S = (LAS float*)F.lds;
    LAS float* RED = (LAS float*)(F.lds + 32768);
    const float* c = F.in[I_C]; const float* cc = F.in[I_CCTX];
    for (int i = F.tid; i < 5 * D; i += 512) { const int r = i >> 10, k = i & 1023; const float v = (r < 4) ? c[r * D + k] : cc[k]; S[i] = siluf(v); }
    __syncthreads();
    const int col = F.tid & 63, kg = F.tid >> 6;
    const float* wp = F.in[I_WMOD] + (size_t)(kg * 128) * NMOD + cb * 64 + col;
    float a0 = 0.f, a1 = 0.f, a2 = 0.f, a3 = 0.f, a4 = 0.f;
#pragma unroll 8
    for (int k = 0; k < 128; ++k) { const float w = wp[(size_t)k * NMOD]; const int kk = kg * 128 + k;
        a0 += S[kk] * w; a1 += S[D + kk] * w; a2 += S[2 * D + kk] * w; a3 += S[3 * D + kk] * w; a4 += S[4 * D + kk] * w; }
    RED[(kg * 5 + 0) * 64 + col] = a0; RED[(kg * 5 + 1) * 64 + col] = a1; RED[(kg * 5 + 2) * 64 + col] = a2; RED[(kg * 5 + 3) * 64 + col] = a3; RED[(kg * 5 + 4) * 64 + col] = a4;
    __syncthreads();
    if (F.tid < 320) { const int r = F.tid >> 6, cl = F.tid & 63; float s = F.in[I_BMOD][cb * 64 + cl];
#pragma unroll
        for (int g = 0; g < 8; ++g) s += RED[(g * 5 + r) * 64 + cl];
        ((float*)(F.ws + WS_MOD))[r * NMOD + cb * 64 + cl] = s; }
    __syncthreads();
}
__device__ __forceinline__ void p0_weff_item(Frame& F, int item) {
    const int hs = item >> 4, kb = item & 15;
    LAS float* SK = (LAS float*)F.lds;
    LAS float* WQ = (LAS float*)(F.lds + 128 * 132 * 4);
    const float* sk = F.in[I_SUBK] + (size_t)hs * 128 * 128;
    const float* wq = F.in[I_WQ] + (size_t)(kb * 64) * 2048 + hs * 128;
#pragma unroll
    for (int i = 0; i < 8; ++i) { const int idx = F.tid + 512 * i, row = idx >> 5, c4 = idx & 31; const f32x4 v = *(const f32x4*)(sk + row * 128 + c4 * 4); *(LAS f32x4*)(SK + row * 132 + c4 * 4) = v; }
#pragma unroll
    for (int i = 0; i < 4; ++i) { const int idx = F.tid + 512 * i, row = idx >> 5, c4 = idx & 31; const f32x4 v = *(const f32x4*)(wq + (size_t)row * 2048 + c4 * 4); *(LAS f32x4*)(WQ + row * 132 + c4 * 4) = v; }
    __syncthreads();
    const int key = F.tid >> 2, kq = F.tid & 3;
    float acc[16];
#pragma unroll
    for (int i = 0; i < 16; ++i) acc[i] = 0.f;
    for (int d = 0; d < 128; d += 4) {
        const f32x4 a = *(const LAS f32x4*)(SK + key * 132 + d);
#pragma unroll
        for (int i = 0; i < 16; ++i) { const f32x4 b = *(const LAS f32x4*)(WQ + (4 * i + kq) * 132 + d); acc[i] += a.x * b.x + a.y * b.y + a.z * b.z + a.w * b.w; }
    }
    bf16* dst = (bf16*)(F.ws + WS_WEFFT) + (size_t)(hs * 128 + key) * D + kb * 64;
#pragma unroll
    for (int i = 0; i < 16; ++i) dst[4 * i + kq] = (bf16)(pk2(acc[i], 0.f) & 0xffffu);
    __syncthreads();
}
__device__ __forceinline__ void p0_prep(Frame& F) {
    for (int it = F.bid; it < 96 + 256; it += F.G) { if (it < 96) p0_mod_item(F, it); else p0_weff_item(F, it - 96); }
    LAS float* scr = (LAS float*)(F.lds + F.wave * 16384);
    const int gw = F.bid * NWAVES + F.wave, NGW = F.G * NWAVES;
    constexpr int I_IN = (D / 64) * (NPROJ / 32), I_OUT = (D / 64) * (D / 32), I_GW = (128 / 64) * (512 / 32);
    for (int it = gw; it < I_IN + I_OUT + I_GW; it += NGW) {
        if (it < I_IN) p0_transpose_item(F.in[I_WIN], D, NPROJ, (bf16*)(F.ws + WS_WINT), scr, it, F.lane);
        else if (it < I_IN + I_OUT) p0_transpose_item(F.in[I_WOUT], D, D, (bf16*)(F.ws + WS_WOUTT), scr, it - I_IN, F.lane);
        else p0_transpose_item(F.in[I_GW2], 128, 512, (bf16*)(F.ws + WS_GWT), scr, it - I_IN - I_OUT, F.lane);
    }
    { v4u* z = (v4u*)((bf16*)(F.ws + WS_WINT) + (size_t)NPROJ * D); const int n16 = (NPROJ_PAD - NPROJ) * D * 2 / 16;
      for (int i = F.bid * 512 + F.tid; i < n16; i += F.G * 512) z[i] = (v4u){0u, 0u, 0u, 0u}; }
    { const f32x4* pu = (const f32x4*)F.in[I_PU]; v2u* du = (v2u*)(F.ws + WS_U);
      const int n8 = NEXP * D / 8;
      for (int i = F.bid * 512 + F.tid; i < n8; i += F.G * 512) {
          const f32x4 a0 = pu[2 * i] * 32.f, a1 = pu[2 * i + 1] * 32.f;
          int w0 = __builtin_amdgcn_cvt_pk_fp8_f32(a0.x, a0.y, 0, false); w0 = __builtin_amdgcn_cvt_pk_fp8_f32(a0.z, a0.w, w0, true);
          int w1 = __builtin_amdgcn_cvt_pk_fp8_f32(a1.x, a1.y, 0, false); w1 = __builtin_amdgcn_cvt_pk_fp8_f32(a1.z, a1.w, w1, true);
          du[i] = (v2u){(unsigned)w0, (unsigned)w1}; } }
}

__device__ __forceinline__ void p1_hx(Frame& F) {
    const float* mod = (const float*)(F.ws + WS_MOD); const float* ng = F.in[I_NG];
    bf16* hx = (bf16*)(F.ws + WS_HX);
    for (int m = F.bid * NWAVES + F.wave; m < MA; m += F.G * NWAVES) {
        const float* src = (m < MX) ? F.in[I_X] + (size_t)m * D : F.in[I_CTX] + (size_t)(m - MX) * D;
        const float* mr = mod + ((m < MX) ? (m >> 12) : 4) * NMOD;
        f32x4 v[4]; float ss = 0.f;
#pragma unroll
        for (int j = 0; j < 4; ++j) { v[j] = *(const f32x4*)(src + j * 256 + F.lane * 4); ss += v[j].x * v[j].x + v[j].y * v[j].y + v[j].z * v[j].z + v[j].w * v[j].w; }
        const float rstd = __builtin_amdgcn_rsqf(wave_sum(ss) * (1.f / D) + NORM_EPS);
#pragma unroll
        for (int j = 0; j < 4; ++j) { const int c = j * 256 + F.lane * 4;
            const f32x4 g = *(const f32x4*)(ng + c), sh = *(const f32x4*)(mr + c), sc = *(const f32x4*)(mr + D + c);
            const float o0 = v[j].x * rstd * g.x * (1.f + sc.x) + sh.x, o1 = v[j].y * rstd * g.y * (1.f + sc.y) + sh.y, o2 = v[j].z * rstd * g.z * (1.f + sc.z) + sh.z, o3 = v[j].w * rstd * g.w * (1.f + sc.w) + sh.w;
            *(v2u*)(hx + (size_t)m * D + c) = (v2u){pk2(o0, o1), pk2(o2, o3)}; }
    }
}
constexpr int BL_APT = 0, BL_NPT = 4608, BL_RH = 7168, BL_MKR = 11776, BL_MBR = 14336, BL_KGC = 16896, BL_BGC = 22016, BL_GC = 27136, BL_VT = 27648, BL_BYTES = 32768;
constexpr int HSZ = 66048;
constexpr int CS_RAW = 0, CS_TLW = 13056, CS_LOA = 17664, CS_LG = 22272, CS_NBA = 32768, CS_AH = 38912, CS_BH = 43520, CS_KH = 48128, CS_AHC = 52736, CS_E = 57856, CS_NKA = 57856, CS_TT = 60416;
constexpr int CS_CONST = 2 * HSZ, CS_W2T = CS_CONST + 2560, CS_A2T = CS_W2T + 9216, CS_END = CS_A2T + 9216;
static_assert(CS_END <= LDSCTL_OFF, "scan prep LDS map");
constexpr int CS_RH = BL_RH, CS_KGC = BL_KGC, CS_BGC = BL_BGC, CS_VT = BL_VT, CS_GC = BL_GC, CS_APT = BL_APT, CS_NPT = BL_NPT, CS_MKR = BL_MKR, CS_MBR = BL_MBR;
constexpr int SC_NTILE = (TC + T) / 32, SC_RT = 18, SC_NROUND = (SC_NTILE + SC_RT - 1) / SC_RT;
constexpr int SC_ST = 1;
constexpr int GS_YS = 65536;
__device__ __forceinline__ void scan_issue_loads(const bf16* proj, int b, int h, int d, int tile, int tid, v4u (&rg)[3]) {
    const bool isctx = tile < TC / 32; const int L = isctx ? TC : T; const int jt = isctx ? tile : tile - TC / 32;
    const unsigned rowbase = isctx ? (unsigned)(MX + b * TC) : (unsigned)(b * T);
    const int tlo = d == 0 ? 32 * jt : L - 32 * (jt + 1);
    const unsigned char* base = (const unsigned char*)proj;
#pragma unroll
    for (int i = 0; i < 3; ++i) {
        const unsigned q = (unsigned)tid + 512u * i;
        const unsigned row = (q * 2731u) >> 16, rem = q - row * 24u;
        int tok = tlo - 1 + (int)row; tok = tok < 0 ? 0 : (tok >= L ? L - 1 : tok);
        const unsigned q2 = (q - 816u) & 511u, row2 = q2 >> 4, rem2 = q2 & 15u;
        const unsigned offA = (rowbase + (unsigned)tok) * (NPROJ * 2u) + (COL_R + (rem >> 3) * 512u + h * 64u + (rem & 7u) * 8u) * 2u;
        const unsigned offB = (rowbase + (unsigned)tlo + row2) * (NPROJ * 2u) + (((rem2 >> 3) ? COL_LA : COL_LW) + d * 64u + (rem2 & 7u) * 8u) * 2u;
        rg[i] = *(const v4u*)(base + (q < 816u ? offA : offB));
    }
}
__device__ __forceinline__ unsigned tanh_pk(unsigned w) { return pk2(tanh_fast(bf_lo(w)), tanh_fast(bf_hi(w))); }
__device__ __forceinline__ void scan_store_raw(LAS unsigned char* lds, int tid, int d, int tile, const v4u (&rg)[3]) {
    const bool isctx = tile < TC / 32; const int L = isctx ? TC : T; const int jt = isctx ? tile : tile - TC / 32;
    const int tlo = d == 0 ? 32 * jt : L - 32 * (jt + 1);
#pragma unroll
    for (int i = 0; i < 3; ++i) {
        const int q = tid + 512 * i;
        if (q < 816) { const int row = q / 24, rem = q - row * 24, which = rem >> 3, ch8 = rem & 7; const int tok = tlo - 1 + row;
            *(LAS v4u*)(lds + CS_RAW + (which * 34 + row) * 128 + ch8 * 16) = (tok >= 0 && tok < L) ? rg[i] : (v4u){0u, 0u, 0u, 0u}; }
        else if (q < 1328) { const int q2 = q - 816, row = q2 >> 4, rem = q2 & 15, which = rem >> 3, ch8 = rem & 7;
            if (which) *(LAS v4u*)(lds + CS_LOA + row * 144 + ch8 * 16) = rg[i];
            else { v4u t; t.x = tanh_pk(rg[i].x); t.y = tanh_pk(rg[i].y); t.z = tanh_pk(rg[i].z); t.w = tanh_pk(rg[i].w); *(LAS v4u*)(lds + CS_TLW + row * 144 + ch8 * 16) = t; } }
    }
}
__device__ __forceinline__ int cmsw(int row) { return ((row >> 2) ^ (row >> 4)) & 3; }
__device__ __forceinline__ v2u pack4(f32x4 v) { return (v2u){pk2(v.x, v.y), pk2(v.z, v.w)}; }
__device__ __forceinline__ bf16 bfs(float v) { return (bf16)(pk2(v, 0.f) & 0xffffu); }
typedef v2u v2u_t;
__device__ __forceinline__ bf16x8 frag2(const LAS unsigned char* p0, const LAS unsigned char* p1) {
    const v2u a = *(const LAS v2u*)p0, b = *(const LAS v2u*)p1; const v4u w = (v4u){a.x, a.y, b.x, b.y}; return __builtin_bit_cast(bf16x8, w);
}
__device__ __forceinline__ bf16x8 frag_acc(f32x4 lo, f32x4 hi) { const v4u w = (v4u){pk2(lo.x, lo.y), pk2(lo.z, lo.w), pk2(hi.x, hi.y), pk2(hi.z, hi.w)}; return __builtin_bit_cast(bf16x8, w); }
__device__ __forceinline__ bf16x8 frag_zero() { const v4u w = (v4u){0u, 0u, 0u, 0u}; return __builtin_bit_cast(bf16x8, w); }
__device__ __forceinline__ void scan_prep_pair(Frame& F, const bf16* proj, int chain, int tile0, bool two, bool load_consts, bool have_next, int ntile0, bool ntwo, v4u (&rg)[6], unsigned char* blob0) {
    LAS unsigned char* lds = F.lds; int tid = F.tid; asm volatile("" : "+v"(tid));
    const int lane = tid & 63, wave = F.wave, wl = wave & 3, ts = wave >> 2;
    const int b = chain >> 4, h = (chain >> 1) & 7, d = chain & 1;
    const bool act = ts == 0 || two;
    if (load_consts) {
        __syncthreads();
        LAS float* C = (LAS float*)(lds + CS_CONST);
        if (tid < 384) { const int pn = tid / 192, r = tid - pn * 192, which = r >> 6, c = r & 63; C[pn * 192 + which * 64 + c] = F.in[I_TMU][(pn * 3 + which) * 512 + h * 64 + c]; }
        else if (tid < 448) { const int c = tid - 384; C[384 + c] = F.in[I_KK][h * 64 + c]; C[448 + c] = F.in[I_KA][h * 64 + c]; }
        else { const int c = tid - 448; C[512 + c] = F.in[I_DW0][d * 512 + h * 64 + c]; C[576 + c] = F.in[I_A0][d * 512 + h * 64 + c]; }
        const float* w2 = F.in[I_DW2] + (size_t)d * 64 * 512 + h * 64; const float* a2 = F.in[I_A2] + (size_t)d * 64 * 512 + h * 64;
        float wv[8], av[8];
#pragma unroll
        for (int i = 0; i < 8; ++i) { const int idx = tid + 512 * i, j = idx >> 6, c = idx & 63; wv[i] = w2[j * 512 + c]; av[i] = a2[j * 512 + c]; }
#pragma unroll
        for (int i = 0; i < 8; ++i) { const int idx = tid + 512 * i, j = idx >> 6, c = idx & 63;
            *(LAS bf16*)(lds + CS_W2T + c * 144 + j * 2) = bfs(wv[i]);
            *(LAS bf16*)(lds + CS_A2T + c * 144 + j * 2) = bfs(av[i]); }
    }
    { const v4u r0[3] = {rg[0], rg[1], rg[2]}; scan_store_raw(lds, tid, d, tile0, r0); }
    if (two) { const v4u r1[3] = {rg[3], rg[4], rg[5]}; scan_store_raw(lds + HSZ, tid, d, tile0 + 1, r1); }
    __syncthreads();
    { LAS unsigned char* hl = lds + ts * HSZ;
            if (act) {
                const int mat = wl >> 1, nt = wl & 1, r = lane & 31, hh = lane >> 5;
                const LAS unsigned char* Ab = hl + (mat ? CS_LOA : CS_TLW) + r * 144 + hh * 16;
                const LAS unsigned char* Bb = lds + (mat ? CS_A2T : CS_W2T) + (nt * 32 + r) * 144 + hh * 16;
                f32x16 acc;
#pragma unroll
                for (int i = 0; i < 16; ++i) acc[i] = 0.f;
#pragma unroll
                for (int ks = 0; ks < 4; ++ks) { const bf16x8 a = *(const LAS bf16x8*)(Ab + ks * 32), bb = *(const LAS bf16x8*)(Bb + ks * 32); acc = __builtin_amdgcn_mfma_f32_32x32x16_bf16(a, bb, acc, 0, 0, 0); }
                LAS float* LG = (LAS float*)(hl + CS_LG) + mat * 2048 + nt * 32 + r;
#pragma unroll
                for (int i = 0; i < 16; ++i) LG[((i & 3) + 8 * (i >> 2) + 4 * hh) * 64] = acc[i];
            }
    }
    __syncthreads();
    const int tok = tid >> 4, cq = tid & 15, c0 = cq * 4, s = d == 0 ? tok : 31 - tok;
    f32x4 rs, vs, kd, kk, kka, ev;
    { LAS unsigned char* hl = lds;
            { const LAS float* C = (const LAS float*)(lds + CS_CONST);
              v2u rp_[3], rx_[3], rn_[3]; f32x4 mp_[3], mn_[3];
#pragma unroll
              for (int which = 0; which < 3; ++which) {
                  const LAS unsigned char* rp = hl + CS_RAW + (which * 34 + tok) * 128 + c0 * 2;
                  rp_[which] = *(const LAS v2u*)rp; rx_[which] = *(const LAS v2u*)(rp + 128); rn_[which] = *(const LAS v2u*)(rp + 256);
                  mp_[which] = *(const LAS f32x4*)(C + which * 64 + c0); mn_[which] = *(const LAS f32x4*)(C + 192 + which * 64 + c0); }
              const f32x4 kkc = *(const LAS f32x4*)(C + 384 + c0), kac = *(const LAS f32x4*)(C + 448 + c0), w0 = *(const LAS f32x4*)(C + 512 + c0), a0 = *(const LAS f32x4*)(C + 576 + c0);
              const f32x4 lgw = *(const LAS f32x4*)(hl + CS_LG + (tok * 64 + c0) * 4), lga = *(const LAS f32x4*)(hl + CS_LG + 8192 + (tok * 64 + c0) * 4);
              asm volatile("" :: "v"(rp_[0]), "v"(rx_[0]), "v"(rn_[0]), "v"(rp_[1]), "v"(rx_[1]), "v"(rn_[1]), "v"(rp_[2]), "v"(rx_[2]), "v"(rn_[2]), "v"(mp_[0]), "v"(mn_[0]), "v"(mp_[1]), "v"(mn_[1]), "v"(mp_[2]), "v"(mn_[2]));
              asm volatile("" :: "v"(kkc), "v"(kac), "v"(w0), "v"(a0), "v"(lgw), "v"(lga));
              f32x4 xs[3];
#pragma unroll
              for (int which = 0; which < 3; ++which) { const v2u p = rp_[which], x = rx_[which], n = rn_[which];
                  const f32x4 xp = (f32x4){bf_lo(p.x), bf_hi(p.x), bf_lo(p.y), bf_hi(p.y)}, xc = (f32x4){bf_lo(x.x), bf_hi(x.x), bf_lo(x.y), bf_hi(x.y)}, xn = (f32x4){bf_lo(n.x), bf_hi(n.x), bf_lo(n.y), bf_hi(n.y)};
                  xs[which] = xc + mp_[which] * (xp - xc) + mn_[which] * (xn - xc); }
              kk = xs[1] * kkc;
              const float ss = rowsum16(kk.x * kk.x + kk.y * kk.y + kk.z * kk.z + kk.w * kk.w);
              kk = kk * __builtin_amdgcn_rsqf(ss + 1e-12f);
              const f32x4 uw = lgw + w0, ua = lga + a0;
              f32x4 av;
#pragma unroll
              for (int e = 0; e < 4; ++e) { ev[e] = 0.60653066f * sigmoidf(uw[e]); av[e] = sigmoidf(ua[e]); }
              kd = xs[1] * (1.f + (av - 1.f) * kac); kka = kk * av; rs = xs[0]; vs = xs[2];
              *(LAS f32x4*)(hl + CS_E + (s * 64 + c0) * 4) = ev; }
    }
    __syncthreads();
    { LAS unsigned char* hl = lds;
            { const int cb = s & 16, sl = s & 15;
              f32x4 cum = (f32x4){0.f, 0.f, 0.f, 0.f}, tot = cum;
#pragma unroll
              for (int hb = 0; hb < 2; ++hb) { f32x4 e8[8];
#pragma unroll
                  for (int ii = 0; ii < 8; ++ii) e8[ii] = *(const LAS f32x4*)(hl + CS_E + ((cb + 8 * hb + ii) * 64 + c0) * 4);
                  asm volatile("" :: "v"(e8[0]), "v"(e8[1]), "v"(e8[2]), "v"(e8[3]), "v"(e8[4]), "v"(e8[5]), "v"(e8[6]), "v"(e8[7]));
#pragma unroll
                  for (int ii = 0; ii < 8; ++ii) { tot = tot + e8[ii]; if (8 * hb + ii <= sl) cum = cum + e8[ii]; } }
              f32x4 g, gm1, gi, ge, gt;
#pragma unroll
              for (int e = 0; e < 4; ++e) { g[e] = fast_exp(-cum[e]); gm1[e] = fast_exp(ev[e] - cum[e]); gi[e] = fast_exp(cum[e]); ge[e] = fast_exp(cum[e] - tot[e]); gt[e] = fast_exp(-tot[e]); }
              const f32x4 ah = gm1 * kk, bh = kka * gi, kh = kd * gi, rh = g * rs, kg = kd * ge, bg = kka * ge;
              *(LAS v2u*)(hl + CS_AH + s * 144 + c0 * 2) = pack4(ah); *(LAS v2u*)(hl + CS_BH + s * 144 + c0 * 2) = pack4(bh);
              *(LAS v2u*)(hl + CS_KH + s * 144 + c0 * 2) = pack4(kh); *(LAS v2u*)(hl + CS_RH + s * 144 + c0 * 2) = pack4(rh);
              const int so = (((s >> 3) ^ cmsw(c0)) << 4) + (s & 7) * 2;
#pragma unroll
              for (int e = 0; e < 4; ++e) { *(LAS bf16*)(hl + CS_AHC + (c0 + e) * 80 + so) = bfs(ah[e]); *(LAS bf16*)(hl + CS_KGC + (c0 + e) * 80 + so) = bfs(kg[e]); *(LAS bf16*)(hl + CS_BGC + (c0 + e) * 80 + so) = bfs(-bg[e]); }
#pragma unroll
              for (int e = 0; e < 4; ++e) *(LAS bf16*)(hl + CS_VT + (c0 + e) * 80 + so) = bfs(vs[e]);
              if (sl == 15) *(LAS f32x4*)(hl + CS_GC + ((s >> 4) * 64 + c0) * 4) = gt; }
    }
    __builtin_amdgcn_sched_barrier(0);
    if (two) {
        LAS unsigned char* hl = lds + HSZ;
            { const LAS float* C = (const LAS float*)(lds + CS_CONST);
              v2u rp_[3], rx_[3], rn_[3]; f32x4 mp_[3], mn_[3];
#pragma unroll
              for (int which = 0; which < 3; ++which) {
                  const LAS unsigned char* rp = hl + CS_RAW + (which * 34 + tok) * 128 + c0 * 2;
                  rp_[which] = *(const LAS v2u*)rp; rx_[which] = *(const LAS v2u*)(rp + 128); rn_[which] = *(const LAS v2u*)(rp + 256);
                  mp_[which] = *(const LAS f32x4*)(C + which * 64 + c0); mn_[which] = *(const LAS f32x4*)(C + 192 + which * 64 + c0); }
              const f32x4 kkc = *(const LAS f32x4*)(C + 384 + c0), kac = *(const LAS f32x4*)(C + 448 + c0), w0 = *(const LAS f32x4*)(C + 512 + c0), a0 = *(const LAS f32x4*)(C + 576 + c0);
              const f32x4 lgw = *(const LAS f32x4*)(hl + CS_LG + (tok * 64 + c0) * 4), lga = *(const LAS f32x4*)(hl + CS_LG + 8192 + (tok * 64 + c0) * 4);
              asm volatile("" :: "v"(rp_[0]), "v"(rx_[0]), "v"(rn_[0]), "v"(rp_[1]), "v"(rx_[1]), "v"(rn_[1]), "v"(rp_[2]), "v"(rx_[2]), "v"(rn_[2]), "v"(mp_[0]), "v"(mn_[0]), "v"(mp_[1]), "v"(mn_[1]), "v"(mp_[2]), "v"(mn_[2]));
              asm volatile("" :: "v"(kkc), "v"(kac), "v"(w0), "v"(a0), "v"(lgw), "v"(lga));
              f32x4 xs[3];
#pragma unroll
              for (int which = 0; which < 3; ++which) { const v2u p = rp_[which], x = rx_[which], n = rn_[which];
                  const f32x4 xp = (f32x4){bf_lo(p.x), bf_hi(p.x), bf_lo(p.y), bf_hi(p.y)}, xc = (f32x4){bf_lo(x.x), bf_hi(x.x), bf_lo(x.y), bf_hi(x.y)}, xn = (f32x4){bf_lo(n.x), bf_hi(n.x), bf_lo(n.y), bf_hi(n.y)};
                  xs[which] = xc + mp_[which] * (xp - xc) + mn_[which] * (xn - xc); }
              kk = xs[1] * kkc;
              const float ss = rowsum16(kk.x * kk.x + kk.y * kk.y + kk.z * kk.z + kk.w * kk.w);
              kk = kk * __builtin_amdgcn_rsqf(ss + 1e-12f);
              const f32x4 uw = lgw + w0, ua = lga + a0;
              f32x4 av;
#pragma unroll
              for (int e = 0; e < 4; ++e) { ev[e] = 0.60653066f * sigmoidf(uw[e]); av[e] = sigmoidf(ua[e]); }
              kd = xs[1] * (1.f + (av - 1.f) * kac); kka = kk * av; rs = xs[0]; vs = xs[2];
              *(LAS f32x4*)(hl + CS_E + (s * 64 + c0) * 4) = ev; }
    }
    __syncthreads();
    if (two) {
        LAS unsigned char* hl = lds + HSZ;
            { const int cb = s & 16, sl = s & 15;
              f32x4 cum = (f32x4){0.f, 0.f, 0.f, 0.f}, tot = cum;
#pragma unroll
              for (int hb = 0; hb < 2; ++hb) { f32x4 e8[8];
#pragma unroll
                  for (int ii = 0; ii < 8; ++ii) e8[ii] = *(const LAS f32x4*)(hl + CS_E + ((cb + 8 * hb + ii) * 64 + c0) * 4);
                  asm volatile("" :: "v"(e8[0]), "v"(e8[1]), "v"(e8[2]), "v"(e8[3]), "v"(e8[4]), "v"(e8[5]), "v"(e8[6]), "v"(e8[7]));
#pragma unroll
                  for (int ii = 0; ii < 8; ++ii) { tot = tot + e8[ii]; if (8 * hb + ii <= sl) cum = cum + e8[ii]; } }
              f32x4 g, gm1, gi, ge, gt;
#pragma unroll
              for (int e = 0; e < 4; ++e) { g[e] = fast_exp(-cum[e]); gm1[e] = fast_exp(ev[e] - cum[e]); gi[e] = fast_exp(cum[e]); ge[e] = fast_exp(cum[e] - tot[e]); gt[e] = fast_exp(-tot[e]); }
              const f32x4 ah = gm1 * kk, bh = kka * gi, kh = kd * gi, rh = g * rs, kg = kd * ge, bg = kka * ge;
              *(LAS v2u*)(hl + CS_AH + s * 144 + c0 * 2) = pack4(ah); *(LAS v2u*)(hl + CS_BH + s * 144 + c0 * 2) = pack4(bh);
              *(LAS v2u*)(hl + CS_KH + s * 144 + c0 * 2) = pack4(kh); *(LAS v2u*)(hl + CS_RH + s * 144 + c0 * 2) = pack4(rh);
              const int so = (((s >> 3) ^ cmsw(c0)) << 4) + (s & 7) * 2;
#pragma unroll
              for (int e = 0; e < 4; ++e) { *(LAS bf16*)(hl + CS_AHC + (c0 + e) * 80 + so) = bfs(ah[e]); *(LAS bf16*)(hl + CS_KGC + (c0 + e) * 80 + so) = bfs(kg[e]); *(LAS bf16*)(hl + CS_BGC + (c0 + e) * 80 + so) = bfs(-bg[e]); }
#pragma unroll
              for (int e = 0; e < 4; ++e) *(LAS bf16*)(hl + CS_VT + (c0 + e) * 80 + so) = bfs(vs[e]);
              if (sl == 15) *(LAS f32x4*)(hl + CS_GC + ((s >> 4) * 64 + c0) * 4) = gt; }
    }
    __syncthreads();
    if (have_next) { v4u n0[3]; scan_issue_loads(proj, b, h, d, ntile0, tid, n0); rg[0] = n0[0]; rg[1] = n0[1]; rg[2] = n0[2];
        if (ntwo) { v4u n1[3]; scan_issue_loads(proj, b, h, d, ntile0 + 1, tid, n1); rg[3] = n1[0]; rg[4] = n1[1]; rg[5] = n1[2]; } }
    { LAS unsigned char* hl = lds + ts * HSZ;
            if (act) {
                const int r = lane & 31, hh = lane >> 5;
                const LAS unsigned char* Ab = hl + ((wl == 0 || wl == 3) ? CS_BH : CS_KH) + r * 144 + hh * 16;
                const LAS unsigned char* Bb = hl + (wl < 2 ? CS_AH : CS_RH) + r * 144 + hh * 16;
                f32x16 acc;
#pragma unroll
                for (int i = 0; i < 16; ++i) acc[i] = 0.f;
#pragma unroll
                for (int ks = 0; ks < 4; ++ks) { const bf16x8 a = *(const LAS bf16x8*)(Ab + ks * 32), bb = *(const LAS bf16x8*)(Bb + ks * 32); acc = __builtin_amdgcn_mfma_f32_32x32x16_bf16(a, bb, acc, 0, 0, 0); }
                const int t = r;
#pragma unroll
                for (int i = 0; i < 16; ++i) { const int j = (i & 3) + 8 * (i >> 2) + 4 * hh; const bool same = (j >> 4) == (t >> 4);
                    const bool keep = same && (wl < 2 ? (j < t) : (j <= t)); acc[i] = keep ? acc[i] : 0.f; }
                if (wl == 0) {
#pragma unroll
                    for (int i = 0; i < 16; ++i) { const int j = (i & 3) + 8 * (i >> 2) + 4 * hh; *(LAS float*)(hl + CS_NBA + (t * 36 + j) * 4) = acc[i]; } }
                else if (wl == 1) {
#pragma unroll
                    for (int i = 0; i < 16; ++i) { const int j = (i & 3) + 8 * (i >> 2) + 4 * hh; *(LAS bf16*)(hl + CS_NKA + j * 80 + t * 2) = bfs(acc[i]); } }
                else { const float sg = wl == 2 ? 1.f : -1.f; const int base = wl == 2 ? CS_MKR : CS_MBR;
#pragma unroll
                    for (int q4 = 0; q4 < 4; ++q4) *(LAS v2u*)(hl + base + t * 80 + (8 * q4 + 4 * hh) * 2) = pack4((f32x4){sg * acc[4 * q4], sg * acc[4 * q4 + 1], sg * acc[4 * q4 + 2], sg * acc[4 * q4 + 3]}); }
            }
    __syncthreads();
            if (act && wl == 0 && lane < 32) {
                const int blk = lane >> 4, i = lane & 15;
                float Tr[16];
#pragma unroll
                for (int t = 0; t < 16; ++t) {
                    float acc = (t == i) ? 1.f : 0.f;
                    const LAS float* np = (const LAS float*)(hl + CS_NBA) + (16 * blk + t) * 36 + 16 * blk;
#pragma unroll
                    for (int j = 0; j < t; ++j) acc -= Tr[j] * np[j];
                    Tr[t] = acc;
                }
#pragma unroll
                for (int t = 0; t < 16; ++t) { *(LAS bf16*)(hl + CS_TT + (16 * blk + t) * 80 + (16 * blk + i) * 2) = bfs(Tr[t]); *(LAS bf16*)(hl + CS_TT + (16 * blk + t) * 80 + (16 * (1 - blk) + i) * 2) = (bf16)0; }
            }
    __syncthreads();
            if (act && wl < 3) {
                const int r = lane & 31, hh = lane >> 5;
                const LAS unsigned char* Ab = hl + (wl < 2 ? CS_AHC + (32 * wl + r) * 80 : CS_NKA + r * 80);
                const int asw = wl < 2 ? cmsw(32 * wl + r) : 0;
                const LAS unsigned char* Bb = hl + CS_TT + r * 80 + hh * 16;
                f32x16 acc;
#pragma unroll
                for (int i = 0; i < 16; ++i) acc[i] = 0.f;
#pragma unroll
                for (int ks = 0; ks < 2; ++ks) { const bf16x8 a = *(const LAS bf16x8*)(Ab + (((2 * ks + hh) ^ asw) << 4)), bb = *(const LAS bf16x8*)(Bb + ks * 32); acc = __builtin_amdgcn_mfma_f32_32x32x16_bf16(a, bb, acc, 0, 0, 0); }
                const int t = r;
#pragma unroll
                for (int q4 = 0; q4 < 4; ++q4) { const v2u pk = pack4((f32x4){acc[4 * q4], acc[4 * q4 + 1], acc[4 * q4 + 2], acc[4 * q4 + 3]});
                    if (wl < 2) *(LAS v2u*)(hl + CS_APT + t * 144 + (32 * wl + 8 * q4 + 4 * hh) * 2) = pk;
                    else *(LAS v2u*)(hl + CS_NPT + t * 80 + (8 * q4 + 4 * hh) * 2) = pk; }
            }
    }
    __syncthreads();
#pragma unroll
    for (int i = 0; i < 4; ++i) { const int idx = tid + 512 * i; *(v4u*)(blob0 + idx * 16) = *(const LAS v4u*)(lds + idx * 16); }
    if (two) {
#pragma unroll
        for (int i = 0; i < 4; ++i) { const int idx = tid + 512 * i; *(v4u*)(blob0 + BL_BYTES + idx * 16) = *(const LAS v4u*)(lds + HSZ + idx * 16); } }
}
__device__ __forceinline__ void scan_y_store(Frame& F, int chain, int tile, int t0, int tid2) {
    const int b = chain >> 4, h = (chain >> 1) & 7, d = chain & 1;
    const int jt = tile - TC / 32, tlo = d == 0 ? 32 * jt : T - 32 * (jt + 1);
    const int s2 = tid2 >> 3, part = tid2 & 7; const int tk = d == 0 ? tlo + s2 : tlo + 31 - s2;
    const LAS float* ys = (const LAS float*)(F.lds + GS_YS + ((tile - t0) & 1) * 8192) + s2 * 64 + part * 8;
    float* dst = F.out + ((size_t)(b * T + tk)) * D + d * 512 + h * 64 + part * 8;
    *(f32x4*)dst = *(const LAS f32x4*)ys; *(f32x4*)(dst + 4) = *(const LAS f32x4*)(ys + 4);
}
__device__ __forceinline__ void scan_state_round(Frame& F, int chain, int t0, int t1, const unsigned char* blobs) {
    LAS unsigned char* lds = F.lds; const int tid = F.tid, lane = F.lane, wave = F.wave;
    f32x4* zs = (f32x4*)(F.ws + WS_ZS) + ((size_t)chain * 256 + (tid & 255)) * 4;
    f32x4 Z[4];
#pragma unroll
    for (int kt = 0; kt < 4; ++kt) Z[kt] = (t0 > 0 && wave < 4) ? zs[kt] : (f32x4){0.f, 0.f, 0.f, 0.f};
    __syncthreads();
    { v4u b0[4];
#pragma unroll
      for (int i = 0; i < 4; ++i) b0[i] = *(const v4u*)(blobs + (tid + 512 * i) * 16);
#pragma unroll
      for (int i = 0; i < 4; ++i) *(LAS v4u*)(lds + (tid + 512 * i) * 16) = b0[i]; }
    const int tid2 = tid - 256;
    v4u bg[4];
    if (t0 + 1 < t1) {
#pragma unroll
        for (int i = 0; i < 4; ++i) bg[i] = *(const v4u*)(blobs + (size_t)BL_BYTES + (tid + 512 * i) * 16); }
    __syncthreads();
    for (int tile = t0; tile < t1; ++tile) {
        const bool isctx = tile < TC / 32;
        const LAS unsigned char* bl = lds + ((tile - t0) & 1) * BL_BYTES;
        if (tile + 1 < t1) {
#pragma unroll
            for (int i = 0; i < 4; ++i) *(LAS v4u*)(lds + ((tile + 1 - t0) & 1) * BL_BYTES + (tid + 512 * i) * 16) = bg[i]; }
        if (tile + 2 < t1) {
#pragma unroll
            for (int i = 0; i < 4; ++i) bg[i] = *(const v4u*)(blobs + (size_t)(tile + 2 - t0) * BL_BYTES + (tid + 512 * i) * 16); }
        if (wave >= 4 && tile > t0 && tile - 1 >= TC / 32) scan_y_store(F, chain, tile - 1, t0, tid2);
        if (wave < 4) {
            const int n = lane & 15, g = lane >> 4;
            const bf16x8 bvt = *(const LAS bf16x8*)(bl + BL_VT + (16 * wave + n) * 80 + ((g ^ (((n >> 2) ^ wave) & 3)) << 4));
            f32x4 U[2]; U[0] = (f32x4){0.f, 0.f, 0.f, 0.f}; U[1] = U[0];
#pragma unroll
            for (int cc = 0; cc < 2; ++cc) {
                if (cc == 1) __builtin_amdgcn_sched_barrier(0);
                const int trow = 16 * cc + n;
                const LAS unsigned char* ap = bl + BL_APT + trow * 144; const LAS unsigned char* rp = bl + BL_RH + trow * 144; const LAS unsigned char* mp = bl + BL_MBR + trow * 80;
                const bf16x8 fAP0 = frag2(ap + (4 * g) * 2, ap + (16 + 4 * g) * 2), fAP1 = frag2(ap + (32 + 4 * g) * 2, ap + (48 + 4 * g) * 2);
                const bf16x8 fNP = *(const LAS bf16x8*)(bl + BL_NPT + trow * 80 + g * 16);
                f32x4 gcv = *(const LAS f32x4*)(bl + BL_GC + (cc * 64 + 4 * g) * 4);
                const int sw0 = (n >> 2) & 3;
                bf16x8 fKG = *(const LAS bf16x8*)(bl + BL_KGC + n * 80 + ((g ^ sw0) << 4));
                v2u fBG = *(const LAS v2u*)(bl + BL_BGC + n * 80 + (((2 * cc + (g >> 1)) ^ sw0) << 4) + (g & 1) * 8);
                asm volatile("" :: "v"(fAP0), "v"(fAP1), "v"(fNP), "v"(gcv), "v"(fKG), "v"(fBG));
                const bf16x8 bz01 = frag_acc(Z[0], Z[1]), bz23 = frag_acc(Z[2], Z[3]);
                f32x4 u = __builtin_amdgcn_mfma_f32_16x16x32_bf16(fAP0, bz01, (f32x4){0.f, 0.f, 0.f, 0.f}, 0, 0, 0);
                u = __builtin_amdgcn_mfma_f32_16x16x32_bf16(fAP1, bz23, u, 0, 0, 0);
                u = __builtin_amdgcn_mfma_f32_16x16x32_bf16(fNP, bvt, u, 0, 0, 0);
                U[cc] = u;
                const bf16x8 bu = frag_acc(U[0], U[1]);
                if (!isctx) {
                    const bf16x8 fRH0 = frag2(rp + (4 * g) * 2, rp + (16 + 4 * g) * 2), fRH1 = frag2(rp + (32 + 4 * g) * 2, rp + (48 + 4 * g) * 2);
                    const bf16x8 fMK = *(const LAS bf16x8*)(bl + BL_MKR + trow * 80 + g * 16);
                    const bf16x8 fMB = frag2(mp + (4 * g) * 2, mp + (16 + 4 * g) * 2);
                    asm volatile("" :: "v"(fRH0), "v"(fRH1), "v"(fMK), "v"(fMB));
                    f32x4 y = __builtin_amdgcn_mfma_f32_16x16x32_bf16(fRH0, bz01, (f32x4){0.f, 0.f, 0.f, 0.f}, 0, 0, 0);
                    y = __builtin_amdgcn_mfma_f32_16x16x32_bf16(fRH1, bz23, y, 0, 0, 0);
                    y = __builtin_amdgcn_mfma_f32_16x16x32_bf16(fMK, bvt, y, 0, 0, 0);
                    y = __builtin_amdgcn_mfma_f32_16x16x32_bf16(fMB, bu, y, 0, 0, 0);
#pragma unroll
                    for (int i = 0; i < 4; ++i) *(LAS float*)(lds + GS_YS + ((tile - t0) & 1) * 8192 + ((16 * cc + 4 * g + i) * 64 + 16 * wave + n) * 4) = y[i]; }
#pragma unroll
                for (int kt = 0; kt < 4; ++kt) {
                    f32x4 gcn = gcv; bf16x8 fKGn = fKG; v2u fBGn = fBG;
                    if (kt < 3) { const int sw = (sw0 ^ (kt + 1)) & 3;
                        gcn = *(const LAS f32x4*)(bl + BL_GC + (cc * 64 + 16 * (kt + 1) + 4 * g) * 4);
                        fKGn = *(const LAS bf16x8*)(bl + BL_KGC + (16 * (kt + 1) + n) * 80 + ((g ^ sw) << 4));
                        fBGn = *(const LAS v2u*)(bl + BL_BGC + (16 * (kt + 1) + n) * 80 + (((2 * cc + (g >> 1)) ^ sw) << 4) + (g & 1) * 8); }
                    const bf16x8 ka = ((g >> 1) == cc) ? fKG : frag_zero();
                    const v4u bw = cc == 0 ? (v4u){fBG.x, fBG.y, 0u, 0u} : (v4u){0u, 0u, fBG.x, fBG.y};
                    f32x4 z = Z[kt] * gcv;
                    z = __builtin_amdgcn_mfma_f32_16x16x32_bf16(ka, bvt, z, 0, 0, 0);
                    z = __builtin_amdgcn_mfma_f32_16x16x32_bf16(__builtin_bit_cast(bf16x8, bw), bu, z, 0, 0, 0);
                    Z[kt] = z;
                    if (kt < 3) asm volatile("" :: "v"(gcn), "v"(fKGn), "v"(fBGn));
                    gcv = gcn; fKG = fKGn; fBG = fBGn;
                }
            }
        }
        __syncthreads();
    }
    if (t1 - 1 >= TC / 32 && wave >= 4) scan_y_store(F, chain, t1 - 1, t0, tid - 256);
    if (wave < 4 && t1 < SC_NTILE) {
#pragma unroll
        for (int kt = 0; kt < 4; ++kt) zs[kt] = Z[kt]; }
    __syncthreads();
}
template <int LEVEL> __device__ __forceinline__ void p3_scan(Frame& F, const XcdBarrier& bar) {
    const bf16* proj = (const bf16*)(F.ws + WS_PROJ);
    const bool state_role = F.bid < 64;
    const int pj = (F.bid - 64) >> 3;
    const int pchain = state_role ? F.bid : (F.bid & 7) + 8 * (pj / 3), psub = state_role ? 0 : pj % 3;
    int prev_chain = -1;
    for (int step = 0; step <= SC_NROUND; ++step) {
        if (LEVEL != 1 && step >= 1 && state_role) {
            const int r = step - 1, t0 = r * SC_RT, t1 = (t0 + SC_RT < SC_NTILE) ? t0 + SC_RT : SC_NTILE;
            scan_state_round(F, F.bid, t0, t1, F.ws + ((r & 1) ? WS_BLOB1 : WS_BLOB0) + (size_t)F.bid * SC_RT * BL_BYTES);
        }
        if (LEVEL != 2 && step < SC_NROUND) {
            const int t0 = step * SC_RT, nt = (t0 + SC_RT < SC_NTILE) ? SC_RT : SC_NTILE - t0;
            unsigned char* base = F.ws + ((step & 1) ? WS_BLOB1 : WS_BLOB0) + (size_t)pchain * SC_RT * BL_BYTES;
            int a0, a1;
            if (state_role) { a0 = 0; a1 = (step == 0) ? 0 : 0; } else { a0 = nt * psub / 3; a1 = nt * (psub + 1) / 3; }
            v4u rg[6];
            if (a0 < a1) { v4u n0[3]; scan_issue_loads(proj, pchain >> 4, (pchain >> 1) & 7, pchain & 1, t0 + a0, F.tid, n0); rg[0] = n0[0]; rg[1] = n0[1]; rg[2] = n0[2];
                if (a0 + 1 < a1) { v4u n1[3]; scan_issue_loads(proj, pchain >> 4, (pchain >> 1) & 7, pchain & 1, t0 + a0 + 1, F.tid, n1); rg[3] = n1[0]; rg[4] = n1[1]; rg[5] = n1[2]; } }
            for (int tl = a0; tl < a1; tl += 2) {
                const bool two = tl + 1 < a1, have_next = tl + 2 < a1, ntwo = tl + 3 < a1;
                scan_prep_pair(F, proj, pchain, t0 + tl, two, pchain != prev_chain, have_next, t0 + tl + 2, ntwo, rg, base + (size_t)tl * BL_BYTES);
                prev_chain = pchain;
            }
        }
        if (step < SC_NROUND) xcd_barrier(bar);
    }
}
constexpr int P4_SG = 0, P4_GT = 17408, P4_CST = 17408 + 64 * 1040, P4_END = P4_CST + 12 * 2048;
__device__ __forceinline__ f32x4 ldq(const LAS float* p) { return *(const LAS f32x4*)p; }
__device__ __forceinline__ void unpack8(v4u w, float (&o)[8]) { o[0] = bf_lo(w.x); o[1] = bf_hi(w.x); o[2] = bf_lo(w.y); o[3] = bf_hi(w.y); o[4] = bf_lo(w.z); o[5] = bf_hi(w.z); o[6] = bf_lo(w.w); o[7] = bf_hi(w.w); }
__device__ __forceinline__ float sum8lanes(float p) { p += dppf<0xB1>(p); p += dppf<0x4E>(p); p += dppf<0x141>(p); return p; }
__device__ __forceinline__ void p4_mix(Frame& F) {
    LAS unsigned char* lds = F.lds; const int tid = F.tid, lane = F.lane, wave = F.wave;
    const bf16* proj = (const bf16*)(F.ws + WS_PROJ); bf16* cat = (bf16*)(F.ws + WS_HX); const float* yscr = F.out; const bf16* gwt = (const bf16*)(F.ws + WS_GWT);
    LAS float* CST = (LAS float*)(lds + P4_CST);
    __syncthreads();
    for (int i = tid; i < 12 * 512; i += 512) { const int row = i >> 9, c = i & 511;
        CST[i] = row < 6 ? F.in[I_TMU][row * 512 + c] : row == 6 ? F.in[I_RK][c] : row == 7 ? F.in[I_LNG][c] : row == 8 ? F.in[I_LNB][c] : F.in[I_CONVW][(row - 9) * 512 + c]; }
    for (int unit = F.bid; unit < MX / 64; unit += F.G) {
        const size_t row0 = (size_t)unit * 64; const int tb0 = (unit * 64) & (T - 1);
        __syncthreads();
#pragma unroll
        for (int i = 0; i < 2; ++i) { const int ck = tid + 512 * i, tok = ck >> 4, j0 = (ck & 15) * 8;
            const v4u w = *(const v4u*)(proj + (row0 + tok) * NPROJ + COL_G + j0);
            v4u o; o.x = pk2(sigmoidf(bf_lo(w.x)), sigmoidf(bf_hi(w.x))); o.y = pk2(sigmoidf(bf_lo(w.y)), sigmoidf(bf_hi(w.y))); o.z = pk2(sigmoidf(bf_lo(w.z)), sigmoidf(bf_hi(w.z))); o.w = pk2(sigmoidf(bf_lo(w.w)), sigmoidf(bf_hi(w.w)));
            *(LAS v4u*)(lds + P4_SG + tok * 272 + j0 * 2) = o; }
        __syncthreads();
        { const int r = lane & 31, hh = lane >> 5;
#pragma unroll
          for (int nt = 0; nt < 2; ++nt) {
              const bf16* bp = gwt + (size_t)(64 * wave + 32 * nt + r) * 128 + hh * 8;
              bf16x8 bfr[8];
#pragma unroll
              for (int ks = 0; ks < 8; ++ks) bfr[ks] = *(const bf16x8*)(bp + ks * 16);
#pragma unroll
              for (int mt = 0; mt < 2; ++mt) {
                  f32x16 acc;
#pragma unroll
                  for (int i = 0; i < 16; ++i) acc[i] = 0.f;
#pragma unroll
                  for (int ks = 0; ks < 8; ++ks) { const bf16x8 a = *(const LAS bf16x8*)(lds + P4_SG + (32 * mt + r) * 272 + ks * 32 + hh * 16); acc = __builtin_amdgcn_mfma_f32_32x32x16_bf16(a, bfr[ks], acc, 0, 0, 0); }
#pragma unroll
                  for (int i = 0; i < 16; ++i) *(LAS bf16*)(lds + P4_GT + (32 * mt + (i & 3) + 8 * (i >> 2) + 4 * hh) * 1040 + (64 * wave + 32 * nt + r) * 2) = (bf16)(pk2(acc[i], 0.f) & 0xffffu);
              } } }
        __syncthreads();
        const int gq = tid & 63, c0 = gq * 8;
#pragma unroll 2
        for (int n = 0; n < 8; ++n) { const int t = 8 * n + (tid >> 6); const int tb = tb0 + t;
            const bf16* pr = proj + (row0 + t) * NPROJ + c0;
            float xs[3][8];
#pragma unroll
            for (int which = 0; which < 3; ++which) { const int col = COL_R + which * 512;
                float xc[8], xp[8], xn[8];
                unpack8(*(const v4u*)(pr + col), xc);
                if (tb > 0) unpack8(*(const v4u*)(pr - NPROJ + col), xp); else {
#pragma unroll
                    for (int e = 0; e < 8; ++e) xp[e] = 0.f; }
                if (tb + 1 < T) unpack8(*(const v4u*)(pr + NPROJ + col), xn); else {
#pragma unroll
                    for (int e = 0; e < 8; ++e) xn[e] = 0.f; }
                const f32x4 mp0 = ldq(CST + which * 512 + c0), mp1 = ldq(CST + which * 512 + c0 + 4), mn0 = ldq(CST + (3 + which) * 512 + c0), mn1 = ldq(CST + (3 + which) * 512 + c0 + 4);
#pragma unroll
                for (int e = 0; e < 8; ++e) { const float mp = e < 4 ? mp0[e & 3] : mp1[e & 3], mn = e < 4 ? mn0[e & 3] : mn1[e & 3]; xs[which][e] = xc[e] + mp * (xp[e] - xc[e]) + mn * (xn[e] - xc[e]); } }
            const float* yr = yscr + (row0 + t) * D + c0;
            const f32x4 ya = *(const f32x4*)yr + *(const f32x4*)(yr + 512), yb = *(const f32x4*)(yr + 4) + *(const f32x4*)(yr + 516);
            float y[8] = {ya.x, ya.y, ya.z, ya.w, yb.x, yb.y, yb.z, yb.w};
            float sm = 0.f, sb = 0.f;
            const f32x4 rk0 = ldq(CST + 6 * 512 + c0), rk1 = ldq(CST + 6 * 512 + c0 + 4);
#pragma unroll
            for (int e = 0; e < 8; ++e) { sm += y[e]; sb += xs[0][e] * xs[1][e] * (e < 4 ? rk0[e & 3] : rk1[e & 3]); }
            const float mu = sum8lanes(sm) * (1.f / 64.f); const float bon = sum8lanes(sb);
            float sv = 0.f;
#pragma unroll
            for (int e = 0; e < 8; ++e) { y[e] -= mu; sv += y[e] * y[e]; }
            const float rstd = __builtin_amdgcn_rsqf(sum8lanes(sv) * (1.f / 64.f) + LNX_EPS);
            const f32x4 lg0 = ldq(CST + 7 * 512 + c0), lg1 = ldq(CST + 7 * 512 + c0 + 4), lb0 = ldq(CST + 8 * 512 + c0), lb1 = ldq(CST + 8 * 512 + c0 + 4);
            float gt[8]; unpack8(*(const LAS v4u*)(lds + P4_GT + t * 1040 + c0 * 2), gt);
            float o[8];
#pragma unroll
            for (int e = 0; e < 8; ++e) o[e] = (y[e] * rstd * (e < 4 ? lg0[e & 3] : lg1[e & 3]) + (e < 4 ? lb0[e & 3] : lb1[e & 3]) + bon * xs[2][e]) * gt[e];
            *(v4u*)(cat + (row0 + t) * D + 512 + c0) = (v4u){pk2(o[0], o[1]), pk2(o[2], o[3]), pk2(o[4], o[5]), pk2(o[6], o[7])};
        }
#pragma unroll 2
        for (int n = 0; n < 8; ++n) { const int t = 8 * n + (tid >> 6);
            const bf16* pr = proj + (row0 + t) * NPROJ + c0;
            float zc[8], zp[8], zn[8], g8[8], x8[8], xb[8];
            unpack8(*(const v4u*)(pr + COL_XG), g8); unpack8(*(const v4u*)(pr + COL_XC), x8);
#pragma unroll
            for (int e = 0; e < 8; ++e) zc[e] = g8[e] * x8[e];
            if (t > 0) { unpack8(*(const v4u*)(pr - NPROJ + COL_XG), g8); unpack8(*(const v4u*)(pr - NPROJ + COL_XC), x8);
#pragma unroll
                for (int e = 0; e < 8; ++e) zp[e] = g8[e] * x8[e]; } else {
#pragma unroll
                for (int e = 0; e < 8; ++e) zp[e] = 0.f; }
            if (t < 63) { unpack8(*(const v4u*)(pr + NPROJ + COL_XG), g8); unpack8(*(const v4u*)(pr + NPROJ + COL_XC), x8);
#pragma unroll
                for (int e = 0; e < 8; ++e) zn[e] = g8[e] * x8[e]; } else {
#pragma unroll
                for (int e = 0; e < 8; ++e) zn[e] = 0.f; }
            unpack8(*(const v4u*)(pr + COL_XB), xb);
            const f32x4 w00 = ldq(CST + 9 * 512 + c0), w01 = ldq(CST + 9 * 512 + c0 + 4), w10 = ldq(CST + 10 * 512 + c0), w11 = ldq(CST + 10 * 512 + c0 + 4), w20 = ldq(CST + 11 * 512 + c0), w21 = ldq(CST + 11 * 512 + c0 + 4);
            float o[8];
#pragma unroll
            for (int e = 0; e < 8; ++e) o[e] = xb[e] * ((e < 4 ? w00[e & 3] : w01[e & 3]) * zp[e] + (e < 4 ? w10[e & 3] : w11[e & 3]) * zc[e] + (e < 4 ? w20[e & 3] : w21[e & 3]) * zn[e]);
            *(v4u*)(cat + (row0 + t) * D + c0) = (v4u){pk2(o[0], o[1]), pk2(o[2], o[3]), pk2(o[4], o[5]), pk2(o[6], o[7])};
        }
    }
}

__device__ __forceinline__ void p6_mid(Frame& F) {
    const float* mod = (const float*)(F.ws + WS_MOD); const float* ng = F.in[I_NG];
    const float* yx = (const float*)(F.ws + WS_PROJ); bf16* hx2 = (bf16*)(F.ws + WS_HX);
    for (int m = F.bid * NWAVES + F.wave; m < MX; m += F.G * NWAVES) {
        const float* mr = mod + (m >> 12) * NMOD;
        f32x4 v[4], xv[4]; float ss = 0.f;
#pragma unroll
        for (int j = 0; j < 4; ++j) { v[j] = *(const f32x4*)(yx + (size_t)m * D + j * 256 + F.lane * 4); xv[j] = *(const f32x4*)(F.in[I_X] + (size_t)m * D + j * 256 + F.lane * 4);
            ss += v[j].x * v[j].x + v[j].y * v[j].y + v[j].z * v[j].z + v[j].w * v[j].w; }
        const float rstd = __builtin_amdgcn_rsqf(wave_sum(ss) * (1.f / D) + NORM_EPS);
        float ss2 = 0.f;
#pragma unroll
        for (int j = 0; j < 4; ++j) { const int c = j * 256 + F.lane * 4;
            const f32x4 g1 = *(const f32x4*)(ng + D + c), gt = *(const f32x4*)(mr + 2 * D + c);
            xv[j] = xv[j] + gt * (v[j] * rstd * g1);
            *(f32x4*)(F.out + (size_t)m * D + c) = xv[j];
            ss2 += xv[j].x * xv[j].x + xv[j].y * xv[j].y + xv[j].z * xv[j].z + xv[j].w * xv[j].w; }
        const float rstd2 = __builtin_amdgcn_rsqf(wave_sum(ss2) * (1.f / D) + NORM_EPS);
#pragma unroll
        for (int j = 0; j < 4; ++j) { const int c = j * 256 + F.lane * 4;
            const f32x4 g2 = *(const f32x4*)(ng + 2 * D + c), sh = *(const f32x4*)(mr + 3 * D + c), sc = *(const f32x4*)(mr + 4 * D + c);
            const f32x4 o = xv[j] * rstd2 * g2 * (1.f + sc) + sh;
            *(v2u*)(hx2 + (size_t)m * D + c) = (v2u){pk2(o.x, o.y), pk2(o.z, o.w)}; }
    }
}
__device__ __forceinline__ float gelu_erf(float x) { return 0.5f * x * (1.f + erff(x * 0.70710678118f)); }
__device__ __forceinline__ float dot2bf(unsigned a, unsigned b, float c) {
    typedef __bf16 bf2 __attribute__((ext_vector_type(2)));
    return __builtin_amdgcn_fdot2_f32_bf16(__builtin_bit_cast(bf2, a), __builtin_bit_cast(bf2, b), c, false);
}
__device__ __forceinline__ unsigned uminu(unsigned a, unsigned b) { return a < b ? a : b; }
__device__ __forceinline__ void ce_desc(unsigned& x, unsigned& y) { const unsigned hi = umaxu(x, y), lo = uminu(x, y); x = hi; y = lo; }
template <int N> __device__ __forceinline__ void bitonic_sort_desc(unsigned (&a)[N]) {
#pragma unroll
    for (int k = 2; k <= N; k <<= 1)
#pragma unroll
        for (int j = k >> 1; j > 0; j >>= 1)
#pragma unroll
            for (int i = 0; i < N; ++i) { const int l = i ^ j; if (l > i) { if ((i & k) == 0) ce_desc(a[i], a[l]); else ce_desc(a[l], a[i]); } }
}
template <int N> __device__ __forceinline__ void bitonic_merge_desc(unsigned (&a)[N]) {
#pragma unroll
    for (int j = N >> 1; j > 0; j >>= 1)
#pragma unroll
        for (int i = 0; i < N; ++i) { const int l = i ^ j; if (l > i) ce_desc(a[i], a[l]); }
}
__device__ __forceinline__ void p8a_route(Frame& F) {
    const int lane = F.lane, wave = F.wave, part = lane & 3, L = lane >> 2, side = L & 1;
    LAS unsigned char* WL = F.lds + 1024 + wave * 1024;
    LAS unsigned char* TAB = F.lds;
    const float* scores = (const float*)(F.ws + WS_PROJ);
    unsigned short* exl = (unsigned short*)(F.ws + WS_EXL); float* gl = (float*)(F.ws + WS_GL);
    __syncthreads();
    if (F.tid < 64) { int l = F.tid, i = 0; for (; i < 16; ++i) { const int n = 16 / (i + 1); if (l < n) break; l -= n; } TAB[F.tid] = (unsigned char)(i < 16 ? i * 16 + l : 0); }
    __syncthreads();
    for (int m = F.bid * NWAVES + wave; m < MX; m += F.G * NWAVES) {
        const float* lp = scores + (size_t)m * NSC + L * 128 + part * 32;
        unsigned lo16[16], hi16[16];
#pragma unroll
        for (int q = 0; q < 4; ++q) { const f32x4 v = *(const f32x4*)(lp + 4 * q), w = *(const f32x4*)(lp + 16 + 4 * q);
#pragma unroll
            for (int e = 0; e < 4; ++e) { lo16[4 * q + e] = (f2key(v[e]) & ~127u) | (unsigned)(127 - part * 32 - (4 * q + e)); hi16[4 * q + e] = (f2key(w[e]) & ~127u) | (unsigned)(127 - part * 32 - 16 - (4 * q + e)); } }
        bitonic_sort_desc<16>(lo16); bitonic_sort_desc<16>(hi16);
        unsigned r[16];
#pragma unroll
        for (int i = 0; i < 16; ++i) r[i] = umaxu(lo16[i], hi16[15 - i]);
        bitonic_merge_desc<16>(r);
        { unsigned c[16];
#pragma unroll
          for (int i = 0; i < 16; ++i) c[i] = umaxu(r[i], dppu<0xB1>(r[15 - i]));
          bitonic_merge_desc<16>(c);
#pragma unroll
          for (int i = 0; i < 16; ++i) r[i] = umaxu(c[i], dppu<0x4E>(c[15 - i]));
          bitonic_merge_desc<16>(r); }
        if (part == 0) {
#pragma unroll
            for (int i = 0; i < 16; ++i) WL[L * 16 + i] = (unsigned char)(127u - (r[i] & 127u)); }
        float fa[16], fb[16];
#pragma unroll
        for (int i = 0; i < 16; ++i) { const unsigned up = dppu<0x104>(r[i]), dn = dppu<0x114>(r[i]);
            const unsigned av = side ? dn : r[i], bv = side ? r[i] : up; fa[i] = key2f(av & ~127u); fb[i] = key2f(bv & ~127u); }
        unsigned R[16];
#pragma unroll
        for (int j = 0; j < 16; ++j) R[j] = (f2key(fa[0] + fb[j]) & ~63u) | (unsigned)(63 - j);
        { int code = 16;
#pragma unroll
          for (int i = 1; i < 16; ++i) {
#pragma unroll
              for (int j = 0; j < 16; ++j) { if ((i + 1) * (j + 1) <= 16) {
                  const unsigned x = (f2key(fa[i] + fb[j]) & ~63u) | (unsigned)(63 - code); const int p0 = (i + 1) * (j + 1) - 1;
#pragma unroll
                  for (int p = 15; p > p0; --p) R[p] = umaxu(R[p], uminu(R[p - 1], x));
                  R[p0] = umaxu(R[p0], x); ++code; } } } }
        if ((lane & 7) == 0) {
#pragma unroll
            for (int k = 0; k < 16; ++k) *(LAS unsigned*)(WL + 256 + ((lane >> 3) * 16 + k) * 4) = R[k]; }
        LDS_WAIT();
#pragma unroll
        for (int half = 0; half < 2; ++half) { const int e = lane + 64 * half, hd = e >> 4;
            const unsigned rk = *(const LAS unsigned*)(WL + 256 + e * 4); const int ij = TAB[63 - (int)(rk & 63u)];
            const int idx0 = WL[(2 * hd) * 16 + (ij >> 4)], idx1 = WL[(2 * hd + 1) * 16 + (ij & 15)];
            const float scv = key2f(rk & ~63u);
            float mx = scv; mx = fmaxf(mx, dppf<0xB1>(mx)); mx = fmaxf(mx, dppf<0x4E>(mx)); mx = fmaxf(mx, dppf<0x141>(mx)); mx = fmaxf(mx, dppf<0x140>(mx));
            const float ev = fast_exp(scv - mx); const float den = rowsum16(ev);
            exl[(size_t)m * 128 + e] = (unsigned short)(idx0 * 128 + idx1); gl[(size_t)m * 128 + e] = ev * fast_rcp(den); }
        LDS_WAIT();
    }
}
__device__ __forceinline__ void p9_upass(Frame& F) {
    const int lane = F.lane, wave = F.wave, x = F.bid & 7, r = F.bid >> 3, nr = F.G >> 3, g = lane >> 3, q = lane & 7;
    LAS unsigned short* EXW = (LAS unsigned short*)(F.lds + wave * 256);
    const unsigned* exl32 = (const unsigned*)(F.ws + WS_EXL); const bf16* hx2 = (const bf16*)(F.ws + WS_HX);
    const unsigned char* U = F.ws + WS_U + 128 * x + 16 * q; float* part = (float*)(F.ws + WS_PART) + (size_t)x * MX * 128;
    for (int m = r + nr * wave; m < MX; m += nr * NWAVES) {
        *(LAS unsigned*)(EXW + 2 * lane) = exl32[(size_t)m * 64 + lane];
        const v4u h0 = *(const v4u*)(hx2 + (size_t)m * D + 128 * x + 16 * q), h1 = *(const v4u*)(hx2 + (size_t)m * D + 128 * x + 16 * q + 8);
        float hf[16];
        hf[0] = bf_lo(h0.x); hf[1] = bf_hi(h0.x); hf[2] = bf_lo(h0.y); hf[3] = bf_hi(h0.y); hf[4] = bf_lo(h0.z); hf[5] = bf_hi(h0.z); hf[6] = bf_lo(h0.w); hf[7] = bf_hi(h0.w);
        hf[8] = bf_lo(h1.x); hf[9] = bf_hi(h1.x); hf[10] = bf_lo(h1.y); hf[11] = bf_hi(h1.y); hf[12] = bf_lo(h1.z); hf[13] = bf_hi(h1.z); hf[14] = bf_lo(h1.w); hf[15] = bf_hi(h1.w);
        LDS_WAIT();
        float keep[2];
#pragma unroll
        for (int j = 0; j < 2; ++j) {
            float kp = 0.f;
            v4u uu[8];
#pragma unroll
            for (int i = 0; i < 8; ++i) { const unsigned ex = EXW[64 * j + 8 * i + g]; uu[i] = *(const v4u*)(U + (size_t)ex * 1024); }
#pragma unroll
            for (int i = 0; i < 8; ++i) { float p = 0.f;
#pragma unroll
                for (int w = 0; w < 4; ++w) { const f32x2 lo = __builtin_amdgcn_cvt_pk_f32_fp8((int)uu[i][w], false), hi = __builtin_amdgcn_cvt_pk_f32_fp8((int)uu[i][w], true);
                    p += lo.x * hf[4 * w] + lo.y * hf[4 * w + 1] + hi.x * hf[4 * w + 2] + hi.y * hf[4 * w + 3]; }
                p += dppf<0xB1>(p); p += dppf<0x4E>(p); p += dppf<0x141>(p);
                kp = (q == i) ? p : kp; }
            keep[j] = kp * (1.f / 32.f);
        }
        part[(size_t)m * 128 + 8 * q + g] = keep[0]; part[(size_t)m * 128 + 64 + 8 * q + g] = keep[1];
        LDS_WAIT();
    }
}
__device__ __forceinline__ void p10_combine(Frame& F) {
    const float* __restrict__ part = (const float*)(F.ws + WS_PART); const float* __restrict__ gl = (const float*)(F.ws + WS_GL);
    const unsigned short* __restrict__ exl = (const unsigned short*)(F.ws + WS_EXL); unsigned* __restrict__ plt = (unsigned*)(F.ws + WS_PL);
    LAS unsigned* TL = (LAS unsigned*)F.lds;
    for (int unit = F.bid; unit < MX / 64; unit += F.G) {
        const int m0 = unit * 64;
        __syncthreads();
#pragma unroll 4
        for (int i = 0; i < 16; ++i) { const int idx = F.tid + 512 * i, ml = idx >> 7, k = idx & 127; const size_t gi = (size_t)(m0 + ml) * 128 + k;
            float s = part[gi];
#pragma unroll
            for (int x = 1; x < 8; ++x) s += part[(size_t)x * MX * 128 + gi];
            TL[k * 65 + ml] = (unsigned)exl[gi] | ((unsigned)__builtin_bit_cast(unsigned short, (_Float16)(gl[gi] * gelu_erf(s))) << 16); }
        __syncthreads();
#pragma unroll 4
        for (int i = 0; i < 16; ++i) { const int idx = F.tid + 512 * i, k = idx >> 6, ml = idx & 63; plt[(size_t)k * MX + m0 + ml] = TL[k * 65 + ml]; }
    }
}
typedef _Float16 h2_t __attribute__((ext_vector_type(2)));
typedef _Float16 h4_t __attribute__((ext_vector_type(4)));
template <int MODE> __device__ __forceinline__ void p11_vpass(Frame& F) {
    const int lane = F.lane, wave = F.wave;
    const unsigned* __restrict__ plt = (const unsigned*)(F.ws + WS_PL); float* __restrict__ po = (float*)(F.ws + WS_PO);
    for (int cg = F.bid; cg < 256; cg += F.G) {
        const int c0 = 128 * (cg & 7) + 4 * (cg >> 3);
        __syncthreads();
        for (int e = F.tid; e < NEXP; e += 512) { const f32x4 vv = *(const f32x4*)(F.in[I_PV] + (size_t)e * D + c0);
            const h2_t a = {(_Float16)vv.x, (_Float16)vv.y}, b = {(_Float16)vv.z, (_Float16)vv.w};
            *(LAS v2u*)(F.lds + e * 8) = (v2u){__builtin_bit_cast(unsigned, a), __builtin_bit_cast(unsigned, b)}; }
        __syncthreads();
        for (int mg = wave; mg < MX / 64; mg += NWAVES) {
            const unsigned* __restrict__ pg = plt + mg * 64;
            f32x4 acc = (f32x4){0.f, 0.f, 0.f, 0.f};
#pragma unroll 2
            for (int k0 = 0; k0 < 128; k0 += 8) {
                unsigned p[8];
#pragma unroll
                for (int i = 0; i < 8; ++i) p[i] = pg[(size_t)(k0 + i) * MX + lane];
                h2_t a01 = {(_Float16)0.f, (_Float16)0.f}, a23 = a01;
#pragma unroll
                for (int i = 0; i < 8; ++i) { const h4_t hv = *(const LAS h4_t*)(unsigned)((p[i] & 0xffffu) << 3);
                    const _Float16 cf = __builtin_bit_cast(_Float16, (unsigned short)(p[i] >> 16)); const h2_t c2 = {cf, cf};
                    a01 = __builtin_shufflevector(hv, hv, 0, 1) * c2 + a01; a23 = __builtin_shufflevector(hv, hv, 2, 3) * c2 + a23; }
                acc.x += (float)a01.x; acc.y += (float)a01.y; acc.z += (float)a23.x; acc.w += (float)a23.y;
            }
            *(f32x4*)(po + (size_t)(mg * 64 + lane) * D + c0) = acc;
        }
    }
}
__device__ __forceinline__ void p12_final(Frame& F) {
    const float* mod = (const float*)(F.ws + WS_MOD); const float* ng3 = F.in[I_NG] + 3 * D; const float* po = (const float*)(F.ws + WS_PO);
    for (int m = F.bid * NWAVES + F.wave; m < MX; m += F.G * NWAVES) {
        const float* gt2 = mod + (m >> 12) * NMOD + 5 * D;
        f32x4 v[4]; float ss = 0.f;
#pragma unroll
        for (int j = 0; j < 4; ++j) { v[j] = *(const f32x4*)(po + (size_t)m * D + j * 256 + F.lane * 4); ss += v[j].x * v[j].x + v[j].y * v[j].y + v[j].z * v[j].z + v[j].w * v[j].w; }
        const float rstd = __builtin_amdgcn_rsqf(wave_sum(ss) * (1.f / D) + NORM_EPS);
#pragma unroll
        for (int j = 0; j < 4; ++j) { const int c = j * 256 + F.lane * 4; float* op = F.out + (size_t)m * D + c;
            const f32x4 x1 = *(const f32x4*)op, g = *(const f32x4*)(ng3 + c), gt = *(const f32x4*)(gt2 + c);
            *(f32x4*)op = x1 + gt * (v[j] * rstd * g); }
    }
}
struct Args { const float* in[25]; float* out; unsigned char* ws; int ph_lo, ph_hi; };
__global__ void __launch_bounds__(NWAVES * 64, 2) mk_fwd(Args args) {
    extern __shared__ __attribute__((aligned(16))) unsigned char lds_raw[];
    Frame F;
    F.lds = (LAS unsigned char*)lds_raw;
    F.MISC = (volatile LAS unsigned*)(F.lds + MISC_OFF);
    F.tid = threadIdx.x; F.lane = F.tid & 63; F.wave = __builtin_amdgcn_readfirstlane(F.tid >> 6);
    F.G = gridDim.x; F.bid = blockIdx.x;
#pragma unroll
    for (int i = 0; i < 25; ++i) F.in[i] = args.in[i];
    F.out = args.out; F.ws = args.ws; F.ctl = (gu32*)(args.ws + WS_CTL);
    for (int u = F.tid; u < (LDS_BYTES - LDSCTL_OFF) / 4; u += NWAVES * 64) ((LAS unsigned*)(F.lds + LDSCTL_OFF))[u] = 0u;
    __syncthreads();
    const int lo = args.ph_lo, hi = args.ph_hi;
    XcdBarrier bar; bar.bar = (unsigned*)(F.ctl + CW_BAR); bar.x = 0; bar.st = nullptr;
    if (hi - lo > 1) bar = xcd_barrier_post((unsigned*)(F.ctl + CW_BAR), F.MISC + 8);
#ifndef PROBE_LO
#define PROBE_LO -1
#define PROBE_HI -1
#endif
#define IN(k) (lo <= (k) && (k) < hi)
#define SEAM(k) do { if (IN(k) && IN((k) + 1)) xcd_barrier(bar); } while (0)
#define PH0 { p0_prep(F); }
#define PH1 { p1_hx(F); }
#define PH2 { pg8::Gemm g{(const pg8::bf16_t*)(F.ws + WS_HX), (const pg8::bf16_t*)(F.ws + WS_WINT), MA, NPROJ_PAD, D}; pg8::StaticOrder S; S.init(MA, NPROJ_PAD, F.G, F.bid); \
        pg8::EpiProj E{(pg8::bf16_t*)(F.ws + WS_PROJ), NPROJ, NPROJ}; \
        pg8::gemm_phase<pg8::EpiProj, pg8::StaticOrder, PG8_ALIGN, PG8_SP2>(F.lds, g, S, E); }
#define PH3 { p3_scan<0>(F, bar); }
#define PH4 { p4_mix(F); }
#define PH5 { pg8::Gemm g{(const pg8::bf16_t*)(F.ws + WS_HX), (const pg8::bf16_t*)(F.ws + WS_WOUTT), MX, D, D}; pg8::StaticOrder S; S.init(MX, D, F.G, F.bid); \
        pg8::EpiF32 E{(float*)(F.ws + WS_PROJ), D}; \
        pg8::gemm_phase<pg8::EpiF32, pg8::StaticOrder, PG8_ALIGN, PG8_SP2>(F.lds, g, S, E); }
#define PH6 { p6_mid(F); }
#define PH7 { pg8::Gemm g{(const pg8::bf16_t*)(F.ws + WS_HX), (const pg8::bf16_t*)(F.ws + WS_WEFFT), MX, NSC, D}; pg8::StaticOrder S; S.init(MX, NSC, F.G, F.bid); \
        pg8::EpiF32 E{(float*)(F.ws + WS_PROJ), NSC}; \
        pg8::gemm_phase<pg8::EpiF32, pg8::StaticOrder, PG8_ALIGN, PG8_SP2>(F.lds, g, S, E); }
#define PH8 { p8a_route(F); }
#define PH9 { p9_upass(F); }
#define PH10 { p10_combine(F); }
#define PH11 { p11_vpass<0>(F); }
#define PH12 { p12_final(F); }
#define PRB(k, body) if constexpr (PROBE_LO <= (k) && (k) <= PROBE_HI) { xcd_barrier(bar); body }
    if (IN(0)) PH0 PRB(0, PH0) SEAM(0);
    if constexpr (PROBE_LO == 62) { for (int i = 0; i < 10; ++i) xcd_barrier(bar); }
    if constexpr (PROBE_LO == 65 || PROBE_LO == 66) { const unsigned long long t0 = __builtin_amdgcn_s_memrealtime(); while (__builtin_amdgcn_s_memrealtime() - t0 < 60000ull) __builtin_amdgcn_s_sleep(8); }
    if constexpr (PROBE_LO == 66) { for (int i = 0; i < 10; ++i) xcd_barrier(bar); }
    if (IN(1)) PH1 PRB(1, PH1) SEAM(1);
    if (IN(2)) PH2 PRB(2, PH2) SEAM(2);
    if constexpr (PROBE_LO == 33) { p3_scan<1>(F, bar); xcd_barrier(bar); }
    if constexpr (PROBE_LO == 51) { p3_scan<11>(F, bar); xcd_barrier(bar); }
    if constexpr (PROBE_LO == 52) { p3_scan<12>(F, bar); xcd_barrier(bar); }
    if constexpr (PROBE_LO == 53) { p3_scan<13>(F, bar); xcd_barrier(bar); }
    if constexpr (PROBE_LO == 54) { p3_scan<14>(F, bar); xcd_barrier(bar); }
    if constexpr (PROBE_LO == 55) { p3_scan<15>(F, bar); xcd_barrier(bar); }
    if constexpr (PROBE_LO == 56) { p3_scan<16>(F, bar); xcd_barrier(bar); }
    if constexpr (PROBE_LO == 57) { p3_scan<17>(F, bar); xcd_barrier(bar); }
    if constexpr (PROBE_LO == 58) { p3_scan<31>(F, bar); xcd_barrier(bar); }
    if constexpr (PROBE_LO == 59) { p3_scan<40>(F, bar); xcd_barrier(bar); }
    if constexpr (PROBE_LO == 60) { p3_scan<41>(F, bar); xcd_barrier(bar); }
    if constexpr (PROBE_LO == 61) { for (int i = 0; i < 10; ++i) xcd_barrier(bar); }
    if constexpr (PROBE_LO == 34) { p3_scan<2>(F, bar); xcd_barrier(bar); }
    if constexpr (PROBE_LO == 35) { p3_scan<21>(F, bar); xcd_barrier(bar); }
    if (IN(3)) PH3 PRB(3, PH3) SEAM(3);
    if constexpr (PROBE_LO == 63) { for (int i = 0; i < 10; ++i) xcd_barrier(bar); }
    if (IN(4)) PH4 PRB(4, PH4) SEAM(4);
    if constexpr (PROBE_LO == 67) { for (int i = 0; i < 10; ++i) xcd_barrier(bar); }
    if (IN(5)) PH5 PRB(5, PH5) SEAM(5);
    if constexpr (PROBE_LO == 68) { for (int i = 0; i < 10; ++i) xcd_barrier(bar); }
    if (IN(6)) PH6 PRB(6, PH6) SEAM(6);
    if constexpr (PROBE_LO == 69) { for (int i = 0; i < 10; ++i) xcd_barrier(bar); }
    if (IN(7)) PH7 PRB(7, PH7) SEAM(7);
    if constexpr (PROBE_LO == 64) { for (int i = 0; i < 10; ++i) xcd_barrier(bar); }
    if (IN(8)) PH8 PRB(8, PH8) SEAM(8);
    if (IN(9)) PH9 PRB(9, PH9) SEAM(9);
    if (IN(10)) PH10 PRB(10, PH10) SEAM(10);
    if constexpr (PROBE_LO == 111) { p11_vpass<1>(F); xcd_barrier(bar); }
    if constexpr (PROBE_LO == 112) { p11_vpass<2>(F); xcd_barrier(bar); }
    if (IN(11)) PH11 PRB(11, PH11) SEAM(11);
    if (IN(12)) PH12
#undef IN
#undef SEAM
}

extern "C" void kernel_launch(void* const* d_in, const int* in_sizes, int n_in, void* d_out, int out_size, void* d_ws, size_t ws_size, hipStream_t stream) {
    static int grid = 0;
    if (grid == 0) {
        if (n_in != 25 || in_sizes[0] != MX * D || out_size != MX * D || ws_size < WS_END) { fprintf(stderr, "kernel_launch: unexpected problem (n_in %d, in0 %d, out %d, ws %zu); nothing launched\n", n_in, n_in > 0 ? in_sizes[0] : -1, out_size, ws_size); grid = -1; return; }
        int dev = 0, cus = 0, per_cu = 0;
        if (hipGetDevice(&dev) != hipSuccess || hipDeviceGetAttribute(&cus, hipDeviceAttributeMultiprocessorCount, dev) != hipSuccess) { fprintf(stderr, "kernel_launch: device query failed\n"); grid = -1; return; }
        if (hipFuncSetAttribute((const void*)mk_fwd, hipFuncAttributeMaxDynamicSharedMemorySize, LDS_BYTES) != hipSuccess) { fprintf(stderr, "kernel_launch: hipFuncSetAttribute failed\n"); grid = -1; return; }
        if (hipOccupancyMaxActiveBlocksPerMultiprocessor(&per_cu, (const void*)mk_fwd, NWAVES * 64, LDS_BYTES) != hipSuccess || per_cu < 1) fprintf(stderr, "kernel_launch: occupancy query reports %d workgroups per CU\n", per_cu);
        (void)hipGetLastError();
        grid = cus;
        if (grid != 256) { fprintf(stderr, "kernel_launch: this build needs a 256-CU device (got %d); nothing launched\n", grid); grid = -1; return; }
    }
    if (grid < 0) return;
    if (hipMemsetAsync((char*)d_ws + WS_CTL, 0, CTL_ZERO_BYTES, stream) != hipSuccess) { fprintf(stderr, "kernel_launch: memset failed\n"); return; }
    Args a{};
    for (int i = 0; i < 25; ++i) a.in[i] = (const float*)d_in[i];
    a.out = (float*)d_out; a.ws = (unsigned char*)d_ws;
    if (MK_N_LAUNCHES == 1) { a.ph_lo = 0; a.ph_hi = NPH; hipLaunchKernelGGL(mk_fwd, dim3(grid), dim3(NWAVES * 64), LDS_BYTES, stream, a); }
    else for (int p = 0; p < NPH; ++p) { a.ph_lo = p; a.ph_hi = p + 1; hipLaunchKernelGGL(mk_fwd, dim3(grid), dim3(NWAVES * 64), LDS_BYTES, stream, a); }
    const hipError_t le = hipPeekAtLastError();
    if (le != hipSuccess) fprintf(stderr, "kernel_launch: launch failed: %s\n", hipGetErrorName(le));
}
```
